# Optimizing an MI355X kernel written in HIP

```python
import math
import jax
import jax.numpy as jnp
from jax import lax
import numpy as np


D_MODEL = 2048
BATCH = 2
SEQ = 4096
DEPTH = 4

GRID_W = 64
CTX_LEN = 256
N_EVEN = (DEPTH + 1) // 2
N_ODD = DEPTH // 2
EPS = 1e-6

GLA_HEADS = 4
GLA_DK = 128
GLA_DV = 256
GLA_GATE_RANK = 16
GLA_TAU = 16.0
GLA_CHUNK = 64
SC_WIDTH = 1024
DA_HEADS = 8
DA_DQK = 64
DA_DV = 128
ROPE_BASE = 10000.0
ROPE_PAIRS = DA_DQK // 4
Q_BLOCK = 128
ML_HEADS = 4
ML_DK = 128
ML_DV = 256
ML_CHUNK = 64
D_FF = 5632

EVEN_SIZES = (GLA_HEADS * GLA_DK, GLA_HEADS * GLA_DK, GLA_HEADS * GLA_DV, GLA_HEADS * GLA_DV,
              2 * GLA_GATE_RANK, SC_WIDTH, SC_WIDTH, SC_WIDTH)
ODD_SIZES = (DA_HEADS * 2 * DA_DQK, DA_HEADS * 2 * DA_DQK, DA_HEADS * DA_DV,
             ML_HEADS * ML_DK, ML_HEADS * ML_DK, ML_HEADS * ML_DV, ML_HEADS * ML_DV, 4 * ML_HEADS)
EVEN_IN = sum(EVEN_SIZES)
ODD_IN = sum(ODD_SIZES)
EVEN_MIX = GLA_HEADS * GLA_DV + SC_WIDTH
ODD_MIX = DA_HEADS * DA_DV + ML_HEADS * ML_DV

kernel_name = 'hybrid_prefix_diffusion_trunk'


def _rmsnorm(x, g):
    xf = x.astype(jnp.float32)
    y = xf * lax.rsqrt(jnp.mean(xf * xf, axis=-1, keepdims=True) + EPS)
    return (y * g.astype(jnp.float32)).astype(x.dtype)


def _dwconv3(x, w):
    xp = jnp.pad(x, ((0, 0), (1, 1), (0, 0)))
    return xp[:, :-2] * w[0] + xp[:, 1:-1] * w[1] + xp[:, 2:] * w[2]


def _split(a, sizes):
    idx = [int(i) for i in np.cumsum(sizes)[:-1]]
    return jnp.split(a, idx, axis=-1)


def _to_heads(a, h):
    b, n, _ = a.shape
    return a.reshape(b, n, h, -1).transpose(0, 2, 1, 3)


def _from_heads(a):
    b, h, n, d = a.shape
    return a.transpose(0, 2, 1, 3).reshape(b, n, h * d)


def _to_chunks(a, size):
    n = a.shape[2]
    a = a.reshape(a.shape[:2] + (n // size, size) + a.shape[3:])
    return jnp.moveaxis(a, 2, 0).astype(jnp.float32)


def _from_chunks(o):
    o = jnp.moveaxis(o, 0, 2)
    return o.reshape(o.shape[:2] + (-1, o.shape[-1]))


def _gla_scan(q, k, v, g, s0):
    L = GLA_CHUNK
    mask = jnp.tril(jnp.ones((L, L), dtype=bool))[:, :, None]

    def step(S, inp):
        qc, kc, vc, gc = inp
        b = jnp.cumsum(gc, axis=2)
        o_inter = jnp.einsum('bhld,bhde->bhle', qc * jnp.exp(b), S)
        rel = jnp.where(mask, b[:, :, :, None, :] - b[:, :, None, :, :], -jnp.inf)
        A = jnp.einsum('bhijd,bhjd->bhij', qc[:, :, :, None, :] * jnp.exp(rel), kc)
        o_intra = jnp.einsum('bhij,bhje->bhie', A, vc)
        b_last = b[:, :, -1:, :]
        S_new = jnp.exp(b_last[:, :, 0, :])[..., None] * S + jnp.einsum(
            'bhld,bhle->bhde', kc * jnp.exp(b_last - b), vc)
        return S_new, o_inter + o_intra

    S, o = lax.scan(step, s0, tuple(_to_chunks(a, L) for a in (q, k, v, g)))
    return _from_chunks(o), S


def _mlstm_scan(q, k, v, ig, fg, state):
    L = ML_CHUNK
    mask = jnp.tril(jnp.ones((L, L), dtype=bool))

    def step(carry, inp):
        C, n, m = carry
        qc, kc, vc, ic, fc = inp
        b = jnp.cumsum(jax.nn.log_sigmoid(fc), axis=-1)
        a = b + m[..., None]
        dmat = jnp.where(mask, b[..., :, None] - b[..., None, :] + ic[..., None, :], -jnp.inf)
        m_t = jnp.maximum(a, jnp.max(dmat, axis=-1))
        w_inter = jnp.exp(a - m_t)
        s = jnp.einsum('bhtd,bhsd->bhts', qc, kc) * jnp.exp(dmat - m_t[..., None])
        num = w_inter[..., None] * jnp.einsum('bhtd,bhde->bhte', qc, C) + jnp.einsum('bhts,bhse->bhte', s, vc)
        den = w_inter * jnp.einsum('bhtd,bhd->bht', qc, n) + jnp.sum(s, axis=-1)
        h = num / jnp.maximum(jnp.abs(den), jnp.exp(-m_t))[..., None]
        b_last = b[..., -1]
        g_s = b_last[..., None] - b + ic
        m_new = jnp.maximum(b_last + m, jnp.max(g_s, axis=-1))
        carry_decay = jnp.exp(b_last + m - m_new)
        w_s = jnp.exp(g_s - m_new[..., None])
        C_new = carry_decay[..., None, None] * C + jnp.einsum('bhs,bhsd,bhse->bhde', w_s, kc, vc)
        n_new = carry_decay[..., None] * n + jnp.einsum('bhs,bhsd->bhd', w_s, kc)
        return (C_new, n_new, m_new), h

    state, h = lax.scan(step, state, tuple(_to_chunks(a, L) for a in (q, k, v, ig, fg)))
    return _from_chunks(h), state


def _bidir_prefix_scan(scan_fn, init, ctx_fwd, lat_fwd, ctx_bwd, lat_bwd):
    flip = lambda t: tuple(jnp.flip(a, axis=2) for a in t)
    oc_f, st_f = scan_fn(*ctx_fwd, init)
    ol_f, _ = scan_fn(*lat_fwd, st_f)
    oc_b, st_b = scan_fn(*flip(ctx_bwd), init)
    ol_b, _ = scan_fn(*flip(lat_bwd), st_b)
    return oc_f + jnp.flip(oc_b, axis=2), ol_f + jnp.flip(ol_b, axis=2)


def _axial_rope_tables(n_lat):
    rows = n_lat // GRID_W
    row = jnp.repeat(jnp.arange(rows, dtype=jnp.float32), GRID_W)
    col = jnp.tile(jnp.arange(GRID_W, dtype=jnp.float32), rows)
    inv = jnp.power(ROPE_BASE, -jnp.arange(ROPE_PAIRS, dtype=jnp.float32) / ROPE_PAIRS)
    ang_r = row[:, None] * inv
    ang_c = col[:, None] * inv
    return (jnp.cos(ang_r), jnp.sin(ang_r), jnp.cos(ang_c), jnp.sin(ang_c))


def _rope_half(x, cos, sin):
    x1, x2 = jnp.split(x, 2, axis=-1)
    return jnp.concatenate([x1 * cos - x2 * sin, x1 * sin + x2 * cos], axis=-1)


def _axial_rope(x, tabs):
    cr, sr, cc, sc = (t[None, :, None, None, :] for t in tabs)
    xr, xc = jnp.split(x, 2, axis=-1)
    return jnp.concatenate([_rope_half(xr, cr, sr), _rope_half(xc, cc, sc)], axis=-1).astype(x.dtype)


def _diff_softmax(q, k, v, lam):
    s = jnp.einsum('bqhmd,bkhmd->bhmqk', q, k).astype(jnp.float32) * (DA_DQK ** -0.5)
    p = jax.nn.softmax(s, axis=-1)
    w = p[:, :, 0] - lam * p[:, :, 1]
    return jnp.einsum('bhqk,bkhe->bqhe', w.astype(v.dtype), v)


def _even_mixer(hc, hl, w_in, w_out, gate_w2, gate_b, gla_norm_g, sc_conv_w):
    def project(h):
        q, k, v, r, glr, sx, sb, scg = _split(h @ w_in, EVEN_SIZES)
        glr_f, glr_b = jnp.split(glr, 2, axis=-1)
        g_f = jax.nn.log_sigmoid(glr_f @ gate_w2[0] + gate_b[0]) / GLA_TAU
        g_b = jax.nn.log_sigmoid(glr_b @ gate_w2[1] + gate_b[1]) / GLA_TAU
        qkv = (_to_heads(q, GLA_HEADS) * (GLA_DK ** -0.5), _to_heads(k, GLA_HEADS), _to_heads(v, GLA_HEADS))
        conv_out = sb * _dwconv3(scg * sx, sc_conv_w)
        return qkv + (_to_heads(g_f, GLA_HEADS),), qkv + (_to_heads(g_b, GLA_HEADS),), r, conv_out

    fc, bc, rc, cc = project(hc)
    fl, bl, rl, cl = project(hl)
    bsz = hl.shape[0]
    init = jnp.zeros((bsz, GLA_HEADS, GLA_DK, GLA_DV), jnp.float32)
    oc, ol = _bidir_prefix_scan(_gla_scan, init, fc, fl, bc, bl)

    def finish(o, r, conv_out):
        o = _from_heads(_rmsnorm(o.astype(r.dtype), gla_norm_g)) * jax.nn.silu(r)
        return jnp.concatenate([o, conv_out], axis=-1) @ w_out

    return finish(oc, rc, cc), finish(ol, rl, cl)


def _odd_mixer(hc, hl, rope_tabs, layer, w_in, w_out, qn_g, kn_g, lam_p, subln_g,
               ml_conv_w, ml_gate_b, ml_norm_g):
    lam_init = 0.8 - 0.6 * math.exp(-0.3 * layer)
    lam = (jnp.exp(jnp.sum(lam_p[0] * lam_p[1]).astype(jnp.float32))
           - jnp.exp(jnp.sum(lam_p[2] * lam_p[3]).astype(jnp.float32)) + lam_init)

    def project(h, tabs):
        bsz, n, _ = h.shape
        dq, dk, dv, mq, mk, mv, mo, mg = _split(h @ w_in, ODD_SIZES)
        q = _rmsnorm(dq.reshape(bsz, n, DA_HEADS, 2, DA_DQK), qn_g)
        k = _rmsnorm(dk.reshape(bsz, n, DA_HEADS, 2, DA_DQK), kn_g)
        if tabs is not None:
            q = _axial_rope(q, tabs)
            k = _axial_rope(k, tabs)
        v = dv.reshape(bsz, n, DA_HEADS, DA_DV)
        mqk = jax.nn.silu(_dwconv3(jnp.concatenate([mq, mk], axis=-1), ml_conv_w))
        mq, mk = jnp.split(mqk, 2, axis=-1)
        gates = (mg + ml_gate_b).reshape(bsz, n, 2, 2, ML_HEADS)
        gates = jnp.moveaxis(gates, 1, -1).astype(jnp.float32)
        hq, hk, hv = _to_heads(mq, ML_HEADS), _to_heads(mk, ML_HEADS) * (ML_DK ** -0.5), _to_heads(mv, ML_HEADS)
        fwd = (hq, hk, hv, gates[:, 0, 0], gates[:, 0, 1])
        bwd = (hq, hk, hv, gates[:, 1, 0], gates[:, 1, 1])
        return (q, k, v), fwd, bwd, mo

    (qc, kc, vc), fc, bc, moc = project(hc, None)
    (ql, kl, vl), fl, bl, mol = project(hl, rope_tabs)

    da_c = _diff_softmax(qc, kc, vc, lam)
    bsz, n_lat = ql.shape[:2]
    k_all = jnp.concatenate([kc, kl], axis=1)
    v_all = jnp.concatenate([vc, vl], axis=1)
    qb = jnp.moveaxis(ql.reshape((bsz, n_lat // Q_BLOCK, Q_BLOCK) + ql.shape[2:]), 1, 0)
    da_l = lax.map(lambda qq: _diff_softmax(qq, k_all, v_all, lam), qb)
    da_l = jnp.moveaxis(da_l, 0, 1).reshape(bsz, n_lat, DA_HEADS, DA_DV)

    init = (jnp.zeros((bsz, ML_HEADS, ML_DK, ML_DV), jnp.float32),
            jnp.zeros((bsz, ML_HEADS, ML_DK), jnp.float32),
            jnp.zeros((bsz, ML_HEADS), jnp.float32))
    mc, ml = _bidir_prefix_scan(_mlstm_scan, init, fc, fl, bc, bl)

    def finish(da, m, mo):
        b_, n_ = da.shape[:2]
        da = (_rmsnorm(da, subln_g) * (1.0 - lam_init)).reshape(b_, n_, DA_HEADS * DA_DV)
        m = _from_heads(_rmsnorm(m.astype(mo.dtype), ml_norm_g)) * jax.nn.sigmoid(mo)
        return jnp.concatenate([da, m], axis=-1) @ w_out

    return finish(da_c, mc, moc), finish(da_l, ml, mol)


def _conv_ffn(h, w_up, conv_w, conv_b, w_down):
    gate, val = jnp.split(h @ w_up, 2, axis=-1)
    return (jax.nn.silu(_dwconv3(gate, conv_w) + conv_b) * val) @ w_down


def setup_inputs(seed: int = 0) -> dict:
    key = jax.random.key(seed)
    ks = iter(jax.random.split(key, 40))
    f32 = jnp.float32
    D = D_MODEL
    nrm = lambda shape, scale: scale * jax.random.normal(next(ks), shape, f32)
    gain = lambda shape: 1.0 + 0.02 * jax.random.normal(next(ks), shape, f32)
    ib = 0.1 * jax.random.normal(next(ks), (N_ODD, 2, 1, ML_HEADS), f32)
    fb = jax.random.uniform(next(ks), (N_ODD, 2, 1, ML_HEADS), f32, 3.0, 6.0)
    return {
        'x': nrm((BATCH, SEQ, D), 1.0),
        'c': nrm((BATCH, D), 1.0),
        'ctx': nrm((BATCH, CTX_LEN, D), 1.0),
        'c_ctx': nrm((D,), 1.0),
        'ada_w': nrm((DEPTH, D, 6 * D), 0.3 * D ** -0.5),
        'ada_b': nrm((DEPTH, 6 * D), 0.02),
        'norm1_g': gain((DEPTH, D)),
        'norm2_g': gain((DEPTH, D)),
        'ev_w_in': nrm((N_EVEN, D, EVEN_IN), D ** -0.5),
        'ev_w_out': nrm((N_EVEN, EVEN_MIX, D), EVEN_MIX ** -0.5),
        'gla_gate_w2': nrm((N_EVEN, 2, GLA_GATE_RANK, GLA_HEADS * GLA_DK), GLA_GATE_RANK ** -0.5),
        'gla_gate_b': nrm((N_EVEN, 2, GLA_HEADS * GLA_DK), 0.1),
        'gla_norm_g': gain((N_EVEN, GLA_DV)),
        'sc_conv_w': nrm((N_EVEN, 3, SC_WIDTH), 3 ** -0.5),
        'od_w_in': nrm((N_ODD, D, ODD_IN), D ** -0.5),
        'od_w_out': nrm((N_ODD, ODD_MIX, D), ODD_MIX ** -0.5),
        'da_qnorm_g': gain((N_ODD, DA_DQK)),
        'da_knorm_g': gain((N_ODD, DA_DQK)),
        'da_lambda': nrm((N_ODD, 4, DA_DQK), 0.1),
        'da_subln_g': gain((N_ODD, DA_DV)),
        'ml_conv_w': nrm((N_ODD, 3, 2 * ML_HEADS * ML_DK), 3 ** -0.5),
        'ml_gate_b': jnp.concatenate([ib, fb], axis=2).reshape(N_ODD, 4 * ML_HEADS),
        'ml_norm_g': gain((N_ODD, ML_DV)),
        'ffn_w_up': nrm((DEPTH, D, 2 * D_FF), D ** -0.5),
        'ffn_conv_w': nrm((DEPTH, 3, D_FF), 3 ** -0.5),
        'ffn_conv_b': nrm((DEPTH, D_FF), 0.02),
        'ffn_w_down': nrm((DEPTH, D_FF, D), D_FF ** -0.5),
    }


def reference(x, c, ctx, c_ctx, ada_w, ada_b, norm1_g, norm2_g, ev_w_in, ev_w_out, gla_gate_w2,
              gla_gate_b, gla_norm_g, sc_conv_w, od_w_in, od_w_out, da_qnorm_g, da_knorm_g, da_lambda,
              da_subln_g, ml_conv_w, ml_gate_b, ml_norm_g, ffn_w_up, ffn_conv_w, ffn_conv_b, ffn_w_down):
    n_lat = x.shape[1]
    rope_tabs = _axial_rope_tables(n_lat)
    xl, xc = x, ctx
    for layer in range(DEPTH):
        last = layer == DEPTH - 1
        mod_l = (jax.nn.silu(c) @ ada_w[layer] + ada_b[layer])[:, None, :]
        mod_c = (jax.nn.silu(c_ctx) @ ada_w[layer] + ada_b[layer])[None, None, :]
        sh1_l, sc1_l, g1_l, sh2_l, sc2_l, g2_l = jnp.split(mod_l, 6, axis=-1)
        sh1_c, sc1_c, g1_c, sh2_c, sc2_c, g2_c = jnp.split(mod_c, 6, axis=-1)

        hl = _rmsnorm(xl, norm1_g[layer]) * (1.0 + sc1_l) + sh1_l
        hc = _rmsnorm(xc, norm1_g[layer]) * (1.0 + sc1_c) + sh1_c
        if layer % 2 == 0:
            i = layer // 2
            oc, ol = _even_mixer(hc, hl, ev_w_in[i], ev_w_out[i], gla_gate_w2[i], gla_gate_b[i],
                                 gla_norm_g[i], sc_conv_w[i])
        else:
            i = layer // 2
            oc, ol = _odd_mixer(hc, hl, rope_tabs, layer, od_w_in[i], od_w_out[i], da_qnorm_g[i],
                                da_knorm_g[i], da_lambda[i], da_subln_g[i], ml_conv_w[i],
                                ml_gate_b[i], ml_norm_g[i])
        xl = xl + g1_l * ol
        hl = _rmsnorm(xl, norm2_g[layer]) * (1.0 + sc2_l) + sh2_l
        xl = xl + g2_l * _conv_ffn(hl, ffn_w_up[layer], ffn_conv_w[layer], ffn_conv_b[layer], ffn_w_down[layer])
        if not last:
            xc = xc + g1_c * oc
            hc = _rmsnorm(xc, norm2_g[layer]) * (1.0 + sc2_c) + sh2_c
            xc = xc + g2_c * _conv_ffn(hc, ffn_w_up[layer], ffn_conv_w[layer], ffn_conv_b[layer], ffn_w_down[layer])
    return xl
```

```cpp
#include <hip/hip_runtime.h>
#include <cstdio>
#include <cstdint>
namespace pg8 {
#define PG8_LAS __attribute__((address_space(3)))
typedef unsigned short bf16_t;
typedef short bf16x8 __attribute__((ext_vector_type(8)));
typedef float f32x4 __attribute__((ext_vector_type(4)));
typedef unsigned u32x4 __attribute__((ext_vector_type(4)));
constexpr int BM = 256, BK = 64, HALF = 128, HTB = HALF * BK * 2  , STAGE_BYTES = 8 * HTB, NXCD = 8, WGM = 8;

__host__ __device__ __forceinline__ int lds_byte(int r, int c) { const int st = (r >> 4) * 2 + (c >> 5), rr = r & 15, cc = c & 31, ob = rr * 64 + cc * 2; return st * 1024 + (ob ^ (((ob >> 9) & 1) << 5)); }
__host__ __device__ __forceinline__ void stage_rc(int b, int& R, int& C) { const int st = b / 1024, sb = b % 1024, swz = sb ^ (((sb >> 9) & 1) << 5); R = (st >> 1) * 16 + swz / 64; C = (st & 1) * 32 + (swz % 64) / 2; }
__host__ __device__ __forceinline__ int perm32(int rho) { const int n = rho >> 4, i = rho & 15; return 8 * (i >> 2) + 4 * n + (i & 3); }

struct Unit { int pm, pn; };
struct Gemm { const bf16_t* A; const bf16_t* Bt; int M, N, K; };

struct StaticOrder {
    int nM, nN, nwg, G, c;
    __host__ __device__ void init(int M, int N, int G_, int c_) { nM = M / BM; nN = N / BM; nwg = nM * nN; G = G_; c = c_; }
    __host__ __device__ bool next(int i, Unit& u) const {
        const long L = (long)i * G + c; if (L >= nwg) return false;
        int wgid = (int)L; { const int q = nwg / NXCD, r = nwg % NXCD, xcd = wgid % NXCD, off = wgid / NXCD; wgid = (xcd < r ? xcd * (q + 1) : r * (q + 1) + (xcd - r) * q) + off; }
        const int nig = WGM * nN, gid = wgid / nig, fm = gid * WGM, gsz = (nM - fm) < WGM ? (nM - fm) : WGM;
        u.pm = fm + ((wgid % nig) % gsz); u.pn = (wgid % nig) / gsz; return true;
    }
    __device__ __forceinline__ void a_ready(const Unit&) const {}
    __device__ __forceinline__ void done(const Unit&) const {}
};
__device__ __forceinline__ unsigned cvt_pk_bf16(float lo, float hi) { unsigned r; asm volatile("v_cvt_pk_bf16_f32 %0, %1, %2" : "=v"(r) : "v"(lo), "v"(hi)); return r; }

struct EpiStore {
    static constexpr bool PERM = true, AFTER_DRAIN = false;
    bf16_t* O; int ldc;
    __device__ __forceinline__ void operator()(const f32x4 (&acc)[2][2][4][2], const Unit& u, int wr, int wc, int fr, int fq) const {
        const int row0 = u.pm * BM + wr * 64 + fr, col0 = u.pn * BM + wc * 32 + 8 * fq;
#pragma unroll
        for (int ai = 0; ai < 2; ++ai)
#pragma unroll
            for (int m = 0; m < 4; ++m) { bf16_t* rowp = O + (size_t)(row0 + ai * HALF + m * 16) * ldc + col0;
#pragma unroll
                for (int bj = 0; bj < 2; ++bj) { const f32x4 v0 = acc[ai][bj][m][0], v1 = acc[ai][bj][m][1];
                    u32x4 w; w.x = cvt_pk_bf16(v0[0], v0[1]); w.y = cvt_pk_bf16(v0[2], v0[3]); w.z = cvt_pk_bf16(v1[0], v1[1]); w.w = cvt_pk_bf16(v1[2], v1[3]);
                    *(u32x4*)(rowp + bj * HALF) = w; } }
    }
};
struct EpiResid {
    static constexpr bool PERM = false, AFTER_DRAIN = false;
    float* X; const float* gate; float* out; int final_;
    __device__ __forceinline__ void operator()(const f32x4 (&acc)[2][2][4][2], const Unit& u, int wr, int wc, int fr, int fq) const {
        if (final_ && u.pm >= 32) return;
        const int mi = u.pm < 32 ? (u.pm >> 4) : 2;
        const float* g = gate + (size_t)mi * 12288;
        const int row0 = u.pm * BM + wr * 64 + fr, col0 = u.pn * BM + wc * 32 + 4 * fq;
        f32x4 gv[2][2];
#pragma unroll
        for (int bj = 0; bj < 2; ++bj)
#pragma unroll
            for (int n = 0; n < 2; ++n) gv[bj][n] = *(const f32x4*)(g + col0 + bj * HALF + n * 16);
#pragma unroll
        for (int ai = 0; ai < 2; ++ai)
#pragma unroll
            for (int m = 0; m < 4; ++m) { const size_t ro = (size_t)(row0 + ai * HALF + m * 16) * 2048 + col0; const float* xr = X + ro; float* orow = (final_ ? out : X) + ro;
#pragma unroll
                for (int bj = 0; bj < 2; ++bj)
#pragma unroll
                    for (int n = 0; n < 2; ++n) { const f32x4 xv = *(const f32x4*)(xr + bj * HALF + n * 16); *(f32x4*)(orow + bj * HALF + n * 16) = xv + gv[bj][n] * acc[ai][bj][m][n]; } }
    }
};
template <class Epi, class Sched, bool ALIGN_EPI = false, bool SP2 = false>
__device__ __forceinline__ void gemm_phase(PG8_LAS unsigned char* lds, const Gemm g, const Sched& S, const Epi& E) {
    int tid = threadIdx.x; asm volatile("" : "+v"(tid));
    const int wid = __builtin_amdgcn_readfirstlane(tid >> 6), lane = tid & 63, wr = wid >> 2, wc = wid & 3, fr = lane & 15, fq = lane >> 4;
    const int K = g.K, nt = K / BK;
    unsigned voffA[2], voffB[2];
#pragma unroll
    for (int i = 0; i < 2; ++i) { int R, C; stage_rc(tid * 16 + i * 8192, R, C); const int Rb = Epi::PERM ? ((R & ~31) + perm32(R & 31)) : R;
        voffA[i] = (unsigned)(R * K + C) * 2u; voffB[i] = (unsigned)(Rb * K + C) * 2u; }
    const size_t kstep = (size_t)(BK * 2);
    const size_t hstep = (size_t)HALF * K * 2;
    const size_t tstep = 2 * hstep;
    const unsigned ldsw = (unsigned)wid * 1024u;
    const int aoff = lds_byte(wr * 64 + fr, fq * 8), boff = lds_byte(wc * 32 + fr, fq * 8);
#define PG8_SA(b, h) (((b) * 2 + (h)) * HTB)
#define PG8_SB(b, h) ((4 + (b) * 2 + (h)) * HTB)
#define PG8_STAGE(bufoff, gbase, voff) do { _Pragma("unroll") for (int _i = 0; _i < 2; ++_i) \
        __builtin_amdgcn_global_load_lds((const unsigned*)((const char*)(gbase) + (voff)[_i]), (PG8_LAS unsigned*)(lds + (bufoff) + ldsw + _i * 8192), 16, 0, 0); } while (0)
#define PG8_LDA(dst, b, h) do { _Pragma("unroll") for (int m = 0; m < 4; ++m) _Pragma("unroll") for (int k = 0; k < 2; ++k) dst[m][k] = *(const PG8_LAS bf16x8*)(lds + PG8_SA(b, h) + aoff + m * 2048 + k * 1024); } while (0)
#define PG8_LDB(dst, b, h) do { _Pragma("unroll") for (int n = 0; n < 2; ++n) _Pragma("unroll") for (int k = 0; k < 2; ++k) dst[n][k] = *(const PG8_LAS bf16x8*)(lds + PG8_SB(b, h) + boff + n * 2048 + k * 1024); } while (0)
#define PG8_MMA(ai, bj, At, Bt) do { __builtin_amdgcn_s_setprio(1); _Pragma("unroll") for (int m = 0; m < 4; ++m) _Pragma("unroll") for (int n = 0; n < 2; ++n) _Pragma("unroll") for (int k = 0; k < 2; ++k) \
        acc[ai][bj][m][n] = __builtin_amdgcn_mfma_f32_16x16x32_bf16(Bt[n][k], At[m][k], acc[ai][bj][m][n], 0, 0, 0); __builtin_amdgcn_s_setprio(0); } while (0)
#define PG8_WAIT_V(n) asm volatile("s_waitcnt vmcnt(" #n ")" ::: "memory")
#define PG8_WAIT_L(n) asm volatile("s_waitcnt lgkmcnt(" #n ")" ::: "memory")
#define PG8_BAR __builtin_amdgcn_s_barrier()
#define PG8_SCHED __builtin_amdgcn_sched_barrier(0)
    Unit cur, nxt; int ui = 0;
    if (!S.next(0, cur)) return;
    f32x4 acc[2][2][4][2];
#pragma unroll
    for (int a = 0; a < 2; ++a)
#pragma unroll
        for (int b = 0; b < 2; ++b)
#pragma unroll
            for (int m = 0; m < 4; ++m)
#pragma unroll
                for (int n = 0; n < 2; ++n) acc[a][b][m][n] = (f32x4){0.f, 0.f, 0.f, 0.f};
    bf16x8 At[4][2], B0[2][2], B1[2][2];
    const char* cA = (const char*)g.A + (size_t)cur.pm * tstep; const char* cB = (const char*)g.Bt + (size_t)cur.pn * tstep;
    S.a_ready(cur);
    if constexpr (SP2) {
        PG8_STAGE(PG8_SB(0, 0), cB, voffB); PG8_STAGE(PG8_SB(0, 1), cB + hstep, voffB); PG8_STAGE(PG8_SA(0, 0), cA, voffA); PG8_STAGE(PG8_SA(0, 1), cA + hstep, voffA);
        if (wr == 1) PG8_BAR;
        PG8_WAIT_V(2); PG8_BAR;
        PG8_STAGE(PG8_SB(1, 0), cB + kstep, voffB); PG8_STAGE(PG8_SA(1, 0), cA + kstep, voffA); PG8_STAGE(PG8_SB(1, 1), cB + hstep + kstep, voffB);
        PG8_WAIT_V(6); PG8_BAR;
    } else {
        PG8_STAGE(PG8_SB(0, 0), cB, voffB); PG8_STAGE(PG8_SA(0, 0), cA, voffA); PG8_STAGE(PG8_SB(0, 1), cB + hstep, voffB); PG8_STAGE(PG8_SA(0, 1), cA + hstep, voffA);
        if (wr == 1) PG8_BAR;
        PG8_WAIT_V(4); PG8_BAR;
        PG8_STAGE(PG8_SB(1, 0), cB + kstep, voffB); PG8_STAGE(PG8_SA(1, 0), cA + kstep, voffA); PG8_STAGE(PG8_SB(1, 1), cB + hstep + kstep, voffB);
        PG8_WAIT_V(6); PG8_BAR;
    }
    for (;;) {
        const bool has_next = S.next(ui + 1, nxt);
        const char* nA = has_next ? (const char*)g.A + (size_t)nxt.pm * tstep : cA; const char* nB = has_next ? (const char*)g.Bt + (size_t)nxt.pn * tstep : cB;
        for (int t = 0; t < nt; t += 2) {
            const bool last = (t == nt - 2);
            const char* a1 = cA + (size_t)(t + 1) * kstep;
            const char* a2 = last ? nA : cA + (size_t)(t + 2) * kstep; const char* b2 = last ? nB : cB + (size_t)(t + 2) * kstep;
            const char* a3 = a2 + kstep; const char* b3 = b2 + kstep;
            if (last && has_next) S.a_ready(nxt);
            if constexpr (SP2) {
            PG8_LDB(B0, 0, 0); PG8_LDB(B1, 0, 1); PG8_SCHED; PG8_LDA(At, 0, 0); PG8_STAGE(PG8_SA(1, 1), a1 + hstep, voffA);
            PG8_WAIT_V(8); PG8_WAIT_L(0); PG8_BAR; PG8_MMA(0, 0, At, B0); PG8_MMA(0, 1, At, B1); PG8_BAR; PG8_SCHED;
            PG8_LDA(At, 0, 1); PG8_STAGE(PG8_SB(0, 0), b2, voffB); PG8_STAGE(PG8_SB(0, 1), b2 + hstep, voffB); PG8_STAGE(PG8_SA(0, 0), a2, voffA);
            PG8_WAIT_V(8); PG8_WAIT_L(0); PG8_BAR; PG8_MMA(1, 0, At, B0); PG8_MMA(1, 1, At, B1); PG8_BAR; PG8_SCHED;
            PG8_LDB(B0, 1, 0); PG8_LDB(B1, 1, 1); PG8_SCHED; PG8_LDA(At, 1, 0); PG8_STAGE(PG8_SA(0, 1), a2 + hstep, voffA);
            PG8_WAIT_V(8); PG8_WAIT_L(0); PG8_BAR; PG8_MMA(0, 0, At, B0); PG8_MMA(0, 1, At, B1); PG8_BAR; PG8_SCHED;
            PG8_LDA(At, 1, 1); PG8_STAGE(PG8_SB(1, 0), b3, voffB); PG8_STAGE(PG8_SB(1, 1), b3 + hstep, voffB); PG8_STAGE(PG8_SA(1, 0), a3, voffA);
            PG8_WAIT_V(8); PG8_WAIT_L(0); PG8_BAR; PG8_MMA(1, 0, At, B0); PG8_MMA(1, 1, At, B1); PG8_BAR; PG8_SCHED;
            } else {
            PG8_LDB(B0, 0, 0); PG8_SCHED; PG8_LDA(At, 0, 0); PG8_STAGE(PG8_SA(1, 1), a1 + hstep, voffA);
            PG8_WAIT_L(8); PG8_BAR; PG8_WAIT_L(0); PG8_MMA(0, 0, At, B0); PG8_BAR; PG8_SCHED;
            PG8_LDB(B1, 0, 1); PG8_STAGE(PG8_SB(0, 0), b2, voffB);
            PG8_BAR; PG8_WAIT_L(0); PG8_MMA(0, 1, At, B1); PG8_BAR;
            PG8_LDA(At, 0, 1); PG8_STAGE(PG8_SA(0, 0), a2, voffA);
            PG8_BAR; PG8_WAIT_L(0); PG8_MMA(1, 0, At, B0); PG8_BAR; PG8_SCHED;
            PG8_STAGE(PG8_SB(0, 1), b2 + hstep, voffB);
            PG8_WAIT_V(6); PG8_BAR; PG8_MMA(1, 1, At, B1); PG8_BAR;
            PG8_LDB(B0, 1, 0); PG8_SCHED; PG8_LDA(At, 1, 0); PG8_STAGE(PG8_SA(0, 1), a2 + hstep, voffA);
            PG8_WAIT_L(8); PG8_BAR; PG8_WAIT_L(0); PG8_MMA(0, 0, At, B0); PG8_BAR; PG8_SCHED;
            PG8_LDB(B1, 1, 1); PG8_STAGE(PG8_SB(1, 0), b3, voffB);
            PG8_BAR; PG8_WAIT_L(0); PG8_MMA(0, 1, At, B1); PG8_BAR;
            PG8_LDA(At, 1, 1); PG8_STAGE(PG8_SA(1, 0), a3, voffA);
            PG8_BAR; PG8_WAIT_L(0); PG8_MMA(1, 0, At, B0); PG8_BAR; PG8_SCHED;
            PG8_STAGE(PG8_SB(1, 1), b3 + hstep, voffB);
            PG8_WAIT_V(6); PG8_BAR; PG8_MMA(1, 1, At, B1); PG8_BAR;
            }
        }
        if constexpr (ALIGN_EPI) { if (wr == 0) PG8_BAR; }
        if constexpr (!Epi::AFTER_DRAIN) { E(acc, cur, wr, wc, fr, fq); S.done(cur); }
        if (!has_next) break;
#pragma unroll
        for (int a = 0; a < 2; ++a)
#pragma unroll
            for (int b = 0; b < 2; ++b)
#pragma unroll
                for (int m = 0; m < 4; ++m)
#pragma unroll
                    for (int n = 0; n < 2; ++n) acc[a][b][m][n] = (f32x4){0.f, 0.f, 0.f, 0.f};
        cur = nxt; cA = nA; cB = nB; ++ui;
        if constexpr (ALIGN_EPI) { if (wr == 1) PG8_BAR; }
    }
    PG8_WAIT_V(0);
    if constexpr (!ALIGN_EPI) { if (wr == 0) PG8_BAR; }
    PG8_BAR;
    if constexpr (Epi::AFTER_DRAIN) { E.fused(acc, cur, wr, wc, fr, fq, lds, wid, lane); S.done(cur); }
#undef PG8_SA
#undef PG8_SB
#undef PG8_STAGE
#undef PG8_LDA
#undef PG8_LDB
#undef PG8_MMA
#undef PG8_WAIT_V
#undef PG8_WAIT_L
#undef PG8_BAR
#undef PG8_SCHED
}
}
#define GAS __attribute__((address_space(1)))
#define LAS __attribute__((address_space(3)))
typedef unsigned short bf16;
typedef unsigned v4u __attribute__((ext_vector_type(4)));
typedef unsigned v2u __attribute__((ext_vector_type(2)));
typedef float f32x4 __attribute__((ext_vector_type(4)));
typedef float f32x16 __attribute__((ext_vector_type(16)));
typedef short bf16x8 __attribute__((ext_vector_type(8)));
typedef short s16x4 __attribute__((ext_vector_type(4)));
typedef GAS unsigned gu32;
#define RLX_AGENT __ATOMIC_RELAXED, __HIP_MEMORY_SCOPE_AGENT
#define XB_TMO      128
#define XB_XCNT(j)  (256  + 64 * (j))
#define XB_XSUB(j)  (1280 + 64 * (j))
#define XB_XGEN(j)  (2304 + 64 * (j))
#define XB_TOP      3328
#define XB_TOPGEN   3392
#define XCD_BAR_WORDS 3456
#define XB_SPIN_CAP (1u << 18)

__device__ __forceinline__ unsigned xb_ld(unsigned* p)              { return __hip_atomic_load(p, __ATOMIC_RELAXED, __HIP_MEMORY_SCOPE_AGENT); }
__device__ __forceinline__ unsigned xb_add(unsigned* p, unsigned v) { return __hip_atomic_fetch_add(p, v, __ATOMIC_RELAXED, __HIP_MEMORY_SCOPE_AGENT); }
__device__ __forceinline__ unsigned xb_xcc_id() { return (unsigned)__builtin_amdgcn_s_getreg((3 << 11) | 20) & 0xFu; }
#define XB_SPIN(cond, bar) do { unsigned _sp = 0; while (cond) { __builtin_amdgcn_s_sleep(1); \
    if ((++_sp & 255u) == 0u) { if (xb_ld(&(bar)[XB_TMO])) break; if (_sp > XB_SPIN_CAP) { atomicAdd(&(bar)[XB_TMO], 1u); break; } } } } while (0)

struct XcdBarrier {
    unsigned* bar; unsigned x;
    volatile LAS unsigned* st;
};

__device__ __forceinline__ XcdBarrier xcd_barrier_post(unsigned* bar, volatile LAS unsigned* st) {
    XcdBarrier b; b.bar = bar; b.x = xb_xcc_id(); b.st = st;
    if (threadIdx.x == 0) (void)xb_add(&bar[XB_XCNT(b.x)], 1u);
    return b;
}
__device__ __forceinline__ void xcd_barrier_complete(unsigned* bar, unsigned x, unsigned& nloc, unsigned& nx) {
    const unsigned G = gridDim.x * gridDim.y * gridDim.z;
    unsigned sum, cnt, mine, sp = 0u;
    for (;;) {
        sum = 0u; cnt = 0u; mine = 0u;
#pragma unroll
        for (unsigned j = 0; j < 16; ++j) { const unsigned c = xb_ld(&bar[XB_XCNT(j)]); sum += c; cnt += (c > 0u) ? 1u : 0u; mine = (j == x) ? c : mine; }
        if (sum == G) break;
        __builtin_amdgcn_s_sleep(1);
        if ((++sp & 255u) == 0u) { if (xb_ld(&bar[XB_TMO])) break; if (sp > XB_SPIN_CAP) { atomicAdd(&bar[XB_TMO], 1u); break; } }
    }
    nloc = mine > 0u ? mine : 1u; nx = cnt > 0u ? cnt : 1u;
}

__device__ __forceinline__ void xcd_barrier(const XcdBarrier& b) {
    asm volatile("s_waitcnt vmcnt(0)" ::: "memory");
    __syncthreads();
    if (threadIdx.x == 0) {
        unsigned* bar = b.bar;
        __builtin_amdgcn_s_waitcnt(0);
        unsigned nloc = b.st[0], nx = b.st[1];
        if (nloc == 0u) { xcd_barrier_complete(bar, b.x, nloc, nx); b.st[0] = nloc; b.st[1] = nx; }
        const unsigned old = xb_add(&bar[XB_XSUB(b.x)], 1u);
        const unsigned gen = old / nloc;
        if (old + 1u == (gen + 1u) * nloc) {
            __builtin_amdgcn_fence(__ATOMIC_RELEASE, "agent");
            asm volatile("s_waitcnt vmcnt(0)" ::: "memory");
            const unsigned og = xb_add(&bar[XB_TOP], 1u);
            const unsigned tg = og / nx;
            if (og + 1u == (tg + 1u) * nx) xb_add(&bar[XB_TOPGEN], 1u);
            else XB_SPIN(xb_ld(&bar[XB_TOPGEN]) == tg, bar);
            __builtin_amdgcn_fence(__ATOMIC_ACQUIRE, "agent");
            xb_add(&bar[XB_XGEN(b.x)], 1u);
            asm volatile("s_waitcnt vmcnt(0)" ::: "memory");
        } else {
            XB_SPIN(xb_ld(&bar[XB_XGEN(b.x)]) == gen, bar);
            __builtin_amdgcn_fence(__ATOMIC_ACQUIRE, "agent");
            asm volatile("s_waitcnt vmcnt(0)" ::: "memory");
        }
    }
    __syncthreads();
}
#ifndef ONE_LAUNCH
#define ONE_LAUNCH 0
#endif
#ifndef NLAYERS
#define NLAYERS 4
#endif
constexpr int DM = 2048, MR = 8704, NLATR = 8192;
constexpr int NINP = 6400, DFF = 5632, NUP = 11264, EVIN = 6176, ODIN = 6160;
constexpr int NWAVES = 8, NTHR = 512;
constexpr float EPS = 1e-6f;
constexpr int NCHUNK = 68;
constexpr int PPL = 11, NPH = 1 + 4 * PPL;
constexpr size_t MiB = 1ull << 20;
constexpr size_t WS_CTL = 0, CTL_BYTES = 1 * MiB;
constexpr size_t WS_MOD = 1 * MiB, WS_ROPE = 1 * MiB + 640 * 1024;
constexpr size_t WS_W = 4 * MiB, W_LAYER = 99 * MiB, W_OUT = 25 * MiB, W_UP = 33 * MiB, W_DN = 77 * MiB;
constexpr size_t WS_XS = 400 * MiB, WS_H = 468 * MiB, WS_MIX = 502 * MiB, WS_P = 536 * MiB, WS_U = 644 * MiB, WS_ACT = 832 * MiB;
constexpr size_t WS_QR = 926 * MiB, WS_KR = 943 * MiB, WS_MQK = 960 * MiB, WS_DST = 977 * MiB, WS_SST = 1113 * MiB, WS_SM = 1181 * MiB, WS_END = 1186 * MiB;
constexpr size_t SM_GAM = 0, SM_DN = 1 * MiB, SM_NIN = 2 * MiB, SM_BL = 3 * MiB, SM_ML = 3 * MiB + 8192, SM_MIN = 3 * MiB + 16384;
constexpr int CW_BAR = 4096;
constexpr int LDS_BYTES = 147456, MISC_OFF = 131072 + 320;

struct Args { const float* in[27]; float* out; unsigned char* ws; int ph_lo, ph_hi, li, pad; };

__device__ __forceinline__ float bf_lo(unsigned u) { return __builtin_bit_cast(float, u << 16); }
__device__ __forceinline__ float bf_hi(unsigned u) { return __builtin_bit_cast(float, u & 0xffff0000u); }
__device__ __forceinline__ float bf1(bf16 b) { return __builtin_bit_cast(float, (unsigned)b << 16); }
typedef float f32x2_t __attribute__((ext_vector_type(2))); typedef __bf16 bf16x2_t __attribute__((ext_vector_type(2)));
__device__ __forceinline__ unsigned pk2(float lo, float hi) { f32x2_t v = {lo, hi}; bf16x2_t b = __builtin_convertvector(v, bf16x2_t); return __builtin_bit_cast(unsigned, b); }
__device__ __forceinline__ bf16 f2bf(float f) { return (bf16)(pk2(f, 0.f) & 0xffffu); }
__device__ __forceinline__ void unpack8(const v4u w, float (&f)[8]) { f[0] = bf_lo(w.x); f[1] = bf_hi(w.x); f[2] = bf_lo(w.y); f[3] = bf_hi(w.y); f[4] = bf_lo(w.z); f[5] = bf_hi(w.z); f[6] = bf_lo(w.w); f[7] = bf_hi(w.w); }
__device__ __forceinline__ v4u pack8(const float (&f)[8]) { v4u w; w.x = pk2(f[0], f[1]); w.y = pk2(f[2], f[3]); w.z = pk2(f[4], f[5]); w.w = pk2(f[6], f[7]); return w; }
__device__ __forceinline__ float silu_f(float x) { return x / (1.f + __expf(-x)); }
__device__ __forceinline__ float sigmoid_f(float x) { return 1.f / (1.f + __expf(-x)); }
__device__ __forceinline__ float logsig_f(float z) { return fminf(z, 0.f) - log1pf(__expf(-fabsf(z))); }
__device__ __forceinline__ float wave_sum(float v) {
#pragma unroll
    for (int o = 1; o < 64; o <<= 1) v += __shfl_xor(v, o);
    return v;
}
__device__ __forceinline__ float wave_max(float v) {
#pragma unroll
    for (int o = 1; o < 64; o <<= 1) v = fmaxf(v, __shfl_xor(v, o));
    return v;
}
__device__ __forceinline__ float wave_scan_sum(float v, int dir, int lane) {
#pragma unroll
    for (int o = 1; o < 64; o <<= 1) { const float up = __shfl_up(v, o), dn = __shfl_down(v, o); if (dir == 0) { if (lane >= o) v += up; } else { if (lane + o < 64) v += dn; } }
    return v;
}
__device__ __forceinline__ float wave_scan_max(float v, int dir, int lane) {
#pragma unroll
    for (int o = 1; o < 64; o <<= 1) { const float up = __shfl_up(v, o), dn = __shfl_down(v, o); if (dir == 0) { if (lane >= o) v = fmaxf(v, up); } else { if (lane + o < 64) v = fmaxf(v, dn); } }
    return v;
}
__device__ __forceinline__ bool seq_start(int r) { return r < NLATR ? (r & 4095) == 0 : ((r - NLATR) & 255) == 0; }

__device__ __forceinline__ bf16x8 frag_row(LAS const unsigned char* base, int stride, int row0, int k0, int lane) {
    return *(LAS const bf16x8*)(base + (row0 + (lane & 31)) * stride + (k0 + 8 * (lane >> 5)) * 2);
}
__device__ __forceinline__ s16x4 tr4(LAS const unsigned char* p) { return __builtin_amdgcn_ds_read_tr16_b64_v4i16((LAS s16x4*)p); }
__device__ __forceinline__ bf16x8 frag_tr(LAS const unsigned char* base, int stride, int k0, int col0, int lane) {
    const int h = lane >> 5, blk = (lane >> 4) & 1, q = (lane & 15) >> 2, p = lane & 3;
    LAS const unsigned char* a = base + (k0 + 8 * h + q) * stride + (col0 + 16 * blk + 4 * p) * 2;
    const s16x4 lo = tr4(a), hi = tr4(a + 4 * stride);
    return (bf16x8){lo[0], lo[1], lo[2], lo[3], hi[0], hi[1], hi[2], hi[3]};
}
__device__ __forceinline__ bf16x8 frag_tr_perm(LAS const unsigned char* base, int stride, int k0, int col0, int lane) {
    const int h = lane >> 5, blk = (lane >> 4) & 1, q = (lane & 15) >> 2, p = lane & 3;
    LAS const unsigned char* a = base + (k0 + 4 * h + q) * stride + (col0 + 16 * blk + 4 * p) * 2;
    const s16x4 lo = tr4(a), hi = tr4(a + 8 * stride);
    return (bf16x8){lo[0], lo[1], lo[2], lo[3], hi[0], hi[1], hi[2], hi[3]};
}
#define MFMA32(a, b, c) __builtin_amdgcn_mfma_f32_32x32x16_bf16((a), (b), (c), 0, 0, 0)
__device__ __forceinline__ f32x16 zero16() { f32x16 z;
#pragma unroll
    for (int i = 0; i < 16; ++i) z[i] = 0.f;
    return z; }
__device__ __forceinline__ void load_tile(LAS unsigned char* dst, int ls, const bf16* src, size_t ld, int rows, int cols, int tid) {
    const int cpr = cols >> 3, n = rows * cpr;
    for (int c = tid; c < n; c += NTHR) { const int r = c / cpr, cc = c - r * cpr; *(LAS v4u*)(dst + r * ls + cc * 16) = *(const v4u*)(src + (size_t)r * ld + cc * 8); }
}

__device__ __forceinline__ void transpose_item(const float* W, int K, int N, int Npad, bf16* WT, LAS float* scr, int item, int lane) {
    const int nblk = Npad / 32, kb = item / nblk, nb = item - kb * nblk, k0 = 64 * kb, n0 = 32 * nb;
    const int n = n0 + (lane & 31);
#pragma unroll 8
    for (int i = 0; i < 32; ++i) { const int kk = 2 * i + (lane >> 5); scr[kk * 33 + (lane & 31)] = n < N ? W[(size_t)(k0 + kk) * N + n] : 0.f; }
    asm volatile("s_waitcnt lgkmcnt(0)" ::: "memory");
    const int c = lane & 7;
#pragma unroll
    for (int j = 0; j < 4; ++j) { const int nn = (lane >> 3) + 8 * j; const LAS float* s = scr + (8 * c) * 33 + nn;
        v4u o; o.x = pk2(s[0 * 33], s[1 * 33]); o.y = pk2(s[2 * 33], s[3 * 33]); o.z = pk2(s[4 * 33], s[5 * 33]); o.w = pk2(s[6 * 33], s[7 * 33]);
        *(v4u*)(WT + (size_t)(n0 + nn) * K + k0 + 8 * c) = o; }
    asm volatile("s_waitcnt lgkmcnt(0)" ::: "memory");
}
__device__ __forceinline__ void tr_matrix(const float* W, int K, int N, int Npad, bf16* WT, LAS float* scr, int& off, int gw, int NGW, int lane) {
    const int nitems = (K / 64) * (Npad / 32);
    int start = (gw - off) % NGW; if (start < 0) start += NGW;
    for (int it = start; it < nitems; it += NGW) transpose_item(W, K, N, Npad, WT, scr, it, lane);
    off = (off + nitems) % NGW;
}
__device__ __forceinline__ void ph_prologue(const Args& a, unsigned char* ws, LAS unsigned char* lds, int tid, int lane, int wave, int bid, int G) {
    float* MOD = (float*)(ws + WS_MOD);
    LAS float* vec = (LAS float*)(lds + 73728);
    LAS float* red = (LAS float*)(lds + 98304);
    for (int e = tid; e < 3 * DM; e += NTHR) { const float v = e < 2 * DM ? a.in[1][e] : a.in[3][e - 2 * DM]; vec[e] = silu_f(v); }
    __syncthreads();
    for (int it = bid; it < 4 * 48; it += G) {
        const int layer = it / 48, cg = it - layer * 48, col = cg * 256 + 4 * lane;
        const float* W = a.in[4] + (size_t)layer * DM * 12288 + col;
        f32x4 a0 = {0.f, 0.f, 0.f, 0.f}, a1 = a0, a2 = a0;
#pragma unroll 8
        for (int k = 0; k < 256; ++k) { const int kk = 256 * wave + k; const f32x4 w4 = *(const f32x4*)(W + (size_t)kk * 12288);
            a0 += w4 * vec[kk]; a1 += w4 * vec[DM + kk]; a2 += w4 * vec[2 * DM + kk]; }
        *(LAS f32x4*)(red + (wave * 3 + 0) * 256 + 4 * lane) = a0; *(LAS f32x4*)(red + (wave * 3 + 1) * 256 + 4 * lane) = a1; *(LAS f32x4*)(red + (wave * 3 + 2) * 256 + 4 * lane) = a2;
        __syncthreads();
        for (int e = tid; e < 768; e += NTHR) { const int j = e >> 8, c = e & 255; float s = a.in[5][layer * 12288 + cg * 256 + c];
#pragma unroll
            for (int w = 0; w < 8; ++w) s += red[(w * 3 + j) * 256 + c];
            MOD[(size_t)(layer * 3 + j) * 12288 + cg * 256 + c] = s; }
        __syncthreads();
    }
    if (bid == G - 1) { float* rope = (float*)(ws + WS_ROPE);
        for (int e = tid; e < 1024; e += NTHR) { const int pos = e >> 4, f = e & 15; const float inv = powf(10000.f, -(float)f / 16.f), ang = (float)pos * inv; rope[e] = cosf(ang); rope[1024 + e] = sinf(ang); } }
    { f32x4* XS = (f32x4*)(ws + WS_XS); const f32x4* x4 = (const f32x4*)a.in[0]; const f32x4* c4 = (const f32x4*)a.in[2];
      const int nl = NLATR * DM / 4, nt = MR * DM / 4;
      for (int e = bid * NTHR + tid; e < nt; e += G * NTHR) XS[e] = e < nl ? x4[e] : c4[e - nl]; }
    LAS float* scr = (LAS float*)(lds + wave * 8448);
    const int gw = bid * NWAVES + wave, NGW = G * NWAVES; int off = 0;
    for (int layer = 0; layer < 4; ++layer) {
        const int li = layer >> 1; unsigned char* wb = ws + WS_W + (size_t)layer * W_LAYER;
        if (layer & 1) tr_matrix(a.in[14] + (size_t)li * DM * ODIN, DM, ODIN, NINP, (bf16*)wb, scr, off, gw, NGW, lane);
        else           tr_matrix(a.in[8] + (size_t)li * DM * EVIN, DM, EVIN, NINP, (bf16*)wb, scr, off, gw, NGW, lane);
        tr_matrix((layer & 1 ? a.in[15] : a.in[9]) + (size_t)li * DM * DM, DM, DM, DM, (bf16*)(wb + W_OUT), scr, off, gw, NGW, lane);
        tr_matrix(a.in[23] + (size_t)layer * DM * NUP, DM, NUP, NUP, (bf16*)(wb + W_UP), scr, off, gw, NGW, lane);
        tr_matrix(a.in[26] + (size_t)layer * DFF * DM, DFF, DM, DM, (bf16*)(wb + W_DN), scr, off, gw, NGW, lane);
    }
}

__device__ __forceinline__ void ph_norm(const float* XS, const float* ng, const float* msh, const float* msc, bf16* H, int gw, int NGW, int lane) {
    for (int row = gw; row < MR; row += NGW) {
        const int mi = row < NLATR ? (row >> 12) : 2;
        const f32x4* xr = (const f32x4*)(XS + (size_t)row * DM) + lane;
        f32x4 v[8]; float ss = 0.f;
#pragma unroll
        for (int j = 0; j < 8; ++j) { v[j] = xr[64 * j]; ss += (v[j].x * v[j].x + v[j].y * v[j].y) + (v[j].z * v[j].z + v[j].w * v[j].w); }
        const float r = rsqrtf(wave_sum(ss) * (1.f / DM) + EPS);
#pragma unroll
        for (int j = 0; j < 8; ++j) { const int col = 4 * lane + 256 * j;
            const f32x4 g4 = *(const f32x4*)(ng + col), sc4 = *(const f32x4*)(msc + (size_t)mi * 12288 + col), sh4 = *(const f32x4*)(msh + (size_t)mi * 12288 + col);
            const f32x4 y = v[j] * r * g4 * (sc4 + 1.f) + sh4;
            v2u o; o.x = pk2(y.x, y.y); o.y = pk2(y.z, y.w);
            *(v2u*)(H + (size_t)row * DM + col) = o; }
    }
}

template <int MODE>
__device__ __forceinline__ void ph_conv(const bf16* SRC, const float* cw, const float* cb, bf16* DST, int gtid, int NT) {
    constexpr int NC = MODE == 0 ? DFF : 1024, NCG = NC / 8, NRB = MR / 16;
    constexpr int LDS_ = MODE == 0 ? NUP : NINP, LDD = MODE == 0 ? DFF : (MODE == 1 ? DM : 1024);
    for (int it = gtid; it < NRB * NCG; it += NT) {
        const int rb = it / NCG, cg = it - rb * NCG, r0 = rb * 16, c0 = cg * 8;
        float w0[8], w1[8], w2[8], bb[8];
#pragma unroll
        for (int j = 0; j < 8; ++j) { w0[j] = cw[c0 + j]; w1[j] = cw[NC + c0 + j]; w2[j] = cw[2 * NC + c0 + j]; bb[j] = MODE == 0 ? cb[c0 + j] : 0.f; }
        auto ld = [&](int r, float (&f)[8]) {
            if (MODE == 0) { unpack8(*(const v4u*)(SRC + (size_t)r * LDS_ + c0), f); }
            else if (MODE == 1) { float s1[8], s2[8]; unpack8(*(const v4u*)(SRC + (size_t)r * LDS_ + 3104 + c0), s1); unpack8(*(const v4u*)(SRC + (size_t)r * LDS_ + 5152 + c0), s2);
#pragma unroll
                for (int j = 0; j < 8; ++j) f[j] = s1[j] * s2[j]; }
            else { unpack8(*(const v4u*)(SRC + (size_t)r * LDS_ + 3072 + c0), f); }
        };
        float prev[8], cur[8], nxt[8];
        if (!seq_start(r0)) ld(r0 - 1, prev); else {
#pragma unroll
            for (int j = 0; j < 8; ++j) prev[j] = 0.f; }
        ld(r0, cur);
#pragma unroll 2
        for (int i = 0; i < 16; ++i) {
            const int r = r0 + i;
            if (i < 15 || !seq_start(r0 + 16)) ld(r + 1, nxt); else {
#pragma unroll
                for (int j = 0; j < 8; ++j) nxt[j] = 0.f; }
            float o[8];
            if (MODE == 0) { float vv[8]; unpack8(*(const v4u*)(SRC + (size_t)r * LDS_ + DFF + c0), vv);
#pragma unroll
                for (int j = 0; j < 8; ++j) o[j] = silu_f(w0[j] * prev[j] + w1[j] * cur[j] + w2[j] * nxt[j] + bb[j]) * vv[j]; }
            else if (MODE == 1) { float vv[8]; unpack8(*(const v4u*)(SRC + (size_t)r * LDS_ + 4128 + c0), vv);
#pragma unroll
                for (int j = 0; j < 8; ++j) o[j] = (w0[j] * prev[j] + w1[j] * cur[j] + w2[j] * nxt[j]) * vv[j]; }
            else { const float sc = c0 >= 512 ? 0.08838834764831845f : 1.f;
#pragma unroll
                for (int j = 0; j < 8; ++j) o[j] = silu_f(w0[j] * prev[j] + w1[j] * cur[j] + w2[j] * nxt[j]) * sc; }
            *(v4u*)(DST + (size_t)r * LDD + (MODE == 1 ? 1024 : 0) + c0) = pack8(o);
#pragma unroll
            for (int j = 0; j < 8; ++j) { prev[j] = cur[j]; cur[j] = nxt[j]; }
        }
    }
}

__device__ __forceinline__ void ph_qkprep(const bf16* P, const float* qg, const float* kg, const float* rope, bf16* QR, bf16* KR, int gw, int NGW, int lane) {
    for (int it = gw; it < MR * 4; it += NGW) {
        const int row = it >> 2, qtr = it & 3, isk = qtr >> 1;
        float x[8]; unpack8(*(const v4u*)(P + (size_t)row * NINP + isk * 1024 + (qtr & 1) * 512 + 8 * lane), x);
        float ss = 0.f;
#pragma unroll
        for (int j = 0; j < 8; ++j) ss += x[j] * x[j];
        ss += __shfl_xor(ss, 1); ss += __shfl_xor(ss, 2); ss += __shfl_xor(ss, 4);
        const float r = rsqrtf(ss * (1.f / 64.f) + EPS);
        const int i = lane & 7; const float* gp = (isk ? kg : qg) + 8 * i;
        float y[8], o[8];
#pragma unroll
        for (int j = 0; j < 8; ++j) y[j] = x[j] * r * gp[j];
        if (row < NLATR) {
            const int t = row & 4095, pos = (i < 4) ? (t >> 6) : (t & 63), f0 = 8 * (i & 1);
#pragma unroll
            for (int j = 0; j < 8; ++j) { const float pj = __shfl_xor(y[j], 2), c = rope[pos * 16 + f0 + j], s = rope[1024 + pos * 16 + f0 + j];
                o[j] = (i & 2) ? (pj * s + y[j] * c) : (y[j] * c - pj * s); }
        } else {
#pragma unroll
            for (int j = 0; j < 8; ++j) o[j] = y[j]; }
        if (!isk) {
#pragma unroll
            for (int j = 0; j < 8; ++j) o[j] *= 0.18033688011112042f; }
        *(v4u*)((isk ? KR : QR) + (size_t)row * 1024 + (qtr & 1) * 512 + 8 * lane) = pack8(o);
    }
}

struct ScanP {
    const bf16* P; const bf16* MQK; bf16* MIX;
    const float* gw2; const float* gb;
    const float* mgb;
    const float* ng;
    float* DSTp; bf16* SSTp; float* GAM; float* DN; float* NIN; float* BL; float* ML; float* MINp;
};
__device__ __forceinline__ void scan_unit(int u, int& b, int& head, int& mm, int& rowbase) {
    b = u / 272; const int rem = u - b * 272; head = rem / 68; mm = rem - head * 68;
    rowbase = mm < 4 ? NLATR + b * 256 + 64 * mm : b * 4096 + 64 * (mm - 4);
}
__device__ __forceinline__ int scan_chunk(int mm, int dir) { return dir ? (mm < 4 ? 3 - mm : 71 - mm) : mm; }

__device__ __forceinline__ void gla_gates(const ScanP& s, LAS const float* glr, LAS float* tot, int head, int dir, int tid, float (&bb)[16], float& btot) {
    const int dk = tid & 127, grp = tid >> 7;
    float w2[16];
#pragma unroll
    for (int r = 0; r < 16; ++r) w2[r] = s.gw2[(dir * 16 + r) * 512 + head * 128 + dk];
    const float bias = s.gb[dir * 512 + head * 128 + dk];
#pragma unroll
    for (int tt = 0; tt < 16; ++tt) { const int t = 16 * grp + tt; float z = bias;
#pragma unroll
        for (int r = 0; r < 16; ++r) z += glr[t * 32 + dir * 16 + r] * w2[r];
        bb[tt] = logsig_f(z) * 0.0625f; }
    if (dir == 0) {
#pragma unroll
        for (int tt = 1; tt < 16; ++tt) bb[tt] += bb[tt - 1];
        tot[grp * 128 + dk] = bb[15];
    } else {
#pragma unroll
        for (int tt = 14; tt >= 0; --tt) bb[tt] += bb[tt + 1];
        tot[grp * 128 + dk] = bb[0];
    }
    __syncthreads();
    float off = 0.f; btot = 0.f;
#pragma unroll
    for (int g = 0; g < 4; ++g) { const float tv = tot[g * 128 + dk]; btot += tv; if (dir == 0 ? g < grp : g > grp) off += tv; }
#pragma unroll
    for (int tt = 0; tt < 16; ++tt) bb[tt] += off;
}

template <int MODE>
__device__ __forceinline__ void ph_scan_local(const ScanP& s, LAS unsigned char* lds, int tid, int lane, int wave, int bid, int G) {
    LAS unsigned char* Vs = lds; LAS unsigned char* Kh = lds + 33792;
    LAS float* glr = (LAS float*)(lds + 51200); LAS float* tot = (LAS float*)(lds + 59392); LAS float* wv = (LAS float*)(lds + 61440); LAS float* dnp = (LAS float*)(lds + 61696);
    const int dk = tid & 127, grp = tid >> 7;
    for (int u = bid; u < 544; u += G) {
        int b, head, mm, rowbase; scan_unit(u, b, head, mm, rowbase);
        load_tile(Vs, 528, s.P + (size_t)rowbase * NINP + (MODE ? 4096 : 1024) + head * 256, NINP, 64, 256, tid);
        if (MODE == 0) for (int e = tid; e < 2048; e += NTHR) glr[e] = bf1(s.P[(size_t)(rowbase + (e >> 5)) * NINP + 3072 + (e & 31)]);
        __syncthreads();
        for (int dir = 0; dir < 2; ++dir) {
            const int chain = (b * 4 + head) * 2 + dir, c = scan_chunk(mm, dir); const size_t cc = (size_t)chain * NCHUNK + c;
            if (MODE == 0) {
                float bb[16], btot; gla_gates(s, glr, tot, head, dir, tid, bb, btot);
#pragma unroll
                for (int tt = 0; tt < 16; ++tt) { const int t = 16 * grp + tt; const float kv = bf1(s.P[(size_t)(rowbase + t) * NINP + 512 + head * 128 + dk]) * __expf(btot - bb[tt]);
                    *(LAS bf16*)(Kh + t * 272 + dk * 2) = f2bf(kv); }
                if (grp == 0) s.GAM[cc * 128 + dk] = __expf(btot);
            } else {
                if (wave == 0) {
                    const float ig = bf1(s.P[(size_t)(rowbase + lane) * NINP + 6144 + dir * 8 + head]) + s.mgb[dir * 8 + head];
                    const float fg = bf1(s.P[(size_t)(rowbase + lane) * NINP + 6144 + dir * 8 + 4 + head]) + s.mgb[dir * 8 + 4 + head];
                    const float lf = logsig_f(fg), bcs = wave_scan_sum(lf, dir, lane), blast = wave_sum(lf);
                    const float gs = blast - bcs + ig, mloc = wave_max(gs);
                    wv[lane] = __expf(gs - mloc);
                    if (lane == 0) { s.BL[cc] = blast; s.ML[cc] = mloc; }
                }
                __syncthreads();
                float part = 0.f;
#pragma unroll
                for (int tt = 0; tt < 16; ++tt) { const int t = 16 * grp + tt; const float kv = bf1(s.MQK[(size_t)(rowbase + t) * 1024 + 512 + head * 128 + dk]) * wv[t];
                    *(LAS bf16*)(Kh + t * 272 + dk * 2) = f2bf(kv); part += kv; }
                dnp[grp * 128 + dk] = part;
            }
            __syncthreads();
            if (MODE == 1 && tid < 128) s.DN[cc * 128 + tid] = (dnp[tid] + dnp[128 + tid]) + (dnp[256 + tid] + dnp[384 + tid]);
            f32x16 acc[4];
#pragma unroll
            for (int nt = 0; nt < 4; ++nt) acc[nt] = zero16();
#pragma unroll
            for (int ks = 0; ks < 4; ++ks) { const bf16x8 af = frag_tr(Vs, 528, 16 * ks, 32 * wave, lane);
#pragma unroll
                for (int nt = 0; nt < 4; ++nt) { const bf16x8 bfr = frag_tr(Kh, 272, 16 * ks, 32 * nt, lane); acc[nt] = MFMA32(af, bfr, acc[nt]); } }
            float* D = s.DSTp + cc * 32768;
#pragma unroll
            for (int nt = 0; nt < 4; ++nt)
#pragma unroll
                for (int r = 0; r < 16; ++r) { const int dv = 32 * wave + (r & 3) + 8 * (r >> 2) + 4 * (lane >> 5); D[dv * 128 + 32 * nt + (lane & 31)] = acc[nt][r]; }
            __syncthreads();
        }
    }
}

template <int MODE>
__device__ __forceinline__ void ph_scan_carry(const ScanP& s, int gtid, int NT) {
    for (int e = gtid; e < 16 * 8192; e += NT) {
        const int chain = e >> 13, rem = e & 8191, dv = rem >> 5, dk = (rem & 31) * 4;
        f32x4 st = {0.f, 0.f, 0.f, 0.f}, nst = st; float m = 0.f;
        for (int c0 = 0; c0 < NCHUNK; c0 += 4) {
            f32x4 d[4], gm[4]; float bl[4], ml[4];
#pragma unroll
            for (int j = 0; j < 4; ++j) { const size_t cc = (size_t)chain * NCHUNK + c0 + j; d[j] = *(const f32x4*)(s.DSTp + cc * 32768 + dv * 128 + dk);
                if (MODE == 0) gm[j] = *(const f32x4*)(s.GAM + cc * 128 + dk);
                else { bl[j] = s.BL[cc]; ml[j] = s.ML[cc]; gm[j] = (dv == 0) ? *(const f32x4*)(s.DN + cc * 128 + dk) : (f32x4){0.f, 0.f, 0.f, 0.f}; } }
#pragma unroll
            for (int j = 0; j < 4; ++j) { const size_t cc = (size_t)chain * NCHUNK + c0 + j;
                v2u o; o.x = pk2(st.x, st.y); o.y = pk2(st.z, st.w); *(v2u*)(s.SSTp + cc * 32768 + dv * 128 + dk) = o;
                if (MODE == 0) st = gm[j] * st + d[j];
                else { if (dv == 0) { *(f32x4*)(s.NIN + cc * 128 + dk) = nst; if (dk == 0) s.MINp[cc] = m; }
                    const float mn = fmaxf(bl[j] + m, ml[j]), dec = __expf(bl[j] + m - mn), sc = __expf(ml[j] - mn);
                    st = st * dec + d[j] * sc; nst = nst * dec + gm[j] * sc; m = mn; } }
        }
    }
}

template <int MODE>
__device__ __forceinline__ void ph_scan_out(const ScanP& s, LAS unsigned char* lds, int tid, int lane, int wave, int bid, int G) {
    LAS unsigned char* Vs = lds; LAS unsigned char* Qx = lds + 33792; LAS unsigned char* Ki = lds + 51200; LAS unsigned char* Qi = lds + 68608; LAS unsigned char* Am = lds + 86016;
    LAS float* glr = (LAS float*)(lds + 95232); LAS float* tot = (LAS float*)(lds + 103424);
    LAS float* us = (LAS float*)(lds + 105472); LAS float* Mts = us + 64; LAS float* wint = us + 128; LAS float* thr = us + 192; LAS float* fac = us + 256; LAS float* qn = us + 320; LAS float* rs = us + 384;
    LAS float* qnp = (LAS float*)(lds + 107520);
    LAS float* Os = (LAS float*)lds;
    const int dk = tid & 127, grp = tid >> 7;
    for (int u = bid; u < 544; u += G) {
        int b, head, mm, rowbase; scan_unit(u, b, head, mm, rowbase);
        load_tile(Vs, 528, s.P + (size_t)rowbase * NINP + (MODE ? 4096 : 1024) + head * 256, NINP, 64, 256, tid);
        if (MODE == 0) { for (int e = tid; e < 2048; e += NTHR) glr[e] = bf1(s.P[(size_t)(rowbase + (e >> 5)) * NINP + 3072 + (e & 31)]); if (tid < 64) fac[tid] = 1.f; }
        f32x16 hsum[2]; hsum[0] = zero16(); hsum[1] = zero16();
        __syncthreads();
        for (int dir = 0; dir < 2; ++dir) {
            const int chain = (b * 4 + head) * 2 + dir, c = scan_chunk(mm, dir); const size_t cc = (size_t)chain * NCHUNK + c;
            if (MODE == 0) {
                float bb[16], btot; gla_gates(s, glr, tot, head, dir, tid, bb, btot);
#pragma unroll
                for (int tt = 0; tt < 16; ++tt) { const int t = 16 * grp + tt; const size_t ro = (size_t)(rowbase + t) * NINP + head * 128 + dk;
                    const float qv = bf1(s.P[ro]), kv = bf1(s.P[ro + 512]);
                    *(LAS bf16*)(Qx + t * 272 + dk * 2) = f2bf(qv * __expf(bb[tt]) * 0.08838834764831845f);
                    *(LAS bf16*)(Ki + t * 272 + dk * 2) = f2bf(kv * __expf(-bb[tt])); }
            } else {
                if (wave == 0) {
                    const float ig = bf1(s.P[(size_t)(rowbase + lane) * NINP + 6144 + dir * 8 + head]) + s.mgb[dir * 8 + head];
                    const float fg = bf1(s.P[(size_t)(rowbase + lane) * NINP + 6144 + dir * 8 + 4 + head]) + s.mgb[dir * 8 + 4 + head];
                    const float lf = logsig_f(fg), bcs = wave_scan_sum(lf, dir, lane);
                    const float uu = ig - bcs, pm = wave_scan_max(uu, dir, lane), min_ = s.MINp[cc], Mt = fmaxf(min_, pm);
                    us[lane] = uu; Mts[lane] = Mt; wint[lane] = __expf(min_ - Mt); thr[lane] = __expf(-bcs - Mt);
                }
                __syncthreads();
#pragma unroll
                for (int tt = 0; tt < 16; ++tt) { const int t = 16 * grp + tt; const size_t ro = (size_t)(rowbase + t) * 1024 + head * 128 + dk;
                    const bf16 qb = s.MQK[ro], kb = s.MQK[ro + 512];
                    *(LAS bf16*)(Qi + t * 272 + dk * 2) = qb; *(LAS bf16*)(Ki + t * 272 + dk * 2) = kb;
                    *(LAS bf16*)(Qx + t * 272 + dk * 2) = f2bf(bf1(qb) * wint[t]); }
                __syncthreads();
                { const int t = tid & 63, part = tid >> 6; float acc = 0.f;
#pragma unroll
                  for (int j = 0; j < 16; ++j) acc += bf1(*(LAS const bf16*)(Qi + t * 272 + (part * 16 + j) * 2)) * s.NIN[cc * 128 + part * 16 + j];
                  qnp[part * 64 + t] = acc; }
            }
            __syncthreads();
            if (MODE == 1 && tid < 64) { float q = 0.f;
#pragma unroll
                for (int p = 0; p < 8; ++p) q += qnp[p * 64 + tid];
                qn[tid] = q; }
            if (wave < 4) {
                const int ti = wave >> 1, tj = wave & 1; f32x16 acc = zero16();
#pragma unroll
                for (int ks = 0; ks < 8; ++ks) { const bf16x8 af = frag_row(MODE ? Qi : Qx, 272, 32 * ti, 16 * ks, lane), bfr = frag_row(Ki, 272, 32 * tj, 16 * ks, lane); acc = MFMA32(af, bfr, acc); }
                const int sidx = 32 * tj + (lane & 31);
                const float usv = MODE ? us[sidx] : 0.f;
#pragma unroll
                for (int r = 0; r < 16; ++r) { const int t = 32 * ti + (r & 3) + 8 * (r >> 2) + 4 * (lane >> 5);
                    const bool keep = dir == 0 ? (sidx <= t) : (sidx >= t);
                    float v = acc[r];
                    if (MODE == 1) v *= __expf(usv - Mts[t]);
                    v = keep ? v : 0.f;
                    *(LAS bf16*)(Am + t * 144 + sidx * 2) = f2bf(v);
                    if (MODE == 1) { float rsum = v; rsum += __shfl_xor(rsum, 1); rsum += __shfl_xor(rsum, 2); rsum += __shfl_xor(rsum, 4); rsum += __shfl_xor(rsum, 8); rsum += __shfl_xor(rsum, 16);
                        if ((lane & 31) == 0) rs[tj * 64 + t] = rsum; } }
            }
            __syncthreads();
            if (MODE == 1 && tid < 64) { const float den = wint[tid] * qn[tid] + rs[tid] + rs[64 + tid]; fac[tid] = 1.f / fmaxf(fabsf(den), thr[tid]); }
            f32x16 acc2[2]; acc2[0] = zero16(); acc2[1] = zero16();
            { const bf16* Sg = s.SSTp + cc * 32768 + (size_t)(32 * wave + (lane & 31)) * 128 + 8 * (lane >> 5);
#pragma unroll
              for (int ks = 0; ks < 8; ++ks) { const bf16x8 bfr = *(const bf16x8*)(Sg + 16 * ks);
#pragma unroll
                  for (int rt = 0; rt < 2; ++rt) { const bf16x8 af = frag_row(Qx, 272, 32 * rt, 16 * ks, lane); acc2[rt] = MFMA32(af, bfr, acc2[rt]); } } }
#pragma unroll
            for (int ks = 0; ks < 4; ++ks) { const bf16x8 bfr = frag_tr(Vs, 528, 16 * ks, 32 * wave, lane);
#pragma unroll
                for (int rt = 0; rt < 2; ++rt) { const bf16x8 af = frag_row(Am, 144, 32 * rt, 16 * ks, lane); acc2[rt] = MFMA32(af, bfr, acc2[rt]); } }
            __syncthreads();
#pragma unroll
            for (int rt = 0; rt < 2; ++rt)
#pragma unroll
                for (int r = 0; r < 16; ++r) { const int t = 32 * rt + (r & 3) + 8 * (r >> 2) + 4 * (lane >> 5); hsum[rt][r] += acc2[rt][r] * fac[t]; }
        }
        __syncthreads();
#pragma unroll
        for (int rt = 0; rt < 2; ++rt)
#pragma unroll
            for (int r = 0; r < 16; ++r) { const int t = 32 * rt + (r & 3) + 8 * (r >> 2) + 4 * (lane >> 5); Os[t * 260 + 32 * wave + (lane & 31)] = hsum[rt][r]; }
        __syncthreads();
        { const int t = tid >> 3, part = tid & 7; float o[32]; float ss = 0.f;
#pragma unroll
          for (int j = 0; j < 8; ++j) { const f32x4 v = *(LAS const f32x4*)(Os + t * 260 + 32 * part + 4 * j); o[4 * j] = v.x; o[4 * j + 1] = v.y; o[4 * j + 2] = v.z; o[4 * j + 3] = v.w; ss += (v.x * v.x + v.y * v.y) + (v.z * v.z + v.w * v.w); }
          ss += __shfl_xor(ss, 1); ss += __shfl_xor(ss, 2); ss += __shfl_xor(ss, 4);
          const float rn = rsqrtf(ss * (1.f / 256.f) + EPS);
          const size_t row = (size_t)(rowbase + t);
          const bf16* gsrc = s.P + row * NINP + (MODE ? 5120 : 2048) + head * 256 + 32 * part;
          bf16* dst = s.MIX + row * DM + (MODE ? 1024 : 0) + head * 256 + 32 * part;
#pragma unroll
          for (int j = 0; j < 4; ++j) { float gv[8], ov[8]; unpack8(*(const v4u*)(gsrc + 8 * j), gv);
#pragma unroll
              for (int e = 0; e < 8; ++e) { const float gt = MODE ? sigmoid_f(gv[e]) : silu_f(gv[e]); ov[e] = o[8 * j + e] * rn * s.ng[32 * part + 8 * j + e] * gt; }
              *(v4u*)(dst + 8 * j) = pack8(ov); } }
        __syncthreads();
    }
}

struct AttnP { const bf16* QR; const bf16* KR; const bf16* P; bf16* MIX; const float* lamp; const float* subg; const float* qg; const float* kg; float lam_init; };
__device__ __forceinline__ void ph_attn(const AttnP& p, LAS unsigned char* lds, int tid, int lane, int wave, int bid, int G) {
    const float l01 = wave_sum(p.lamp[lane] * p.lamp[64 + lane]), l23 = wave_sum(p.lamp[128 + lane] * p.lamp[192 + lane]);
    const float lam = __expf(l01) - __expf(l23) + p.lam_init;
    const float negm2 = -8.f * wave_max(fabsf(p.qg[lane])) * wave_max(fabsf(p.kg[lane])) * 1.4426950408889634f * 1.02f;
    const int r = lane & 31, h = lane >> 5, mp = wave >> 2, wq = wave & 3;
    LAS float* Ex = (LAS float*)lds;
    for (int u = bid; u < 544; u += G) {
        int b, hd, qrow0, nkt;
        if (u < 512) { b = u >> 8; hd = (u >> 5) & 7; qrow0 = b * 4096 + 128 * (u & 31); nkt = 68; }
        else { const int uu = u - 512; b = uu >> 4; hd = (uu >> 1) & 7; qrow0 = NLATR + b * 256 + 128 * (uu & 1); nkt = 4; }
        const int qrow = qrow0 + 32 * wq + r;
        bf16x8 Qf[4];
#pragma unroll
        for (int ks = 0; ks < 4; ++ks) Qf[ks] = *(const bf16x8*)(p.QR + (size_t)qrow * 1024 + (hd * 2 + mp) * 64 + 16 * ks + 8 * h);
        f32x16 O[4];
#pragma unroll
        for (int dt = 0; dt < 4; ++dt) O[dt] = zero16();
        float ls = 0.f;
        const int c0r = tid >> 4, c0c = tid & 15;
        v4u kr0, kr1, vr0, vr1;
        auto gload = [&](int kt) { const int krow = kt < 4 ? NLATR + b * 256 + 64 * kt : b * 4096 + 64 * (kt - 4);
            kr0 = *(const v4u*)(p.KR + (size_t)(krow + c0r) * 1024 + hd * 128 + c0c * 8); kr1 = *(const v4u*)(p.KR + (size_t)(krow + 32 + c0r) * 1024 + hd * 128 + c0c * 8);
            vr0 = *(const v4u*)(p.P + (size_t)(krow + c0r) * NINP + 2048 + hd * 128 + c0c * 8); vr1 = *(const v4u*)(p.P + (size_t)(krow + 32 + c0r) * NINP + 2048 + hd * 128 + c0c * 8); };
        auto lstore = [&](int buf) { LAS unsigned char* Kt = lds + buf * 17408; LAS unsigned char* Vt = lds + 34816 + buf * 17408;
            *(LAS v4u*)(Kt + c0r * 272 + c0c * 16) = kr0; *(LAS v4u*)(Kt + (32 + c0r) * 272 + c0c * 16) = kr1;
            *(LAS v4u*)(Vt + c0r * 272 + c0c * 16) = vr0; *(LAS v4u*)(Vt + (32 + c0r) * 272 + c0c * 16) = vr1; };
        gload(0); lstore(0);
        __syncthreads();
        for (int kt = 0; kt < nkt; ++kt) {
            const bool more = kt + 1 < nkt;
            if (more) gload(kt + 1);
            LAS const unsigned char* Kt = lds + (kt & 1) * 17408; LAS const unsigned char* Vt = lds + 34816 + (kt & 1) * 17408;
#pragma unroll
            for (int kb = 0; kb < 2; ++kb) {
                f32x16 S = zero16();
#pragma unroll
                for (int ks = 0; ks < 4; ++ks) { const bf16x8 a0 = frag_row(Kt, 272, 32 * kb, 64 * mp + 16 * ks, lane); S = MFMA32(a0, Qf[ks], S); }
                unsigned pf[8]; float lacc = 0.f;
#pragma unroll
                for (int i = 0; i < 8; ++i) { const float e0 = __builtin_amdgcn_exp2f(S[2 * i] + negm2), e1 = __builtin_amdgcn_exp2f(S[2 * i + 1] + negm2); lacc += e0 + e1; pf[i] = pk2(e0, e1); }
                ls += lacc;
                const bf16x8 P0 = __builtin_bit_cast(bf16x8, (v4u){pf[0], pf[1], pf[2], pf[3]}), P1 = __builtin_bit_cast(bf16x8, (v4u){pf[4], pf[5], pf[6], pf[7]});
#pragma unroll
                for (int dt = 0; dt < 4; ++dt) { const bf16x8 av0 = frag_tr_perm(Vt, 272, 32 * kb, 32 * dt, lane), av1 = frag_tr_perm(Vt, 272, 32 * kb + 16, 32 * dt, lane);
                    O[dt] = MFMA32(av0, P0, O[dt]); O[dt] = MFMA32(av1, P1, O[dt]); }
            }
            if (more) lstore((kt + 1) & 1);
            __syncthreads();
        }
        const float l = ls + __shfl_xor(ls, 32);
        if (mp == 1) { const float sc = lam / l;
#pragma unroll
            for (int dt = 0; dt < 4; ++dt)
#pragma unroll
                for (int i = 0; i < 16; ++i) Ex[(32 * wq + r) * 132 + 32 * dt + (i & 3) + 8 * (i >> 2) + 4 * h] = O[dt][i] * sc; }
        __syncthreads();
        if (mp == 0) { const float a0 = 1.f / l; float ss = 0.f;
#pragma unroll
            for (int dt = 0; dt < 4; ++dt)
#pragma unroll
                for (int i = 0; i < 16; ++i) { const float v = O[dt][i] * a0 - Ex[(32 * wq + r) * 132 + 32 * dt + (i & 3) + 8 * (i >> 2) + 4 * h]; O[dt][i] = v; ss += v * v; }
            ss += __shfl_xor(ss, 32);
            const float rn = rsqrtf(ss * (1.f / 128.f) + EPS) * (1.f - p.lam_init);
            bf16* dst = p.MIX + (size_t)qrow * DM + hd * 128;
#pragma unroll
            for (int dt = 0; dt < 4; ++dt)
#pragma unroll
                for (int g4 = 0; g4 < 4; ++g4) { const int dv0 = 32 * dt + 8 * g4 + 4 * h; const f32x4 sg = *(const f32x4*)(p.subg + dv0);
                    v2u o; o.x = pk2(O[dt][4 * g4] * rn * sg.x, O[dt][4 * g4 + 1] * rn * sg.y); o.y = pk2(O[dt][4 * g4 + 2] * rn * sg.z, O[dt][4 * g4 + 3] * rn * sg.w);
                    *(v2u*)(dst + dv0) = o; } }
        __syncthreads();
    }
}

#ifndef PHASE_MASK
#define PHASE_MASK 0xFFFFFFu
#endif
#define PM(j) ((PHASE_MASK >> (j)) & 1u)
#define PHASE_BEGIN int tid = tid0, lane = lane0; asm volatile("" : "+v"(tid), "+v"(lane)); int wave = wave0, bid = bid0, G = G0; asm volatile("" : "+s"(wave), "+s"(bid), "+s"(G)); \
    unsigned char* ws = ws0; asm volatile("" : "+s"(ws)); const int gw = bid * NWAVES + wave, NGW = G * NWAVES, gtid = bid * NTHR + tid, NT = G * NTHR; (void)gw; (void)NGW; (void)gtid; (void)NT; (void)lane;
__device__ __forceinline__ void fill_scanp(ScanP& sp, const Args& a, unsigned char* ws, int li, bool even) {
    sp.P = (const bf16*)(ws + WS_P); sp.MQK = (const bf16*)(ws + WS_MQK); sp.MIX = (bf16*)(ws + WS_MIX);
    sp.gw2 = a.in[10] + (size_t)li * 2 * 16 * 512; sp.gb = a.in[11] + (size_t)li * 2 * 512; sp.mgb = a.in[21] + (size_t)li * 16;
    sp.ng = even ? a.in[12] + (size_t)li * 256 : a.in[22] + (size_t)li * 256;
    sp.DSTp = (float*)(ws + WS_DST); sp.SSTp = (bf16*)(ws + WS_SST); sp.GAM = (float*)(ws + WS_SM + SM_GAM); sp.DN = (float*)(ws + WS_SM + SM_DN); sp.NIN = (float*)(ws + WS_SM + SM_NIN);
    sp.BL = (float*)(ws + WS_SM + SM_BL); sp.ML = (float*)(ws + WS_SM + SM_ML); sp.MINp = (float*)(ws + WS_SM + SM_MIN);
}
__global__ void __launch_bounds__(NTHR, 2) fwd_kernel(Args a) {
    extern __shared__ __attribute__((aligned(16))) unsigned char lds_raw[];
    LAS unsigned char* lds = (LAS unsigned char*)lds_raw;
    const int tid0 = threadIdx.x, lane0 = tid0 & 63, wave0 = __builtin_amdgcn_readfirstlane(tid0 >> 6), bid0 = blockIdx.x, G0 = gridDim.x;
    unsigned char* ws0 = a.ws;
    volatile LAS unsigned* MISC = (volatile LAS unsigned*)(lds + MISC_OFF);
    if (tid0 < 32) MISC[tid0] = 0u;
    __syncthreads();
    XcdBarrier bar = xcd_barrier_post((unsigned*)(ws0 + WS_CTL) + CW_BAR + a.li * XCD_BAR_WORDS, MISC + 8);
    const int lo = a.ph_lo, hi = a.ph_hi;
#define IN(k) (lo <= (k) && (k) < hi)
#define SEAM(k) do { if (IN(k) && IN((k) + 1)) xcd_barrier(bar); } while (0)

    if (PM(11) && IN(0)) { PHASE_BEGIN; ph_prologue(a, ws, lds, tid, lane, wave, bid, G); }
    SEAM(0);
    for (int layer = 0; layer < NLAYERS; ++layer) {
        const int pb = 1 + layer * PPL, li = layer >> 1; const bool even = (layer & 1) == 0;
        const size_t mod_off = WS_MOD + (size_t)layer * 3 * 12288 * 4;
        const size_t wb_off = WS_W + (size_t)layer * W_LAYER;

        if (PM(0) && IN(pb + 0)) { PHASE_BEGIN; const float* mod = (const float*)(ws + mod_off);
            ph_norm((const float*)(ws + WS_XS), a.in[6] + (size_t)layer * DM, mod + 0 * DM, mod + 1 * DM, (bf16*)(ws + WS_H), gw, NGW, lane); }
        SEAM(pb + 0);
        if (PM(1) && IN(pb + 1)) { PHASE_BEGIN; pg8::Gemm g{(const bf16*)(ws + WS_H), (const bf16*)(ws + wb_off), MR, NINP, DM}; pg8::StaticOrder S; S.init(MR, NINP, G, bid); pg8::EpiStore E{(bf16*)(ws + WS_P), NINP};
            pg8::gemm_phase<pg8::EpiStore, pg8::StaticOrder, true, true>(lds, g, S, E); }
        SEAM(pb + 1);
        if (PM(2) && IN(pb + 2)) {
            if (even) {
                if (PM(12)) { PHASE_BEGIN; ph_conv<1>((const bf16*)(ws + WS_P), a.in[13] + (size_t)li * 3 * 1024, nullptr, (bf16*)(ws + WS_MIX), gtid, NT); }
                if (PM(13)) { PHASE_BEGIN; ScanP sp; fill_scanp(sp, a, ws, li, even); ph_scan_local<0>(sp, lds, tid, lane, wave, bid, G); }
            } else {
                if (PM(14)) { PHASE_BEGIN; ph_qkprep((const bf16*)(ws + WS_P), a.in[16] + (size_t)li * 64, a.in[17] + (size_t)li * 64, (const float*)(ws + WS_ROPE), (bf16*)(ws + WS_QR), (bf16*)(ws + WS_KR), gw, NGW, lane); }
                if (PM(15)) { PHASE_BEGIN; ph_conv<2>((const bf16*)(ws + WS_P), a.in[20] + (size_t)li * 3 * 1024, nullptr, (bf16*)(ws + WS_MQK), gtid, NT); }
            }
        }
        SEAM(pb + 2);
        if (PM(3) && IN(pb + 3)) { if (!even) { PHASE_BEGIN; ScanP sp; fill_scanp(sp, a, ws, li, even); ph_scan_local<1>(sp, lds, tid, lane, wave, bid, G); } }
        SEAM(pb + 3);
        if (PM(4) && IN(pb + 4)) { PHASE_BEGIN; ScanP sp; fill_scanp(sp, a, ws, li, even); if (even) ph_scan_carry<0>(sp, gtid, NT); else ph_scan_carry<1>(sp, gtid, NT); }
        SEAM(pb + 4);
        if (PM(5) && IN(pb + 5)) {
            if (even) { if (PM(16)) { PHASE_BEGIN; ScanP sp; fill_scanp(sp, a, ws, li, even); ph_scan_out<0>(sp, lds, tid, lane, wave, bid, G); } }
            else {
                if (PM(17)) { PHASE_BEGIN; AttnP ap{(const bf16*)(ws + WS_QR), (const bf16*)(ws + WS_KR), (const bf16*)(ws + WS_P), (bf16*)(ws + WS_MIX), a.in[18] + (size_t)li * 256, a.in[19] + (size_t)li * 128, a.in[16] + (size_t)li * 64, a.in[17] + (size_t)li * 64, 0.8f - 0.6f * expf(-0.3f * (float)layer)};
                    ph_attn(ap, lds, tid, lane, wave, bid, G); }
                if (PM(18)) { PHASE_BEGIN; ScanP sp; fill_scanp(sp, a, ws, li, even); ph_scan_out<1>(sp, lds, tid, lane, wave, bid, G); }
            }
        }
        SEAM(pb + 5);
        if (PM(6) && IN(pb + 6)) { PHASE_BEGIN; pg8::Gemm g{(const bf16*)(ws + WS_MIX), (const bf16*)(ws + wb_off + W_OUT), MR, DM, DM}; pg8::StaticOrder S; S.init(MR, DM, G, bid);
            pg8::EpiResid E{(float*)(ws + WS_XS), (const float*)(ws + mod_off) + 2 * DM, nullptr, 0};
            pg8::gemm_phase<pg8::EpiResid, pg8::StaticOrder, true, true>(lds, g, S, E); }
        SEAM(pb + 6);
        if (PM(7) && IN(pb + 7)) { PHASE_BEGIN; const float* mod = (const float*)(ws + mod_off);
            ph_norm((const float*)(ws + WS_XS), a.in[7] + (size_t)layer * DM, mod + 3 * DM, mod + 4 * DM, (bf16*)(ws + WS_H), gw, NGW, lane); }
        SEAM(pb + 7);
        if (PM(8) && IN(pb + 8)) { PHASE_BEGIN; pg8::Gemm g{(const bf16*)(ws + WS_H), (const bf16*)(ws + wb_off + W_UP), MR, NUP, DM}; pg8::StaticOrder S; S.init(MR, NUP, G, bid); pg8::EpiStore E{(bf16*)(ws + WS_U), NUP};
            pg8::gemm_phase<pg8::EpiStore, pg8::StaticOrder, true, true>(lds, g, S, E); }
        SEAM(pb + 8);
        if (PM(9) && IN(pb + 9)) { PHASE_BEGIN; ph_conv<0>((const bf16*)(ws + WS_U), a.in[24] + (size_t)layer * 3 * DFF, a.in[25] + (size_t)layer * DFF, (bf16*)(ws + WS_ACT), gtid, NT); }
        SEAM(pb + 9);
        if (PM(10) && IN(pb + 10)) { PHASE_BEGIN; pg8::Gemm g{(const bf16*)(ws + WS_ACT), (const bf16*)(ws + wb_off + W_DN), MR, DM, DFF}; pg8::StaticOrder S; S.init(MR, DM, G, bid);
            pg8::EpiResid E{(float*)(ws + WS_XS), (const float*)(ws + mod_off) + 5 * DM, a.out, layer == NLAYERS - 1 ? 1 : 0};
            pg8::gemm_phase<pg8::EpiResid, pg8::StaticOrder, true, true>(lds, g, S, E); }
        if (layer < NLAYERS - 1) SEAM(pb + 10);
    }
#undef IN
#undef SEAM
}

extern "C" void kernel_launch(void* const* d_in, const int* in_sizes, int n_in, void* d_out, int out_size, void* d_ws, size_t ws_size, hipStream_t stream) {
    static int grid = 0;
    if (grid == 0) {
        int dev = 0, cus = 0;
        if (n_in != 27 || out_size != NLATR * DM || ws_size < WS_END) { fprintf(stderr, "kernel_launch: unexpected problem (n_in %d out %d ws %zu)\n", n_in, out_size, ws_size); grid = -1; return; }
        if (hipGetDevice(&dev) != hipSuccess || hipDeviceGetAttribute(&cus, hipDeviceAttributeMultiprocessorCount, dev) != hipSuccess) { grid = -1; return; }
        if (hipFuncSetAttribute((const void*)fwd_kernel, hipFuncAttributeMaxDynamicSharedMemorySize, LDS_BYTES) != hipSuccess) { fprintf(stderr, "kernel_launch: hipFuncSetAttribute failed\n"); grid = -1; return; }
        int per_cu = 0;
        if (hipOccupancyMaxActiveBlocksPerMultiprocessor(&per_cu, (const void*)fwd_kernel, NTHR, LDS_BYTES) != hipSuccess || per_cu < 1) fprintf(stderr, "kernel_launch: occupancy query reports %d\n", per_cu);
        (void)hipGetLastError();
        grid = cus;
    }
    if (grid < 0) return;
    (void)hipMemsetAsync((char*)d_ws + WS_CTL, 0, CTL_BYTES, stream);
    Args a{};
    for (int i = 0; i < 27; ++i) a.in[i] = (const float*)d_in[i];
    a.out = (float*)d_out; a.ws = (unsigned char*)d_ws; a.pad = 0;
#if ONE_LAUNCH
    a.ph_lo = 0; a.ph_hi = 1 + NLAYERS * PPL; a.li = 0;
    hipLaunchKernelGGL(fwd_kernel, dim3(grid), dim3(NTHR), LDS_BYTES, stream, a);
#else
    for (int p = 0; p < 1 + NLAYERS * PPL; ++p) {
        const int k = p == 0 ? 0 : (p - 1) % PPL, layer = p == 0 ? 0 : (p - 1) / PPL;
        if (p > 0 && k == 3 && (layer & 1) == 0) continue;
        a.ph_lo = p; a.ph_hi = p + 1; a.li = p;
        hipLaunchKernelGGL(fwd_kernel, dim3(grid), dim3(NTHR), LDS_BYTES, stream, a);
    }
#endif
}
```

```cpp
#include <hip/hip_runtime.h>
#include <cstdio>
#include <cstdint>
namespace pg8 {
#define PG8_LAS __attribute__((address_space(3)))
typedef unsigned short bf16_t;
typedef short bf16x8 __attribute__((ext_vector_type(8)));
typedef float f32x4 __attribute__((ext_vector_type(4)));
typedef unsigned u32x4 __attribute__((ext_vector_type(4)));
constexpr int BM = 256, BK = 64, HALF = 128, HTB = HALF * BK * 2  , STAGE_BYTES = 8 * HTB, NXCD = 8, WGM = 8;

__host__ __device__ __forceinline__ int lds_byte(int r, int c) { const int st = (r >> 4) * 2 + (c >> 5), rr = r & 15, cc = c & 31, ob = rr * 64 + cc * 2; return st * 1024 + (ob ^ (((ob >> 9) & 1) << 5)); }
__host__ __device__ __forceinline__ void stage_rc(int b, int& R, int& C) { const int st = b / 1024, sb = b % 1024, swz = sb ^ (((sb >> 9) & 1) << 5); R = (st >> 1) * 16 + swz / 64; C = (st & 1) * 32 + (swz % 64) / 2; }
__host__ __device__ __forceinline__ int perm32(int rho) { const int n = rho >> 4, i = rho & 15; return 8 * (i >> 2) + 4 * n + (i & 3); }

struct Unit { int pm, pn; };
struct Gemm { const bf16_t* A; const bf16_t* Bt; int M, N, K; };

struct StaticOrder {
    int nM, nN, nwg, G, c;
    __host__ __device__ void init(int M, int N, int G_, int c_) { nM = M / BM; nN = N / BM; nwg = nM * nN; G = G_; c = c_; }
    __host__ __device__ bool next(int i, Unit& u) const {
        const long L = (long)i * G + c; if (L >= nwg) return false;
        int wgid = (int)L; { const int q = nwg / NXCD, r = nwg % NXCD, xcd = wgid % NXCD, off = wgid / NXCD; wgid = (xcd < r ? xcd * (q + 1) : r * (q + 1) + (xcd - r) * q) + off; }
        const int nig = WGM * nN, gid = wgid / nig, fm = gid * WGM, gsz = (nM - fm) < WGM ? (nM - fm) : WGM;
        u.pm = fm + ((wgid % nig) % gsz); u.pn = (wgid % nig) / gsz; return true;
    }
    __device__ __forceinline__ void a_ready(const Unit&) const {}
    __device__ __forceinline__ void done(const Unit&) const {}
};
__device__ __forceinline__ unsigned cvt_pk_bf16(float lo, float hi) { unsigned r; asm volatile("v_cvt_pk_bf16_f32 %0, %1, %2" : "=v"(r) : "v"(lo), "v"(hi)); return r; }

struct EpiStore {
    static constexpr bool PERM = true, AFTER_DRAIN = false;
    bf16_t* O; int ldc;
    __device__ __forceinline__ void operator()(const f32x4 (&acc)[2][2][4][2], const Unit& u, int wr, int wc, int fr, int fq) const {
        const int row0 = u.pm * BM + wr * 64 + fr, col0 = u.pn * BM + wc * 32 + 8 * fq;
#pragma unroll
        for (int ai = 0; ai < 2; ++ai)
#pragma unroll
            for (int m = 0; m < 4; ++m) { bf16_t* rowp = O + (size_t)(row0 + ai * HALF + m * 16) * ldc + col0;
#pragma unroll
                for (int bj = 0; bj < 2; ++bj) { const f32x4 v0 = acc[ai][bj][m][0], v1 = acc[ai][bj][m][1];
                    u32x4 w; w.x = cvt_pk_bf16(v0[0], v0[1]); w.y = cvt_pk_bf16(v0[2], v0[3]); w.z = cvt_pk_bf16(v1[0], v1[1]); w.w = cvt_pk_bf16(v1[2], v1[3]);
                    *(u32x4*)(rowp + bj * HALF) = w; } }
    }
};
struct EpiResid {
    static constexpr bool PERM = false, AFTER_DRAIN = false;
    float* X; const float* gate; float* out; int final_;
    __device__ __forceinline__ void operator()(const f32x4 (&acc)[2][2][4][2], const Unit& u, int wr, int wc, int fr, int fq) const {
        if (final_ && u.pm >= 32) return;
        const int mi = u.pm < 32 ? (u.pm >> 4) : 2;
        const float* g = gate + (size_t)mi * 12288;
        const int row0 = u.pm * BM + wr * 64 + fr, col0 = u.pn * BM + wc * 32 + 4 * fq;
        f32x4 gv[2][2];
#pragma unroll
        for (int bj = 0; bj < 2; ++bj)
#pragma unroll
            for (int n = 0; n < 2; ++n) gv[bj][n] = *(const f32x4*)(g + col0 + bj * HALF + n * 16);
#pragma unroll
        for (int ai = 0; ai < 2; ++ai)
#pragma unroll
            for (int m = 0; m < 4; ++m) { const size_t ro = (size_t)(row0 + ai * HALF + m * 16) * 2048 + col0; const float* xr = X + ro; float* orow = (final_ ? out : X) + ro;
#pragma unroll
                for (int bj = 0; bj < 2; ++bj)
#pragma unroll
                    for (int n = 0; n < 2; ++n) { const f32x4 xv = *(const f32x4*)(xr + bj * HALF + n * 16); *(f32x4*)(orow + bj * HALF + n * 16) = xv + gv[bj][n] * acc[ai][bj][m][n]; } }
    }
};
template <class Epi, class Sched, bool ALIGN_EPI = false, bool SP2 = false>
__device__ __forceinline__ void gemm_phase(PG8_LAS unsigned char* lds, const Gemm g, const Sched& S, const Epi& E) {
    int tid = threadIdx.x; asm volatile("" : "+v"(tid));
    const int wid = __builtin_amdgcn_readfirstlane(tid >> 6), lane = tid & 63, wr = wid >> 2, wc = wid & 3, fr = lane & 15, fq = lane >> 4;
    const int K = g.K, nt = K / BK;
    unsigned voffA[2], voffB[2];
#pragma unroll
    for (int i = 0; i < 2; ++i) { int R, C; stage_rc(tid * 16 + i * 8192, R, C); const int Rb = Epi::PERM ? ((R & ~31) + perm32(R & 31)) : R;
        voffA[i] = (unsigned)(R * K + C) * 2u; voffB[i] = (unsigned)(Rb * K + C) * 2u; }
    const size_t kstep = (size_t)(BK * 2);
    const size_t hstep = (size_t)HALF * K * 2;
    const size_t tstep = 2 * hstep;
    const unsigned ldsw = (unsigned)wid * 1024u;
    const int aoff = lds_byte(wr * 64 + fr, fq * 8), boff = lds_byte(wc * 32 + fr, fq * 8);
#define PG8_SA(b, h) (((b) * 2 + (h)) * HTB)
#define PG8_SB(b, h) ((4 + (b) * 2 + (h)) * HTB)
#define PG8_STAGE(bufoff, gbase, voff) do { _Pragma("unroll") for (int _i = 0; _i < 2; ++_i) \
        __builtin_amdgcn_global_load_lds((const unsigned*)((const char*)(gbase) + (voff)[_i]), (PG8_LAS unsigned*)(lds + (bufoff) + ldsw + _i * 8192), 16, 0, 0); } while (0)
#define PG8_LDA(dst, b, h) do { _Pragma("unroll") for (int m = 0; m < 4; ++m) _Pragma("unroll") for (int k = 0; k < 2; ++k) dst[m][k] = *(const PG8_LAS bf16x8*)(lds + PG8_SA(b, h) + aoff + m * 2048 + k * 1024); } while (0)
#define PG8_LDB(dst, b, h) do { _Pragma("unroll") for (int n = 0; n < 2; ++n) _Pragma("unroll") for (int k = 0; k < 2; ++k) dst[n][k] = *(const PG8_LAS bf16x8*)(lds + PG8_SB(b, h) + boff + n * 2048 + k * 1024); } while (0)
#define PG8_MMA(ai, bj, At, Bt) do { __builtin_amdgcn_s_setprio(1); _Pragma("unroll") for (int m = 0; m < 4; ++m) _Pragma("unroll") for (int n = 0; n < 2; ++n) _Pragma("unroll") for (int k = 0; k < 2; ++k) \
        acc[ai][bj][m][n] = __builtin_amdgcn_mfma_f32_16x16x32_bf16(Bt[n][k], At[m][k], acc[ai][bj][m][n], 0, 0, 0); __builtin_amdgcn_s_setprio(0); } while (0)
#define PG8_WAIT_V(n) asm volatile("s_waitcnt vmcnt(" #n ")" ::: "memory")
#define PG8_WAIT_L(n) asm volatile("s_waitcnt lgkmcnt(" #n ")" ::: "memory")
#define PG8_BAR __builtin_amdgcn_s_barrier()
#define PG8_SCHED __builtin_amdgcn_sched_barrier(0)
    Unit cur, nxt; int ui = 0;
    if (!S.next(0, cur)) return;
    f32x4 acc[2][2][4][2];
#pragma unroll
    for (int a = 0; a < 2; ++a)
#pragma unroll
        for (int b = 0; b < 2; ++b)
#pragma unroll
            for (int m = 0; m < 4; ++m)
#pragma unroll
                for (int n = 0; n < 2; ++n) acc[a][b][m][n] = (f32x4){0.f, 0.f, 0.f, 0.f};
    bf16x8 At[4][2], B0[2][2], B1[2][2];
    const char* cA = (const char*)g.A + (size_t)cur.pm * tstep; const char* cB = (const char*)g.Bt + (size_t)cur.pn * tstep;
    S.a_ready(cur);
    if constexpr (SP2) {
        PG8_STAGE(PG8_SB(0, 0), cB, voffB); PG8_STAGE(PG8_SB(0, 1), cB + hstep, voffB); PG8_STAGE(PG8_SA(0, 0), cA, voffA); PG8_STAGE(PG8_SA(0, 1), cA + hstep, voffA);
        if (wr == 1) PG8_BAR;
        PG8_WAIT_V(2); PG8_BAR;
        PG8_STAGE(PG8_SB(1, 0), cB + kstep, voffB); PG8_STAGE(PG8_SA(1, 0), cA + kstep, voffA); PG8_STAGE(PG8_SB(1, 1), cB + hstep + kstep, voffB);
        PG8_WAIT_V(6); PG8_BAR;
    } else {
        PG8_STAGE(PG8_SB(0, 0), cB, voffB); PG8_STAGE(PG8_SA(0, 0), cA, voffA); PG8_STAGE(PG8_SB(0, 1), cB + hstep, voffB); PG8_STAGE(PG8_SA(0, 1), cA + hstep, voffA);
        if (wr == 1) PG8_BAR;
        PG8_WAIT_V(4); PG8_BAR;
        PG8_STAGE(PG8_SB(1, 0), cB + kstep, voffB); PG8_STAGE(PG8_SA(1, 0), cA + kstep, voffA); PG8_STAGE(PG8_SB(1, 1), cB + hstep + kstep, voffB);
        PG8_WAIT_V(6); PG8_BAR;
    }
    for (;;) {
        const bool has_next = S.next(ui + 1, nxt);
        const char* nA = has_next ? (const char*)g.A + (size_t)nxt.pm * tstep : cA; const char* nB = has_next ? (const char*)g.Bt + (size_t)nxt.pn * tstep : cB;
        for (int t = 0; t < nt; t += 2) {
            const bool last = (t == nt - 2);
            const char* a1 = cA + (size_t)(t + 1) * kstep;
            const char* a2 = last ? nA : cA + (size_t)(t + 2) * kstep; const char* b2 = last ? nB : cB + (size_t)(t + 2) * kstep;
            const char* a3 = a2 + kstep; const char* b3 = b2 + kstep;
            if (last && has_next) S.a_ready(nxt);
            if constexpr (SP2) {
            PG8_LDB(B0, 0, 0); PG8_LDB(B1, 0, 1); PG8_SCHED; PG8_LDA(At, 0, 0); PG8_STAGE(PG8_SA(1, 1), a1 + hstep, voffA);
            PG8_WAIT_V(8); PG8_WAIT_L(0); PG8_BAR; PG8_MMA(0, 0, At, B0); PG8_MMA(0, 1, At, B1); PG8_BAR; PG8_SCHED;
            PG8_LDA(At, 0, 1); PG8_STAGE(PG8_SB(0, 0), b2, voffB); PG8_STAGE(PG8_SB(0, 1), b2 + hstep, voffB); PG8_STAGE(PG8_SA(0, 0), a2, voffA);
            PG8_WAIT_V(8); PG8_WAIT_L(0); PG8_BAR; PG8_MMA(1, 0, At, B0); PG8_MMA(1, 1, At, B1); PG8_BAR; PG8_SCHED;
            PG8_LDB(B0, 1, 0); PG8_LDB(B1, 1, 1); PG8_SCHED; PG8_LDA(At, 1, 0); PG8_STAGE(PG8_SA(0, 1), a2 + hstep, voffA);
            PG8_WAIT_V(8); PG8_WAIT_L(0); PG8_BAR; PG8_MMA(0, 0, At, B0); PG8_MMA(0, 1, At, B1); PG8_BAR; PG8_SCHED;
            PG8_LDA(At, 1, 1); PG8_STAGE(PG8_SB(1, 0), b3, voffB); PG8_STAGE(PG8_SB(1, 1), b3 + hstep, voffB); PG8_STAGE(PG8_SA(1, 0), a3, voffA);
            PG8_WAIT_V(8); PG8_WAIT_L(0); PG8_BAR; PG8_MMA(1, 0, At, B0); PG8_MMA(1, 1, At, B1); PG8_BAR; PG8_SCHED;
            } else {
            PG8_LDB(B0, 0, 0); PG8_SCHED; PG8_LDA(At, 0, 0); PG8_STAGE(PG8_SA(1, 1), a1 + hstep, voffA);
            PG8_WAIT_L(8); PG8_BAR; PG8_WAIT_L(0); PG8_MMA(0, 0, At, B0); PG8_BAR; PG8_SCHED;
            PG8_LDB(B1, 0, 1); PG8_STAGE(PG8_SB(0, 0), b2, voffB);
            PG8_BAR; PG8_WAIT_L(0); PG8_MMA(0, 1, At, B1); PG8_BAR;
            PG8_LDA(At, 0, 1); PG8_STAGE(PG8_SA(0, 0), a2, voffA);
            PG8_BAR; PG8_WAIT_L(0); PG8_MMA(1, 0, At, B0); PG8_BAR; PG8_SCHED;
            PG8_STAGE(PG8_SB(0, 1), b2 + hstep, voffB);
            PG8_WAIT_V(6); PG8_BAR; PG8_MMA(1, 1, At, B1); PG8_BAR;
            PG8_LDB(B0, 1, 0); PG8_SCHED; PG8_LDA(At, 1, 0); PG8_STAGE(PG8_SA(0, 1), a2 + hstep, voffA);
            PG8_WAIT_L(8); PG8_BAR; PG8_WAIT_L(0); PG8_MMA(0, 0, At, B0); PG8_BAR; PG8_SCHED;
            PG8_LDB(B1, 1, 1); PG8_STAGE(PG8_SB(1, 0), b3, voffB);
            PG8_BAR; PG8_WAIT_L(0); PG8_MMA(0, 1, At, B1); PG8_BAR;
            PG8_LDA(At, 1, 1); PG8_STAGE(PG8_SA(1, 0), a3, voffA);
            PG8_BAR; PG8_WAIT_L(0); PG8_MMA(1, 0, At, B0); PG8_BAR; PG8_SCHED;
            PG8_STAGE(PG8_SB(1, 1), b3 + hstep, voffB);
            PG8_WAIT_V(6); PG8_BAR; PG8_MMA(1, 1, At, B1); PG8_BAR;
            }
        }
        if constexpr (ALIGN_EPI) { if (wr == 0) PG8_BAR; }
        if constexpr (!Epi::AFTER_DRAIN) { E(acc, cur, wr, wc, fr, fq); S.done(cur); }
        if (!has_next) break;
#pragma unroll
        for (int a = 0; a < 2; ++a)
#pragma unroll
            for (int b = 0; b < 2; ++b)
#pragma unroll
                for (int m = 0; m < 4; ++m)
#pragma unroll
                    for (int n = 0; n < 2; ++n) acc[a][b][m][n] = (f32x4){0.f, 0.f, 0.f, 0.f};
        cur = nxt; cA = nA; cB = nB; ++ui;
        if constexpr (ALIGN_EPI) { if (wr == 1) PG8_BAR; }
    }
    PG8_WAIT_V(0);
    if constexpr (!ALIGN_EPI) { if (wr == 0) PG8_BAR; }
    PG8_BAR;
    if constexpr (Epi::AFTER_DRAIN) { E.fused(acc, cur, wr, wc, fr, fq, lds, wid, lane); S.done(cur); }
#undef PG8_SA
#undef PG8_SB
#undef PG8_STAGE
#undef PG8_LDA
#undef PG8_LDB
#undef PG8_MMA
#undef PG8_WAIT_V
#undef PG8_WAIT_L
#undef PG8_BAR
#undef PG8_SCHED
}
}
#define GAS __attribute__((address_space(1)))
#define LAS __attribute__((address_space(3)))
typedef unsigned short bf16;
typedef unsigned v4u __attribute__((ext_vector_type(4)));
typedef unsigned v2u __attribute__((ext_vector_type(2)));
typedef float f32x4 __attribute__((ext_vector_type(4)));
typedef float f32x16 __attribute__((ext_vector_type(16)));
typedef short bf16x8 __attribute__((ext_vector_type(8)));
typedef short s16x4 __attribute__((ext_vector_type(4)));
typedef GAS unsigned gu32;
#define RLX_AGENT __ATOMIC_RELAXED, __HIP_MEMORY_SCOPE_AGENT
#define XB_TMO      128
#define XB_XCNT(j)  (256  + 64 * (j))
#define XB_XSUB(j)  (1280 + 64 * (j))
#define XB_XGEN(j)  (2304 + 64 * (j))
#define XB_TOP      3328
#define XB_TOPGEN   3392
#define XCD_BAR_WORDS 3456
#define XB_SPIN_CAP (1u << 18)

__device__ __forceinline__ unsigned xb_ld(unsigned* p)              { return __hip_atomic_load(p, __ATOMIC_RELAXED, __HIP_MEMORY_SCOPE_AGENT); }
__device__ __forceinline__ unsigned xb_add(unsigned* p, unsigned v) { return __hip_atomic_fetch_add(p, v, __ATOMIC_RELAXED, __HIP_MEMORY_SCOPE_AGENT); }
__device__ __forceinline__ unsigned xb_xcc_id() { return (unsigned)__builtin_amdgcn_s_getreg((3 << 11) | 20) & 0xFu; }
#define XB_SPIN(cond, bar) do { unsigned _sp = 0; while (cond) { __builtin_amdgcn_s_sleep(1); \
    if ((++_sp & 255u) == 0u) { if (xb_ld(&(bar)[XB_TMO])) break; if (_sp > XB_SPIN_CAP) { atomicAdd(&(bar)[XB_TMO], 1u); break; } } } } while (0)

struct XcdBarrier {
    unsigned* bar; unsigned x;
    volatile LAS unsigned* st;
};

__device__ __forceinline__ XcdBarrier xcd_barrier_post(unsigned* bar, volatile LAS unsigned* st) {
    XcdBarrier b; b.bar = bar; b.x = xb_xcc_id(); b.st = st;
    if (threadIdx.x == 0) (void)xb_add(&bar[XB_XCNT(b.x)], 1u);
    return b;
}
__device__ __forceinline__ void xcd_barrier_complete(unsigned* bar, unsigned x, unsigned& nloc, unsigned& nx) {
    const unsigned G = gridDim.x * gridDim.y * gridDim.z;
    unsigned sum, cnt, mine, sp = 0u;
    for (;;) {
        sum = 0u; cnt = 0u; mine = 0u;
#pragma unroll
        for (unsigned j = 0; j < 16; ++j) { const unsigned c = xb_ld(&bar[XB_XCNT(j)]); sum += c; cnt += (c > 0u) ? 1u : 0u; mine = (j == x) ? c : mine; }
        if (sum == G) break;
        __builtin_amdgcn_s_sleep(1);
        if ((++sp & 255u) == 0u) { if (xb_ld(&bar[XB_TMO])) break; if (sp > XB_SPIN_CAP) { atomicAdd(&bar[XB_TMO], 1u); break; } }
    }
    nloc = mine > 0u ? mine : 1u; nx = cnt > 0u ? cnt : 1u;
}

__device__ __forceinline__ void xcd_barrier(const XcdBarrier& b) {
    asm volatile("s_waitcnt vmcnt(0)" ::: "memory");
    __syncthreads();
    if (threadIdx.x == 0) {
        unsigned* bar = b.bar;
        __builtin_amdgcn_s_waitcnt(0);
        unsigned nloc = b.st[0], nx = b.st[1];
        if (nloc == 0u) { xcd_barrier_complete(bar, b.x, nloc, nx); b.st[0] = nloc; b.st[1] = nx; }
        const unsigned old = xb_add(&bar[XB_XSUB(b.x)], 1u);
        const unsigned gen = old / nloc;
        if (old + 1u == (gen + 1u) * nloc) {
            __builtin_amdgcn_fence(__ATOMIC_RELEASE, "agent");
            asm volatile("s_waitcnt vmcnt(0)" ::: "memory");
            const unsigned og = xb_add(&bar[XB_TOP], 1u);
            const unsigned tg = og / nx;
            if (og + 1u == (tg + 1u) * nx) xb_add(&bar[XB_TOPGEN], 1u);
            else XB_SPIN(xb_ld(&bar[XB_TOPGEN]) == tg, bar);
            __builtin_amdgcn_fence(__ATOMIC_ACQUIRE, "agent");
            xb_add(&bar[XB_XGEN(b.x)], 1u);
            asm volatile("s_waitcnt vmcnt(0)" ::: "memory");
        } else {
            XB_SPIN(xb_ld(&bar[XB_XGEN(b.x)]) == gen, bar);
            __builtin_amdgcn_fence(__ATOMIC_ACQUIRE, "agent");
            asm volatile("s_waitcnt vmcnt(0)" ::: "memory");
        }
    }
    __syncthreads();
}
#ifndef ONE_LAUNCH
#define ONE_LAUNCH 1
#endif
#ifndef NLAYERS
#define NLAYERS 4
#endif
constexpr int DM = 2048, MR = 8704, NLATR = 8192;
constexpr int NINP = 6400, DFF = 5632, NUP = 11264, EVIN = 6176, ODIN = 6160;
constexpr int NWAVES = 8, NTHR = 512;
constexpr float EPS = 1e-6f;
constexpr int NCHUNK = 68;
constexpr int PPL = 11, NPH = 1 + 4 * PPL;
constexpr size_t MiB = 1ull << 20;
constexpr size_t WS_CTL = 0, CTL_BYTES = 1 * MiB;
constexpr size_t WS_MOD = 1 * MiB, WS_ROPE = 1 * MiB + 640 * 1024;
constexpr size_t WS_W = 4 * MiB, W_LAYER = 99 * MiB, W_OUT = 25 * MiB, W_UP = 33 * MiB, W_DN = 77 * MiB;
constexpr size_t WS_XS = 400 * MiB, WS_H = 468 * MiB, WS_MIX = 502 * MiB, WS_P = 536 * MiB, WS_U = 644 * MiB, WS_ACT = 832 * MiB;
constexpr size_t WS_QR = 926 * MiB, WS_KR = 943 * MiB, WS_MQK = 960 * MiB, WS_DST = 977 * MiB, WS_SST = 1113 * MiB, WS_SM = 1181 * MiB, WS_END = 1186 * MiB;
constexpr size_t SM_GAM = 0, SM_DN = 1 * MiB, SM_NIN = 2 * MiB, SM_BL = 3 * MiB, SM_ML = 3 * MiB + 8192, SM_MIN = 3 * MiB + 16384;
constexpr int CW_BAR = 4096;
constexpr int LDS_BYTES = 147456, MISC_OFF = 131072 + 320;

struct Args { const float* in[27]; float* out; unsigned char* ws; int ph_lo, ph_hi, li, pad; };

__device__ __forceinline__ float bf_lo(unsigned u) { return __builtin_bit_cast(float, u << 16); }
__device__ __forceinline__ float bf_hi(unsigned u) { return __builtin_bit_cast(float, u & 0xffff0000u); }
__device__ __forceinline__ float bf1(bf16 b) { return __builtin_bit_cast(float, (unsigned)b << 16); }
typedef float f32x2_t __attribute__((ext_vector_type(2))); typedef __bf16 bf16x2_t __attribute__((ext_vector_type(2)));
__device__ __forceinline__ unsigned pk2(float lo, float hi) { f32x2_t v = {lo, hi}; bf16x2_t b = __builtin_convertvector(v, bf16x2_t); return __builtin_bit_cast(unsigned, b); }
__device__ __forceinline__ bf16 f2bf(float f) { return (bf16)(pk2(f, 0.f) & 0xffffu); }
__device__ __forceinline__ void unpack8(const v4u w, float (&f)[8]) { f[0] = bf_lo(w.x); f[1] = bf_hi(w.x); f[2] = bf_lo(w.y); f[3] = bf_hi(w.y); f[4] = bf_lo(w.z); f[5] = bf_hi(w.z); f[6] = bf_lo(w.w); f[7] = bf_hi(w.w); }
__device__ __forceinline__ v4u pack8(const float (&f)[8]) { v4u w; w.x = pk2(f[0], f[1]); w.y = pk2(f[2], f[3]); w.z = pk2(f[4], f[5]); w.w = pk2(f[6], f[7]); return w; }
__device__ __forceinline__ float silu_f(float x) { return x / (1.f + __expf(-x)); }
__device__ __forceinline__ float sigmoid_f(float x) { return 1.f / (1.f + __expf(-x)); }
__device__ __forceinline__ float logsig_f(float z) { return fminf(z, 0.f) - log1pf(__expf(-fabsf(z))); }
__device__ __forceinline__ float wave_sum(float v) {
#pragma unroll
    for (int o = 1; o < 64; o <<= 1) v += __shfl_xor(v, o);
    return v;
}
__device__ __forceinline__ float wave_max(float v) {
#pragma unroll
    for (int o = 1; o < 64; o <<= 1) v = fmaxf(v, __shfl_xor(v, o));
    return v;
}
__device__ __forceinline__ float wave_scan_sum(float v, int dir, int lane) {
#pragma unroll
    for (int o = 1; o < 64; o <<= 1) { const float up = __shfl_up(v, o), dn = __shfl_down(v, o); if (dir == 0) { if (lane >= o) v += up; } else { if (lane + o < 64) v += dn; } }
    return v;
}
__device__ __forceinline__ float wave_scan_max(float v, int dir, int lane) {
#pragma unroll
    for (int o = 1; o < 64; o <<= 1) { const float up = __shfl_up(v, o), dn = __shfl_down(v, o); if (dir == 0) { if (lane >= o) v = fmaxf(v, up); } else { if (lane + o < 64) v = fmaxf(v, dn); } }
    return v;
}
__device__ __forceinline__ bool seq_start(int r) { return r < NLATR ? (r & 4095) == 0 : ((r - NLATR) & 255) == 0; }

__device__ __forceinline__ bf16x8 frag_row(LAS const unsigned char* base, int stride, int row0, int k0, int lane) {
    return *(LAS const bf16x8*)(base + (row0 + (lane & 31)) * stride + (k0 + 8 * (lane >> 5)) * 2);
}
__device__ __forceinline__ s16x4 tr4(LAS const unsigned char* p) { return __builtin_amdgcn_ds_read_tr16_b64_v4i16((LAS s16x4*)p); }
__device__ __forceinline__ bf16x8 frag_tr(LAS const unsigned char* base, int stride, int k0, int col0, int lane) {
    const int h = lane >> 5, blk = (lane >> 4) & 1, q = (lane & 15) >> 2, p = lane & 3;
    LAS const unsigned char* a = base + (k0 + 8 * h + q) * stride + (col0 + 16 * blk + 4 * p) * 2;
    const s16x4 lo = tr4(a), hi = tr4(a + 4 * stride);
    return (bf16x8){lo[0], lo[1], lo[2], lo[3], hi[0], hi[1], hi[2], hi[3]};
}
__device__ __forceinline__ bf16x8 frag_tr_perm(LAS const unsigned char* base, int stride, int k0, int col0, int lane) {
    const int h = lane >> 5, blk = (lane >> 4) & 1, q = (lane & 15) >> 2, p = lane & 3;
    LAS const unsigned char* a = base + (k0 + 4 * h + q) * stride + (col0 + 16 * blk + 4 * p) * 2;
    const s16x4 lo = tr4(a), hi = tr4(a + 8 * stride);
    return (bf16x8){lo[0], lo[1], lo[2], lo[3], hi[0], hi[1], hi[2], hi[3]};
}
#define MFMA32(a, b, c) __builtin_amdgcn_mfma_f32_32x32x16_bf16((a), (b), (c), 0, 0, 0)
__device__ __forceinline__ f32x16 zero16() { f32x16 z;
#pragma unroll
    for (int i = 0; i < 16; ++i) z[i] = 0.f;
    return z; }
__device__ __forceinline__ void load_tile(LAS unsigned char* dst, int ls, const bf16* src, size_t ld, int rows, int cols, int tid) {
    const int cpr = cols >> 3, n = rows * cpr;
    for (int c = tid; c < n; c += NTHR) { const int r = c / cpr, cc = c - r * cpr; *(LAS v4u*)(dst + r * ls + cc * 16) = *(const v4u*)(src + (size_t)r * ld + cc * 8); }
}

__device__ __forceinline__ void transpose_item(const float* W, int K, int N, int Npad, bf16* WT, LAS float* scr, int item, int lane) {
    const int nblk = Npad / 32, kb = item / nblk, nb = item - kb * nblk, k0 = 64 * kb, n0 = 32 * nb;
    const int n = n0 + (lane & 31);
#pragma unroll 8
    for (int i = 0; i < 32; ++i) { const int kk = 2 * i + (lane >> 5); scr[kk * 33 + (lane & 31)] = n < N ? W[(size_t)(k0 + kk) * N + n] : 0.f; }
    asm volatile("s_waitcnt lgkmcnt(0)" ::: "memory");
    const int c = lane & 7;
#pragma unroll
    for (int j = 0; j < 4; ++j) { const int nn = (lane >> 3) + 8 * j; const LAS float* s = scr + (8 * c) * 33 + nn;
        v4u o; o.x = pk2(s[0 * 33], s[1 * 33]); o.y = pk2(s[2 * 33], s[3 * 33]); o.z = pk2(s[4 * 33], s[5 * 33]); o.w = pk2(s[6 * 33], s[7 * 33]);
        *(v4u*)(WT + (size_t)(n0 + nn) * K + k0 + 8 * c) = o; }
    asm volatile("s_waitcnt lgkmcnt(0)" ::: "memory");
}
__device__ __forceinline__ void tr_matrix(const float* W, int K, int N, int Npad, bf16* WT, LAS float* scr, int& off, int gw, int NGW, int lane) {
    const int nitems = (K / 64) * (Npad / 32);
    int start = (gw - off) % NGW; if (start < 0) start += NGW;
    for (int it = start; it < nitems; it += NGW) transpose_item(W, K, N, Npad, WT, scr, it, lane);
    off = (off + nitems) % NGW;
}
__device__ __forceinline__ void ph_prologue(const Args& a, unsigned char* ws, LAS unsigned char* lds, int tid, int lane, int wave, int bid, int G) {
    float* MOD = (float*)(ws + WS_MOD);
    LAS float* vec = (LAS float*)(lds + 73728);
    LAS float* red = (LAS float*)(lds + 98304);
    for (int e = tid; e < 3 * DM; e += NTHR) { const float v = e < 2 * DM ? a.in[1][e] : a.in[3][e - 2 * DM]; vec[e] = silu_f(v); }
    __syncthreads();
    for (int it = bid; it < 4 * 48; it += G) {
        const int layer = it / 48, cg = it - layer * 48, col = cg * 256 + 4 * lane;
        const float* W = a.in[4] + (size_t)layer * DM * 12288 + col;
        f32x4 a0 = {0.f, 0.f, 0.f, 0.f}, a1 = a0, a2 = a0;
#pragma unroll 8
        for (int k = 0; k < 256; ++k) { const int kk = 256 * wave + k; const f32x4 w4 = *(const f32x4*)(W + (size_t)kk * 12288);
            a0 += w4 * vec[kk]; a1 += w4 * vec[DM + kk]; a2 += w4 * vec[2 * DM + kk]; }
        *(LAS f32x4*)(red + (wave * 3 + 0) * 256 + 4 * lane) = a0; *(LAS f32x4*)(red + (wave * 3 + 1) * 256 + 4 * lane) = a1; *(LAS f32x4*)(red + (wave * 3 + 2) * 256 + 4 * lane) = a2;
        __syncthreads();
        for (int e = tid; e < 768; e += NTHR) { const int j = e >> 8, c = e & 255; float s = a.in[5][layer * 12288 + cg * 256 + c];
#pragma unroll
            for (int w = 0; w < 8; ++w) s += red[(w * 3 + j) * 256 + c];
            MOD[(size_t)(layer * 3 + j) * 12288 + cg * 256 + c] = s; }
        __syncthreads();
    }
    if (bid == G - 1) { float* rope = (float*)(ws + WS_ROPE);
        for (int e = tid; e < 1024; e += NTHR) { const int pos = e >> 4, f = e & 15; const float inv = powf(10000.f, -(float)f / 16.f), ang = (float)pos * inv; rope[e] = cosf(ang); rope[1024 + e] = sinf(ang); } }
    { f32x4* XS = (f32x4*)(ws + WS_XS); const f32x4* x4 = (const f32x4*)a.in[0]; const f32x4* c4 = (const f32x4*)a.in[2];
      const int nl = NLATR * DM / 4, nt = MR * DM / 4;
      for (int e = bid * NTHR + tid; e < nt; e += G * NTHR) XS[e] = e < nl ? x4[e] : c4[e - nl]; }
    LAS float* scr = (LAS float*)(lds + wave * 8448);
    const int gw = bid * NWAVES + wave, NGW = G * NWAVES; int off = 0;
    for (int layer = 0; layer < 4; ++layer) {
        const int li = layer >> 1; unsigned char* wb = ws + WS_W + (size_t)layer * W_LAYER;
        if (layer & 1) tr_matrix(a.in[14] + (size_t)li * DM * ODIN, DM, ODIN, NINP, (bf16*)wb, scr, off, gw, NGW, lane);
        else           tr_matrix(a.in[8] + (size_t)li * DM * EVIN, DM, EVIN, NINP, (bf16*)wb, scr, off, gw, NGW, lane);
        tr_matrix((layer & 1 ? a.in[15] : a.in[9]) + (size_t)li * DM * DM, DM, DM, DM, (bf16*)(wb + W_OUT), scr, off, gw, NGW, lane);
        tr_matrix(a.in[23] + (size_t)layer * DM * NUP, DM, NUP, NUP, (bf16*)(wb + W_UP), scr, off, gw, NGW, lane);
        tr_matrix(a.in[26] + (size_t)layer * DFF * DM, DFF, DM, DM, (bf16*)(wb + W_DN), scr, off, gw, NGW, lane);
    }
}

__device__ __forceinline__ void ph_norm(const float* XS, const float* ng, const float* msh, const float* msc, bf16* H, int gw, int NGW, int lane) {
    for (int row = gw; row < MR; row += NGW) {
        const int mi = row < NLATR ? (row >> 12) : 2;
        const f32x4* xr = (const f32x4*)(XS + (size_t)row * DM) + lane;
        f32x4 v[8]; float ss = 0.f;
#pragma unroll
        for (int j = 0; j < 8; ++j) { v[j] = xr[64 * j]; ss += (v[j].x * v[j].x + v[j].y * v[j].y) + (v[j].z * v[j].z + v[j].w * v[j].w); }
        const float r = rsqrtf(wave_sum(ss) * (1.f / DM) + EPS);
#pragma unroll
        for (int j = 0; j < 8; ++j) { const int col = 4 * lane + 256 * j;
            const f32x4 g4 = *(const f32x4*)(ng + col), sc4 = *(const f32x4*)(msc + (size_t)mi * 12288 + col), sh4 = *(const f32x4*)(msh + (size_t)mi * 12288 + col);
            const f32x4 y = v[j] * r * g4 * (sc4 + 1.f) + sh4;
            v2u o; o.x = pk2(y.x, y.y); o.y = pk2(y.z, y.w);
            *(v2u*)(H + (size_t)row * DM + col) = o; }
    }
}

template <int MODE>
__device__ __forceinline__ void ph_conv(const bf16* SRC, const float* cw, const float* cb, bf16* DST, int gtid, int NT) {
    constexpr int NC = MODE == 0 ? DFF : 1024, NCG = NC / 8, NRB = MR / 16;
    constexpr int LDS_ = MODE == 0 ? NUP : NINP, LDD = MODE == 0 ? DFF : (MODE == 1 ? DM : 1024);
    for (int it = gtid; it < NRB * NCG; it += NT) {
        const int rb = it / NCG, cg = it - rb * NCG, r0 = rb * 16, c0 = cg * 8;
        float w0[8], w1[8], w2[8], bb[8];
#pragma unroll
        for (int j = 0; j < 8; ++j) { w0[j] = cw[c0 + j]; w1[j] = cw[NC + c0 + j]; w2[j] = cw[2 * NC + c0 + j]; bb[j] = MODE == 0 ? cb[c0 + j] : 0.f; }
        auto ld = [&](int r, float (&f)[8]) {
            if (MODE == 0) { unpack8(*(const v4u*)(SRC + (size_t)r * LDS_ + c0), f); }
            else if (MODE == 1) { float s1[8], s2[8]; unpack8(*(const v4u*)(SRC + (size_t)r * LDS_ + 3104 + c0), s1); unpack8(*(const v4u*)(SRC + (size_t)r * LDS_ + 5152 + c0), s2);
#pragma unroll
                for (int j = 0; j < 8; ++j) f[j] = s1[j] * s2[j]; }
            else { unpack8(*(const v4u*)(SRC + (size_t)r * LDS_ + 3072 + c0), f); }
        };
        float prev[8], cur[8], nxt[8];
        if (!seq_start(r0)) ld(r0 - 1, prev); else {
#pragma unroll
            for (int j = 0; j < 8; ++j) prev[j] = 0.f; }
        ld(r0, cur);
#pragma unroll 2
        for (int i = 0; i < 16; ++i) {
            const int r = r0 + i;
            if (i < 15 || !seq_start(r0 + 16)) ld(r + 1, nxt); else {
#pragma unroll
                for (int j = 0; j < 8; ++j) nxt[j] = 0.f; }
            float o[8];
            if (MODE == 0) { float vv[8]; unpack8(*(const v4u*)(SRC + (size_t)r * LDS_ + DFF + c0), vv);
#pragma unroll
                for (int j = 0; j < 8; ++j) o[j] = silu_f(w0[j] * prev[j] + w1[j] * cur[j] + w2[j] * nxt[j] + bb[j]) * vv[j]; }
            else if (MODE == 1) { float vv[8]; unpack8(*(const v4u*)(SRC + (size_t)r * LDS_ + 4128 + c0), vv);
#pragma unroll
                for (int j = 0; j < 8; ++j) o[j] = (w0[j] * prev[j] + w1[j] * cur[j] + w2[j] * nxt[j]) * vv[j]; }
            else { const float sc = c0 >= 512 ? 0.08838834764831845f : 1.f;
#pragma unroll
                for (int j = 0; j < 8; ++j) o[j] = silu_f(w0[j] * prev[j] + w1[j] * cur[j] + w2[j] * nxt[j]) * sc; }
            *(v4u*)(DST + (size_t)r * LDD + (MODE == 1 ? 1024 : 0) + c0) = pack8(o);
#pragma unroll
            for (int j = 0; j < 8; ++j) { prev[j] = cur[j]; cur[j] = nxt[j]; }
        }
    }
}

__device__ __forceinline__ void ph_qkprep(const bf16* P, const float* qg, const float* kg, const float* rope, bf16* QR, bf16* KR, int gw, int NGW, int lane) {
    for (int it = gw; it < MR * 4; it += NGW) {
        const int row = it >> 2, qtr = it & 3, isk = qtr >> 1;
        float x[8]; unpack8(*(const v4u*)(P + (size_t)row * NINP + isk * 1024 + (qtr & 1) * 512 + 8 * lane), x);
        float ss = 0.f;
#pragma unroll
        for (int j = 0; j < 8; ++j) ss += x[j] * x[j];
        ss += __shfl_xor(ss, 1); ss += __shfl_xor(ss, 2); ss += __shfl_xor(ss, 4);
        const float r = rsqrtf(ss * (1.f / 64.f) + EPS);
        const int i = lane & 7; const float* gp = (isk ? kg : qg) + 8 * i;
        float y[8], o[8];
#pragma unroll
        for (int j = 0; j < 8; ++j) y[j] = x[j] * r * gp[j];
        if (row < NLATR) {
            const int t = row & 4095, pos = (i < 4) ? (t >> 6) : (t & 63), f0 = 8 * (i & 1);
#pragma unroll
            for (int j = 0; j < 8; ++j) { const float pj = __shfl_xor(y[j], 2), c = rope[pos * 16 + f0 + j], s = rope[1024 + pos * 16 + f0 + j];
                o[j] = (i & 2) ? (pj * s + y[j] * c) : (y[j] * c - pj * s); }
        } else {
#pragma unroll
            for (int j = 0; j < 8; ++j) o[j] = y[j]; }
        if (!isk) {
#pragma unroll
            for (int j = 0; j < 8; ++j) o[j] *= 0.18033688011112042f; }
        *(v4u*)((isk ? KR : QR) + (size_t)row * 1024 + (qtr & 1) * 512 + 8 * lane) = pack8(o);
    }
}

struct ScanP {
    const bf16* P; const bf16* MQK; bf16* MIX;
    const float* gw2; const float* gb;
    const float* mgb;
    const float* ng;
    float* DSTp; bf16* SSTp; float* GAM; float* DN; float* NIN; float* BL; float* ML; float* MINp;
};
__device__ __forceinline__ void scan_unit(int u, int& b, int& head, int& mm, int& rowbase) {
    b = u / 272; const int rem = u - b * 272; head = rem / 68; mm = rem - head * 68;
    rowbase = mm < 4 ? NLATR + b * 256 + 64 * mm : b * 4096 + 64 * (mm - 4);
}
__device__ __forceinline__ int scan_chunk(int mm, int dir) { return dir ? (mm < 4 ? 3 - mm : 71 - mm) : mm; }

__device__ __forceinline__ void gla_gates(const ScanP& s, LAS const float* glr, LAS float* tot, int head, int dir, int tid, float (&bb)[16], float& btot) {
    const int dk = tid & 127, grp = tid >> 7;
    float w2[16];
#pragma unroll
    for (int r = 0; r < 16; ++r) w2[r] = s.gw2[(dir * 16 + r) * 512 + head * 128 + dk];
    const float bias = s.gb[dir * 512 + head * 128 + dk];
#pragma unroll
    for (int tt = 0; tt < 16; ++tt) { const int t = 16 * grp + tt; float z = bias;
#pragma unroll
        for (int r = 0; r < 16; ++r) z += glr[t * 32 + dir * 16 + r] * w2[r];
        bb[tt] = logsig_f(z) * 0.0625f; }
    if (dir == 0) {
#pragma unroll
        for (int tt = 1; tt < 16; ++tt) bb[tt] += bb[tt - 1];
        tot[grp * 128 + dk] = bb[15];
    } else {
#pragma unroll
        for (int tt = 14; tt >= 0; --tt) bb[tt] += bb[tt + 1];
        tot[grp * 128 + dk] = bb[0];
    }
    __syncthreads();
    float off = 0.f; btot = 0.f;
#pragma unroll
    for (int g = 0; g < 4; ++g) { const float tv = tot[g * 128 + dk]; btot += tv; if (dir == 0 ? g < grp : g > grp) off += tv; }
#pragma unroll
    for (int tt = 0; tt < 16; ++tt) bb[tt] += off;
}

template <int MODE>
__device__ __forceinline__ void ph_scan_local(const ScanP& s, LAS unsigned char* lds, int tid, int lane, int wave, int bid, int G) {
    LAS unsigned char* Vs = lds; LAS unsigned char* Kh = lds + 33792;
    LAS float* glr = (LAS float*)(lds + 51200); LAS float* tot = (LAS float*)(lds + 59392); LAS float* wv = (LAS float*)(lds + 61440); LAS float* dnp = (LAS float*)(lds + 61696);
    const int dk = tid & 127, grp = tid >> 7;
    for (int u = bid; u < 544; u += G) {
        int b, head, mm, rowbase; scan_unit(u, b, head, mm, rowbase);
        load_tile(Vs, 528, s.P + (size_t)rowbase * NINP + (MODE ? 4096 : 1024) + head * 256, NINP, 64, 256, tid);
        if (MODE == 0) for (int e = tid; e < 2048; e += NTHR) glr[e] = bf1(s.P[(size_t)(rowbase + (e >> 5)) * NINP + 3072 + (e & 31)]);
        __syncthreads();
        for (int dir = 0; dir < 2; ++dir) {
            const int chain = (b * 4 + head) * 2 + dir, c = scan_chunk(mm, dir); const size_t cc = (size_t)chain * NCHUNK + c;
            if (MODE == 0) {
                float bb[16], btot; gla_gates(s, glr, tot, head, dir, tid, bb, btot);
#pragma unroll
                for (int tt = 0; tt < 16; ++tt) { const int t = 16 * grp + tt; const float kv = bf1(s.P[(size_t)(rowbase + t) * NINP + 512 + head * 128 + dk]) * __expf(btot - bb[tt]);
                    *(LAS bf16*)(Kh + t * 272 + dk * 2) = f2bf(kv); }
                if (grp == 0) s.GAM[cc * 128 + dk] = __expf(btot);
            } else {
                if (wave == 0) {
                    const float ig = bf1(s.P[(size_t)(rowbase + lane) * NINP + 6144 + dir * 8 + head]) + s.mgb[dir * 8 + head];
                    const float fg = bf1(s.P[(size_t)(rowbase + lane) * NINP + 6144 + dir * 8 + 4 + head]) + s.mgb[dir * 8 + 4 + head];
                    const float lf = logsig_f(fg), bcs = wave_scan_sum(lf, dir, lane), blast = wave_sum(lf);
                    const float gs = blast - bcs + ig, mloc = wave_max(gs);
                    wv[lane] = __expf(gs - mloc);
                    if (lane == 0) { s.BL[cc] = blast; s.ML[cc] = mloc; }
                }
                __syncthreads();
                float part = 0.f;
#pragma unroll
                for (int tt = 0; tt < 16; ++tt) { const int t = 16 * grp + tt; const float kv = bf1(s.MQK[(size_t)(rowbase + t) * 1024 + 512 + head * 128 + dk]) * wv[t];
                    *(LAS bf16*)(Kh + t * 272 + dk * 2) = f2bf(kv); part += kv; }
                dnp[grp * 128 + dk] = part;
            }
            __syncthreads();
            if (MODE == 1 && tid < 128) s.DN[cc * 128 + tid] = (dnp[tid] + dnp[128 + tid]) + (dnp[256 + tid] + dnp[384 + tid]);
            f32x16 acc[4];
#pragma unroll
            for (int nt = 0; nt < 4; ++nt) acc[nt] = zero16();
#pragma unroll
            for (int ks = 0; ks < 4; ++ks) { const bf16x8 af = frag_tr(Vs, 528, 16 * ks, 32 * wave, lane);
#pragma unroll
                for (int nt = 0; nt < 4; ++nt) { const bf16x8 bfr = frag_tr(Kh, 272, 16 * ks, 32 * nt, lane); acc[nt] = MFMA32(af, bfr, acc[nt]); } }
            float* D = s.DSTp + cc * 32768;
#pragma unroll
            for (int nt = 0; nt < 4; ++nt)
#pragma unroll
                for (int r = 0; r < 16; ++r) { const int dv = 32 * wave + (r & 3) + 8 * (r >> 2) + 4 * (lane >> 5); D[dv * 128 + 32 * nt + (lane & 31)] = acc[nt][r]; }
            __syncthreads();
        }
    }
}

template <int MODE>
__device__ __forceinline__ void ph_scan_carry(const ScanP& s, int gtid, int NT) {
    for (int e = gtid; e < 16 * 8192; e += NT) {
        const int chain = e >> 13, rem = e & 8191, dv = rem >> 5, dk = (rem & 31) * 4;
        f32x4 st = {0.f, 0.f, 0.f, 0.f}, nst = st; float m = 0.f;
        for (int c0 = 0; c0 < NCHUNK; c0 += 4) {
            f32x4 d[4], gm[4]; float bl[4], ml[4];
#pragma unroll
            for (int j = 0; j < 4; ++j) { const size_t cc = (size_t)chain * NCHUNK + c0 + j; d[j] = *(const f32x4*)(s.DSTp + cc * 32768 + dv * 128 + dk);
                if (MODE == 0) gm[j] = *(const f32x4*)(s.GAM + cc * 128 + dk);
                else { bl[j] = s.BL[cc]; ml[j] = s.ML[cc]; gm[j] = (dv == 0) ? *(const f32x4*)(s.DN + cc * 128 + dk) : (f32x4){0.f, 0.f, 0.f, 0.f}; } }
#pragma unroll
            for (int j = 0; j < 4; ++j) { const size_t cc = (size_t)chain * NCHUNK + c0 + j;
                v2u o; o.x = pk2(st.x, st.y); o.y = pk2(st.z, st.w); *(v2u*)(s.SSTp + cc * 32768 + dv * 128 + dk) = o;
                if (MODE == 0) st = gm[j] * st + d[j];
                else { if (dv == 0) { *(f32x4*)(s.NIN + cc * 128 + dk) = nst; if (dk == 0) s.MINp[cc] = m; }
                    const float mn = fmaxf(bl[j] + m, ml[j]), dec = __expf(bl[j] + m - mn), sc = __expf(ml[j] - mn);
                    st = st * dec + d[j] * sc; nst = nst * dec + gm[j] * sc; m = mn; } }
        }
    }
}

template <int MODE>
__device__ __forceinline__ void ph_scan_out(const ScanP& s, LAS unsigned char* lds, int tid, int lane, int wave, int bid, int G) {
    LAS unsigned char* Vs = lds; LAS unsigned char* Qx = lds + 33792; LAS unsigned char* Ki = lds + 51200; LAS unsigned char* Qi = lds + 68608; LAS unsigned char* Am = lds + 86016;
    LAS float* glr = (LAS float*)(lds + 95232); LAS float* tot = (LAS float*)(lds + 103424);
    LAS float* us = (LAS float*)(lds + 105472); LAS float* Mts = us + 64; LAS float* wint = us + 128; LAS float* thr = us + 192; LAS float* fac = us + 256; LAS float* qn = us + 320; LAS float* rs = us + 384;
    LAS float* qnp = (LAS float*)(lds + 107520);
    LAS float* Os = (LAS float*)lds;
    const int dk = tid & 127, grp = tid >> 7;
    for (int u = bid; u < 544; u += G) {
        int b, head, mm, rowbase; scan_unit(u, b, head, mm, rowbase);
        load_tile(Vs, 528, s.P + (size_t)rowbase * NINP + (MODE ? 4096 : 1024) + head * 256, NINP, 64, 256, tid);
        if (MODE == 0) { for (int e = tid; e < 2048; e += NTHR) glr[e] = bf1(s.P[(size_t)(rowbase + (e >> 5)) * NINP + 3072 + (e & 31)]); if (tid < 64) fac[tid] = 1.f; }
        f32x16 hsum[2]; hsum[0] = zero16(); hsum[1] = zero16();
        __syncthreads();
        for (int dir = 0; dir < 2; ++dir) {
            const int chain = (b * 4 + head) * 2 + dir, c = scan_chunk(mm, dir); const size_t cc = (size_t)chain * NCHUNK + c;
            if (MODE == 0) {
                float bb[16], btot; gla_gates(s, glr, tot, head, dir, tid, bb, btot);
#pragma unroll
                for (int tt = 0; tt < 16; ++tt) { const int t = 16 * grp + tt; const size_t ro = (size_t)(rowbase + t) * NINP + head * 128 + dk;
                    const float qv = bf1(s.P[ro]), kv = bf1(s.P[ro + 512]);
                    *(LAS bf16*)(Qx + t * 272 + dk * 2) = f2bf(qv * __expf(bb[tt]) * 0.08838834764831845f);
                    *(LAS bf16*)(Ki + t * 272 + dk * 2) = f2bf(kv * __expf(-bb[tt])); }
            } else {
                if (wave == 0) {
                    const float ig = bf1(s.P[(size_t)(rowbase + lane) * NINP + 6144 + dir * 8 + head]) + s.mgb[dir * 8 + head];
                    const float fg = bf1(s.P[(size_t)(rowbase + lane) * NINP + 6144 + dir * 8 + 4 + head]) + s.mgb[dir * 8 + 4 + head];
                    const float lf = logsig_f(fg), bcs = wave_scan_sum(lf, dir, lane);
                    const float uu = ig - bcs, pm = wave_scan_max(uu, dir, lane), min_ = s.MINp[cc], Mt = fmaxf(min_, pm);
                    us[lane] = uu; Mts[lane] = Mt; wint[lane] = __expf(min_ - Mt); thr[lane] = __expf(-bcs - Mt);
                }
                __syncthreads();
#pragma unroll
                for (int tt = 0; tt < 16; ++tt) { const int t = 16 * grp + tt; const size_t ro = (size_t)(rowbase + t) * 1024 + head * 128 + dk;
                    const bf16 qb = s.MQK[ro], kb = s.MQK[ro + 512];
                    *(LAS bf16*)(Qi + t * 272 + dk * 2) = qb; *(LAS bf16*)(Ki + t * 272 + dk * 2) = kb;
                    *(LAS bf16*)(Qx + t * 272 + dk * 2) = f2bf(bf1(qb) * wint[t]); }
                __syncthreads();
                { const int t = tid & 63, part = tid >> 6; float acc = 0.f;
#pragma unroll
                  for (int j = 0; j < 16; ++j) acc += bf1(*(LAS const bf16*)(Qi + t * 272 + (part * 16 + j) * 2)) * s.NIN[cc * 128 + part * 16 + j];
                  qnp[part * 64 + t] = acc; }
            }
            __syncthreads();
            if (MODE == 1 && tid < 64) { float q = 0.f;
#pragma unroll
                for (int p = 0; p < 8; ++p) q += qnp[p * 64 + tid];
                qn[tid] = q; }
            if (wave < 4) {
                const int ti = wave >> 1, tj = wave & 1; f32x16 acc = zero16();
#pragma unroll
                for (int ks = 0; ks < 8; ++ks) { const bf16x8 af = frag_row(MODE ? Qi : Qx, 272, 32 * ti, 16 * ks, lane), bfr = frag_row(Ki, 272, 32 * tj, 16 * ks, lane); acc = MFMA32(af, bfr, acc); }
                const int sidx = 32 * tj + (lane & 31);
                const float usv = MODE ? us[sidx] : 0.f;
#pragma unroll
                for (int r = 0; r < 16; ++r) { const int t = 32 * ti + (r & 3) + 8 * (r >> 2) + 4 * (lane >> 5);
                    const bool keep = dir == 0 ? (sidx <= t) : (sidx >= t);
                    float v = acc[r];
                    if (MODE == 1) v *= __expf(usv - Mts[t]);
                    v = keep ? v : 0.f;
                    *(LAS bf16*)(Am + t * 144 + sidx * 2) = f2bf(v);
                    if (MODE == 1) { float rsum = v; rsum += __shfl_xor(rsum, 1); rsum += __shfl_xor(rsum, 2); rsum += __shfl_xor(rsum, 4); rsum += __shfl_xor(rsum, 8); rsum += __shfl_xor(rsum, 16);
                        if ((lane & 31) == 0) rs[tj * 64 + t] = rsum; } }
            }
            __syncthreads();
            if (MODE == 1 && tid < 64) { const float den = wint[tid] * qn[tid] + rs[tid] + rs[64 + tid]; fac[tid] = 1.f / fmaxf(fabsf(den), thr[tid]); }
            f32x16 acc2[2]; acc2[0] = zero16(); acc2[1] = zero16();
            { const bf16* Sg = s.SSTp + cc * 32768 + (size_t)(32 * wave + (lane & 31)) * 128 + 8 * (lane >> 5);
#pragma unroll
              for (int ks = 0; ks < 8; ++ks) { const bf16x8 bfr = *(const bf16x8*)(Sg + 16 * ks);
#pragma unroll
                  for (int rt = 0; rt < 2; ++rt) { const bf16x8 af = frag_row(Qx, 272, 32 * rt, 16 * ks, lane); acc2[rt] = MFMA32(af, bfr, acc2[rt]); } } }
#pragma unroll
            for (int ks = 0; ks < 4; ++ks) { const bf16x8 bfr = frag_tr(Vs, 528, 16 * ks, 32 * wave, lane);
#pragma unroll
                for (int rt = 0; rt < 2; ++rt) { const bf16x8 af = frag_row(Am, 144, 32 * rt, 16 * ks, lane); acc2[rt] = MFMA32(af, bfr, acc2[rt]); } }
            __syncthreads();
#pragma unroll
            for (int rt = 0; rt < 2; ++rt)
#pragma unroll
                for (int r = 0; r < 16; ++r) { const int t = 32 * rt + (r & 3) + 8 * (r >> 2) + 4 * (lane >> 5); hsum[rt][r] += acc2[rt][r] * fac[t]; }
        }
        __syncthreads();
#pragma unroll
        for (int rt = 0; rt < 2; ++rt)
#pragma unroll
            for (int r = 0; r < 16; ++r) { const int t = 32 * rt + (r & 3) + 8 * (r >> 2) + 4 * (lane >> 5); Os[t * 260 + 32 * wave + (lane & 31)] = hsum[rt][r]; }
        __syncthreads();
        { const int t = tid >> 3, part = tid & 7; float o[32]; float ss = 0.f;
#pragma unroll
          for (int j = 0; j < 8; ++j) { const f32x4 v = *(LAS const f32x4*)(Os + t * 260 + 32 * part + 4 * j); o[4 * j] = v.x; o[4 * j + 1] = v.y; o[4 * j + 2] = v.z; o[4 * j + 3] = v.w; ss += (v.x * v.x + v.y * v.y) + (v.z * v.z + v.w * v.w); }
          ss += __shfl_xor(ss, 1); ss += __shfl_xor(ss, 2); ss += __shfl_xor(ss, 4);
          const float rn = rsqrtf(ss * (1.f / 256.f) + EPS);
          const size_t row = (size_t)(rowbase + t);
          const bf16* gsrc = s.P + row * NINP + (MODE ? 5120 : 2048) + head * 256 + 32 * part;
          bf16* dst = s.MIX + row * DM + (MODE ? 1024 : 0) + head * 256 + 32 * part;
#pragma unroll
          for (int j = 0; j < 4; ++j) { float gv[8], ov[8]; unpack8(*(const v4u*)(gsrc + 8 * j), gv);
#pragma unroll
              for (int e = 0; e < 8; ++e) { const float gt = MODE ? sigmoid_f(gv[e]) : silu_f(gv[e]); ov[e] = o[8 * j + e] * rn * s.ng[32 * part + 8 * j + e] * gt; }
              *(v4u*)(dst + 8 * j) = pack8(ov); } }
        __syncthreads();
    }
}

struct AttnP { const bf16* QR; const bf16* KR; const bf16* P; bf16* MIX; const float* lamp; const float* subg; const float* qg; const float* kg; float lam_init; };
__device__ __forceinline__ void ph_attn(const AttnP& p, LAS unsigned char* lds, int tid, int lane, int wave, int bid, int G) {
    const float l01 = wave_sum(p.lamp[lane] * p.lamp[64 + lane]), l23 = wave_sum(p.lamp[128 + lane] * p.lamp[192 + lane]);
    const float lam = __expf(l01) - __expf(l23) + p.lam_init;
    const float negm2 = -8.f * wave_max(fabsf(p.qg[lane])) * wave_max(fabsf(p.kg[lane])) * 1.4426950408889634f * 1.02f;
    const int r = lane & 31, h = lane >> 5, mp = wave >> 2, wq = wave & 3;
    LAS float* Ex = (LAS float*)lds;
    for (int u = bid; u < 544; u += G) {
        int b, hd, qrow0, nkt;
        if (u < 512) { b = u >> 8; hd = (u >> 5) & 7; qrow0 = b * 4096 + 128 * (u & 31); nkt = 68; }
        else { const int uu = u - 512; b = uu >> 4; hd = (uu >> 1) & 7; qrow0 = NLATR + b * 256 + 128 * (uu & 1); nkt = 4; }
        const int qrow = qrow0 + 32 * wq + r;
        bf16x8 Qf[4];
#pragma unroll
        for (int ks = 0; ks < 4; ++ks) Qf[ks] = *(const bf16x8*)(p.QR + (size_t)qrow * 1024 + (hd * 2 + mp) * 64 + 16 * ks + 8 * h);
        f32x16 O[4];
#pragma unroll
        for (int dt = 0; dt < 4; ++dt) O[dt] = zero16();
        float ls = 0.f;
        const int c0r = tid >> 4, c0c = tid & 15;
        v4u kr0, kr1, vr0, vr1;
        auto gload = [&](int kt) { const int krow = kt < 4 ? NLATR + b * 256 + 64 * kt : b * 4096 + 64 * (kt - 4);
            kr0 = *(const v4u*)(p.KR + (size_t)(krow + c0r) * 1024 + hd * 128 + c0c * 8); kr1 = *(const v4u*)(p.KR + (size_t)(krow + 32 + c0r) * 1024 + hd * 128 + c0c * 8);
            vr0 = *(const v4u*)(p.P + (size_t)(krow + c0r) * NINP + 2048 + hd * 128 + c0c * 8); vr1 = *(const v4u*)(p.P + (size_t)(krow + 32 + c0r) * NINP + 2048 + hd * 128 + c0c * 8); };
        auto lstore = [&](int buf) { LAS unsigned char* Kt = lds + buf * 17408; LAS unsigned char* Vt = lds + 34816 + buf * 17408;
            *(LAS v4u*)(Kt + c0r * 272 + c0c * 16) = kr0; *(LAS v4u*)(Kt + (32 + c0r) * 272 + c0c * 16) = kr1;
            *(LAS v4u*)(Vt + c0r * 272 + c0c * 16) = vr0; *(LAS v4u*)(Vt + (32 + c0r) * 272 + c0c * 16) = vr1; };
        gload(0); lstore(0);
        __syncthreads();
        for (int kt = 0; kt < nkt; ++kt) {
            const bool more = kt + 1 < nkt;
            if (more) gload(kt + 1);
            LAS const unsigned char* Kt = lds + (kt & 1) * 17408; LAS const unsigned char* Vt = lds + 34816 + (kt & 1) * 17408;
#pragma unroll
            for (int kb = 0; kb < 2; ++kb) {
                f32x16 S = zero16();
#pragma unroll
                for (int ks = 0; ks < 4; ++ks) { const bf16x8 a0 = frag_row(Kt, 272, 32 * kb, 64 * mp + 16 * ks, lane); S = MFMA32(a0, Qf[ks], S); }
                unsigned pf[8]; float lacc = 0.f;
#pragma unroll
                for (int i = 0; i < 8; ++i) { const float e0 = __builtin_amdgcn_exp2f(S[2 * i] + negm2), e1 = __builtin_amdgcn_exp2f(S[2 * i + 1] + negm2); lacc += e0 + e1; pf[i] = pk2(e0, e1); }
                ls += lacc;
                const bf16x8 P0 = __builtin_bit_cast(bf16x8, (v4u){pf[0], pf[1], pf[2], pf[3]}), P1 = __builtin_bit_cast(bf16x8, (v4u){pf[4], pf[5], pf[6], pf[7]});
#pragma unroll
                for (int dt = 0; dt < 4; ++dt) { const bf16x8 av0 = frag_tr_perm(Vt, 272, 32 * kb, 32 * dt, lane), av1 = frag_tr_perm(Vt, 272, 32 * kb + 16, 32 * dt, lane);
                    O[dt] = MFMA32(av0, P0, O[dt]); O[dt] = MFMA32(av1, P1, O[dt]); }
            }
            if (more) lstore((kt + 1) & 1);
            __syncthreads();
        }
        const float l = ls + __shfl_xor(ls, 32);
        if (mp == 1) { const float sc = lam / l;
#pragma unroll
            for (int dt = 0; dt < 4; ++dt)
#pragma unroll
                for (int i = 0; i < 16; ++i) Ex[(32 * wq + r) * 132 + 32 * dt + (i & 3) + 8 * (i >> 2) + 4 * h] = O[dt][i] * sc; }
        __syncthreads();
        if (mp == 0) { const float a0 = 1.f / l; float ss = 0.f;
#pragma unroll
            for (int dt = 0; dt < 4; ++dt)
#pragma unroll
                for (int i = 0; i < 16; ++i) { const float v = O[dt][i] * a0 - Ex[(32 * wq + r) * 132 + 32 * dt + (i & 3) + 8 * (i >> 2) + 4 * h]; O[dt][i] = v; ss += v * v; }
            ss += __shfl_xor(ss, 32);
            const float rn = rsqrtf(ss * (1.f / 128.f) + EPS) * (1.f - p.lam_init);
            bf16* dst = p.MIX + (size_t)qrow * DM + hd * 128;
#pragma unroll
            for (int dt = 0; dt < 4; ++dt)
#pragma unroll
                for (int g4 = 0; g4 < 4; ++g4) { const int dv0 = 32 * dt + 8 * g4 + 4 * h; const f32x4 sg = *(const f32x4*)(p.subg + dv0);
                    v2u o; o.x = pk2(O[dt][4 * g4] * rn * sg.x, O[dt][4 * g4 + 1] * rn * sg.y); o.y = pk2(O[dt][4 * g4 + 2] * rn * sg.z, O[dt][4 * g4 + 3] * rn * sg.w);
                    *(v2u*)(dst + dv0) = o; } }
        __syncthreads();
    }
}

#ifndef PHASE_MASK
#define PHASE_MASK 0xFFFFFFu
#endif
#define PM(j) ((PHASE_MASK >> (j)) & 1u)
#define PHASE_BEGIN int tid = tid0, lane = lane0; asm volatile("" : "+v"(tid), "+v"(lane)); int wave = wave0, bid = bid0, G = G0; asm volatile("" : "+s"(wave), "+s"(bid), "+s"(G)); \
    unsigned char* ws = ws0; asm volatile("" : "+s"(ws)); const int gw = bid * NWAVES + wave, NGW = G * NWAVES, gtid = bid * NTHR + tid, NT = G * NTHR; (void)gw; (void)NGW; (void)gtid; (void)NT; (void)lane;
__device__ __forceinline__ void fill_scanp(ScanP& sp, const Args& a, unsigned char* ws, int li, bool even) {
    sp.P = (const bf16*)(ws + WS_P); sp.MQK = (const bf16*)(ws + WS_MQK); sp.MIX = (bf16*)(ws + WS_MIX);
    sp.gw2 = a.in[10] + (size_t)li * 2 * 16 * 512; sp.gb = a.in[11] + (size_t)li * 2 * 512; sp.mgb = a.in[21] + (size_t)li * 16;
    sp.ng = even ? a.in[12] + (size_t)li * 256 : a.in[22] + (size_t)li * 256;
    sp.DSTp = (float*)(ws + WS_DST); sp.SSTp = (bf16*)(ws + WS_SST); sp.GAM = (float*)(ws + WS_SM + SM_GAM); sp.DN = (float*)(ws + WS_SM + SM_DN); sp.NIN = (float*)(ws + WS_SM + SM_NIN);
    sp.BL = (float*)(ws + WS_SM + SM_BL); sp.ML = (float*)(ws + WS_SM + SM_ML); sp.MINp = (float*)(ws + WS_SM + SM_MIN);
}
__global__ void __launch_bounds__(NTHR, 2) fwd_kernel(Args a) {
    extern __shared__ __attribute__((aligned(16))) unsigned char lds_raw[];
    LAS unsigned char* lds = (LAS unsigned char*)lds_raw;
    const int tid0 = threadIdx.x, lane0 = tid0 & 63, wave0 = __builtin_amdgcn_readfirstlane(tid0 >> 6), bid0 = blockIdx.x, G0 = gridDim.x;
    unsigned char* ws0 = a.ws;
    volatile LAS unsigned* MISC = (volatile LAS unsigned*)(lds + MISC_OFF);
    if (tid0 < 32) MISC[tid0] = 0u;
    __syncthreads();
    XcdBarrier bar = xcd_barrier_post((unsigned*)(ws0 + WS_CTL) + CW_BAR + a.li * XCD_BAR_WORDS, MISC + 8);
    const int lo = a.ph_lo, hi = a.ph_hi;
#define IN(k) (lo <= (k) && (k) < hi)
#define SEAM(k) do { if (IN(k) && IN((k) + 1)) xcd_barrier(bar); } while (0)

    if (PM(11) && IN(0)) { PHASE_BEGIN; ph_prologue(a, ws, lds, tid, lane, wave, bid, G); }
    SEAM(0);
    for (int layer = 0; layer < NLAYERS; ++layer) {
        const int pb = 1 + layer * PPL, li = layer >> 1; const bool even = (layer & 1) == 0;
        const size_t mod_off = WS_MOD + (size_t)layer * 3 * 12288 * 4;
        const size_t wb_off = WS_W + (size_t)layer * W_LAYER;

        if (PM(0) && IN(pb + 0)) { PHASE_BEGIN; const float* mod = (const float*)(ws + mod_off);
            ph_norm((const float*)(ws + WS_XS), a.in[6] + (size_t)layer * DM, mod + 0 * DM, mod + 1 * DM, (bf16*)(ws + WS_H), gw, NGW, lane); }
        SEAM(pb + 0);
        if (PM(1) && IN(pb + 1)) { PHASE_BEGIN; pg8::Gemm g{(const bf16*)(ws + WS_H), (const bf16*)(ws + wb_off), MR, NINP, DM}; pg8::StaticOrder S; S.init(MR, NINP, G, bid); pg8::EpiStore E{(bf16*)(ws + WS_P), NINP};
            pg8::gemm_phase<pg8::EpiStore, pg8::StaticOrder, true, true>(lds, g, S, E); }
        SEAM(pb + 1);
        if (PM(2) && IN(pb + 2)) {
            if (even) {
                if (PM(12)) { PHASE_BEGIN; ph_conv<1>((const bf16*)(ws + WS_P), a.in[13] + (size_t)li * 3 * 1024, nullptr, (bf16*)(ws + WS_MIX), gtid, NT); }
                if (PM(13)) { PHASE_BEGIN; ScanP sp; fill_scanp(sp, a, ws, li, even); ph_scan_local<0>(sp, lds, tid, lane, wave, bid, G); }
            } else {
                if (PM(14)) { PHASE_BEGIN; ph_qkprep((const bf16*)(ws + WS_P), a.in[16] + (size_t)li * 64, a.in[17] + (size_t)li * 64, (const float*)(ws + WS_ROPE), (bf16*)(ws + WS_QR), (bf16*)(ws + WS_KR), gw, NGW, lane); }
                if (PM(15)) { PHASE_BEGIN; ph_conv<2>((const bf16*)(ws + WS_P), a.in[20] + (size_t)li * 3 * 1024, nullptr, (bf16*)(ws + WS_MQK), gtid, NT); }
            }
        }
        SEAM(pb + 2);
        if (PM(3) && IN(pb + 3)) { if (!even) { PHASE_BEGIN; ScanP sp; fill_scanp(sp, a, ws, li, even); ph_scan_local<1>(sp, lds, tid, lane, wave, bid, G); } }
        SEAM(pb + 3);
        if (PM(4) && IN(pb + 4)) { PHASE_BEGIN; ScanP sp; fill_scanp(sp, a, ws, li, even); if (even) ph_scan_carry<0>(sp, gtid, NT); else ph_scan_carry<1>(sp, gtid, NT); }
        SEAM(pb + 4);
        if (PM(5) && IN(pb + 5)) {
            if (even) { if (PM(16)) { PHASE_BEGIN; ScanP sp; fill_scanp(sp, a, ws, li, even); ph_scan_out<0>(sp, lds, tid, lane, wave, bid, G); } }
            else {
                if (PM(17)) { PHASE_BEGIN; AttnP ap{(const bf16*)(ws + WS_QR), (const bf16*)(ws + WS_KR), (const bf16*)(ws + WS_P), (bf16*)(ws + WS_MIX), a.in[18] + (size_t)li * 256, a.in[19] + (size_t)li * 128, a.in[16] + (size_t)li * 64, a.in[17] + (size_t)li * 64, 0.8f - 0.6f * expf(-0.3f * (float)layer)};
                    ph_attn(ap, lds, tid, lane, wave, bid, G); }
                if (PM(18)) { PHASE_BEGIN; ScanP sp; fill_scanp(sp, a, ws, li, even); ph_scan_out<1>(sp, lds, tid, lane, wave, bid, G); }
            }
        }
        SEAM(pb + 5);
        if (PM(6) && IN(pb + 6)) { PHASE_BEGIN; pg8::Gemm g{(const bf16*)(ws + WS_MIX), (const bf16*)(ws + wb_off + W_OUT), MR, DM, DM}; pg8::StaticOrder S; S.init(MR, DM, G, bid);
            pg8::EpiResid E{(float*)(ws + WS_XS), (const float*)(ws + mod_off) + 2 * DM, nullptr, 0};
            pg8::gemm_phase<pg8::EpiResid, pg8::StaticOrder, true, true>(lds, g, S, E); }
        SEAM(pb + 6);
        if (PM(7) && IN(pb + 7)) { PHASE_BEGIN; const float* mod = (const float*)(ws + mod_off);
            ph_norm((const float*)(ws + WS_XS), a.in[7] + (size_t)layer * DM, mod + 3 * DM, mod + 4 * DM, (bf16*)(ws + WS_H), gw, NGW, lane); }
        SEAM(pb + 7);
        if (PM(8) && IN(pb + 8)) { PHASE_BEGIN; pg8::Gemm g{(const bf16*)(ws + WS_H), (const bf16*)(ws + wb_off + W_UP), MR, NUP, DM}; pg8::StaticOrder S; S.init(MR, NUP, G, bid); pg8::EpiStore E{(bf16*)(ws + WS_U), NUP};
            pg8::gemm_phase<pg8::EpiStore, pg8::StaticOrder, true, true>(lds, g, S, E); }
        SEAM(pb + 8);
        if (PM(9) && IN(pb + 9)) { PHASE_BEGIN; ph_conv<0>((const bf16*)(ws + WS_U), a.in[24] + (size_t)layer * 3 * DFF, a.in[25] + (size_t)layer * DFF, (bf16*)(ws + WS_ACT), gtid, NT); }
        SEAM(pb + 9);
        if (PM(10) && IN(pb + 10)) { PHASE_BEGIN; pg8::Gemm g{(const bf16*)(ws + WS_ACT), (const bf16*)(ws + wb_off + W_DN), MR, DM, DFF}; pg8::StaticOrder S; S.init(MR, DM, G, bid);
            pg8::EpiResid E{(float*)(ws + WS_XS), (const float*)(ws + mod_off) + 5 * DM, a.out, layer == NLAYERS - 1 ? 1 : 0};
            pg8::gemm_phase<pg8::EpiResid, pg8::StaticOrder, true, true>(lds, g, S, E); }
        if (layer < NLAYERS - 1) SEAM(pb + 10);
    }
#undef IN
#undef SEAM
}

extern "C" void kernel_launch(void* const* d_in, const int* in_sizes, int n_in, void* d_out, int out_size, void* d_ws, size_t ws_size, hipStream_t stream) {
    static int grid = 0;
    if (grid == 0) {
        int dev = 0, cus = 0;
        if (n_in != 27 || out_size != NLATR * DM || ws_size < WS_END) { fprintf(stderr, "kernel_launch: unexpected problem (n_in %d out %d ws %zu)\n", n_in, out_size, ws_size); grid = -1; return; }
        if (hipGetDevice(&dev) != hipSuccess || hipDeviceGetAttribute(&cus, hipDeviceAttributeMultiprocessorCount, dev) != hipSuccess) { grid = -1; return; }
        if (hipFuncSetAttribute((const void*)fwd_kernel, hipFuncAttributeMaxDynamicSharedMemorySize, LDS_BYTES) != hipSuccess) { fprintf(stderr, "kernel_launch: hipFuncSetAttribute failed\n"); grid = -1; return; }
        int per_cu = 0;
        if (hipOccupancyMaxActiveBlocksPerMultiprocessor(&per_cu, (const void*)fwd_kernel, NTHR, LDS_BYTES) != hipSuccess || per_cu < 1) fprintf(stderr, "kernel_launch: occupancy query reports %d\n", per_cu);
        (void)hipGetLastError();
        grid = cus;
    }
    if (grid < 0) return;
    (void)hipMemsetAsync((char*)d_ws + WS_CTL, 0, CTL_BYTES, stream);
    Args a{};
    for (int i = 0; i < 27; ++i) a.in[i] = (const float*)d_in[i];
    a.out = (float*)d_out; a.ws = (unsigned char*)d_ws; a.pad = 0;
#if ONE_LAUNCH
    a.ph_lo = 0; a.ph_hi = 1 + NLAYERS * PPL; a.li = 0;
    hipLaunchKernelGGL(fwd_kernel, dim3(grid), dim3(NTHR), LDS_BYTES, stream, a);
#else
    for (int p = 0; p < 1 + NLAYERS * PPL; ++p) {
        const int k = p == 0 ? 0 : (p - 1) % PPL, layer = p == 0 ? 0 : (p - 1) / PPL;
        if (p > 0 && k == 3 && (layer & 1) == 0) continue;
        a.ph_lo = p; a.ph_hi = p + 1; a.li = p;
        hipLaunchKernelGGL(fwd_kernel, dim3(grid), dim3(NTHR), LDS_BYTES, stream, a);
    }
#endif
}
```

```cpp
#include <hip/hip_runtime.h>
#include <cstdio>
#include <cstdint>
namespace pg8 {
#define PG8_LAS __attribute__((address_space(3)))
typedef unsigned short bf16_t;
typedef short bf16x8 __attribute__((ext_vector_type(8)));
typedef float f32x4 __attribute__((ext_vector_type(4)));
typedef unsigned u32x4 __attribute__((ext_vector_type(4)));
constexpr int BM = 256, BK = 64, HALF = 128, HTB = HALF * BK * 2  , STAGE_BYTES = 8 * HTB, NXCD = 8, WGM = 8;

__host__ __device__ __forceinline__ int lds_byte(int r, int c) { const int st = (r >> 4) * 2 + (c >> 5), rr = r & 15, cc = c & 31, ob = rr * 64 + cc * 2; return st * 1024 + (ob ^ (((ob >> 9) & 1) << 5)); }
__host__ __device__ __forceinline__ void stage_rc(int b, int& R, int& C) { const int st = b / 1024, sb = b % 1024, swz = sb ^ (((sb >> 9) & 1) << 5); R = (st >> 1) * 16 + swz / 64; C = (st & 1) * 32 + (swz % 64) / 2; }
__host__ __device__ __forceinline__ int perm32(int rho) { const int n = rho >> 4, i = rho & 15; return 8 * (i >> 2) + 4 * n + (i & 3); }

struct Unit { int pm, pn; };
struct Gemm { const bf16_t* A; const bf16_t* Bt; int M, N, K; };

struct StaticOrder {
    int nM, nN, nwg, G, c;
    __host__ __device__ void init(int M, int N, int G_, int c_) { nM = M / BM; nN = N / BM; nwg = nM * nN; G = G_; c = c_; }
    __host__ __device__ bool next(int i, Unit& u) const {
        const long L = (long)i * G + c; if (L >= nwg) return false;
        int wgid = (int)L; { const int q = nwg / NXCD, r = nwg % NXCD, xcd = wgid % NXCD, off = wgid / NXCD; wgid = (xcd < r ? xcd * (q + 1) : r * (q + 1) + (xcd - r) * q) + off; }
        const int nig = WGM * nN, gid = wgid / nig, fm = gid * WGM, gsz = (nM - fm) < WGM ? (nM - fm) : WGM;
        u.pm = fm + ((wgid % nig) % gsz); u.pn = (wgid % nig) / gsz; return true;
    }
    __device__ __forceinline__ void a_ready(const Unit&) const {}
    __device__ __forceinline__ void done(const Unit&) const {}
};
__device__ __forceinline__ unsigned cvt_pk_bf16(float lo, float hi) { unsigned r; asm volatile("v_cvt_pk_bf16_f32 %0, %1, %2" : "=v"(r) : "v"(lo), "v"(hi)); return r; }

struct EpiStore {
    static constexpr bool PERM = true, AFTER_DRAIN = false;
    bf16_t* O; int ldc;
    __device__ __forceinline__ void operator()(const f32x4 (&acc)[2][2][4][2], const Unit& u, int wr, int wc, int fr, int fq) const {
        const int row0 = u.pm * BM + wr * 64 + fr, col0 = u.pn * BM + wc * 32 + 8 * fq;
#pragma unroll
        for (int ai = 0; ai < 2; ++ai)
#pragma unroll
            for (int m = 0; m < 4; ++m) { bf16_t* rowp = O + (size_t)(row0 + ai * HALF + m * 16) * ldc + col0;
#pragma unroll
                for (int bj = 0; bj < 2; ++bj) { const f32x4 v0 = acc[ai][bj][m][0], v1 = acc[ai][bj][m][1];
                    u32x4 w; w.x = cvt_pk_bf16(v0[0], v0[1]); w.y = cvt_pk_bf16(v0[2], v0[3]); w.z = cvt_pk_bf16(v1[0], v1[1]); w.w = cvt_pk_bf16(v1[2], v1[3]);
                    *(u32x4*)(rowp + bj * HALF) = w; } }
    }
};
struct EpiResid {
    static constexpr bool PERM = false, AFTER_DRAIN = false;
    float* X; const float* gate; float* out; int final_; int dry;
    __device__ __forceinline__ void operator()(const f32x4 (&acc)[2][2][4][2], const Unit& u, int wr, int wc, int fr, int fq) const {
        if (final_ && u.pm >= 32) return;
        const int mi = u.pm < 32 ? (u.pm >> 4) : 2;
        const float* g = gate + (size_t)mi * 12288;
        const int row0 = u.pm * BM + wr * 64 + fr, col0 = u.pn * BM + wc * 32 + 4 * fq;
        f32x4 gv[2][2];
#pragma unroll
        for (int bj = 0; bj < 2; ++bj)
#pragma unroll
            for (int n = 0; n < 2; ++n) gv[bj][n] = *(const f32x4*)(g + col0 + bj * HALF + n * 16);
        if (dry && gv[0][0][0] != 1.2345e30f) return;
#pragma unroll
        for (int ai = 0; ai < 2; ++ai)
#pragma unroll
            for (int m = 0; m < 4; ++m) { const size_t ro = (size_t)(row0 + ai * HALF + m * 16) * 2048 + col0; const float* xr = X + ro; float* orow = (final_ ? out : X) + ro;
#pragma unroll
                for (int bj = 0; bj < 2; ++bj)
#pragma unroll
                    for (int n = 0; n < 2; ++n) { const f32x4 xv = *(const f32x4*)(xr + bj * HALF + n * 16); *(f32x4*)(orow + bj * HALF + n * 16) = xv + gv[bj][n] * acc[ai][bj][m][n]; } }
    }
};
template <class Epi, class Sched, bool ALIGN_EPI = false, bool SP2 = false>
__device__ __forceinline__ void gemm_phase(PG8_LAS unsigned char* lds, const Gemm g, const Sched& S, const Epi& E) {
    int tid = threadIdx.x; asm volatile("" : "+v"(tid));
    const int wid = __builtin_amdgcn_readfirstlane(tid >> 6), lane = tid & 63, wr = wid >> 2, wc = wid & 3, fr = lane & 15, fq = lane >> 4;
    const int K = g.K, nt = K / BK;
    unsigned voffA[2], voffB[2];
#pragma unroll
    for (int i = 0; i < 2; ++i) { int R, C; stage_rc(tid * 16 + i * 8192, R, C); const int Rb = Epi::PERM ? ((R & ~31) + perm32(R & 31)) : R;
        voffA[i] = (unsigned)(R * K + C) * 2u; voffB[i] = (unsigned)(Rb * K + C) * 2u; }
    const size_t kstep = (size_t)(BK * 2);
    const size_t hstep = (size_t)HALF * K * 2;
    const size_t tstep = 2 * hstep;
    const unsigned ldsw = (unsigned)wid * 1024u;
    const int aoff = lds_byte(wr * 64 + fr, fq * 8), boff = lds_byte(wc * 32 + fr, fq * 8);
#define PG8_SA(b, h) (((b) * 2 + (h)) * HTB)
#define PG8_SB(b, h) ((4 + (b) * 2 + (h)) * HTB)
#define PG8_STAGE(bufoff, gbase, voff) do { _Pragma("unroll") for (int _i = 0; _i < 2; ++_i) \
        __builtin_amdgcn_global_load_lds((const unsigned*)((const char*)(gbase) + (voff)[_i]), (PG8_LAS unsigned*)(lds + (bufoff) + ldsw + _i * 8192), 16, 0, 0); } while (0)
#define PG8_LDA(dst, b, h) do { _Pragma("unroll") for (int m = 0; m < 4; ++m) _Pragma("unroll") for (int k = 0; k < 2; ++k) dst[m][k] = *(const PG8_LAS bf16x8*)(lds + PG8_SA(b, h) + aoff + m * 2048 + k * 1024); } while (0)
#define PG8_LDB(dst, b, h) do { _Pragma("unroll") for (int n = 0; n < 2; ++n) _Pragma("unroll") for (int k = 0; k < 2; ++k) dst[n][k] = *(const PG8_LAS bf16x8*)(lds + PG8_SB(b, h) + boff + n * 2048 + k * 1024); } while (0)
#define PG8_MMA(ai, bj, At, Bt) do { __builtin_amdgcn_s_setprio(1); _Pragma("unroll") for (int m = 0; m < 4; ++m) _Pragma("unroll") for (int n = 0; n < 2; ++n) _Pragma("unroll") for (int k = 0; k < 2; ++k) \
        acc[ai][bj][m][n] = __builtin_amdgcn_mfma_f32_16x16x32_bf16(Bt[n][k], At[m][k], acc[ai][bj][m][n], 0, 0, 0); __builtin_amdgcn_s_setprio(0); } while (0)
#define PG8_WAIT_V(n) asm volatile("s_waitcnt vmcnt(" #n ")" ::: "memory")
#define PG8_WAIT_L(n) asm volatile("s_waitcnt lgkmcnt(" #n ")" ::: "memory")
#define PG8_BAR __builtin_amdgcn_s_barrier()
#define PG8_SCHED __builtin_amdgcn_sched_barrier(0)
    Unit cur, nxt; int ui = 0;
    if (!S.next(0, cur)) return;
    f32x4 acc[2][2][4][2];
#pragma unroll
    for (int a = 0; a < 2; ++a)
#pragma unroll
        for (int b = 0; b < 2; ++b)
#pragma unroll
            for (int m = 0; m < 4; ++m)
#pragma unroll
                for (int n = 0; n < 2; ++n) acc[a][b][m][n] = (f32x4){0.f, 0.f, 0.f, 0.f};
    bf16x8 At[4][2], B0[2][2], B1[2][2];
    const char* cA = (const char*)g.A + (size_t)cur.pm * tstep; const char* cB = (const char*)g.Bt + (size_t)cur.pn * tstep;
    S.a_ready(cur);
    if constexpr (SP2) {
        PG8_STAGE(PG8_SB(0, 0), cB, voffB); PG8_STAGE(PG8_SB(0, 1), cB + hstep, voffB); PG8_STAGE(PG8_SA(0, 0), cA, voffA); PG8_STAGE(PG8_SA(0, 1), cA + hstep, voffA);
        if (wr == 1) PG8_BAR;
        PG8_WAIT_V(2); PG8_BAR;
        PG8_STAGE(PG8_SB(1, 0), cB + kstep, voffB); PG8_STAGE(PG8_SA(1, 0), cA + kstep, voffA); PG8_STAGE(PG8_SB(1, 1), cB + hstep + kstep, voffB);
        PG8_WAIT_V(6); PG8_BAR;
    } else {
        PG8_STAGE(PG8_SB(0, 0), cB, voffB); PG8_STAGE(PG8_SA(0, 0), cA, voffA); PG8_STAGE(PG8_SB(0, 1), cB + hstep, voffB); PG8_STAGE(PG8_SA(0, 1), cA + hstep, voffA);
        if (wr == 1) PG8_BAR;
        PG8_WAIT_V(4); PG8_BAR;
        PG8_STAGE(PG8_SB(1, 0), cB + kstep, voffB); PG8_STAGE(PG8_SA(1, 0), cA + kstep, voffA); PG8_STAGE(PG8_SB(1, 1), cB + hstep + kstep, voffB);
        PG8_WAIT_V(6); PG8_BAR;
    }
    for (;;) {
        const bool has_next = S.next(ui + 1, nxt);
        const char* nA = has_next ? (const char*)g.A + (size_t)nxt.pm * tstep : cA; const char* nB = has_next ? (const char*)g.Bt + (size_t)nxt.pn * tstep : cB;
        for (int t = 0; t < nt; t += 2) {
            const bool last = (t == nt - 2);
            const char* a1 = cA + (size_t)(t + 1) * kstep;
            const char* a2 = last ? nA : cA + (size_t)(t + 2) * kstep; const char* b2 = last ? nB : cB + (size_t)(t + 2) * kstep;
            const char* a3 = a2 + kstep; const char* b3 = b2 + kstep;
            if (last && has_next) S.a_ready(nxt);
            if constexpr (SP2) {
            PG8_LDB(B0, 0, 0); PG8_LDB(B1, 0, 1); PG8_SCHED; PG8_LDA(At, 0, 0); PG8_STAGE(PG8_SA(1, 1), a1 + hstep, voffA);
            PG8_WAIT_V(8); PG8_WAIT_L(0); PG8_BAR; PG8_MMA(0, 0, At, B0); PG8_MMA(0, 1, At, B1); PG8_BAR; PG8_SCHED;
            PG8_LDA(At, 0, 1); PG8_STAGE(PG8_SB(0, 0), b2, voffB); PG8_STAGE(PG8_SB(0, 1), b2 + hstep, voffB); PG8_STAGE(PG8_SA(0, 0), a2, voffA);
            PG8_WAIT_V(8); PG8_WAIT_L(0); PG8_BAR; PG8_MMA(1, 0, At, B0); PG8_MMA(1, 1, At, B1); PG8_BAR; PG8_SCHED;
            PG8_LDB(B0, 1, 0); PG8_LDB(B1, 1, 1); PG8_SCHED; PG8_LDA(At, 1, 0); PG8_STAGE(PG8_SA(0, 1), a2 + hstep, voffA);
            PG8_WAIT_V(8); PG8_WAIT_L(0); PG8_BAR; PG8_MMA(0, 0, At, B0); PG8_MMA(0, 1, At, B1); PG8_BAR; PG8_SCHED;
            PG8_LDA(At, 1, 1); PG8_STAGE(PG8_SB(1, 0), b3, voffB); PG8_STAGE(PG8_SB(1, 1), b3 + hstep, voffB); PG8_STAGE(PG8_SA(1, 0), a3, voffA);
            PG8_WAIT_V(8); PG8_WAIT_L(0); PG8_BAR; PG8_MMA(1, 0, At, B0); PG8_MMA(1, 1, At, B1); PG8_BAR; PG8_SCHED;
            } else {
            PG8_LDB(B0, 0, 0); PG8_SCHED; PG8_LDA(At, 0, 0); PG8_STAGE(PG8_SA(1, 1), a1 + hstep, voffA);
            PG8_WAIT_L(8); PG8_BAR; PG8_WAIT_L(0); PG8_MMA(0, 0, At, B0); PG8_BAR; PG8_SCHED;
            PG8_LDB(B1, 0, 1); PG8_STAGE(PG8_SB(0, 0), b2, voffB);
            PG8_BAR; PG8_WAIT_L(0); PG8_MMA(0, 1, At, B1); PG8_BAR;
            PG8_LDA(At, 0, 1); PG8_STAGE(PG8_SA(0, 0), a2, voffA);
            PG8_BAR; PG8_WAIT_L(0); PG8_MMA(1, 0, At, B0); PG8_BAR; PG8_SCHED;
            PG8_STAGE(PG8_SB(0, 1), b2 + hstep, voffB);
            PG8_WAIT_V(6); PG8_BAR; PG8_MMA(1, 1, At, B1); PG8_BAR;
            PG8_LDB(B0, 1, 0); PG8_SCHED; PG8_LDA(At, 1, 0); PG8_STAGE(PG8_SA(0, 1), a2 + hstep, voffA);
            PG8_WAIT_L(8); PG8_BAR; PG8_WAIT_L(0); PG8_MMA(0, 0, At, B0); PG8_BAR; PG8_SCHED;
            PG8_LDB(B1, 1, 1); PG8_STAGE(PG8_SB(1, 0), b3, voffB);
            PG8_BAR; PG8_WAIT_L(0); PG8_MMA(0, 1, At, B1); PG8_BAR;
            PG8_LDA(At, 1, 1); PG8_STAGE(PG8_SA(1, 0), a3, voffA);
            PG8_BAR; PG8_WAIT_L(0); PG8_MMA(1, 0, At, B0); PG8_BAR; PG8_SCHED;
            PG8_STAGE(PG8_SB(1, 1), b3 + hstep, voffB);
            PG8_WAIT_V(6); PG8_BAR; PG8_MMA(1, 1, At, B1); PG8_BAR;
            }
        }
        if constexpr (ALIGN_EPI) { if (wr == 0) PG8_BAR; }
        if constexpr (!Epi::AFTER_DRAIN) { E(acc, cur, wr, wc, fr, fq); S.done(cur); }
        if (!has_next) break;
#pragma unroll
        for (int a = 0; a < 2; ++a)
#pragma unroll
            for (int b = 0; b < 2; ++b)
#pragma unroll
                for (int m = 0; m < 4; ++m)
#pragma unroll
                    for (int n = 0; n < 2; ++n) acc[a][b][m][n] = (f32x4){0.f, 0.f, 0.f, 0.f};
        cur = nxt; cA = nA; cB = nB; ++ui;
        if constexpr (ALIGN_EPI) { if (wr == 1) PG8_BAR; }
    }
    PG8_WAIT_V(0);
    if constexpr (!ALIGN_EPI) { if (wr == 0) PG8_BAR; }
    PG8_BAR;
    if constexpr (Epi::AFTER_DRAIN) { E.fused(acc, cur, wr, wc, fr, fq, lds, wid, lane); S.done(cur); }
#undef PG8_SA
#undef PG8_SB
#undef PG8_STAGE
#undef PG8_LDA
#undef PG8_LDB
#undef PG8_MMA
#undef PG8_WAIT_V
#undef PG8_WAIT_L
#undef PG8_BAR
#undef PG8_SCHED
}
}
#define GAS __attribute__((address_space(1)))
#define LAS __attribute__((address_space(3)))
typedef unsigned short bf16;
typedef unsigned v4u __attribute__((ext_vector_type(4)));
typedef unsigned v2u __attribute__((ext_vector_type(2)));
typedef float f32x4 __attribute__((ext_vector_type(4)));
typedef float f32x16 __attribute__((ext_vector_type(16)));
typedef short bf16x8 __attribute__((ext_vector_type(8)));
typedef short s16x4 __attribute__((ext_vector_type(4)));
typedef GAS unsigned gu32;
#define RLX_AGENT __ATOMIC_RELAXED, __HIP_MEMORY_SCOPE_AGENT
#define XB_TMO      128
#define XB_XCNT(j)  (256  + 64 * (j))
#define XB_XSUB(j)  (1280 + 64 * (j))
#define XB_XGEN(j)  (2304 + 64 * (j))
#define XB_TOP      3328
#define XB_TOPGEN   3392
#define XCD_BAR_WORDS 3456
#define XB_SPIN_CAP (1u << 18)

__device__ __forceinline__ unsigned xb_ld(unsigned* p)              { return __hip_atomic_load(p, __ATOMIC_RELAXED, __HIP_MEMORY_SCOPE_AGENT); }
__device__ __forceinline__ unsigned xb_add(unsigned* p, unsigned v) { return __hip_atomic_fetch_add(p, v, __ATOMIC_RELAXED, __HIP_MEMORY_SCOPE_AGENT); }
__device__ __forceinline__ unsigned xb_xcc_id() { return (unsigned)__builtin_amdgcn_s_getreg((3 << 11) | 20) & 0xFu; }
#define XB_SPIN(cond, bar) do { unsigned _sp = 0; while (cond) { __builtin_amdgcn_s_sleep(1); \
    if ((++_sp & 255u) == 0u) { if (xb_ld(&(bar)[XB_TMO])) break; if (_sp > XB_SPIN_CAP) { atomicAdd(&(bar)[XB_TMO], 1u); break; } } } } while (0)

struct XcdBarrier {
    unsigned* bar; unsigned x;
    volatile LAS unsigned* st;
};

__device__ __forceinline__ XcdBarrier xcd_barrier_post(unsigned* bar, volatile LAS unsigned* st) {
    XcdBarrier b; b.bar = bar; b.x = xb_xcc_id(); b.st = st;
    if (threadIdx.x == 0) (void)xb_add(&bar[XB_XCNT(b.x)], 1u);
    return b;
}
__device__ __forceinline__ void xcd_barrier_complete(unsigned* bar, unsigned x, unsigned& nloc, unsigned& nx) {
    const unsigned G = gridDim.x * gridDim.y * gridDim.z;
    unsigned sum, cnt, mine, sp = 0u;
    for (;;) {
        sum = 0u; cnt = 0u; mine = 0u;
#pragma unroll
        for (unsigned j = 0; j < 16; ++j) { const unsigned c = xb_ld(&bar[XB_XCNT(j)]); sum += c; cnt += (c > 0u) ? 1u : 0u; mine = (j == x) ? c : mine; }
        if (sum == G) break;
        __builtin_amdgcn_s_sleep(1);
        if ((++sp & 255u) == 0u) { if (xb_ld(&bar[XB_TMO])) break; if (sp > XB_SPIN_CAP) { atomicAdd(&bar[XB_TMO], 1u); break; } }
    }
    nloc = mine > 0u ? mine : 1u; nx = cnt > 0u ? cnt : 1u;
}

__device__ __forceinline__ void xcd_barrier(const XcdBarrier& b) {
    asm volatile("s_waitcnt vmcnt(0)" ::: "memory");
    __syncthreads();
    if (threadIdx.x == 0) {
        unsigned* bar = b.bar;
        __builtin_amdgcn_s_waitcnt(0);
        unsigned nloc = b.st[0], nx = b.st[1];
        if (nloc == 0u) { xcd_barrier_complete(bar, b.x, nloc, nx); b.st[0] = nloc; b.st[1] = nx; }
        const unsigned old = xb_add(&bar[XB_XSUB(b.x)], 1u);
        const unsigned gen = old / nloc;
        if (old + 1u == (gen + 1u) * nloc) {
            __builtin_amdgcn_fence(__ATOMIC_RELEASE, "agent");
            asm volatile("s_waitcnt vmcnt(0)" ::: "memory");
            const unsigned og = xb_add(&bar[XB_TOP], 1u);
            const unsigned tg = og / nx;
            if (og + 1u == (tg + 1u) * nx) xb_add(&bar[XB_TOPGEN], 1u);
            else XB_SPIN(xb_ld(&bar[XB_TOPGEN]) == tg, bar);
            __builtin_amdgcn_fence(__ATOMIC_ACQUIRE, "agent");
            xb_add(&bar[XB_XGEN(b.x)], 1u);
            asm volatile("s_waitcnt vmcnt(0)" ::: "memory");
        } else {
            XB_SPIN(xb_ld(&bar[XB_XGEN(b.x)]) == gen, bar);
            __builtin_amdgcn_fence(__ATOMIC_ACQUIRE, "agent");
            asm volatile("s_waitcnt vmcnt(0)" ::: "memory");
        }
    }
    __syncthreads();
}
#ifndef ONE_LAUNCH
#define ONE_LAUNCH 1
#endif
#ifndef NLAYERS
#define NLAYERS 4
#endif
constexpr int DM = 2048, MR = 8704, NLATR = 8192;
constexpr int NINP = 6400, DFF = 5632, NUP = 11264, EVIN = 6176, ODIN = 6160;
constexpr int NWAVES = 8, NTHR = 512;
constexpr float EPS = 1e-6f;
constexpr int NCHUNK = 68;
constexpr int PPL = 11, NPH = 1 + 4 * PPL;
constexpr size_t MiB = 1ull << 20;
constexpr size_t WS_CTL = 0, CTL_BYTES = 1 * MiB;
constexpr size_t WS_MOD = 1 * MiB, WS_ROPE = 1 * MiB + 640 * 1024;
constexpr size_t WS_W = 4 * MiB, W_LAYER = 99 * MiB, W_OUT = 25 * MiB, W_UP = 33 * MiB, W_DN = 77 * MiB;
constexpr size_t WS_XS = 400 * MiB, WS_H = 468 * MiB, WS_MIX = 502 * MiB, WS_P = 536 * MiB, WS_U = 644 * MiB, WS_ACT = 832 * MiB;
constexpr size_t WS_QR = 926 * MiB, WS_KR = 943 * MiB, WS_MQK = 960 * MiB, WS_DST = 977 * MiB, WS_SST = 1113 * MiB, WS_SM = 1181 * MiB, WS_END = 1186 * MiB;
constexpr size_t SM_GAM = 0, SM_DN = 1 * MiB, SM_NIN = 2 * MiB, SM_BL = 3 * MiB, SM_ML = 3 * MiB + 8192, SM_MIN = 3 * MiB + 16384;
constexpr int CW_BAR = 4096;
constexpr int LDS_BYTES = 147456, MISC_OFF = 131072 + 320;

struct Args { const float* in[27]; float* out; unsigned char* ws; int ph_lo, ph_hi, li, pad; };

__device__ __forceinline__ float bf_lo(unsigned u) { return __builtin_bit_cast(float, u << 16); }
__device__ __forceinline__ float bf_hi(unsigned u) { return __builtin_bit_cast(float, u & 0xffff0000u); }
__device__ __forceinline__ float bf1(bf16 b) { return __builtin_bit_cast(float, (unsigned)b << 16); }
typedef float f32x2_t __attribute__((ext_vector_type(2))); typedef __bf16 bf16x2_t __attribute__((ext_vector_type(2)));
__device__ __forceinline__ unsigned pk2(float lo, float hi) { f32x2_t v = {lo, hi}; bf16x2_t b = __builtin_convertvector(v, bf16x2_t); return __builtin_bit_cast(unsigned, b); }
__device__ __forceinline__ bf16 f2bf(float f) { return (bf16)(pk2(f, 0.f) & 0xffffu); }
__device__ __forceinline__ void unpack8(const v4u w, float (&f)[8]) { f[0] = bf_lo(w.x); f[1] = bf_hi(w.x); f[2] = bf_lo(w.y); f[3] = bf_hi(w.y); f[4] = bf_lo(w.z); f[5] = bf_hi(w.z); f[6] = bf_lo(w.w); f[7] = bf_hi(w.w); }
__device__ __forceinline__ v4u pack8(const float (&f)[8]) { v4u w; w.x = pk2(f[0], f[1]); w.y = pk2(f[2], f[3]); w.z = pk2(f[4], f[5]); w.w = pk2(f[6], f[7]); return w; }
__device__ __forceinline__ float silu_f(float x) { return x / (1.f + __expf(-x)); }
__device__ __forceinline__ float sigmoid_f(float x) { return 1.f / (1.f + __expf(-x)); }
__device__ __forceinline__ float logsig_f(float z) { return fminf(z, 0.f) - log1pf(__expf(-fabsf(z))); }
__device__ __forceinline__ float wave_sum(float v) {
#pragma unroll
    for (int o = 1; o < 64; o <<= 1) v += __shfl_xor(v, o);
    return v;
}
__device__ __forceinline__ float wave_max(float v) {
#pragma unroll
    for (int o = 1; o < 64; o <<= 1) v = fmaxf(v, __shfl_xor(v, o));
    return v;
}
__device__ __forceinline__ float wave_scan_sum(float v, int dir, int lane) {
#pragma unroll
    for (int o = 1; o < 64; o <<= 1) { const float up = __shfl_up(v, o), dn = __shfl_down(v, o); if (dir == 0) { if (lane >= o) v += up; } else { if (lane + o < 64) v += dn; } }
    return v;
}
__device__ __forceinline__ float wave_scan_max(float v, int dir, int lane) {
#pragma unroll
    for (int o = 1; o < 64; o <<= 1) { const float up = __shfl_up(v, o), dn = __shfl_down(v, o); if (dir == 0) { if (lane >= o) v = fmaxf(v, up); } else { if (lane + o < 64) v = fmaxf(v, dn); } }
    return v;
}
__device__ __forceinline__ bool seq_start(int r) { return r < NLATR ? (r & 4095) == 0 : ((r - NLATR) & 255) == 0; }

__device__ __forceinline__ bf16x8 frag_row(LAS const unsigned char* base, int stride, int row0, int k0, int lane) {
    return *(LAS const bf16x8*)(base + (row0 + (lane & 31)) * stride + (k0 + 8 * (lane >> 5)) * 2);
}
__device__ __forceinline__ s16x4 tr4(LAS const unsigned char* p) { return __builtin_amdgcn_ds_read_tr16_b64_v4i16((LAS s16x4*)p); }
__device__ __forceinline__ bf16x8 frag_tr(LAS const unsigned char* base, int stride, int k0, int col0, int lane) {
    const int h = lane >> 5, blk = (lane >> 4) & 1, q = (lane & 15) >> 2, p = lane & 3;
    LAS const unsigned char* a = base + (k0 + 8 * h + q) * stride + (col0 + 16 * blk + 4 * p) * 2;
    const s16x4 lo = tr4(a), hi = tr4(a + 4 * stride);
    return (bf16x8){lo[0], lo[1], lo[2], lo[3], hi[0], hi[1], hi[2], hi[3]};
}
__device__ __forceinline__ bf16x8 frag_tr_perm(LAS const unsigned char* base, int stride, int k0, int col0, int lane) {
    const int h = lane >> 5, blk = (lane >> 4) & 1, q = (lane & 15) >> 2, p = lane & 3;
    LAS const unsigned char* a = base + (k0 + 4 * h + q) * stride + (col0 + 16 * blk + 4 * p) * 2;
    const s16x4 lo = tr4(a), hi = tr4(a + 8 * stride);
    return (bf16x8){lo[0], lo[1], lo[2], lo[3], hi[0], hi[1], hi[2], hi[3]};
}
#define MFMA32(a, b, c) __builtin_amdgcn_mfma_f32_32x32x16_bf16((a), (b), (c), 0, 0, 0)
__device__ __forceinline__ f32x16 zero16() { f32x16 z;
#pragma unroll
    for (int i = 0; i < 16; ++i) z[i] = 0.f;
    return z; }
__device__ __forceinline__ void load_tile(LAS unsigned char* dst, int ls, const bf16* src, size_t ld, int rows, int cols, int tid) {
    const int cpr = cols >> 3, n = rows * cpr;
    for (int c = tid; c < n; c += NTHR) { const int r = c / cpr, cc = c - r * cpr; *(LAS v4u*)(dst + r * ls + cc * 16) = *(const v4u*)(src + (size_t)r * ld + cc * 8); }
}

struct TrItem { const float* W; bf16* WT; int K, N, k0, n0; };
__device__ __forceinline__ void tr_issue(const TrItem& t, f32x4 (&v)[8], int lane) {
    const int n = t.n0 + 4 * (lane & 7);
#pragma unroll
    for (int i = 0; i < 8; ++i) { const int kk = 8 * i + (lane >> 3); v[i] = n < t.N ? *(const f32x4*)(t.W + (size_t)(t.k0 + kk) * t.N + n) : (f32x4){0.f, 0.f, 0.f, 0.f}; }
}
__device__ __forceinline__ void tr_finish(const TrItem& t, const f32x4 (&v)[8], LAS float* scr, int lane) {
#pragma unroll
    for (int i = 0; i < 8; ++i) { const int kk = 8 * i + (lane >> 3); LAS float* d = scr + kk * 33 + 4 * (lane & 7); d[0] = v[i].x; d[1] = v[i].y; d[2] = v[i].z; d[3] = v[i].w; }
    asm volatile("s_waitcnt lgkmcnt(0)" ::: "memory");
    const int c = lane & 7;
#pragma unroll
    for (int j = 0; j < 4; ++j) { const int nn = (lane >> 3) + 8 * j; const LAS float* s = scr + (8 * c) * 33 + nn;
        v4u o; o.x = pk2(s[0 * 33], s[1 * 33]); o.y = pk2(s[2 * 33], s[3 * 33]); o.z = pk2(s[4 * 33], s[5 * 33]); o.w = pk2(s[6 * 33], s[7 * 33]);
        *(v4u*)(t.WT + (size_t)(t.n0 + nn) * t.K + t.k0 + 8 * c) = o; }
    asm volatile("s_waitcnt lgkmcnt(0)" ::: "memory");
}
__device__ __forceinline__ void tr_decode(const Args& a, unsigned char* ws, int g, TrItem& t) {
    const int layer = g / 25344; int r = g - layer * 25344; const int li = layer >> 1;
    unsigned char* wb = ws + WS_W + (size_t)layer * W_LAYER;
    int nblk;
    if (r < 6400) { if (layer & 1) { t.W = a.in[14] + (size_t)li * DM * ODIN; t.N = ODIN; } else { t.W = a.in[8] + (size_t)li * DM * EVIN; t.N = EVIN; } t.WT = (bf16*)wb; t.K = DM; nblk = NINP / 32; }
    else if ((r -= 6400) < 2048) { t.W = (layer & 1 ? a.in[15] : a.in[9]) + (size_t)li * DM * DM; t.N = DM; t.WT = (bf16*)(wb + W_OUT); t.K = DM; nblk = DM / 32; }
    else if ((r -= 2048) < 11264) { t.W = a.in[23] + (size_t)layer * DM * NUP; t.N = NUP; t.WT = (bf16*)(wb + W_UP); t.K = DM; nblk = NUP / 32; }
    else { r -= 11264; t.W = a.in[26] + (size_t)layer * DFF * DM; t.N = DM; t.WT = (bf16*)(wb + W_DN); t.K = DFF; nblk = DM / 32; }
    const int kb = r / nblk, nb = r - kb * nblk; t.k0 = 64 * kb; t.n0 = 32 * nb;
}
__device__ __forceinline__ void ph_prologue(const Args& a, unsigned char* ws, LAS unsigned char* lds, int tid, int lane, int wave, int bid, int G) {
    float* MOD = (float*)(ws + WS_MOD);
    LAS float* vec = (LAS float*)(lds + 73728);
    LAS float* red = (LAS float*)(lds + 98304);
    for (int e = tid; e < 3 * DM; e += NTHR) { const float v = e < 2 * DM ? a.in[1][e] : a.in[3][e - 2 * DM]; vec[e] = silu_f(v); }
    __syncthreads();
    for (int it = bid; it < 4 * 192; it += G) {
        const int layer = it / 192, cg = it - layer * 192, col = cg * 64 + 4 * (lane & 15), rq = lane >> 4;
        const float* W = a.in[4] + (size_t)layer * DM * 12288 + col;
        f32x4 a0 = {0.f, 0.f, 0.f, 0.f}, a1 = a0, a2 = a0;
#pragma unroll 16
        for (int i = 0; i < 64; ++i) { const int kk = 256 * wave + 4 * i + rq; const f32x4 w4 = *(const f32x4*)(W + (size_t)kk * 12288);
            a0 += w4 * vec[kk]; a1 += w4 * vec[DM + kk]; a2 += w4 * vec[2 * DM + kk]; }
#pragma unroll
        for (int e = 0; e < 4; ++e) { a0[e] += __shfl_xor(a0[e], 16); a0[e] += __shfl_xor(a0[e], 32); a1[e] += __shfl_xor(a1[e], 16); a1[e] += __shfl_xor(a1[e], 32); a2[e] += __shfl_xor(a2[e], 16); a2[e] += __shfl_xor(a2[e], 32); }
        if (lane < 16) { *(LAS f32x4*)(red + (wave * 3 + 0) * 64 + 4 * lane) = a0; *(LAS f32x4*)(red + (wave * 3 + 1) * 64 + 4 * lane) = a1; *(LAS f32x4*)(red + (wave * 3 + 2) * 64 + 4 * lane) = a2; }
        __syncthreads();
        if (tid < 192) { const int j = tid >> 6, c = tid & 63; float s = a.in[5][layer * 12288 + cg * 64 + c];
#pragma unroll
            for (int w = 0; w < 8; ++w) s += red[(w * 3 + j) * 64 + c];
            MOD[(size_t)(layer * 3 + j) * 12288 + cg * 64 + c] = s; }
        __syncthreads();
    }
    if (bid == G - 1) { float* rope = (float*)(ws + WS_ROPE);
        for (int e = tid; e < 1024; e += NTHR) { const int pos = e >> 4, f = e & 15; const float inv = powf(10000.f, -(float)f / 16.f), ang = (float)pos * inv; rope[e] = cosf(ang); rope[1024 + e] = sinf(ang); } }
    { f32x4* XS = (f32x4*)(ws + WS_XS); const f32x4* x4 = (const f32x4*)a.in[0]; const f32x4* c4 = (const f32x4*)a.in[2];
      const int nl = NLATR * DM / 4, nt = MR * DM / 4, NTt = G * NTHR;
      for (int e = bid * NTHR + tid; e < nt; e += 2 * NTt) { const int e1 = e + NTt; const f32x4 v0 = e < nl ? x4[e] : c4[e - nl]; f32x4 v1 = v0; if (e1 < nt) v1 = e1 < nl ? x4[e1] : c4[e1 - nl]; XS[e] = v0; if (e1 < nt) XS[e1] = v1; } }
    LAS float* scr = (LAS float*)(lds + wave * 8448);
    const int gw = bid * NWAVES + wave, NGW = G * NWAVES;
    constexpr int NITEMS = 4 * 25344;
    TrItem cur, nxt; f32x4 va[8], vb[8];
    int g = gw;
    if (g < NITEMS) { tr_decode(a, ws, g, cur); tr_issue(cur, va, lane); }
    while (g < NITEMS) {
        const int g1 = g + NGW; if (g1 < NITEMS) { tr_decode(a, ws, g1, nxt); tr_issue(nxt, vb, lane); }
        tr_finish(cur, va, scr, lane);
        const int g2 = g1 + NGW; if (g1 < NITEMS) { if (g2 < NITEMS) { tr_decode(a, ws, g2, cur); tr_issue(cur, va, lane); } tr_finish(nxt, vb, scr, lane); }
        g = g2;
    }
}

__device__ __forceinline__ void ph_norm(const float* XS, const float* ng, const float* msh, const float* msc, bf16* H, int gw, int NGW, int lane) {
    for (int row = gw; row < MR; row += NGW) {
        const int mi = row < NLATR ? (row >> 12) : 2;
        const f32x4* xr = (const f32x4*)(XS + (size_t)row * DM) + lane;
        f32x4 v[8]; float ss = 0.f;
#pragma unroll
        for (int j = 0; j < 8; ++j) { v[j] = xr[64 * j]; ss += (v[j].x * v[j].x + v[j].y * v[j].y) + (v[j].z * v[j].z + v[j].w * v[j].w); }
        const float r = rsqrtf(wave_sum(ss) * (1.f / DM) + EPS);
#pragma unroll
        for (int j = 0; j < 8; ++j) { const int col = 4 * lane + 256 * j;
            const f32x4 g4 = *(const f32x4*)(ng + col), sc4 = *(const f32x4*)(msc + (size_t)mi * 12288 + col), sh4 = *(const f32x4*)(msh + (size_t)mi * 12288 + col);
            const f32x4 y = v[j] * r * g4 * (sc4 + 1.f) + sh4;
            v2u o; o.x = pk2(y.x, y.y); o.y = pk2(y.z, y.w);
            *(v2u*)(H + (size_t)row * DM + col) = o; }
    }
}

template <int MODE>
__device__ __forceinline__ void ph_conv(const bf16* SRC, const float* cw, const float* cb, bf16* DST, int gtid, int NT) {
    constexpr int NC = MODE == 0 ? DFF : 1024, NCG = NC / 8, NRB = MR / 16;
    constexpr int LDS_ = MODE == 0 ? NUP : NINP, LDD = MODE == 0 ? DFF : (MODE == 1 ? DM : 1024);
    for (int it = gtid; it < NRB * NCG; it += NT) {
        const int rb = it / NCG, cg = it - rb * NCG, r0 = rb * 16, c0 = cg * 8;
        float w0[8], w1[8], w2[8], bb[8];
#pragma unroll
        for (int j = 0; j < 8; ++j) { w0[j] = cw[c0 + j]; w1[j] = cw[NC + c0 + j]; w2[j] = cw[2 * NC + c0 + j]; bb[j] = MODE == 0 ? cb[c0 + j] : 0.f; }
        auto ld = [&](int r, float (&f)[8]) {
            if (MODE == 0) { unpack8(*(const v4u*)(SRC + (size_t)r * LDS_ + c0), f); }
            else if (MODE == 1) { float s1[8], s2[8]; unpack8(*(const v4u*)(SRC + (size_t)r * LDS_ + 3104 + c0), s1); unpack8(*(const v4u*)(SRC + (size_t)r * LDS_ + 5152 + c0), s2);
#pragma unroll
                for (int j = 0; j < 8; ++j) f[j] = s1[j] * s2[j]; }
            else { unpack8(*(const v4u*)(SRC + (size_t)r * LDS_ + 3072 + c0), f); }
        };
        float prev[8], cur[8], nxt[8];
        if (!seq_start(r0)) ld(r0 - 1, prev); else {
#pragma unroll
            for (int j = 0; j < 8; ++j) prev[j] = 0.f; }
        ld(r0, cur);
#pragma unroll 2
        for (int i = 0; i < 16; ++i) {
            const int r = r0 + i;
            if (i < 15 || !seq_start(r0 + 16)) ld(r + 1, nxt); else {
#pragma unroll
                for (int j = 0; j < 8; ++j) nxt[j] = 0.f; }
            float o[8];
            if (MODE == 0) { float vv[8]; unpack8(*(const v4u*)(SRC + (size_t)r * LDS_ + DFF + c0), vv);
#pragma unroll
                for (int j = 0; j < 8; ++j) o[j] = silu_f(w0[j] * prev[j] + w1[j] * cur[j] + w2[j] * nxt[j] + bb[j]) * vv[j]; }
            else if (MODE == 1) { float vv[8]; unpack8(*(const v4u*)(SRC + (size_t)r * LDS_ + 4128 + c0), vv);
#pragma unroll
                for (int j = 0; j < 8; ++j) o[j] = (w0[j] * prev[j] + w1[j] * cur[j] + w2[j] * nxt[j]) * vv[j]; }
            else { const float sc = c0 >= 512 ? 0.08838834764831845f : 1.f;
#pragma unroll
                for (int j = 0; j < 8; ++j) o[j] = silu_f(w0[j] * prev[j] + w1[j] * cur[j] + w2[j] * nxt[j]) * sc; }
            *(v4u*)(DST + (size_t)r * LDD + (MODE == 1 ? 1024 : 0) + c0) = pack8(o);
#pragma unroll
            for (int j = 0; j < 8; ++j) { prev[j] = cur[j]; cur[j] = nxt[j]; }
        }
    }
}

__device__ __forceinline__ void ph_qkprep(const bf16* P, const float* qg, const float* kg, const float* rope, bf16* QR, bf16* KR, int gw, int NGW, int lane) {
    for (int it = gw; it < MR * 4; it += NGW) {
        const int row = it >> 2, qtr = it & 3, isk = qtr >> 1;
        float x[8]; unpack8(*(const v4u*)(P + (size_t)row * NINP + isk * 1024 + (qtr & 1) * 512 + 8 * lane), x);
        float ss = 0.f;
#pragma unroll
        for (int j = 0; j < 8; ++j) ss += x[j] * x[j];
        ss += __shfl_xor(ss, 1); ss += __shfl_xor(ss, 2); ss += __shfl_xor(ss, 4);
        const float r = rsqrtf(ss * (1.f / 64.f) + EPS);
        const int i = lane & 7; const float* gp = (isk ? kg : qg) + 8 * i;
        float y[8], o[8];
#pragma unroll
        for (int j = 0; j < 8; ++j) y[j] = x[j] * r * gp[j];
        if (row < NLATR) {
            const int t = row & 4095, pos = (i < 4) ? (t >> 6) : (t & 63), f0 = 8 * (i & 1);
#pragma unroll
            for (int j = 0; j < 8; ++j) { const float pj = __shfl_xor(y[j], 2), c = rope[pos * 16 + f0 + j], s = rope[1024 + pos * 16 + f0 + j];
                o[j] = (i & 2) ? (pj * s + y[j] * c) : (y[j] * c - pj * s); }
        } else {
#pragma unroll
            for (int j = 0; j < 8; ++j) o[j] = y[j]; }
        if (!isk) {
#pragma unroll
            for (int j = 0; j < 8; ++j) o[j] *= 0.18033688011112042f; }
        *(v4u*)((isk ? KR : QR) + (size_t)row * 1024 + (qtr & 1) * 512 + 8 * lane) = pack8(o);
    }
}

struct ScanP {
    const bf16* P; const bf16* MQK; bf16* MIX;
    const float* gw2; const float* gb;
    const float* mgb;
    const float* ng;
    float* DSTp; bf16* SSTp; float* GAM; float* DN; float* NIN; float* BL; float* ML; float* MINp;
};
__device__ __forceinline__ void scan_unit(int u, int& b, int& head, int& mm, int& rowbase) {
    b = u / 272; const int rem = u - b * 272; head = rem / 68; mm = rem - head * 68;
    rowbase = mm < 4 ? NLATR + b * 256 + 64 * mm : b * 4096 + 64 * (mm - 4);
}
__device__ __forceinline__ int scan_chunk(int mm, int dir) { return dir ? (mm < 4 ? 3 - mm : 71 - mm) : mm; }

__device__ __forceinline__ void gla_gates(const ScanP& s, LAS const float* glr, LAS float* tot, int head, int dir, int tid, float (&bb)[16], float& btot) {
    const int dk = tid & 127, grp = tid >> 7;
    float w2[16];
#pragma unroll
    for (int r = 0; r < 16; ++r) w2[r] = s.gw2[(dir * 16 + r) * 512 + head * 128 + dk];
    const float bias = s.gb[dir * 512 + head * 128 + dk];
#pragma unroll
    for (int tt = 0; tt < 16; ++tt) { const int t = 16 * grp + tt; float z = bias;
#pragma unroll
        for (int r = 0; r < 16; ++r) z += glr[t * 32 + dir * 16 + r] * w2[r];
        bb[tt] = logsig_f(z) * 0.0625f; }
    if (dir == 0) {
#pragma unroll
        for (int tt = 1; tt < 16; ++tt) bb[tt] += bb[tt - 1];
        tot[grp * 128 + dk] = bb[15];
    } else {
#pragma unroll
        for (int tt = 14; tt >= 0; --tt) bb[tt] += bb[tt + 1];
        tot[grp * 128 + dk] = bb[0];
    }
    __syncthreads();
    float off = 0.f; btot = 0.f;
#pragma unroll
    for (int g = 0; g < 4; ++g) { const float tv = tot[g * 128 + dk]; btot += tv; if (dir == 0 ? g < grp : g > grp) off += tv; }
#pragma unroll
    for (int tt = 0; tt < 16; ++tt) bb[tt] += off;
}

template <int MODE>
__device__ __forceinline__ void ph_scan_local(const ScanP& s, LAS unsigned char* lds, int tid, int lane, int wave, int bid, int G) {
    LAS unsigned char* Vs = lds; LAS unsigned char* Kh = lds + 33792;
    LAS float* glr = (LAS float*)(lds + 51200); LAS float* tot = (LAS float*)(lds + 59392); LAS float* wv = (LAS float*)(lds + 61440); LAS float* dnp = (LAS float*)(lds + 61696);
    const int dk = tid & 127, grp = tid >> 7;
    for (int u = bid; u < 544; u += G) {
        int b, head, mm, rowbase; scan_unit(u, b, head, mm, rowbase);
        load_tile(Vs, 528, s.P + (size_t)rowbase * NINP + (MODE ? 4096 : 1024) + head * 256, NINP, 64, 256, tid);
        if (MODE == 0) for (int e = tid; e < 2048; e += NTHR) glr[e] = bf1(s.P[(size_t)(rowbase + (e >> 5)) * NINP + 3072 + (e & 31)]);
        __syncthreads();
        for (int dir = 0; dir < 2; ++dir) {
            const int chain = (b * 4 + head) * 2 + dir, c = scan_chunk(mm, dir); const size_t cc = (size_t)chain * NCHUNK + c;
            if (MODE == 0) {
                float bb[16], btot; gla_gates(s, glr, tot, head, dir, tid, bb, btot);
#pragma unroll
                for (int tt = 0; tt < 16; ++tt) { const int t = 16 * grp + tt; const float kv = bf1(s.P[(size_t)(rowbase + t) * NINP + 512 + head * 128 + dk]) * __expf(btot - bb[tt]);
                    *(LAS bf16*)(Kh + t * 272 + dk * 2) = f2bf(kv); }
                if (grp == 0) s.GAM[cc * 128 + dk] = __expf(btot);
            } else {
                if (wave == 0) {
                    const float ig = bf1(s.P[(size_t)(rowbase + lane) * NINP + 6144 + dir * 8 + head]) + s.mgb[dir * 8 + head];
                    const float fg = bf1(s.P[(size_t)(rowbase + lane) * NINP + 6144 + dir * 8 + 4 + head]) + s.mgb[dir * 8 + 4 + head];
                    const float lf = logsig_f(fg), bcs = wave_scan_sum(lf, dir, lane), blast = wave_sum(lf);
                    const float gs = blast - bcs + ig, mloc = wave_max(gs);
                    wv[lane] = __expf(gs - mloc);
                    if (lane == 0) { s.BL[cc] = blast; s.ML[cc] = mloc; }
                }
                __syncthreads();
                float part = 0.f;
#pragma unroll
                for (int tt = 0; tt < 16; ++tt) { const int t = 16 * grp + tt; const float kv = bf1(s.MQK[(size_t)(rowbase + t) * 1024 + 512 + head * 128 + dk]) * wv[t];
                    *(LAS bf16*)(Kh + t * 272 + dk * 2) = f2bf(kv); part += kv; }
                dnp[grp * 128 + dk] = part;
            }
            __syncthreads();
            if (MODE == 1 && tid < 128) s.DN[cc * 128 + tid] = (dnp[tid] + dnp[128 + tid]) + (dnp[256 + tid] + dnp[384 + tid]);
            f32x16 acc[4];
#pragma unroll
            for (int nt = 0; nt < 4; ++nt) acc[nt] = zero16();
#pragma unroll
            for (int ks = 0; ks < 4; ++ks) { const bf16x8 af = frag_tr(Vs, 528, 16 * ks, 32 * wave, lane);
#pragma unroll
                for (int nt = 0; nt < 4; ++nt) { const bf16x8 bfr = frag_tr(Kh, 272, 16 * ks, 32 * nt, lane); acc[nt] = MFMA32(af, bfr, acc[nt]); } }
            float* D = s.DSTp + cc * 32768;
#pragma unroll
            for (int nt = 0; nt < 4; ++nt)
#pragma unroll
                for (int r = 0; r < 16; ++r) { const int dv = 32 * wave + (r & 3) + 8 * (r >> 2) + 4 * (lane >> 5); D[dv * 128 + 32 * nt + (lane & 31)] = acc[nt][r]; }
            __syncthreads();
        }
    }
}

template <int MODE>
__device__ __forceinline__ void ph_scan_carry(const ScanP& s, int gtid, int NT) {
    for (int e = gtid; e < 16 * 8192; e += NT) {
        const int chain = e >> 13, rem = e & 8191, dv = rem >> 5, dk = (rem & 31) * 4;
        f32x4 st = {0.f, 0.f, 0.f, 0.f}, nst = st; float m = 0.f;
        for (int c0 = 0; c0 < NCHUNK; c0 += 4) {
            f32x4 d[4], gm[4]; float bl[4], ml[4];
#pragma unroll
            for (int j = 0; j < 4; ++j) { const size_t cc = (size_t)chain * NCHUNK + c0 + j; d[j] = *(const f32x4*)(s.DSTp + cc * 32768 + dv * 128 + dk);
                if (MODE == 0) gm[j] = *(const f32x4*)(s.GAM + cc * 128 + dk);
                else { bl[j] = s.BL[cc]; ml[j] = s.ML[cc]; gm[j] = (dv == 0) ? *(const f32x4*)(s.DN + cc * 128 + dk) : (f32x4){0.f, 0.f, 0.f, 0.f}; } }
#pragma unroll
            for (int j = 0; j < 4; ++j) { const size_t cc = (size_t)chain * NCHUNK + c0 + j;
                v2u o; o.x = pk2(st.x, st.y); o.y = pk2(st.z, st.w); *(v2u*)(s.SSTp + cc * 32768 + dv * 128 + dk) = o;
                if (MODE == 0) st = gm[j] * st + d[j];
                else { if (dv == 0) { *(f32x4*)(s.NIN + cc * 128 + dk) = nst; if (dk == 0) s.MINp[cc] = m; }
                    const float mn = fmaxf(bl[j] + m, ml[j]), dec = __expf(bl[j] + m - mn), sc = __expf(ml[j] - mn);
                    st = st * dec + d[j] * sc; nst = nst * dec + gm[j] * sc; m = mn; } }
        }
    }
}

template <int MODE>
__device__ __forceinline__ void ph_scan_out(const ScanP& s, LAS unsigned char* lds, int tid, int lane, int wave, int bid, int G) {
    LAS unsigned char* Vs = lds; LAS unsigned char* Qx = lds + 33792; LAS unsigned char* Ki = lds + 51200; LAS unsigned char* Qi = lds + 68608; LAS unsigned char* Am = lds + 86016;
    LAS float* glr = (LAS float*)(lds + 95232); LAS float* tot = (LAS float*)(lds + 103424);
    LAS float* us = (LAS float*)(lds + 105472); LAS float* Mts = us + 64; LAS float* wint = us + 128; LAS float* thr = us + 192; LAS float* fac = us + 256; LAS float* qn = us + 320; LAS float* rs = us + 384;
    LAS float* qnp = (LAS float*)(lds + 107520);
    LAS float* Os = (LAS float*)lds;
    const int dk = tid & 127, grp = tid >> 7;
    for (int u = bid; u < 544; u += G) {
        int b, head, mm, rowbase; scan_unit(u, b, head, mm, rowbase);
        load_tile(Vs, 528, s.P + (size_t)rowbase * NINP + (MODE ? 4096 : 1024) + head * 256, NINP, 64, 256, tid);
        if (MODE == 0) { for (int e = tid; e < 2048; e += NTHR) glr[e] = bf1(s.P[(size_t)(rowbase + (e >> 5)) * NINP + 3072 + (e & 31)]); if (tid < 64) fac[tid] = 1.f; }
        f32x16 hsum[2]; hsum[0] = zero16(); hsum[1] = zero16();
        __syncthreads();
        for (int dir = 0; dir < 2; ++dir) {
            const int chain = (b * 4 + head) * 2 + dir, c = scan_chunk(mm, dir); const size_t cc = (size_t)chain * NCHUNK + c;
            if (MODE == 0) {
                float bb[16], btot; gla_gates(s, glr, tot, head, dir, tid, bb, btot);
#pragma unroll
                for (int tt = 0; tt < 16; ++tt) { const int t = 16 * grp + tt; const size_t ro = (size_t)(rowbase + t) * NINP + head * 128 + dk;
                    const float qv = bf1(s.P[ro]), kv = bf1(s.P[ro + 512]);
                    *(LAS bf16*)(Qx + t * 272 + dk * 2) = f2bf(qv * __expf(bb[tt]) * 0.08838834764831845f);
                    *(LAS bf16*)(Ki + t * 272 + dk * 2) = f2bf(kv * __expf(-bb[tt])); }
            } else {
                if (wave == 0) {
                    const float ig = bf1(s.P[(size_t)(rowbase + lane) * NINP + 6144 + dir * 8 + head]) + s.mgb[dir * 8 + head];
                    const float fg = bf1(s.P[(size_t)(rowbase + lane) * NINP + 6144 + dir * 8 + 4 + head]) + s.mgb[dir * 8 + 4 + head];
                    const float lf = logsig_f(fg), bcs = wave_scan_sum(lf, dir, lane);
                    const float uu = ig - bcs, pm = wave_scan_max(uu, dir, lane), min_ = s.MINp[cc], Mt = fmaxf(min_, pm);
                    us[lane] = uu; Mts[lane] = Mt; wint[lane] = __expf(min_ - Mt); thr[lane] = __expf(-bcs - Mt);
                }
                __syncthreads();
#pragma unroll
                for (int tt = 0; tt < 16; ++tt) { const int t = 16 * grp + tt; const size_t ro = (size_t)(rowbase + t) * 1024 + head * 128 + dk;
                    const bf16 qb = s.MQK[ro], kb = s.MQK[ro + 512];
                    *(LAS bf16*)(Qi + t * 272 + dk * 2) = qb; *(LAS bf16*)(Ki + t * 272 + dk * 2) = kb;
                    *(LAS bf16*)(Qx + t * 272 + dk * 2) = f2bf(bf1(qb) * wint[t]); }
                __syncthreads();
                { const int t = tid & 63, part = tid >> 6; float acc = 0.f;
#pragma unroll
                  for (int j = 0; j < 16; ++j) acc += bf1(*(LAS const bf16*)(Qi + t * 272 + (part * 16 + j) * 2)) * s.NIN[cc * 128 + part * 16 + j];
                  qnp[part * 64 + t] = acc; }
            }
            __syncthreads();
            if (MODE == 1 && tid < 64) { float q = 0.f;
#pragma unroll
                for (int p = 0; p < 8; ++p) q += qnp[p * 64 + tid];
                qn[tid] = q; }
            if (wave < 4) {
                const int ti = wave >> 1, tj = wave & 1; f32x16 acc = zero16();
#pragma unroll
                for (int ks = 0; ks < 8; ++ks) { const bf16x8 af = frag_row(MODE ? Qi : Qx, 272, 32 * ti, 16 * ks, lane), bfr = frag_row(Ki, 272, 32 * tj, 16 * ks, lane); acc = MFMA32(af, bfr, acc); }
                const int sidx = 32 * tj + (lane & 31);
                const float usv = MODE ? us[sidx] : 0.f;
#pragma unroll
                for (int r = 0; r < 16; ++r) { const int t = 32 * ti + (r & 3) + 8 * (r >> 2) + 4 * (lane >> 5);
                    const bool keep = dir == 0 ? (sidx <= t) : (sidx >= t);
                    float v = acc[r];
                    if (MODE == 1) v *= __expf(usv - Mts[t]);
                    v = keep ? v : 0.f;
                    *(LAS bf16*)(Am + t * 144 + sidx * 2) = f2bf(v);
                    if (MODE == 1) { float rsum = v; rsum += __shfl_xor(rsum, 1); rsum += __shfl_xor(rsum, 2); rsum += __shfl_xor(rsum, 4); rsum += __shfl_xor(rsum, 8); rsum += __shfl_xor(rsum, 16);
                        if ((lane & 31) == 0) rs[tj * 64 + t] = rsum; } }
            }
            __syncthreads();
            if (MODE == 1 && tid < 64) { const float den = wint[tid] * qn[tid] + rs[tid] + rs[64 + tid]; fac[tid] = 1.f / fmaxf(fabsf(den), thr[tid]); }
            f32x16 acc2[2]; acc2[0] = zero16(); acc2[1] = zero16();
            { const bf16* Sg = s.SSTp + cc * 32768 + (size_t)(32 * wave + (lane & 31)) * 128 + 8 * (lane >> 5);
#pragma unroll
              for (int ks = 0; ks < 8; ++ks) { const bf16x8 bfr = *(const bf16x8*)(Sg + 16 * ks);
#pragma unroll
                  for (int rt = 0; rt < 2; ++rt) { const bf16x8 af = frag_row(Qx, 272, 32 * rt, 16 * ks, lane); acc2[rt] = MFMA32(af, bfr, acc2[rt]); } } }
#pragma unroll
            for (int ks = 0; ks < 4; ++ks) { const bf16x8 bfr = frag_tr(Vs, 528, 16 * ks, 32 * wave, lane);
#pragma unroll
                for (int rt = 0; rt < 2; ++rt) { const bf16x8 af = frag_row(Am, 144, 32 * rt, 16 * ks, lane); acc2[rt] = MFMA32(af, bfr, acc2[rt]); } }
            __syncthreads();
#pragma unroll
            for (int rt = 0; rt < 2; ++rt)
#pragma unroll
                for (int r = 0; r < 16; ++r) { const int t = 32 * rt + (r & 3) + 8 * (r >> 2) + 4 * (lane >> 5); hsum[rt][r] += acc2[rt][r] * fac[t]; }
        }
        __syncthreads();
#pragma unroll
        for (int rt = 0; rt < 2; ++rt)
#pragma unroll
            for (int r = 0; r < 16; ++r) { const int t = 32 * rt + (r & 3) + 8 * (r >> 2) + 4 * (lane >> 5); Os[t * 260 + 32 * wave + (lane & 31)] = hsum[rt][r]; }
        __syncthreads();
        { const int t = tid >> 3, part = tid & 7; float o[32]; float ss = 0.f;
#pragma unroll
          for (int j = 0; j < 8; ++j) { const f32x4 v = *(LAS const f32x4*)(Os + t * 260 + 32 * part + 4 * j); o[4 * j] = v.x; o[4 * j + 1] = v.y; o[4 * j + 2] = v.z; o[4 * j + 3] = v.w; ss += (v.x * v.x + v.y * v.y) + (v.z * v.z + v.w * v.w); }
          ss += __shfl_xor(ss, 1); ss += __shfl_xor(ss, 2); ss += __shfl_xor(ss, 4);
          const float rn = rsqrtf(ss * (1.f / 256.f) + EPS);
          const size_t row = (size_t)(rowbase + t);
          const bf16* gsrc = s.P + row * NINP + (MODE ? 5120 : 2048) + head * 256 + 32 * part;
          bf16* dst = s.MIX + row * DM + (MODE ? 1024 : 0) + head * 256 + 32 * part;
#pragma unroll
          for (int j = 0; j < 4; ++j) { float gv[8], ov[8]; unpack8(*(const v4u*)(gsrc + 8 * j), gv);
#pragma unroll
              for (int e = 0; e < 8; ++e) { const float gt = MODE ? sigmoid_f(gv[e]) : silu_f(gv[e]); ov[e] = o[8 * j + e] * rn * s.ng[32 * part + 8 * j + e] * gt; }
              *(v4u*)(dst + 8 * j) = pack8(ov); } }
        __syncthreads();
    }
}

struct AttnP { const bf16* QR; const bf16* KR; const bf16* P; bf16* MIX; const float* lamp; const float* subg; const float* qg; const float* kg; float lam_init; };
__device__ __forceinline__ void ph_attn(const AttnP& p, LAS unsigned char* lds, int tid, int lane, int wave, int bid, int G) {
    const float l01 = wave_sum(p.lamp[lane] * p.lamp[64 + lane]), l23 = wave_sum(p.lamp[128 + lane] * p.lamp[192 + lane]);
    const float lam = __expf(l01) - __expf(l23) + p.lam_init;
    const float negm2 = -8.f * wave_max(fabsf(p.qg[lane])) * wave_max(fabsf(p.kg[lane])) * 1.4426950408889634f * 1.02f;
    const int r = lane & 31, h = lane >> 5, mp = wave >> 2, wq = wave & 3;
    LAS float* Ex = (LAS float*)lds;
    for (int u = bid; u < 544; u += G) {
        int b, hd, qrow0, nkt;
        if (u < 512) { b = u >> 8; hd = (u >> 5) & 7; qrow0 = b * 4096 + 128 * (u & 31); nkt = 68; }
        else { const int uu = u - 512; b = uu >> 4; hd = (uu >> 1) & 7; qrow0 = NLATR + b * 256 + 128 * (uu & 1); nkt = 4; }
        const int qrow = qrow0 + 32 * wq + r;
        bf16x8 Qf[4];
#pragma unroll
        for (int ks = 0; ks < 4; ++ks) Qf[ks] = *(const bf16x8*)(p.QR + (size_t)qrow * 1024 + (hd * 2 + mp) * 64 + 16 * ks + 8 * h);
        f32x16 O[4];
#pragma unroll
        for (int dt = 0; dt < 4; ++dt) O[dt] = zero16();
        float ls = 0.f;
        const int c0r = tid >> 4, c0c = tid & 15;
        v4u kr0, kr1, vr0, vr1;
        auto gload = [&](int kt) { const int krow = kt < 4 ? NLATR + b * 256 + 64 * kt : b * 4096 + 64 * (kt - 4);
            kr0 = *(const v4u*)(p.KR + (size_t)(krow + c0r) * 1024 + hd * 128 + c0c * 8); kr1 = *(const v4u*)(p.KR + (size_t)(krow + 32 + c0r) * 1024 + hd * 128 + c0c * 8);
            vr0 = *(const v4u*)(p.P + (size_t)(krow + c0r) * NINP + 2048 + hd * 128 + c0c * 8); vr1 = *(const v4u*)(p.P + (size_t)(krow + 32 + c0r) * NINP + 2048 + hd * 128 + c0c * 8); };
        auto lstore = [&](int buf) { LAS unsigned char* Kt = lds + buf * 17408; LAS unsigned char* Vt = lds + 34816 + buf * 17408;
            *(LAS v4u*)(Kt + c0r * 272 + c0c * 16) = kr0; *(LAS v4u*)(Kt + (32 + c0r) * 272 + c0c * 16) = kr1;
            *(LAS v4u*)(Vt + c0r * 272 + c0c * 16) = vr0; *(LAS v4u*)(Vt + (32 + c0r) * 272 + c0c * 16) = vr1; };
        gload(0); lstore(0);
        __syncthreads();
        for (int kt = 0; kt < nkt; ++kt) {
            const bool more = kt + 1 < nkt;
            if (more) gload(kt + 1);
            LAS const unsigned char* Kt = lds + (kt & 1) * 17408; LAS const unsigned char* Vt = lds + 34816 + (kt & 1) * 17408;
#pragma unroll
            for (int kb = 0; kb < 2; ++kb) {
                f32x16 S = zero16();
#pragma unroll
                for (int ks = 0; ks < 4; ++ks) { const bf16x8 a0 = frag_row(Kt, 272, 32 * kb, 64 * mp + 16 * ks, lane); S = MFMA32(a0, Qf[ks], S); }
                unsigned pf[8]; float lacc = 0.f;
#pragma unroll
                for (int i = 0; i < 8; ++i) { const float e0 = __builtin_amdgcn_exp2f(S[2 * i] + negm2), e1 = __builtin_amdgcn_exp2f(S[2 * i + 1] + negm2); lacc += e0 + e1; pf[i] = pk2(e0, e1); }
                ls += lacc;
                const bf16x8 P0 = __builtin_bit_cast(bf16x8, (v4u){pf[0], pf[1], pf[2], pf[3]}), P1 = __builtin_bit_cast(bf16x8, (v4u){pf[4], pf[5], pf[6], pf[7]});
#pragma unroll
                for (int dt = 0; dt < 4; ++dt) { const bf16x8 av0 = frag_tr_perm(Vt, 272, 32 * kb, 32 * dt, lane), av1 = frag_tr_perm(Vt, 272, 32 * kb + 16, 32 * dt, lane);
                    O[dt] = MFMA32(av0, P0, O[dt]); O[dt] = MFMA32(av1, P1, O[dt]); }
            }
            if (more) lstore((kt + 1) & 1);
            __syncthreads();
        }
        const float l = ls + __shfl_xor(ls, 32);
        if (mp == 1) { const float sc = lam / l;
#pragma unroll
            for (int dt = 0; dt < 4; ++dt)
#pragma unroll
                for (int i = 0; i < 16; ++i) Ex[(32 * wq + r) * 132 + 32 * dt + (i & 3) + 8 * (i >> 2) + 4 * h] = O[dt][i] * sc; }
        __syncthreads();
        if (mp == 0) { const float a0 = 1.f / l; float ss = 0.f;
#pragma unroll
            for (int dt = 0; dt < 4; ++dt)
#pragma unroll
                for (int i = 0; i < 16; ++i) { const float v = O[dt][i] * a0 - Ex[(32 * wq + r) * 132 + 32 * dt + (i & 3) + 8 * (i >> 2) + 4 * h]; O[dt][i] = v; ss += v * v; }
            ss += __shfl_xor(ss, 32);
            const float rn = rsqrtf(ss * (1.f / 128.f) + EPS) * (1.f - p.lam_init);
            bf16* dst = p.MIX + (size_t)qrow * DM + hd * 128;
#pragma unroll
            for (int dt = 0; dt < 4; ++dt)
#pragma unroll
                for (int g4 = 0; g4 < 4; ++g4) { const int dv0 = 32 * dt + 8 * g4 + 4 * h; const f32x4 sg = *(const f32x4*)(p.subg + dv0);
                    v2u o; o.x = pk2(O[dt][4 * g4] * rn * sg.x, O[dt][4 * g4 + 1] * rn * sg.y); o.y = pk2(O[dt][4 * g4 + 2] * rn * sg.z, O[dt][4 * g4 + 3] * rn * sg.w);
                    *(v2u*)(dst + dv0) = o; } }
        __syncthreads();
    }
}

#ifndef PHASE_MASK
#define PHASE_MASK 0xFFFFFFu
#endif
#define PM(j) ((PHASE_MASK >> (j)) & 1u)
#ifndef REP_MASK
#define REP_MASK 0u
#endif
#define REPS(j) ((((REP_MASK) >> (j)) & 1u) ? 2 : 1)
#define PH_BEGIN(j, k) if (PM(j) && IN(k)) for (int rep_ = 0; rep_ < REPS(j); ++rep_) { if (rep_) xcd_barrier(bar);
#define PH_END }
#define PHASE_BEGIN int tid = tid0, lane = lane0; asm volatile("" : "+v"(tid), "+v"(lane)); int wave = wave0, bid = bid0, G = G0; asm volatile("" : "+s"(wave), "+s"(bid), "+s"(G)); \
    unsigned char* ws = ws0; asm volatile("" : "+s"(ws)); const int gw = bid * NWAVES + wave, NGW = G * NWAVES, gtid = bid * NTHR + tid, NT = G * NTHR; (void)gw; (void)NGW; (void)gtid; (void)NT; (void)lane;
__device__ __forceinline__ void fill_scanp(ScanP& sp, const Args& a, unsigned char* ws, int li, bool even) {
    sp.P = (const bf16*)(ws + WS_P); sp.MQK = (const bf16*)(ws + WS_MQK); sp.MIX = (bf16*)(ws + WS_MIX);
    sp.gw2 = a.in[10] + (size_t)li * 2 * 16 * 512; sp.gb = a.in[11] + (size_t)li * 2 * 512; sp.mgb = a.in[21] + (size_t)li * 16;
    sp.ng = even ? a.in[12] + (size_t)li * 256 : a.in[22] + (size_t)li * 256;
    sp.DSTp = (float*)(ws + WS_DST); sp.SSTp = (bf16*)(ws + WS_SST); sp.GAM = (float*)(ws + WS_SM + SM_GAM); sp.DN = (float*)(ws + WS_SM + SM_DN); sp.NIN = (float*)(ws + WS_SM + SM_NIN);
    sp.BL = (float*)(ws + WS_SM + SM_BL); sp.ML = (float*)(ws + WS_SM + SM_ML); sp.MINp = (float*)(ws + WS_SM + SM_MIN);
}
__global__ void __launch_bounds__(NTHR, 2) fwd_kernel(Args a) {
    extern __shared__ __attribute__((aligned(16))) unsigned char lds_raw[];
    LAS unsigned char* lds = (LAS unsigned char*)lds_raw;
    const int tid0 = threadIdx.x, lane0 = tid0 & 63, wave0 = __builtin_amdgcn_readfirstlane(tid0 >> 6), bid0 = blockIdx.x, G0 = gridDim.x;
    unsigned char* ws0 = a.ws;
    volatile LAS unsigned* MISC = (volatile LAS unsigned*)(lds + MISC_OFF);
    if (tid0 < 32) MISC[tid0] = 0u;
    __syncthreads();
    XcdBarrier bar = xcd_barrier_post((unsigned*)(ws0 + WS_CTL) + CW_BAR + a.li * XCD_BAR_WORDS, MISC + 8);
    const int lo = a.ph_lo, hi = a.ph_hi;
#define IN(k) (lo <= (k) && (k) < hi)
#define SEAM(k) do { if (IN(k) && IN((k) + 1)) xcd_barrier(bar); } while (0)

    PH_BEGIN(11, 0) PHASE_BEGIN; ph_prologue(a, ws, lds, tid, lane, wave, bid, G); PH_END
    SEAM(0);
    for (int layer = 0; layer < NLAYERS; ++layer) {
        const int pb = 1 + layer * PPL, li = layer >> 1; const bool even = (layer & 1) == 0;
        const size_t mod_off = WS_MOD + (size_t)layer * 3 * 12288 * 4;
        const size_t wb_off = WS_W + (size_t)layer * W_LAYER;

        PH_BEGIN(0, pb + 0) PHASE_BEGIN; const float* mod = (const float*)(ws + mod_off);
            ph_norm((const float*)(ws + WS_XS), a.in[6] + (size_t)layer * DM, mod + 0 * DM, mod + 1 * DM, (bf16*)(ws + WS_H), gw, NGW, lane); }
        SEAM(pb + 0);
        PH_BEGIN(1, pb + 1) PHASE_BEGIN; pg8::Gemm g{(const bf16*)(ws + WS_H), (const bf16*)(ws + wb_off), MR, NINP, DM}; pg8::StaticOrder S; S.init(MR, NINP, G, bid); pg8::EpiStore E{(bf16*)(ws + WS_P), NINP};
            pg8::gemm_phase<pg8::EpiStore, pg8::StaticOrder, true, true>(lds, g, S, E); }
        SEAM(pb + 1);
        PH_BEGIN(2, pb + 2)
            if (even) {
                if (PM(12)) { PHASE_BEGIN; ph_conv<1>((const bf16*)(ws + WS_P), a.in[13] + (size_t)li * 3 * 1024, nullptr, (bf16*)(ws + WS_MIX), gtid, NT); }
                if (PM(13)) { PHASE_BEGIN; ScanP sp; fill_scanp(sp, a, ws, li, even); ph_scan_local<0>(sp, lds, tid, lane, wave, bid, G); }
            } else {
                if (PM(14)) { PHASE_BEGIN; ph_qkprep((const bf16*)(ws + WS_P), a.in[16] + (size_t)li * 64, a.in[17] + (size_t)li * 64, (const float*)(ws + WS_ROPE), (bf16*)(ws + WS_QR), (bf16*)(ws + WS_KR), gw, NGW, lane); }
                if (PM(15)) { PHASE_BEGIN; ph_conv<2>((const bf16*)(ws + WS_P), a.in[20] + (size_t)li * 3 * 1024, nullptr, (bf16*)(ws + WS_MQK), gtid, NT); }
            }
        }
        SEAM(pb + 2);
        PH_BEGIN(3, pb + 3) if (!even) { PHASE_BEGIN; ScanP sp; fill_scanp(sp, a, ws, li, even); ph_scan_local<1>(sp, lds, tid, lane, wave, bid, G); } }
        SEAM(pb + 3);
        PH_BEGIN(4, pb + 4) PHASE_BEGIN; ScanP sp; fill_scanp(sp, a, ws, li, even); if (even) ph_scan_carry<0>(sp, gtid, NT); else ph_scan_carry<1>(sp, gtid, NT); }
        SEAM(pb + 4);
        PH_BEGIN(5, pb + 5)
            if (even) { if (PM(16)) { PHASE_BEGIN; ScanP sp; fill_scanp(sp, a, ws, li, even); ph_scan_out<0>(sp, lds, tid, lane, wave, bid, G); } }
            else {
                if (PM(17)) { PHASE_BEGIN; AttnP ap{(const bf16*)(ws + WS_QR), (const bf16*)(ws + WS_KR), (const bf16*)(ws + WS_P), (bf16*)(ws + WS_MIX), a.in[18] + (size_t)li * 256, a.in[19] + (size_t)li * 128, a.in[16] + (size_t)li * 64, a.in[17] + (size_t)li * 64, 0.8f - 0.6f * expf(-0.3f * (float)layer)};
                    ph_attn(ap, lds, tid, lane, wave, bid, G); }
                if (PM(18)) { PHASE_BEGIN; ScanP sp; fill_scanp(sp, a, ws, li, even); ph_scan_out<1>(sp, lds, tid, lane, wave, bid, G); }
            }
        }
        SEAM(pb + 5);
        PH_BEGIN(6, pb + 6) PHASE_BEGIN; pg8::Gemm g{(const bf16*)(ws + WS_MIX), (const bf16*)(ws + wb_off + W_OUT), MR, DM, DM}; pg8::StaticOrder S; S.init(MR, DM, G, bid);
            pg8::EpiResid E{(float*)(ws + WS_XS), (const float*)(ws + mod_off) + 2 * DM, nullptr, 0, rep_};
            pg8::gemm_phase<pg8::EpiResid, pg8::StaticOrder, true, true>(lds, g, S, E); }
        SEAM(pb + 6);
        PH_BEGIN(7, pb + 7) PHASE_BEGIN; const float* mod = (const float*)(ws + mod_off);
            ph_norm((const float*)(ws + WS_XS), a.in[7] + (size_t)layer * DM, mod + 3 * DM, mod + 4 * DM, (bf16*)(ws + WS_H), gw, NGW, lane); }
        SEAM(pb + 7);
        PH_BEGIN(8, pb + 8) PHASE_BEGIN; pg8::Gemm g{(const bf16*)(ws + WS_H), (const bf16*)(ws + wb_off + W_UP), MR, NUP, DM}; pg8::StaticOrder S; S.init(MR, NUP, G, bid); pg8::EpiStore E{(bf16*)(ws + WS_U), NUP};
            pg8::gemm_phase<pg8::EpiStore, pg8::StaticOrder, true, true>(lds, g, S, E); }
        SEAM(pb + 8);
        PH_BEGIN(9, pb + 9) PHASE_BEGIN; ph_conv<0>((const bf16*)(ws + WS_U), a.in[24] + (size_t)layer * 3 * DFF, a.in[25] + (size_t)layer * DFF, (bf16*)(ws + WS_ACT), gtid, NT); }
        SEAM(pb + 9);
        PH_BEGIN(10, pb + 10) PHASE_BEGIN; pg8::Gemm g{(const bf16*)(ws + WS_ACT), (const bf16*)(ws + wb_off + W_DN), MR, DM, DFF}; pg8::StaticOrder S; S.init(MR, DM, G, bid);
            pg8::EpiResid E{(float*)(ws + WS_XS), (const float*)(ws + mod_off) + 5 * DM, a.out, layer == NLAYERS - 1 ? 1 : 0, rep_};
            pg8::gemm_phase<pg8::EpiResid, pg8::StaticOrder, true, true>(lds, g, S, E); }
        if (layer < NLAYERS - 1) SEAM(pb + 10);
    }
#undef IN
#undef SEAM
}

extern "C" void kernel_launch(void* const* d_in, const int* in_sizes, int n_in, void* d_out, int out_size, void* d_ws, size_t ws_size, hipStream_t stream) {
    static int grid = 0;
    if (grid == 0) {
        int dev = 0, cus = 0;
        if (n_in != 27 || out_size != NLATR * DM || ws_size < WS_END) { fprintf(stderr, "kernel_launch: unexpected problem (n_in %d out %d ws %zu)\n", n_in, out_size, ws_size); grid = -1; return; }
        if (hipGetDevice(&dev) != hipSuccess || hipDeviceGetAttribute(&cus, hipDeviceAttributeMultiprocessorCount, dev) != hipSuccess) { grid = -1; return; }
        if (hipFuncSetAttribute((const void*)fwd_kernel, hipFuncAttributeMaxDynamicSharedMemorySize, LDS_BYTES) != hipSuccess) { fprintf(stderr, "kernel_launch: hipFuncSetAttribute failed\n"); grid = -1; return; }
        int per_cu = 0;
        if (hipOccupancyMaxActiveBlocksPerMultiprocessor(&per_cu, (const void*)fwd_kernel, NTHR, LDS_BYTES) != hipSuccess || per_cu < 1) fprintf(stderr, "kernel_launch: occupancy query reports %d\n", per_cu);
        (void)hipGetLastError();
        grid = cus;
    }
    if (grid < 0) return;
    (void)hipMemsetAsync((char*)d_ws + WS_CTL, 0, CTL_BYTES, stream);
    Args a{};
    for (int i = 0; i < 27; ++i) a.in[i] = (const float*)d_in[i];
    a.out = (float*)d_out; a.ws = (unsigned char*)d_ws; a.pad = 0;
#if ONE_LAUNCH
    a.ph_lo = 0; a.ph_hi = 1 + NLAYERS * PPL; a.li = 0;
    hipLaunchKernelGGL(fwd_kernel, dim3(grid), dim3(NTHR), LDS_BYTES, stream, a);
#else
    for (int p = 0; p < 1 + NLAYERS * PPL; ++p) {
        const int k = p == 0 ? 0 : (p - 1) % PPL, layer = p == 0 ? 0 : (p - 1) / PPL;
        if (p > 0 && k == 3 && (layer & 1) == 0) continue;
        a.ph_lo = p; a.ph_hi = p + 1; a.li = p;
        hipLaunchKernelGGL(fwd_kernel, dim3(grid), dim3(NTHR), LDS_BYTES, stream, a);
    }
#endif
}
```

```cpp
#include <hip/hip_runtime.h>
#include <cstdio>
#include <cstdint>
namespace pg8 {
#define PG8_LAS __attribute__((address_space(3)))
typedef unsigned short bf16_t;
typedef short bf16x8 __attribute__((ext_vector_type(8)));
typedef float f32x4 __attribute__((ext_vector_type(4)));
typedef unsigned u32x4 __attribute__((ext_vector_type(4)));
constexpr int BM = 256, BK = 64, HALF = 128, HTB = HALF * BK * 2  , STAGE_BYTES = 8 * HTB, NXCD = 8, WGM = 8;

__host__ __device__ __forceinline__ int lds_byte(int r, int c) { const int st = (r >> 4) * 2 + (c >> 5), rr = r & 15, cc = c & 31, ob = rr * 64 + cc * 2; return st * 1024 + (ob ^ (((ob >> 9) & 1) << 5)); }
__host__ __device__ __forceinline__ void stage_rc(int b, int& R, int& C) { const int st = b / 1024, sb = b % 1024, swz = sb ^ (((sb >> 9) & 1) << 5); R = (st >> 1) * 16 + swz / 64; C = (st & 1) * 32 + (swz % 64) / 2; }
__host__ __device__ __forceinline__ int perm32(int rho) { const int n = rho >> 4, i = rho & 15; return 8 * (i >> 2) + 4 * n + (i & 3); }

struct Unit { int pm, pn, k0, nt; };
struct Gemm { const bf16_t* A; const bf16_t* Bt; int M, N, K; };

struct StaticOrder {
    int nM, nN, nwg, G, c;
    __host__ __device__ void init(int M, int N, int G_, int c_) { nM = M / BM; nN = N / BM; nwg = nM * nN; G = G_; c = c_; }
    __host__ __device__ bool next(int i, Unit& u) const {
        const long L = (long)i * G + c; if (L >= nwg) return false;
        int wgid = (int)L; { const int q = nwg / NXCD, r = nwg % NXCD, xcd = wgid % NXCD, off = wgid / NXCD; wgid = (xcd < r ? xcd * (q + 1) : r * (q + 1) + (xcd - r) * q) + off; }
        const int nig = WGM * nN, gid = wgid / nig, fm = gid * WGM, gsz = (nM - fm) < WGM ? (nM - fm) : WGM;
        u.pm = fm + ((wgid % nig) % gsz); u.pn = (wgid % nig) / gsz; u.k0 = 0; u.nt = 0; return true;
    }
    __device__ __forceinline__ void a_ready(const Unit&) const {}
    __device__ __forceinline__ void done(const Unit&) const {}
};
__device__ __forceinline__ unsigned cvt_pk_bf16(float lo, float hi) { unsigned r; asm volatile("v_cvt_pk_bf16_f32 %0, %1, %2" : "=v"(r) : "v"(lo), "v"(hi)); return r; }

struct EpiStore {
    static constexpr bool PERM = true, AFTER_DRAIN = false;
    bf16_t* O; int ldc;
    __device__ __forceinline__ void operator()(const f32x4 (&acc)[2][2][4][2], const Unit& u, int wr, int wc, int fr, int fq) const {
        const int row0 = u.pm * BM + wr * 64 + fr, col0 = u.pn * BM + wc * 32 + 8 * fq;
#pragma unroll
        for (int ai = 0; ai < 2; ++ai)
#pragma unroll
            for (int m = 0; m < 4; ++m) { bf16_t* rowp = O + (size_t)(row0 + ai * HALF + m * 16) * ldc + col0;
#pragma unroll
                for (int bj = 0; bj < 2; ++bj) { const f32x4 v0 = acc[ai][bj][m][0], v1 = acc[ai][bj][m][1];
                    u32x4 w; w.x = cvt_pk_bf16(v0[0], v0[1]); w.y = cvt_pk_bf16(v0[2], v0[3]); w.z = cvt_pk_bf16(v1[0], v1[1]); w.w = cvt_pk_bf16(v1[2], v1[3]);
                    *(u32x4*)(rowp + bj * HALF) = w; } }
    }
};
struct EpiResid {
    static constexpr bool PERM = false, AFTER_DRAIN = false;
    float* X; const float* gate; float* out; int final_; int dry;
    __device__ __forceinline__ void operator()(const f32x4 (&acc)[2][2][4][2], const Unit& u, int wr, int wc, int fr, int fq) const {
        if (final_ && u.pm >= 32) return;
        const int mi = u.pm < 32 ? (u.pm >> 4) : 2;
        const float* g = gate + (size_t)mi * 12288;
        const int row0 = u.pm * BM + wr * 64 + fr, col0 = u.pn * BM + wc * 32 + 4 * fq;
        f32x4 gv[2][2];
#pragma unroll
        for (int bj = 0; bj < 2; ++bj)
#pragma unroll
            for (int n = 0; n < 2; ++n) gv[bj][n] = *(const f32x4*)(g + col0 + bj * HALF + n * 16);
        if (dry && gv[0][0][0] != 1.2345e30f) return;
#pragma unroll
        for (int ai = 0; ai < 2; ++ai)
#pragma unroll
            for (int m = 0; m < 4; ++m) { const size_t ro = (size_t)(row0 + ai * HALF + m * 16) * 2048 + col0; const float* xr = X + ro; float* orow = (final_ ? out : X) + ro;
#pragma unroll
                for (int bj = 0; bj < 2; ++bj)
#pragma unroll
                    for (int n = 0; n < 2; ++n) { const f32x4 xv = *(const f32x4*)(xr + bj * HALF + n * 16); *(f32x4*)(orow + bj * HALF + n * 16) = xv + gv[bj][n] * acc[ai][bj][m][n]; } }
    }
};

struct ResidOrder {
    StaticOrder L; int G, c, nsub, ksub;
    __device__ void init(int G_, int c_, int nsplit, int ksub_) { L.init(8192, 2048, G_, c_); G = G_; c = c_; nsub = 16 * nsplit; ksub = ksub_; }
    __device__ bool next(int i, Unit& u) const {
        const int nl = c < 256 ? (255 - c) / G + 1 : 0;
        if (i < nl) return L.next(i, u);
        const int s = (i - nl) * G + c; if (s >= nsub) return false;
        const int tile = s & 15, j = s >> 4; u.pm = 32 + (tile >> 3); u.pn = tile & 7; u.k0 = j * ksub; u.nt = ksub / BK; return true;
    }
    __device__ __forceinline__ void a_ready(const Unit&) const {}
    __device__ __forceinline__ void done(const Unit&) const {}
};
struct EpiResid2 {
    static constexpr bool PERM = false, AFTER_DRAIN = false;
    float* X; const float* gate; float* out; float* part; int final_; int ksub; int dry;
    __device__ __forceinline__ void operator()(const f32x4 (&acc)[2][2][4][2], const Unit& u, int wr, int wc, int fr, int fq) const {
        const int row0 = u.pm * BM + wr * 64 + fr, col0 = u.pn * BM + wc * 32 + 4 * fq;
        if (u.pm >= 32) {
            float* pb = part + ((size_t)(u.k0 / ksub) * 512 + (row0 - 8192)) * 2048 + col0;
#pragma unroll
            for (int ai = 0; ai < 2; ++ai)
#pragma unroll
                for (int m = 0; m < 4; ++m)
#pragma unroll
                    for (int bj = 0; bj < 2; ++bj)
#pragma unroll
                        for (int n = 0; n < 2; ++n) *(f32x4*)(pb + (size_t)(ai * HALF + m * 16) * 2048 + bj * HALF + n * 16) = acc[ai][bj][m][n];
            return;
        }
        const float* g = gate + (size_t)(u.pm >> 4) * 12288;
        f32x4 gv[2][2];
#pragma unroll
        for (int bj = 0; bj < 2; ++bj)
#pragma unroll
            for (int n = 0; n < 2; ++n) gv[bj][n] = *(const f32x4*)(g + col0 + bj * HALF + n * 16);
        if (dry && gv[0][0][0] != 1.2345e30f) return;
#pragma unroll
        for (int ai = 0; ai < 2; ++ai)
#pragma unroll
            for (int m = 0; m < 4; ++m) { const size_t ro = (size_t)(row0 + ai * HALF + m * 16) * 2048 + col0; const float* xr = X + ro; float* orow = (final_ ? out : X) + ro;
#pragma unroll
                for (int bj = 0; bj < 2; ++bj)
#pragma unroll
                    for (int n = 0; n < 2; ++n) { const f32x4 xv = *(const f32x4*)(xr + bj * HALF + n * 16); *(f32x4*)(orow + bj * HALF + n * 16) = xv + gv[bj][n] * acc[ai][bj][m][n]; } }
    }
};

struct EpiAct {
    static constexpr bool PERM = true, AFTER_DRAIN = false;
    bf16_t* ACT; const float* cw; const float* cb; float* halo; PG8_LAS float* exb; mutable int par;
    __device__ __forceinline__ void operator()(const f32x4 (&acc)[2][2][4][2], const Unit& u, int wr, int wc, int fr, int fq) const {
        const int lane = fq * 16 + fr, ch0 = wc * 32 + 8 * fq, chg = u.pn * 128 + ch0;
        float w0[8], w1[8], w2[8], bb[8];
#pragma unroll
        for (int c = 0; c < 8; ++c) { w0[c] = cw[chg + c]; w1[c] = cw[5632 + chg + c]; w2[c] = cw[2 * 5632 + chg + c]; bb[c] = cb[chg + c]; }
        PG8_LAS float* xb = exb + par * 1024; par ^= 1;
#pragma unroll
        for (int ai = 0; ai < 2; ++ai) { const int q = ai * 2 + wr;
            if (fr == 0) {
#pragma unroll
                for (int n = 0; n < 2; ++n) *(PG8_LAS f32x4*)(xb + q * 128 + ch0 + 4 * n) = acc[ai][0][0][n]; }
            if (fr == 15) {
#pragma unroll
                for (int n = 0; n < 2; ++n) *(PG8_LAS f32x4*)(xb + (4 + q) * 128 + ch0 + 4 * n) = acc[ai][0][3][n]; } }
        asm volatile("s_waitcnt lgkmcnt(0)" ::: "memory"); __builtin_amdgcn_s_barrier(); asm volatile("" ::: "memory");
        const int srcp = (lane & 48) | ((fr + 15) & 15), srcn = (lane & 48) | ((fr + 1) & 15);
        float* hb = halo + (size_t)(u.pm * 44 + u.pn) * 768 + ch0;
#pragma unroll
        for (int ai = 0; ai < 2; ++ai) { const int q = ai * 2 + wr;
            float pB[8], nB[8];
#pragma unroll
            for (int n = 0; n < 2; ++n) { const f32x4 p4 = q > 0 ? *(PG8_LAS const f32x4*)(xb + (4 + q - 1) * 128 + ch0 + 4 * n) : (f32x4){0.f, 0.f, 0.f, 0.f};
                const f32x4 n4 = q < 3 ? *(PG8_LAS const f32x4*)(xb + (q + 1) * 128 + ch0 + 4 * n) : (f32x4){0.f, 0.f, 0.f, 0.f};
#pragma unroll
                for (int el = 0; el < 4; ++el) { pB[4 * n + el] = p4[el]; nB[4 * n + el] = n4[el]; } }
#pragma unroll
            for (int m = 0; m < 4; ++m) {
                float o[8], cv[8];
#pragma unroll
                for (int c = 0; c < 8; ++c) { const int n = c >> 2, el = c & 3;
                    const float x = acc[ai][0][m][n][el];
                    const float sp = fr == 15 ? (m > 0 ? acc[ai][0][m > 0 ? m - 1 : 0][n][el] : pB[c]) : x;
                    const float sn = fr == 0 ? (m < 3 ? acc[ai][0][m < 3 ? m + 1 : 3][n][el] : nB[c]) : x;
                    const float pv = __shfl(sp, srcp), nv = __shfl(sn, srcn);
                    cv[c] = w0[c] * pv + w1[c] * x + w2[c] * nv + bb[c];
                    o[c] = cv[c] / (1.f + __expf(-cv[c])) * acc[ai][1][m][n][el]; }
                const bool top = (q == 0 && m == 0 && fr == 0), bot = (q == 3 && m == 3 && fr == 15);
                if (top || bot) { const int sl = top ? 0 : 1;
#pragma unroll
                    for (int n = 0; n < 2; ++n) { *(f32x4*)(hb + sl * 128 + 4 * n) = acc[ai][0][m][n]; *(f32x4*)(hb + (2 + sl) * 128 + 4 * n) = (f32x4){cv[4 * n], cv[4 * n + 1], cv[4 * n + 2], cv[4 * n + 3]}; *(f32x4*)(hb + (4 + sl) * 128 + 4 * n) = acc[ai][1][m][n]; }
                } else {
                    u32x4 w; w.x = cvt_pk_bf16(o[0], o[1]); w.y = cvt_pk_bf16(o[2], o[3]); w.z = cvt_pk_bf16(o[4], o[5]); w.w = cvt_pk_bf16(o[6], o[7]);
                    *(u32x4*)(ACT + (size_t)(u.pm * BM + q * 64 + m * 16 + fr) * 5632 + chg) = w; }
            }
        }
    }
};
template <class Epi, class Sched, bool ALIGN_EPI = false, bool SP2 = false>
__device__ __forceinline__ void gemm_phase(PG8_LAS unsigned char* lds, const Gemm g, const Sched& S, const Epi& E) {
    int tid = threadIdx.x; asm volatile("" : "+v"(tid));
    const int wid = __builtin_amdgcn_readfirstlane(tid >> 6), lane = tid & 63, wr = wid >> 2, wc = wid & 3, fr = lane & 15, fq = lane >> 4;
    const int K = g.K, nt = K / BK;
    unsigned voffA[2], voffB[2];
#pragma unroll
    for (int i = 0; i < 2; ++i) { int R, C; stage_rc(tid * 16 + i * 8192, R, C); const int Rb = Epi::PERM ? ((R & ~31) + perm32(R & 31)) : R;
        voffA[i] = (unsigned)(R * K + C) * 2u; voffB[i] = (unsigned)(Rb * K + C) * 2u; }
    const size_t kstep = (size_t)(BK * 2);
    const size_t hstep = (size_t)HALF * K * 2;
    const size_t tstep = 2 * hstep;
    const unsigned ldsw = (unsigned)wid * 1024u;
    const int aoff = lds_byte(wr * 64 + fr, fq * 8), boff = lds_byte(wc * 32 + fr, fq * 8);
#define PG8_SA(b, h) (((b) * 2 + (h)) * HTB)
#define PG8_SB(b, h) ((4 + (b) * 2 + (h)) * HTB)
#define PG8_STAGE(bufoff, gbase, voff) do { _Pragma("unroll") for (int _i = 0; _i < 2; ++_i) \
        __builtin_amdgcn_global_load_lds((const unsigned*)((const char*)(gbase) + (voff)[_i]), (PG8_LAS unsigned*)(lds + (bufoff) + ldsw + _i * 8192), 16, 0, 0); } while (0)
#define PG8_LDA(dst, b, h) do { _Pragma("unroll") for (int m = 0; m < 4; ++m) _Pragma("unroll") for (int k = 0; k < 2; ++k) dst[m][k] = *(const PG8_LAS bf16x8*)(lds + PG8_SA(b, h) + aoff + m * 2048 + k * 1024); } while (0)
#define PG8_LDB(dst, b, h) do { _Pragma("unroll") for (int n = 0; n < 2; ++n) _Pragma("unroll") for (int k = 0; k < 2; ++k) dst[n][k] = *(const PG8_LAS bf16x8*)(lds + PG8_SB(b, h) + boff + n * 2048 + k * 1024); } while (0)
#define PG8_MMA(ai, bj, At, Bt) do { __builtin_amdgcn_s_setprio(1); _Pragma("unroll") for (int m = 0; m < 4; ++m) _Pragma("unroll") for (int n = 0; n < 2; ++n) _Pragma("unroll") for (int k = 0; k < 2; ++k) \
        acc[ai][bj][m][n] = __builtin_amdgcn_mfma_f32_16x16x32_bf16(Bt[n][k], At[m][k], acc[ai][bj][m][n], 0, 0, 0); __builtin_amdgcn_s_setprio(0); } while (0)
#define PG8_WAIT_V(n) asm volatile("s_waitcnt vmcnt(" #n ")" ::: "memory")
#define PG8_WAIT_L(n) asm volatile("s_waitcnt lgkmcnt(" #n ")" ::: "memory")
#define PG8_BAR __builtin_amdgcn_s_barrier()
#define PG8_SCHED __builtin_amdgcn_sched_barrier(0)
    Unit cur, nxt; int ui = 0;
    if (!S.next(0, cur)) return;
    f32x4 acc[2][2][4][2];
#pragma unroll
    for (int a = 0; a < 2; ++a)
#pragma unroll
        for (int b = 0; b < 2; ++b)
#pragma unroll
            for (int m = 0; m < 4; ++m)
#pragma unroll
                for (int n = 0; n < 2; ++n) acc[a][b][m][n] = (f32x4){0.f, 0.f, 0.f, 0.f};
    bf16x8 At[4][2], B0[2][2], B1[2][2];
    const char* cA = (const char*)g.A + (size_t)cur.pm * tstep + (size_t)cur.k0 * 2; const char* cB = (const char*)g.Bt + (size_t)cur.pn * tstep + (size_t)cur.k0 * 2;
    S.a_ready(cur);
    if constexpr (SP2) {
        PG8_STAGE(PG8_SB(0, 0), cB, voffB); PG8_STAGE(PG8_SB(0, 1), cB + hstep, voffB); PG8_STAGE(PG8_SA(0, 0), cA, voffA); PG8_STAGE(PG8_SA(0, 1), cA + hstep, voffA);
        if (wr == 1) PG8_BAR;
        PG8_WAIT_V(2); PG8_BAR;
        PG8_STAGE(PG8_SB(1, 0), cB + kstep, voffB); PG8_STAGE(PG8_SA(1, 0), cA + kstep, voffA); PG8_STAGE(PG8_SB(1, 1), cB + hstep + kstep, voffB);
        PG8_WAIT_V(6); PG8_BAR;
    } else {
        PG8_STAGE(PG8_SB(0, 0), cB, voffB); PG8_STAGE(PG8_SA(0, 0), cA, voffA); PG8_STAGE(PG8_SB(0, 1), cB + hstep, voffB); PG8_STAGE(PG8_SA(0, 1), cA + hstep, voffA);
        if (wr == 1) PG8_BAR;
        PG8_WAIT_V(4); PG8_BAR;
        PG8_STAGE(PG8_SB(1, 0), cB + kstep, voffB); PG8_STAGE(PG8_SA(1, 0), cA + kstep, voffA); PG8_STAGE(PG8_SB(1, 1), cB + hstep + kstep, voffB);
        PG8_WAIT_V(6); PG8_BAR;
    }
    for (;;) {
        const bool has_next = S.next(ui + 1, nxt);
        const char* nA = has_next ? (const char*)g.A + (size_t)nxt.pm * tstep + (size_t)nxt.k0 * 2 : cA; const char* nB = has_next ? (const char*)g.Bt + (size_t)nxt.pn * tstep + (size_t)nxt.k0 * 2 : cB;
        const int unt = cur.nt ? cur.nt : nt;
        for (int t = 0; t < unt; t += 2) {
            const bool last = (t == unt - 2);
            const char* a1 = cA + (size_t)(t + 1) * kstep;
            const char* a2 = last ? nA : cA + (size_t)(t + 2) * kstep; const char* b2 = last ? nB : cB + (size_t)(t + 2) * kstep;
            const char* a3 = a2 + kstep; const char* b3 = b2 + kstep;
            if (last && has_next) S.a_ready(nxt);
            if constexpr (SP2) {
            PG8_LDB(B0, 0, 0); PG8_LDB(B1, 0, 1); PG8_SCHED; PG8_LDA(At, 0, 0); PG8_STAGE(PG8_SA(1, 1), a1 + hstep, voffA);
            PG8_WAIT_V(8); PG8_WAIT_L(0); PG8_BAR; PG8_MMA(0, 0, At, B0); PG8_MMA(0, 1, At, B1); PG8_BAR; PG8_SCHED;
            PG8_LDA(At, 0, 1); PG8_STAGE(PG8_SB(0, 0), b2, voffB); PG8_STAGE(PG8_SB(0, 1), b2 + hstep, voffB); PG8_STAGE(PG8_SA(0, 0), a2, voffA);
            PG8_WAIT_V(8); PG8_WAIT_L(0); PG8_BAR; PG8_MMA(1, 0, At, B0); PG8_MMA(1, 1, At, B1); PG8_BAR; PG8_SCHED;
            PG8_LDB(B0, 1, 0); PG8_LDB(B1, 1, 1); PG8_SCHED; PG8_LDA(At, 1, 0); PG8_STAGE(PG8_SA(0, 1), a2 + hstep, voffA);
            PG8_WAIT_V(8); PG8_WAIT_L(0); PG8_BAR; PG8_MMA(0, 0, At, B0); PG8_MMA(0, 1, At, B1); PG8_BAR; PG8_SCHED;
            PG8_LDA(At, 1, 1); PG8_STAGE(PG8_SB(1, 0), b3, voffB); PG8_STAGE(PG8_SB(1, 1), b3 + hstep, voffB); PG8_STAGE(PG8_SA(1, 0), a3, voffA);
            PG8_WAIT_V(8); PG8_WAIT_L(0); PG8_BAR; PG8_MMA(1, 0, At, B0); PG8_MMA(1, 1, At, B1); PG8_BAR; PG8_SCHED;
            } else {
            PG8_LDB(B0, 0, 0); PG8_SCHED; PG8_LDA(At, 0, 0); PG8_STAGE(PG8_SA(1, 1), a1 + hstep, voffA);
            PG8_WAIT_L(8); PG8_BAR; PG8_WAIT_L(0); PG8_MMA(0, 0, At, B0); PG8_BAR; PG8_SCHED;
            PG8_LDB(B1, 0, 1); PG8_STAGE(PG8_SB(0, 0), b2, voffB);
            PG8_BAR; PG8_WAIT_L(0); PG8_MMA(0, 1, At, B1); PG8_BAR;
            PG8_LDA(At, 0, 1); PG8_STAGE(PG8_SA(0, 0), a2, voffA);
            PG8_BAR; PG8_WAIT_L(0); PG8_MMA(1, 0, At, B0); PG8_BAR; PG8_SCHED;
            PG8_STAGE(PG8_SB(0, 1), b2 + hstep, voffB);
            PG8_WAIT_V(6); PG8_BAR; PG8_MMA(1, 1, At, B1); PG8_BAR;
            PG8_LDB(B0, 1, 0); PG8_SCHED; PG8_LDA(At, 1, 0); PG8_STAGE(PG8_SA(0, 1), a2 + hstep, voffA);
            PG8_WAIT_L(8); PG8_BAR; PG8_WAIT_L(0); PG8_MMA(0, 0, At, B0); PG8_BAR; PG8_SCHED;
            PG8_LDB(B1, 1, 1); PG8_STAGE(PG8_SB(1, 0), b3, voffB);
            PG8_BAR; PG8_WAIT_L(0); PG8_MMA(0, 1, At, B1); PG8_BAR;
            PG8_LDA(At, 1, 1); PG8_STAGE(PG8_SA(1, 0), a3, voffA);
            PG8_BAR; PG8_WAIT_L(0); PG8_MMA(1, 0, At, B0); PG8_BAR; PG8_SCHED;
            PG8_STAGE(PG8_SB(1, 1), b3 + hstep, voffB);
            PG8_WAIT_V(6); PG8_BAR; PG8_MMA(1, 1, At, B1); PG8_BAR;
            }
        }
        if constexpr (ALIGN_EPI) { if (wr == 0) PG8_BAR; }
        if constexpr (!Epi::AFTER_DRAIN) { E(acc, cur, wr, wc, fr, fq); S.done(cur); }
        if (!has_next) break;
#pragma unroll
        for (int a = 0; a < 2; ++a)
#pragma unroll
            for (int b = 0; b < 2; ++b)
#pragma unroll
                for (int m = 0; m < 4; ++m)
#pragma unroll
                    for (int n = 0; n < 2; ++n) acc[a][b][m][n] = (f32x4){0.f, 0.f, 0.f, 0.f};
        cur = nxt; cA = nA; cB = nB; ++ui;
        if constexpr (ALIGN_EPI) { if (wr == 1) PG8_BAR; }
    }
    PG8_WAIT_V(0);
    if constexpr (!ALIGN_EPI) { if (wr == 0) PG8_BAR; }
    PG8_BAR;
    if constexpr (Epi::AFTER_DRAIN) { E.fused(acc, cur, wr, wc, fr, fq, lds, wid, lane); S.done(cur); }
#undef PG8_SA
#undef PG8_SB
#undef PG8_STAGE
#undef PG8_LDA
#undef PG8_LDB
#undef PG8_MMA
#undef PG8_WAIT_V
#undef PG8_WAIT_L
#undef PG8_BAR
#undef PG8_SCHED
}
}
#define GAS __attribute__((address_space(1)))
#define LAS __attribute__((address_space(3)))
typedef unsigned short bf16;
typedef unsigned v4u __attribute__((ext_vector_type(4)));
typedef unsigned v2u __attribute__((ext_vector_type(2)));
typedef float f32x4 __attribute__((ext_vector_type(4)));
typedef float f32x16 __attribute__((ext_vector_type(16)));
typedef short bf16x8 __attribute__((ext_vector_type(8)));
typedef short s16x4 __attribute__((ext_vector_type(4)));
typedef GAS unsigned gu32;
#define RLX_AGENT __ATOMIC_RELAXED, __HIP_MEMORY_SCOPE_AGENT
#define XB_TMO      128
#define XB_XCNT(j)  (256  + 64 * (j))
#define XB_XSUB(j)  (1280 + 64 * (j))
#define XB_XGEN(j)  (2304 + 64 * (j))
#define XB_TOP      3328
#define XB_TOPGEN   3392
#define XCD_BAR_WORDS 3456
#define XB_SPIN_CAP (1u << 18)

__device__ __forceinline__ unsigned xb_ld(unsigned* p)              { return __hip_atomic_load(p, __ATOMIC_RELAXED, __HIP_MEMORY_SCOPE_AGENT); }
__device__ __forceinline__ unsigned xb_add(unsigned* p, unsigned v) { return __hip_atomic_fetch_add(p, v, __ATOMIC_RELAXED, __HIP_MEMORY_SCOPE_AGENT); }
__device__ __forceinline__ unsigned xb_xcc_id() { return (unsigned)__builtin_amdgcn_s_getreg((3 << 11) | 20) & 0xFu; }
#define XB_SPIN(cond, bar) do { unsigned _sp = 0; while (cond) { __builtin_amdgcn_s_sleep(1); \
    if ((++_sp & 255u) == 0u) { if (xb_ld(&(bar)[XB_TMO])) break; if (_sp > XB_SPIN_CAP) { atomicAdd(&(bar)[XB_TMO], 1u); break; } } } } while (0)

struct XcdBarrier {
    unsigned* bar; unsigned x;
    volatile LAS unsigned* st;
};

__device__ __forceinline__ XcdBarrier xcd_barrier_post(unsigned* bar, volatile LAS unsigned* st) {
    XcdBarrier b; b.bar = bar; b.x = xb_xcc_id(); b.st = st;
    if (threadIdx.x == 0) (void)xb_add(&bar[XB_XCNT(b.x)], 1u);
    return b;
}
__device__ __forceinline__ void xcd_barrier_complete(unsigned* bar, unsigned x, unsigned& nloc, unsigned& nx) {
    const unsigned G = gridDim.x * gridDim.y * gridDim.z;
    unsigned sum, cnt, mine, sp = 0u;
    for (;;) {
        sum = 0u; cnt = 0u; mine = 0u;
#pragma unroll
        for (unsigned j = 0; j < 16; ++j) { const unsigned c = xb_ld(&bar[XB_XCNT(j)]); sum += c; cnt += (c > 0u) ? 1u : 0u; mine = (j == x) ? c : mine; }
        if (sum == G) break;
        __builtin_amdgcn_s_sleep(1);
        if ((++sp & 255u) == 0u) { if (xb_ld(&bar[XB_TMO])) break; if (sp > XB_SPIN_CAP) { atomicAdd(&bar[XB_TMO], 1u); break; } }
    }
    nloc = mine > 0u ? mine : 1u; nx = cnt > 0u ? cnt : 1u;
}

__device__ __forceinline__ void xcd_barrier(const XcdBarrier& b) {
    asm volatile("s_waitcnt vmcnt(0)" ::: "memory");
    __syncthreads();
    if (threadIdx.x == 0) {
        unsigned* bar = b.bar;
        __builtin_amdgcn_s_waitcnt(0);
        unsigned nloc = b.st[0], nx = b.st[1];
        if (nloc == 0u) { xcd_barrier_complete(bar, b.x, nloc, nx); b.st[0] = nloc; b.st[1] = nx; }
        const unsigned old = xb_add(&bar[XB_XSUB(b.x)], 1u);
        const unsigned gen = old / nloc;
        if (old + 1u == (gen + 1u) * nloc) {
            __builtin_amdgcn_fence(__ATOMIC_RELEASE, "agent");
            asm volatile("s_waitcnt vmcnt(0)" ::: "memory");
            const unsigned og = xb_add(&bar[XB_TOP], 1u);
            const unsigned tg = og / nx;
            if (og + 1u == (tg + 1u) * nx) xb_add(&bar[XB_TOPGEN], 1u);
            else XB_SPIN(xb_ld(&bar[XB_TOPGEN]) == tg, bar);
            __builtin_amdgcn_fence(__ATOMIC_ACQUIRE, "agent");
            xb_add(&bar[XB_XGEN(b.x)], 1u);
            asm volatile("s_waitcnt vmcnt(0)" ::: "memory");
        } else {
            XB_SPIN(xb_ld(&bar[XB_XGEN(b.x)]) == gen, bar);
            __builtin_amdgcn_fence(__ATOMIC_ACQUIRE, "agent");
            asm volatile("s_waitcnt vmcnt(0)" ::: "memory");
        }
    }
    __syncthreads();
}
#ifndef ONE_LAUNCH
#define ONE_LAUNCH 1
#endif
#ifndef NLAYERS
#define NLAYERS 4
#endif
constexpr int DM = 2048, MR = 8704, NLATR = 8192;
constexpr int NINP = 6400, DFF = 5632, NUP = 11264, EVIN = 6176, ODIN = 6160;
constexpr int NWAVES = 8, NTHR = 512;
constexpr float EPS = 1e-6f;
constexpr int NCHUNK = 68;
constexpr int PPL = 11, NPH = 1 + 4 * PPL;
constexpr size_t MiB = 1ull << 20;
constexpr size_t WS_CTL = 0, CTL_BYTES = 1 * MiB;
constexpr size_t WS_MOD = 1 * MiB, WS_ROPE = 1 * MiB + 640 * 1024;
constexpr size_t WS_W = 4 * MiB, W_LAYER = 99 * MiB, W_OUT = 25 * MiB, W_UP = 33 * MiB, W_DN = 77 * MiB;
constexpr size_t WS_XS = 400 * MiB, WS_H = 468 * MiB, WS_MIX = 502 * MiB, WS_P = 536 * MiB, WS_U = 644 * MiB, WS_ACT = 832 * MiB;
constexpr size_t WS_QR = 926 * MiB, WS_KR = 943 * MiB, WS_MQK = 960 * MiB, WS_DST = 977 * MiB, WS_SST = 1113 * MiB, WS_SM = 1181 * MiB, WS_END = 1186 * MiB;
constexpr size_t SM_GAM = 0, SM_DN = 1 * MiB, SM_NIN = 2 * MiB, SM_BL = 3 * MiB, SM_ML = 3 * MiB + 8192, SM_MIN = 3 * MiB + 16384;
constexpr int CW_BAR = 4096;
constexpr int LDS_BYTES = 147456, MISC_OFF = 131072 + 320;

struct Args { const float* in[27]; float* out; unsigned char* ws; int ph_lo, ph_hi, li, pad; };

__device__ __forceinline__ float bf_lo(unsigned u) { return __builtin_bit_cast(float, u << 16); }
__device__ __forceinline__ float bf_hi(unsigned u) { return __builtin_bit_cast(float, u & 0xffff0000u); }
__device__ __forceinline__ float bf1(bf16 b) { return __builtin_bit_cast(float, (unsigned)b << 16); }
typedef float f32x2_t __attribute__((ext_vector_type(2))); typedef __bf16 bf16x2_t __attribute__((ext_vector_type(2)));
__device__ __forceinline__ unsigned pk2(float lo, float hi) { f32x2_t v = {lo, hi}; bf16x2_t b = __builtin_convertvector(v, bf16x2_t); return __builtin_bit_cast(unsigned, b); }
__device__ __forceinline__ bf16 f2bf(float f) { return (bf16)(pk2(f, 0.f) & 0xffffu); }
__device__ __forceinline__ void unpack8(const v4u w, float (&f)[8]) { f[0] = bf_lo(w.x); f[1] = bf_hi(w.x); f[2] = bf_lo(w.y); f[3] = bf_hi(w.y); f[4] = bf_lo(w.z); f[5] = bf_hi(w.z); f[6] = bf_lo(w.w); f[7] = bf_hi(w.w); }
__device__ __forceinline__ v4u pack8(const float (&f)[8]) { v4u w; w.x = pk2(f[0], f[1]); w.y = pk2(f[2], f[3]); w.z = pk2(f[4], f[5]); w.w = pk2(f[6], f[7]); return w; }
__device__ __forceinline__ float silu_f(float x) { return x / (1.f + __expf(-x)); }
__device__ __forceinline__ float sigmoid_f(float x) { return 1.f / (1.f + __expf(-x)); }
__device__ __forceinline__ float logsig_f(float z) { return fminf(z, 0.f) - log1pf(__expf(-fabsf(z))); }
__device__ __forceinline__ float wave_sum(float v) {
#pragma unroll
    for (int o = 1; o < 64; o <<= 1) v += __shfl_xor(v, o);
    return v;
}
__device__ __forceinline__ float wave_max(float v) {
#pragma unroll
    for (int o = 1; o < 64; o <<= 1) v = fmaxf(v, __shfl_xor(v, o));
    return v;
}
__device__ __forceinline__ float wave_scan_sum(float v, int dir, int lane) {
#pragma unroll
    for (int o = 1; o < 64; o <<= 1) { const float up = __shfl_up(v, o), dn = __shfl_down(v, o); if (dir == 0) { if (lane >= o) v += up; } else { if (lane + o < 64) v += dn; } }
    return v;
}
__device__ __forceinline__ float wave_scan_max(float v, int dir, int lane) {
#pragma unroll
    for (int o = 1; o < 64; o <<= 1) { const float up = __shfl_up(v, o), dn = __shfl_down(v, o); if (dir == 0) { if (lane >= o) v = fmaxf(v, up); } else { if (lane + o < 64) v = fmaxf(v, dn); } }
    return v;
}
__device__ __forceinline__ bool seq_start(int r) { return r < NLATR ? (r & 4095) == 0 : ((r - NLATR) & 255) == 0; }

__device__ __forceinline__ bf16x8 frag_row(LAS const unsigned char* base, int stride, int row0, int k0, int lane) {
    return *(LAS const bf16x8*)(base + (row0 + (lane & 31)) * stride + (k0 + 8 * (lane >> 5)) * 2);
}
__device__ __forceinline__ s16x4 tr4(LAS const unsigned char* p) { return __builtin_amdgcn_ds_read_tr16_b64_v4i16((LAS s16x4*)p); }
__device__ __forceinline__ bf16x8 frag_tr(LAS const unsigned char* base, int stride, int k0, int col0, int lane) {
    const int h = lane >> 5, blk = (lane >> 4) & 1, q = (lane & 15) >> 2, p = lane & 3;
    LAS const unsigned char* a = base + (k0 + 8 * h + q) * stride + (col0 + 16 * blk + 4 * p) * 2;
    const s16x4 lo = tr4(a), hi = tr4(a + 4 * stride);
    return (bf16x8){lo[0], lo[1], lo[2], lo[3], hi[0], hi[1], hi[2], hi[3]};
}
__device__ __forceinline__ bf16x8 frag_tr_perm(LAS const unsigned char* base, int stride, int k0, int col0, int lane) {
    const int h = lane >> 5, blk = (lane >> 4) & 1, q = (lane & 15) >> 2, p = lane & 3;
    LAS const unsigned char* a = base + (k0 + 4 * h + q) * stride + (col0 + 16 * blk + 4 * p) * 2;
    const s16x4 lo = tr4(a), hi = tr4(a + 8 * stride);
    return (bf16x8){lo[0], lo[1], lo[2], lo[3], hi[0], hi[1], hi[2], hi[3]};
}
#define MFMA32(a, b, c) __builtin_amdgcn_mfma_f32_32x32x16_bf16((a), (b), (c), 0, 0, 0)
__device__ __forceinline__ f32x16 zero16() { f32x16 z;
#pragma unroll
    for (int i = 0; i < 16; ++i) z[i] = 0.f;
    return z; }
__device__ __forceinline__ void load_tile(LAS unsigned char* dst, int ls, const bf16* src, size_t ld, int rows, int cols, int tid) {
    const int cpr = cols >> 3, n = rows * cpr;
    for (int c = tid; c < n; c += NTHR) { const int r = c / cpr, cc = c - r * cpr; *(LAS v4u*)(dst + r * ls + cc * 16) = *(const v4u*)(src + (size_t)r * ld + cc * 8); }
}

struct TrItem { const float* W; bf16* WT; int K, N, k0, n0, dn0; };
__device__ __forceinline__ void tr_issue(const TrItem& t, f32x4 (&v)[8], int lane) {
    const int n = t.n0 + 4 * (lane & 7);
#pragma unroll
    for (int i = 0; i < 8; ++i) { const int kk = 8 * i + (lane >> 3); v[i] = n < t.N ? *(const f32x4*)(t.W + (size_t)(t.k0 + kk) * t.N + n) : (f32x4){0.f, 0.f, 0.f, 0.f}; }
}
__device__ __forceinline__ void tr_finish(const TrItem& t, const f32x4 (&v)[8], LAS float* scr, int lane) {
#pragma unroll
    for (int i = 0; i < 8; ++i) { const int kk = 8 * i + (lane >> 3); LAS float* d = scr + kk * 33 + 4 * (lane & 7); d[0] = v[i].x; d[1] = v[i].y; d[2] = v[i].z; d[3] = v[i].w; }
    asm volatile("s_waitcnt lgkmcnt(0)" ::: "memory");
    const int c = lane & 7;
#pragma unroll
    for (int j = 0; j < 4; ++j) { const int nn = (lane >> 3) + 8 * j; const LAS float* s = scr + (8 * c) * 33 + nn;
        v4u o; o.x = pk2(s[0 * 33], s[1 * 33]); o.y = pk2(s[2 * 33], s[3 * 33]); o.z = pk2(s[4 * 33], s[5 * 33]); o.w = pk2(s[6 * 33], s[7 * 33]);
        *(v4u*)(t.WT + (size_t)(t.dn0 + nn) * t.K + t.k0 + 8 * c) = o; }
    asm volatile("s_waitcnt lgkmcnt(0)" ::: "memory");
}
__device__ __forceinline__ void tr_decode(const Args& a, unsigned char* ws, int g, TrItem& t) {
    const int layer = g / 25344; int r = g - layer * 25344; const int li = layer >> 1;
    unsigned char* wb = ws + WS_W + (size_t)layer * W_LAYER;
    int nblk;
    if (r < 6400) { if (layer & 1) { t.W = a.in[14] + (size_t)li * DM * ODIN; t.N = ODIN; } else { t.W = a.in[8] + (size_t)li * DM * EVIN; t.N = EVIN; } t.WT = (bf16*)wb; t.K = DM; nblk = NINP / 32; }
    else if ((r -= 6400) < 2048) { t.W = (layer & 1 ? a.in[15] : a.in[9]) + (size_t)li * DM * DM; t.N = DM; t.WT = (bf16*)(wb + W_OUT); t.K = DM; nblk = DM / 32; }
    else if ((r -= 2048) < 11264) { t.W = a.in[23] + (size_t)layer * DM * NUP; t.N = NUP; t.WT = (bf16*)(wb + W_UP); t.K = DM; nblk = NUP / 32; }
    else { r -= 11264; t.W = a.in[26] + (size_t)layer * DFF * DM; t.N = DM; t.WT = (bf16*)(wb + W_DN); t.K = DFF; nblk = DM / 32; }
    const int kb = r / nblk, nb = r - kb * nblk; t.k0 = 64 * kb; t.n0 = 32 * nb; t.dn0 = t.n0;
    if (t.N == NUP) { const int m0 = t.n0 < DFF ? t.n0 : t.n0 - DFF; t.dn0 = 256 * (m0 >> 7) + (t.n0 < DFF ? 0 : 128) + (m0 & 127); }
}
__device__ __forceinline__ void ph_convert(const Args& a, unsigned char* ws, LAS unsigned char* lds, int g_lo, int g_hi, int w, int nw, int wave, int lane) {
    LAS float* scr = (LAS float*)(lds + wave * 8448);
    TrItem cur, nxt; f32x4 va[8], vb[8];
    int g = g_lo + w;
    if (g < g_hi) { tr_decode(a, ws, g, cur); tr_issue(cur, va, lane); }
    while (g < g_hi) {
        const int g1 = g + nw; if (g1 < g_hi) { tr_decode(a, ws, g1, nxt); tr_issue(nxt, vb, lane); }
        tr_finish(cur, va, scr, lane);
        const int g2 = g1 + nw; if (g1 < g_hi) { if (g2 < g_hi) { tr_decode(a, ws, g2, cur); tr_issue(cur, va, lane); } tr_finish(nxt, vb, scr, lane); }
        g = g2;
    }
}
__device__ __forceinline__ void ph_prologue(const Args& a, unsigned char* ws, LAS unsigned char* lds, int tid, int lane, int wave, int bid, int G) {
    float* MOD = (float*)(ws + WS_MOD);
    LAS float* vec = (LAS float*)(lds + 73728);
    LAS float* red = (LAS float*)(lds + 98304);
    for (int e = tid; e < 3 * DM; e += NTHR) { const float v = e < 2 * DM ? a.in[1][e] : a.in[3][e - 2 * DM]; vec[e] = silu_f(v); }
    __syncthreads();
    for (int it = bid; it < 4 * 192; it += G) {
        const int layer = it / 192, cg = it - layer * 192, col = cg * 64 + 4 * (lane & 15), rq = lane >> 4;
        const float* W = a.in[4] + (size_t)layer * DM * 12288 + col;
        f32x4 a0 = {0.f, 0.f, 0.f, 0.f}, a1 = a0, a2 = a0;
#pragma unroll 16
        for (int i = 0; i < 64; ++i) { const int kk = 256 * wave + 4 * i + rq; const f32x4 w4 = *(const f32x4*)(W + (size_t)kk * 12288);
            a0 += w4 * vec[kk]; a1 += w4 * vec[DM + kk]; a2 += w4 * vec[2 * DM + kk]; }
#pragma unroll
        for (int e = 0; e < 4; ++e) { a0[e] += __shfl_xor(a0[e], 16); a0[e] += __shfl_xor(a0[e], 32); a1[e] += __shfl_xor(a1[e], 16); a1[e] += __shfl_xor(a1[e], 32); a2[e] += __shfl_xor(a2[e], 16); a2[e] += __shfl_xor(a2[e], 32); }
        if (lane < 16) { *(LAS f32x4*)(red + (wave * 3 + 0) * 64 + 4 * lane) = a0; *(LAS f32x4*)(red + (wave * 3 + 1) * 64 + 4 * lane) = a1; *(LAS f32x4*)(red + (wave * 3 + 2) * 64 + 4 * lane) = a2; }
        __syncthreads();
        if (tid < 192) { const int j = tid >> 6, c = tid & 63; float s = a.in[5][layer * 12288 + cg * 64 + c];
#pragma unroll
            for (int w = 0; w < 8; ++w) s += red[(w * 3 + j) * 64 + c];
            MOD[(size_t)(layer * 3 + j) * 12288 + cg * 64 + c] = s; }
        __syncthreads();
    }
    if (bid == G - 1) { float* rope = (float*)(ws + WS_ROPE);
        for (int e = tid; e < 1024; e += NTHR) { const int pos = e >> 4, f = e & 15; const float inv = powf(10000.f, -(float)f / 16.f), ang = (float)pos * inv; rope[e] = cosf(ang); rope[1024 + e] = sinf(ang); } }
    { f32x4* XS = (f32x4*)(ws + WS_XS); const f32x4* x4 = (const f32x4*)a.in[0]; const f32x4* c4 = (const f32x4*)a.in[2];
      const int nl = NLATR * DM / 4, nt = MR * DM / 4, NTt = G * NTHR;
      for (int e = bid * NTHR + tid; e < nt; e += 2 * NTt) { const int e1 = e + NTt; const f32x4 v0 = e < nl ? x4[e] : c4[e - nl]; f32x4 v1 = v0; if (e1 < nt) v1 = e1 < nl ? x4[e1] : c4[e1 - nl]; XS[e] = v0; if (e1 < nt) XS[e1] = v1; } }
    ph_convert(a, ws, lds, 0, 25344, bid * NWAVES + wave, G * NWAVES, wave, lane);
}

__device__ __forceinline__ void norm_row(float* XS, const float* ng, const float* msh, const float* msc, bf16* H, int row, int lane, const float* part, const float* pgate, int nsplit) {
    const int mi = row < NLATR ? (row >> 12) : 2;
    f32x4* xr = (f32x4*)(XS + (size_t)row * DM) + lane;
    f32x4 v[8];
#pragma unroll
    for (int j = 0; j < 8; ++j) v[j] = xr[64 * j];
    if (row >= NLATR && nsplit > 0) {
        f32x4 sacc[8];
#pragma unroll
        for (int j = 0; j < 8; ++j) sacc[j] = (f32x4){0.f, 0.f, 0.f, 0.f};
        for (int sp = 0; sp < nsplit; ++sp) { const f32x4* pr = (const f32x4*)(part + ((size_t)sp * 512 + (row - NLATR)) * DM) + lane;
#pragma unroll
            for (int j = 0; j < 8; ++j) sacc[j] += pr[64 * j]; }
#pragma unroll
        for (int j = 0; j < 8; ++j) { v[j] += *(const f32x4*)(pgate + 4 * lane + 256 * j) * sacc[j]; xr[64 * j] = v[j]; }
    }
    float ss = 0.f;
#pragma unroll
    for (int j = 0; j < 8; ++j) ss += (v[j].x * v[j].x + v[j].y * v[j].y) + (v[j].z * v[j].z + v[j].w * v[j].w);
    const float r = rsqrtf(wave_sum(ss) * (1.f / DM) + EPS);
#pragma unroll
    for (int j = 0; j < 8; ++j) { const int col = 4 * lane + 256 * j;
        const f32x4 g4 = *(const f32x4*)(ng + col), sc4 = *(const f32x4*)(msc + (size_t)mi * 12288 + col), sh4 = *(const f32x4*)(msh + (size_t)mi * 12288 + col);
        const f32x4 y = v[j] * r * g4 * (sc4 + 1.f) + sh4;
        v2u o; o.x = pk2(y.x, y.y); o.y = pk2(y.z, y.w);
        *(v2u*)(H + (size_t)row * DM + col) = o; }
}
__device__ __forceinline__ void ph_norm(float* XS, const float* ng, const float* msh, const float* msc, bf16* H, int gw, int NGW, int lane, const float* part, const float* pgate, int nsplit) {
    for (int cr = gw; cr < 2048; cr += NGW) if ((cr & 3) == 0) norm_row(XS, ng, msh, msc, H, NLATR + (cr >> 2), lane, part, pgate, nsplit);
    for (int row = gw; row < NLATR; row += NGW) norm_row(XS, ng, msh, msc, H, row, lane, part, pgate, 0);
}

template <int MODE>
__device__ __forceinline__ void ph_conv(const bf16* SRC, const float* cw, const float* cb, bf16* DST, int gtid, int NT) {
    constexpr int NC = MODE == 0 ? DFF : 1024, NCG = NC / 8, NRB = MR / 16;
    constexpr int LDS_ = MODE == 0 ? NUP : NINP, LDD = MODE == 0 ? DFF : (MODE == 1 ? DM : 1024);
    for (int it = gtid; it < NRB * NCG; it += NT) {
        const int rb = it / NCG, cg = it - rb * NCG, r0 = rb * 16, c0 = cg * 8;
        float w0[8], w1[8], w2[8], bb[8];
#pragma unroll
        for (int j = 0; j < 8; ++j) { w0[j] = cw[c0 + j]; w1[j] = cw[NC + c0 + j]; w2[j] = cw[2 * NC + c0 + j]; bb[j] = MODE == 0 ? cb[c0 + j] : 0.f; }
        auto ld = [&](int r, float (&f)[8]) {
            if (MODE == 0) { unpack8(*(const v4u*)(SRC + (size_t)r * LDS_ + c0), f); }
            else if (MODE == 1) { float s1[8], s2[8]; unpack8(*(const v4u*)(SRC + (size_t)r * LDS_ + 3104 + c0), s1); unpack8(*(const v4u*)(SRC + (size_t)r * LDS_ + 5152 + c0), s2);
#pragma unroll
                for (int j = 0; j < 8; ++j) f[j] = s1[j] * s2[j]; }
            else { unpack8(*(const v4u*)(SRC + (size_t)r * LDS_ + 3072 + c0), f); }
        };
        float prev[8], cur[8], nxt[8];
        if (!seq_start(r0)) ld(r0 - 1, prev); else {
#pragma unroll
            for (int j = 0; j < 8; ++j) prev[j] = 0.f; }
        ld(r0, cur);
#pragma unroll 2
        for (int i = 0; i < 16; ++i) {
            const int r = r0 + i;
            if (i < 15 || !seq_start(r0 + 16)) ld(r + 1, nxt); else {
#pragma unroll
                for (int j = 0; j < 8; ++j) nxt[j] = 0.f; }
            float o[8];
            if (MODE == 0) { float vv[8]; unpack8(*(const v4u*)(SRC + (size_t)r * LDS_ + DFF + c0), vv);
#pragma unroll
                for (int j = 0; j < 8; ++j) o[j] = silu_f(w0[j] * prev[j] + w1[j] * cur[j] + w2[j] * nxt[j] + bb[j]) * vv[j]; }
            else if (MODE == 1) { float vv[8]; unpack8(*(const v4u*)(SRC + (size_t)r * LDS_ + 4128 + c0), vv);
#pragma unroll
                for (int j = 0; j < 8; ++j) o[j] = (w0[j] * prev[j] + w1[j] * cur[j] + w2[j] * nxt[j]) * vv[j]; }
            else { const float sc = c0 >= 512 ? 0.08838834764831845f : 1.f;
#pragma unroll
                for (int j = 0; j < 8; ++j) o[j] = silu_f(w0[j] * prev[j] + w1[j] * cur[j] + w2[j] * nxt[j]) * sc; }
            *(v4u*)(DST + (size_t)r * LDD + (MODE == 1 ? 1024 : 0) + c0) = pack8(o);
#pragma unroll
            for (int j = 0; j < 8; ++j) { prev[j] = cur[j]; cur[j] = nxt[j]; }
        }
    }
}

__device__ __forceinline__ void ph_act_fix(const float* halo, const float* cw, bf16* ACT, int gtid, int NT) {
    for (int e = gtid; e < 34 * 44 * 256; e += NT) {
        const int ch = e & 127, which = (e >> 7) & 1, tile = e >> 8, pm = tile / 44, pn = tile - pm * 44, chg = pn * 128 + ch;
        const float* hb = halo + (size_t)tile * 768;
        const int row = 256 * pm + (which ? 255 : 0);
        float g = 0.f;
        if (which == 0) { if (!seq_start(row)) g = halo[(size_t)(tile - 44) * 768 + 128 + ch] * cw[chg]; }
        else { if (!seq_start(row + 1)) g = halo[(size_t)(tile + 44) * 768 + ch] * cw[2 * DFF + chg]; }
        const float cv = hb[(2 + which) * 128 + ch] + g;
        ACT[(size_t)row * DFF + chg] = f2bf(silu_f(cv) * hb[(4 + which) * 128 + ch]);
    }
}

__device__ __forceinline__ void ph_qkprep(const bf16* P, const float* qg, const float* kg, const float* rope, bf16* QR, bf16* KR, int gw, int NGW, int lane) {
    for (int it = gw; it < MR * 4; it += NGW) {
        const int row = it >> 2, qtr = it & 3, isk = qtr >> 1;
        float x[8]; unpack8(*(const v4u*)(P + (size_t)row * NINP + isk * 1024 + (qtr & 1) * 512 + 8 * lane), x);
        float ss = 0.f;
#pragma unroll
        for (int j = 0; j < 8; ++j) ss += x[j] * x[j];
        ss += __shfl_xor(ss, 1); ss += __shfl_xor(ss, 2); ss += __shfl_xor(ss, 4);
        const float r = rsqrtf(ss * (1.f / 64.f) + EPS);
        const int i = lane & 7; const float* gp = (isk ? kg : qg) + 8 * i;
        float y[8], o[8];
#pragma unroll
        for (int j = 0; j < 8; ++j) y[j] = x[j] * r * gp[j];
        if (row < NLATR) {
            const int t = row & 4095, pos = (i < 4) ? (t >> 6) : (t & 63), f0 = 8 * (i & 1);
#pragma unroll
            for (int j = 0; j < 8; ++j) { const float pj = __shfl_xor(y[j], 2), c = rope[pos * 16 + f0 + j], s = rope[1024 + pos * 16 + f0 + j];
                o[j] = (i & 2) ? (pj * s + y[j] * c) : (y[j] * c - pj * s); }
        } else {
#pragma unroll
            for (int j = 0; j < 8; ++j) o[j] = y[j]; }
        if (!isk) {
#pragma unroll
            for (int j = 0; j < 8; ++j) o[j] *= 0.18033688011112042f; }
        *(v4u*)((isk ? KR : QR) + (size_t)row * 1024 + (qtr & 1) * 512 + 8 * lane) = pack8(o);
    }
}

struct ScanP {
    const bf16* P; const bf16* MQK; bf16* MIX;
    const float* gw2; const float* gb;
    const float* mgb;
    const float* ng;
    float* DSTp; bf16* SSTp; float* GAM; float* DN; float* NIN; float* BL; float* ML; float* MINp;
};
__device__ __forceinline__ void scan_unit(int u, int& b, int& head, int& mm, int& rowbase) {
    b = u / 272; const int rem = u - b * 272; head = rem / 68; mm = rem - head * 68;
    rowbase = mm < 4 ? NLATR + b * 256 + 64 * mm : b * 4096 + 64 * (mm - 4);
}
__device__ __forceinline__ int scan_chunk(int mm, int dir) { return dir ? (mm < 4 ? 3 - mm : 71 - mm) : mm; }

__device__ __forceinline__ void gla_gates(const ScanP& s, LAS const float* glr, LAS float* tot, int head, int dir, int tid, float (&bb)[16], float& btot) {
    const int dk = tid & 127, grp = tid >> 7;
    float w2[16];
#pragma unroll
    for (int r = 0; r < 16; ++r) w2[r] = s.gw2[(dir * 16 + r) * 512 + head * 128 + dk];
    const float bias = s.gb[dir * 512 + head * 128 + dk];
#pragma unroll
    for (int tt = 0; tt < 16; ++tt) { const int t = 16 * grp + tt; float z = bias;
#pragma unroll
        for (int r = 0; r < 16; ++r) z += glr[t * 32 + dir * 16 + r] * w2[r];
        bb[tt] = logsig_f(z) * 0.0625f; }
    if (dir == 0) {
#pragma unroll
        for (int tt = 1; tt < 16; ++tt) bb[tt] += bb[tt - 1];
        tot[grp * 128 + dk] = bb[15];
    } else {
#pragma unroll
        for (int tt = 14; tt >= 0; --tt) bb[tt] += bb[tt + 1];
        tot[grp * 128 + dk] = bb[0];
    }
    __syncthreads();
    float off = 0.f; btot = 0.f;
#pragma unroll
    for (int g = 0; g < 4; ++g) { const float tv = tot[g * 128 + dk]; btot += tv; if (dir == 0 ? g < grp : g > grp) off += tv; }
#pragma unroll
    for (int tt = 0; tt < 16; ++tt) bb[tt] += off;
}

template <int MODE>
__device__ __forceinline__ void ph_scan_local(const ScanP& s, LAS unsigned char* lds, int tid, int lane, int wave, int bid, int G) {
    LAS unsigned char* Vs = lds; LAS unsigned char* Kh = lds + 33792;
    LAS float* glr = (LAS float*)(lds + 51200); LAS float* tot = (LAS float*)(lds + 59392); LAS float* wv = (LAS float*)(lds + 61440); LAS float* dnp = (LAS float*)(lds + 61696);
    const int dk = tid & 127, grp = tid >> 7;
    for (int u = bid; u < 544; u += G) {
        int b, head, mm, rowbase; scan_unit(u, b, head, mm, rowbase);
        load_tile(Vs, 528, s.P + (size_t)rowbase * NINP + (MODE ? 4096 : 1024) + head * 256, NINP, 64, 256, tid);
        if (MODE == 0) for (int e = tid; e < 2048; e += NTHR) glr[e] = bf1(s.P[(size_t)(rowbase + (e >> 5)) * NINP + 3072 + (e & 31)]);
        __syncthreads();
        for (int dir = 0; dir < 2; ++dir) {
            const int chain = (b * 4 + head) * 2 + dir, c = scan_chunk(mm, dir); const size_t cc = (size_t)chain * NCHUNK + c;
            if (MODE == 0) {
                float bb[16], btot; gla_gates(s, glr, tot, head, dir, tid, bb, btot);
#pragma unroll
                for (int tt = 0; tt < 16; ++tt) { const int t = 16 * grp + tt; const float kv = bf1(s.P[(size_t)(rowbase + t) * NINP + 512 + head * 128 + dk]) * __expf(btot - bb[tt]);
                    *(LAS bf16*)(Kh + t * 272 + dk * 2) = f2bf(kv); }
                if (grp == 0) s.GAM[cc * 128 + dk] = __expf(btot);
            } else {
                if (wave == 0) {
                    const float ig = bf1(s.P[(size_t)(rowbase + lane) * NINP + 6144 + dir * 8 + head]) + s.mgb[dir * 8 + head];
                    const float fg = bf1(s.P[(size_t)(rowbase + lane) * NINP + 6144 + dir * 8 + 4 + head]) + s.mgb[dir * 8 + 4 + head];
                    const float lf = logsig_f(fg), bcs = wave_scan_sum(lf, dir, lane), blast = wave_sum(lf);
                    const float gs = blast - bcs + ig, mloc = wave_max(gs);
                    wv[lane] = __expf(gs - mloc);
                    if (lane == 0) { s.BL[cc] = blast; s.ML[cc] = mloc; }
                }
                __syncthreads();
                float part = 0.f;
#pragma unroll
                for (int tt = 0; tt < 16; ++tt) { const int t = 16 * grp + tt; const float kv = bf1(s.MQK[(size_t)(rowbase + t) * 1024 + 512 + head * 128 + dk]) * wv[t];
                    *(LAS bf16*)(Kh + t * 272 + dk * 2) = f2bf(kv); part += kv; }
                dnp[grp * 128 + dk] = part;
            }
            __syncthreads();
            if (MODE == 1 && tid < 128) s.DN[cc * 128 + tid] = (dnp[tid] + dnp[128 + tid]) + (dnp[256 + tid] + dnp[384 + tid]);
            f32x16 acc[4];
#pragma unroll
            for (int nt = 0; nt < 4; ++nt) acc[nt] = zero16();
#pragma unroll
            for (int ks = 0; ks < 4; ++ks) { const bf16x8 af = frag_tr(Vs, 528, 16 * ks, 32 * wave, lane);
#pragma unroll
                for (int nt = 0; nt < 4; ++nt) { const bf16x8 bfr = frag_tr(Kh, 272, 16 * ks, 32 * nt, lane); acc[nt] = MFMA32(af, bfr, acc[nt]); } }
            float* D = s.DSTp + cc * 32768;
#pragma unroll
            for (int nt = 0; nt < 4; ++nt)
#pragma unroll
                for (int r = 0; r < 16; ++r) { const int dv = 32 * wave + (r & 3) + 8 * (r >> 2) + 4 * (lane >> 5); D[dv * 128 + 32 * nt + (lane & 31)] = acc[nt][r]; }
            __syncthreads();
        }
    }
}

template <int MODE>
__device__ __forceinline__ void ph_scan_carry(const ScanP& s, int gtid, int NT) {
    for (int e = gtid; e < 16 * 8192; e += NT) {
        const int chain = e >> 13, rem = e & 8191, dv = rem >> 5, dk = (rem & 31) * 4;
        f32x4 st = {0.f, 0.f, 0.f, 0.f}, nst = st; float m = 0.f;
        for (int c0 = 0; c0 < NCHUNK; c0 += 4) {
            f32x4 d[4], gm[4]; float bl[4], ml[4];
#pragma unroll
            for (int j = 0; j < 4; ++j) { const size_t cc = (size_t)chain * NCHUNK + c0 + j; d[j] = *(const f32x4*)(s.DSTp + cc * 32768 + dv * 128 + dk);
                if (MODE == 0) gm[j] = *(const f32x4*)(s.GAM + cc * 128 + dk);
                else { bl[j] = s.BL[cc]; ml[j] = s.ML[cc]; gm[j] = (dv == 0) ? *(const f32x4*)(s.DN + cc * 128 + dk) : (f32x4){0.f, 0.f, 0.f, 0.f}; } }
#pragma unroll
            for (int j = 0; j < 4; ++j) { const size_t cc = (size_t)chain * NCHUNK + c0 + j;
                v2u o; o.x = pk2(st.x, st.y); o.y = pk2(st.z, st.w); *(v2u*)(s.SSTp + cc * 32768 + dv * 128 + dk) = o;
                if (MODE == 0) st = gm[j] * st + d[j];
                else { if (dv == 0) { *(f32x4*)(s.NIN + cc * 128 + dk) = nst; if (dk == 0) s.MINp[cc] = m; }
                    const float mn = fmaxf(bl[j] + m, ml[j]), dec = __expf(bl[j] + m - mn), sc = __expf(ml[j] - mn);
                    st = st * dec + d[j] * sc; nst = nst * dec + gm[j] * sc; m = mn; } }
        }
    }
}

template <int MODE>
__device__ __forceinline__ void ph_scan_out(const ScanP& s, LAS unsigned char* lds, int tid, int lane, int wave, int bid, int G) {
    LAS unsigned char* Vs = lds; LAS unsigned char* Qx = lds + 33792; LAS unsigned char* Ki = lds + 51200; LAS unsigned char* Qi = lds + 68608; LAS unsigned char* Am = lds + 86016;
    LAS float* glr = (LAS float*)(lds + 95232); LAS float* tot = (LAS float*)(lds + 103424);
    LAS float* us = (LAS float*)(lds + 105472); LAS float* Mts = us + 64; LAS float* wint = us + 128; LAS float* thr = us + 192; LAS float* fac = us + 256; LAS float* qn = us + 320; LAS float* rs = us + 384;
    LAS float* qnp = (LAS float*)(lds + 107520);
    LAS float* Os = (LAS float*)lds;
    const int dk = tid & 127, grp = tid >> 7;
    for (int u = bid; u < 544; u += G) {
        int b, head, mm, rowbase; scan_unit(u, b, head, mm, rowbase);
        load_tile(Vs, 528, s.P + (size_t)rowbase * NINP + (MODE ? 4096 : 1024) + head * 256, NINP, 64, 256, tid);
        if (MODE == 0) { for (int e = tid; e < 2048; e += NTHR) glr[e] = bf1(s.P[(size_t)(rowbase + (e >> 5)) * NINP + 3072 + (e & 31)]); if (tid < 64) fac[tid] = 1.f; }
        f32x16 hsum[2]; hsum[0] = zero16(); hsum[1] = zero16();
        __syncthreads();
        for (int dir = 0; dir < 2; ++dir) {
            const int chain = (b * 4 + head) * 2 + dir, c = scan_chunk(mm, dir); const size_t cc = (size_t)chain * NCHUNK + c;
            if (MODE == 0) {
                float bb[16], btot; gla_gates(s, glr, tot, head, dir, tid, bb, btot);
#pragma unroll
                for (int tt = 0; tt < 16; ++tt) { const int t = 16 * grp + tt; const size_t ro = (size_t)(rowbase + t) * NINP + head * 128 + dk;
                    const float qv = bf1(s.P[ro]), kv = bf1(s.P[ro + 512]);
                    *(LAS bf16*)(Qx + t * 272 + dk * 2) = f2bf(qv * __expf(bb[tt]) * 0.08838834764831845f);
                    *(LAS bf16*)(Ki + t * 272 + dk * 2) = f2bf(kv * __expf(-bb[tt])); }
            } else {
                if (wave == 0) {
                    const float ig = bf1(s.P[(size_t)(rowbase + lane) * NINP + 6144 + dir * 8 + head]) + s.mgb[dir * 8 + head];
                    const float fg = bf1(s.P[(size_t)(rowbase + lane) * NINP + 6144 + dir * 8 + 4 + head]) + s.mgb[dir * 8 + 4 + head];
                    const float lf = logsig_f(fg), bcs = wave_scan_sum(lf, dir, lane);
                    const float uu = ig - bcs, pm = wave_scan_max(uu, dir, lane), min_ = s.MINp[cc], Mt = fmaxf(min_, pm);
                    us[lane] = uu; Mts[lane] = Mt; wint[lane] = __expf(min_ - Mt); thr[lane] = __expf(-bcs - Mt);
                }
                __syncthreads();
#pragma unroll
                for (int tt = 0; tt < 16; ++tt) { const int t = 16 * grp + tt; const size_t ro = (size_t)(rowbase + t) * 1024 + head * 128 + dk;
                    const bf16 qb = s.MQK[ro], kb = s.MQK[ro + 512];
                    *(LAS bf16*)(Qi + t * 272 + dk * 2) = qb; *(LAS bf16*)(Ki + t * 272 + dk * 2) = kb;
                    *(LAS bf16*)(Qx + t * 272 + dk * 2) = f2bf(bf1(qb) * wint[t]); }
                __syncthreads();
                { const int t = tid & 63, part = tid >> 6; float acc = 0.f;
#pragma unroll
                  for (int j = 0; j < 16; ++j) acc += bf1(*(LAS const bf16*)(Qi + t * 272 + (part * 16 + j) * 2)) * s.NIN[cc * 128 + part * 16 + j];
                  qnp[part * 64 + t] = acc; }
            }
            __syncthreads();
            if (MODE == 1 && tid < 64) { float q = 0.f;
#pragma unroll
                for (int p = 0; p < 8; ++p) q += qnp[p * 64 + tid];
                qn[tid] = q; }
            if (wave < 4) {
                const int ti = wave >> 1, tj = wave & 1; f32x16 acc = zero16();
#pragma unroll
                for (int ks = 0; ks < 8; ++ks) { const bf16x8 af = frag_row(MODE ? Qi : Qx, 272, 32 * ti, 16 * ks, lane), bfr = frag_row(Ki, 272, 32 * tj, 16 * ks, lane); acc = MFMA32(af, bfr, acc); }
                const int sidx = 32 * tj + (lane & 31);
                const float usv = MODE ? us[sidx] : 0.f;
#pragma unroll
                for (int r = 0; r < 16; ++r) { const int t = 32 * ti + (r & 3) + 8 * (r >> 2) + 4 * (lane >> 5);
                    const bool keep = dir == 0 ? (sidx <= t) : (sidx >= t);
                    float v = acc[r];
                    if (MODE == 1) v *= __expf(usv - Mts[t]);
                    v = keep ? v : 0.f;
                    *(LAS bf16*)(Am + t * 144 + sidx * 2) = f2bf(v);
                    if (MODE == 1) { float rsum = v; rsum += __shfl_xor(rsum, 1); rsum += __shfl_xor(rsum, 2); rsum += __shfl_xor(rsum, 4); rsum += __shfl_xor(rsum, 8); rsum += __shfl_xor(rsum, 16);
                        if ((lane & 31) == 0) rs[tj * 64 + t] = rsum; } }
            }
            __syncthreads();
            if (MODE == 1 && tid < 64) { const float den = wint[tid] * qn[tid] + rs[tid] + rs[64 + tid]; fac[tid] = 1.f / fmaxf(fabsf(den), thr[tid]); }
            f32x16 acc2[2]; acc2[0] = zero16(); acc2[1] = zero16();
            { const bf16* Sg = s.SSTp + cc * 32768 + (size_t)(32 * wave + (lane & 31)) * 128 + 8 * (lane >> 5);
#pragma unroll
              for (int ks = 0; ks < 8; ++ks) { const bf16x8 bfr = *(const bf16x8*)(Sg + 16 * ks);
#pragma unroll
                  for (int rt = 0; rt < 2; ++rt) { const bf16x8 af = frag_row(Qx, 272, 32 * rt, 16 * ks, lane); acc2[rt] = MFMA32(af, bfr, acc2[rt]); } } }
#pragma unroll
            for (int ks = 0; ks < 4; ++ks) { const bf16x8 bfr = frag_tr(Vs, 528, 16 * ks, 32 * wave, lane);
#pragma unroll
                for (int rt = 0; rt < 2; ++rt) { const bf16x8 af = frag_row(Am, 144, 32 * rt, 16 * ks, lane); acc2[rt] = MFMA32(af, bfr, acc2[rt]); } }
            __syncthreads();
#pragma unroll
            for (int rt = 0; rt < 2; ++rt)
#pragma unroll
                for (int r = 0; r < 16; ++r) { const int t = 32 * rt + (r & 3) + 8 * (r >> 2) + 4 * (lane >> 5); hsum[rt][r] += acc2[rt][r] * fac[t]; }
        }
        __syncthreads();
#pragma unroll
        for (int rt = 0; rt < 2; ++rt)
#pragma unroll
            for (int r = 0; r < 16; ++r) { const int t = 32 * rt + (r & 3) + 8 * (r >> 2) + 4 * (lane >> 5); Os[t * 260 + 32 * wave + (lane & 31)] = hsum[rt][r]; }
        __syncthreads();
        { const int t = tid >> 3, part = tid & 7; float o[32]; float ss = 0.f;
#pragma unroll
          for (int j = 0; j < 8; ++j) { const f32x4 v = *(LAS const f32x4*)(Os + t * 260 + 32 * part + 4 * j); o[4 * j] = v.x; o[4 * j + 1] = v.y; o[4 * j + 2] = v.z; o[4 * j + 3] = v.w; ss += (v.x * v.x + v.y * v.y) + (v.z * v.z + v.w * v.w); }
          ss += __shfl_xor(ss, 1); ss += __shfl_xor(ss, 2); ss += __shfl_xor(ss, 4);
          const float rn = rsqrtf(ss * (1.f / 256.f) + EPS);
          const size_t row = (size_t)(rowbase + t);
          const bf16* gsrc = s.P + row * NINP + (MODE ? 5120 : 2048) + head * 256 + 32 * part;
          bf16* dst = s.MIX + row * DM + (MODE ? 1024 : 0) + head * 256 + 32 * part;
#pragma unroll
          for (int j = 0; j < 4; ++j) { float gv[8], ov[8]; unpack8(*(const v4u*)(gsrc + 8 * j), gv);
#pragma unroll
              for (int e = 0; e < 8; ++e) { const float gt = MODE ? sigmoid_f(gv[e]) : silu_f(gv[e]); ov[e] = o[8 * j + e] * rn * s.ng[32 * part + 8 * j + e] * gt; }
              *(v4u*)(dst + 8 * j) = pack8(ov); } }
        __syncthreads();
    }
}

struct AttnP { const bf16* QR; const bf16* KR; const bf16* P; bf16* MIX; const float* lamp; const float* subg; const float* qg; const float* kg; float lam_init; };
__device__ __forceinline__ void ph_attn(const AttnP& p, LAS unsigned char* lds, int tid, int lane, int wave, int bid, int G) {
    const float l01 = wave_sum(p.lamp[lane] * p.lamp[64 + lane]), l23 = wave_sum(p.lamp[128 + lane] * p.lamp[192 + lane]);
    const float lam = __expf(l01) - __expf(l23) + p.lam_init;
    const float negm2 = -8.f * wave_max(fabsf(p.qg[lane])) * wave_max(fabsf(p.kg[lane])) * 1.4426950408889634f * 1.02f;
    const int r = lane & 31, h = lane >> 5, mp = wave >> 2, wq = wave & 3;
    LAS float* Ex = (LAS float*)lds;
    for (int u = bid; u < 544; u += G) {
        int b, hd, qrow0, nkt;
        if (u < 512) { b = u >> 8; hd = (u >> 5) & 7; qrow0 = b * 4096 + 128 * (u & 31); nkt = 68; }
        else { const int uu = u - 512; b = uu >> 4; hd = (uu >> 1) & 7; qrow0 = NLATR + b * 256 + 128 * (uu & 1); nkt = 4; }
        const int qrow = qrow0 + 32 * wq + r;
        bf16x8 Qf[4];
#pragma unroll
        for (int ks = 0; ks < 4; ++ks) Qf[ks] = *(const bf16x8*)(p.QR + (size_t)qrow * 1024 + (hd * 2 + mp) * 64 + 16 * ks + 8 * h);
        f32x16 O[4];
#pragma unroll
        for (int dt = 0; dt < 4; ++dt) O[dt] = zero16();
        float ls = 0.f;
        const int c0r = tid >> 4, c0c = tid & 15;
        v4u kr0, kr1, vr0, vr1;
        auto gload = [&](int kt) { const int krow = kt < 4 ? NLATR + b * 256 + 64 * kt : b * 4096 + 64 * (kt - 4);
            kr0 = *(const v4u*)(p.KR + (size_t)(krow + c0r) * 1024 + hd * 128 + c0c * 8); kr1 = *(const v4u*)(p.KR + (size_t)(krow + 32 + c0r) * 1024 + hd * 128 + c0c * 8);
            vr0 = *(const v4u*)(p.P + (size_t)(krow + c0r) * NINP + 2048 + hd * 128 + c0c * 8); vr1 = *(const v4u*)(p.P + (size_t)(krow + 32 + c0r) * NINP + 2048 + hd * 128 + c0c * 8); };
        auto lstore = [&](int buf) { LAS unsigned char* Kt = lds + buf * 17408; LAS unsigned char* Vt = lds + 34816 + buf * 17408;
            *(LAS v4u*)(Kt + c0r * 272 + c0c * 16) = kr0; *(LAS v4u*)(Kt + (32 + c0r) * 272 + c0c * 16) = kr1;
            *(LAS v4u*)(Vt + c0r * 272 + c0c * 16) = vr0; *(LAS v4u*)(Vt + (32 + c0r) * 272 + c0c * 16) = vr1; };
        gload(0); lstore(0);
        __syncthreads();
        for (int kt = 0; kt < nkt; ++kt) {
            const bool more = kt + 1 < nkt;
            if (more) gload(kt + 1);
            LAS const unsigned char* Kt = lds + (kt & 1) * 17408; LAS const unsigned char* Vt = lds + 34816 + (kt & 1) * 17408;
#pragma unroll
            for (int kb = 0; kb < 2; ++kb) {
                f32x16 S = zero16();
#pragma unroll
                for (int ks = 0; ks < 4; ++ks) { const bf16x8 a0 = frag_row(Kt, 272, 32 * kb, 64 * mp + 16 * ks, lane); S = MFMA32(a0, Qf[ks], S); }
                unsigned pf[8]; float lacc = 0.f;
#pragma unroll
                for (int i = 0; i < 8; ++i) { const float e0 = __builtin_amdgcn_exp2f(S[2 * i] + negm2), e1 = __builtin_amdgcn_exp2f(S[2 * i + 1] + negm2); lacc += e0 + e1; pf[i] = pk2(e0, e1); }
                ls += lacc;
                const bf16x8 P0 = __builtin_bit_cast(bf16x8, (v4u){pf[0], pf[1], pf[2], pf[3]}), P1 = __builtin_bit_cast(bf16x8, (v4u){pf[4], pf[5], pf[6], pf[7]});
#pragma unroll
                for (int dt = 0; dt < 4; ++dt) { const bf16x8 av0 = frag_tr_perm(Vt, 272, 32 * kb, 32 * dt, lane), av1 = frag_tr_perm(Vt, 272, 32 * kb + 16, 32 * dt, lane);
                    O[dt] = MFMA32(av0, P0, O[dt]); O[dt] = MFMA32(av1, P1, O[dt]); }
            }
            if (more) lstore((kt + 1) & 1);
            __syncthreads();
        }
        const float l = ls + __shfl_xor(ls, 32);
        if (mp == 1) { const float sc = lam / l;
#pragma unroll
            for (int dt = 0; dt < 4; ++dt)
#pragma unroll
                for (int i = 0; i < 16; ++i) Ex[(32 * wq + r) * 132 + 32 * dt + (i & 3) + 8 * (i >> 2) + 4 * h] = O[dt][i] * sc; }
        __syncthreads();
        if (mp == 0) { const float a0 = 1.f / l; float ss = 0.f;
#pragma unroll
            for (int dt = 0; dt < 4; ++dt)
#pragma unroll
                for (int i = 0; i < 16; ++i) { const float v = O[dt][i] * a0 - Ex[(32 * wq + r) * 132 + 32 * dt + (i & 3) + 8 * (i >> 2) + 4 * h]; O[dt][i] = v; ss += v * v; }
            ss += __shfl_xor(ss, 32);
            const float rn = rsqrtf(ss * (1.f / 128.f) + EPS) * (1.f - p.lam_init);
            bf16* dst = p.MIX + (size_t)qrow * DM + hd * 128;
#pragma unroll
            for (int dt = 0; dt < 4; ++dt)
#pragma unroll
                for (int g4 = 0; g4 < 4; ++g4) { const int dv0 = 32 * dt + 8 * g4 + 4 * h; const f32x4 sg = *(const f32x4*)(p.subg + dv0);
                    v2u o; o.x = pk2(O[dt][4 * g4] * rn * sg.x, O[dt][4 * g4 + 1] * rn * sg.y); o.y = pk2(O[dt][4 * g4 + 2] * rn * sg.z, O[dt][4 * g4 + 3] * rn * sg.w);
                    *(v2u*)(dst + dv0) = o; } }
        __syncthreads();
    }
}

#ifndef PHASE_MASK
#define PHASE_MASK 0xFFFFFFu
#endif
#define PM(j) ((PHASE_MASK >> (j)) & 1u)
#ifndef REP_MASK
#define REP_MASK 0u
#endif
#define REPS(j) ((((REP_MASK) >> (j)) & 1u) ? 2 : 1)
#define PH_BEGIN(j, k) if (PM(j) && IN(k)) for (int rep_ = 0; rep_ < REPS(j); ++rep_) { if (rep_) xcd_barrier(bar);
#define PH_END }
#define PHASE_BEGIN int tid = tid0, lane = lane0; asm volatile("" : "+v"(tid), "+v"(lane)); int wave = wave0, bid = bid0, G = G0; asm volatile("" : "+s"(wave), "+s"(bid), "+s"(G)); \
    unsigned char* ws = ws0; asm volatile("" : "+s"(ws)); const int gw = bid * NWAVES + wave, NGW = G * NWAVES, gtid = bid * NTHR + tid, NT = G * NTHR; (void)gw; (void)NGW; (void)gtid; (void)NT; (void)lane;
__device__ __forceinline__ void fill_scanp(ScanP& sp, const Args& a, unsigned char* ws, int li, bool even) {
    sp.P = (const bf16*)(ws + WS_P); sp.MQK = (const bf16*)(ws + WS_MQK); sp.MIX = (bf16*)(ws + WS_MIX);
    sp.gw2 = a.in[10] + (size_t)li * 2 * 16 * 512; sp.gb = a.in[11] + (size_t)li * 2 * 512; sp.mgb = a.in[21] + (size_t)li * 16;
    sp.ng = even ? a.in[12] + (size_t)li * 256 : a.in[22] + (size_t)li * 256;
    sp.DSTp = (float*)(ws + WS_DST); sp.SSTp = (bf16*)(ws + WS_SST); sp.GAM = (float*)(ws + WS_SM + SM_GAM); sp.DN = (float*)(ws + WS_SM + SM_DN); sp.NIN = (float*)(ws + WS_SM + SM_NIN);
    sp.BL = (float*)(ws + WS_SM + SM_BL); sp.ML = (float*)(ws + WS_SM + SM_ML); sp.MINp = (float*)(ws + WS_SM + SM_MIN);
}
__global__ void __launch_bounds__(NTHR, 2) fwd_kernel(Args a) {
    extern __shared__ __attribute__((aligned(16))) unsigned char lds_raw[];
    LAS unsigned char* lds = (LAS unsigned char*)lds_raw;
    const int tid0 = threadIdx.x, lane0 = tid0 & 63, wave0 = __builtin_amdgcn_readfirstlane(tid0 >> 6), bid0 = blockIdx.x, G0 = gridDim.x;
    unsigned char* ws0 = a.ws;
    volatile LAS unsigned* MISC = (volatile LAS unsigned*)(lds + MISC_OFF);
    if (tid0 < 32) MISC[tid0] = 0u;
    __syncthreads();
    XcdBarrier bar = xcd_barrier_post((unsigned*)(ws0 + WS_CTL) + CW_BAR + a.li * XCD_BAR_WORDS, MISC + 8);
    const int lo = a.ph_lo, hi = a.ph_hi;
#define IN(k) (lo <= (k) && (k) < hi)
#define SEAM(k) do { if (IN(k) && IN((k) + 1)) xcd_barrier(bar); } while (0)

    PH_BEGIN(11, 0) PHASE_BEGIN; ph_prologue(a, ws, lds, tid, lane, wave, bid, G); PH_END
    SEAM(0);
    for (int layer = 0; layer < NLAYERS; ++layer) {
        const int pb = 1 + layer * PPL, li = layer >> 1; const bool even = (layer & 1) == 0;
        const size_t mod_off = WS_MOD + (size_t)layer * 3 * 12288 * 4;
        const size_t wb_off = WS_W + (size_t)layer * W_LAYER;

        PH_BEGIN(0, pb + 0) PHASE_BEGIN; const float* mod = (const float*)(ws + mod_off);
            ph_norm((float*)(ws + WS_XS), a.in[6] + (size_t)layer * DM, mod + 0 * DM, mod + 1 * DM, (bf16*)(ws + WS_H), gw, NGW, lane, (const float*)(ws + WS_DST), mod - 3 * 12288 + 2 * 12288 + 5 * DM, layer > 0 ? 11 : 0); }
        SEAM(pb + 0);
        PH_BEGIN(1, pb + 1) PHASE_BEGIN; pg8::Gemm g{(const bf16*)(ws + WS_H), (const bf16*)(ws + wb_off), MR, NINP, DM}; pg8::StaticOrder S; S.init(MR, NINP, G, bid); pg8::EpiStore E{(bf16*)(ws + WS_P), NINP};
            pg8::gemm_phase<pg8::EpiStore, pg8::StaticOrder, true, true>(lds, g, S, E);
            if (layer + 1 < NLAYERS && G == 256 && bid >= 82) { __syncthreads(); ph_convert(a, ws, lds, (layer + 1) * 25344, (layer + 2) * 25344, (bid - 82) * NWAVES + wave, 174 * NWAVES, wave, lane); }
            else if (layer + 1 < NLAYERS && G != 256) { __syncthreads(); ph_convert(a, ws, lds, (layer + 1) * 25344, (layer + 2) * 25344, bid * NWAVES + wave, G * NWAVES, wave, lane); } }
        SEAM(pb + 1);
        PH_BEGIN(2, pb + 2)
            if (even) {
                if (PM(12)) { PHASE_BEGIN; ph_conv<1>((const bf16*)(ws + WS_P), a.in[13] + (size_t)li * 3 * 1024, nullptr, (bf16*)(ws + WS_MIX), gtid, NT); }
                if (PM(13)) { PHASE_BEGIN; ScanP sp; fill_scanp(sp, a, ws, li, even); ph_scan_local<0>(sp, lds, tid, lane, wave, bid, G); }
            } else {
                if (PM(14)) { PHASE_BEGIN; ph_qkprep((const bf16*)(ws + WS_P), a.in[16] + (size_t)li * 64, a.in[17] + (size_t)li * 64, (const float*)(ws + WS_ROPE), (bf16*)(ws + WS_QR), (bf16*)(ws + WS_KR), gw, NGW, lane); }
                if (PM(15)) { PHASE_BEGIN; ph_conv<2>((const bf16*)(ws + WS_P), a.in[20] + (size_t)li * 3 * 1024, nullptr, (bf16*)(ws + WS_MQK), gtid, NT); }
            }
        }
        SEAM(pb + 2);
        PH_BEGIN(3, pb + 3) if (!even) { PHASE_BEGIN; ScanP sp; fill_scanp(sp, a, ws, li, even); ph_scan_local<1>(sp, lds, tid, lane, wave, bid, G); } }
        SEAM(pb + 3);
        PH_BEGIN(4, pb + 4) PHASE_BEGIN; ScanP sp; fill_scanp(sp, a, ws, li, even); if (even) ph_scan_carry<0>(sp, gtid, NT); else ph_scan_carry<1>(sp, gtid, NT); }
        SEAM(pb + 4);
        PH_BEGIN(5, pb + 5)
            if (even) { if (PM(16)) { PHASE_BEGIN; ScanP sp; fill_scanp(sp, a, ws, li, even); ph_scan_out<0>(sp, lds, tid, lane, wave, bid, G); } }
            else {
                if (PM(17)) { PHASE_BEGIN; AttnP ap{(const bf16*)(ws + WS_QR), (const bf16*)(ws + WS_KR), (const bf16*)(ws + WS_P), (bf16*)(ws + WS_MIX), a.in[18] + (size_t)li * 256, a.in[19] + (size_t)li * 128, a.in[16] + (size_t)li * 64, a.in[17] + (size_t)li * 64, 0.8f - 0.6f * expf(-0.3f * (float)layer)};
                    for (int r2 = 0; r2 < REPS(17); ++r2) { if (r2) __syncthreads(); ph_attn(ap, lds, tid, lane, wave, bid, G); } }
                if (PM(18)) { PHASE_BEGIN; ScanP sp; fill_scanp(sp, a, ws, li, even); ph_scan_out<1>(sp, lds, tid, lane, wave, bid, G); }
            }
        }
        SEAM(pb + 5);
        PH_BEGIN(6, pb + 6) PHASE_BEGIN; pg8::Gemm g{(const bf16*)(ws + WS_MIX), (const bf16*)(ws + wb_off + W_OUT), MR, DM, DM}; pg8::ResidOrder S; S.init(G, bid, layer < NLAYERS - 1 ? 8 : 0, 256);
            pg8::EpiResid2 E{(float*)(ws + WS_XS), (const float*)(ws + mod_off) + 2 * DM, nullptr, (float*)(ws + WS_DST), 0, 256, rep_};
            pg8::gemm_phase<pg8::EpiResid2, pg8::ResidOrder, true, true>(lds, g, S, E); }
        SEAM(pb + 6);
        PH_BEGIN(7, pb + 7) PHASE_BEGIN; const float* mod = (const float*)(ws + mod_off);
            ph_norm((float*)(ws + WS_XS), a.in[7] + (size_t)layer * DM, mod + 3 * DM, mod + 4 * DM, (bf16*)(ws + WS_H), gw, NGW, lane, (const float*)(ws + WS_DST), mod + 2 * 12288 + 2 * DM, layer < NLAYERS - 1 ? 8 : 0); }
        SEAM(pb + 7);
        PH_BEGIN(8, pb + 8) PHASE_BEGIN; pg8::Gemm g{(const bf16*)(ws + WS_H), (const bf16*)(ws + wb_off + W_UP), MR, NUP, DM}; pg8::StaticOrder S; S.init(MR, NUP, G, bid);
            pg8::EpiAct E{(bf16*)(ws + WS_ACT), a.in[24] + (size_t)layer * 3 * DFF, a.in[25] + (size_t)layer * DFF, (float*)(ws + WS_U), (LAS float*)(lds + 131584), 0};
            pg8::gemm_phase<pg8::EpiAct, pg8::StaticOrder, true, true>(lds, g, S, E); }
        SEAM(pb + 8);
        PH_BEGIN(9, pb + 9) PHASE_BEGIN; ph_act_fix((const float*)(ws + WS_U), a.in[24] + (size_t)layer * 3 * DFF, (bf16*)(ws + WS_ACT), gtid, NT); }
        SEAM(pb + 9);
        PH_BEGIN(10, pb + 10) PHASE_BEGIN; pg8::Gemm g{(const bf16*)(ws + WS_ACT), (const bf16*)(ws + wb_off + W_DN), MR, DM, DFF}; pg8::ResidOrder S; S.init(G, bid, layer < NLAYERS - 1 ? 11 : 0, 512);
            pg8::EpiResid2 E{(float*)(ws + WS_XS), (const float*)(ws + mod_off) + 5 * DM, a.out, (float*)(ws + WS_DST), layer == NLAYERS - 1 ? 1 : 0, 512, rep_};
            pg8::gemm_phase<pg8::EpiResid2, pg8::ResidOrder, true, true>(lds, g, S, E); }
        if (layer < NLAYERS - 1) SEAM(pb + 10);
    }
#undef IN
#undef SEAM
}

extern "C" void kernel_launch(void* const* d_in, const int* in_sizes, int n_in, void* d_out, int out_size, void* d_ws, size_t ws_size, hipStream_t stream) {
    static int grid = 0;
    if (grid == 0) {
        int dev = 0, cus = 0;
        if (n_in != 27 || out_size != NLATR * DM || ws_size < WS_END) { fprintf(stderr, "kernel_launch: unexpected problem (n_in %d out %d ws %zu)\n", n_in, out_size, ws_size); grid = -1; return; }
        if (hipGetDevice(&dev) != hipSuccess || hipDeviceGetAttribute(&cus, hipDeviceAttributeMultiprocessorCount, dev) != hipSuccess) { grid = -1; return; }
        if (hipFuncSetAttribute((const void*)fwd_kernel, hipFuncAttributeMaxDynamicSharedMemorySize, LDS_BYTES) != hipSuccess) { fprintf(stderr, "kernel_launch: hipFuncSetAttribute failed\n"); grid = -1; return; }
        int per_cu = 0;
        if (hipOccupancyMaxActiveBlocksPerMultiprocessor(&per_cu, (const void*)fwd_kernel, NTHR, LDS_BYTES) != hipSuccess || per_cu < 1) fprintf(stderr, "kernel_launch: occupancy query reports %d\n", per_cu);
        (void)hipGetLastError();
        grid = cus;
    }
    if (grid < 0) return;
    (void)hipMemsetAsync((char*)d_ws + WS_CTL, 0, CTL_BYTES, stream);
    Args a{};
    for (int i = 0; i < 27; ++i) a.in[i] = (const float*)d_in[i];
    a.out = (float*)d_out; a.ws = (unsigned char*)d_ws; a.pad = 0;
#if ONE_LAUNCH
    a.ph_lo = 0; a.ph_hi = 1 + NLAYERS * PPL; a.li = 0;
    hipLaunchKernelGGL(fwd_kernel, dim3(grid), dim3(NTHR), LDS_BYTES, stream, a);
#else
    for (int p = 0; p < 1 + NLAYERS * PPL; ++p) {
        const int k = p == 0 ? 0 : (p - 1) % PPL, layer = p == 0 ? 0 : (p - 1) / PPL;
        if (p > 0 && k == 3 && (layer & 1) == 0) continue;
        a.ph_lo = p; a.ph_hi = p + 1; a.li = p;
        hipLaunchKernelGGL(fwd_kernel, dim3(grid), dim3(NTHR), LDS_BYTES, stream, a);
    }
#endif
}
```

```cpp
#include <hip/hip_runtime.h>
#include <cstdio>
#include <cstdint>
namespace pg8 {
#define PG8_LAS __attribute__((address_space(3)))
typedef unsigned short bf16_t;
typedef short bf16x8 __attribute__((ext_vector_type(8)));
typedef float f32x4 __attribute__((ext_vector_type(4)));
typedef unsigned u32x4 __attribute__((ext_vector_type(4)));
constexpr int BM = 256, BK = 64, HALF = 128, HTB = HALF * BK * 2  , STAGE_BYTES = 8 * HTB, NXCD = 8, WGM = 8;

__host__ __device__ __forceinline__ int lds_byte(int r, int c) { const int st = (r >> 4) * 2 + (c >> 5), rr = r & 15, cc = c & 31, ob = rr * 64 + cc * 2; return st * 1024 + (ob ^ (((ob >> 9) & 1) << 5)); }
__host__ __device__ __forceinline__ void stage_rc(int b, int& R, int& C) { const int st = b / 1024, sb = b % 1024, swz = sb ^ (((sb >> 9) & 1) << 5); R = (st >> 1) * 16 + swz / 64; C = (st & 1) * 32 + (swz % 64) / 2; }
__host__ __device__ __forceinline__ int perm32(int rho) { const int n = rho >> 4, i = rho & 15; return 8 * (i >> 2) + 4 * n + (i & 3); }

struct Unit { int pm, pn, k0, nt; };
struct Gemm { const bf16_t* A; const bf16_t* Bt; int M, N, K; };

struct StaticOrder {
    int nM, nN, nwg, G, c;
    __host__ __device__ __forceinline__ void init(int M, int N, int G_, int c_) { nM = M / BM; nN = N / BM; nwg = nM * nN; G = G_; c = c_; }
    __host__ __device__ __forceinline__ bool next(int i, Unit& u) const {
        const long L = (long)i * G + c; if (L >= nwg) return false;
        int wgid = (int)L; { const int q = nwg / NXCD, r = nwg % NXCD, xcd = wgid % NXCD, off = wgid / NXCD; wgid = (xcd < r ? xcd * (q + 1) : r * (q + 1) + (xcd - r) * q) + off; }
        const int nig = WGM * nN, gid = wgid / nig, fm = gid * WGM, gsz = (nM - fm) < WGM ? (nM - fm) : WGM;
        u.pm = fm + ((wgid % nig) % gsz); u.pn = (wgid % nig) / gsz; u.k0 = 0; u.nt = 0; return true;
    }
    __device__ __forceinline__ void a_ready(const Unit&) const {}
    __device__ __forceinline__ void done(const Unit&) const {}
};
__device__ __forceinline__ unsigned cvt_pk_bf16(float lo, float hi) { unsigned r; asm volatile("v_cvt_pk_bf16_f32 %0, %1, %2" : "=v"(r) : "v"(lo), "v"(hi)); return r; }

struct EpiStore {
    static constexpr bool PERM = true, AFTER_DRAIN = false;
    bf16_t* O; int ldc; const float* ssq; const float* bias; int ldb;
    __device__ __forceinline__ void operator()(const f32x4 (&acc)[2][2][4][2], const Unit& u, int wr, int wc, int fr, int fq) const {
        const int row0 = u.pm * BM + wr * 64 + fr, col0 = u.pn * BM + wc * 32 + 8 * fq, mi = u.pm < 32 ? (u.pm >> 4) : 2;
        f32x4 bv[2][2];
#pragma unroll
        for (int bj = 0; bj < 2; ++bj)
#pragma unroll
            for (int n = 0; n < 2; ++n) bv[bj][n] = *(const f32x4*)(bias + (size_t)mi * ldb + col0 + bj * HALF + 4 * n);
#pragma unroll
        for (int ai = 0; ai < 2; ++ai)
#pragma unroll
            for (int m = 0; m < 4; ++m) { const int row = row0 + ai * HALF + m * 16; bf16_t* rowp = O + (size_t)row * ldc + col0;
                const float r = __builtin_amdgcn_rsqf(ssq[row] * (1.f / 2048.f) + 1e-6f);
#pragma unroll
                for (int bj = 0; bj < 2; ++bj) { const f32x4 v0 = acc[ai][bj][m][0] * r + bv[bj][0], v1 = acc[ai][bj][m][1] * r + bv[bj][1];
                    u32x4 w; w.x = cvt_pk_bf16(v0[0], v0[1]); w.y = cvt_pk_bf16(v0[2], v0[3]); w.z = cvt_pk_bf16(v1[0], v1[1]); w.w = cvt_pk_bf16(v1[2], v1[3]);
                    *(u32x4*)(rowp + bj * HALF) = w; } }
    }
};
struct ResidOrder {
    StaticOrder L; int G, c, nsub, ksub;
    __device__ __forceinline__ void init(int G_, int c_, int nsplit, int ksub_) { L.init(8192, 2048, G_, c_); G = G_; c = c_; nsub = 16 * nsplit; ksub = ksub_; }
    __device__ __forceinline__ bool next(int i, Unit& u) const {
        const int nl = c < 256 ? (255 - c) / G + 1 : 0;
        if (i < nl) return L.next(i, u);
        const int s = (i - nl) * G + c; if (s >= nsub) return false;
        const int tile = s & 15, j = s >> 4; u.pm = 32 + (tile >> 3); u.pn = tile & 7; u.k0 = j * ksub; u.nt = ksub / BK; return true;
    }
    __device__ __forceinline__ void a_ready(const Unit&) const {}
    __device__ __forceinline__ void done(const Unit&) const {}
};
struct EpiResid2 {
    static constexpr bool PERM = true, AFTER_DRAIN = false;
    float* X; const float* gate; float* out; float* part; int final_; int ksub; int dry;
    bf16_t* Hn; const float* ngn; const float* scn; float* ssqn;
    __device__ __forceinline__ void operator()(const f32x4 (&acc)[2][2][4][2], const Unit& u, int wr, int wc, int fr, int fq) const {
        const int row0 = u.pm * BM + wr * 64 + fr, col0 = u.pn * BM + wc * 32 + 8 * fq;
        if (u.pm >= 32) {
            float* pb = part + ((size_t)(u.k0 / ksub) * 512 + (row0 - 8192)) * 2048 + col0;
#pragma unroll
            for (int ai = 0; ai < 2; ++ai)
#pragma unroll
                for (int m = 0; m < 4; ++m)
#pragma unroll
                    for (int bj = 0; bj < 2; ++bj)
#pragma unroll
                        for (int n = 0; n < 2; ++n) *(f32x4*)(pb + (size_t)(ai * HALF + m * 16) * 2048 + bj * HALF + 4 * n) = acc[ai][bj][m][n];
            return;
        }
        const int mi = u.pm >> 4;
        f32x4 gv[2][2], av[2][2];
#pragma unroll
        for (int bj = 0; bj < 2; ++bj)
#pragma unroll
            for (int n = 0; n < 2; ++n) { const int c = col0 + bj * HALF + 4 * n; gv[bj][n] = *(const f32x4*)(gate + (size_t)mi * 12288 + c);
                av[bj][n] = Hn ? *(const f32x4*)(ngn + c) * (*(const f32x4*)(scn + (size_t)mi * 12288 + c) + 1.f) : (f32x4){0.f, 0.f, 0.f, 0.f}; }
        if (dry && gv[0][0][0] != 1.2345e30f) return;
#pragma unroll
        for (int ai = 0; ai < 2; ++ai)
#pragma unroll
            for (int m = 0; m < 4; ++m) { const int row = row0 + ai * HALF + m * 16; const size_t ro = (size_t)row * 2048 + col0; const float* xr = X + ro; float* orow = (final_ ? out : X) + ro; float ss = 0.f;
#pragma unroll
                for (int bj = 0; bj < 2; ++bj) {
                    const f32x4 x0 = *(const f32x4*)(xr + bj * HALF) + gv[bj][0] * acc[ai][bj][m][0], x1 = *(const f32x4*)(xr + bj * HALF + 4) + gv[bj][1] * acc[ai][bj][m][1];
                    *(f32x4*)(orow + bj * HALF) = x0; *(f32x4*)(orow + bj * HALF + 4) = x1;
                    if (Hn) { ss += (x0[0] * x0[0] + x0[1] * x0[1]) + (x0[2] * x0[2] + x0[3] * x0[3]) + (x1[0] * x1[0] + x1[1] * x1[1]) + (x1[2] * x1[2] + x1[3] * x1[3]);
                        const f32x4 h0 = x0 * av[bj][0], h1 = x1 * av[bj][1];
                        u32x4 w; w.x = cvt_pk_bf16(h0[0], h0[1]); w.y = cvt_pk_bf16(h0[2], h0[3]); w.z = cvt_pk_bf16(h1[0], h1[1]); w.w = cvt_pk_bf16(h1[2], h1[3]);
                        *(u32x4*)(Hn + ro + bj * HALF) = w; } }
                if (Hn) { ss += __shfl_xor(ss, 16); ss += __shfl_xor(ss, 32); if (fq == 0) (void)__hip_atomic_fetch_add(ssqn + row, ss, __ATOMIC_RELAXED, __HIP_MEMORY_SCOPE_AGENT); } }
    }
};
struct EpiAct {
    static constexpr bool PERM = true, AFTER_DRAIN = false;
    bf16_t* ACT; const float* cw; const float* cb; float* halo; PG8_LAS float* exb; const float* ssq; const float* bias; mutable int par;
    __device__ __forceinline__ void operator()(const f32x4 (&acc)[2][2][4][2], const Unit& u, int wr, int wc, int fr, int fq) const {
        const int lane = fq * 16 + fr, ch0 = wc * 32 + 8 * fq, chg = u.pn * 128 + ch0;
        PG8_LAS float* xb = exb + par * 1024; par ^= 1;
        const int mi = u.pm < 32 ? (u.pm >> 4) : 2;
        const float* bp = bias + (size_t)mi * 11264 + u.pn * BM + ch0;
        float rr[2][4];
#pragma unroll
        for (int ai = 0; ai < 2; ++ai)
#pragma unroll
            for (int m = 0; m < 4; ++m) rr[ai][m] = __builtin_amdgcn_rsqf(ssq[u.pm * BM + ai * HALF + wr * 64 + m * 16 + fr] * (1.f / 2048.f) + 1e-6f);
#pragma unroll
        for (int ai = 0; ai < 2; ++ai) { const int q = ai * 2 + wr;
#pragma unroll
            for (int n = 0; n < 2; ++n) { const f32x4 bg4 = *(const f32x4*)(bp + 4 * n);
                if (fr == 0) *(PG8_LAS f32x4*)(xb + q * 128 + ch0 + 4 * n) = acc[ai][0][0][n] * rr[ai][0] + bg4;
                if (fr == 15) *(PG8_LAS f32x4*)(xb + (4 + q) * 128 + ch0 + 4 * n) = acc[ai][0][3][n] * rr[ai][3] + bg4; } }
        asm volatile("s_waitcnt lgkmcnt(0)" ::: "memory"); __builtin_amdgcn_s_barrier(); asm volatile("" ::: "memory");
        const int srcp = (lane & 48) | ((fr + 15) & 15), srcn = (lane & 48) | ((fr + 1) & 15);
        float* hb = halo + (size_t)(u.pm * 44 + u.pn) * 768 + ch0;
#pragma unroll
        for (int n = 0; n < 2; ++n) {
            const f32x4 w0 = *(const f32x4*)(cw + chg + 4 * n), w1 = *(const f32x4*)(cw + 5632 + chg + 4 * n), w2 = *(const f32x4*)(cw + 2 * 5632 + chg + 4 * n), bb = *(const f32x4*)(cb + chg + 4 * n);
            const f32x4 bg = *(const f32x4*)(bp + 4 * n), bvv = *(const f32x4*)(bp + 128 + 4 * n);
#pragma unroll
            for (int ai = 0; ai < 2; ++ai) { const int q = ai * 2 + wr;
                const f32x4 pB = q > 0 ? *(PG8_LAS const f32x4*)(xb + (4 + q - 1) * 128 + ch0 + 4 * n) : (f32x4){0.f, 0.f, 0.f, 0.f};
                const f32x4 nB = q < 3 ? *(PG8_LAS const f32x4*)(xb + (q + 1) * 128 + ch0 + 4 * n) : (f32x4){0.f, 0.f, 0.f, 0.f};
#pragma unroll
                for (int m = 0; m < 4; ++m) {
                    const f32x4 x = acc[ai][0][m][n] * rr[ai][m] + bg, vx = acc[ai][1][m][n] * rr[ai][m] + bvv;
                    const f32x4 xm = m > 0 ? acc[ai][0][m > 0 ? m - 1 : 0][n] * rr[ai][m > 0 ? m - 1 : 0] + bg : pB;
                    const f32x4 xq = m < 3 ? acc[ai][0][m < 3 ? m + 1 : 3][n] * rr[ai][m < 3 ? m + 1 : 3] + bg : nB;
                    f32x4 cv, o;
#pragma unroll
                    for (int el = 0; el < 4; ++el) { const float sp = fr == 15 ? xm[el] : x[el], sn = fr == 0 ? xq[el] : x[el];
                        const float pv = __shfl(sp, srcp), nv = __shfl(sn, srcn);
                        cv[el] = w0[el] * pv + w1[el] * x[el] + w2[el] * nv + bb[el];
                        o[el] = cv[el] / (1.f + __expf(-cv[el])) * vx[el]; }
                    const bool top = (q == 0 && m == 0 && fr == 0), bot = (q == 3 && m == 3 && fr == 15);
                    if (top || bot) { const int sl = top ? 0 : 1; *(f32x4*)(hb + sl * 128 + 4 * n) = x; *(f32x4*)(hb + (2 + sl) * 128 + 4 * n) = cv; *(f32x4*)(hb + (4 + sl) * 128 + 4 * n) = vx; }
                    else { typedef unsigned u32x2_ __attribute__((ext_vector_type(2))); u32x2_ w; w.x = cvt_pk_bf16(o[0], o[1]); w.y = cvt_pk_bf16(o[2], o[3]);
                        *(u32x2_*)(ACT + (size_t)(u.pm * BM + q * 64 + m * 16 + fr) * 5632 + chg + 4 * n) = w; }
                }
            }
        }
    }
};
template <class Epi, class Sched, bool ALIGN_EPI = false, bool SP2 = false>
__device__ __forceinline__ void gemm_phase(PG8_LAS unsigned char* lds, const Gemm g, const Sched& S, const Epi& E, int wid_in) {
    int wid = wid_in, zz_ = 0; asm volatile("" : "+s"(wid), "+s"(zz_));
    const int lane = (int)__builtin_amdgcn_mbcnt_hi(~0u, __builtin_amdgcn_mbcnt_lo(~0u, (unsigned)zz_)), tid = wid * 64 + lane, wr = wid >> 2, wc = wid & 3, fr = lane & 15, fq = lane >> 4;
    const int K = g.K, nt = K / BK;
    unsigned voffA[2], voffB[2];
#pragma unroll
    for (int i = 0; i < 2; ++i) { int R, C; stage_rc(tid * 16 + i * 8192, R, C); const int Rb = Epi::PERM ? ((R & ~31) + perm32(R & 31)) : R;
        voffA[i] = (unsigned)(R * K + C) * 2u; voffB[i] = (unsigned)(Rb * K + C) * 2u; }
    const size_t kstep = (size_t)(BK * 2);
    const size_t hstep = (size_t)HALF * K * 2;
    const size_t tstep = 2 * hstep;
    const unsigned ldsw = (unsigned)wid * 1024u;
    const int aoff = lds_byte(wr * 64 + fr, fq * 8), boff = lds_byte(wc * 32 + fr, fq * 8);
#define PG8_SA(b, h) (((b) * 2 + (h)) * HTB)
#define PG8_SB(b, h) ((4 + (b) * 2 + (h)) * HTB)
#define PG8_STAGE(bufoff, gbase, voff) do { _Pragma("unroll") for (int _i = 0; _i < 2; ++_i) \
        __builtin_amdgcn_global_load_lds((const unsigned*)((const char*)(gbase) + (voff)[_i]), (PG8_LAS unsigned*)(lds + (bufoff) + ldsw + _i * 8192), 16, 0, 0); } while (0)
#define PG8_LDA(dst, b, h) do { _Pragma("unroll") for (int m = 0; m < 4; ++m) _Pragma("unroll") for (int k = 0; k < 2; ++k) dst[m][k] = *(const PG8_LAS bf16x8*)(lds + PG8_SA(b, h) + aoff + m * 2048 + k * 1024); } while (0)
#define PG8_LDB(dst, b, h) do { _Pragma("unroll") for (int n = 0; n < 2; ++n) _Pragma("unroll") for (int k = 0; k < 2; ++k) dst[n][k] = *(const PG8_LAS bf16x8*)(lds + PG8_SB(b, h) + boff + n * 2048 + k * 1024); } while (0)
#define PG8_MMA(ai, bj, At, Bt) do { __builtin_amdgcn_s_setprio(1); _Pragma("unroll") for (int m = 0; m < 4; ++m) _Pragma("unroll") for (int n = 0; n < 2; ++n) _Pragma("unroll") for (int k = 0; k < 2; ++k) \
        acc[ai][bj][m][n] = __builtin_amdgcn_mfma_f32_16x16x32_bf16(Bt[n][k], At[m][k], acc[ai][bj][m][n], 0, 0, 0); __builtin_amdgcn_s_setprio(0); } while (0)
#define PG8_WAIT_V(n) asm volatile("s_waitcnt vmcnt(" #n ")" ::: "memory")
#define PG8_WAIT_L(n) asm volatile("s_waitcnt lgkmcnt(" #n ")" ::: "memory")
#define PG8_BAR __builtin_amdgcn_s_barrier()
#define PG8_SCHED __builtin_amdgcn_sched_barrier(0)
    Unit cur, nxt; int ui = 0;
    if (!S.next(0, cur)) return;
    f32x4 acc[2][2][4][2];
#pragma unroll
    for (int a = 0; a < 2; ++a)
#pragma unroll
        for (int b = 0; b < 2; ++b)
#pragma unroll
            for (int m = 0; m < 4; ++m)
#pragma unroll
                for (int n = 0; n < 2; ++n) acc[a][b][m][n] = (f32x4){0.f, 0.f, 0.f, 0.f};
    bf16x8 At[4][2], B0[2][2], B1[2][2];
    const char* cA = (const char*)g.A + (size_t)cur.pm * tstep + (size_t)cur.k0 * 2; const char* cB = (const char*)g.Bt + (size_t)cur.pn * tstep + (size_t)cur.k0 * 2;
    S.a_ready(cur);
    if constexpr (SP2) {
        PG8_STAGE(PG8_SB(0, 0), cB, voffB); PG8_STAGE(PG8_SB(0, 1), cB + hstep, voffB); PG8_STAGE(PG8_SA(0, 0), cA, voffA); PG8_STAGE(PG8_SA(0, 1), cA + hstep, voffA);
        if (wr == 1) PG8_BAR;
        PG8_WAIT_V(2); PG8_BAR;
        PG8_STAGE(PG8_SB(1, 0), cB + kstep, voffB); PG8_STAGE(PG8_SA(1, 0), cA + kstep, voffA); PG8_STAGE(PG8_SB(1, 1), cB + hstep + kstep, voffB);
        PG8_WAIT_V(6); PG8_BAR;
    } else {
        PG8_STAGE(PG8_SB(0, 0), cB, voffB); PG8_STAGE(PG8_SA(0, 0), cA, voffA); PG8_STAGE(PG8_SB(0, 1), cB + hstep, voffB); PG8_STAGE(PG8_SA(0, 1), cA + hstep, voffA);
        if (wr == 1) PG8_BAR;
        PG8_WAIT_V(4); PG8_BAR;
        PG8_STAGE(PG8_SB(1, 0), cB + kstep, voffB); PG8_STAGE(PG8_SA(1, 0), cA + kstep, voffA); PG8_STAGE(PG8_SB(1, 1), cB + hstep + kstep, voffB);
        PG8_WAIT_V(6); PG8_BAR;
    }
    for (;;) {
        const bool has_next = S.next(ui + 1, nxt);
        const char* nA = has_next ? (const char*)g.A + (size_t)nxt.pm * tstep + (size_t)nxt.k0 * 2 : cA; const char* nB = has_next ? (const char*)g.Bt + (size_t)nxt.pn * tstep + (size_t)nxt.k0 * 2 : cB;
        const int unt = cur.nt ? cur.nt : nt;
        for (int t = 0; t < unt; t += 2) {
            const bool last = (t == unt - 2);
            const char* a1 = cA + (size_t)(t + 1) * kstep;
            const char* a2 = last ? nA : cA + (size_t)(t + 2) * kstep; const char* b2 = last ? nB : cB + (size_t)(t + 2) * kstep;
            const char* a3 = a2 + kstep; const char* b3 = b2 + kstep;
            if (last && has_next) S.a_ready(nxt);
            if constexpr (SP2) {
            PG8_LDB(B0, 0, 0); PG8_LDB(B1, 0, 1); PG8_SCHED; PG8_LDA(At, 0, 0); PG8_STAGE(PG8_SA(1, 1), a1 + hstep, voffA);
            PG8_WAIT_V(8); PG8_WAIT_L(0); PG8_BAR; PG8_MMA(0, 0, At, B0); PG8_MMA(0, 1, At, B1); PG8_BAR; PG8_SCHED;
            PG8_LDA(At, 0, 1); PG8_STAGE(PG8_SB(0, 0), b2, voffB); PG8_STAGE(PG8_SB(0, 1), b2 + hstep, voffB); PG8_STAGE(PG8_SA(0, 0), a2, voffA);
            PG8_WAIT_V(8); PG8_WAIT_L(0); PG8_BAR; PG8_MMA(1, 0, At, B0); PG8_MMA(1, 1, At, B1); PG8_BAR; PG8_SCHED;
            PG8_LDB(B0, 1, 0); PG8_LDB(B1, 1, 1); PG8_SCHED; PG8_LDA(At, 1, 0); PG8_STAGE(PG8_SA(0, 1), a2 + hstep, voffA);
            PG8_WAIT_V(8); PG8_WAIT_L(0); PG8_BAR; PG8_MMA(0, 0, At, B0); PG8_MMA(0, 1, At, B1); PG8_BAR; PG8_SCHED;
            PG8_LDA(At, 1, 1); PG8_STAGE(PG8_SB(1, 0), b3, voffB); PG8_STAGE(PG8_SB(1, 1), b3 + hstep, voffB); PG8_STAGE(PG8_SA(1, 0), a3, voffA);
            PG8_WAIT_V(8); PG8_WAIT_L(0); PG8_BAR; PG8_MMA(1, 0, At, B0); PG8_MMA(1, 1, At, B1); PG8_BAR; PG8_SCHED;
            } else {
            PG8_LDB(B0, 0, 0); PG8_SCHED; PG8_LDA(At, 0, 0); PG8_STAGE(PG8_SA(1, 1), a1 + hstep, voffA);
            PG8_WAIT_L(8); PG8_BAR; PG8_WAIT_L(0); PG8_MMA(0, 0, At, B0); PG8_BAR; PG8_SCHED;
            PG8_LDB(B1, 0, 1); PG8_STAGE(PG8_SB(0, 0), b2, voffB);
            PG8_BAR; PG8_WAIT_L(0); PG8_MMA(0, 1, At, B1); PG8_BAR;
            PG8_LDA(At, 0, 1); PG8_STAGE(PG8_SA(0, 0), a2, voffA);
            PG8_BAR; PG8_WAIT_L(0); PG8_MMA(1, 0, At, B0); PG8_BAR; PG8_SCHED;
            PG8_STAGE(PG8_SB(0, 1), b2 + hstep, voffB);
            PG8_WAIT_V(6); PG8_BAR; PG8_MMA(1, 1, At, B1); PG8_BAR;
            PG8_LDB(B0, 1, 0); PG8_SCHED; PG8_LDA(At, 1, 0); PG8_STAGE(PG8_SA(0, 1), a2 + hstep, voffA);
            PG8_WAIT_L(8); PG8_BAR; PG8_WAIT_L(0); PG8_MMA(0, 0, At, B0); PG8_BAR; PG8_SCHED;
            PG8_LDB(B1, 1, 1); PG8_STAGE(PG8_SB(1, 0), b3, voffB);
            PG8_BAR; PG8_WAIT_L(0); PG8_MMA(0, 1, At, B1); PG8_BAR;
            PG8_LDA(At, 1, 1); PG8_STAGE(PG8_SA(1, 0), a3, voffA);
            PG8_BAR; PG8_WAIT_L(0); PG8_MMA(1, 0, At, B0); PG8_BAR; PG8_SCHED;
            PG8_STAGE(PG8_SB(1, 1), b3 + hstep, voffB);
            PG8_WAIT_V(6); PG8_BAR; PG8_MMA(1, 1, At, B1); PG8_BAR;
            }
        }
        if constexpr (ALIGN_EPI) { if (wr == 0) PG8_BAR; }
        if constexpr (!Epi::AFTER_DRAIN) { E(acc, cur, wr, wc, fr, fq); S.done(cur); }
        if (!has_next) break;
#pragma unroll
        for (int a = 0; a < 2; ++a)
#pragma unroll
            for (int b = 0; b < 2; ++b)
#pragma unroll
                for (int m = 0; m < 4; ++m)
#pragma unroll
                    for (int n = 0; n < 2; ++n) acc[a][b][m][n] = (f32x4){0.f, 0.f, 0.f, 0.f};
        cur = nxt; cA = nA; cB = nB; ++ui;
        if constexpr (ALIGN_EPI) { if (wr == 1) PG8_BAR; }
    }
    PG8_WAIT_V(0);
    if constexpr (!ALIGN_EPI) { if (wr == 0) PG8_BAR; }
    PG8_BAR;
    if constexpr (Epi::AFTER_DRAIN) { E.fused(acc, cur, wr, wc, fr, fq, lds, wid, lane); S.done(cur); }
#undef PG8_SA
#undef PG8_SB
#undef PG8_STAGE
#undef PG8_LDA
#undef PG8_LDB
#undef PG8_MMA
#undef PG8_WAIT_V
#undef PG8_WAIT_L
#undef PG8_BAR
#undef PG8_SCHED
}
}
#define GAS __attribute__((address_space(1)))
#define LAS __attribute__((address_space(3)))
typedef unsigned short bf16;
typedef unsigned v4u __attribute__((ext_vector_type(4)));
typedef unsigned v2u __attribute__((ext_vector_type(2)));
typedef float f32x4 __attribute__((ext_vector_type(4)));
typedef float f32x16 __attribute__((ext_vector_type(16)));
typedef short bf16x8 __attribute__((ext_vector_type(8)));
typedef short s16x4 __attribute__((ext_vector_type(4)));
typedef GAS unsigned gu32;
#define RLX_AGENT __ATOMIC_RELAXED, __HIP_MEMORY_SCOPE_AGENT
#define XB_TMO      128
#define XB_XCNT(j)  (256  + 64 * (j))
#define XB_XSUB(j)  (1280 + 64 * (j))
#define XB_XGEN(j)  (2304 + 64 * (j))
#define XB_TOP      3328
#define XB_TOPGEN   3392
#define XCD_BAR_WORDS 3456
#define XB_SPIN_CAP (1u << 18)

__device__ __forceinline__ unsigned xb_ld(unsigned* p)              { return __hip_atomic_load(p, __ATOMIC_RELAXED, __HIP_MEMORY_SCOPE_AGENT); }
__device__ __forceinline__ unsigned xb_add(unsigned* p, unsigned v) { return __hip_atomic_fetch_add(p, v, __ATOMIC_RELAXED, __HIP_MEMORY_SCOPE_AGENT); }
__device__ __forceinline__ unsigned xb_xcc_id() { return (unsigned)__builtin_amdgcn_s_getreg((3 << 11) | 20) & 0xFu; }
#define XB_SPIN(cond, bar) do { unsigned _sp = 0; while (cond) { __builtin_amdgcn_s_sleep(1); \
    if ((++_sp & 255u) == 0u) { if (xb_ld(&(bar)[XB_TMO])) break; if (_sp > XB_SPIN_CAP) { atomicAdd(&(bar)[XB_TMO], 1u); break; } } } } while (0)

struct XcdBarrier {
    unsigned* bar; unsigned x;
    volatile LAS unsigned* st;
    unsigned wv;
};

__device__ __forceinline__ unsigned xb_lane() { return __builtin_amdgcn_mbcnt_hi(~0u, __builtin_amdgcn_mbcnt_lo(~0u, 0u)); }
__device__ __forceinline__ XcdBarrier xcd_barrier_post(unsigned* bar, volatile LAS unsigned* st, unsigned wv) {
    XcdBarrier b; b.bar = bar; b.x = xb_xcc_id(); b.st = st; b.wv = wv;
    if (wv == 0u && xb_lane() == 0u) (void)xb_add(&bar[XB_XCNT(b.x)], 1u);
    return b;
}
__device__ __forceinline__ void xcd_barrier_complete(unsigned* bar, unsigned x, unsigned& nloc, unsigned& nx) {
    const unsigned G = gridDim.x * gridDim.y * gridDim.z;
    unsigned sum, cnt, mine, sp = 0u;
    for (;;) {
        sum = 0u; cnt = 0u; mine = 0u;
#pragma unroll
        for (unsigned j = 0; j < 16; ++j) { const unsigned c = xb_ld(&bar[XB_XCNT(j)]); sum += c; cnt += (c > 0u) ? 1u : 0u; mine = (j == x) ? c : mine; }
        if (sum == G) break;
        __builtin_amdgcn_s_sleep(1);
        if ((++sp & 255u) == 0u) { if (xb_ld(&bar[XB_TMO])) break; if (sp > XB_SPIN_CAP) { atomicAdd(&bar[XB_TMO], 1u); break; } }
    }
    nloc = mine > 0u ? mine : 1u; nx = cnt > 0u ? cnt : 1u;
}

__device__ __forceinline__ void xcd_barrier(const XcdBarrier& b) {
    asm volatile("s_waitcnt vmcnt(0)" ::: "memory");
    __syncthreads();
    if (b.wv == 0u && xb_lane() == 0u) {
        unsigned* bar = b.bar;
        __builtin_amdgcn_s_waitcnt(0);
        unsigned nloc = b.st[0], nx = b.st[1];
        if (nloc == 0u) { xcd_barrier_complete(bar, b.x, nloc, nx); b.st[0] = nloc; b.st[1] = nx; }
        const unsigned old = xb_add(&bar[XB_XSUB(b.x)], 1u);
        const unsigned gen = old / nloc;
        if (old + 1u == (gen + 1u) * nloc) {
            __builtin_amdgcn_fence(__ATOMIC_RELEASE, "agent");
            asm volatile("s_waitcnt vmcnt(0)" ::: "memory");
            const unsigned og = xb_add(&bar[XB_TOP], 1u);
            const unsigned tg = og / nx;
            if (og + 1u == (tg + 1u) * nx) xb_add(&bar[XB_TOPGEN], 1u);
            else XB_SPIN(xb_ld(&bar[XB_TOPGEN]) == tg, bar);
            __builtin_amdgcn_fence(__ATOMIC_ACQUIRE, "agent");
            xb_add(&bar[XB_XGEN(b.x)], 1u);
            asm volatile("s_waitcnt vmcnt(0)" ::: "memory");
        } else {
            XB_SPIN(xb_ld(&bar[XB_XGEN(b.x)]) == gen, bar);
            __builtin_amdgcn_fence(__ATOMIC_ACQUIRE, "agent");
            asm volatile("s_waitcnt vmcnt(0)" ::: "memory");
        }
    }
    __syncthreads();
}
#ifndef ONE_LAUNCH
#define ONE_LAUNCH 1
#endif
#ifndef NLAYERS
#define NLAYERS 4
#endif
constexpr int DM = 2048, MR = 8704, NLATR = 8192;
constexpr int NINP = 6400, DFF = 5632, NUP = 11264, EVIN = 6176, ODIN = 6160;
constexpr int NWAVES = 8, NTHR = 512;
constexpr float EPS = 1e-6f;
constexpr int NCHUNK = 68;
constexpr int PPL = 11, NPH = 1 + 4 * PPL;
constexpr size_t MiB = 1ull << 20;
constexpr size_t WS_CTL = 0, CTL_BYTES = 1 * MiB;
constexpr size_t WS_MOD = 1 * MiB, WS_ROPE = 1 * MiB + 640 * 1024;
constexpr size_t WS_W = 4 * MiB, W_LAYER = 99 * MiB, W_OUT = 25 * MiB, W_UP = 33 * MiB, W_DN = 77 * MiB;
constexpr size_t WS_XS = 400 * MiB, WS_H = 468 * MiB, WS_MIX = 502 * MiB, WS_P = 536 * MiB, WS_U = 644 * MiB, WS_ACT = 832 * MiB;
constexpr size_t WS_QR = 926 * MiB, WS_KR = 943 * MiB, WS_MQK = 960 * MiB, WS_DST = 977 * MiB, WS_SST = 1113 * MiB, WS_SM = 1181 * MiB, WS_B1 = 1185 * MiB, WS_B2 = 1186 * MiB, WS_END = 1187 * MiB;
constexpr size_t WS_SSQ = 524288;
constexpr size_t SM_GAM = 0, SM_DN = 1 * MiB, SM_NIN = 2 * MiB, SM_BL = 3 * MiB, SM_ML = 3 * MiB + 8192, SM_MIN = 3 * MiB + 16384;
constexpr int CW_BAR = 4096;
constexpr int LDS_BYTES = 147456, MISC_OFF = 131072 + 320;

struct Args { const float* in[27]; float* out; unsigned char* ws; int ph_lo, ph_hi, li, pad; };

__device__ __forceinline__ float bf_lo(unsigned u) { return __builtin_bit_cast(float, u << 16); }
__device__ __forceinline__ float bf_hi(unsigned u) { return __builtin_bit_cast(float, u & 0xffff0000u); }
__device__ __forceinline__ float bf1(bf16 b) { return __builtin_bit_cast(float, (unsigned)b << 16); }
typedef float f32x2_t __attribute__((ext_vector_type(2))); typedef __bf16 bf16x2_t __attribute__((ext_vector_type(2)));
__device__ __forceinline__ unsigned pk2(float lo, float hi) { f32x2_t v = {lo, hi}; bf16x2_t b = __builtin_convertvector(v, bf16x2_t); return __builtin_bit_cast(unsigned, b); }
__device__ __forceinline__ bf16 f2bf(float f) { return (bf16)(pk2(f, 0.f) & 0xffffu); }
__device__ __forceinline__ void unpack8(const v4u w, float (&f)[8]) { f[0] = bf_lo(w.x); f[1] = bf_hi(w.x); f[2] = bf_lo(w.y); f[3] = bf_hi(w.y); f[4] = bf_lo(w.z); f[5] = bf_hi(w.z); f[6] = bf_lo(w.w); f[7] = bf_hi(w.w); }
__device__ __forceinline__ v4u pack8(const float (&f)[8]) { v4u w; w.x = pk2(f[0], f[1]); w.y = pk2(f[2], f[3]); w.z = pk2(f[4], f[5]); w.w = pk2(f[6], f[7]); return w; }
__device__ __forceinline__ float silu_f(float x) { return x / (1.f + __expf(-x)); }
__device__ __forceinline__ float sigmoid_f(float x) { return 1.f / (1.f + __expf(-x)); }
__device__ __forceinline__ float logsig_f(float z) { return fminf(z, 0.f) - __logf(1.f + __expf(-fabsf(z))); }
__device__ __forceinline__ float wave_sum(float v) {
#pragma unroll
    for (int o = 1; o < 64; o <<= 1) v += __shfl_xor(v, o);
    return v;
}
__device__ __forceinline__ float wave_max(float v) {
#pragma unroll
    for (int o = 1; o < 64; o <<= 1) v = fmaxf(v, __shfl_xor(v, o));
    return v;
}
__device__ __forceinline__ float wave_scan_sum(float v, int dir, int lane) {
#pragma unroll
    for (int o = 1; o < 64; o <<= 1) { const float up = __shfl_up(v, o), dn = __shfl_down(v, o); if (dir == 0) { if (lane >= o) v += up; } else { if (lane + o < 64) v += dn; } }
    return v;
}
__device__ __forceinline__ float wave_scan_max(float v, int dir, int lane) {
#pragma unroll
    for (int o = 1; o < 64; o <<= 1) { const float up = __shfl_up(v, o), dn = __shfl_down(v, o); if (dir == 0) { if (lane >= o) v = fmaxf(v, up); } else { if (lane + o < 64) v = fmaxf(v, dn); } }
    return v;
}
__device__ __forceinline__ bool seq_start(int r) { return r < NLATR ? (r & 4095) == 0 : ((r - NLATR) & 255) == 0; }

__device__ __forceinline__ bf16x8 frag_row(LAS const unsigned char* base, int stride, int row0, int k0, int lane) {
    return *(LAS const bf16x8*)(base + (row0 + (lane & 31)) * stride + (k0 + 8 * (lane >> 5)) * 2);
}
__device__ __forceinline__ s16x4 tr4(LAS const unsigned char* p) { return __builtin_amdgcn_ds_read_tr16_b64_v4i16((LAS s16x4*)p); }
__device__ __forceinline__ bf16x8 frag_tr(LAS const unsigned char* base, int stride, int k0, int col0, int lane) {
    const int h = lane >> 5, blk = (lane >> 4) & 1, q = (lane & 15) >> 2, p = lane & 3;
    LAS const unsigned char* a = base + (k0 + 8 * h + q) * stride + (col0 + 16 * blk + 4 * p) * 2;
    const s16x4 lo = tr4(a), hi = tr4(a + 4 * stride);
    return (bf16x8){lo[0], lo[1], lo[2], lo[3], hi[0], hi[1], hi[2], hi[3]};
}
__device__ __forceinline__ bf16x8 frag_tr_perm(LAS const unsigned char* base, int stride, int k0, int col0, int lane) {
    const int h = lane >> 5, blk = (lane >> 4) & 1, q = (lane & 15) >> 2, p = lane & 3;
    LAS const unsigned char* a = base + (k0 + 4 * h + q) * stride + (col0 + 16 * blk + 4 * p) * 2;
    const s16x4 lo = tr4(a), hi = tr4(a + 8 * stride);
    return (bf16x8){lo[0], lo[1], lo[2], lo[3], hi[0], hi[1], hi[2], hi[3]};
}
__device__ __forceinline__ int swz_off(int row, int ch) { return 256 * row + 16 * (ch ^ (((row & 3) << 2) | ((row >> 2) & 3))); }
__device__ __forceinline__ bf16x8 sfrag_row(LAS const unsigned char* base, int row0, int k0, int lane) {
    return *(LAS const bf16x8*)(base + swz_off(row0 + (lane & 31), (k0 >> 3) + (lane >> 5)));
}
__device__ __forceinline__ bf16x8 sfrag_tr_perm(LAS const unsigned char* base, int k0, int col0, int lane) {
    const int h = lane >> 5, blk = (lane >> 4) & 1, q = (lane & 15) >> 2, p = lane & 3, ch = (col0 >> 3) + 2 * blk + (p >> 1), r0 = k0 + 4 * h + q;
    const s16x4 lo = tr4(base + swz_off(r0, ch) + 8 * (p & 1)), hi = tr4(base + swz_off(r0 + 8, ch) + 8 * (p & 1));
    return (bf16x8){lo[0], lo[1], lo[2], lo[3], hi[0], hi[1], hi[2], hi[3]};
}
#define MFMA32(a, b, c) __builtin_amdgcn_mfma_f32_32x32x16_bf16((a), (b), (c), 0, 0, 0)
__device__ __forceinline__ f32x16 zero16() { f32x16 z;
#pragma unroll
    for (int i = 0; i < 16; ++i) z[i] = 0.f;
    return z; }
__device__ __forceinline__ void load_tile(LAS unsigned char* dst, int ls, const bf16* src, size_t ld, int rows, int cols, int tid) {
    const int cpr = cols >> 3, n = rows * cpr;
    for (int c = tid; c < n; c += NTHR) { const int r = c / cpr, cc = c - r * cpr; *(LAS v4u*)(dst + r * ls + cc * 16) = *(const v4u*)(src + (size_t)r * ld + cc * 8); }
}

struct TrItem { const float* W; bf16* WT; int K, N, k0, n0, dn0; };
__device__ __forceinline__ void tr_issue(const TrItem& t, f32x4 (&v)[8], int lane) {
    const int n = t.n0 + 4 * (lane & 7);
#pragma unroll
    for (int i = 0; i < 8; ++i) { const int kk = 8 * i + (lane >> 3); v[i] = n < t.N ? *(const f32x4*)(t.W + (size_t)(t.k0 + kk) * t.N + n) : (f32x4){0.f, 0.f, 0.f, 0.f}; }
}
__device__ __forceinline__ void tr_finish(const TrItem& t, const f32x4 (&v)[8], LAS float* scr, int lane) {
#pragma unroll
    for (int i = 0; i < 8; ++i) { const int kk = 8 * i + (lane >> 3); LAS float* d = scr + kk * 33 + 4 * (lane & 7); d[0] = v[i].x; d[1] = v[i].y; d[2] = v[i].z; d[3] = v[i].w; }
    asm volatile("s_waitcnt lgkmcnt(0)" ::: "memory");
    const int c = lane & 7;
#pragma unroll
    for (int j = 0; j < 4; ++j) { const int nn = (lane >> 3) + 8 * j; const LAS float* s = scr + (8 * c) * 33 + nn;
        v4u o; o.x = pk2(s[0 * 33], s[1 * 33]); o.y = pk2(s[2 * 33], s[3 * 33]); o.z = pk2(s[4 * 33], s[5 * 33]); o.w = pk2(s[6 * 33], s[7 * 33]);
        *(v4u*)(t.WT + (size_t)(t.dn0 + nn) * t.K + t.k0 + 8 * c) = o; }
    asm volatile("s_waitcnt lgkmcnt(0)" ::: "memory");
}
__device__ __forceinline__ void tr_decode(const Args& a, unsigned char* ws, int g, TrItem& t) {
    const int layer = g / 25344; int r = g - layer * 25344; const int li = layer >> 1;
    unsigned char* wb = ws + WS_W + (size_t)layer * W_LAYER;
    int nblk;
    if (r < 6400) { if (layer & 1) { t.W = a.in[14] + (size_t)li * DM * ODIN; t.N = ODIN; } else { t.W = a.in[8] + (size_t)li * DM * EVIN; t.N = EVIN; } t.WT = (bf16*)wb; t.K = DM; nblk = NINP / 32; }
    else if ((r -= 6400) < 2048) { t.W = (layer & 1 ? a.in[15] : a.in[9]) + (size_t)li * DM * DM; t.N = DM; t.WT = (bf16*)(wb + W_OUT); t.K = DM; nblk = DM / 32; }
    else if ((r -= 2048) < 11264) { t.W = a.in[23] + (size_t)layer * DM * NUP; t.N = NUP; t.WT = (bf16*)(wb + W_UP); t.K = DM; nblk = NUP / 32; }
    else { r -= 11264; t.W = a.in[26] + (size_t)layer * DFF * DM; t.N = DM; t.WT = (bf16*)(wb + W_DN); t.K = DFF; nblk = DM / 32; }
    const int kb = r / nblk, nb = r - kb * nblk; t.k0 = 64 * kb; t.n0 = 32 * nb; t.dn0 = t.n0;
    if (t.N == NUP) { const int m0 = t.n0 < DFF ? t.n0 : t.n0 - DFF; t.dn0 = 256 * (m0 >> 7) + (t.n0 < DFF ? 0 : 128) + (m0 & 127); }
}
__device__ __forceinline__ void ph_convert(const Args& a, unsigned char* ws, LAS unsigned char* lds, int g_lo, int g_hi, int w, int nw, int wave, int lane) {
    LAS float* scr = (LAS float*)(lds + wave * 8448);
    TrItem cur, nxt; f32x4 va[8], vb[8];
    int g = g_lo + w;
    if (g < g_hi) { tr_decode(a, ws, g, cur); tr_issue(cur, va, lane); }
    while (g < g_hi) {
        const int g1 = g + nw; if (g1 < g_hi) { tr_decode(a, ws, g1, nxt); tr_issue(nxt, vb, lane); }
        tr_finish(cur, va, scr, lane);
        const int g2 = g1 + nw; if (g1 < g_hi) { if (g2 < g_hi) { tr_decode(a, ws, g2, cur); tr_issue(cur, va, lane); } tr_finish(nxt, vb, scr, lane); }
        g = g2;
    }
}
__device__ __forceinline__ void ph_prologue(const Args& a, unsigned char* ws, LAS unsigned char* lds, int tid, int lane, int wave, int bid, int G) {
    float* MOD = (float*)(ws + WS_MOD);
    LAS float* vec = (LAS float*)(lds + 73728);
    LAS float* red = (LAS float*)(lds + 98304);
    for (int e = tid; e < 3 * DM; e += NTHR) { const float v = e < 2 * DM ? a.in[1][e] : a.in[3][e - 2 * DM]; vec[e] = silu_f(v); }
    __syncthreads();
    for (int it = bid; it < 4 * 192; it += G) {
        const int layer = it / 192, cg = it - layer * 192, col = cg * 64 + 4 * (lane & 15), rq = lane >> 4;
        const float* W = a.in[4] + (size_t)layer * DM * 12288 + col;
        f32x4 a0 = {0.f, 0.f, 0.f, 0.f}, a1 = a0, a2 = a0;
#pragma unroll 16
        for (int i = 0; i < 64; ++i) { const int kk = 256 * wave + 4 * i + rq; const f32x4 w4 = *(const f32x4*)(W + (size_t)kk * 12288);
            a0 += w4 * vec[kk]; a1 += w4 * vec[DM + kk]; a2 += w4 * vec[2 * DM + kk]; }
#pragma unroll
        for (int e = 0; e < 4; ++e) { a0[e] += __shfl_xor(a0[e], 16); a0[e] += __shfl_xor(a0[e], 32); a1[e] += __shfl_xor(a1[e], 16); a1[e] += __shfl_xor(a1[e], 32); a2[e] += __shfl_xor(a2[e], 16); a2[e] += __shfl_xor(a2[e], 32); }
        if (lane < 16) { *(LAS f32x4*)(red + (wave * 3 + 0) * 64 + 4 * lane) = a0; *(LAS f32x4*)(red + (wave * 3 + 1) * 64 + 4 * lane) = a1; *(LAS f32x4*)(red + (wave * 3 + 2) * 64 + 4 * lane) = a2; }
        __syncthreads();
        if (tid < 192) { const int j = tid >> 6, c = tid & 63; float s = a.in[5][layer * 12288 + cg * 64 + c];
#pragma unroll
            for (int w = 0; w < 8; ++w) s += red[(w * 3 + j) * 64 + c];
            MOD[(size_t)(layer * 3 + j) * 12288 + cg * 64 + c] = s; }
        __syncthreads();
    }
    if (bid == G - 1) { float* rope = (float*)(ws + WS_ROPE);
        for (int e = tid; e < 1024; e += NTHR) { const int pos = e >> 4, f = e & 15; const float inv = powf(10000.f, -(float)f / 16.f), ang = (float)pos * inv; rope[e] = cosf(ang); rope[1024 + e] = sinf(ang); } }
    ph_convert(a, ws, lds, 0, 25344, bid * NWAVES + wave, G * NWAVES, wave, lane);
}

__device__ __forceinline__ void fuse_row(const float* src, float* XS, int row, int lane, const float* part, const float* pgate, int nsplit, const float* ng, const float* msc, bf16* H, float* ssq) {
    const int mi = row < NLATR ? (row >> 12) : 2;
    const f32x4* sr = (const f32x4*)src + lane; f32x4* xr = (f32x4*)(XS + (size_t)row * DM) + lane;
    f32x4 v[8];
#pragma unroll
    for (int j = 0; j < 8; ++j) v[j] = sr[64 * j];
    if (nsplit > 0) {
        f32x4 sacc[8];
#pragma unroll
        for (int j = 0; j < 8; ++j) sacc[j] = (f32x4){0.f, 0.f, 0.f, 0.f};
        for (int sp = 0; sp < nsplit; ++sp) { const f32x4* pr = (const f32x4*)(part + ((size_t)sp * 512 + (row - NLATR)) * DM) + lane;
#pragma unroll
            for (int j = 0; j < 8; ++j) sacc[j] += pr[64 * j]; }
#pragma unroll
        for (int j = 0; j < 8; ++j) v[j] += *(const f32x4*)(pgate + 4 * lane + 256 * j) * sacc[j];
    }
    float ss = 0.f;
#pragma unroll
    for (int j = 0; j < 8; ++j) { xr[64 * j] = v[j]; ss += (v[j].x * v[j].x + v[j].y * v[j].y) + (v[j].z * v[j].z + v[j].w * v[j].w); }
    ss = wave_sum(ss);
    if (lane == 0) ssq[row] = ss;
#pragma unroll
    for (int j = 0; j < 8; ++j) { const int col = 4 * lane + 256 * j;
        const f32x4 y = v[j] * *(const f32x4*)(ng + col) * (*(const f32x4*)(msc + (size_t)mi * 12288 + col) + 1.f);
        v2u o; o.x = pk2(y.x, y.y); o.y = pk2(y.z, y.w);
        *(v2u*)(H + (size_t)row * DM + col) = o; }
}
__device__ __forceinline__ void ph_norm0(const float* x, const float* ctx, float* XS, const float* ng, const float* msc, bf16* H, float* ssq, int gw, int NGW, int lane) {
    for (int row = gw; row < MR; row += NGW) fuse_row(row < NLATR ? x + (size_t)row * DM : ctx + (size_t)(row - NLATR) * DM, XS, row, lane, nullptr, nullptr, 0, ng, msc, H, ssq);
}
template <int NS>
__device__ __forceinline__ void ph_ctxfix(float* XS, const float* part, const float* pgate, const float* ng, const float* msc, bf16* H, float* ssq, int gw, int NGW, int lane) {
    for (int it = gw; it < 2048; it += NGW) {
        const int row = NLATR + (it >> 2), c0 = (it & 3) * 512 + 8 * lane;
        float* xp = XS + (size_t)row * DM + c0;
        f32x4 v0 = *(const f32x4*)xp, v1 = *(const f32x4*)(xp + 4);
        f32x4 p0[NS], p1[NS];
#pragma unroll
        for (int sp = 0; sp < NS; ++sp) { const float* pp = part + ((size_t)sp * 512 + (row - NLATR)) * DM + c0; p0[sp] = *(const f32x4*)pp; p1[sp] = *(const f32x4*)(pp + 4); }
        f32x4 s0 = p0[0], s1 = p1[0];
#pragma unroll
        for (int sp = 1; sp < NS; ++sp) { s0 += p0[sp]; s1 += p1[sp]; }
        v0 += *(const f32x4*)(pgate + c0) * s0; v1 += *(const f32x4*)(pgate + c0 + 4) * s1;
        *(f32x4*)xp = v0; *(f32x4*)(xp + 4) = v1;
        float ss = (v0.x * v0.x + v0.y * v0.y) + (v0.z * v0.z + v0.w * v0.w) + (v1.x * v1.x + v1.y * v1.y) + (v1.z * v1.z + v1.w * v1.w);
        ss = wave_sum(ss);
        if (lane == 0) (void)__hip_atomic_fetch_add(ssq + row, ss, __ATOMIC_RELAXED, __HIP_MEMORY_SCOPE_AGENT);
        const f32x4 y0 = v0 * *(const f32x4*)(ng + c0) * (*(const f32x4*)(msc + 2 * 12288 + c0) + 1.f), y1 = v1 * *(const f32x4*)(ng + c0 + 4) * (*(const f32x4*)(msc + 2 * 12288 + c0 + 4) + 1.f);
        v4u o; o.x = pk2(y0.x, y0.y); o.y = pk2(y0.z, y0.w); o.z = pk2(y1.x, y1.y); o.w = pk2(y1.z, y1.w);
        *(v4u*)(H + (size_t)row * DM + c0) = o;
    }
}
__device__ __forceinline__ void ph_bias(const bf16* WIN, const bf16* WUPt, const float* mod, float* b1, float* b2, int gw, int NGW, int lane) {
    for (int which = 0; which < 2; ++which) {
        const bf16* WT = which ? WUPt : WIN; const int N = which ? NUP : NINP; const float* sh = mod + (which ? 3 * DM : 0); float* out = which ? b2 : b1;
        float s0[32], s1[32], s2[32];
#pragma unroll
        for (int i = 0; i < 4; ++i)
#pragma unroll
            for (int h = 0; h < 2; ++h) { const int k = 512 * i + 8 * lane + 4 * h; const f32x4 a0 = *(const f32x4*)(sh + k), a1 = *(const f32x4*)(sh + 12288 + k), a2 = *(const f32x4*)(sh + 2 * 12288 + k);
#pragma unroll
                for (int el = 0; el < 4; ++el) { s0[8 * i + 4 * h + el] = a0[el]; s1[8 * i + 4 * h + el] = a1[el]; s2[8 * i + 4 * h + el] = a2[el]; } }
#pragma unroll 1
        for (int n0 = gw * 2; n0 < N; n0 += NGW * 2) {
            v4u wv[2][4];
#pragma unroll
            for (int rr = 0; rr < 2; ++rr)
#pragma unroll
                for (int i = 0; i < 4; ++i) wv[rr][i] = *(const v4u*)(WT + (size_t)(n0 + rr) * DM + 512 * i + 8 * lane);
            float d[2][3];
#pragma unroll
            for (int rr = 0; rr < 2; ++rr) { d[rr][0] = 0.f; d[rr][1] = 0.f; d[rr][2] = 0.f;
#pragma unroll
                for (int i = 0; i < 4; ++i) { float w[8]; unpack8(wv[rr][i], w);
#pragma unroll
                    for (int el = 0; el < 8; ++el) { d[rr][0] += w[el] * s0[8 * i + el]; d[rr][1] += w[el] * s1[8 * i + el]; d[rr][2] += w[el] * s2[8 * i + el]; } } }
#pragma unroll
            for (int rr = 0; rr < 2; ++rr)
#pragma unroll
                for (int j = 0; j < 3; ++j) d[rr][j] = wave_sum(d[rr][j]);
            if (lane == 0) {
#pragma unroll
                for (int rr = 0; rr < 2; ++rr) { out[n0 + rr] = d[rr][0]; out[N + n0 + rr] = d[rr][1]; out[2 * N + n0 + rr] = d[rr][2]; } }
        }
    }
}

template <int MODE>
__device__ __forceinline__ void ph_conv(const bf16* SRC, const float* cw, const float* cb, bf16* DST, int gtid, int NT) {
    constexpr int NC = MODE == 0 ? DFF : 1024, NCG = NC / 8, NRB = MR / 16;
    constexpr int LDS_ = MODE == 0 ? NUP : NINP, LDD = MODE == 0 ? DFF : (MODE == 1 ? DM : 1024);
    for (int it = gtid; it < NRB * NCG; it += NT) {
        const int rb = it / NCG, cg = it - rb * NCG, r0 = rb * 16, c0 = cg * 8;
        float w0[8], w1[8], w2[8], bb[8];
#pragma unroll
        for (int j = 0; j < 8; ++j) { w0[j] = cw[c0 + j]; w1[j] = cw[NC + c0 + j]; w2[j] = cw[2 * NC + c0 + j]; bb[j] = MODE == 0 ? cb[c0 + j] : 0.f; }
        auto ld = [&](int r, float (&f)[8]) {
            if (MODE == 0) { unpack8(*(const v4u*)(SRC + (size_t)r * LDS_ + c0), f); }
            else if (MODE == 1) { float s1[8], s2[8]; unpack8(*(const v4u*)(SRC + (size_t)r * LDS_ + 3104 + c0), s1); unpack8(*(const v4u*)(SRC + (size_t)r * LDS_ + 5152 + c0), s2);
#pragma unroll
                for (int j = 0; j < 8; ++j) f[j] = s1[j] * s2[j]; }
            else { unpack8(*(const v4u*)(SRC + (size_t)r * LDS_ + 3072 + c0), f); }
        };
        float prev[8], cur[8], nxt[8];
        if (!seq_start(r0)) ld(r0 - 1, prev); else {
#pragma unroll
            for (int j = 0; j < 8; ++j) prev[j] = 0.f; }
        ld(r0, cur);
#pragma unroll 2
        for (int i = 0; i < 16; ++i) {
            const int r = r0 + i;
            if (i < 15 || !seq_start(r0 + 16)) ld(r + 1, nxt); else {
#pragma unroll
                for (int j = 0; j < 8; ++j) nxt[j] = 0.f; }
            float o[8];
            if (MODE == 0) { float vv[8]; unpack8(*(const v4u*)(SRC + (size_t)r * LDS_ + DFF + c0), vv);
#pragma unroll
                for (int j = 0; j < 8; ++j) o[j] = silu_f(w0[j] * prev[j] + w1[j] * cur[j] + w2[j] * nxt[j] + bb[j]) * vv[j]; }
            else if (MODE == 1) { float vv[8]; unpack8(*(const v4u*)(SRC + (size_t)r * LDS_ + 4128 + c0), vv);
#pragma unroll
                for (int j = 0; j < 8; ++j) o[j] = (w0[j] * prev[j] + w1[j] * cur[j] + w2[j] * nxt[j]) * vv[j]; }
            else { const float sc = c0 >= 512 ? 0.08838834764831845f : 1.f;
#pragma unroll
                for (int j = 0; j < 8; ++j) o[j] = silu_f(w0[j] * prev[j] + w1[j] * cur[j] + w2[j] * nxt[j]) * sc; }
            *(v4u*)(DST + (size_t)r * LDD + (MODE == 1 ? 1024 : 0) + c0) = pack8(o);
#pragma unroll
            for (int j = 0; j < 8; ++j) { prev[j] = cur[j]; cur[j] = nxt[j]; }
        }
    }
}

__device__ __forceinline__ void ph_act_fix(const float* halo, const float* cw, bf16* ACT, int gtid, int NT) {
    for (int e = gtid; e < 34 * 44 * 256; e += NT) {
        const int ch = e & 127, which = (e >> 7) & 1, tile = e >> 8, pm = tile / 44, pn = tile - pm * 44, chg = pn * 128 + ch;
        const float* hb = halo + (size_t)tile * 768;
        const int row = 256 * pm + (which ? 255 : 0);
        float g = 0.f;
        if (which == 0) { if (!seq_start(row)) g = halo[(size_t)(tile - 44) * 768 + 128 + ch] * cw[chg]; }
        else { if (!seq_start(row + 1)) g = halo[(size_t)(tile + 44) * 768 + ch] * cw[2 * DFF + chg]; }
        const float cv = hb[(2 + which) * 128 + ch] + g;
        ACT[(size_t)row * DFF + chg] = f2bf(silu_f(cv) * hb[(4 + which) * 128 + ch]);
    }
}

__device__ __forceinline__ void act_fix_tile(const float* halo, const float* cw, bf16* ACT, int pm, int tid) {
    f32x4 cp[6], vv[6], gg[6];
#pragma unroll
    for (int i = 0; i < 6; ++i) { const int e = tid + NTHR * i; const bool ok = e < 2816; const int ee = ok ? e : 0;
        const int c4 = ee & 31, which = (ee >> 5) & 1, pn = ee >> 6, tile = pm * 44 + pn, chg = pn * 128 + 4 * c4;
        const float* hb = halo + (size_t)tile * 768 + 4 * c4;
        const int row = 256 * pm + (which ? 255 : 0);
        cp[i] = *(const f32x4*)(hb + (2 + which) * 128); vv[i] = *(const f32x4*)(hb + (4 + which) * 128);
        const bool edge = which == 0 ? seq_start(row) : seq_start(row + 1);
        const f32x4 nb = edge ? (f32x4){0.f, 0.f, 0.f, 0.f} : *(const f32x4*)(halo + (size_t)(which == 0 ? tile - 44 : tile + 44) * 768 + (which == 0 ? 128 : 0) + 4 * c4);
        gg[i] = nb * *(const f32x4*)(cw + (which == 0 ? 0 : 2 * DFF) + chg); }
#pragma unroll
    for (int i = 0; i < 6; ++i) { const int e = tid + NTHR * i; if (e < 2816) {
        const int c4 = e & 31, which = (e >> 5) & 1, pn = e >> 6, chg = pn * 128 + 4 * c4; const int row = 256 * pm + (which ? 255 : 0);
        const f32x4 cv = cp[i] + gg[i];
        v2u o; o.x = pk2(silu_f(cv.x) * vv[i].x, silu_f(cv.y) * vv[i].y); o.y = pk2(silu_f(cv.z) * vv[i].z, silu_f(cv.w) * vv[i].w);
        *(v2u*)(ACT + (size_t)row * DFF + chg) = o; } }
}

__device__ __forceinline__ void ph_qkprep(const bf16* P, const float* qg, const float* kg, const float* rope, bf16* QR, bf16* KR, int gw, int NGW, int lane) {
    for (int it = gw; it < MR * 4; it += NGW) {
        const int row = it >> 2, qtr = it & 3, isk = qtr >> 1;
        float x[8]; unpack8(*(const v4u*)(P + (size_t)row * NINP + isk * 1024 + (qtr & 1) * 512 + 8 * lane), x);
        float ss = 0.f;
#pragma unroll
        for (int j = 0; j < 8; ++j) ss += x[j] * x[j];
        ss += __shfl_xor(ss, 1); ss += __shfl_xor(ss, 2); ss += __shfl_xor(ss, 4);
        const float r = rsqrtf(ss * (1.f / 64.f) + EPS);
        const int i = lane & 7; const float* gp = (isk ? kg : qg) + 8 * i;
        float y[8], o[8];
#pragma unroll
        for (int j = 0; j < 8; ++j) y[j] = x[j] * r * gp[j];
        if (row < NLATR) {
            const int t = row & 4095, pos = (i < 4) ? (t >> 6) : (t & 63), f0 = 8 * (i & 1);
#pragma unroll
            for (int j = 0; j < 8; ++j) { const float pj = __shfl_xor(y[j], 2), c = rope[pos * 16 + f0 + j], s = rope[1024 + pos * 16 + f0 + j];
                o[j] = (i & 2) ? (pj * s + y[j] * c) : (y[j] * c - pj * s); }
        } else {
#pragma unroll
            for (int j = 0; j < 8; ++j) o[j] = y[j]; }
        if (!isk) {
#pragma unroll
            for (int j = 0; j < 8; ++j) o[j] *= 0.18033688011112042f; }
        *(v4u*)((isk ? KR : QR) + (size_t)row * 1024 + (qtr & 1) * 512 + 8 * lane) = pack8(o);
    }
}

struct ScanP {
    const bf16* P; const bf16* MQK; bf16* MIX;
    const float* gw2; const float* gb;
    const float* mgb;
    const float* ng;
    bf16* DSTp; bf16* SSTp; float* GAM; float* DN; float* NIN; float* BL; float* ML; float* MINp;
};
__device__ __forceinline__ void scan_unit(int u, int& b, int& head, int& mm, int& rowbase) {
    b = u / 272; const int rem = u - b * 272; head = rem / 68; mm = rem - head * 68;
    rowbase = mm < 4 ? NLATR + b * 256 + 64 * mm : b * 4096 + 64 * (mm - 4);
}
__device__ __forceinline__ int scan_chunk(int mm, int dir) { return dir ? (mm < 4 ? 3 - mm : 71 - mm) : mm; }

__device__ __forceinline__ void gla_gates(const ScanP& s, LAS const float* glr, LAS float* tot, int head, int dir, int tid, float (&bb)[16], float& btot) {
    const int dk = tid & 127, grp = tid >> 7;
    float w2[16];
#pragma unroll
    for (int r = 0; r < 16; ++r) w2[r] = s.gw2[(dir * 16 + r) * 512 + head * 128 + dk];
    const float bias = s.gb[dir * 512 + head * 128 + dk];
#pragma unroll
    for (int tt = 0; tt < 16; ++tt) { const int t = 16 * grp + tt; float z = bias;
#pragma unroll
        for (int r = 0; r < 16; ++r) z += glr[t * 32 + dir * 16 + r] * w2[r];
        bb[tt] = logsig_f(z) * 0.0625f; }
    if (dir == 0) {
#pragma unroll
        for (int tt = 1; tt < 16; ++tt) bb[tt] += bb[tt - 1];
        tot[grp * 128 + dk] = bb[15];
    } else {
#pragma unroll
        for (int tt = 14; tt >= 0; --tt) bb[tt] += bb[tt + 1];
        tot[grp * 128 + dk] = bb[0];
    }
    __syncthreads();
    float off = 0.f; btot = 0.f;
#pragma unroll
    for (int g = 0; g < 4; ++g) { const float tv = tot[g * 128 + dk]; btot += tv; if (dir == 0 ? g < grp : g > grp) off += tv; }
#pragma unroll
    for (int tt = 0; tt < 16; ++tt) bb[tt] += off;
}

template <int MODE>
__device__ __forceinline__ void ph_scan_local(const ScanP& s, LAS unsigned char* lds, int tid, int lane, int wave, int bid, int G) {
    LAS unsigned char* Vs = lds; LAS unsigned char* Kh = lds + 33792;
    LAS float* glr = (LAS float*)(lds + 51200); LAS float* tot = (LAS float*)(lds + 59392); LAS float* wv = (LAS float*)(lds + 61440); LAS float* dnp = (LAS float*)(lds + 61696);
    const int dk = tid & 127, grp = tid >> 7;
    for (int u = bid; u < 544; u += G) {
        int b, head, mm, rowbase; scan_unit(u, b, head, mm, rowbase);
        load_tile(Vs, 528, s.P + (size_t)rowbase * NINP + (MODE ? 4096 : 1024) + head * 256, NINP, 64, 256, tid);
        if (MODE == 0) for (int e = tid; e < 2048; e += NTHR) glr[e] = bf1(s.P[(size_t)(rowbase + (e >> 5)) * NINP + 3072 + (e & 31)]);
        __syncthreads();
        for (int dir = 0; dir < 2; ++dir) {
            const int chain = (b * 4 + head) * 2 + dir, c = scan_chunk(mm, dir); const size_t cc = (size_t)chain * NCHUNK + c;
            if (MODE == 0) {
                float bb[16], btot; gla_gates(s, glr, tot, head, dir, tid, bb, btot);
#pragma unroll
                for (int tt = 0; tt < 16; ++tt) { const int t = 16 * grp + tt; const float kv = bf1(s.P[(size_t)(rowbase + t) * NINP + 512 + head * 128 + dk]) * __expf(btot - bb[tt]);
                    *(LAS bf16*)(Kh + t * 272 + dk * 2) = f2bf(kv); }
                if (grp == 0) s.GAM[cc * 128 + dk] = __expf(btot);
            } else {
                if (wave == 0) {
                    const float ig = bf1(s.P[(size_t)(rowbase + lane) * NINP + 6144 + dir * 8 + head]) + s.mgb[dir * 8 + head];
                    const float fg = bf1(s.P[(size_t)(rowbase + lane) * NINP + 6144 + dir * 8 + 4 + head]) + s.mgb[dir * 8 + 4 + head];
                    const float lf = logsig_f(fg), bcs = wave_scan_sum(lf, dir, lane), blast = wave_sum(lf);
                    const float gs = blast - bcs + ig, mloc = wave_max(gs);
                    wv[lane] = __expf(gs - mloc);
                    if (lane == 0) { s.BL[cc] = blast; s.ML[cc] = mloc; }
                }
                __syncthreads();
                float part = 0.f;
#pragma unroll
                for (int tt = 0; tt < 16; ++tt) { const int t = 16 * grp + tt; const float kv = bf1(s.MQK[(size_t)(rowbase + t) * 1024 + 512 + head * 128 + dk]) * wv[t];
                    *(LAS bf16*)(Kh + t * 272 + dk * 2) = f2bf(kv); part += kv; }
                dnp[grp * 128 + dk] = part;
            }
            __syncthreads();
            if (MODE == 1 && tid < 128) s.DN[cc * 128 + tid] = (dnp[tid] + dnp[128 + tid]) + (dnp[256 + tid] + dnp[384 + tid]);
            f32x16 acc[4];
#pragma unroll
            for (int nt = 0; nt < 4; ++nt) acc[nt] = zero16();
#pragma unroll
            for (int ks = 0; ks < 4; ++ks) { const bf16x8 af = frag_tr(Vs, 528, 16 * ks, 32 * wave, lane);
#pragma unroll
                for (int nt = 0; nt < 4; ++nt) { const bf16x8 bfr = frag_tr(Kh, 272, 16 * ks, 32 * nt, lane); acc[nt] = MFMA32(af, bfr, acc[nt]); } }
            bf16* D = s.DSTp + cc * 32768;
#pragma unroll
            for (int nt = 0; nt < 4; ++nt)
#pragma unroll
                for (int r = 0; r < 16; ++r) { const int dv = 32 * wave + (r & 3) + 8 * (r >> 2) + 4 * (lane >> 5); D[dv * 128 + 32 * nt + (lane & 31)] = f2bf(acc[nt][r]); }
            __syncthreads();
        }
    }
}

__device__ __forceinline__ void ph_gla_local(const ScanP& s, bf16* QT, bf16* KT, LAS unsigned char* lds, int tid, int lane, int wave, int bid, int G) {
    LAS unsigned char* Vs = lds; LAS unsigned char* Kh = lds + 33792; LAS unsigned char* Qr = lds + 51200; LAS unsigned char* Kr = lds + 68608;
    LAS float* glr = (LAS float*)(lds + 86016); LAS float* tot = (LAS float*)(lds + 90112);
    const int dk = tid & 127, grp = tid >> 7;
    for (int u = bid; u < 1088; u += G) {
        const int dir = u & 1; int b, head, mm, rowbase; scan_unit(u >> 1, b, head, mm, rowbase);
        const int chain = (b * 4 + head) * 2 + dir, c = scan_chunk(mm, dir); const size_t cc = (size_t)chain * NCHUNK + c;
        load_tile(Vs, 528, s.P + (size_t)rowbase * NINP + 1024 + head * 256, NINP, 64, 256, tid);
        load_tile(Qr, 272, s.P + (size_t)rowbase * NINP + head * 128, NINP, 64, 128, tid);
        load_tile(Kr, 272, s.P + (size_t)rowbase * NINP + 512 + head * 128, NINP, 64, 128, tid);
        for (int e = tid; e < 1024; e += NTHR) glr[e] = bf1(s.P[(size_t)(rowbase + (e >> 4)) * NINP + 3072 + dir * 16 + (e & 15)]);
        __syncthreads();
        float bb[16], btot;
        { float w2[16];
#pragma unroll
          for (int r = 0; r < 16; ++r) w2[r] = s.gw2[(dir * 16 + r) * 512 + head * 128 + dk];
          const float bias = s.gb[dir * 512 + head * 128 + dk];
#pragma unroll
          for (int tt = 0; tt < 16; ++tt) { const int t = 16 * grp + tt; float z = bias;
#pragma unroll
              for (int r = 0; r < 16; ++r) z += glr[t * 16 + r] * w2[r];
              bb[tt] = logsig_f(z) * 0.0625f; }
          if (dir == 0) {
#pragma unroll
              for (int tt = 1; tt < 16; ++tt) bb[tt] += bb[tt - 1];
              tot[grp * 128 + dk] = bb[15];
          } else {
#pragma unroll
              for (int tt = 14; tt >= 0; --tt) bb[tt] += bb[tt + 1];
              tot[grp * 128 + dk] = bb[0];
          }
          __syncthreads();
          float off = 0.f; btot = 0.f;
#pragma unroll
          for (int g = 0; g < 4; ++g) { const float tv = tot[g * 128 + dk]; btot += tv; if (dir == 0 ? g < grp : g > grp) off += tv; }
#pragma unroll
          for (int tt = 0; tt < 16; ++tt) bb[tt] += off; }
#pragma unroll
        for (int tt = 0; tt < 16; ++tt) { const int t = 16 * grp + tt;
            const float qv = bf1(*(LAS const bf16*)(Qr + t * 272 + dk * 2)), kv = bf1(*(LAS const bf16*)(Kr + t * 272 + dk * 2));
            const float e1 = __expf(bb[tt]);
            *(LAS bf16*)(Kh + t * 272 + dk * 2) = f2bf(kv * __expf(btot - bb[tt]));
            const size_t go = ((size_t)dir * MR + rowbase + t) * 512 + head * 128 + dk;
            QT[go] = f2bf(qv * e1 * 0.08838834764831845f); KT[go] = f2bf(kv * __builtin_amdgcn_rcpf(e1)); }
        if (grp == 0) s.GAM[cc * 128 + dk] = __expf(btot);
        __syncthreads();
        f32x16 acc[4];
#pragma unroll
        for (int nt = 0; nt < 4; ++nt) acc[nt] = zero16();
#pragma unroll
        for (int ks = 0; ks < 4; ++ks) { const bf16x8 af = frag_tr(Vs, 528, 16 * ks, 32 * wave, lane);
#pragma unroll
            for (int nt = 0; nt < 4; ++nt) { const bf16x8 bfr = frag_tr(Kh, 272, 16 * ks, 32 * nt, lane); acc[nt] = MFMA32(af, bfr, acc[nt]); } }
        bf16* D = s.DSTp + cc * 32768;
#pragma unroll
        for (int nt = 0; nt < 4; ++nt)
#pragma unroll
            for (int r = 0; r < 16; ++r) { const int dv = 32 * wave + (r & 3) + 8 * (r >> 2) + 4 * (lane >> 5); D[dv * 128 + 32 * nt + (lane & 31)] = f2bf(acc[nt][r]); }
        __syncthreads();
    }
}
__device__ __forceinline__ void ph_gla_out(const ScanP& s, const bf16* QT, const bf16* KT, LAS unsigned char* lds, int tid, int lane, int wave, int bid, int G) {
    LAS unsigned char* Vs = lds;
    LAS unsigned char* Qx = lds + 33792;
    LAS unsigned char* Ki = lds + 68608;
    LAS unsigned char* Am = lds + 103424;
    LAS float* Os = (LAS float*)lds;
    for (int u = bid; u < 544; u += G) {
        int b, head, mm, rowbase; scan_unit(u, b, head, mm, rowbase);
        load_tile(Vs, 528, s.P + (size_t)rowbase * NINP + 1024 + head * 256, NINP, 64, 256, tid);
#pragma unroll
        for (int dir = 0; dir < 2; ++dir) {
            load_tile(Qx + dir * 17408, 272, QT + ((size_t)dir * MR + rowbase) * 512 + head * 128, 512, 64, 128, tid);
            load_tile(Ki + dir * 17408, 272, KT + ((size_t)dir * MR + rowbase) * 512 + head * 128, 512, 64, 128, tid); }
        bf16x8 sf[2][8];
#pragma unroll
        for (int dir = 0; dir < 2; ++dir) { const int chain = (b * 4 + head) * 2 + dir, c = scan_chunk(mm, dir); const size_t cc = (size_t)chain * NCHUNK + c;
            const bf16* Sg = s.SSTp + cc * 32768 + (size_t)(32 * wave + (lane & 31)) * 128 + 8 * (lane >> 5);
#pragma unroll
            for (int ks = 0; ks < 8; ++ks) sf[dir][ks] = *(const bf16x8*)(Sg + 16 * ks); }
        __syncthreads();
        {
            const int dir = wave >> 2, ti = (wave >> 1) & 1, tj = wave & 1; f32x16 acc = zero16();
#pragma unroll
            for (int ks = 0; ks < 8; ++ks) { const bf16x8 af = frag_row(Qx + dir * 17408, 272, 32 * ti, 16 * ks, lane), bfr = frag_row(Ki + dir * 17408, 272, 32 * tj, 16 * ks, lane); acc = MFMA32(af, bfr, acc); }
            const int sidx = 32 * tj + (lane & 31);
#pragma unroll
            for (int r = 0; r < 16; ++r) { const int t = 32 * ti + (r & 3) + 8 * (r >> 2) + 4 * (lane >> 5);
                const bool keep = dir == 0 ? (sidx <= t) : (sidx >= t);
                *(LAS bf16*)(Am + dir * 9216 + t * 144 + sidx * 2) = f2bf(keep ? acc[r] : 0.f); }
        }
        __syncthreads();
        f32x16 acc2[2]; acc2[0] = zero16(); acc2[1] = zero16();
#pragma unroll
        for (int dir = 0; dir < 2; ++dir) {
#pragma unroll
            for (int ks = 0; ks < 8; ++ks)
#pragma unroll
                for (int rt = 0; rt < 2; ++rt) { const bf16x8 af = frag_row(Qx + dir * 17408, 272, 32 * rt, 16 * ks, lane); acc2[rt] = MFMA32(af, sf[dir][ks], acc2[rt]); }
#pragma unroll
            for (int ks = 0; ks < 4; ++ks) { const bf16x8 bfr = frag_tr(Vs, 528, 16 * ks, 32 * wave, lane);
#pragma unroll
                for (int rt = 0; rt < 2; ++rt) { const bf16x8 af = frag_row(Am + dir * 9216, 144, 32 * rt, 16 * ks, lane); acc2[rt] = MFMA32(af, bfr, acc2[rt]); } }
        }
        __syncthreads();
#pragma unroll
        for (int rt = 0; rt < 2; ++rt)
#pragma unroll
            for (int r = 0; r < 16; ++r) { const int t = 32 * rt + (r & 3) + 8 * (r >> 2) + 4 * (lane >> 5); Os[t * 260 + 32 * wave + (lane & 31)] = acc2[rt][r]; }
        __syncthreads();
        { const int t = tid >> 3, part = tid & 7; float o[32]; float ss = 0.f;
#pragma unroll
          for (int j = 0; j < 8; ++j) { const f32x4 v = *(LAS const f32x4*)(Os + t * 260 + 32 * part + 4 * j); o[4 * j] = v.x; o[4 * j + 1] = v.y; o[4 * j + 2] = v.z; o[4 * j + 3] = v.w; ss += (v.x * v.x + v.y * v.y) + (v.z * v.z + v.w * v.w); }
          ss += __shfl_xor(ss, 1); ss += __shfl_xor(ss, 2); ss += __shfl_xor(ss, 4);
          const float rn = rsqrtf(ss * (1.f / 256.f) + EPS);
          const size_t row = (size_t)(rowbase + t);
          const bf16* gsrc = s.P + row * NINP + 2048 + head * 256 + 32 * part;
          bf16* dst = s.MIX + row * DM + head * 256 + 32 * part;
#pragma unroll
          for (int j = 0; j < 4; ++j) { float gv[8], ov[8]; unpack8(*(const v4u*)(gsrc + 8 * j), gv);
#pragma unroll
              for (int e = 0; e < 8; ++e) ov[e] = o[8 * j + e] * rn * s.ng[32 * part + 8 * j + e] * silu_f(gv[e]);
              *(v4u*)(dst + 8 * j) = pack8(ov); } }
        __syncthreads();
    }
}

template <int MODE>
__device__ __forceinline__ void ph_scan_carry(const ScanP& s, int gtid, int NT) {
    for (int e = gtid; e < 16 * 8192; e += NT) {
        const int chain = e >> 13, rem = e & 8191, dv = rem >> 5, dk = (rem & 31) * 4;
        f32x4 st = {0.f, 0.f, 0.f, 0.f}, nst = st; float m = 0.f;
        for (int c0 = 0; c0 < NCHUNK; c0 += 4) {
            f32x4 d[4], gm[4]; float bl[4], ml[4];
#pragma unroll
            for (int j = 0; j < 4; ++j) { const size_t cc = (size_t)chain * NCHUNK + c0 + j; { const v2u dw = *(const v2u*)(s.DSTp + cc * 32768 + dv * 128 + dk); d[j] = (f32x4){bf_lo(dw.x), bf_hi(dw.x), bf_lo(dw.y), bf_hi(dw.y)}; }
                if (MODE == 0) gm[j] = *(const f32x4*)(s.GAM + cc * 128 + dk);
                else { bl[j] = s.BL[cc]; ml[j] = s.ML[cc]; gm[j] = (dv == 0) ? *(const f32x4*)(s.DN + cc * 128 + dk) : (f32x4){0.f, 0.f, 0.f, 0.f}; } }
#pragma unroll
            for (int j = 0; j < 4; ++j) { const size_t cc = (size_t)chain * NCHUNK + c0 + j;
                v2u o; o.x = pk2(st.x, st.y); o.y = pk2(st.z, st.w); *(v2u*)(s.SSTp + cc * 32768 + dv * 128 + dk) = o;
                if (MODE == 0) st = gm[j] * st + d[j];
                else { if (dv == 0) { *(f32x4*)(s.NIN + cc * 128 + dk) = nst; if (dk == 0) s.MINp[cc] = m; }
                    const float mn = fmaxf(bl[j] + m, ml[j]), dec = __expf(bl[j] + m - mn), sc = __expf(ml[j] - mn);
                    st = st * dec + d[j] * sc; nst = nst * dec + gm[j] * sc; m = mn; } }
        }
    }
}

template <int MODE>
__device__ __forceinline__ void ph_scan_out(const ScanP& s, LAS unsigned char* lds, int tid, int lane, int wave, int bid, int G) {
    LAS unsigned char* Vs = lds; LAS unsigned char* Qx = lds + 33792; LAS unsigned char* Ki = lds + 51200; LAS unsigned char* Qi = lds + 68608; LAS unsigned char* Am = lds + 86016;
    LAS float* glr = (LAS float*)(lds + 95232); LAS float* tot = (LAS float*)(lds + 103424);
    LAS float* us = (LAS float*)(lds + 105472); LAS float* Mts = us + 64; LAS float* wint = us + 128; LAS float* thr = us + 192; LAS float* fac = us + 256; LAS float* qn = us + 320; LAS float* rs = us + 384;
    LAS float* qnp = (LAS float*)(lds + 107520);
    LAS float* Os = (LAS float*)lds;
    const int dk = tid & 127, grp = tid >> 7;
    for (int u = bid; u < 544; u += G) {
        int b, head, mm, rowbase; scan_unit(u, b, head, mm, rowbase);
        load_tile(Vs, 528, s.P + (size_t)rowbase * NINP + (MODE ? 4096 : 1024) + head * 256, NINP, 64, 256, tid);
        if (MODE == 0) { for (int e = tid; e < 2048; e += NTHR) glr[e] = bf1(s.P[(size_t)(rowbase + (e >> 5)) * NINP + 3072 + (e & 31)]); if (tid < 64) fac[tid] = 1.f; }
        else { load_tile(Qi, 272, s.MQK + (size_t)rowbase * 1024 + head * 128, 1024, 64, 128, tid); load_tile(Ki, 272, s.MQK + (size_t)rowbase * 1024 + 512 + head * 128, 1024, 64, 128, tid); }
        f32x16 hsum[2]; hsum[0] = zero16(); hsum[1] = zero16();
        __syncthreads();
        for (int dir = 0; dir < 2; ++dir) {
            const int chain = (b * 4 + head) * 2 + dir, c = scan_chunk(mm, dir); const size_t cc = (size_t)chain * NCHUNK + c;
            if (MODE == 0) {
                float bb[16], btot; gla_gates(s, glr, tot, head, dir, tid, bb, btot);
#pragma unroll
                for (int tt = 0; tt < 16; ++tt) { const int t = 16 * grp + tt; const size_t ro = (size_t)(rowbase + t) * NINP + head * 128 + dk;
                    const float qv = bf1(s.P[ro]), kv = bf1(s.P[ro + 512]);
                    *(LAS bf16*)(Qx + t * 272 + dk * 2) = f2bf(qv * __expf(bb[tt]) * 0.08838834764831845f);
                    *(LAS bf16*)(Ki + t * 272 + dk * 2) = f2bf(kv * __expf(-bb[tt])); }
            } else {
                if (wave == 0) {
                    const float ig = bf1(s.P[(size_t)(rowbase + lane) * NINP + 6144 + dir * 8 + head]) + s.mgb[dir * 8 + head];
                    const float fg = bf1(s.P[(size_t)(rowbase + lane) * NINP + 6144 + dir * 8 + 4 + head]) + s.mgb[dir * 8 + 4 + head];
                    const float lf = logsig_f(fg), bcs = wave_scan_sum(lf, dir, lane);
                    const float uu = ig - bcs, pm = wave_scan_max(uu, dir, lane), min_ = s.MINp[cc], Mt = fmaxf(min_, pm);
                    us[lane] = uu; Mts[lane] = Mt; wint[lane] = __expf(min_ - Mt); thr[lane] = __expf(-bcs - Mt);
                }
                __syncthreads();
                { const int t = tid & 63, part = tid >> 6; float acc = 0.f;
                  const float wi = wint[t];
#pragma unroll
                  for (int hh = 0; hh < 2; ++hh) { float qv[8], ov[8]; unpack8(*(LAS const v4u*)(Qi + t * 272 + (part * 16 + 8 * hh) * 2), qv);
                      const f32x4 n0 = *(const f32x4*)(s.NIN + cc * 128 + part * 16 + 8 * hh), n1 = *(const f32x4*)(s.NIN + cc * 128 + part * 16 + 8 * hh + 4);
                      acc += (qv[0] * n0.x + qv[1] * n0.y) + (qv[2] * n0.z + qv[3] * n0.w) + (qv[4] * n1.x + qv[5] * n1.y) + (qv[6] * n1.z + qv[7] * n1.w);
#pragma unroll
                      for (int e = 0; e < 8; ++e) ov[e] = qv[e] * wi;
                      *(LAS v4u*)(Qx + t * 272 + (part * 16 + 8 * hh) * 2) = pack8(ov); }
                  qnp[part * 64 + t] = acc; }
            }
            __syncthreads();
            if (MODE == 1 && tid < 64) { float q = 0.f;
#pragma unroll
                for (int p = 0; p < 8; ++p) q += qnp[p * 64 + tid];
                qn[tid] = q; }
            if (wave < 4) {
                const int ti = wave >> 1, tj = wave & 1; f32x16 acc = zero16();
#pragma unroll
                for (int ks = 0; ks < 8; ++ks) { const bf16x8 af = frag_row(MODE ? Qi : Qx, 272, 32 * ti, 16 * ks, lane), bfr = frag_row(Ki, 272, 32 * tj, 16 * ks, lane); acc = MFMA32(af, bfr, acc); }
                const int sidx = 32 * tj + (lane & 31);
                const float usv = MODE ? us[sidx] : 0.f;
#pragma unroll
                for (int r = 0; r < 16; ++r) { const int t = 32 * ti + (r & 3) + 8 * (r >> 2) + 4 * (lane >> 5);
                    const bool keep = dir == 0 ? (sidx <= t) : (sidx >= t);
                    float v = acc[r];
                    if (MODE == 1) v *= __expf(usv - Mts[t]);
                    v = keep ? v : 0.f;
                    *(LAS bf16*)(Am + t * 144 + sidx * 2) = f2bf(v);
                    if (MODE == 1) { float rsum = v; rsum += __shfl_xor(rsum, 1); rsum += __shfl_xor(rsum, 2); rsum += __shfl_xor(rsum, 4); rsum += __shfl_xor(rsum, 8); rsum += __shfl_xor(rsum, 16);
                        if ((lane & 31) == 0) rs[tj * 64 + t] = rsum; } }
            }
            __syncthreads();
            if (MODE == 1 && tid < 64) { const float den = wint[tid] * qn[tid] + rs[tid] + rs[64 + tid]; fac[tid] = 1.f / fmaxf(fabsf(den), thr[tid]); }
            f32x16 acc2[2]; acc2[0] = zero16(); acc2[1] = zero16();
            { const bf16* Sg = s.SSTp + cc * 32768 + (size_t)(32 * wave + (lane & 31)) * 128 + 8 * (lane >> 5);
#pragma unroll
              for (int ks = 0; ks < 8; ++ks) { const bf16x8 bfr = *(const bf16x8*)(Sg + 16 * ks);
#pragma unroll
                  for (int rt = 0; rt < 2; ++rt) { const bf16x8 af = frag_row(Qx, 272, 32 * rt, 16 * ks, lane); acc2[rt] = MFMA32(af, bfr, acc2[rt]); } } }
#pragma unroll
            for (int ks = 0; ks < 4; ++ks) { const bf16x8 bfr = frag_tr(Vs, 528, 16 * ks, 32 * wave, lane);
#pragma unroll
                for (int rt = 0; rt < 2; ++rt) { const bf16x8 af = frag_row(Am, 144, 32 * rt, 16 * ks, lane); acc2[rt] = MFMA32(af, bfr, acc2[rt]); } }
            __syncthreads();
#pragma unroll
            for (int rt = 0; rt < 2; ++rt)
#pragma unroll
                for (int r = 0; r < 16; ++r) { const int t = 32 * rt + (r & 3) + 8 * (r >> 2) + 4 * (lane >> 5); hsum[rt][r] += acc2[rt][r] * fac[t]; }
        }
        __syncthreads();
#pragma unroll
        for (int rt = 0; rt < 2; ++rt)
#pragma unroll
            for (int r = 0; r < 16; ++r) { const int t = 32 * rt + (r & 3) + 8 * (r >> 2) + 4 * (lane >> 5); Os[t * 260 + 32 * wave + (lane & 31)] = hsum[rt][r]; }
        __syncthreads();
        { const int t = tid >> 3, part = tid & 7; float o[32]; float ss = 0.f;
#pragma unroll
          for (int j = 0; j < 8; ++j) { const f32x4 v = *(LAS const f32x4*)(Os + t * 260 + 32 * part + 4 * j); o[4 * j] = v.x; o[4 * j + 1] = v.y; o[4 * j + 2] = v.z; o[4 * j + 3] = v.w; ss += (v.x * v.x + v.y * v.y) + (v.z * v.z + v.w * v.w); }
          ss += __shfl_xor(ss, 1); ss += __shfl_xor(ss, 2); ss += __shfl_xor(ss, 4);
          const float rn = rsqrtf(ss * (1.f / 256.f) + EPS);
          const size_t row = (size_t)(rowbase + t);
          const bf16* gsrc = s.P + row * NINP + (MODE ? 5120 : 2048) + head * 256 + 32 * part;
          bf16* dst = s.MIX + row * DM + (MODE ? 1024 : 0) + head * 256 + 32 * part;
#pragma unroll
          for (int j = 0; j < 4; ++j) { float gv[8], ov[8]; unpack8(*(const v4u*)(gsrc + 8 * j), gv);
#pragma unroll
              for (int e = 0; e < 8; ++e) { const float gt = MODE ? sigmoid_f(gv[e]) : silu_f(gv[e]); ov[e] = o[8 * j + e] * rn * s.ng[32 * part + 8 * j + e] * gt; }
              *(v4u*)(dst + 8 * j) = pack8(ov); } }
        __syncthreads();
    }
}

__device__ __forceinline__ void glds16(const void* sbase  , unsigned voff  , unsigned lds_dst  ) { unsigned keep;
    asm volatile("s_mov_b32 %0, m0\n\ts_mov_b32 m0, %3\n\ts_nop 0\n\tglobal_load_lds_dwordx4 %1, %2\n\ts_mov_b32 m0, %0" : "=&s"(keep) : "v"(voff), "s"(sbase), "s"(lds_dst) : "memory"); }
struct AttnP { const bf16* QR; const bf16* KR; const bf16* P; bf16* MIX; const float* lamp; const float* subg; const float* qg; const float* kg; float lam_init; unsigned* queue; };
template <bool SUB>
__device__ __forceinline__ void ph_attn(const AttnP& p, LAS unsigned char* lds, int tid, int lane, int wave, int bid, int G) {
    const float l01 = wave_sum(p.lamp[lane] * p.lamp[64 + lane]), l23 = wave_sum(p.lamp[128 + lane] * p.lamp[192 + lane]);
    const float lam = __expf(l01) - __expf(l23) + p.lam_init;
    const float negm2 = -8.f * wave_max(fabsf(p.qg[lane])) * wave_max(fabsf(p.kg[lane])) * 1.4426950408889634f * 1.02f;
    const int r = lane & 31, h = lane >> 5, mp = wave >> 2, wq = wave & 3;
    LAS float* Ex = (LAS float*)lds;
    const unsigned xcc = xb_xcc_id() & 7u;
    volatile LAS int* qslot = (volatile LAS int*)(lds + MISC_OFF + 96);
    for (int qq = 0; qq < 8; ++qq) for (;;) {
        const int hd = (int)((xcc + (unsigned)qq) & 7u);
        if (tid == 0) qslot[0] = (int)__hip_atomic_fetch_add(p.queue + 16 * hd, 1u, __ATOMIC_RELAXED, __HIP_MEMORY_SCOPE_AGENT);
        __syncthreads();
        const int idx = qslot[0];
        __syncthreads();
        if (idx >= 68) break;
        int b, qrow0, nkt;
        if (idx < 64) { b = idx >> 5; qrow0 = b * 4096 + 128 * (idx & 31); nkt = 68; }
        else { const int uu = idx - 64; b = uu >> 1; qrow0 = NLATR + b * 256 + 128 * (uu & 1); nkt = 4; }
        const int qrow = qrow0 + 32 * wq + r;
        bf16x8 Qf[4];
#pragma unroll
        for (int ks = 0; ks < 4; ++ks) Qf[ks] = *(const bf16x8*)(p.QR + (size_t)qrow * 1024 + (hd * 2 + mp) * 64 + 16 * ks + 8 * h);
        f32x16 O[4];
#pragma unroll
        for (int dt = 0; dt < 4; ++dt) O[dt] = zero16();
        float ls = 0.f;
        const int dq = lane >> 4, dp = lane & 15;
        unsigned voffK[4], voffV[4];
#pragma unroll
        for (int j = 0; j < 4; ++j) { const unsigned ch = 16u * (unsigned)(dp ^ ((dq << 2) | j)); voffK[j] = (unsigned)dq * 2048u + ch; voffV[j] = (unsigned)dq * (unsigned)(NINP * 2) + ch; }
        int kaddr[4], vaddr[2][4];
#pragma unroll
        for (int ks = 0; ks < 4; ++ks) kaddr[ks] = swz_off(r, 8 * mp + 2 * ks + h);
        { const int blk = (lane >> 4) & 1, q = (lane & 15) >> 2, pp = lane & 3;
#pragma unroll
          for (int e = 0; e < 2; ++e)
#pragma unroll
              for (int dt = 0; dt < 4; ++dt) vaddr[e][dt] = swz_off(4 * h + q + 8 * e, 4 * dt + 2 * blk + (pp >> 1)) + 8 * (pp & 1); }
        const int nkt2 = nkt >> 1;
        const unsigned ldsb = (unsigned)(size_t)lds;
#define AT_DMA(kt_, buf_) do { const int krow_ = (kt_) < 2 ? NLATR + b * 256 + 128 * (kt_) : b * 4096 + 128 * ((kt_) - 2); \
            _Pragma("unroll") for (int j = 0; j < 4; ++j) { const int g_ = 4 * wave + j, row_ = krow_ + 4 * g_; \
                glds16(p.KR + (size_t)row_ * 1024 + hd * 128, voffK[j], (unsigned)__builtin_amdgcn_readfirstlane((int)(ldsb + (buf_) * 32768 + 1024 * g_))); \
                glds16(p.P + (size_t)row_ * NINP + 2048 + hd * 128, voffV[j], (unsigned)__builtin_amdgcn_readfirstlane((int)(ldsb + 65536 + (buf_) * 32768 + 1024 * g_))); } } while (0)
#define AT_QK(S_, kb_) do { S_ = zero16(); _Pragma("unroll") for (int ks = 0; ks < 4; ++ks) { const bf16x8 a0 = *(LAS const bf16x8*)(Kt + kaddr[ks] + 8192 * (kb_)); S_ = MFMA32(a0, Qf[ks], S_); } } while (0)
        AT_DMA(0, 0);
        asm volatile("s_waitcnt vmcnt(0)" ::: "memory");
        __syncthreads();
        for (int kt = 0; kt < nkt2; ++kt) {
            const bool more = kt + 1 < nkt2;
            if (more) AT_DMA(kt + 1, (kt + 1) & 1);
            LAS const unsigned char* Kt = lds + (kt & 1) * 32768; LAS const unsigned char* Vt = lds + 65536 + (kt & 1) * 32768;
#define AT_VF(dst_, kb_, dt_) do { const s16x4 t0_ = tr4(Vt + vaddr[0][dt_] + 8192 * (kb_)), t1_ = tr4(Vt + vaddr[1][dt_] + 8192 * (kb_)), t2_ = tr4(Vt + vaddr[0][dt_] + 8192 * (kb_) + 4096), t3_ = tr4(Vt + vaddr[1][dt_] + 8192 * (kb_) + 4096); \
                dst_[0] = (bf16x8){t0_[0], t0_[1], t0_[2], t0_[3], t1_[0], t1_[1], t1_[2], t1_[3]}; dst_[1] = (bf16x8){t2_[0], t2_[1], t2_[2], t2_[3], t3_[0], t3_[1], t3_[2], t3_[3]}; } while (0)
            bf16x8 kf[4], P0, P1;
#pragma unroll
            for (int ks = 0; ks < 4; ++ks) kf[ks] = *(LAS const bf16x8*)(Kt + kaddr[ks]);
            { f32x16 S0 = zero16();
#pragma unroll
              for (int ks = 0; ks < 4; ++ks) S0 = MFMA32(kf[ks], Qf[ks], S0);
#pragma unroll
              for (int ks = 0; ks < 4; ++ks) kf[ks] = *(LAS const bf16x8*)(Kt + kaddr[ks] + 8192);
              unsigned pf[8]; float lacc = 0.f;
#pragma unroll
              for (int i = 0; i < 8; ++i) { const float e0 = __builtin_amdgcn_exp2f(SUB ? S0[2 * i] + negm2 : S0[2 * i]), e1 = __builtin_amdgcn_exp2f(SUB ? S0[2 * i + 1] + negm2 : S0[2 * i + 1]); lacc += e0 + e1; pf[i] = pk2(e0, e1); }
              ls += lacc;
              P0 = __builtin_bit_cast(bf16x8, (v4u){pf[0], pf[1], pf[2], pf[3]}); P1 = __builtin_bit_cast(bf16x8, (v4u){pf[4], pf[5], pf[6], pf[7]}); }
            __builtin_amdgcn_sched_barrier(0);
#pragma unroll
            for (int kb = 0; kb < 4; ++kb) {
                bf16x8 v0[2], v1[2], v2[2], v3[2];
                AT_VF(v0, kb, 0); AT_VF(v1, kb, 1); AT_VF(v2, kb, 2); AT_VF(v3, kb, 3);
                f32x16 Sn = zero16();
                if (kb < 3) {
#pragma unroll
                    for (int ks = 0; ks < 4; ++ks) Sn = MFMA32(kf[ks], Qf[ks], Sn);
                    if (kb < 2) {
#pragma unroll
                        for (int ks = 0; ks < 4; ++ks) kf[ks] = *(LAS const bf16x8*)(Kt + kaddr[ks] + 8192 * (kb + 2)); } }
                O[0] = MFMA32(v0[0], P0, O[0]); O[0] = MFMA32(v0[1], P1, O[0]); O[1] = MFMA32(v1[0], P0, O[1]); O[1] = MFMA32(v1[1], P1, O[1]);
                O[2] = MFMA32(v2[0], P0, O[2]); O[2] = MFMA32(v2[1], P1, O[2]); O[3] = MFMA32(v3[0], P0, O[3]); O[3] = MFMA32(v3[1], P1, O[3]);
                if (kb < 3) {
                    unsigned pf[8]; float lacc = 0.f;
#pragma unroll
                    for (int i = 0; i < 8; ++i) { const float e0 = __builtin_amdgcn_exp2f(SUB ? Sn[2 * i] + negm2 : Sn[2 * i]), e1 = __builtin_amdgcn_exp2f(SUB ? Sn[2 * i + 1] + negm2 : Sn[2 * i + 1]); lacc += e0 + e1; pf[i] = pk2(e0, e1); }
                    ls += lacc;
                    P0 = __builtin_bit_cast(bf16x8, (v4u){pf[0], pf[1], pf[2], pf[3]}); P1 = __builtin_bit_cast(bf16x8, (v4u){pf[4], pf[5], pf[6], pf[7]});
                    __builtin_amdgcn_sched_group_barrier(0x100, 20, 0); __builtin_amdgcn_sched_group_barrier(0x008, 6, 0);
#pragma unroll
                    for (int gI = 0; gI < 6; ++gI) { __builtin_amdgcn_sched_group_barrier(0x002, 8, 0); __builtin_amdgcn_sched_group_barrier(0x008, 1, 0); }
                }
                __builtin_amdgcn_sched_barrier(0);
            }
#undef AT_VF
            asm volatile("s_waitcnt vmcnt(0)" ::: "memory");
            __syncthreads();
        }
#undef AT_DMA
#undef AT_QK
        const float l = ls + __shfl_xor(ls, 32);
        if (mp == 1) { const float sc = lam / l;
#pragma unroll
            for (int dt = 0; dt < 4; ++dt)
#pragma unroll
                for (int i = 0; i < 16; ++i) Ex[(32 * wq + r) * 132 + 32 * dt + (i & 3) + 8 * (i >> 2) + 4 * h] = O[dt][i] * sc; }
        __syncthreads();
        if (mp == 0) { const float a0 = 1.f / l; float ss = 0.f;
#pragma unroll
            for (int dt = 0; dt < 4; ++dt)
#pragma unroll
                for (int i = 0; i < 16; ++i) { const float v = O[dt][i] * a0 - Ex[(32 * wq + r) * 132 + 32 * dt + (i & 3) + 8 * (i >> 2) + 4 * h]; O[dt][i] = v; ss += v * v; }
            ss += __shfl_xor(ss, 32);
            const float rn = rsqrtf(ss * (1.f / 128.f) + EPS) * (1.f - p.lam_init);
            int qrow2 = qrow0 + 32 * wq + r; asm volatile("" : "+v"(qrow2));
            bf16* dst = p.MIX + (size_t)qrow2 * DM + hd * 128;
#pragma unroll
            for (int dt = 0; dt < 4; ++dt)
#pragma unroll
                for (int g4 = 0; g4 < 4; ++g4) { const int dv0 = 32 * dt + 8 * g4 + 4 * h; const f32x4 sg = *(const f32x4*)(p.subg + dv0);
                    v2u o; o.x = pk2(O[dt][4 * g4] * rn * sg.x, O[dt][4 * g4 + 1] * rn * sg.y); o.y = pk2(O[dt][4 * g4 + 2] * rn * sg.z, O[dt][4 * g4 + 3] * rn * sg.w);
                    *(v2u*)(dst + dv0) = o; } }
        __syncthreads();
    }
}

#ifndef PHASE_MASK
#define PHASE_MASK 0xFFFFFFu
#endif
#define PM(j) ((PHASE_MASK >> (j)) & 1u)
#ifndef REP_MASK
#define REP_MASK 0u
#endif
#define REPS(j) ((((REP_MASK) >> (j)) & 1u) ? 2 : 1)
#define PH_BEGIN(j, k) if (PM(j) && IN(k)) for (int rep_ = 0; rep_ < REPS(j); ++rep_) { if (rep_) xcd_barrier(bar);
#define PH_END }
#define PHASE_BEGIN int wave = wave0, bid = bid0, G = G0, zz_ = 0; asm volatile("" : "+s"(wave), "+s"(bid), "+s"(G), "+s"(zz_)); const int lane = (int)__builtin_amdgcn_mbcnt_hi(~0u, __builtin_amdgcn_mbcnt_lo(~0u, (unsigned)zz_)), tid = wave * 64 + lane; \
    unsigned char* ws = ws0; asm volatile("" : "+s"(ws)); const __attribute__((address_space(4))) Args* ap_ = (const __attribute__((address_space(4))) Args*)__builtin_amdgcn_kernarg_segment_ptr(); asm volatile("" : "+s"(ap_)); const Args& a = *(const Args*)ap_; (void)a; const int gw = bid * NWAVES + wave, NGW = G * NWAVES, gtid = bid * NTHR + tid, NT = G * NTHR; (void)gw; (void)NGW; (void)gtid; (void)NT; (void)lane;
__device__ __forceinline__ void fill_scanp(ScanP& sp, const Args& a, unsigned char* ws, int li, bool even) {
    sp.P = (const bf16*)(ws + WS_P); sp.MQK = (const bf16*)(ws + WS_MQK); sp.MIX = (bf16*)(ws + WS_MIX);
    sp.gw2 = a.in[10] + (size_t)li * 2 * 16 * 512; sp.gb = a.in[11] + (size_t)li * 2 * 512; sp.mgb = a.in[21] + (size_t)li * 16;
    sp.ng = even ? a.in[12] + (size_t)li * 256 : a.in[22] + (size_t)li * 256;
    sp.DSTp = (bf16*)(ws + WS_DST); sp.SSTp = (bf16*)(ws + WS_SST); sp.GAM = (float*)(ws + WS_SM + SM_GAM); sp.DN = (float*)(ws + WS_SM + SM_DN); sp.NIN = (float*)(ws + WS_SM + SM_NIN);
    sp.BL = (float*)(ws + WS_SM + SM_BL); sp.ML = (float*)(ws + WS_SM + SM_ML); sp.MINp = (float*)(ws + WS_SM + SM_MIN);
}
__global__ void __launch_bounds__(NTHR, 2) fwd_kernel(Args a) {
    extern __shared__ __attribute__((aligned(16))) unsigned char lds_raw[];
    LAS unsigned char* lds = (LAS unsigned char*)lds_raw;
    const int tid0 = threadIdx.x, wave0 = __builtin_amdgcn_readfirstlane(tid0 >> 6), bid0 = blockIdx.x, G0 = gridDim.x;
    unsigned char* ws0 = a.ws;
    volatile LAS unsigned* MISC = (volatile LAS unsigned*)(lds + MISC_OFF);
    if (tid0 < 32) MISC[tid0] = 0u;
    __syncthreads();
    XcdBarrier bar = xcd_barrier_post((unsigned*)(ws0 + WS_CTL) + CW_BAR + a.li * XCD_BAR_WORDS, MISC + 8, (unsigned)wave0);
    const int lo = a.ph_lo, hi = a.ph_hi;
#define IN(k) (lo <= (k) && (k) < hi)
#ifndef TMASK
#define TMASK 0u
#endif
#ifndef LMASK
#define LMASK 0xFu
#endif
    volatile LAS unsigned long long* tst_ = (volatile LAS unsigned long long*)(lds + MISC_OFF + 64);
    if (TMASK && tid0 == 0) { tst_[0] = __builtin_amdgcn_s_memrealtime(); tst_[1] = 0ull; }
#define SEAM2(k, kk, ll) do { if (IN(k) && IN((k) + 1)) xcd_barrier(bar); if (TMASK && wave0 == 0 && xb_lane() == 0u) { const unsigned long long now_ = __builtin_amdgcn_s_memrealtime(); if (((TMASK >> (kk)) & 1u) && ((LMASK >> (ll)) & 1u)) tst_[1] += now_ - tst_[0]; tst_[0] = now_; } } while (0)
#define SEAM(k) SEAM2(k, (k) == 0 ? 11 : ((k) - 1) % PPL, (k) == 0 ? 0 : ((k) - 1) / PPL)

    PH_BEGIN(11, 0) PHASE_BEGIN; ph_prologue(a, ws, lds, tid, lane, wave, bid, G); PH_END
    SEAM(0);
    for (int layer = 0; layer < NLAYERS; ++layer) {
        const int pb = 1 + layer * PPL, li = layer >> 1; const bool even = (layer & 1) == 0;
        const size_t mod_off = WS_MOD + (size_t)layer * 3 * 12288 * 4;
        const size_t wb_off = WS_W + (size_t)layer * W_LAYER;

        PH_BEGIN(0, pb + 0) PHASE_BEGIN; const float* mod = (const float*)(ws + mod_off); float* ssq = (float*)(ws + WS_SSQ) + (size_t)(2 * layer) * MR;
            if (layer == 0) ph_norm0(a.in[0], a.in[2], (float*)(ws + WS_XS), a.in[6], mod + 1 * DM, (bf16*)(ws + WS_H), ssq, gw, NGW, lane);
            else ph_ctxfix<11>((float*)(ws + WS_XS), (const float*)(ws + WS_DST), mod - 3 * 12288 + 2 * 12288 + 5 * DM, a.in[6] + (size_t)layer * DM, mod + 1 * DM, (bf16*)(ws + WS_H), ssq, gw, NGW, lane);
            { PHASE_BEGIN; const float* mod2 = (const float*)(ws + mod_off); ph_bias((const bf16*)(ws + wb_off), (const bf16*)(ws + wb_off + W_UP), mod2, (float*)(ws + WS_B1) + (size_t)layer * 3 * NINP, (float*)(ws + WS_B2) + (size_t)layer * 3 * NUP, gw, NGW, lane); } }
        SEAM(pb + 0);
        PH_BEGIN(1, pb + 1) PHASE_BEGIN; pg8::Gemm g{(const bf16*)(ws + WS_H), (const bf16*)(ws + wb_off), MR, NINP, DM}; pg8::StaticOrder S; S.init(MR, NINP, G, bid); pg8::EpiStore E{(bf16*)(ws + WS_P), NINP, (const float*)(ws + WS_SSQ) + (size_t)(2 * layer) * MR, (const float*)(ws + WS_B1) + (size_t)layer * 3 * NINP, NINP};
            pg8::gemm_phase<pg8::EpiStore, pg8::StaticOrder, true, true>(lds, g, S, E, wave);
            if (layer + 1 < NLAYERS && G == 256 && bid >= 82) { __syncthreads(); ph_convert(a, ws, lds, (layer + 1) * 25344, (layer + 2) * 25344, (bid - 82) * NWAVES + wave, 174 * NWAVES, wave, lane); }
            else if (layer + 1 < NLAYERS && G != 256) { __syncthreads(); ph_convert(a, ws, lds, (layer + 1) * 25344, (layer + 2) * 25344, bid * NWAVES + wave, G * NWAVES, wave, lane); } }
        SEAM(pb + 1);
        PH_BEGIN(2, pb + 2)
            if (even) {
                if (PM(12)) { PHASE_BEGIN; ph_conv<1>((const bf16*)(ws + WS_P), a.in[13] + (size_t)li * 3 * 1024, nullptr, (bf16*)(ws + WS_MIX), gtid, NT); }
                if (PM(13)) { PHASE_BEGIN; ScanP sp; fill_scanp(sp, a, ws, li, even); ph_gla_local(sp, (bf16*)(ws + WS_QR), (bf16*)(ws + WS_KR), lds, tid, lane, wave, bid, G); }
            } else {
                if (PM(14)) { PHASE_BEGIN; ph_qkprep((const bf16*)(ws + WS_P), a.in[16] + (size_t)li * 64, a.in[17] + (size_t)li * 64, (const float*)(ws + WS_ROPE), (bf16*)(ws + WS_QR), (bf16*)(ws + WS_KR), gw, NGW, lane); }
                if (PM(15)) { PHASE_BEGIN; ph_conv<2>((const bf16*)(ws + WS_P), a.in[20] + (size_t)li * 3 * 1024, nullptr, (bf16*)(ws + WS_MQK), gtid, NT); }
            }
        }
        SEAM(pb + 2);
        PH_BEGIN(3, pb + 3) if (!even) { PHASE_BEGIN; ScanP sp; fill_scanp(sp, a, ws, li, even); ph_scan_local<1>(sp, lds, tid, lane, wave, bid, G); } }
        if (!even) SEAM(pb + 3);
        PH_BEGIN(4, pb + 4) PHASE_BEGIN; ScanP sp; fill_scanp(sp, a, ws, li, even); if (even) ph_scan_carry<0>(sp, gtid, NT); else ph_scan_carry<1>(sp, gtid, NT); }
        SEAM(pb + 4);
        PH_BEGIN(5, pb + 5)
            if (even) { if (PM(16)) { PHASE_BEGIN; ScanP sp; fill_scanp(sp, a, ws, li, even); ph_gla_out(sp, (const bf16*)(ws + WS_QR), (const bf16*)(ws + WS_KR), lds, tid, lane, wave, bid, G); } }
            else {
                if (PM(17)) { PHASE_BEGIN; AttnP ap{(const bf16*)(ws + WS_QR), (const bf16*)(ws + WS_KR), (const bf16*)(ws + WS_P), (bf16*)(ws + WS_MIX), a.in[18] + (size_t)li * 256, a.in[19] + (size_t)li * 128, a.in[16] + (size_t)li * 64, a.in[17] + (size_t)li * 64, 0.8f - 0.6f * expf(-0.3f * (float)layer), (unsigned*)(ws + 32768 + 1024 * li)};
                    const float bound = 8.f * wave_max(fabsf(ap.qg[lane])) * wave_max(fabsf(ap.kg[lane])) * 1.4426950408889634f;
                    if (bound < 60.f) ph_attn<false>(ap, lds, tid, lane, wave, bid, G); else ph_attn<true>(ap, lds, tid, lane, wave, bid, G);
                    if (TMASK && wave0 == 0 && xb_lane() == 0u) { const unsigned long long now_ = __builtin_amdgcn_s_memrealtime(); if (((TMASK >> 12) & 1u) && ((LMASK >> layer) & 1u)) tst_[1] += now_ - tst_[0]; tst_[0] = now_; } }
                if (PM(18)) { PHASE_BEGIN; ScanP sp; fill_scanp(sp, a, ws, li, even); ph_scan_out<1>(sp, lds, tid, lane, wave, bid, G); }
            }
        }
        SEAM(pb + 5);
        PH_BEGIN(6, pb + 6) PHASE_BEGIN; pg8::Gemm g{(const bf16*)(ws + WS_MIX), (const bf16*)(ws + wb_off + W_OUT), MR, DM, DM}; pg8::ResidOrder S; S.init(G, bid, layer < NLAYERS - 1 ? 8 : 0, 256);
            pg8::EpiResid2 E{(float*)(ws + WS_XS), (const float*)(ws + mod_off) + 2 * DM, nullptr, (float*)(ws + WS_DST), 0, 256, rep_,
                (bf16*)(ws + WS_H), a.in[7] + (size_t)layer * DM, (const float*)(ws + mod_off) + 4 * DM, (float*)(ws + WS_SSQ) + (size_t)(2 * layer + 1) * MR};
            pg8::gemm_phase<pg8::EpiResid2, pg8::ResidOrder, true, true>(lds, g, S, E, wave); }
        SEAM(pb + 6);
        PH_BEGIN(7, pb + 7) PHASE_BEGIN; const float* mod = (const float*)(ws + mod_off);
            if (layer < NLAYERS - 1) ph_ctxfix<8>((float*)(ws + WS_XS), (const float*)(ws + WS_DST), mod + 2 * 12288 + 2 * DM, a.in[7] + (size_t)layer * DM, mod + 4 * DM, (bf16*)(ws + WS_H), (float*)(ws + WS_SSQ) + (size_t)(2 * layer + 1) * MR, gw, NGW, lane); }
        if (layer < NLAYERS - 1) SEAM(pb + 7);
        PH_BEGIN(8, pb + 8) PHASE_BEGIN; pg8::Gemm g{(const bf16*)(ws + WS_H), (const bf16*)(ws + wb_off + W_UP), MR, NUP, DM}; pg8::StaticOrder S; S.init(MR, NUP, G, bid);
            pg8::EpiAct E{(bf16*)(ws + WS_ACT), a.in[24] + (size_t)layer * 3 * DFF, a.in[25] + (size_t)layer * DFF, (float*)(ws + WS_U), (LAS float*)(lds + 131584), (const float*)(ws + WS_SSQ) + (size_t)(2 * layer + 1) * MR, (const float*)(ws + WS_B2) + (size_t)layer * 3 * NUP, 0};
            pg8::gemm_phase<pg8::EpiAct, pg8::StaticOrder, true, true>(lds, g, S, E, wave); }
        SEAM(pb + 8);
        PH_BEGIN(10, pb + 10)
            { PHASE_BEGIN; pg8::ResidOrder S0; S0.init(G, bid, layer < NLAYERS - 1 ? 11 : 0, 512); pg8::Unit uu_;
#pragma unroll 1
              for (int i_ = 0; S0.next(i_, uu_); ++i_) act_fix_tile((const float*)(ws + WS_U), a.in[24] + (size_t)layer * 3 * DFF, (bf16*)(ws + WS_ACT), uu_.pm, tid);
              asm volatile("s_waitcnt vmcnt(0)" ::: "memory"); __syncthreads(); }
            PHASE_BEGIN; pg8::Gemm g{(const bf16*)(ws + WS_ACT), (const bf16*)(ws + wb_off + W_DN), MR, DM, DFF}; pg8::ResidOrder S; S.init(G, bid, layer < NLAYERS - 1 ? 11 : 0, 512);
            pg8::EpiResid2 E{(float*)(ws + WS_XS), (const float*)(ws + mod_off) + 5 * DM, a.out, (float*)(ws + WS_DST), layer == NLAYERS - 1 ? 1 : 0, 512, rep_,
                layer < NLAYERS - 1 ? (bf16*)(ws + WS_H) : nullptr, a.in[6] + (size_t)(layer + 1) * DM, (const float*)(ws + mod_off) + 3 * 12288 + 1 * DM, (float*)(ws + WS_SSQ) + (size_t)(2 * layer + 2) * MR};
            pg8::gemm_phase<pg8::EpiResid2, pg8::ResidOrder, true, true>(lds, g, S, E, wave); }
        if (layer < NLAYERS - 1) SEAM(pb + 10); else if (TMASK && wave0 == 0 && xb_lane() == 0u) { const unsigned long long now_ = __builtin_amdgcn_s_memrealtime(); if (((TMASK >> 10) & 1u) && ((LMASK >> layer) & 1u)) tst_[1] += now_ - tst_[0]; tst_[0] = now_; }
    }
    if (TMASK) { __syncthreads(); const unsigned long long tacc_ = tst_[1], t0_ = __builtin_amdgcn_s_memrealtime(); while (__builtin_amdgcn_s_memrealtime() - t0_ < tacc_) __builtin_amdgcn_s_sleep(8); }
#undef IN
#undef SEAM
}

extern "C" void kernel_launch(void* const* d_in, const int* in_sizes, int n_in, void* d_out, int out_size, void* d_ws, size_t ws_size, hipStream_t stream) {
    static int grid = 0;
    if (grid == 0) {
        int dev = 0, cus = 0;
        if (n_in != 27 || out_size != NLATR * DM || ws_size < WS_END) { fprintf(stderr, "kernel_launch: unexpected problem (n_in %d out %d ws %zu)\n", n_in, out_size, ws_size); grid = -1; return; }
        if (hipGetDevice(&dev) != hipSuccess || hipDeviceGetAttribute(&cus, hipDeviceAttributeMultiprocessorCount, dev) != hipSuccess) { grid = -1; return; }
        if (hipFuncSetAttribute((const void*)fwd_kernel, hipFuncAttributeMaxDynamicSharedMemorySize, LDS_BYTES) != hipSuccess) { fprintf(stderr, "kernel_launch: hipFuncSetAttribute failed\n"); grid = -1; return; }
        int per_cu = 0;
        if (hipOccupancyMaxActiveBlocksPerMultiprocessor(&per_cu, (const void*)fwd_kernel, NTHR, LDS_BYTES) != hipSuccess || per_cu < 1) fprintf(stderr, "kernel_launch: occupancy query reports %d\n", per_cu);
        (void)hipGetLastError();
        grid = cus;
    }
    if (grid < 0) return;
    (void)hipMemsetAsync((char*)d_ws + WS_CTL, 0, CTL_BYTES, stream);
    Args a{};
    for (int i = 0; i < 27; ++i) a.in[i] = (const float*)d_in[i];
    a.out = (float*)d_out; a.ws = (unsigned char*)d_ws; a.pad = 0;
#if ONE_LAUNCH
    a.ph_lo = 0; a.ph_hi = 1 + NLAYERS * PPL; a.li = 0;
    hipLaunchKernelGGL(fwd_kernel, dim3(grid), dim3(NTHR), LDS_BYTES, stream, a);
#else
    for (int p = 0; p < 1 + NLAYERS * PPL; ++p) {
        const int k = p == 0 ? 0 : (p - 1) % PPL, layer = p == 0 ? 0 : (p - 1) / PPL;
        if (p > 0 && k == 3 && (layer & 1) == 0) continue;
        a.ph_lo = p; a.ph_hi = p + 1; a.li = p;
        hipLaunchKernelGGL(fwd_kernel, dim3(grid), dim3(NTHR), LDS_BYTES, stream, a);
    }
#endif
}
```

```cpp
#include <hip/hip_runtime.h>
#include <cstdio>
#include <cstdint>
namespace pg8 {
#define PG8_LAS __attribute__((address_space(3)))
typedef unsigned short bf16_t;
typedef short bf16x8 __attribute__((ext_vector_type(8)));
typedef float f32x4 __attribute__((ext_vector_type(4)));
typedef unsigned u32x4 __attribute__((ext_vector_type(4)));
constexpr int BM = 256, BK = 64, HALF = 128, HTB = HALF * BK * 2  , STAGE_BYTES = 8 * HTB, NXCD = 8, WGM = 8;

__host__ __device__ __forceinline__ int lds_byte(int r, int c) { const int st = (r >> 4) * 2 + (c >> 5), rr = r & 15, cc = c & 31, ob = rr * 64 + cc * 2; return st * 1024 + (ob ^ (((ob >> 9) & 1) << 5)); }
__host__ __device__ __forceinline__ void stage_rc(int b, int& R, int& C) { const int st = b / 1024, sb = b % 1024, swz = sb ^ (((sb >> 9) & 1) << 5); R = (st >> 1) * 16 + swz / 64; C = (st & 1) * 32 + (swz % 64) / 2; }
__host__ __device__ __forceinline__ int perm32(int rho) { const int n = rho >> 4, i = rho & 15; return 8 * (i >> 2) + 4 * n + (i & 3); }

struct Unit { int pm, pn, k0, nt; };
struct Gemm { const bf16_t* A; const bf16_t* Bt; int M, N, K; };

struct StaticOrder {
    int nM, nN, nwg, G, c;
    __host__ __device__ __forceinline__ void init(int M, int N, int G_, int c_) { nM = M / BM; nN = N / BM; nwg = nM * nN; G = G_; c = c_; }
    __host__ __device__ __forceinline__ bool next(int i, Unit& u) const {
        const long L = (long)i * G + c; if (L >= nwg) return false;
        int wgid = (int)L; { const int q = nwg / NXCD, r = nwg % NXCD, xcd = wgid % NXCD, off = wgid / NXCD; wgid = (xcd < r ? xcd * (q + 1) : r * (q + 1) + (xcd - r) * q) + off; }
        const int nig = WGM * nN, gid = wgid / nig, fm = gid * WGM, gsz = (nM - fm) < WGM ? (nM - fm) : WGM;
        u.pm = fm + ((wgid % nig) % gsz); u.pn = (wgid % nig) / gsz; u.k0 = 0; u.nt = 0; return true;
    }
    __device__ __forceinline__ void a_ready(const Unit&) const {}
    __device__ __forceinline__ void done(const Unit&) const {}
};
__device__ __forceinline__ unsigned cvt_pk_bf16(float lo, float hi) { unsigned r; asm volatile("v_cvt_pk_bf16_f32 %0, %1, %2" : "=v"(r) : "v"(lo), "v"(hi)); return r; }

struct EpiStore {
    static constexpr bool PERM = true, AFTER_DRAIN = false;
    bf16_t* O; int ldc; const float* ssq; const float* bias; int ldb;
    __device__ __forceinline__ void operator()(const f32x4 (&acc)[2][2][4][2], const Unit& u, int wr, int wc, int fr, int fq) const {
        const int row0 = u.pm * BM + wr * 64 + fr, col0 = u.pn * BM + wc * 32 + 8 * fq, mi = u.pm < 32 ? (u.pm >> 4) : 2;
        f32x4 bv[2][2];
#pragma unroll
        for (int bj = 0; bj < 2; ++bj)
#pragma unroll
            for (int n = 0; n < 2; ++n) bv[bj][n] = *(const f32x4*)(bias + (size_t)mi * ldb + col0 + bj * HALF + 4 * n);
#pragma unroll
        for (int ai = 0; ai < 2; ++ai)
#pragma unroll
            for (int m = 0; m < 4; ++m) { const int row = row0 + ai * HALF + m * 16; bf16_t* rowp = O + (size_t)row * ldc + col0;
                const float r = __builtin_amdgcn_rsqf(ssq[row] * (1.f / 2048.f) + 1e-6f);
#pragma unroll
                for (int bj = 0; bj < 2; ++bj) { const f32x4 v0 = acc[ai][bj][m][0] * r + bv[bj][0], v1 = acc[ai][bj][m][1] * r + bv[bj][1];
                    u32x4 w; w.x = cvt_pk_bf16(v0[0], v0[1]); w.y = cvt_pk_bf16(v0[2], v0[3]); w.z = cvt_pk_bf16(v1[0], v1[1]); w.w = cvt_pk_bf16(v1[2], v1[3]);
                    *(u32x4*)(rowp + bj * HALF) = w; } }
    }
};
struct ResidOrder {
    StaticOrder L; int G, c, nsub, ksub;
    __device__ __forceinline__ void init(int G_, int c_, int nsplit, int ksub_) { L.init(8192, 2048, G_, c_); G = G_; c = c_; nsub = 16 * nsplit; ksub = ksub_; }
    __device__ __forceinline__ bool next(int i, Unit& u) const {
        const int nl = c < 256 ? (255 - c) / G + 1 : 0;
        if (i < nl) return L.next(i, u);
        const int s = (i - nl) * G + c; if (s >= nsub) return false;
        const int tile = s & 15, j = s >> 4; u.pm = 32 + (tile >> 3); u.pn = tile & 7; u.k0 = j * ksub; u.nt = ksub / BK; return true;
    }
    __device__ __forceinline__ void a_ready(const Unit&) const {}
    __device__ __forceinline__ void done(const Unit&) const {}
};
struct EpiResid2 {
    static constexpr bool PERM = true, AFTER_DRAIN = false;
    float* X; const float* gate; float* out; float* part; int final_; int ksub; int dry;
    bf16_t* Hn; const float* ngn; const float* scn; float* ssqn;
    __device__ __forceinline__ void operator()(const f32x4 (&acc)[2][2][4][2], const Unit& u, int wr, int wc, int fr, int fq) const {
        const int row0 = u.pm * BM + wr * 64 + fr, col0 = u.pn * BM + wc * 32 + 8 * fq;
        if (u.pm >= 32) {
            float* pb = part + ((size_t)(u.k0 / ksub) * 512 + (row0 - 8192)) * 2048 + col0;
#pragma unroll
            for (int ai = 0; ai < 2; ++ai)
#pragma unroll
                for (int m = 0; m < 4; ++m)
#pragma unroll
                    for (int bj = 0; bj < 2; ++bj)
#pragma unroll
                        for (int n = 0; n < 2; ++n) *(f32x4*)(pb + (size_t)(ai * HALF + m * 16) * 2048 + bj * HALF + 4 * n) = acc[ai][bj][m][n];
            return;
        }
        const int mi = u.pm >> 4;
        f32x4 gv[2][2], av[2][2];
#pragma unroll
        for (int bj = 0; bj < 2; ++bj)
#pragma unroll
            for (int n = 0; n < 2; ++n) { const int c = col0 + bj * HALF + 4 * n; gv[bj][n] = *(const f32x4*)(gate + (size_t)mi * 12288 + c);
                av[bj][n] = Hn ? *(const f32x4*)(ngn + c) * (*(const f32x4*)(scn + (size_t)mi * 12288 + c) + 1.f) : (f32x4){0.f, 0.f, 0.f, 0.f}; }
        if (dry && gv[0][0][0] != 1.2345e30f) return;
#pragma unroll
        for (int ai = 0; ai < 2; ++ai)
#pragma unroll
            for (int m = 0; m < 4; ++m) { const int row = row0 + ai * HALF + m * 16; const size_t ro = (size_t)row * 2048 + col0; const float* xr = X + ro; float* orow = (final_ ? out : X) + ro; float ss = 0.f;
#pragma unroll
                for (int bj = 0; bj < 2; ++bj) {
                    const f32x4 x0 = *(const f32x4*)(xr + bj * HALF) + gv[bj][0] * acc[ai][bj][m][0], x1 = *(const f32x4*)(xr + bj * HALF + 4) + gv[bj][1] * acc[ai][bj][m][1];
                    *(f32x4*)(orow + bj * HALF) = x0; *(f32x4*)(orow + bj * HALF + 4) = x1;
                    if (Hn) { ss += (x0[0] * x0[0] + x0[1] * x0[1]) + (x0[2] * x0[2] + x0[3] * x0[3]) + (x1[0] * x1[0] + x1[1] * x1[1]) + (x1[2] * x1[2] + x1[3] * x1[3]);
                        const f32x4 h0 = x0 * av[bj][0], h1 = x1 * av[bj][1];
                        u32x4 w; w.x = cvt_pk_bf16(h0[0], h0[1]); w.y = cvt_pk_bf16(h0[2], h0[3]); w.z = cvt_pk_bf16(h1[0], h1[1]); w.w = cvt_pk_bf16(h1[2], h1[3]);
                        *(u32x4*)(Hn + ro + bj * HALF) = w; } }
                if (Hn) { ss += __shfl_xor(ss, 16); ss += __shfl_xor(ss, 32); if (fq == 0) (void)__hip_atomic_fetch_add(ssqn + row, ss, __ATOMIC_RELAXED, __HIP_MEMORY_SCOPE_AGENT); } }
    }
};
struct EpiAct {
    static constexpr bool PERM = true, AFTER_DRAIN = false;
    bf16_t* ACT; const float* cw; const float* cb; float* halo; PG8_LAS float* exb; const float* ssq; const float* bias; mutable int par;
    __device__ __forceinline__ void operator()(const f32x4 (&acc)[2][2][4][2], const Unit& u, int wr, int wc, int fr, int fq) const {
        const int lane = fq * 16 + fr, ch0 = wc * 32 + 8 * fq, chg = u.pn * 128 + ch0;
        PG8_LAS float* xb = exb + par * 1024; par ^= 1;
        const int mi = u.pm < 32 ? (u.pm >> 4) : 2;
        const float* bp = bias + (size_t)mi * 11264 + u.pn * BM + ch0;
        float rr[2][4];
#pragma unroll
        for (int ai = 0; ai < 2; ++ai)
#pragma unroll
            for (int m = 0; m < 4; ++m) rr[ai][m] = __builtin_amdgcn_rsqf(ssq[u.pm * BM + ai * HALF + wr * 64 + m * 16 + fr] * (1.f / 2048.f) + 1e-6f);
#pragma unroll
        for (int ai = 0; ai < 2; ++ai) { const int q = ai * 2 + wr;
#pragma unroll
            for (int n = 0; n < 2; ++n) { const f32x4 bg4 = *(const f32x4*)(bp + 4 * n);
                if (fr == 0) *(PG8_LAS f32x4*)(xb + q * 128 + ch0 + 4 * n) = acc[ai][0][0][n] * rr[ai][0] + bg4;
                if (fr == 15) *(PG8_LAS f32x4*)(xb + (4 + q) * 128 + ch0 + 4 * n) = acc[ai][0][3][n] * rr[ai][3] + bg4; } }
        asm volatile("s_waitcnt lgkmcnt(0)" ::: "memory"); __builtin_amdgcn_s_barrier(); asm volatile("" ::: "memory");
        const int srcp = (lane & 48) | ((fr + 15) & 15), srcn = (lane & 48) | ((fr + 1) & 15);
        float* hb = halo + (size_t)(u.pm * 44 + u.pn) * 768 + ch0;
#pragma unroll
        for (int n = 0; n < 2; ++n) {
            const f32x4 w0 = *(const f32x4*)(cw + chg + 4 * n), w1 = *(const f32x4*)(cw + 5632 + chg + 4 * n), w2 = *(const f32x4*)(cw + 2 * 5632 + chg + 4 * n), bb = *(const f32x4*)(cb + chg + 4 * n);
            const f32x4 bg = *(const f32x4*)(bp + 4 * n), bvv = *(const f32x4*)(bp + 128 + 4 * n);
#pragma unroll
            for (int ai = 0; ai < 2; ++ai) { const int q = ai * 2 + wr;
                const f32x4 pB = q > 0 ? *(PG8_LAS const f32x4*)(xb + (4 + q - 1) * 128 + ch0 + 4 * n) : (f32x4){0.f, 0.f, 0.f, 0.f};
                const f32x4 nB = q < 3 ? *(PG8_LAS const f32x4*)(xb + (q + 1) * 128 + ch0 + 4 * n) : (f32x4){0.f, 0.f, 0.f, 0.f};
#pragma unroll
                for (int m = 0; m < 4; ++m) {
                    const f32x4 x = acc[ai][0][m][n] * rr[ai][m] + bg, vx = acc[ai][1][m][n] * rr[ai][m] + bvv;
                    const f32x4 xm = m > 0 ? acc[ai][0][m > 0 ? m - 1 : 0][n] * rr[ai][m > 0 ? m - 1 : 0] + bg : pB;
                    const f32x4 xq = m < 3 ? acc[ai][0][m < 3 ? m + 1 : 3][n] * rr[ai][m < 3 ? m + 1 : 3] + bg : nB;
                    f32x4 cv, o;
#pragma unroll
                    for (int el = 0; el < 4; ++el) { const float sp = fr == 15 ? xm[el] : x[el], sn = fr == 0 ? xq[el] : x[el];
                        const float pv = __shfl(sp, srcp), nv = __shfl(sn, srcn);
                        cv[el] = w0[el] * pv + w1[el] * x[el] + w2[el] * nv + bb[el];
                        o[el] = cv[el] / (1.f + __expf(-cv[el])) * vx[el]; }
                    const bool top = (q == 0 && m == 0 && fr == 0), bot = (q == 3 && m == 3 && fr == 15);
                    if (top || bot) { const int sl = top ? 0 : 1; *(f32x4*)(hb + sl * 128 + 4 * n) = x; *(f32x4*)(hb + (2 + sl) * 128 + 4 * n) = cv; *(f32x4*)(hb + (4 + sl) * 128 + 4 * n) = vx; }
                    else { typedef unsigned u32x2_ __attribute__((ext_vector_type(2))); u32x2_ w; w.x = cvt_pk_bf16(o[0], o[1]); w.y = cvt_pk_bf16(o[2], o[3]);
                        *(u32x2_*)(ACT + (size_t)(u.pm * BM + q * 64 + m * 16 + fr) * 5632 + chg + 4 * n) = w; }
                }
            }
        }
    }
};
template <class Epi, class Sched, bool ALIGN_EPI = false, bool SP2 = false>
__device__ __forceinline__ void gemm_phase(PG8_LAS unsigned char* lds, const Gemm g, const Sched& S, const Epi& E, int wid_in) {
    int wid = wid_in, zz_ = 0; asm volatile("" : "+s"(wid), "+s"(zz_));
    const int lane = (int)__builtin_amdgcn_mbcnt_hi(~0u, __builtin_amdgcn_mbcnt_lo(~0u, (unsigned)zz_)), tid = wid * 64 + lane, wr = wid >> 2, wc = wid & 3, fr = lane & 15, fq = lane >> 4;
    const int K = g.K, nt = K / BK;
    unsigned voffA[2], voffB[2];
#pragma unroll
    for (int i = 0; i < 2; ++i) { int R, C; stage_rc(tid * 16 + i * 8192, R, C); const int Rb = Epi::PERM ? ((R & ~31) + perm32(R & 31)) : R;
        voffA[i] = (unsigned)(R * K + C) * 2u; voffB[i] = (unsigned)(Rb * K + C) * 2u; }
    const size_t kstep = (size_t)(BK * 2);
    const size_t hstep = (size_t)HALF * K * 2;
    const size_t tstep = 2 * hstep;
    const unsigned ldsw = (unsigned)wid * 1024u;
    const int aoff = lds_byte(wr * 64 + fr, fq * 8), boff = lds_byte(wc * 32 + fr, fq * 8);
#define PG8_SA(b, h) (((b) * 2 + (h)) * HTB)
#define PG8_SB(b, h) ((4 + (b) * 2 + (h)) * HTB)
#define PG8_STAGE(bufoff, gbase, voff) do { _Pragma("unroll") for (int _i = 0; _i < 2; ++_i) \
        __builtin_amdgcn_global_load_lds((const unsigned*)((const char*)(gbase) + (voff)[_i]), (PG8_LAS unsigned*)(lds + (bufoff) + ldsw + _i * 8192), 16, 0, 0); } while (0)
#define PG8_LDA(dst, b, h) do { _Pragma("unroll") for (int m = 0; m < 4; ++m) _Pragma("unroll") for (int k = 0; k < 2; ++k) dst[m][k] = *(const PG8_LAS bf16x8*)(lds + PG8_SA(b, h) + aoff + m * 2048 + k * 1024); } while (0)
#define PG8_LDB(dst, b, h) do { _Pragma("unroll") for (int n = 0; n < 2; ++n) _Pragma("unroll") for (int k = 0; k < 2; ++k) dst[n][k] = *(const PG8_LAS bf16x8*)(lds + PG8_SB(b, h) + boff + n * 2048 + k * 1024); } while (0)
#define PG8_MMA(ai, bj, At, Bt) do { __builtin_amdgcn_s_setprio(1); _Pragma("unroll") for (int m = 0; m < 4; ++m) _Pragma("unroll") for (int n = 0; n < 2; ++n) _Pragma("unroll") for (int k = 0; k < 2; ++k) \
        acc[ai][bj][m][n] = __builtin_amdgcn_mfma_f32_16x16x32_bf16(Bt[n][k], At[m][k], acc[ai][bj][m][n], 0, 0, 0); __builtin_amdgcn_s_setprio(0); } while (0)
#define PG8_WAIT_V(n) asm volatile("s_waitcnt vmcnt(" #n ")" ::: "memory")
#define PG8_WAIT_L(n) asm volatile("s_waitcnt lgkmcnt(" #n ")" ::: "memory")
#define PG8_BAR __builtin_amdgcn_s_barrier()
#define PG8_SCHED __builtin_amdgcn_sched_barrier(0)
    Unit cur, nxt; int ui = 0;
    if (!S.next(0, cur)) return;
    f32x4 acc[2][2][4][2];
#pragma unroll
    for (int a = 0; a < 2; ++a)
#pragma unroll
        for (int b = 0; b < 2; ++b)
#pragma unroll
            for (int m = 0; m < 4; ++m)
#pragma unroll
                for (int n = 0; n < 2; ++n) acc[a][b][m][n] = (f32x4){0.f, 0.f, 0.f, 0.f};
    bf16x8 At[4][2], B0[2][2], B1[2][2];
    const char* cA = (const char*)g.A + (size_t)cur.pm * tstep + (size_t)cur.k0 * 2; const char* cB = (const char*)g.Bt + (size_t)cur.pn * tstep + (size_t)cur.k0 * 2;
    S.a_ready(cur);
    if constexpr (SP2) {
        PG8_STAGE(PG8_SB(0, 0), cB, voffB); PG8_STAGE(PG8_SB(0, 1), cB + hstep, voffB); PG8_STAGE(PG8_SA(0, 0), cA, voffA); PG8_STAGE(PG8_SA(0, 1), cA + hstep, voffA);
        if (wr == 1) PG8_BAR;
        PG8_WAIT_V(2); PG8_BAR;
        PG8_STAGE(PG8_SB(1, 0), cB + kstep, voffB); PG8_STAGE(PG8_SA(1, 0), cA + kstep, voffA); PG8_STAGE(PG8_SB(1, 1), cB + hstep + kstep, voffB);
        PG8_WAIT_V(6); PG8_BAR;
    } else {
        PG8_STAGE(PG8_SB(0, 0), cB, voffB); PG8_STAGE(PG8_SA(0, 0), cA, voffA); PG8_STAGE(PG8_SB(0, 1), cB + hstep, voffB); PG8_STAGE(PG8_SA(0, 1), cA + hstep, voffA);
        if (wr == 1) PG8_BAR;
        PG8_WAIT_V(4); PG8_BAR;
        PG8_STAGE(PG8_SB(1, 0), cB + kstep, voffB); PG8_STAGE(PG8_SA(1, 0), cA + kstep, voffA); PG8_STAGE(PG8_SB(1, 1), cB + hstep + kstep, voffB);
        PG8_WAIT_V(6); PG8_BAR;
    }
    for (;;) {
        const bool has_next = S.next(ui + 1, nxt);
        const char* nA = has_next ? (const char*)g.A + (size_t)nxt.pm * tstep + (size_t)nxt.k0 * 2 : cA; const char* nB = has_next ? (const char*)g.Bt + (size_t)nxt.pn * tstep + (size_t)nxt.k0 * 2 : cB;
        const int unt = cur.nt ? cur.nt : nt;
        for (int t = 0; t < unt; t += 2) {
            const bool last = (t == unt - 2);
            const char* a1 = cA + (size_t)(t + 1) * kstep;
            const char* a2 = last ? nA : cA + (size_t)(t + 2) * kstep; const char* b2 = last ? nB : cB + (size_t)(t + 2) * kstep;
            const char* a3 = a2 + kstep; const char* b3 = b2 + kstep;
            if (last && has_next) S.a_ready(nxt);
            if constexpr (SP2) {
            PG8_LDB(B0, 0, 0); PG8_LDB(B1, 0, 1); PG8_SCHED; PG8_LDA(At, 0, 0); PG8_STAGE(PG8_SA(1, 1), a1 + hstep, voffA);
            PG8_WAIT_V(8); PG8_WAIT_L(0); PG8_BAR; PG8_MMA(0, 0, At, B0); PG8_MMA(0, 1, At, B1); PG8_BAR; PG8_SCHED;
            PG8_LDA(At, 0, 1); PG8_STAGE(PG8_SB(0, 0), b2, voffB); PG8_STAGE(PG8_SB(0, 1), b2 + hstep, voffB); PG8_STAGE(PG8_SA(0, 0), a2, voffA);
            PG8_WAIT_V(8); PG8_WAIT_L(0); PG8_BAR; PG8_MMA(1, 0, At, B0); PG8_MMA(1, 1, At, B1); PG8_BAR; PG8_SCHED;
            PG8_LDB(B0, 1, 0); PG8_LDB(B1, 1, 1); PG8_SCHED; PG8_LDA(At, 1, 0); PG8_STAGE(PG8_SA(0, 1), a2 + hstep, voffA);
            PG8_WAIT_V(8); PG8_WAIT_L(0); PG8_BAR; PG8_MMA(0, 0, At, B0); PG8_MMA(0, 1, At, B1); PG8_BAR; PG8_SCHED;
            PG8_LDA(At, 1, 1); PG8_STAGE(PG8_SB(1, 0), b3, voffB); PG8_STAGE(PG8_SB(1, 1), b3 + hstep, voffB); PG8_STAGE(PG8_SA(1, 0), a3, voffA);
            PG8_WAIT_V(8); PG8_WAIT_L(0); PG8_BAR; PG8_MMA(1, 0, At, B0); PG8_MMA(1, 1, At, B1); PG8_BAR; PG8_SCHED;
            } else {
            PG8_LDB(B0, 0, 0); PG8_SCHED; PG8_LDA(At, 0, 0); PG8_STAGE(PG8_SA(1, 1), a1 + hstep, voffA);
            PG8_WAIT_L(8); PG8_BAR; PG8_WAIT_L(0); PG8_MMA(0, 0, At, B0); PG8_BAR; PG8_SCHED;
            PG8_LDB(B1, 0, 1); PG8_STAGE(PG8_SB(0, 0), b2, voffB);
            PG8_BAR; PG8_WAIT_L(0); PG8_MMA(0, 1, At, B1); PG8_BAR;
            PG8_LDA(At, 0, 1); PG8_STAGE(PG8_SA(0, 0), a2, voffA);
            PG8_BAR; PG8_WAIT_L(0); PG8_MMA(1, 0, At, B0); PG8_BAR; PG8_SCHED;
            PG8_STAGE(PG8_SB(0, 1), b2 + hstep, voffB);
            PG8_WAIT_V(6); PG8_BAR; PG8_MMA(1, 1, At, B1); PG8_BAR;
            PG8_LDB(B0, 1, 0); PG8_SCHED; PG8_LDA(At, 1, 0); PG8_STAGE(PG8_SA(0, 1), a2 + hstep, voffA);
            PG8_WAIT_L(8); PG8_BAR; PG8_WAIT_L(0); PG8_MMA(0, 0, At, B0); PG8_BAR; PG8_SCHED;
            PG8_LDB(B1, 1, 1); PG8_STAGE(PG8_SB(1, 0), b3, voffB);
            PG8_BAR; PG8_WAIT_L(0); PG8_MMA(0, 1, At, B1); PG8_BAR;
            PG8_LDA(At, 1, 1); PG8_STAGE(PG8_SA(1, 0), a3, voffA);
            PG8_BAR; PG8_WAIT_L(0); PG8_MMA(1, 0, At, B0); PG8_BAR; PG8_SCHED;
            PG8_STAGE(PG8_SB(1, 1), b3 + hstep, voffB);
            PG8_WAIT_V(6); PG8_BAR; PG8_MMA(1, 1, At, B1); PG8_BAR;
            }
        }
        if constexpr (ALIGN_EPI) { if (wr == 0) PG8_BAR; }
        if constexpr (!Epi::AFTER_DRAIN) { E(acc, cur, wr, wc, fr, fq); S.done(cur); }
        if (!has_next) break;
#pragma unroll
        for (int a = 0; a < 2; ++a)
#pragma unroll
            for (int b = 0; b < 2; ++b)
#pragma unroll
                for (int m = 0; m < 4; ++m)
#pragma unroll
                    for (int n = 0; n < 2; ++n) acc[a][b][m][n] = (f32x4){0.f, 0.f, 0.f, 0.f};
        cur = nxt; cA = nA; cB = nB; ++ui;
        if constexpr (ALIGN_EPI) { if (wr == 1) PG8_BAR; }
    }
    PG8_WAIT_V(0);
    if constexpr (!ALIGN_EPI) { if (wr == 0) PG8_BAR; }
    PG8_BAR;
    if constexpr (Epi::AFTER_DRAIN) { E.fused(acc, cur, wr, wc, fr, fq, lds, wid, lane); S.done(cur); }
#undef PG8_SA
#undef PG8_SB
#undef PG8_STAGE
#undef PG8_LDA
#undef PG8_LDB
#undef PG8_MMA
#undef PG8_WAIT_V
#undef PG8_WAIT_L
#undef PG8_BAR
#undef PG8_SCHED
}
}
#define GAS __attribute__((address_space(1)))
#define LAS __attribute__((address_space(3)))
typedef unsigned short bf16;
typedef unsigned v4u __attribute__((ext_vector_type(4)));
typedef unsigned v2u __attribute__((ext_vector_type(2)));
typedef float f32x4 __attribute__((ext_vector_type(4)));
typedef float f32x16 __attribute__((ext_vector_type(16)));
typedef short bf16x8 __attribute__((ext_vector_type(8)));
typedef short s16x4 __attribute__((ext_vector_type(4)));
typedef GAS unsigned gu32;
#define RLX_AGENT __ATOMIC_RELAXED, __HIP_MEMORY_SCOPE_AGENT
#define XB_TMO      128
#define XB_XCNT(j)  (256  + 64 * (j))
#define XB_XSUB(j)  (1280 + 64 * (j))
#define XB_XGEN(j)  (2304 + 64 * (j))
#define XB_TOP      3328
#define XB_TOPGEN   3392
#define XCD_BAR_WORDS 3456
#define XB_SPIN_CAP (1u << 18)

__device__ __forceinline__ unsigned xb_ld(unsigned* p)              { return __hip_atomic_load(p, __ATOMIC_RELAXED, __HIP_MEMORY_SCOPE_AGENT); }
__device__ __forceinline__ unsigned xb_add(unsigned* p, unsigned v) { return __hip_atomic_fetch_add(p, v, __ATOMIC_RELAXED, __HIP_MEMORY_SCOPE_AGENT); }
__device__ __forceinline__ unsigned xb_xcc_id() { return (unsigned)__builtin_amdgcn_s_getreg((3 << 11) | 20) & 0xFu; }
#define XB_SPIN(cond, bar) do { unsigned _sp = 0; while (cond) { __builtin_amdgcn_s_sleep(1); \
    if ((++_sp & 255u) == 0u) { if (xb_ld(&(bar)[XB_TMO])) break; if (_sp > XB_SPIN_CAP) { atomicAdd(&(bar)[XB_TMO], 1u); break; } } } } while (0)

struct XcdBarrier {
    unsigned* bar; unsigned x;
    volatile LAS unsigned* st;
    unsigned wv;
};

__device__ __forceinline__ unsigned xb_lane() { return __builtin_amdgcn_mbcnt_hi(~0u, __builtin_amdgcn_mbcnt_lo(~0u, 0u)); }
__device__ __forceinline__ XcdBarrier xcd_barrier_post(unsigned* bar, volatile LAS unsigned* st, unsigned wv) {
    XcdBarrier b; b.bar = bar; b.x = xb_xcc_id(); b.st = st; b.wv = wv;
    if (wv == 0u && xb_lane() == 0u) (void)xb_add(&bar[XB_XCNT(b.x)], 1u);
    return b;
}
__device__ __forceinline__ void xcd_barrier_complete(unsigned* bar, unsigned x, unsigned& nloc, unsigned& nx) {
    const unsigned G = gridDim.x * gridDim.y * gridDim.z;
    unsigned sum, cnt, mine, sp = 0u;
    for (;;) {
        sum = 0u; cnt = 0u; mine = 0u;
#pragma unroll
        for (unsigned j = 0; j < 16; ++j) { const unsigned c = xb_ld(&bar[XB_XCNT(j)]); sum += c; cnt += (c > 0u) ? 1u : 0u; mine = (j == x) ? c : mine; }
        if (sum == G) break;
        __builtin_amdgcn_s_sleep(1);
        if ((++sp & 255u) == 0u) { if (xb_ld(&bar[XB_TMO])) break; if (sp > XB_SPIN_CAP) { atomicAdd(&bar[XB_TMO], 1u); break; } }
    }
    nloc = mine > 0u ? mine : 1u; nx = cnt > 0u ? cnt : 1u;
}

__device__ __forceinline__ void xcd_barrier(const XcdBarrier& b) {
    asm volatile("s_waitcnt vmcnt(0)" ::: "memory");
    __syncthreads();
    if (b.wv == 0u && xb_lane() == 0u) {
        unsigned* bar = b.bar;
        __builtin_amdgcn_s_waitcnt(0);
        unsigned nloc = b.st[0], nx = b.st[1];
        if (nloc == 0u) { xcd_barrier_complete(bar, b.x, nloc, nx); b.st[0] = nloc; b.st[1] = nx; }
        const unsigned old = xb_add(&bar[XB_XSUB(b.x)], 1u);
        const unsigned gen = old / nloc;
        if (old + 1u == (gen + 1u) * nloc) {
            __builtin_amdgcn_fence(__ATOMIC_RELEASE, "agent");
            asm volatile("s_waitcnt vmcnt(0)" ::: "memory");
            const unsigned og = xb_add(&bar[XB_TOP], 1u);
            const unsigned tg = og / nx;
            if (og + 1u == (tg + 1u) * nx) xb_add(&bar[XB_TOPGEN], 1u);
            else XB_SPIN(xb_ld(&bar[XB_TOPGEN]) == tg, bar);
            __builtin_amdgcn_fence(__ATOMIC_ACQUIRE, "agent");
            xb_add(&bar[XB_XGEN(b.x)], 1u);
            asm volatile("s_waitcnt vmcnt(0)" ::: "memory");
        } else {
            XB_SPIN(xb_ld(&bar[XB_XGEN(b.x)]) == gen, bar);
            __builtin_amdgcn_fence(__ATOMIC_ACQUIRE, "agent");
            asm volatile("s_waitcnt vmcnt(0)" ::: "memory");
        }
    }
    __syncthreads();
}
#ifndef ONE_LAUNCH
#define ONE_LAUNCH 1
#endif
#ifndef NLAYERS
#define NLAYERS 4
#endif
constexpr int DM = 2048, MR = 8704, NLATR = 8192;
constexpr int NINP = 6400, DFF = 5632, NUP = 11264, EVIN = 6176, ODIN = 6160;
constexpr int NWAVES = 8, NTHR = 512;
constexpr float EPS = 1e-6f;
constexpr int NCHUNK = 68;
constexpr int PPL = 11, NPH = 1 + 4 * PPL;
constexpr size_t MiB = 1ull << 20;
constexpr size_t WS_CTL = 0, CTL_BYTES = 1 * MiB;
constexpr size_t WS_MOD = 1 * MiB, WS_ROPE = 1 * MiB + 640 * 1024;
constexpr size_t WS_W = 4 * MiB, W_LAYER = 99 * MiB, W_OUT = 25 * MiB, W_UP = 33 * MiB, W_DN = 77 * MiB;
constexpr size_t WS_XS = 400 * MiB, WS_H = 468 * MiB, WS_MIX = 502 * MiB, WS_P = 536 * MiB, WS_U = 644 * MiB, WS_ACT = 832 * MiB;
constexpr size_t WS_QR = 926 * MiB, WS_KR = 943 * MiB, WS_MQK = 960 * MiB, WS_DST = 977 * MiB, WS_SST = 1113 * MiB, WS_SM = 1181 * MiB, WS_B1 = 1185 * MiB, WS_B2 = 1186 * MiB, WS_END = 1187 * MiB;
constexpr size_t WS_SSQ = 524288;
constexpr size_t SM_GAM = 0, SM_DN = 1 * MiB, SM_NIN = 2 * MiB, SM_BL = 3 * MiB, SM_ML = 3 * MiB + 8192, SM_MIN = 3 * MiB + 16384;
constexpr int CW_BAR = 4096;
constexpr int LDS_BYTES = 147456, MISC_OFF = 131072 + 320;

struct Args { const float* in[27]; float* out; unsigned char* ws; int ph_lo, ph_hi, li, pad; };

__device__ __forceinline__ float bf_lo(unsigned u) { return __builtin_bit_cast(float, u << 16); }
__device__ __forceinline__ float bf_hi(unsigned u) { return __builtin_bit_cast(float, u & 0xffff0000u); }
__device__ __forceinline__ float bf1(bf16 b) { return __builtin_bit_cast(float, (unsigned)b << 16); }
typedef float f32x2_t __attribute__((ext_vector_type(2))); typedef __bf16 bf16x2_t __attribute__((ext_vector_type(2)));
__device__ __forceinline__ unsigned pk2(float lo, float hi) { f32x2_t v = {lo, hi}; bf16x2_t b = __builtin_convertvector(v, bf16x2_t); return __builtin_bit_cast(unsigned, b); }
__device__ __forceinline__ bf16 f2bf(float f) { return (bf16)(pk2(f, 0.f) & 0xffffu); }
__device__ __forceinline__ void unpack8(const v4u w, float (&f)[8]) { f[0] = bf_lo(w.x); f[1] = bf_hi(w.x); f[2] = bf_lo(w.y); f[3] = bf_hi(w.y); f[4] = bf_lo(w.z); f[5] = bf_hi(w.z); f[6] = bf_lo(w.w); f[7] = bf_hi(w.w); }
__device__ __forceinline__ v4u pack8(const float (&f)[8]) { v4u w; w.x = pk2(f[0], f[1]); w.y = pk2(f[2], f[3]); w.z = pk2(f[4], f[5]); w.w = pk2(f[6], f[7]); return w; }
__device__ __forceinline__ float silu_f(float x) { return x / (1.f + __expf(-x)); }
__device__ __forceinline__ float sigmoid_f(float x) { return 1.f / (1.f + __expf(-x)); }
__device__ __forceinline__ float logsig_f(float z) { return fminf(z, 0.f) - __logf(1.f + __expf(-fabsf(z))); }
__device__ __forceinline__ float wave_sum(float v) {
#pragma unroll
    for (int o = 1; o < 64; o <<= 1) v += __shfl_xor(v, o);
    return v;
}
__device__ __forceinline__ float wave_max(float v) {
#pragma unroll
    for (int o = 1; o < 64; o <<= 1) v = fmaxf(v, __shfl_xor(v, o));
    return v;
}
__device__ __forceinline__ float wave_scan_sum(float v, int dir, int lane) {
#pragma unroll
    for (int o = 1; o < 64; o <<= 1) { const float up = __shfl_up(v, o), dn = __shfl_down(v, o); if (dir == 0) { if (lane >= o) v += up; } else { if (lane + o < 64) v += dn; } }
    return v;
}
__device__ __forceinline__ float wave_scan_max(float v, int dir, int lane) {
#pragma unroll
    for (int o = 1; o < 64; o <<= 1) { const float up = __shfl_up(v, o), dn = __shfl_down(v, o); if (dir == 0) { if (lane >= o) v = fmaxf(v, up); } else { if (lane + o < 64) v = fmaxf(v, dn); } }
    return v;
}
__device__ __forceinline__ bool seq_start(int r) { return r < NLATR ? (r & 4095) == 0 : ((r - NLATR) & 255) == 0; }

__device__ __forceinline__ bf16x8 frag_row(LAS const unsigned char* base, int stride, int row0, int k0, int lane) {
    return *(LAS const bf16x8*)(base + (row0 + (lane & 31)) * stride + (k0 + 8 * (lane >> 5)) * 2);
}
__device__ __forceinline__ s16x4 tr4(LAS const unsigned char* p) { return __builtin_amdgcn_ds_read_tr16_b64_v4i16((LAS s16x4*)p); }
__device__ __forceinline__ bf16x8 frag_tr(LAS const unsigned char* base, int stride, int k0, int col0, int lane) {
    const int h = lane >> 5, blk = (lane >> 4) & 1, q = (lane & 15) >> 2, p = lane & 3;
    LAS const unsigned char* a = base + (k0 + 8 * h + q) * stride + (col0 + 16 * blk + 4 * p) * 2;
    const s16x4 lo = tr4(a), hi = tr4(a + 4 * stride);
    return (bf16x8){lo[0], lo[1], lo[2], lo[3], hi[0], hi[1], hi[2], hi[3]};
}
__device__ __forceinline__ bf16x8 frag_tr_perm(LAS const unsigned char* base, int stride, int k0, int col0, int lane) {
    const int h = lane >> 5, blk = (lane >> 4) & 1, q = (lane & 15) >> 2, p = lane & 3;
    LAS const unsigned char* a = base + (k0 + 4 * h + q) * stride + (col0 + 16 * blk + 4 * p) * 2;
    const s16x4 lo = tr4(a), hi = tr4(a + 8 * stride);
    return (bf16x8){lo[0], lo[1], lo[2], lo[3], hi[0], hi[1], hi[2], hi[3]};
}
__device__ __forceinline__ int swz_off(int row, int ch) { return 256 * row + 16 * (ch ^ (((row & 3) << 2) | ((row >> 2) & 3))); }
__device__ __forceinline__ bf16x8 sfrag_row(LAS const unsigned char* base, int row0, int k0, int lane) {
    return *(LAS const bf16x8*)(base + swz_off(row0 + (lane & 31), (k0 >> 3) + (lane >> 5)));
}
__device__ __forceinline__ bf16x8 sfrag_tr_perm(LAS const unsigned char* base, int k0, int col0, int lane) {
    const int h = lane >> 5, blk = (lane >> 4) & 1, q = (lane & 15) >> 2, p = lane & 3, ch = (col0 >> 3) + 2 * blk + (p >> 1), r0 = k0 + 4 * h + q;
    const s16x4 lo = tr4(base + swz_off(r0, ch) + 8 * (p & 1)), hi = tr4(base + swz_off(r0 + 8, ch) + 8 * (p & 1));
    return (bf16x8){lo[0], lo[1], lo[2], lo[3], hi[0], hi[1], hi[2], hi[3]};
}
#define MFMA32(a, b, c) __builtin_amdgcn_mfma_f32_32x32x16_bf16((a), (b), (c), 0, 0, 0)
__device__ __forceinline__ f32x16 zero16() { f32x16 z;
#pragma unroll
    for (int i = 0; i < 16; ++i) z[i] = 0.f;
    return z; }
__device__ __forceinline__ void load_tile(LAS unsigned char* dst, int ls, const bf16* src, size_t ld, int rows, int cols, int tid) {
    const int cpr = cols >> 3, n = rows * cpr;
    for (int c = tid; c < n; c += NTHR) { const int r = c / cpr, cc = c - r * cpr; *(LAS v4u*)(dst + r * ls + cc * 16) = *(const v4u*)(src + (size_t)r * ld + cc * 8); }
}

__device__ __forceinline__ void store_tile(bf16* dst, size_t ld, LAS const unsigned char* src, int ls, int rows, int cols, int tid) {
    const int cpr = cols >> 3, n = rows * cpr;
    for (int c = tid; c < n; c += NTHR) { const int r = c / cpr, cc = c - r * cpr; *(v4u*)(dst + (size_t)r * ld + cc * 8) = *(LAS const v4u*)(src + r * ls + cc * 16); }
}

struct TrItem { const float* W; bf16* WT; int K, N, k0, n0, dn0; };
__device__ __forceinline__ void tr_issue(const TrItem& t, f32x4 (&v)[8], int lane) {
    const int n = t.n0 + 4 * (lane & 7);
#pragma unroll
    for (int i = 0; i < 8; ++i) { const int kk = 8 * i + (lane >> 3); v[i] = n < t.N ? *(const f32x4*)(t.W + (size_t)(t.k0 + kk) * t.N + n) : (f32x4){0.f, 0.f, 0.f, 0.f}; }
}
__device__ __forceinline__ void tr_finish(const TrItem& t, const f32x4 (&v)[8], LAS float* scr, int lane) {
#pragma unroll
    for (int i = 0; i < 8; ++i) { const int kk = 8 * i + (lane >> 3); LAS float* d = scr + kk * 33 + 4 * (lane & 7); d[0] = v[i].x; d[1] = v[i].y; d[2] = v[i].z; d[3] = v[i].w; }
    asm volatile("s_waitcnt lgkmcnt(0)" ::: "memory");
    const int c = lane & 7;
#pragma unroll
    for (int j = 0; j < 4; ++j) { const int nn = (lane >> 3) + 8 * j; const LAS float* s = scr + (8 * c) * 33 + nn;
        v4u o; o.x = pk2(s[0 * 33], s[1 * 33]); o.y = pk2(s[2 * 33], s[3 * 33]); o.z = pk2(s[4 * 33], s[5 * 33]); o.w = pk2(s[6 * 33], s[7 * 33]);
        *(v4u*)(t.WT + (size_t)(t.dn0 + nn) * t.K + t.k0 + 8 * c) = o; }
    asm volatile("s_waitcnt lgkmcnt(0)" ::: "memory");
}
__device__ __forceinline__ void tr_decode(const Args& a, unsigned char* ws, int g, TrItem& t) {
    const int layer = g / 25344; int r = g - layer * 25344; const int li = layer >> 1;
    unsigned char* wb = ws + WS_W + (size_t)layer * W_LAYER;
    int nblk;
    if (r < 6400) { if (layer & 1) { t.W = a.in[14] + (size_t)li * DM * ODIN; t.N = ODIN; } else { t.W = a.in[8] + (size_t)li * DM * EVIN; t.N = EVIN; } t.WT = (bf16*)wb; t.K = DM; nblk = NINP / 32; }
    else if ((r -= 6400) < 2048) { t.W = (layer & 1 ? a.in[15] : a.in[9]) + (size_t)li * DM * DM; t.N = DM; t.WT = (bf16*)(wb + W_OUT); t.K = DM; nblk = DM / 32; }
    else if ((r -= 2048) < 11264) { t.W = a.in[23] + (size_t)layer * DM * NUP; t.N = NUP; t.WT = (bf16*)(wb + W_UP); t.K = DM; nblk = NUP / 32; }
    else { r -= 11264; t.W = a.in[26] + (size_t)layer * DFF * DM; t.N = DM; t.WT = (bf16*)(wb + W_DN); t.K = DFF; nblk = DM / 32; }
    const int kb = r / nblk, nb = r - kb * nblk; t.k0 = 64 * kb; t.n0 = 32 * nb; t.dn0 = t.n0;
    if (t.N == NUP) { const int m0 = t.n0 < DFF ? t.n0 : t.n0 - DFF; t.dn0 = 256 * (m0 >> 7) + (t.n0 < DFF ? 0 : 128) + (m0 & 127); }
}
__device__ __forceinline__ void ph_convert(const Args& a, unsigned char* ws, LAS unsigned char* lds, int g_lo, int g_hi, int w, int nw, int wave, int lane) {
    LAS float* scr = (LAS float*)(lds + wave * 8448);
    TrItem cur, nxt; f32x4 va[8], vb[8];
    int g = g_lo + w;
    if (g < g_hi) { tr_decode(a, ws, g, cur); tr_issue(cur, va, lane); }
    while (g < g_hi) {
        const int g1 = g + nw; if (g1 < g_hi) { tr_decode(a, ws, g1, nxt); tr_issue(nxt, vb, lane); }
        tr_finish(cur, va, scr, lane);
        const int g2 = g1 + nw; if (g1 < g_hi) { if (g2 < g_hi) { tr_decode(a, ws, g2, cur); tr_issue(cur, va, lane); } tr_finish(nxt, vb, scr, lane); }
        g = g2;
    }
}
__device__ __forceinline__ void ph_prologue(const Args& a, unsigned char* ws, LAS unsigned char* lds, int tid, int lane, int wave, int bid, int G) {
    float* MOD = (float*)(ws + WS_MOD);
    LAS float* vec = (LAS float*)(lds + 73728);
    LAS float* red = (LAS float*)(lds + 98304);
    for (int e = tid; e < 3 * DM; e += NTHR) { const float v = e < 2 * DM ? a.in[1][e] : a.in[3][e - 2 * DM]; vec[e] = silu_f(v); }
    __syncthreads();
    for (int it = bid; it < 4 * 192; it += G) {
        const int layer = it / 192, cg = it - layer * 192, col = cg * 64 + 4 * (lane & 15), rq = lane >> 4;
        const float* W = a.in[4] + (size_t)layer * DM * 12288 + col;
        f32x4 a0 = {0.f, 0.f, 0.f, 0.f}, a1 = a0, a2 = a0;
#pragma unroll 16
        for (int i = 0; i < 64; ++i) { const int kk = 256 * wave + 4 * i + rq; const f32x4 w4 = *(const f32x4*)(W + (size_t)kk * 12288);
            a0 += w4 * vec[kk]; a1 += w4 * vec[DM + kk]; a2 += w4 * vec[2 * DM + kk]; }
#pragma unroll
        for (int e = 0; e < 4; ++e) { a0[e] += __shfl_xor(a0[e], 16); a0[e] += __shfl_xor(a0[e], 32); a1[e] += __shfl_xor(a1[e], 16); a1[e] += __shfl_xor(a1[e], 32); a2[e] += __shfl_xor(a2[e], 16); a2[e] += __shfl_xor(a2[e], 32); }
        if (lane < 16) { *(LAS f32x4*)(red + (wave * 3 + 0) * 64 + 4 * lane) = a0; *(LAS f32x4*)(red + (wave * 3 + 1) * 64 + 4 * lane) = a1; *(LAS f32x4*)(red + (wave * 3 + 2) * 64 + 4 * lane) = a2; }
        __syncthreads();
        if (tid < 192) { const int j = tid >> 6, c = tid & 63; float s = a.in[5][layer * 12288 + cg * 64 + c];
#pragma unroll
            for (int w = 0; w < 8; ++w) s += red[(w * 3 + j) * 64 + c];
            MOD[(size_t)(layer * 3 + j) * 12288 + cg * 64 + c] = s; }
        __syncthreads();
    }
    if (bid == G - 1) { float* rope = (float*)(ws + WS_ROPE);
        for (int e = tid; e < 1024; e += NTHR) { const int pos = e >> 4, f = e & 15; const float inv = powf(10000.f, -(float)f / 16.f), ang = (float)pos * inv; rope[e] = cosf(ang); rope[1024 + e] = sinf(ang); } }
    ph_convert(a, ws, lds, 0, 25344, bid * NWAVES + wave, G * NWAVES, wave, lane);
}

__device__ __forceinline__ void fuse_row(const float* src, float* XS, int row, int lane, const float* part, const float* pgate, int nsplit, const float* ng, const float* msc, bf16* H, float* ssq) {
    const int mi = row < NLATR ? (row >> 12) : 2;
    const f32x4* sr = (const f32x4*)src + lane; f32x4* xr = (f32x4*)(XS + (size_t)row * DM) + lane;
    f32x4 v[8];
#pragma unroll
    for (int j = 0; j < 8; ++j) v[j] = sr[64 * j];
    if (nsplit > 0) {
        f32x4 sacc[8];
#pragma unroll
        for (int j = 0; j < 8; ++j) sacc[j] = (f32x4){0.f, 0.f, 0.f, 0.f};
        for (int sp = 0; sp < nsplit; ++sp) { const f32x4* pr = (const f32x4*)(part + ((size_t)sp * 512 + (row - NLATR)) * DM) + lane;
#pragma unroll
            for (int j = 0; j < 8; ++j) sacc[j] += pr[64 * j]; }
#pragma unroll
        for (int j = 0; j < 8; ++j) v[j] += *(const f32x4*)(pgate + 4 * lane + 256 * j) * sacc[j];
    }
    float ss = 0.f;
#pragma unroll
    for (int j = 0; j < 8; ++j) { xr[64 * j] = v[j]; ss += (v[j].x * v[j].x + v[j].y * v[j].y) + (v[j].z * v[j].z + v[j].w * v[j].w); }
    ss = wave_sum(ss);
    if (lane == 0) ssq[row] = ss;
#pragma unroll
    for (int j = 0; j < 8; ++j) { const int col = 4 * lane + 256 * j;
        const f32x4 y = v[j] * *(const f32x4*)(ng + col) * (*(const f32x4*)(msc + (size_t)mi * 12288 + col) + 1.f);
        v2u o; o.x = pk2(y.x, y.y); o.y = pk2(y.z, y.w);
        *(v2u*)(H + (size_t)row * DM + col) = o; }
}
__device__ __forceinline__ void ph_norm0(const float* x, const float* ctx, float* XS, const float* ng, const float* msc, bf16* H, float* ssq, int gw, int NGW, int lane) {
    for (int row = gw; row < MR; row += NGW) fuse_row(row < NLATR ? x + (size_t)row * DM : ctx + (size_t)(row - NLATR) * DM, XS, row, lane, nullptr, nullptr, 0, ng, msc, H, ssq);
}
template <int NS>
__device__ __forceinline__ void ph_ctxfix(float* XS, const float* part, const float* pgate, const float* ng, const float* msc, bf16* H, float* ssq, int gw, int NGW, int lane) {
    for (int it = gw; it < 2048; it += NGW) {
        const int row = NLATR + (it >> 2), c0 = (it & 3) * 512 + 8 * lane;
        float* xp = XS + (size_t)row * DM + c0;
        f32x4 v0 = *(const f32x4*)xp, v1 = *(const f32x4*)(xp + 4);
        f32x4 p0[NS], p1[NS];
#pragma unroll
        for (int sp = 0; sp < NS; ++sp) { const float* pp = part + ((size_t)sp * 512 + (row - NLATR)) * DM + c0; p0[sp] = *(const f32x4*)pp; p1[sp] = *(const f32x4*)(pp + 4); }
        f32x4 s0 = p0[0], s1 = p1[0];
#pragma unroll
        for (int sp = 1; sp < NS; ++sp) { s0 += p0[sp]; s1 += p1[sp]; }
        v0 += *(const f32x4*)(pgate + c0) * s0; v1 += *(const f32x4*)(pgate + c0 + 4) * s1;
        *(f32x4*)xp = v0; *(f32x4*)(xp + 4) = v1;
        float ss = (v0.x * v0.x + v0.y * v0.y) + (v0.z * v0.z + v0.w * v0.w) + (v1.x * v1.x + v1.y * v1.y) + (v1.z * v1.z + v1.w * v1.w);
        ss = wave_sum(ss);
        if (lane == 0) (void)__hip_atomic_fetch_add(ssq + row, ss, __ATOMIC_RELAXED, __HIP_MEMORY_SCOPE_AGENT);
        const f32x4 y0 = v0 * *(const f32x4*)(ng + c0) * (*(const f32x4*)(msc + 2 * 12288 + c0) + 1.f), y1 = v1 * *(const f32x4*)(ng + c0 + 4) * (*(const f32x4*)(msc + 2 * 12288 + c0 + 4) + 1.f);
        v4u o; o.x = pk2(y0.x, y0.y); o.y = pk2(y0.z, y0.w); o.z = pk2(y1.x, y1.y); o.w = pk2(y1.z, y1.w);
        *(v4u*)(H + (size_t)row * DM + c0) = o;
    }
}
__device__ __forceinline__ void ph_bias(const bf16* WIN, const bf16* WUPt, const float* mod, float* b1, float* b2, int gw, int NGW, int lane) {
    for (int which = 0; which < 2; ++which) {
        const bf16* WT = which ? WUPt : WIN; const int N = which ? NUP : NINP; const float* sh = mod + (which ? 3 * DM : 0); float* out = which ? b2 : b1;
        float s0[32], s1[32], s2[32];
#pragma unroll
        for (int i = 0; i < 4; ++i)
#pragma unroll
            for (int h = 0; h < 2; ++h) { const int k = 512 * i + 8 * lane + 4 * h; const f32x4 a0 = *(const f32x4*)(sh + k), a1 = *(const f32x4*)(sh + 12288 + k), a2 = *(const f32x4*)(sh + 2 * 12288 + k);
#pragma unroll
                for (int el = 0; el < 4; ++el) { s0[8 * i + 4 * h + el] = a0[el]; s1[8 * i + 4 * h + el] = a1[el]; s2[8 * i + 4 * h + el] = a2[el]; } }
#pragma unroll 1
        for (int n0 = gw * 2; n0 < N; n0 += NGW * 2) {
            v4u wv[2][4];
#pragma unroll
            for (int rr = 0; rr < 2; ++rr)
#pragma unroll
                for (int i = 0; i < 4; ++i) wv[rr][i] = *(const v4u*)(WT + (size_t)(n0 + rr) * DM + 512 * i + 8 * lane);
            float d[2][3];
#pragma unroll
            for (int rr = 0; rr < 2; ++rr) { d[rr][0] = 0.f; d[rr][1] = 0.f; d[rr][2] = 0.f;
#pragma unroll
                for (int i = 0; i < 4; ++i) { float w[8]; unpack8(wv[rr][i], w);
#pragma unroll
                    for (int el = 0; el < 8; ++el) { d[rr][0] += w[el] * s0[8 * i + el]; d[rr][1] += w[el] * s1[8 * i + el]; d[rr][2] += w[el] * s2[8 * i + el]; } } }
#pragma unroll
            for (int rr = 0; rr < 2; ++rr)
#pragma unroll
                for (int j = 0; j < 3; ++j) d[rr][j] = wave_sum(d[rr][j]);
            if (lane == 0) {
#pragma unroll
                for (int rr = 0; rr < 2; ++rr) { out[n0 + rr] = d[rr][0]; out[N + n0 + rr] = d[rr][1]; out[2 * N + n0 + rr] = d[rr][2]; } }
        }
    }
}

template <int MODE>
__device__ __forceinline__ void ph_conv(const bf16* SRC, const float* cw, const float* cb, bf16* DST, int gtid, int NT) {
    constexpr int NC = MODE == 0 ? DFF : 1024, NCG = NC / 8, NRB = MR / 16;
    constexpr int LDS_ = MODE == 0 ? NUP : NINP, LDD = MODE == 0 ? DFF : (MODE == 1 ? DM : 1024);
    for (int it = gtid; it < NRB * NCG; it += NT) {
        const int rb = it / NCG, cg = it - rb * NCG, r0 = rb * 16, c0 = cg * 8;
        float w0[8], w1[8], w2[8], bb[8];
#pragma unroll
        for (int j = 0; j < 8; ++j) { w0[j] = cw[c0 + j]; w1[j] = cw[NC + c0 + j]; w2[j] = cw[2 * NC + c0 + j]; bb[j] = MODE == 0 ? cb[c0 + j] : 0.f; }
        auto ld = [&](int r, float (&f)[8]) {
            if (MODE == 0) { unpack8(*(const v4u*)(SRC + (size_t)r * LDS_ + c0), f); }
            else if (MODE == 1) { float s1[8], s2[8]; unpack8(*(const v4u*)(SRC + (size_t)r * LDS_ + 3104 + c0), s1); unpack8(*(const v4u*)(SRC + (size_t)r * LDS_ + 5152 + c0), s2);
#pragma unroll
                for (int j = 0; j < 8; ++j) f[j] = s1[j] * s2[j]; }
            else { unpack8(*(const v4u*)(SRC + (size_t)r * LDS_ + 3072 + c0), f); }
        };
        float prev[8], cur[8], nxt[8];
        if (!seq_start(r0)) ld(r0 - 1, prev); else {
#pragma unroll
            for (int j = 0; j < 8; ++j) prev[j] = 0.f; }
        ld(r0, cur);
#pragma unroll 2
        for (int i = 0; i < 16; ++i) {
            const int r = r0 + i;
            if (i < 15 || !seq_start(r0 + 16)) ld(r + 1, nxt); else {
#pragma unroll
                for (int j = 0; j < 8; ++j) nxt[j] = 0.f; }
            float o[8];
            if (MODE == 0) { float vv[8]; unpack8(*(const v4u*)(SRC + (size_t)r * LDS_ + DFF + c0), vv);
#pragma unroll
                for (int j = 0; j < 8; ++j) o[j] = silu_f(w0[j] * prev[j] + w1[j] * cur[j] + w2[j] * nxt[j] + bb[j]) * vv[j]; }
            else if (MODE == 1) { float vv[8]; unpack8(*(const v4u*)(SRC + (size_t)r * LDS_ + 4128 + c0), vv);
#pragma unroll
                for (int j = 0; j < 8; ++j) o[j] = (w0[j] * prev[j] + w1[j] * cur[j] + w2[j] * nxt[j]) * vv[j]; }
            else { const float sc = c0 >= 512 ? 0.08838834764831845f : 1.f;
#pragma unroll
                for (int j = 0; j < 8; ++j) o[j] = silu_f(w0[j] * prev[j] + w1[j] * cur[j] + w2[j] * nxt[j]) * sc; }
            *(v4u*)(DST + (size_t)r * LDD + (MODE == 1 ? 1024 : 0) + c0) = pack8(o);
#pragma unroll
            for (int j = 0; j < 8; ++j) { prev[j] = cur[j]; cur[j] = nxt[j]; }
        }
    }
}

__device__ __forceinline__ void ph_act_fix(const float* halo, const float* cw, bf16* ACT, int gtid, int NT) {
    for (int e = gtid; e < 34 * 44 * 256; e += NT) {
        const int ch = e & 127, which = (e >> 7) & 1, tile = e >> 8, pm = tile / 44, pn = tile - pm * 44, chg = pn * 128 + ch;
        const float* hb = halo + (size_t)tile * 768;
        const int row = 256 * pm + (which ? 255 : 0);
        float g = 0.f;
        if (which == 0) { if (!seq_start(row)) g = halo[(size_t)(tile - 44) * 768 + 128 + ch] * cw[chg]; }
        else { if (!seq_start(row + 1)) g = halo[(size_t)(tile + 44) * 768 + ch] * cw[2 * DFF + chg]; }
        const float cv = hb[(2 + which) * 128 + ch] + g;
        ACT[(size_t)row * DFF + chg] = f2bf(silu_f(cv) * hb[(4 + which) * 128 + ch]);
    }
}

__device__ __forceinline__ void act_fix_tile(const float* halo, const float* cw, bf16* ACT, int pm, int tid) {
    f32x4 cp[6], vv[6], gg[6];
#pragma unroll
    for (int i = 0; i < 6; ++i) { const int e = tid + NTHR * i; const bool ok = e < 2816; const int ee = ok ? e : 0;
        const int c4 = ee & 31, which = (ee >> 5) & 1, pn = ee >> 6, tile = pm * 44 + pn, chg = pn * 128 + 4 * c4;
        const float* hb = halo + (size_t)tile * 768 + 4 * c4;
        const int row = 256 * pm + (which ? 255 : 0);
        cp[i] = *(const f32x4*)(hb + (2 + which) * 128); vv[i] = *(const f32x4*)(hb + (4 + which) * 128);
        const bool edge = which == 0 ? seq_start(row) : seq_start(row + 1);
        const f32x4 nb = edge ? (f32x4){0.f, 0.f, 0.f, 0.f} : *(const f32x4*)(halo + (size_t)(which == 0 ? tile - 44 : tile + 44) * 768 + (which == 0 ? 128 : 0) + 4 * c4);
        gg[i] = nb * *(const f32x4*)(cw + (which == 0 ? 0 : 2 * DFF) + chg); }
#pragma unroll
    for (int i = 0; i < 6; ++i) { const int e = tid + NTHR * i; if (e < 2816) {
        const int c4 = e & 31, which = (e >> 5) & 1, pn = e >> 6, chg = pn * 128 + 4 * c4; const int row = 256 * pm + (which ? 255 : 0);
        const f32x4 cv = cp[i] + gg[i];
        v2u o; o.x = pk2(silu_f(cv.x) * vv[i].x, silu_f(cv.y) * vv[i].y); o.y = pk2(silu_f(cv.z) * vv[i].z, silu_f(cv.w) * vv[i].w);
        *(v2u*)(ACT + (size_t)row * DFF + chg) = o; } }
}

__device__ __forceinline__ void ph_qkprep(const bf16* P, const float* qg, const float* kg, const float* rope, bf16* QR, bf16* KR, int gw, int NGW, int lane) {
    for (int it = gw; it < MR * 4; it += NGW) {
        const int row = it >> 2, qtr = it & 3, isk = qtr >> 1;
        float x[8]; unpack8(*(const v4u*)(P + (size_t)row * NINP + isk * 1024 + (qtr & 1) * 512 + 8 * lane), x);
        float ss = 0.f;
#pragma unroll
        for (int j = 0; j < 8; ++j) ss += x[j] * x[j];
        ss += __shfl_xor(ss, 1); ss += __shfl_xor(ss, 2); ss += __shfl_xor(ss, 4);
        const float r = rsqrtf(ss * (1.f / 64.f) + EPS);
        const int i = lane & 7; const float* gp = (isk ? kg : qg) + 8 * i;
        float y[8], o[8];
#pragma unroll
        for (int j = 0; j < 8; ++j) y[j] = x[j] * r * gp[j];
        if (row < NLATR) {
            const int t = row & 4095, pos = (i < 4) ? (t >> 6) : (t & 63), f0 = 8 * (i & 1);
#pragma unroll
            for (int j = 0; j < 8; ++j) { const float pj = __shfl_xor(y[j], 2), c = rope[pos * 16 + f0 + j], s = rope[1024 + pos * 16 + f0 + j];
                o[j] = (i & 2) ? (pj * s + y[j] * c) : (y[j] * c - pj * s); }
        } else {
#pragma unroll
            for (int j = 0; j < 8; ++j) o[j] = y[j]; }
        if (!isk) {
#pragma unroll
            for (int j = 0; j < 8; ++j) o[j] *= 0.18033688011112042f; }
        *(v4u*)((isk ? KR : QR) + (size_t)row * 1024 + (qtr & 1) * 512 + 8 * lane) = pack8(o);
    }
}

struct ScanP {
    const bf16* P; const bf16* MQK; bf16* MIX;
    const float* gw2; const float* gb;
    const float* mgb;
    const float* ng;
    bf16* DSTp; bf16* SSTp; float* GAM; float* DN; float* NIN; float* BL; float* ML; float* MINp;
};
__device__ __forceinline__ void scan_unit(int u, int& b, int& head, int& mm, int& rowbase) {
    b = u / 272; const int rem = u - b * 272; head = rem / 68; mm = rem - head * 68;
    rowbase = mm < 4 ? NLATR + b * 256 + 64 * mm : b * 4096 + 64 * (mm - 4);
}
__device__ __forceinline__ int scan_chunk(int mm, int dir) { return dir ? (mm < 4 ? 3 - mm : 71 - mm) : mm; }

__device__ __forceinline__ void gla_gates(const ScanP& s, LAS const float* glr, LAS float* tot, int head, int dir, int tid, float (&bb)[16], float& btot) {
    const int dk = tid & 127, grp = tid >> 7;
    float w2[16];
#pragma unroll
    for (int r = 0; r < 16; ++r) w2[r] = s.gw2[(dir * 16 + r) * 512 + head * 128 + dk];
    const float bias = s.gb[dir * 512 + head * 128 + dk];
#pragma unroll
    for (int tt = 0; tt < 16; ++tt) { const int t = 16 * grp + tt; float z = bias;
#pragma unroll
        for (int r = 0; r < 16; ++r) z += glr[t * 32 + dir * 16 + r] * w2[r];
        bb[tt] = logsig_f(z) * 0.0625f; }
    if (dir == 0) {
#pragma unroll
        for (int tt = 1; tt < 16; ++tt) bb[tt] += bb[tt - 1];
        tot[grp * 128 + dk] = bb[15];
    } else {
#pragma unroll
        for (int tt = 14; tt >= 0; --tt) bb[tt] += bb[tt + 1];
        tot[grp * 128 + dk] = bb[0];
    }
    __syncthreads();
    float off = 0.f; btot = 0.f;
#pragma unroll
    for (int g = 0; g < 4; ++g) { const float tv = tot[g * 128 + dk]; btot += tv; if (dir == 0 ? g < grp : g > grp) off += tv; }
#pragma unroll
    for (int tt = 0; tt < 16; ++tt) bb[tt] += off;
}

__device__ __forceinline__ void ph_mlstm_local(const ScanP& s, LAS unsigned char* lds, int tid, int lane, int wave, int bid, int G) {
    LAS unsigned char* Vs = lds; LAS unsigned char* Kh = lds + 33792; LAS unsigned char* Kr = lds + 69632;
    LAS float* wv = (LAS float*)(lds + 87040); LAS float* dnp = (LAS float*)(lds + 87296);
    const int dk = tid & 127, grp = tid >> 7;
    for (int u = bid; u < 544; u += G) {
        int b, head, mm, rowbase; scan_unit(u, b, head, mm, rowbase);
        load_tile(Kr, 272, s.MQK + (size_t)rowbase * 1024 + 512 + head * 128, 1024, 64, 128, tid);
        for (int dir = 0; dir < 2; ++dir) {
            const int chain = (b * 4 + head) * 2 + dir, c = scan_chunk(mm, dir); const size_t cc = (size_t)chain * NCHUNK + c;
            load_tile(Vs, 528, s.P + (size_t)rowbase * NINP + 4096 + head * 256, NINP, 64, 256, tid);
            if (wave == 0) {
                const float ig = bf1(s.P[(size_t)(rowbase + lane) * NINP + 6144 + dir * 8 + head]) + s.mgb[dir * 8 + head];
                const float fg = bf1(s.P[(size_t)(rowbase + lane) * NINP + 6144 + dir * 8 + 4 + head]) + s.mgb[dir * 8 + 4 + head];
                const float lf = logsig_f(fg), bcs = wave_scan_sum(lf, dir, lane), blast = wave_sum(lf);
                const float gs = blast - bcs + ig, mloc = wave_max(gs);
                wv[lane] = __expf(gs - mloc);
                if (lane == 0) { s.BL[cc] = blast; s.ML[cc] = mloc; }
            }
            __syncthreads();
            float part = 0.f;
#pragma unroll
            for (int tt = 0; tt < 16; ++tt) { const int t = 16 * grp + tt; const float kv = bf1(*(LAS const bf16*)(Kr + t * 272 + dk * 2)) * wv[t];
                *(LAS bf16*)(Kh + t * 272 + dk * 2) = f2bf(kv); part += kv; }
            dnp[grp * 128 + dk] = part;
            __syncthreads();
            if (tid < 128) s.DN[cc * 128 + tid] = (dnp[tid] + dnp[128 + tid]) + (dnp[256 + tid] + dnp[384 + tid]);
            f32x16 acc[4];
#pragma unroll
            for (int nt = 0; nt < 4; ++nt) acc[nt] = zero16();
#pragma unroll
            for (int ks = 0; ks < 4; ++ks) { const bf16x8 af = frag_tr(Vs, 528, 16 * ks, 32 * wave, lane);
#pragma unroll
                for (int nt = 0; nt < 4; ++nt) { const bf16x8 bfr = frag_tr(Kh, 272, 16 * ks, 32 * nt, lane); acc[nt] = MFMA32(af, bfr, acc[nt]); } }
            __syncthreads();
#pragma unroll
            for (int nt = 0; nt < 4; ++nt)
#pragma unroll
                for (int r = 0; r < 16; ++r) { const int dv = 32 * wave + (r & 3) + 8 * (r >> 2) + 4 * (lane >> 5); *(LAS bf16*)(lds + dv * 272 + (32 * nt + (lane & 31)) * 2) = f2bf(acc[nt][r]); }
            __syncthreads();
            store_tile(s.DSTp + cc * 32768, 128, lds, 272, 256, 128, tid);
            __syncthreads();
        }
    }
}

__device__ __forceinline__ void ph_gla_local(const ScanP& s, bf16* QT, bf16* KT, LAS unsigned char* lds, int tid, int lane, int wave, int bid, int G) {
    LAS unsigned char* Vs = lds; LAS unsigned char* Kh = lds + 33792; LAS unsigned char* Qr = lds + 51200; LAS unsigned char* Kr = lds + 68608;
    LAS float* glr = (LAS float*)(lds + 86016); LAS float* tot = (LAS float*)(lds + 90112);
    const int dk = tid & 127, grp = tid >> 7;
    for (int u = bid; u < 1088; u += G) {
        const int dir = u & 1; int b, head, mm, rowbase; scan_unit(u >> 1, b, head, mm, rowbase);
        const int chain = (b * 4 + head) * 2 + dir, c = scan_chunk(mm, dir); const size_t cc = (size_t)chain * NCHUNK + c;
        load_tile(Vs, 528, s.P + (size_t)rowbase * NINP + 1024 + head * 256, NINP, 64, 256, tid);
        load_tile(Qr, 272, s.P + (size_t)rowbase * NINP + head * 128, NINP, 64, 128, tid);
        load_tile(Kr, 272, s.P + (size_t)rowbase * NINP + 512 + head * 128, NINP, 64, 128, tid);
        for (int e = tid; e < 1024; e += NTHR) glr[e] = bf1(s.P[(size_t)(rowbase + (e >> 4)) * NINP + 3072 + dir * 16 + (e & 15)]);
        __syncthreads();
        float bb[16], btot;
        { float w2[16];
#pragma unroll
          for (int r = 0; r < 16; ++r) w2[r] = s.gw2[(dir * 16 + r) * 512 + head * 128 + dk];
          const float bias = s.gb[dir * 512 + head * 128 + dk];
#pragma unroll
          for (int tt = 0; tt < 16; ++tt) { const int t = 16 * grp + tt; float z = bias;
#pragma unroll
              for (int r = 0; r < 16; ++r) z += glr[t * 16 + r] * w2[r];
              bb[tt] = logsig_f(z) * 0.0625f; }
          if (dir == 0) {
#pragma unroll
              for (int tt = 1; tt < 16; ++tt) bb[tt] += bb[tt - 1];
              tot[grp * 128 + dk] = bb[15];
          } else {
#pragma unroll
              for (int tt = 14; tt >= 0; --tt) bb[tt] += bb[tt + 1];
              tot[grp * 128 + dk] = bb[0];
          }
          __syncthreads();
          float off = 0.f; btot = 0.f;
#pragma unroll
          for (int g = 0; g < 4; ++g) { const float tv = tot[g * 128 + dk]; btot += tv; if (dir == 0 ? g < grp : g > grp) off += tv; }
#pragma unroll
          for (int tt = 0; tt < 16; ++tt) bb[tt] += off; }
#pragma unroll
        for (int tt = 0; tt < 16; ++tt) { const int t = 16 * grp + tt;
            const float qv = bf1(*(LAS const bf16*)(Qr + t * 272 + dk * 2)), kv = bf1(*(LAS const bf16*)(Kr + t * 272 + dk * 2));
            const float e1 = __expf(bb[tt]);
            *(LAS bf16*)(Kh + t * 272 + dk * 2) = f2bf(kv * __expf(btot - bb[tt]));
            *(LAS bf16*)(Qr + t * 272 + dk * 2) = f2bf(qv * e1 * 0.08838834764831845f); *(LAS bf16*)(Kr + t * 272 + dk * 2) = f2bf(kv * __builtin_amdgcn_rcpf(e1)); }
        if (grp == 0) s.GAM[cc * 128 + dk] = __expf(btot);
        __syncthreads();
        store_tile(QT + ((size_t)dir * MR + rowbase) * 512 + head * 128, 512, Qr, 272, 64, 128, tid);
        store_tile(KT + ((size_t)dir * MR + rowbase) * 512 + head * 128, 512, Kr, 272, 64, 128, tid);
        f32x16 acc[4];
#pragma unroll
        for (int nt = 0; nt < 4; ++nt) acc[nt] = zero16();
#pragma unroll
        for (int ks = 0; ks < 4; ++ks) { const bf16x8 af = frag_tr(Vs, 528, 16 * ks, 32 * wave, lane);
#pragma unroll
            for (int nt = 0; nt < 4; ++nt) { const bf16x8 bfr = frag_tr(Kh, 272, 16 * ks, 32 * nt, lane); acc[nt] = MFMA32(af, bfr, acc[nt]); } }
        __syncthreads();
#pragma unroll
        for (int nt = 0; nt < 4; ++nt)
#pragma unroll
            for (int r = 0; r < 16; ++r) { const int dv = 32 * wave + (r & 3) + 8 * (r >> 2) + 4 * (lane >> 5); *(LAS bf16*)(lds + dv * 272 + (32 * nt + (lane & 31)) * 2) = f2bf(acc[nt][r]); }
        __syncthreads();
        store_tile(s.DSTp + cc * 32768, 128, lds, 272, 256, 128, tid);
        __syncthreads();
    }
}
__device__ __forceinline__ void ph_gla_out(const ScanP& s, const bf16* QT, const bf16* KT, LAS unsigned char* lds, int tid, int lane, int wave, int bid, int G) {
    LAS unsigned char* Vs = lds;
    LAS unsigned char* Qx = lds + 33792;
    LAS unsigned char* Ki = lds + 68608;
    LAS unsigned char* Am = lds + 103424;
    LAS float* Os = (LAS float*)lds;
    for (int u = bid; u < 544; u += G) {
        int b, head, mm, rowbase; scan_unit(u, b, head, mm, rowbase);
        load_tile(Vs, 528, s.P + (size_t)rowbase * NINP + 1024 + head * 256, NINP, 64, 256, tid);
#pragma unroll
        for (int dir = 0; dir < 2; ++dir) {
            load_tile(Qx + dir * 17408, 272, QT + ((size_t)dir * MR + rowbase) * 512 + head * 128, 512, 64, 128, tid);
            load_tile(Ki + dir * 17408, 272, KT + ((size_t)dir * MR + rowbase) * 512 + head * 128, 512, 64, 128, tid); }
        bf16x8 sf[2][8];
#pragma unroll
        for (int dir = 0; dir < 2; ++dir) { const int chain = (b * 4 + head) * 2 + dir, c = scan_chunk(mm, dir); const size_t cc = (size_t)chain * NCHUNK + c;
            const bf16* Sg = s.SSTp + cc * 32768 + (size_t)(32 * wave + (lane & 31)) * 128 + 8 * (lane >> 5);
#pragma unroll
            for (int ks = 0; ks < 8; ++ks) sf[dir][ks] = *(const bf16x8*)(Sg + 16 * ks); }
        __syncthreads();
        {
            const int dir = wave >> 2, ti = (wave >> 1) & 1, tj = wave & 1; f32x16 acc = zero16();
#pragma unroll
            for (int ks = 0; ks < 8; ++ks) { const bf16x8 af = frag_row(Qx + dir * 17408, 272, 32 * ti, 16 * ks, lane), bfr = frag_row(Ki + dir * 17408, 272, 32 * tj, 16 * ks, lane); acc = MFMA32(af, bfr, acc); }
            const int sidx = 32 * tj + (lane & 31);
#pragma unroll
            for (int r = 0; r < 16; ++r) { const int t = 32 * ti + (r & 3) + 8 * (r >> 2) + 4 * (lane >> 5);
                const bool keep = dir == 0 ? (sidx <= t) : (sidx >= t);
                *(LAS bf16*)(Am + dir * 9216 + t * 144 + sidx * 2) = f2bf(keep ? acc[r] : 0.f); }
        }
        __syncthreads();
        f32x16 acc2[2]; acc2[0] = zero16(); acc2[1] = zero16();
#pragma unroll
        for (int dir = 0; dir < 2; ++dir) {
#pragma unroll
            for (int ks = 0; ks < 8; ++ks)
#pragma unroll
                for (int rt = 0; rt < 2; ++rt) { const bf16x8 af = frag_row(Qx + dir * 17408, 272, 32 * rt, 16 * ks, lane); acc2[rt] = MFMA32(af, sf[dir][ks], acc2[rt]); }
#pragma unroll
            for (int ks = 0; ks < 4; ++ks) { const bf16x8 bfr = frag_tr(Vs, 528, 16 * ks, 32 * wave, lane);
#pragma unroll
                for (int rt = 0; rt < 2; ++rt) { const bf16x8 af = frag_row(Am + dir * 9216, 144, 32 * rt, 16 * ks, lane); acc2[rt] = MFMA32(af, bfr, acc2[rt]); } }
        }
        __syncthreads();
#pragma unroll
        for (int rt = 0; rt < 2; ++rt)
#pragma unroll
            for (int r = 0; r < 16; ++r) { const int t = 32 * rt + (r & 3) + 8 * (r >> 2) + 4 * (lane >> 5); Os[t * 260 + 32 * wave + (lane & 31)] = acc2[rt][r]; }
        __syncthreads();
        { const int t = tid >> 3, part = tid & 7; float o[32]; float ss = 0.f;
#pragma unroll
          for (int j = 0; j < 8; ++j) { const f32x4 v = *(LAS const f32x4*)(Os + t * 260 + 32 * part + 4 * j); o[4 * j] = v.x; o[4 * j + 1] = v.y; o[4 * j + 2] = v.z; o[4 * j + 3] = v.w; ss += (v.x * v.x + v.y * v.y) + (v.z * v.z + v.w * v.w); }
          ss += __shfl_xor(ss, 1); ss += __shfl_xor(ss, 2); ss += __shfl_xor(ss, 4);
          const float rn = rsqrtf(ss * (1.f / 256.f) + EPS);
          const size_t row = (size_t)(rowbase + t);
          const bf16* gsrc = s.P + row * NINP + 2048 + head * 256 + 32 * part;
          bf16* dst = s.MIX + row * DM + head * 256 + 32 * part;
#pragma unroll
          for (int j = 0; j < 4; ++j) { float gv[8], ov[8]; unpack8(*(const v4u*)(gsrc + 8 * j), gv);
#pragma unroll
              for (int e = 0; e < 8; ++e) ov[e] = o[8 * j + e] * rn * s.ng[32 * part + 8 * j + e] * silu_f(gv[e]);
              *(v4u*)(dst + 8 * j) = pack8(ov); } }
        __syncthreads();
    }
}

__device__ __forceinline__ void ph_mlstm_out(const ScanP& s, LAS unsigned char* lds, int tid, int lane, int wave, int bid, int G) {
    LAS unsigned char* Vs = lds; LAS unsigned char* Qi = lds + 33792; LAS unsigned char* Ki = lds + 51200; LAS unsigned char* Qx = lds + 68608; LAS unsigned char* Am = lds + 103424;
    LAS float* sc = (LAS float*)(lds + 121856);
    LAS float* qnp = (LAS float*)(lds + 125952);
    LAS float* Os = (LAS float*)lds;
    for (int u = bid; u < 544; u += G) {
        int b, head, mm, rowbase; scan_unit(u, b, head, mm, rowbase);
        load_tile(Vs, 528, s.P + (size_t)rowbase * NINP + 4096 + head * 256, NINP, 64, 256, tid);
        load_tile(Qi, 272, s.MQK + (size_t)rowbase * 1024 + head * 128, 1024, 64, 128, tid);
        load_tile(Ki, 272, s.MQK + (size_t)rowbase * 1024 + 512 + head * 128, 1024, 64, 128, tid);
        size_t ccd[2];
#pragma unroll
        for (int dir = 0; dir < 2; ++dir) ccd[dir] = (size_t)((b * 4 + head) * 2 + dir) * NCHUNK + scan_chunk(mm, dir);
        bf16x8 sf[2][8];
#pragma unroll
        for (int dir = 0; dir < 2; ++dir) { const bf16* Sg = s.SSTp + ccd[dir] * 32768 + (size_t)(32 * wave + (lane & 31)) * 128 + 8 * (lane >> 5);
#pragma unroll
            for (int ks = 0; ks < 8; ++ks) sf[dir][ks] = *(const bf16x8*)(Sg + 16 * ks); }
        if (wave < 2) { const int dir = wave; LAS float* d = sc + dir * 512;
            const float ig = bf1(s.P[(size_t)(rowbase + lane) * NINP + 6144 + dir * 8 + head]) + s.mgb[dir * 8 + head];
            const float fg = bf1(s.P[(size_t)(rowbase + lane) * NINP + 6144 + dir * 8 + 4 + head]) + s.mgb[dir * 8 + 4 + head];
            const float lf = logsig_f(fg), bcs = wave_scan_sum(lf, dir, lane);
            const float uu = ig - bcs, pm = wave_scan_max(uu, dir, lane), min_ = s.MINp[ccd[dir]], Mt = fmaxf(min_, pm);
            d[lane] = uu; d[64 + lane] = Mt; d[128 + lane] = __expf(min_ - Mt); d[192 + lane] = __expf(-bcs - Mt); }
        __syncthreads();
        { const int t = tid & 63, part = tid >> 6;
          float a0 = 0.f, a1 = 0.f; const float w0 = sc[128 + t], w1 = sc[512 + 128 + t];
#pragma unroll
          for (int hh = 0; hh < 2; ++hh) { float qv[8], o0[8], o1[8]; unpack8(*(LAS const v4u*)(Qi + t * 272 + (part * 16 + 8 * hh) * 2), qv);
              const float* n0p = s.NIN + ccd[0] * 128 + part * 16 + 8 * hh; const float* n1p = s.NIN + ccd[1] * 128 + part * 16 + 8 * hh;
              const f32x4 n00 = *(const f32x4*)n0p, n01 = *(const f32x4*)(n0p + 4), n10 = *(const f32x4*)n1p, n11 = *(const f32x4*)(n1p + 4);
              a0 += (qv[0] * n00.x + qv[1] * n00.y) + (qv[2] * n00.z + qv[3] * n00.w) + (qv[4] * n01.x + qv[5] * n01.y) + (qv[6] * n01.z + qv[7] * n01.w);
              a1 += (qv[0] * n10.x + qv[1] * n10.y) + (qv[2] * n10.z + qv[3] * n10.w) + (qv[4] * n11.x + qv[5] * n11.y) + (qv[6] * n11.z + qv[7] * n11.w);
#pragma unroll
              for (int e = 0; e < 8; ++e) { o0[e] = qv[e] * w0; o1[e] = qv[e] * w1; }
              *(LAS v4u*)(Qx + t * 272 + (part * 16 + 8 * hh) * 2) = pack8(o0); *(LAS v4u*)(Qx + 17408 + t * 272 + (part * 16 + 8 * hh) * 2) = pack8(o1); }
          qnp[part * 64 + t] = a0; qnp[512 + part * 64 + t] = a1; }
        {
            const int dir = wave >> 2, ti = (wave >> 1) & 1, tj = wave & 1; LAS const float* d = sc + dir * 512; f32x16 acc = zero16();
#pragma unroll
            for (int ks = 0; ks < 8; ++ks) { const bf16x8 af = frag_row(Qi, 272, 32 * ti, 16 * ks, lane), bfr = frag_row(Ki, 272, 32 * tj, 16 * ks, lane); acc = MFMA32(af, bfr, acc); }
            const int sidx = 32 * tj + (lane & 31); const float usv = d[sidx];
#pragma unroll
            for (int r = 0; r < 16; ++r) { const int t = 32 * ti + (r & 3) + 8 * (r >> 2) + 4 * (lane >> 5);
                const bool keep = dir == 0 ? (sidx <= t) : (sidx >= t);
                const float v = keep ? acc[r] * __expf(usv - d[64 + t]) : 0.f;
                *(LAS bf16*)(Am + dir * 9216 + t * 144 + sidx * 2) = f2bf(v);
                float rsum = v; rsum += __shfl_xor(rsum, 1); rsum += __shfl_xor(rsum, 2); rsum += __shfl_xor(rsum, 4); rsum += __shfl_xor(rsum, 8); rsum += __shfl_xor(rsum, 16);
                if ((lane & 31) == 0) (sc + dir * 512)[384 + tj * 64 + t] = rsum; }
        }
        __syncthreads();
        if (tid < 128) { const int dir = tid >> 6, t = tid & 63; LAS float* d = sc + dir * 512; float q = 0.f;
#pragma unroll
            for (int p = 0; p < 8; ++p) q += qnp[dir * 512 + p * 64 + t];
            const float den = d[128 + t] * q + d[384 + t] + d[448 + t]; d[256 + t] = 1.f / fmaxf(fabsf(den), d[192 + t]); }
        f32x16 ad[2][2];
#pragma unroll
        for (int dir = 0; dir < 2; ++dir) { ad[dir][0] = zero16(); ad[dir][1] = zero16();
#pragma unroll
            for (int ks = 0; ks < 8; ++ks)
#pragma unroll
                for (int rt = 0; rt < 2; ++rt) { const bf16x8 af = frag_row(Qx + dir * 17408, 272, 32 * rt, 16 * ks, lane); ad[dir][rt] = MFMA32(af, sf[dir][ks], ad[dir][rt]); }
#pragma unroll
            for (int ks = 0; ks < 4; ++ks) { const bf16x8 bfr = frag_tr(Vs, 528, 16 * ks, 32 * wave, lane);
#pragma unroll
                for (int rt = 0; rt < 2; ++rt) { const bf16x8 af = frag_row(Am + dir * 9216, 144, 32 * rt, 16 * ks, lane); ad[dir][rt] = MFMA32(af, bfr, ad[dir][rt]); } } }
        __syncthreads();
#pragma unroll
        for (int rt = 0; rt < 2; ++rt)
#pragma unroll
            for (int r = 0; r < 16; ++r) { const int t = 32 * rt + (r & 3) + 8 * (r >> 2) + 4 * (lane >> 5); ad[0][rt][r] = ad[0][rt][r] * sc[256 + t] + ad[1][rt][r] * sc[512 + 256 + t]; }
        __syncthreads();
#pragma unroll
        for (int rt = 0; rt < 2; ++rt)
#pragma unroll
            for (int r = 0; r < 16; ++r) { const int t = 32 * rt + (r & 3) + 8 * (r >> 2) + 4 * (lane >> 5); Os[t * 260 + 32 * wave + (lane & 31)] = ad[0][rt][r]; }
        __syncthreads();
        { const int t = tid >> 3, part = tid & 7; float o[32]; float ss = 0.f;
#pragma unroll
          for (int j = 0; j < 8; ++j) { const f32x4 v = *(LAS const f32x4*)(Os + t * 260 + 32 * part + 4 * j); o[4 * j] = v.x; o[4 * j + 1] = v.y; o[4 * j + 2] = v.z; o[4 * j + 3] = v.w; ss += (v.x * v.x + v.y * v.y) + (v.z * v.z + v.w * v.w); }
          ss += __shfl_xor(ss, 1); ss += __shfl_xor(ss, 2); ss += __shfl_xor(ss, 4);
          const float rn = rsqrtf(ss * (1.f / 256.f) + EPS);
          const size_t row = (size_t)(rowbase + t);
          const bf16* gsrc = s.P + row * NINP + 5120 + head * 256 + 32 * part;
          bf16* dst = s.MIX + row * DM + 1024 + head * 256 + 32 * part;
#pragma unroll
          for (int j = 0; j < 4; ++j) { float gv[8], ov[8]; unpack8(*(const v4u*)(gsrc + 8 * j), gv);
#pragma unroll
              for (int e = 0; e < 8; ++e) ov[e] = o[8 * j + e] * rn * s.ng[32 * part + 8 * j + e] * sigmoid_f(gv[e]);
              *(v4u*)(dst + 8 * j) = pack8(ov); } }
        __syncthreads();
    }
}

template <int MODE>
__device__ __forceinline__ void ph_scan_carry(const ScanP& s, int gtid, int NT) {
    for (int e = gtid; e < 16 * 8192; e += NT) {
        const int chain = e >> 13, rem = e & 8191, dv = rem >> 5, dk = (rem & 31) * 4;
        f32x4 st = {0.f, 0.f, 0.f, 0.f}, nst = st; float m = 0.f;
        for (int c0 = 0; c0 < NCHUNK; c0 += 4) {
            f32x4 d[4], gm[4]; float bl[4], ml[4];
#pragma unroll
            for (int j = 0; j < 4; ++j) { const size_t cc = (size_t)chain * NCHUNK + c0 + j; { const v2u dw = *(const v2u*)(s.DSTp + cc * 32768 + dv * 128 + dk); d[j] = (f32x4){bf_lo(dw.x), bf_hi(dw.x), bf_lo(dw.y), bf_hi(dw.y)}; }
                if (MODE == 0) gm[j] = *(const f32x4*)(s.GAM + cc * 128 + dk);
                else { bl[j] = s.BL[cc]; ml[j] = s.ML[cc]; gm[j] = (dv == 0) ? *(const f32x4*)(s.DN + cc * 128 + dk) : (f32x4){0.f, 0.f, 0.f, 0.f}; } }
#pragma unroll
            for (int j = 0; j < 4; ++j) { const size_t cc = (size_t)chain * NCHUNK + c0 + j;
                v2u o; o.x = pk2(st.x, st.y); o.y = pk2(st.z, st.w); *(v2u*)(s.SSTp + cc * 32768 + dv * 128 + dk) = o;
                if (MODE == 0) st = gm[j] * st + d[j];
                else { if (dv == 0) { *(f32x4*)(s.NIN + cc * 128 + dk) = nst; if (dk == 0) s.MINp[cc] = m; }
                    const float mn = fmaxf(bl[j] + m, ml[j]), dec = __expf(bl[j] + m - mn), sc = __expf(ml[j] - mn);
                    st = st * dec + d[j] * sc; nst = nst * dec + gm[j] * sc; m = mn; } }
        }
    }
}

template <int MODE>
__device__ __forceinline__ void ph_scan_out(const ScanP& s, LAS unsigned char* lds, int tid, int lane, int wave, int bid, int G) {
    LAS unsigned char* Vs = lds; LAS unsigned char* Qx = lds + 33792; LAS unsigned char* Ki = lds + 51200; LAS unsigned char* Qi = lds + 68608; LAS unsigned char* Am = lds + 86016;
    LAS float* glr = (LAS float*)(lds + 95232); LAS float* tot = (LAS float*)(lds + 103424);
    LAS float* us = (LAS float*)(lds + 105472); LAS float* Mts = us + 64; LAS float* wint = us + 128; LAS float* thr = us + 192; LAS float* fac = us + 256; LAS float* qn = us + 320; LAS float* rs = us + 384;
    LAS float* qnp = (LAS float*)(lds + 107520);
    LAS float* Os = (LAS float*)lds;
    const int dk = tid & 127, grp = tid >> 7;
    for (int u = bid; u < 544; u += G) {
        int b, head, mm, rowbase; scan_unit(u, b, head, mm, rowbase);
        load_tile(Vs, 528, s.P + (size_t)rowbase * NINP + (MODE ? 4096 : 1024) + head * 256, NINP, 64, 256, tid);
        if (MODE == 0) { for (int e = tid; e < 2048; e += NTHR) glr[e] = bf1(s.P[(size_t)(rowbase + (e >> 5)) * NINP + 3072 + (e & 31)]); if (tid < 64) fac[tid] = 1.f; }
        else { load_tile(Qi, 272, s.MQK + (size_t)rowbase * 1024 + head * 128, 1024, 64, 128, tid); load_tile(Ki, 272, s.MQK + (size_t)rowbase * 1024 + 512 + head * 128, 1024, 64, 128, tid); }
        f32x16 hsum[2]; hsum[0] = zero16(); hsum[1] = zero16();
        __syncthreads();
        for (int dir = 0; dir < 2; ++dir) {
            const int chain = (b * 4 + head) * 2 + dir, c = scan_chunk(mm, dir); const size_t cc = (size_t)chain * NCHUNK + c;
            if (MODE == 0) {
                float bb[16], btot; gla_gates(s, glr, tot, head, dir, tid, bb, btot);
#pragma unroll
                for (int tt = 0; tt < 16; ++tt) { const int t = 16 * grp + tt; const size_t ro = (size_t)(rowbase + t) * NINP + head * 128 + dk;
                    const float qv = bf1(s.P[ro]), kv = bf1(s.P[ro + 512]);
                    *(LAS bf16*)(Qx + t * 272 + dk * 2) = f2bf(qv * __expf(bb[tt]) * 0.08838834764831845f);
                    *(LAS bf16*)(Ki + t * 272 + dk * 2) = f2bf(kv * __expf(-bb[tt])); }
            } else {
                if (wave == 0) {
                    const float ig = bf1(s.P[(size_t)(rowbase + lane) * NINP + 6144 + dir * 8 + head]) + s.mgb[dir * 8 + head];
                    const float fg = bf1(s.P[(size_t)(rowbase + lane) * NINP + 6144 + dir * 8 + 4 + head]) + s.mgb[dir * 8 + 4 + head];
                    const float lf = logsig_f(fg), bcs = wave_scan_sum(lf, dir, lane);
                    const float uu = ig - bcs, pm = wave_scan_max(uu, dir, lane), min_ = s.MINp[cc], Mt = fmaxf(min_, pm);
                    us[lane] = uu; Mts[lane] = Mt; wint[lane] = __expf(min_ - Mt); thr[lane] = __expf(-bcs - Mt);
                }
                __syncthreads();
                { const int t = tid & 63, part = tid >> 6; float acc = 0.f;
                  const float wi = wint[t];
#pragma unroll
                  for (int hh = 0; hh < 2; ++hh) { float qv[8], ov[8]; unpack8(*(LAS const v4u*)(Qi + t * 272 + (part * 16 + 8 * hh) * 2), qv);
                      const f32x4 n0 = *(const f32x4*)(s.NIN + cc * 128 + part * 16 + 8 * hh), n1 = *(const f32x4*)(s.NIN + cc * 128 + part * 16 + 8 * hh + 4);
                      acc += (qv[0] * n0.x + qv[1] * n0.y) + (qv[2] * n0.z + qv[3] * n0.w) + (qv[4] * n1.x + qv[5] * n1.y) + (qv[6] * n1.z + qv[7] * n1.w);
#pragma unroll
                      for (int e = 0; e < 8; ++e) ov[e] = qv[e] * wi;
                      *(LAS v4u*)(Qx + t * 272 + (part * 16 + 8 * hh) * 2) = pack8(ov); }
                  qnp[part * 64 + t] = acc; }
            }
            __syncthreads();
            if (MODE == 1 && tid < 64) { float q = 0.f;
#pragma unroll
                for (int p = 0; p < 8; ++p) q += qnp[p * 64 + tid];
                qn[tid] = q; }
            if (wave < 4) {
                const int ti = wave >> 1, tj = wave & 1; f32x16 acc = zero16();
#pragma unroll
                for (int ks = 0; ks < 8; ++ks) { const bf16x8 af = frag_row(MODE ? Qi : Qx, 272, 32 * ti, 16 * ks, lane), bfr = frag_row(Ki, 272, 32 * tj, 16 * ks, lane); acc = MFMA32(af, bfr, acc); }
                const int sidx = 32 * tj + (lane & 31);
                const float usv = MODE ? us[sidx] : 0.f;
#pragma unroll
                for (int r = 0; r < 16; ++r) { const int t = 32 * ti + (r & 3) + 8 * (r >> 2) + 4 * (lane >> 5);
                    const bool keep = dir == 0 ? (sidx <= t) : (sidx >= t);
                    float v = acc[r];
                    if (MODE == 1) v *= __expf(usv - Mts[t]);
                    v = keep ? v : 0.f;
                    *(LAS bf16*)(Am + t * 144 + sidx * 2) = f2bf(v);
                    if (MODE == 1) { float rsum = v; rsum += __shfl_xor(rsum, 1); rsum += __shfl_xor(rsum, 2); rsum += __shfl_xor(rsum, 4); rsum += __shfl_xor(rsum, 8); rsum += __shfl_xor(rsum, 16);
                        if ((lane & 31) == 0) rs[tj * 64 + t] = rsum; } }
            }
            __syncthreads();
            if (MODE == 1 && tid < 64) { const float den = wint[tid] * qn[tid] + rs[tid] + rs[64 + tid]; fac[tid] = 1.f / fmaxf(fabsf(den), thr[tid]); }
            f32x16 acc2[2]; acc2[0] = zero16(); acc2[1] = zero16();
            { const bf16* Sg = s.SSTp + cc * 32768 + (size_t)(32 * wave + (lane & 31)) * 128 + 8 * (lane >> 5);
#pragma unroll
              for (int ks = 0; ks < 8; ++ks) { const bf16x8 bfr = *(const bf16x8*)(Sg + 16 * ks);
#pragma unroll
                  for (int rt = 0; rt < 2; ++rt) { const bf16x8 af = frag_row(Qx, 272, 32 * rt, 16 * ks, lane); acc2[rt] = MFMA32(af, bfr, acc2[rt]); } } }
#pragma unroll
            for (int ks = 0; ks < 4; ++ks) { const bf16x8 bfr = frag_tr(Vs, 528, 16 * ks, 32 * wave, lane);
#pragma unroll
                for (int rt = 0; rt < 2; ++rt) { const bf16x8 af = frag_row(Am, 144, 32 * rt, 16 * ks, lane); acc2[rt] = MFMA32(af, bfr, acc2[rt]); } }
            __syncthreads();
#pragma unroll
            for (int rt = 0; rt < 2; ++rt)
#pragma unroll
                for (int r = 0; r < 16; ++r) { const int t = 32 * rt + (r & 3) + 8 * (r >> 2) + 4 * (lane >> 5); hsum[rt][r] += acc2[rt][r] * fac[t]; }
        }
        __syncthreads();
#pragma unroll
        for (int rt = 0; rt < 2; ++rt)
#pragma unroll
            for (int r = 0; r < 16; ++r) { const int t = 32 * rt + (r & 3) + 8 * (r >> 2) + 4 * (lane >> 5); Os[t * 260 + 32 * wave + (lane & 31)] = hsum[rt][r]; }
        __syncthreads();
        { const int t = tid >> 3, part = tid & 7; float o[32]; float ss = 0.f;
#pragma unroll
          for (int j = 0; j < 8; ++j) { const f32x4 v = *(LAS const f32x4*)(Os + t * 260 + 32 * part + 4 * j); o[4 * j] = v.x; o[4 * j + 1] = v.y; o[4 * j + 2] = v.z; o[4 * j + 3] = v.w; ss += (v.x * v.x + v.y * v.y) + (v.z * v.z + v.w * v.w); }
          ss += __shfl_xor(ss, 1); ss += __shfl_xor(ss, 2); ss += __shfl_xor(ss, 4);
          const float rn = rsqrtf(ss * (1.f / 256.f) + EPS);
          const size_t row = (size_t)(rowbase + t);
          const bf16* gsrc = s.P + row * NINP + (MODE ? 5120 : 2048) + head * 256 + 32 * part;
          bf16* dst = s.MIX + row * DM + (MODE ? 1024 : 0) + head * 256 + 32 * part;
#pragma unroll
          for (int j = 0; j < 4; ++j) { float gv[8], ov[8]; unpack8(*(const v4u*)(gsrc + 8 * j), gv);
#pragma unroll
              for (int e = 0; e < 8; ++e) { const float gt = MODE ? sigmoid_f(gv[e]) : silu_f(gv[e]); ov[e] = o[8 * j + e] * rn * s.ng[32 * part + 8 * j + e] * gt; }
              *(v4u*)(dst + 8 * j) = pack8(ov); } }
        __syncthreads();
    }
}

__device__ __forceinline__ void glds16(const void* sbase  , unsigned voff  , unsigned lds_dst  ) { unsigned keep;
    asm volatile("s_mov_b32 %0, m0\n\ts_mov_b32 m0, %3\n\ts_nop 0\n\tglobal_load_lds_dwordx4 %1, %2\n\ts_mov_b32 m0, %0" : "=&s"(keep) : "v"(voff), "s"(sbase), "s"(lds_dst) : "memory"); }
struct AttnP { const bf16* QR; const bf16* KR; const bf16* P; bf16* MIX; const float* lamp; const float* subg; const float* qg; const float* kg; float lam_init; unsigned* queue; };
template <bool SUB>
__device__ __forceinline__ void ph_attn(const AttnP& p, LAS unsigned char* lds, int tid, int lane, int wave, int bid, int G) {
    const float l01 = wave_sum(p.lamp[lane] * p.lamp[64 + lane]), l23 = wave_sum(p.lamp[128 + lane] * p.lamp[192 + lane]);
    const float lam = __expf(l01) - __expf(l23) + p.lam_init;
    const float negm2 = -8.f * wave_max(fabsf(p.qg[lane])) * wave_max(fabsf(p.kg[lane])) * 1.4426950408889634f * 1.02f;
    const int r = lane & 31, h = lane >> 5, mp = wave >> 2, wq = wave & 3;
    LAS float* Ex = (LAS float*)lds;
    const unsigned xcc = xb_xcc_id() & 7u;
    volatile LAS int* qslot = (volatile LAS int*)(lds + MISC_OFF + 96);
    for (int qq = 0; qq < 8; ++qq) for (;;) {
        const int hd = (int)((xcc + (unsigned)qq) & 7u);
        if (tid == 0) qslot[0] = (int)__hip_atomic_fetch_add(p.queue + 16 * hd, 1u, __ATOMIC_RELAXED, __HIP_MEMORY_SCOPE_AGENT);
        __syncthreads();
        const int idx = qslot[0];
        __syncthreads();
        if (idx >= 68) break;
        int b, qrow0, nkt;
        if (idx < 64) { b = idx >> 5; qrow0 = b * 4096 + 128 * (idx & 31); nkt = 68; }
        else { const int uu = idx - 64; b = uu >> 1; qrow0 = NLATR + b * 256 + 128 * (uu & 1); nkt = 4; }
        const int qrow = qrow0 + 32 * wq + r;
        bf16x8 Qf[4];
#pragma unroll
        for (int ks = 0; ks < 4; ++ks) Qf[ks] = *(const bf16x8*)(p.QR + (size_t)qrow * 1024 + (hd * 2 + mp) * 64 + 16 * ks + 8 * h);
        f32x16 O[4];
#pragma unroll
        for (int dt = 0; dt < 4; ++dt) O[dt] = zero16();
        float ls = 0.f;
        const int dq = lane >> 4, dp = lane & 15;
        unsigned voffK[4], voffV[4];
#pragma unroll
        for (int j = 0; j < 4; ++j) { const unsigned ch = 16u * (unsigned)(dp ^ ((dq << 2) | j)); voffK[j] = (unsigned)dq * 2048u + ch; voffV[j] = (unsigned)dq * (unsigned)(NINP * 2) + ch; }
        int kaddr[4], vaddr[2][4];
#pragma unroll
        for (int ks = 0; ks < 4; ++ks) kaddr[ks] = swz_off(r, 8 * mp + 2 * ks + h);
        { const int blk = (lane >> 4) & 1, q = (lane & 15) >> 2, pp = lane & 3;
#pragma unroll
          for (int e = 0; e < 2; ++e)
#pragma unroll
              for (int dt = 0; dt < 4; ++dt) vaddr[e][dt] = swz_off(4 * h + q + 8 * e, 4 * dt + 2 * blk + (pp >> 1)) + 8 * (pp & 1); }
        const int nkt2 = nkt >> 1;
        const unsigned ldsb = (unsigned)(size_t)lds;
#define AT_DMA(kt_, buf_) do { const int krow_ = (kt_) < 2 ? NLATR + b * 256 + 128 * (kt_) : b * 4096 + 128 * ((kt_) - 2); \
            _Pragma("unroll") for (int j = 0; j < 4; ++j) { const int g_ = 4 * wave + j, row_ = krow_ + 4 * g_; \
                glds16(p.KR + (size_t)row_ * 1024 + hd * 128, voffK[j], (unsigned)__builtin_amdgcn_readfirstlane((int)(ldsb + (buf_) * 32768 + 1024 * g_))); \
                glds16(p.P + (size_t)row_ * NINP + 2048 + hd * 128, voffV[j], (unsigned)__builtin_amdgcn_readfirstlane((int)(ldsb + 65536 + (buf_) * 32768 + 1024 * g_))); } } while (0)
#define AT_QK(S_, kb_) do { S_ = zero16(); _Pragma("unroll") for (int ks = 0; ks < 4; ++ks) { const bf16x8 a0 = *(LAS const bf16x8*)(Kt + kaddr[ks] + 8192 * (kb_)); S_ = MFMA32(a0, Qf[ks], S_); } } while (0)
        AT_DMA(0, 0);
        asm volatile("s_waitcnt vmcnt(0)" ::: "memory");
        __syncthreads();
        for (int kt = 0; kt < nkt2; ++kt) {
            const bool more = kt + 1 < nkt2;
            if (more) AT_DMA(kt + 1, (kt + 1) & 1);
            LAS const unsigned char* Kt = lds + (kt & 1) * 32768; LAS const unsigned char* Vt = lds + 65536 + (kt & 1) * 32768;
#define AT_VF(dst_, kb_, dt_) do { const s16x4 t0_ = tr4(Vt + vaddr[0][dt_] + 8192 * (kb_)), t1_ = tr4(Vt + vaddr[1][dt_] + 8192 * (kb_)), t2_ = tr4(Vt + vaddr[0][dt_] + 8192 * (kb_) + 4096), t3_ = tr4(Vt + vaddr[1][dt_] + 8192 * (kb_) + 4096); \
                dst_[0] = (bf16x8){t0_[0], t0_[1], t0_[2], t0_[3], t1_[0], t1_[1], t1_[2], t1_[3]}; dst_[1] = (bf16x8){t2_[0], t2_[1], t2_[2], t2_[3], t3_[0], t3_[1], t3_[2], t3_[3]}; } while (0)
            bf16x8 kf[4], P0, P1;
#pragma unroll
            for (int ks = 0; ks < 4; ++ks) kf[ks] = *(LAS const bf16x8*)(Kt + kaddr[ks]);
            { f32x16 S0 = zero16();
#pragma unroll
              for (int ks = 0; ks < 4; ++ks) S0 = MFMA32(kf[ks], Qf[ks], S0);
#pragma unroll
              for (int ks = 0; ks < 4; ++ks) kf[ks] = *(LAS const bf16x8*)(Kt + kaddr[ks] + 8192);
              unsigned pf[8]; float lacc = 0.f;
#pragma unroll
              for (int i = 0; i < 8; ++i) { const float e0 = __builtin_amdgcn_exp2f(SUB ? S0[2 * i] + negm2 : S0[2 * i]), e1 = __builtin_amdgcn_exp2f(SUB ? S0[2 * i + 1] + negm2 : S0[2 * i + 1]); lacc += e0 + e1; pf[i] = pk2(e0, e1); }
              ls += lacc;
              P0 = __builtin_bit_cast(bf16x8, (v4u){pf[0], pf[1], pf[2], pf[3]}); P1 = __builtin_bit_cast(bf16x8, (v4u){pf[4], pf[5], pf[6], pf[7]}); }
            __builtin_amdgcn_sched_barrier(0);
#pragma unroll
            for (int kb = 0; kb < 4; ++kb) {
                bf16x8 v0[2], v1[2], v2[2], v3[2];
                AT_VF(v0, kb, 0); AT_VF(v1, kb, 1); AT_VF(v2, kb, 2); AT_VF(v3, kb, 3);
                f32x16 Sn = zero16();
                if (kb < 3) {
#pragma unroll
                    for (int ks = 0; ks < 4; ++ks) Sn = MFMA32(kf[ks], Qf[ks], Sn);
                    if (kb < 2) {
#pragma unroll
                        for (int ks = 0; ks < 4; ++ks) kf[ks] = *(LAS const bf16x8*)(Kt + kaddr[ks] + 8192 * (kb + 2)); } }
                O[0] = MFMA32(v0[0], P0, O[0]); O[0] = MFMA32(v0[1], P1, O[0]); O[1] = MFMA32(v1[0], P0, O[1]); O[1] = MFMA32(v1[1], P1, O[1]);
                O[2] = MFMA32(v2[0], P0, O[2]); O[2] = MFMA32(v2[1], P1, O[2]); O[3] = MFMA32(v3[0], P0, O[3]); O[3] = MFMA32(v3[1], P1, O[3]);
                if (kb < 3) {
                    unsigned pf[8]; float lacc = 0.f;
#pragma unroll
                    for (int i = 0; i < 8; ++i) { const float e0 = __builtin_amdgcn_exp2f(SUB ? Sn[2 * i] + negm2 : Sn[2 * i]), e1 = __builtin_amdgcn_exp2f(SUB ? Sn[2 * i + 1] + negm2 : Sn[2 * i + 1]); lacc += e0 + e1; pf[i] = pk2(e0, e1); }
                    ls += lacc;
                    P0 = __builtin_bit_cast(bf16x8, (v4u){pf[0], pf[1], pf[2], pf[3]}); P1 = __builtin_bit_cast(bf16x8, (v4u){pf[4], pf[5], pf[6], pf[7]});
                    __builtin_amdgcn_sched_group_barrier(0x100, 20, 0); __builtin_amdgcn_sched_group_barrier(0x008, 6, 0);
#pragma unroll
                    for (int gI = 0; gI < 6; ++gI) { __builtin_amdgcn_sched_group_barrier(0x002, 8, 0); __builtin_amdgcn_sched_group_barrier(0x008, 1, 0); }
                }
                __builtin_amdgcn_sched_barrier(0);
            }
#undef AT_VF
            asm volatile("s_waitcnt vmcnt(0)" ::: "memory");
            __syncthreads();
        }
#undef AT_DMA
#undef AT_QK
        const float l = ls + __shfl_xor(ls, 32);
        if (mp == 1) { const float sc = lam / l;
#pragma unroll
            for (int dt = 0; dt < 4; ++dt)
#pragma unroll
                for (int i = 0; i < 16; ++i) Ex[(32 * wq + r) * 132 + 32 * dt + (i & 3) + 8 * (i >> 2) + 4 * h] = O[dt][i] * sc; }
        __syncthreads();
        if (mp == 0) { const float a0 = 1.f / l; float ss = 0.f;
#pragma unroll
            for (int dt = 0; dt < 4; ++dt)
#pragma unroll
                for (int i = 0; i < 16; ++i) { const float v = O[dt][i] * a0 - Ex[(32 * wq + r) * 132 + 32 * dt + (i & 3) + 8 * (i >> 2) + 4 * h]; O[dt][i] = v; ss += v * v; }
            ss += __shfl_xor(ss, 32);
            const float rn = rsqrtf(ss * (1.f / 128.f) + EPS) * (1.f - p.lam_init);
            int qrow2 = qrow0 + 32 * wq + r; asm volatile("" : "+v"(qrow2));
            bf16* dst = p.MIX + (size_t)qrow2 * DM + hd * 128;
#pragma unroll
            for (int dt = 0; dt < 4; ++dt)
#pragma unroll
                for (int g4 = 0; g4 < 4; ++g4) { const int dv0 = 32 * dt + 8 * g4 + 4 * h; const f32x4 sg = *(const f32x4*)(p.subg + dv0);
                    v2u o; o.x = pk2(O[dt][4 * g4] * rn * sg.x, O[dt][4 * g4 + 1] * rn * sg.y); o.y = pk2(O[dt][4 * g4 + 2] * rn * sg.z, O[dt][4 * g4 + 3] * rn * sg.w);
                    *(v2u*)(dst + dv0) = o; } }
        __syncthreads();
    }
}

#ifndef PHASE_MASK
#define PHASE_MASK 0xFFFFFFu
#endif
#define PM(j) ((PHASE_MASK >> (j)) & 1u)
#ifndef REP_MASK
#define REP_MASK 0u
#endif
#define REPS(j) ((((REP_MASK) >> (j)) & 1u) ? 2 : 1)
#define PH_BEGIN(j, k) if (PM(j) && IN(k)) for (int rep_ = 0; rep_ < REPS(j); ++rep_) { if (rep_) xcd_barrier(bar);
#define PH_END }
#define PHASE_BEGIN int wave = wave0, bid = bid0, G = G0, zz_ = 0; asm volatile("" : "+s"(wave), "+s"(bid), "+s"(G), "+s"(zz_)); const int lane = (int)__builtin_amdgcn_mbcnt_hi(~0u, __builtin_amdgcn_mbcnt_lo(~0u, (unsigned)zz_)), tid = wave * 64 + lane; \
    unsigned char* ws = ws0; asm volatile("" : "+s"(ws)); const __attribute__((address_space(4))) Args* ap_ = (const __attribute__((address_space(4))) Args*)__builtin_amdgcn_kernarg_segment_ptr(); asm volatile("" : "+s"(ap_)); const Args& a = *(const Args*)ap_; (void)a; const int gw = bid * NWAVES + wave, NGW = G * NWAVES, gtid = bid * NTHR + tid, NT = G * NTHR; (void)gw; (void)NGW; (void)gtid; (void)NT; (void)lane;
__device__ __forceinline__ void fill_scanp(ScanP& sp, const Args& a, unsigned char* ws, int li, bool even) {
    sp.P = (const bf16*)(ws + WS_P); sp.MQK = (const bf16*)(ws + WS_MQK); sp.MIX = (bf16*)(ws + WS_MIX);
    sp.gw2 = a.in[10] + (size_t)li * 2 * 16 * 512; sp.gb = a.in[11] + (size_t)li * 2 * 512; sp.mgb = a.in[21] + (size_t)li * 16;
    sp.ng = even ? a.in[12] + (size_t)li * 256 : a.in[22] + (size_t)li * 256;
    sp.DSTp = (bf16*)(ws + WS_DST); sp.SSTp = (bf16*)(ws + WS_SST); sp.GAM = (float*)(ws + WS_SM + SM_GAM); sp.DN = (float*)(ws + WS_SM + SM_DN); sp.NIN = (float*)(ws + WS_SM + SM_NIN);
    sp.BL = (float*)(ws + WS_SM + SM_BL); sp.ML = (float*)(ws + WS_SM + SM_ML); sp.MINp = (float*)(ws + WS_SM + SM_MIN);
}
__global__ void __launch_bounds__(NTHR, 2) fwd_kernel(Args a) {
    extern __shared__ __attribute__((aligned(16))) unsigned char lds_raw[];
    LAS unsigned char* lds = (LAS unsigned char*)lds_raw;
    const int tid0 = threadIdx.x, wave0 = __builtin_amdgcn_readfirstlane(tid0 >> 6), bid0 = blockIdx.x, G0 = gridDim.x;
    unsigned char* ws0 = a.ws;
    volatile LAS unsigned* MISC = (volatile LAS unsigned*)(lds + MISC_OFF);
    if (tid0 < 32) MISC[tid0] = 0u;
    __syncthreads();
    XcdBarrier bar = xcd_barrier_post((unsigned*)(ws0 + WS_CTL) + CW_BAR + a.li * XCD_BAR_WORDS, MISC + 8, (unsigned)wave0);
    const int lo = a.ph_lo, hi = a.ph_hi;
#define IN(k) (lo <= (k) && (k) < hi)
#ifndef TMASK
#define TMASK 0u
#endif
#ifndef LMASK
#define LMASK 0xFu
#endif
    volatile LAS unsigned long long* tst_ = (volatile LAS unsigned long long*)(lds + MISC_OFF + 64);
    if (TMASK && tid0 == 0) { tst_[0] = __builtin_amdgcn_s_memrealtime(); tst_[1] = 0ull; }
#define SEAM2(k, kk, ll) do { if (IN(k) && IN((k) + 1)) xcd_barrier(bar); if (TMASK && wave0 == 0 && xb_lane() == 0u) { const unsigned long long now_ = __builtin_amdgcn_s_memrealtime(); if (((TMASK >> (kk)) & 1u) && ((LMASK >> (ll)) & 1u)) tst_[1] += now_ - tst_[0]; tst_[0] = now_; } } while (0)
#define SEAM(k) SEAM2(k, (k) == 0 ? 11 : ((k) - 1) % PPL, (k) == 0 ? 0 : ((k) - 1) / PPL)

    PH_BEGIN(11, 0) PHASE_BEGIN; ph_prologue(a, ws, lds, tid, lane, wave, bid, G); PH_END
    SEAM(0);
    for (int layer = 0; layer < NLAYERS; ++layer) {
        const int pb = 1 + layer * PPL, li = layer >> 1; const bool even = (layer & 1) == 0;
        const size_t mod_off = WS_MOD + (size_t)layer * 3 * 12288 * 4;
        const size_t wb_off = WS_W + (size_t)layer * W_LAYER;

        PH_BEGIN(0, pb + 0) PHASE_BEGIN; const float* mod = (const float*)(ws + mod_off); float* ssq = (float*)(ws + WS_SSQ) + (size_t)(2 * layer) * MR;
            if (layer == 0) ph_norm0(a.in[0], a.in[2], (float*)(ws + WS_XS), a.in[6], mod + 1 * DM, (bf16*)(ws + WS_H), ssq, gw, NGW, lane);
            else ph_ctxfix<11>((float*)(ws + WS_XS), (const float*)(ws + WS_DST), mod - 3 * 12288 + 2 * 12288 + 5 * DM, a.in[6] + (size_t)layer * DM, mod + 1 * DM, (bf16*)(ws + WS_H), ssq, gw, NGW, lane);
            { PHASE_BEGIN; const float* mod2 = (const float*)(ws + mod_off); ph_bias((const bf16*)(ws + wb_off), (const bf16*)(ws + wb_off + W_UP), mod2, (float*)(ws + WS_B1) + (size_t)layer * 3 * NINP, (float*)(ws + WS_B2) + (size_t)layer * 3 * NUP, gw, NGW, lane); } }
        SEAM(pb + 0);
        PH_BEGIN(1, pb + 1) PHASE_BEGIN; pg8::Gemm g{(const bf16*)(ws + WS_H), (const bf16*)(ws + wb_off), MR, NINP, DM}; pg8::StaticOrder S; S.init(MR, NINP, G, bid); pg8::EpiStore E{(bf16*)(ws + WS_P), NINP, (const float*)(ws + WS_SSQ) + (size_t)(2 * layer) * MR, (const float*)(ws + WS_B1) + (size_t)layer * 3 * NINP, NINP};
            pg8::gemm_phase<pg8::EpiStore, pg8::StaticOrder, true, true>(lds, g, S, E, wave);
            if (layer + 1 < NLAYERS && G == 256 && bid >= 82) { __syncthreads(); ph_convert(a, ws, lds, (layer + 1) * 25344, (layer + 2) * 25344, (bid - 82) * NWAVES + wave, 174 * NWAVES, wave, lane); }
            else if (layer + 1 < NLAYERS && G != 256) { __syncthreads(); ph_convert(a, ws, lds, (layer + 1) * 25344, (layer + 2) * 25344, bid * NWAVES + wave, G * NWAVES, wave, lane); } }
        SEAM(pb + 1);
        PH_BEGIN(2, pb + 2)
            if (even) {
                if (PM(12)) { PHASE_BEGIN; ph_conv<1>((const bf16*)(ws + WS_P), a.in[13] + (size_t)li * 3 * 1024, nullptr, (bf16*)(ws + WS_MIX), gtid, NT); }
                if (PM(13)) { PHASE_BEGIN; ScanP sp; fill_scanp(sp, a, ws, li, even); ph_gla_local(sp, (bf16*)(ws + WS_QR), (bf16*)(ws + WS_KR), lds, tid, lane, wave, bid, G); }
            } else {
                if (PM(14)) { PHASE_BEGIN; ph_qkprep((const bf16*)(ws + WS_P), a.in[16] + (size_t)li * 64, a.in[17] + (size_t)li * 64, (const float*)(ws + WS_ROPE), (bf16*)(ws + WS_QR), (bf16*)(ws + WS_KR), gw, NGW, lane); }
                if (PM(15)) { PHASE_BEGIN; ph_conv<2>((const bf16*)(ws + WS_P), a.in[20] + (size_t)li * 3 * 1024, nullptr, (bf16*)(ws + WS_MQK), gtid, NT); }
            }
        }
        SEAM(pb + 2);
        PH_BEGIN(3, pb + 3) if (!even) { PHASE_BEGIN; ScanP sp; fill_scanp(sp, a, ws, li, even); ph_mlstm_local(sp, lds, tid, lane, wave, bid, G); } }
        if (!even) SEAM(pb + 3);
        PH_BEGIN(4, pb + 4) PHASE_BEGIN; ScanP sp; fill_scanp(sp, a, ws, li, even); if (even) ph_scan_carry<0>(sp, gtid, NT); else ph_scan_carry<1>(sp, gtid, NT); }
        SEAM(pb + 4);
        PH_BEGIN(5, pb + 5)
            if (even) { if (PM(16)) { PHASE_BEGIN; ScanP sp; fill_scanp(sp, a, ws, li, even); ph_gla_out(sp, (const bf16*)(ws + WS_QR), (const bf16*)(ws + WS_KR), lds, tid, lane, wave, bid, G); } }
            else {
                if (PM(17)) { PHASE_BEGIN; AttnP ap{(const bf16*)(ws + WS_QR), (const bf16*)(ws + WS_KR), (const bf16*)(ws + WS_P), (bf16*)(ws + WS_MIX), a.in[18] + (size_t)li * 256, a.in[19] + (size_t)li * 128, a.in[16] + (size_t)li * 64, a.in[17] + (size_t)li * 64, 0.8f - 0.6f * expf(-0.3f * (float)layer), (unsigned*)(ws + 32768 + 1024 * li)};
                    const float bound = 8.f * wave_max(fabsf(ap.qg[lane])) * wave_max(fabsf(ap.kg[lane])) * 1.4426950408889634f;
                    if (bound < 60.f) ph_attn<false>(ap, lds, tid, lane, wave, bid, G); else ph_attn<true>(ap, lds, tid, lane, wave, bid, G);
                    if (TMASK && wave0 == 0 && xb_lane() == 0u) { const unsigned long long now_ = __builtin_amdgcn_s_memrealtime(); if (((TMASK >> 12) & 1u) && ((LMASK >> layer) & 1u)) tst_[1] += now_ - tst_[0]; tst_[0] = now_; } }
                if (PM(18)) { PHASE_BEGIN; ScanP sp; fill_scanp(sp, a, ws, li, even); ph_mlstm_out(sp, lds, tid, lane, wave, bid, G); }
            }
        }
        SEAM(pb + 5);
        PH_BEGIN(6, pb + 6) PHASE_BEGIN; pg8::Gemm g{(const bf16*)(ws + WS_MIX), (const bf16*)(ws + wb_off + W_OUT), MR, DM, DM}; pg8::ResidOrder S; S.init(G, bid, layer < NLAYERS - 1 ? 8 : 0, 256);
            pg8::EpiResid2 E{(float*)(ws + WS_XS), (const float*)(ws + mod_off) + 2 * DM, nullptr, (float*)(ws + WS_DST), 0, 256, rep_,
                (bf16*)(ws + WS_H), a.in[7] + (size_t)layer * DM, (const float*)(ws + mod_off) + 4 * DM, (float*)(ws + WS_SSQ) + (size_t)(2 * layer + 1) * MR};
            pg8::gemm_phase<pg8::EpiResid2, pg8::ResidOrder, true, true>(lds, g, S, E, wave); }
        SEAM(pb + 6);
        PH_BEGIN(7, pb + 7) PHASE_BEGIN; const float* mod = (const float*)(ws + mod_off);
            if (layer < NLAYERS - 1) ph_ctxfix<8>((float*)(ws + WS_XS), (const float*)(ws + WS_DST), mod + 2 * 12288 + 2 * DM, a.in[7] + (size_t)layer * DM, mod + 4 * DM, (bf16*)(ws + WS_H), (float*)(ws + WS_SSQ) + (size_t)(2 * layer + 1) * MR, gw, NGW, lane); }
        if (layer < NLAYERS - 1) SEAM(pb + 7);
        PH_BEGIN(8, pb + 8) PHASE_BEGIN; pg8::Gemm g{(const bf16*)(ws + WS_H), (const bf16*)(ws + wb_off + W_UP), MR, NUP, DM}; pg8::StaticOrder S; S.init(MR, NUP, G, bid);
            pg8::EpiAct E{(bf16*)(ws + WS_ACT), a.in[24] + (size_t)layer * 3 * DFF, a.in[25] + (size_t)layer * DFF, (float*)(ws + WS_U), (LAS float*)(lds + 131584), (const float*)(ws + WS_SSQ) + (size_t)(2 * layer + 1) * MR, (const float*)(ws + WS_B2) + (size_t)layer * 3 * NUP, 0};
            pg8::gemm_phase<pg8::EpiAct, pg8::StaticOrder, true, true>(lds, g, S, E, wave); }
        SEAM(pb + 8);
        PH_BEGIN(10, pb + 10)
            { PHASE_BEGIN; pg8::ResidOrder S0; S0.init(G, bid, layer < NLAYERS - 1 ? 11 : 0, 512); pg8::Unit uu_;
#pragma unroll 1
              for (int i_ = 0; S0.next(i_, uu_); ++i_) act_fix_tile((const float*)(ws + WS_U), a.in[24] + (size_t)layer * 3 * DFF, (bf16*)(ws + WS_ACT), uu_.pm, tid);
              asm volatile("s_waitcnt vmcnt(0)" ::: "memory"); __syncthreads(); }
            PHASE_BEGIN; pg8::Gemm g{(const bf16*)(ws + WS_ACT), (const bf16*)(ws + wb_off + W_DN), MR, DM, DFF}; pg8::ResidOrder S; S.init(G, bid, layer < NLAYERS - 1 ? 11 : 0, 512);
            pg8::EpiResid2 E{(float*)(ws + WS_XS), (const float*)(ws + mod_off) + 5 * DM, a.out, (float*)(ws + WS_DST), layer == NLAYERS - 1 ? 1 : 0, 512, rep_,
                layer < NLAYERS - 1 ? (bf16*)(ws + WS_H) : nullptr, a.in[6] + (size_t)(layer + 1) * DM, (const float*)(ws + mod_off) + 3 * 12288 + 1 * DM, (float*)(ws + WS_SSQ) + (size_t)(2 * layer + 2) * MR};
            pg8::gemm_phase<pg8::EpiResid2, pg8::ResidOrder, true, true>(lds, g, S, E, wave); }
        if (layer < NLAYERS - 1) SEAM(pb + 10); else if (TMASK && wave0 == 0 && xb_lane() == 0u) { const unsigned long long now_ = __builtin_amdgcn_s_memrealtime(); if (((TMASK >> 10) & 1u) && ((LMASK >> layer) & 1u)) tst_[1] += now_ - tst_[0]; tst_[0] = now_; }
    }
    if (TMASK) { __syncthreads(); const unsigned long long tacc_ = tst_[1], t0_ = __builtin_amdgcn_s_memrealtime(); while (__builtin_amdgcn_s_memrealtime() - t0_ < tacc_) __builtin_amdgcn_s_sleep(8); }
#undef IN
#undef SEAM
}

extern "C" void kernel_launch(void* const* d_in, const int* in_sizes, int n_in, void* d_out, int out_size, void* d_ws, size_t ws_size, hipStream_t stream) {
    static int grid = 0;
    if (grid == 0) {
        int dev = 0, cus = 0;
        if (n_in != 27 || out_size != NLATR * DM || ws_size < WS_END) { fprintf(stderr, "kernel_launch: unexpected problem (n_in %d out %d ws %zu)\n", n_in, out_size, ws_size); grid = -1; return; }
        if (hipGetDevice(&dev) != hipSuccess || hipDeviceGetAttribute(&cus, hipDeviceAttributeMultiprocessorCount, dev) != hipSuccess) { grid = -1; return; }
        if (hipFuncSetAttribute((const void*)fwd_kernel, hipFuncAttributeMaxDynamicSharedMemorySize, LDS_BYTES) != hipSuccess) { fprintf(stderr, "kernel_launch: hipFuncSetAttribute failed\n"); grid = -1; return; }
        int per_cu = 0;
        if (hipOccupancyMaxActiveBlocksPerMultiprocessor(&per_cu, (const void*)fwd_kernel, NTHR, LDS_BYTES) != hipSuccess || per_cu < 1) fprintf(stderr, "kernel_launch: occupancy query reports %d\n", per_cu);
        (void)hipGetLastError();
        grid = cus;
    }
    if (grid < 0) return;
    (void)hipMemsetAsync((char*)d_ws + WS_CTL, 0, CTL_BYTES, stream);
    Args a{};
    for (int i = 0; i < 27; ++i) a.in[i] = (const float*)d_in[i];
    a.out = (float*)d_out; a.ws = (unsigned char*)d_ws; a.pad = 0;
#if ONE_LAUNCH
    a.ph_lo = 0; a.ph_hi = 1 + NLAYERS * PPL; a.li = 0;
    hipLaunchKernelGGL(fwd_kernel, dim3(grid), dim3(NTHR), LDS_BYTES, stream, a);
#else
    for (int p = 0; p < 1 + NLAYERS * PPL; ++p) {
        const int k = p == 0 ? 0 : (p - 1) % PPL, layer = p == 0 ? 0 : (p - 1) / PPL;
        if (p > 0 && k == 3 && (layer & 1) == 0) continue;
        a.ph_lo = p; a.ph_hi = p + 1; a.li = p;
        hipLaunchKernelGGL(fwd_kernel, dim3(grid), dim3(NTHR), LDS_BYTES, stream, a);
    }
#endif
}
```

```cpp
#include <hip/hip_runtime.h>
#include <cstdio>
#include <cstdint>
namespace pg8 {
#define PG8_LAS __attribute__((address_space(3)))
typedef unsigned short bf16_t;
typedef short bf16x8 __attribute__((ext_vector_type(8)));
typedef float f32x4 __attribute__((ext_vector_type(4)));
typedef unsigned u32x4 __attribute__((ext_vector_type(4)));
constexpr int BM = 256, BK = 64, HALF = 128, HTB = HALF * BK * 2  , STAGE_BYTES = 8 * HTB, NXCD = 8, WGM = 8;

__host__ __device__ __forceinline__ int lds_byte(int r, int c) { const int st = (r >> 4) * 2 + (c >> 5), rr = r & 15, cc = c & 31, ob = rr * 64 + cc * 2; return st * 1024 + (ob ^ (((ob >> 9) & 1) << 5)); }
__host__ __device__ __forceinline__ void stage_rc(int b, int& R, int& C) { const int st = b / 1024, sb = b % 1024, swz = sb ^ (((sb >> 9) & 1) << 5); R = (st >> 1) * 16 + swz / 64; C = (st & 1) * 32 + (swz % 64) / 2; }
__host__ __device__ __forceinline__ int perm32(int rho) { const int n = rho >> 4, i = rho & 15; return 8 * (i >> 2) + 4 * n + (i & 3); }

struct Unit { int pm, pn, k0, nt; };
struct Gemm { const bf16_t* A; const bf16_t* Bt; int M, N, K; };

struct StaticOrder {
    int nM, nN, nwg, G, c;
    __host__ __device__ __forceinline__ void init(int M, int N, int G_, int c_) { nM = M / BM; nN = N / BM; nwg = nM * nN; G = G_; c = c_; }
    __host__ __device__ __forceinline__ bool next(int i, Unit& u) const {
        const long L = (long)i * G + c; if (L >= nwg) return false;
        int wgid = (int)L; { const int q = nwg / NXCD, r = nwg % NXCD, xcd = wgid % NXCD, off = wgid / NXCD; wgid = (xcd < r ? xcd * (q + 1) : r * (q + 1) + (xcd - r) * q) + off; }
        const int nig = WGM * nN, gid = wgid / nig, fm = gid * WGM, gsz = (nM - fm) < WGM ? (nM - fm) : WGM;
        u.pm = fm + ((wgid % nig) % gsz); u.pn = (wgid % nig) / gsz; u.k0 = 0; u.nt = 0; return true;
    }
    __device__ __forceinline__ void a_ready(const Unit&) const {}
    __device__ __forceinline__ void done(const Unit&) const {}
};
__device__ __forceinline__ unsigned cvt_pk_bf16(float lo, float hi) { unsigned r; asm volatile("v_cvt_pk_bf16_f32 %0, %1, %2" : "=v"(r) : "v"(lo), "v"(hi)); return r; }

struct EpiStore {
    static constexpr bool PERM = true, AFTER_DRAIN = false;
    bf16_t* O; int ldc; const float* ssq; const float* bias; int ldb;
    __device__ __forceinline__ void operator()(const f32x4 (&acc)[2][2][4][2], const Unit& u, int wr, int wc, int fr, int fq) const {
        const int row0 = u.pm * BM + wr * 64 + fr, col0 = u.pn * BM + wc * 32 + 8 * fq, mi = u.pm < 32 ? (u.pm >> 4) : 2;
        f32x4 bv[2][2];
#pragma unroll
        for (int bj = 0; bj < 2; ++bj)
#pragma unroll
            for (int n = 0; n < 2; ++n) bv[bj][n] = *(const f32x4*)(bias + (size_t)mi * ldb + col0 + bj * HALF + 4 * n);
#pragma unroll
        for (int ai = 0; ai < 2; ++ai)
#pragma unroll
            for (int m = 0; m < 4; ++m) { const int row = row0 + ai * HALF + m * 16; bf16_t* rowp = O + (size_t)row * ldc + col0;
                const float r = __builtin_amdgcn_rsqf(ssq[row] * (1.f / 2048.f) + 1e-6f);
#pragma unroll
                for (int bj = 0; bj < 2; ++bj) { const f32x4 v0 = acc[ai][bj][m][0] * r + bv[bj][0], v1 = acc[ai][bj][m][1] * r + bv[bj][1];
                    u32x4 w; w.x = cvt_pk_bf16(v0[0], v0[1]); w.y = cvt_pk_bf16(v0[2], v0[3]); w.z = cvt_pk_bf16(v1[0], v1[1]); w.w = cvt_pk_bf16(v1[2], v1[3]);
                    *(u32x4*)(rowp + bj * HALF) = w; } }
    }
};
struct ResidOrder {
    StaticOrder L; int G, c, nsub, ksub;
    __device__ __forceinline__ void init(int G_, int c_, int nsplit, int ksub_) { L.init(8192, 2048, G_, c_); G = G_; c = c_; nsub = 16 * nsplit; ksub = ksub_; }
    __device__ __forceinline__ bool next(int i, Unit& u) const {
        const int nl = c < 256 ? (255 - c) / G + 1 : 0;
        if (i < nl) return L.next(i, u);
        const int s = (i - nl) * G + c; if (s >= nsub) return false;
        const int tile = s & 15, j = s >> 4; u.pm = 32 + (tile >> 3); u.pn = tile & 7; u.k0 = j * ksub; u.nt = ksub / BK; return true;
    }
    __device__ __forceinline__ void a_ready(const Unit&) const {}
    __device__ __forceinline__ void done(const Unit&) const {}
};
struct EpiResid2 {
    static constexpr bool PERM = true, AFTER_DRAIN = false;
    float* X; const float* gate; float* out; float* part; int final_; int ksub; int dry;
    bf16_t* Hn; const float* ngn; const float* scn; float* ssqn;
    __device__ __forceinline__ void operator()(const f32x4 (&acc)[2][2][4][2], const Unit& u, int wr, int wc, int fr, int fq) const {
        const int row0 = u.pm * BM + wr * 64 + fr, col0 = u.pn * BM + wc * 32 + 8 * fq;
        if (u.pm >= 32) {
            float* pb = part + ((size_t)(u.k0 / ksub) * 512 + (row0 - 8192)) * 2048 + col0;
#pragma unroll
            for (int ai = 0; ai < 2; ++ai)
#pragma unroll
                for (int m = 0; m < 4; ++m)
#pragma unroll
                    for (int bj = 0; bj < 2; ++bj)
#pragma unroll
                        for (int n = 0; n < 2; ++n) *(f32x4*)(pb + (size_t)(ai * HALF + m * 16) * 2048 + bj * HALF + 4 * n) = acc[ai][bj][m][n];
            return;
        }
        const int mi = u.pm >> 4;
        f32x4 gv[2][2], av[2][2];
#pragma unroll
        for (int bj = 0; bj < 2; ++bj)
#pragma unroll
            for (int n = 0; n < 2; ++n) { const int c = col0 + bj * HALF + 4 * n; gv[bj][n] = *(const f32x4*)(gate + (size_t)mi * 12288 + c);
                av[bj][n] = Hn ? *(const f32x4*)(ngn + c) * (*(const f32x4*)(scn + (size_t)mi * 12288 + c) + 1.f) : (f32x4){0.f, 0.f, 0.f, 0.f}; }
        if (dry && gv[0][0][0] != 1.2345e30f) return;
#pragma unroll
        for (int ai = 0; ai < 2; ++ai)
#pragma unroll
            for (int m = 0; m < 4; ++m) { const int row = row0 + ai * HALF + m * 16; const size_t ro = (size_t)row * 2048 + col0; const float* xr = X + ro; float* orow = (final_ ? out : X) + ro; float ss = 0.f;
#pragma unroll
                for (int bj = 0; bj < 2; ++bj) {
                    const f32x4 x0 = *(const f32x4*)(xr + bj * HALF) + gv[bj][0] * acc[ai][bj][m][0], x1 = *(const f32x4*)(xr + bj * HALF + 4) + gv[bj][1] * acc[ai][bj][m][1];
                    *(f32x4*)(orow + bj * HALF) = x0; *(f32x4*)(orow + bj * HALF + 4) = x1;
                    if (Hn) { ss += (x0[0] * x0[0] + x0[1] * x0[1]) + (x0[2] * x0[2] + x0[3] * x0[3]) + (x1[0] * x1[0] + x1[1] * x1[1]) + (x1[2] * x1[2] + x1[3] * x1[3]);
                        const f32x4 h0 = x0 * av[bj][0], h1 = x1 * av[bj][1];
                        u32x4 w; w.x = cvt_pk_bf16(h0[0], h0[1]); w.y = cvt_pk_bf16(h0[2], h0[3]); w.z = cvt_pk_bf16(h1[0], h1[1]); w.w = cvt_pk_bf16(h1[2], h1[3]);
                        *(u32x4*)(Hn + ro + bj * HALF) = w; } }
                if (Hn) { ss += __shfl_xor(ss, 16); ss += __shfl_xor(ss, 32); if (fq == 0) (void)__hip_atomic_fetch_add(ssqn + row, ss, __ATOMIC_RELAXED, __HIP_MEMORY_SCOPE_AGENT); } }
    }
};
struct EpiAct {
    static constexpr bool PERM = true, AFTER_DRAIN = false;
    bf16_t* ACT; const float* cw; const float* cb; float* halo; PG8_LAS float* exb; const float* ssq; const float* bias; mutable int par;
    __device__ __forceinline__ void operator()(const f32x4 (&acc)[2][2][4][2], const Unit& u, int wr, int wc, int fr, int fq) const {
        const int lane = fq * 16 + fr, ch0 = wc * 32 + 8 * fq, chg = u.pn * 128 + ch0;
        PG8_LAS float* xb = exb + par * 1024; par ^= 1;
        const int mi = u.pm < 32 ? (u.pm >> 4) : 2;
        const float* bp = bias + (size_t)mi * 11264 + u.pn * BM + ch0;
        float rr[2][4];
#pragma unroll
        for (int ai = 0; ai < 2; ++ai)
#pragma unroll
            for (int m = 0; m < 4; ++m) rr[ai][m] = __builtin_amdgcn_rsqf(ssq[u.pm * BM + ai * HALF + wr * 64 + m * 16 + fr] * (1.f / 2048.f) + 1e-6f);
#pragma unroll
        for (int ai = 0; ai < 2; ++ai) { const int q = ai * 2 + wr;
#pragma unroll
            for (int n = 0; n < 2; ++n) { const f32x4 bg4 = *(const f32x4*)(bp + 4 * n);
                if (fr == 0) *(PG8_LAS f32x4*)(xb + q * 128 + ch0 + 4 * n) = acc[ai][0][0][n] * rr[ai][0] + bg4;
                if (fr == 15) *(PG8_LAS f32x4*)(xb + (4 + q) * 128 + ch0 + 4 * n) = acc[ai][0][3][n] * rr[ai][3] + bg4; } }
        asm volatile("s_waitcnt lgkmcnt(0)" ::: "memory"); __builtin_amdgcn_s_barrier(); asm volatile("" ::: "memory");
        float* hb = halo + (size_t)(u.pm * 44 + u.pn) * 768 + ch0;
#pragma unroll
        for (int n = 0; n < 2; ++n) {
            const f32x4 w0 = *(const f32x4*)(cw + chg + 4 * n), w1 = *(const f32x4*)(cw + 5632 + chg + 4 * n), w2 = *(const f32x4*)(cw + 2 * 5632 + chg + 4 * n), bb = *(const f32x4*)(cb + chg + 4 * n);
            const f32x4 bg = *(const f32x4*)(bp + 4 * n), bvv = *(const f32x4*)(bp + 128 + 4 * n);
#pragma unroll
            for (int ai = 0; ai < 2; ++ai) { const int q = ai * 2 + wr;
                const f32x4 pB = q > 0 ? *(PG8_LAS const f32x4*)(xb + (4 + q - 1) * 128 + ch0 + 4 * n) : (f32x4){0.f, 0.f, 0.f, 0.f};
                const f32x4 nB = q < 3 ? *(PG8_LAS const f32x4*)(xb + (q + 1) * 128 + ch0 + 4 * n) : (f32x4){0.f, 0.f, 0.f, 0.f};
#pragma unroll
                for (int m = 0; m < 4; ++m) {
                    const f32x4 x = acc[ai][0][m][n] * rr[ai][m] + bg, vx = acc[ai][1][m][n] * rr[ai][m] + bvv;
                    const f32x4 xm = m > 0 ? acc[ai][0][m > 0 ? m - 1 : 0][n] * rr[ai][m > 0 ? m - 1 : 0] + bg : pB;
                    const f32x4 xq = m < 3 ? acc[ai][0][m < 3 ? m + 1 : 3][n] * rr[ai][m < 3 ? m + 1 : 3] + bg : nB;
                    f32x4 cv, o;
#pragma unroll
                    for (int el = 0; el < 4; ++el) { const float sp = fr == 15 ? xm[el] : x[el], sn = fr == 0 ? xq[el] : x[el];
                        const float pv = __builtin_bit_cast(float, __builtin_amdgcn_update_dpp(0, __builtin_bit_cast(int, sp), 0x121, 0xF, 0xF, false)), nv = __builtin_bit_cast(float, __builtin_amdgcn_update_dpp(0, __builtin_bit_cast(int, sn), 0x12F, 0xF, 0xF, false));
                        cv[el] = w0[el] * pv + w1[el] * x[el] + w2[el] * nv + bb[el];
                        o[el] = cv[el] / (1.f + __expf(-cv[el])) * vx[el]; }
                    const bool top = (q == 0 && m == 0 && fr == 0), bot = (q == 3 && m == 3 && fr == 15);
                    if (top || bot) { const int sl = top ? 0 : 1; *(f32x4*)(hb + sl * 128 + 4 * n) = x; *(f32x4*)(hb + (2 + sl) * 128 + 4 * n) = cv; *(f32x4*)(hb + (4 + sl) * 128 + 4 * n) = vx; }
                    else { typedef unsigned u32x2_ __attribute__((ext_vector_type(2))); u32x2_ w; w.x = cvt_pk_bf16(o[0], o[1]); w.y = cvt_pk_bf16(o[2], o[3]);
                        *(u32x2_*)(ACT + (size_t)(u.pm * BM + q * 64 + m * 16 + fr) * 5632 + chg + 4 * n) = w; }
                }
            }
        }
    }
};
template <class Epi, class Sched, bool ALIGN_EPI = false, bool SP2 = false>
__device__ __forceinline__ void gemm_phase(PG8_LAS unsigned char* lds, const Gemm g, const Sched& S, const Epi& E, int wid_in) {
    int wid = wid_in, zz_ = 0; asm volatile("" : "+s"(wid), "+s"(zz_));
    const int lane = (int)__builtin_amdgcn_mbcnt_hi(~0u, __builtin_amdgcn_mbcnt_lo(~0u, (unsigned)zz_)), tid = wid * 64 + lane, wr = wid >> 2, wc = wid & 3, fr = lane & 15, fq = lane >> 4;
    const int K = g.K, nt = K / BK;
    unsigned voffA[2], voffB[2];
#pragma unroll
    for (int i = 0; i < 2; ++i) { int R, C; stage_rc(tid * 16 + i * 8192, R, C); const int Rb = Epi::PERM ? ((R & ~31) + perm32(R & 31)) : R;
        voffA[i] = (unsigned)(R * K + C) * 2u; voffB[i] = (unsigned)(Rb * K + C) * 2u; }
    const size_t kstep = (size_t)(BK * 2);
    const size_t hstep = (size_t)HALF * K * 2;
    const size_t tstep = 2 * hstep;
    const unsigned ldsw = (unsigned)wid * 1024u;
    const int aoff = lds_byte(wr * 64 + fr, fq * 8), boff = lds_byte(wc * 32 + fr, fq * 8);
#define PG8_SA(b, h) (((b) * 2 + (h)) * HTB)
#define PG8_SB(b, h) ((4 + (b) * 2 + (h)) * HTB)
#define PG8_STAGE(bufoff, gbase, voff) do { _Pragma("unroll") for (int _i = 0; _i < 2; ++_i) \
        __builtin_amdgcn_global_load_lds((const unsigned*)((const char*)(gbase) + (voff)[_i]), (PG8_LAS unsigned*)(lds + (bufoff) + ldsw + _i * 8192), 16, 0, 0); } while (0)
#define PG8_LDA(dst, b, h) do { _Pragma("unroll") for (int m = 0; m < 4; ++m) _Pragma("unroll") for (int k = 0; k < 2; ++k) dst[m][k] = *(const PG8_LAS bf16x8*)(lds + PG8_SA(b, h) + aoff + m * 2048 + k * 1024); } while (0)
#define PG8_LDB(dst, b, h) do { _Pragma("unroll") for (int n = 0; n < 2; ++n) _Pragma("unroll") for (int k = 0; k < 2; ++k) dst[n][k] = *(const PG8_LAS bf16x8*)(lds + PG8_SB(b, h) + boff + n * 2048 + k * 1024); } while (0)
#define PG8_MMA(ai, bj, At, Bt) do { __builtin_amdgcn_s_setprio(1); _Pragma("unroll") for (int m = 0; m < 4; ++m) _Pragma("unroll") for (int n = 0; n < 2; ++n) _Pragma("unroll") for (int k = 0; k < 2; ++k) \
        acc[ai][bj][m][n] = __builtin_amdgcn_mfma_f32_16x16x32_bf16(Bt[n][k], At[m][k], acc[ai][bj][m][n], 0, 0, 0); __builtin_amdgcn_s_setprio(0); } while (0)
#define PG8_WAIT_V(n) asm volatile("s_waitcnt vmcnt(" #n ")" ::: "memory")
#define PG8_WAIT_L(n) asm volatile("s_waitcnt lgkmcnt(" #n ")" ::: "memory")
#define PG8_BAR __builtin_amdgcn_s_barrier()
#define PG8_SCHED __builtin_amdgcn_sched_barrier(0)
    Unit cur, nxt; int ui = 0;
    if (!S.next(0, cur)) return;
    f32x4 acc[2][2][4][2];
#pragma unroll
    for (int a = 0; a < 2; ++a)
#pragma unroll
        for (int b = 0; b < 2; ++b)
#pragma unroll
            for (int m = 0; m < 4; ++m)
#pragma unroll
                for (int n = 0; n < 2; ++n) acc[a][b][m][n] = (f32x4){0.f, 0.f, 0.f, 0.f};
    bf16x8 At[4][2], B0[2][2], B1[2][2];
    const char* cA = (const char*)g.A + (size_t)cur.pm * tstep + (size_t)cur.k0 * 2; const char* cB = (const char*)g.Bt + (size_t)cur.pn * tstep + (size_t)cur.k0 * 2;
    S.a_ready(cur);
    if constexpr (SP2) {
        PG8_STAGE(PG8_SB(0, 0), cB, voffB); PG8_STAGE(PG8_SB(0, 1), cB + hstep, voffB); PG8_STAGE(PG8_SA(0, 0), cA, voffA); PG8_STAGE(PG8_SA(0, 1), cA + hstep, voffA);
        if (wr == 1) PG8_BAR;
        PG8_WAIT_V(2); PG8_BAR;
        PG8_STAGE(PG8_SB(1, 0), cB + kstep, voffB); PG8_STAGE(PG8_SA(1, 0), cA + kstep, voffA); PG8_STAGE(PG8_SB(1, 1), cB + hstep + kstep, voffB);
        PG8_WAIT_V(6); PG8_BAR;
    } else {
        PG8_STAGE(PG8_SB(0, 0), cB, voffB); PG8_STAGE(PG8_SA(0, 0), cA, voffA); PG8_STAGE(PG8_SB(0, 1), cB + hstep, voffB); PG8_STAGE(PG8_SA(0, 1), cA + hstep, voffA);
        if (wr == 1) PG8_BAR;
        PG8_WAIT_V(4); PG8_BAR;
        PG8_STAGE(PG8_SB(1, 0), cB + kstep, voffB); PG8_STAGE(PG8_SA(1, 0), cA + kstep, voffA); PG8_STAGE(PG8_SB(1, 1), cB + hstep + kstep, voffB);
        PG8_WAIT_V(6); PG8_BAR;
    }
    for (;;) {
        const bool has_next = S.next(ui + 1, nxt);
        const char* nA = has_next ? (const char*)g.A + (size_t)nxt.pm * tstep + (size_t)nxt.k0 * 2 : cA; const char* nB = has_next ? (const char*)g.Bt + (size_t)nxt.pn * tstep + (size_t)nxt.k0 * 2 : cB;
        const int unt = cur.nt ? cur.nt : nt;
        for (int t = 0; t < unt; t += 2) {
            const bool last = (t == unt - 2);
            const char* a1 = cA + (size_t)(t + 1) * kstep;
            const char* a2 = last ? nA : cA + (size_t)(t + 2) * kstep; const char* b2 = last ? nB : cB + (size_t)(t + 2) * kstep;
            const char* a3 = a2 + kstep; const char* b3 = b2 + kstep;
            if (last && has_next) S.a_ready(nxt);
            if constexpr (SP2) {
            PG8_LDB(B0, 0, 0); PG8_LDB(B1, 0, 1); PG8_SCHED; PG8_LDA(At, 0, 0); PG8_STAGE(PG8_SA(1, 1), a1 + hstep, voffA);
            PG8_WAIT_V(8); PG8_WAIT_L(0); PG8_BAR; PG8_MMA(0, 0, At, B0); PG8_MMA(0, 1, At, B1); PG8_BAR; PG8_SCHED;
            PG8_LDA(At, 0, 1); PG8_STAGE(PG8_SB(0, 0), b2, voffB); PG8_STAGE(PG8_SB(0, 1), b2 + hstep, voffB); PG8_STAGE(PG8_SA(0, 0), a2, voffA);
            PG8_WAIT_V(8); PG8_WAIT_L(0); PG8_BAR; PG8_MMA(1, 0, At, B0); PG8_MMA(1, 1, At, B1); PG8_BAR; PG8_SCHED;
            PG8_LDB(B0, 1, 0); PG8_LDB(B1, 1, 1); PG8_SCHED; PG8_LDA(At, 1, 0); PG8_STAGE(PG8_SA(0, 1), a2 + hstep, voffA);
            PG8_WAIT_V(8); PG8_WAIT_L(0); PG8_BAR; PG8_MMA(0, 0, At, B0); PG8_MMA(0, 1, At, B1); PG8_BAR; PG8_SCHED;
            PG8_LDA(At, 1, 1); PG8_STAGE(PG8_SB(1, 0), b3, voffB); PG8_STAGE(PG8_SB(1, 1), b3 + hstep, voffB); PG8_STAGE(PG8_SA(1, 0), a3, voffA);
            PG8_WAIT_V(8); PG8_WAIT_L(0); PG8_BAR; PG8_MMA(1, 0, At, B0); PG8_MMA(1, 1, At, B1); PG8_BAR; PG8_SCHED;
            } else {
            PG8_LDB(B0, 0, 0); PG8_SCHED; PG8_LDA(At, 0, 0); PG8_STAGE(PG8_SA(1, 1), a1 + hstep, voffA);
            PG8_WAIT_L(8); PG8_BAR; PG8_WAIT_L(0); PG8_MMA(0, 0, At, B0); PG8_BAR; PG8_SCHED;
            PG8_LDB(B1, 0, 1); PG8_STAGE(PG8_SB(0, 0), b2, voffB);
            PG8_BAR; PG8_WAIT_L(0); PG8_MMA(0, 1, At, B1); PG8_BAR;
            PG8_LDA(At, 0, 1); PG8_STAGE(PG8_SA(0, 0), a2, voffA);
            PG8_BAR; PG8_WAIT_L(0); PG8_MMA(1, 0, At, B0); PG8_BAR; PG8_SCHED;
            PG8_STAGE(PG8_SB(0, 1), b2 + hstep, voffB);
            PG8_WAIT_V(6); PG8_BAR; PG8_MMA(1, 1, At, B1); PG8_BAR;
            PG8_LDB(B0, 1, 0); PG8_SCHED; PG8_LDA(At, 1, 0); PG8_STAGE(PG8_SA(0, 1), a2 + hstep, voffA);
            PG8_WAIT_L(8); PG8_BAR; PG8_WAIT_L(0); PG8_MMA(0, 0, At, B0); PG8_BAR; PG8_SCHED;
            PG8_LDB(B1, 1, 1); PG8_STAGE(PG8_SB(1, 0), b3, voffB);
            PG8_BAR; PG8_WAIT_L(0); PG8_MMA(0, 1, At, B1); PG8_BAR;
            PG8_LDA(At, 1, 1); PG8_STAGE(PG8_SA(1, 0), a3, voffA);
            PG8_BAR; PG8_WAIT_L(0); PG8_MMA(1, 0, At, B0); PG8_BAR; PG8_SCHED;
            PG8_STAGE(PG8_SB(1, 1), b3 + hstep, voffB);
            PG8_WAIT_V(6); PG8_BAR; PG8_MMA(1, 1, At, B1); PG8_BAR;
            }
        }
        if constexpr (ALIGN_EPI) { if (wr == 0) PG8_BAR; }
        if constexpr (!Epi::AFTER_DRAIN) { E(acc, cur, wr, wc, fr, fq); S.done(cur); }
        if (!has_next) break;
#pragma unroll
        for (int a = 0; a < 2; ++a)
#pragma unroll
            for (int b = 0; b < 2; ++b)
#pragma unroll
                for (int m = 0; m < 4; ++m)
#pragma unroll
                    for (int n = 0; n < 2; ++n) acc[a][b][m][n] = (f32x4){0.f, 0.f, 0.f, 0.f};
        cur = nxt; cA = nA; cB = nB; ++ui;
        if constexpr (ALIGN_EPI) { if (wr == 1) PG8_BAR; }
    }
    PG8_WAIT_V(0);
    if constexpr (!ALIGN_EPI) { if (wr == 0) PG8_BAR; }
    PG8_BAR;
    if constexpr (Epi::AFTER_DRAIN) { E.fused(acc, cur, wr, wc, fr, fq, lds, wid, lane); S.done(cur); }
#undef PG8_SA
#undef PG8_SB
#undef PG8_STAGE
#undef PG8_LDA
#undef PG8_LDB
#undef PG8_MMA
#undef PG8_WAIT_V
#undef PG8_WAIT_L
#undef PG8_BAR
#undef PG8_SCHED
}
}
#define GAS __attribute__((address_space(1)))
#define LAS __attribute__((address_space(3)))
typedef unsigned short bf16;
typedef unsigned v4u __attribute__((ext_vector_type(4)));
typedef unsigned v2u __attribute__((ext_vector_type(2)));
typedef float f32x4 __attribute__((ext_vector_type(4)));
typedef float f32x16 __attribute__((ext_vector_type(16)));
typedef short bf16x8 __attribute__((ext_vector_type(8)));
typedef short s16x4 __attribute__((ext_vector_type(4)));
typedef GAS unsigned gu32;
#define RLX_AGENT __ATOMIC_RELAXED, __HIP_MEMORY_SCOPE_AGENT
#define XB_TMO      128
#define XB_XCNT(j)  (256  + 64 * (j))
#define XB_XSUB(j)  (1280 + 64 * (j))
#define XB_XGEN(j)  (2304 + 64 * (j))
#define XB_TOP      3328
#define XB_TOPGEN   3392
#define XCD_BAR_WORDS 3456
#define XB_SPIN_CAP (1u << 18)

__device__ __forceinline__ unsigned xb_ld(unsigned* p)              { return __hip_atomic_load(p, __ATOMIC_RELAXED, __HIP_MEMORY_SCOPE_AGENT); }
__device__ __forceinline__ unsigned xb_add(unsigned* p, unsigned v) { return __hip_atomic_fetch_add(p, v, __ATOMIC_RELAXED, __HIP_MEMORY_SCOPE_AGENT); }
__device__ __forceinline__ unsigned xb_xcc_id() { return (unsigned)__builtin_amdgcn_s_getreg((3 << 11) | 20) & 0xFu; }
#define XB_SPIN(cond, bar) do { unsigned _sp = 0; while (cond) { __builtin_amdgcn_s_sleep(1); \
    if ((++_sp & 255u) == 0u) { if (xb_ld(&(bar)[XB_TMO])) break; if (_sp > XB_SPIN_CAP) { atomicAdd(&(bar)[XB_TMO], 1u); break; } } } } while (0)

struct XcdBarrier {
    unsigned* bar; unsigned x;
    volatile LAS unsigned* st;
    unsigned wv;
};

__device__ __forceinline__ unsigned xb_lane() { return __builtin_amdgcn_mbcnt_hi(~0u, __builtin_amdgcn_mbcnt_lo(~0u, 0u)); }
__device__ __forceinline__ XcdBarrier xcd_barrier_post(unsigned* bar, volatile LAS unsigned* st, unsigned wv) {
    XcdBarrier b; b.bar = bar; b.x = xb_xcc_id(); b.st = st; b.wv = wv;
    if (wv == 0u && xb_lane() == 0u) (void)xb_add(&bar[XB_XCNT(b.x)], 1u);
    return b;
}
__device__ __forceinline__ void xcd_barrier_complete(unsigned* bar, unsigned x, unsigned& nloc, unsigned& nx) {
    const unsigned G = gridDim.x * gridDim.y * gridDim.z;
    unsigned sum, cnt, mine, sp = 0u;
    for (;;) {
        sum = 0u; cnt = 0u; mine = 0u;
#pragma unroll
        for (unsigned j = 0; j < 16; ++j) { const unsigned c = xb_ld(&bar[XB_XCNT(j)]); sum += c; cnt += (c > 0u) ? 1u : 0u; mine = (j == x) ? c : mine; }
        if (sum == G) break;
        __builtin_amdgcn_s_sleep(1);
        if ((++sp & 255u) == 0u) { if (xb_ld(&bar[XB_TMO])) break; if (sp > XB_SPIN_CAP) { atomicAdd(&bar[XB_TMO], 1u); break; } }
    }
    nloc = mine > 0u ? mine : 1u; nx = cnt > 0u ? cnt : 1u;
}

__device__ __forceinline__ void xcd_barrier(const XcdBarrier& b) {
    asm volatile("s_waitcnt vmcnt(0)" ::: "memory");
    __syncthreads();
    if (b.wv == 0u && xb_lane() == 0u) {
        unsigned* bar = b.bar;
        __builtin_amdgcn_s_waitcnt(0);
        unsigned nloc = b.st[0], nx = b.st[1];
        if (nloc == 0u) { xcd_barrier_complete(bar, b.x, nloc, nx); b.st[0] = nloc; b.st[1] = nx; }
        const unsigned old = xb_add(&bar[XB_XSUB(b.x)], 1u);
        const unsigned gen = old / nloc;
        if (old + 1u == (gen + 1u) * nloc) {
            __builtin_amdgcn_fence(__ATOMIC_RELEASE, "agent");
            asm volatile("s_waitcnt vmcnt(0)" ::: "memory");
            const unsigned og = xb_add(&bar[XB_TOP], 1u);
            const unsigned tg = og / nx;
            if (og + 1u == (tg + 1u) * nx) xb_add(&bar[XB_TOPGEN], 1u);
            else XB_SPIN(xb_ld(&bar[XB_TOPGEN]) == tg, bar);
            __builtin_amdgcn_fence(__ATOMIC_ACQUIRE, "agent");
            xb_add(&bar[XB_XGEN(b.x)], 1u);
            asm volatile("s_waitcnt vmcnt(0)" ::: "memory");
        } else {
            XB_SPIN(xb_ld(&bar[XB_XGEN(b.x)]) == gen, bar);
            __builtin_amdgcn_fence(__ATOMIC_ACQUIRE, "agent");
            asm volatile("s_waitcnt vmcnt(0)" ::: "memory");
        }
    }
    __syncthreads();
}
#ifndef ONE_LAUNCH
#define ONE_LAUNCH 1
#endif
#ifndef NLAYERS
#define NLAYERS 4
#endif
constexpr int DM = 2048, MR = 8704, NLATR = 8192;
constexpr int NINP = 6400, DFF = 5632, NUP = 11264, EVIN = 6176, ODIN = 6160;
constexpr int NWAVES = 8, NTHR = 512;
constexpr float EPS = 1e-6f;
constexpr int NCHUNK = 68;
constexpr int PPL = 11, NPH = 1 + 4 * PPL;
constexpr size_t MiB = 1ull << 20;
constexpr size_t WS_CTL = 0, CTL_BYTES = 1 * MiB;
constexpr size_t WS_MOD = 1 * MiB, WS_ROPE = 1 * MiB + 640 * 1024;
constexpr size_t WS_W = 4 * MiB, W_LAYER = 99 * MiB, W_OUT = 25 * MiB, W_UP = 33 * MiB, W_DN = 77 * MiB;
constexpr size_t WS_XS = 400 * MiB, WS_H = 468 * MiB, WS_MIX = 502 * MiB, WS_P = 536 * MiB, WS_U = 644 * MiB, WS_ACT = 832 * MiB;
constexpr size_t WS_QR = 926 * MiB, WS_KR = 943 * MiB, WS_MQK = 960 * MiB, WS_DST = 977 * MiB, WS_SST = 1113 * MiB, WS_SM = 1181 * MiB, WS_B1 = 1185 * MiB, WS_B2 = 1186 * MiB, WS_END = 1187 * MiB;
constexpr size_t WS_SSQ = 524288;
constexpr size_t SM_GAM = 0, SM_DN = 1 * MiB, SM_NIN = 2 * MiB, SM_BL = 3 * MiB, SM_ML = 3 * MiB + 8192, SM_MIN = 3 * MiB + 16384;
constexpr int CW_BAR = 4096;
constexpr int LDS_BYTES = 147456, MISC_OFF = 131072 + 320;

struct Args { const float* in[27]; float* out; unsigned char* ws; int ph_lo, ph_hi, li, pad; };

__device__ __forceinline__ float bf_lo(unsigned u) { return __builtin_bit_cast(float, u << 16); }
__device__ __forceinline__ float bf_hi(unsigned u) { return __builtin_bit_cast(float, u & 0xffff0000u); }
__device__ __forceinline__ float bf1(bf16 b) { return __builtin_bit_cast(float, (unsigned)b << 16); }
typedef float f32x2_t __attribute__((ext_vector_type(2))); typedef __bf16 bf16x2_t __attribute__((ext_vector_type(2)));
__device__ __forceinline__ unsigned pk2(float lo, float hi) { f32x2_t v = {lo, hi}; bf16x2_t b = __builtin_convertvector(v, bf16x2_t); return __builtin_bit_cast(unsigned, b); }
__device__ __forceinline__ bf16 f2bf(float f) { return (bf16)(pk2(f, 0.f) & 0xffffu); }
__device__ __forceinline__ void unpack8(const v4u w, float (&f)[8]) { f[0] = bf_lo(w.x); f[1] = bf_hi(w.x); f[2] = bf_lo(w.y); f[3] = bf_hi(w.y); f[4] = bf_lo(w.z); f[5] = bf_hi(w.z); f[6] = bf_lo(w.w); f[7] = bf_hi(w.w); }
__device__ __forceinline__ v4u pack8(const float (&f)[8]) { v4u w; w.x = pk2(f[0], f[1]); w.y = pk2(f[2], f[3]); w.z = pk2(f[4], f[5]); w.w = pk2(f[6], f[7]); return w; }
__device__ __forceinline__ float silu_f(float x) { return x / (1.f + __expf(-x)); }
__device__ __forceinline__ float sigmoid_f(float x) { return 1.f / (1.f + __expf(-x)); }
__device__ __forceinline__ float logsig_f(float z) { return fminf(z, 0.f) - __logf(1.f + __expf(-fabsf(z))); }
__device__ __forceinline__ float wave_sum(float v) {
#pragma unroll
    for (int o = 1; o < 64; o <<= 1) v += __shfl_xor(v, o);
    return v;
}
__device__ __forceinline__ float wave_max(float v) {
#pragma unroll
    for (int o = 1; o < 64; o <<= 1) v = fmaxf(v, __shfl_xor(v, o));
    return v;
}
__device__ __forceinline__ float wave_scan_sum(float v, int dir, int lane) {
#pragma unroll
    for (int o = 1; o < 64; o <<= 1) { const float up = __shfl_up(v, o), dn = __shfl_down(v, o); if (dir == 0) { if (lane >= o) v += up; } else { if (lane + o < 64) v += dn; } }
    return v;
}
__device__ __forceinline__ float wave_scan_max(float v, int dir, int lane) {
#pragma unroll
    for (int o = 1; o < 64; o <<= 1) { const float up = __shfl_up(v, o), dn = __shfl_down(v, o); if (dir == 0) { if (lane >= o) v = fmaxf(v, up); } else { if (lane + o < 64) v = fmaxf(v, dn); } }
    return v;
}
__device__ __forceinline__ bool seq_start(int r) { return r < NLATR ? (r & 4095) == 0 : ((r - NLATR) & 255) == 0; }

__device__ __forceinline__ bf16x8 frag_row(LAS const unsigned char* base, int stride, int row0, int k0, int lane) {
    return *(LAS const bf16x8*)(base + (row0 + (lane & 31)) * stride + (k0 + 8 * (lane >> 5)) * 2);
}
__device__ __forceinline__ s16x4 tr4(LAS const unsigned char* p) { return __builtin_amdgcn_ds_read_tr16_b64_v4i16((LAS s16x4*)p); }
__device__ __forceinline__ bf16x8 frag_tr(LAS const unsigned char* base, int stride, int k0, int col0, int lane) {
    const int h = lane >> 5, blk = (lane >> 4) & 1, q = (lane & 15) >> 2, p = lane & 3;
    LAS const unsigned char* a = base + (k0 + 8 * h + q) * stride + (col0 + 16 * blk + 4 * p) * 2;
    const s16x4 lo = tr4(a), hi = tr4(a + 4 * stride);
    return (bf16x8){lo[0], lo[1], lo[2], lo[3], hi[0], hi[1], hi[2], hi[3]};
}
__device__ __forceinline__ bf16x8 frag_tr_perm(LAS const unsigned char* base, int stride, int k0, int col0, int lane) {
    const int h = lane >> 5, blk = (lane >> 4) & 1, q = (lane & 15) >> 2, p = lane & 3;
    LAS const unsigned char* a = base + (k0 + 4 * h + q) * stride + (col0 + 16 * blk + 4 * p) * 2;
    const s16x4 lo = tr4(a), hi = tr4(a + 8 * stride);
    return (bf16x8){lo[0], lo[1], lo[2], lo[3], hi[0], hi[1], hi[2], hi[3]};
}
__device__ __forceinline__ int swz_off(int row, int ch) { return 256 * row + 16 * (ch ^ (((row & 3) << 2) | ((row >> 2) & 3))); }
__device__ __forceinline__ bf16x8 sfrag_row(LAS const unsigned char* base, int row0, int k0, int lane) {
    return *(LAS const bf16x8*)(base + swz_off(row0 + (lane & 31), (k0 >> 3) + (lane >> 5)));
}
__device__ __forceinline__ bf16x8 sfrag_tr_perm(LAS const unsigned char* base, int k0, int col0, int lane) {
    const int h = lane >> 5, blk = (lane >> 4) & 1, q = (lane & 15) >> 2, p = lane & 3, ch = (col0 >> 3) + 2 * blk + (p >> 1), r0 = k0 + 4 * h + q;
    const s16x4 lo = tr4(base + swz_off(r0, ch) + 8 * (p & 1)), hi = tr4(base + swz_off(r0 + 8, ch) + 8 * (p & 1));
    return (bf16x8){lo[0], lo[1], lo[2], lo[3], hi[0], hi[1], hi[2], hi[3]};
}
#define MFMA32(a, b, c) __builtin_amdgcn_mfma_f32_32x32x16_bf16((a), (b), (c), 0, 0, 0)
__device__ __forceinline__ f32x16 zero16() { f32x16 z;
#pragma unroll
    for (int i = 0; i < 16; ++i) z[i] = 0.f;
    return z; }
__device__ __forceinline__ void load_tile(LAS unsigned char* dst, int ls, const bf16* src, size_t ld, int rows, int cols, int tid) {
    const int cpr = cols >> 3, n = rows * cpr;
    for (int c = tid; c < n; c += NTHR) { const int r = c / cpr, cc = c - r * cpr; *(LAS v4u*)(dst + r * ls + cc * 16) = *(const v4u*)(src + (size_t)r * ld + cc * 8); }
}

__device__ __forceinline__ void store_tile(bf16* dst, size_t ld, LAS const unsigned char* src, int ls, int rows, int cols, int tid) {
    const int cpr = cols >> 3, n = rows * cpr;
    for (int c = tid; c < n; c += NTHR) { const int r = c / cpr, cc = c - r * cpr; *(v4u*)(dst + (size_t)r * ld + cc * 8) = *(LAS const v4u*)(src + r * ls + cc * 16); }
}

struct TrItem { const float* W; bf16* WT; int K, N, k0, n0, dn0, nts; };
__device__ __forceinline__ void tr_issue(const TrItem& t, f32x4 (&v)[8], int lane) {
    const int n = t.n0 + 4 * (lane & 7);
#pragma unroll
    for (int i = 0; i < 8; ++i) { const int kk = 8 * i + (lane >> 3); v[i] = n < t.N ? __builtin_nontemporal_load((const f32x4*)(t.W + (size_t)(t.k0 + kk) * t.N + n)) : (f32x4){0.f, 0.f, 0.f, 0.f}; }
}
__device__ __forceinline__ void tr_finish(const TrItem& t, const f32x4 (&v)[8], LAS float* scr, int lane) {
#pragma unroll
    for (int i = 0; i < 8; ++i) { const int kk = 8 * i + (lane >> 3); LAS float* d = scr + kk * 33 + 4 * (lane & 7); d[0] = v[i].x; d[1] = v[i].y; d[2] = v[i].z; d[3] = v[i].w; }
    asm volatile("s_waitcnt lgkmcnt(0)" ::: "memory");
    const int c = lane & 7;
#pragma unroll
    for (int j = 0; j < 4; ++j) { const int nn = (lane >> 3) + 8 * j; const LAS float* s = scr + (8 * c) * 33 + nn;
        v4u o; o.x = pk2(s[0 * 33], s[1 * 33]); o.y = pk2(s[2 * 33], s[3 * 33]); o.z = pk2(s[4 * 33], s[5 * 33]); o.w = pk2(s[6 * 33], s[7 * 33]);
        if (t.k0 >= 0 && t.nts) __builtin_nontemporal_store(o, (v4u*)(t.WT + (size_t)(t.dn0 + nn) * t.K + t.k0 + 8 * c)); else *(v4u*)(t.WT + (size_t)(t.dn0 + nn) * t.K + t.k0 + 8 * c) = o; }
    asm volatile("s_waitcnt lgkmcnt(0)" ::: "memory");
}
__device__ __forceinline__ void tr_decode(const Args& a, unsigned char* ws, int g, TrItem& t) {
    const int layer = g / 25344; int r = g - layer * 25344; const int li = layer >> 1; t.nts = layer > 0;
    unsigned char* wb = ws + WS_W + (size_t)layer * W_LAYER;
    int nblk;
    if (r < 6400) { if (layer & 1) { t.W = a.in[14] + (size_t)li * DM * ODIN; t.N = ODIN; } else { t.W = a.in[8] + (size_t)li * DM * EVIN; t.N = EVIN; } t.WT = (bf16*)wb; t.K = DM; nblk = NINP / 32; }
    else if ((r -= 6400) < 2048) { t.W = (layer & 1 ? a.in[15] : a.in[9]) + (size_t)li * DM * DM; t.N = DM; t.WT = (bf16*)(wb + W_OUT); t.K = DM; nblk = DM / 32; }
    else if ((r -= 2048) < 11264) { t.W = a.in[23] + (size_t)layer * DM * NUP; t.N = NUP; t.WT = (bf16*)(wb + W_UP); t.K = DM; nblk = NUP / 32; }
    else { r -= 11264; t.W = a.in[26] + (size_t)layer * DFF * DM; t.N = DM; t.WT = (bf16*)(wb + W_DN); t.K = DFF; nblk = DM / 32; }
    const int kb = r / nblk, nb = r - kb * nblk; t.k0 = 64 * kb; t.n0 = 32 * nb; t.dn0 = t.n0;
    if (t.N == NUP) { const int m0 = t.n0 < DFF ? t.n0 : t.n0 - DFF; t.dn0 = 256 * (m0 >> 7) + (t.n0 < DFF ? 0 : 128) + (m0 & 127); }
}
__device__ __forceinline__ void ph_convert(const Args& a, unsigned char* ws, LAS unsigned char* lds, int g_lo, int g_hi, int w, int nw, int wave, int lane) {
    LAS float* scr = (LAS float*)(lds + wave * 8448);
    TrItem cur, nxt; f32x4 va[8], vb[8];
    int g = g_lo + w;
    if (g < g_hi) { tr_decode(a, ws, g, cur); tr_issue(cur, va, lane); }
    while (g < g_hi) {
        const int g1 = g + nw; if (g1 < g_hi) { tr_decode(a, ws, g1, nxt); tr_issue(nxt, vb, lane); }
        tr_finish(cur, va, scr, lane);
        const int g2 = g1 + nw; if (g1 < g_hi) { if (g2 < g_hi) { tr_decode(a, ws, g2, cur); tr_issue(cur, va, lane); } tr_finish(nxt, vb, scr, lane); }
        g = g2;
    }
}
__device__ __forceinline__ void ph_prologue(const Args& a, unsigned char* ws, LAS unsigned char* lds, int tid, int lane, int wave, int bid, int G) {
    float* MOD = (float*)(ws + WS_MOD);
    LAS float* vec = (LAS float*)(lds + 73728);
    LAS float* red = (LAS float*)(lds + 98304);
    for (int e = tid; e < 3 * DM; e += NTHR) { const float v = e < 2 * DM ? a.in[1][e] : a.in[3][e - 2 * DM]; vec[e] = silu_f(v); }
    __syncthreads();
    for (int it = bid; it < 4 * 192; it += G) {
        const int layer = it / 192, cg = it - layer * 192, col = cg * 64 + 4 * (lane & 15), rq = lane >> 4;
        const float* W = a.in[4] + (size_t)layer * DM * 12288 + col;
        f32x4 a0 = {0.f, 0.f, 0.f, 0.f}, a1 = a0, a2 = a0;
#pragma unroll 16
        for (int i = 0; i < 64; ++i) { const int kk = 256 * wave + 4 * i + rq; const f32x4 w4 = __builtin_nontemporal_load((const f32x4*)(W + (size_t)kk * 12288));
            a0 += w4 * vec[kk]; a1 += w4 * vec[DM + kk]; a2 += w4 * vec[2 * DM + kk]; }
#pragma unroll
        for (int e = 0; e < 4; ++e) { a0[e] += __shfl_xor(a0[e], 16); a0[e] += __shfl_xor(a0[e], 32); a1[e] += __shfl_xor(a1[e], 16); a1[e] += __shfl_xor(a1[e], 32); a2[e] += __shfl_xor(a2[e], 16); a2[e] += __shfl_xor(a2[e], 32); }
        if (lane < 16) { *(LAS f32x4*)(red + (wave * 3 + 0) * 64 + 4 * lane) = a0; *(LAS f32x4*)(red + (wave * 3 + 1) * 64 + 4 * lane) = a1; *(LAS f32x4*)(red + (wave * 3 + 2) * 64 + 4 * lane) = a2; }
        __syncthreads();
        if (tid < 192) { const int j = tid >> 6, c = tid & 63; float s = a.in[5][layer * 12288 + cg * 64 + c];
#pragma unroll
            for (int w = 0; w < 8; ++w) s += red[(w * 3 + j) * 64 + c];
            MOD[(size_t)(layer * 3 + j) * 12288 + cg * 64 + c] = s; }
        __syncthreads();
    }
    if (bid == G - 1) { float* rope = (float*)(ws + WS_ROPE);
        for (int e = tid; e < 1024; e += NTHR) { const int pos = e >> 4, f = e & 15; const float inv = powf(10000.f, -(float)f / 16.f), ang = (float)pos * inv; rope[e] = cosf(ang); rope[1024 + e] = sinf(ang); } }
    ph_convert(a, ws, lds, 0, 25344, bid * NWAVES + wave, G * NWAVES, wave, lane);
}

__device__ __forceinline__ void fuse_row(const float* src, float* XS, int row, int lane, const float* part, const float* pgate, int nsplit, const float* ng, const float* msc, bf16* H, float* ssq) {
    const int mi = row < NLATR ? (row >> 12) : 2;
    const f32x4* sr = (const f32x4*)src + lane; f32x4* xr = (f32x4*)(XS + (size_t)row * DM) + lane;
    f32x4 v[8];
#pragma unroll
    for (int j = 0; j < 8; ++j) v[j] = sr[64 * j];
    if (nsplit > 0) {
        f32x4 sacc[8];
#pragma unroll
        for (int j = 0; j < 8; ++j) sacc[j] = (f32x4){0.f, 0.f, 0.f, 0.f};
        for (int sp = 0; sp < nsplit; ++sp) { const f32x4* pr = (const f32x4*)(part + ((size_t)sp * 512 + (row - NLATR)) * DM) + lane;
#pragma unroll
            for (int j = 0; j < 8; ++j) sacc[j] += pr[64 * j]; }
#pragma unroll
        for (int j = 0; j < 8; ++j) v[j] += *(const f32x4*)(pgate + 4 * lane + 256 * j) * sacc[j];
    }
    float ss = 0.f;
#pragma unroll
    for (int j = 0; j < 8; ++j) { xr[64 * j] = v[j]; ss += (v[j].x * v[j].x + v[j].y * v[j].y) + (v[j].z * v[j].z + v[j].w * v[j].w); }
    ss = wave_sum(ss);
    if (lane == 0) ssq[row] = ss;
#pragma unroll
    for (int j = 0; j < 8; ++j) { const int col = 4 * lane + 256 * j;
        const f32x4 y = v[j] * *(const f32x4*)(ng + col) * (*(const f32x4*)(msc + (size_t)mi * 12288 + col) + 1.f);
        v2u o; o.x = pk2(y.x, y.y); o.y = pk2(y.z, y.w);
        *(v2u*)(H + (size_t)row * DM + col) = o; }
}
__device__ __forceinline__ void ph_norm0(const float* x, const float* ctx, float* XS, const float* ng, const float* msc, bf16* H, float* ssq, int gw, int NGW, int lane) {
    for (int row = gw; row < MR; row += NGW) fuse_row(row < NLATR ? x + (size_t)row * DM : ctx + (size_t)(row - NLATR) * DM, XS, row, lane, nullptr, nullptr, 0, ng, msc, H, ssq);
}
template <int NS>
__device__ __forceinline__ void ph_ctxfix(float* XS, const float* part, const float* pgate, const float* ng, const float* msc, bf16* H, float* ssq, int gw, int NGW, int lane) {
    for (int it = gw; it < 2048; it += NGW) {
        const int row = NLATR + (it >> 2), c0 = (it & 3) * 512 + 8 * lane;
        float* xp = XS + (size_t)row * DM + c0;
        f32x4 v0 = *(const f32x4*)xp, v1 = *(const f32x4*)(xp + 4);
        f32x4 p0[NS], p1[NS];
#pragma unroll
        for (int sp = 0; sp < NS; ++sp) { const float* pp = part + ((size_t)sp * 512 + (row - NLATR)) * DM + c0; p0[sp] = *(const f32x4*)pp; p1[sp] = *(const f32x4*)(pp + 4); }
        f32x4 s0 = p0[0], s1 = p1[0];
#pragma unroll
        for (int sp = 1; sp < NS; ++sp) { s0 += p0[sp]; s1 += p1[sp]; }
        v0 += *(const f32x4*)(pgate + c0) * s0; v1 += *(const f32x4*)(pgate + c0 + 4) * s1;
        *(f32x4*)xp = v0; *(f32x4*)(xp + 4) = v1;
        float ss = (v0.x * v0.x + v0.y * v0.y) + (v0.z * v0.z + v0.w * v0.w) + (v1.x * v1.x + v1.y * v1.y) + (v1.z * v1.z + v1.w * v1.w);
        ss = wave_sum(ss);
        if (lane == 0) (void)__hip_atomic_fetch_add(ssq + row, ss, __ATOMIC_RELAXED, __HIP_MEMORY_SCOPE_AGENT);
        const f32x4 y0 = v0 * *(const f32x4*)(ng + c0) * (*(const f32x4*)(msc + 2 * 12288 + c0) + 1.f), y1 = v1 * *(const f32x4*)(ng + c0 + 4) * (*(const f32x4*)(msc + 2 * 12288 + c0 + 4) + 1.f);
        v4u o; o.x = pk2(y0.x, y0.y); o.y = pk2(y0.z, y0.w); o.z = pk2(y1.x, y1.y); o.w = pk2(y1.z, y1.w);
        *(v4u*)(H + (size_t)row * DM + c0) = o;
    }
}
__device__ __forceinline__ void ph_bias(const bf16* WIN, const bf16* WUPt, const float* mod, float* b1, float* b2, int gw, int NGW, int lane) {
    for (int which = 0; which < 2; ++which) {
        const bf16* WT = which ? WUPt : WIN; const int N = which ? NUP : NINP; const float* sh = mod + (which ? 3 * DM : 0); float* out = which ? b2 : b1;
        float s0[32], s1[32], s2[32];
#pragma unroll
        for (int i = 0; i < 4; ++i)
#pragma unroll
            for (int h = 0; h < 2; ++h) { const int k = 512 * i + 8 * lane + 4 * h; const f32x4 a0 = *(const f32x4*)(sh + k), a1 = *(const f32x4*)(sh + 12288 + k), a2 = *(const f32x4*)(sh + 2 * 12288 + k);
#pragma unroll
                for (int el = 0; el < 4; ++el) { s0[8 * i + 4 * h + el] = a0[el]; s1[8 * i + 4 * h + el] = a1[el]; s2[8 * i + 4 * h + el] = a2[el]; } }
#pragma unroll 1
        for (int n0 = gw * 2; n0 < N; n0 += NGW * 2) {
            v4u wv[2][4];
#pragma unroll
            for (int rr = 0; rr < 2; ++rr)
#pragma unroll
                for (int i = 0; i < 4; ++i) wv[rr][i] = *(const v4u*)(WT + (size_t)(n0 + rr) * DM + 512 * i + 8 * lane);
            float d[2][3];
#pragma unroll
            for (int rr = 0; rr < 2; ++rr) { d[rr][0] = 0.f; d[rr][1] = 0.f; d[rr][2] = 0.f;
#pragma unroll
                for (int i = 0; i < 4; ++i) { float w[8]; unpack8(wv[rr][i], w);
#pragma unroll
                    for (int el = 0; el < 8; ++el) { d[rr][0] += w[el] * s0[8 * i + el]; d[rr][1] += w[el] * s1[8 * i + el]; d[rr][2] += w[el] * s2[8 * i + el]; } } }
#pragma unroll
            for (int rr = 0; rr < 2; ++rr)
#pragma unroll
                for (int j = 0; j < 3; ++j) d[rr][j] = wave_sum(d[rr][j]);
            if (lane == 0) {
#pragma unroll
                for (int rr = 0; rr < 2; ++rr) { out[n0 + rr] = d[rr][0]; out[N + n0 + rr] = d[rr][1]; out[2 * N + n0 + rr] = d[rr][2]; } }
        }
    }
}

template <int MODE>
__device__ __forceinline__ void ph_conv(const bf16* SRC, const float* cw, const float* cb, bf16* DST, int gtid, int NT) {
    constexpr int NC = MODE == 0 ? DFF : 1024, NCG = NC / 8, NRB = MR / 16;
    constexpr int LDS_ = MODE == 0 ? NUP : NINP, LDD = MODE == 0 ? DFF : (MODE == 1 ? DM : 1024);
    for (int it = gtid; it < NRB * NCG; it += NT) {
        const int rb = it / NCG, cg = it - rb * NCG, r0 = rb * 16, c0 = cg * 8;
        float w0[8], w1[8], w2[8], bb[8];
#pragma unroll
        for (int j = 0; j < 8; ++j) { w0[j] = cw[c0 + j]; w1[j] = cw[NC + c0 + j]; w2[j] = cw[2 * NC + c0 + j]; bb[j] = MODE == 0 ? cb[c0 + j] : 0.f; }
        auto ld = [&](int r, float (&f)[8]) {
            if (MODE == 0) { unpack8(*(const v4u*)(SRC + (size_t)r * LDS_ + c0), f); }
            else if (MODE == 1) { float s1[8], s2[8]; unpack8(*(const v4u*)(SRC + (size_t)r * LDS_ + 3104 + c0), s1); unpack8(*(const v4u*)(SRC + (size_t)r * LDS_ + 5152 + c0), s2);
#pragma unroll
                for (int j = 0; j < 8; ++j) f[j] = s1[j] * s2[j]; }
            else { unpack8(*(const v4u*)(SRC + (size_t)r * LDS_ + 3072 + c0), f); }
        };
        float prev[8], cur[8], nxt[8];
        if (!seq_start(r0)) ld(r0 - 1, prev); else {
#pragma unroll
            for (int j = 0; j < 8; ++j) prev[j] = 0.f; }
        ld(r0, cur);
#pragma unroll 2
        for (int i = 0; i < 16; ++i) {
            const int r = r0 + i;
            if (i < 15 || !seq_start(r0 + 16)) ld(r + 1, nxt); else {
#pragma unroll
                for (int j = 0; j < 8; ++j) nxt[j] = 0.f; }
            float o[8];
            if (MODE == 0) { float vv[8]; unpack8(*(const v4u*)(SRC + (size_t)r * LDS_ + DFF + c0), vv);
#pragma unroll
                for (int j = 0; j < 8; ++j) o[j] = silu_f(w0[j] * prev[j] + w1[j] * cur[j] + w2[j] * nxt[j] + bb[j]) * vv[j]; }
            else if (MODE == 1) { float vv[8]; unpack8(*(const v4u*)(SRC + (size_t)r * LDS_ + 4128 + c0), vv);
#pragma unroll
                for (int j = 0; j < 8; ++j) o[j] = (w0[j] * prev[j] + w1[j] * cur[j] + w2[j] * nxt[j]) * vv[j]; }
            else { const float sc = c0 >= 512 ? 0.08838834764831845f : 1.f;
#pragma unroll
                for (int j = 0; j < 8; ++j) o[j] = silu_f(w0[j] * prev[j] + w1[j] * cur[j] + w2[j] * nxt[j]) * sc; }
            *(v4u*)(DST + (size_t)r * LDD + (MODE == 1 ? 1024 : 0) + c0) = pack8(o);
#pragma unroll
            for (int j = 0; j < 8; ++j) { prev[j] = cur[j]; cur[j] = nxt[j]; }
        }
    }
}

__device__ __forceinline__ void ph_act_fix(const float* halo, const float* cw, bf16* ACT, int gtid, int NT) {
    for (int e = gtid; e < 34 * 44 * 256; e += NT) {
        const int ch = e & 127, which = (e >> 7) & 1, tile = e >> 8, pm = tile / 44, pn = tile - pm * 44, chg = pn * 128 + ch;
        const float* hb = halo + (size_t)tile * 768;
        const int row = 256 * pm + (which ? 255 : 0);
        float g = 0.f;
        if (which == 0) { if (!seq_start(row)) g = halo[(size_t)(tile - 44) * 768 + 128 + ch] * cw[chg]; }
        else { if (!seq_start(row + 1)) g = halo[(size_t)(tile + 44) * 768 + ch] * cw[2 * DFF + chg]; }
        const float cv = hb[(2 + which) * 128 + ch] + g;
        ACT[(size_t)row * DFF + chg] = f2bf(silu_f(cv) * hb[(4 + which) * 128 + ch]);
    }
}

__device__ __forceinline__ void act_fix_tile(const float* halo, const float* cw, bf16* ACT, int pm, int tid) {
    f32x4 cp[6], vv[6], gg[6];
#pragma unroll
    for (int i = 0; i < 6; ++i) { const int e = tid + NTHR * i; const bool ok = e < 2816; const int ee = ok ? e : 0;
        const int c4 = ee & 31, which = (ee >> 5) & 1, pn = ee >> 6, tile = pm * 44 + pn, chg = pn * 128 + 4 * c4;
        const float* hb = halo + (size_t)tile * 768 + 4 * c4;
        const int row = 256 * pm + (which ? 255 : 0);
        cp[i] = *(const f32x4*)(hb + (2 + which) * 128); vv[i] = *(const f32x4*)(hb + (4 + which) * 128);
        const bool edge = which == 0 ? seq_start(row) : seq_start(row + 1);
        const f32x4 nb = edge ? (f32x4){0.f, 0.f, 0.f, 0.f} : *(const f32x4*)(halo + (size_t)(which == 0 ? tile - 44 : tile + 44) * 768 + (which == 0 ? 128 : 0) + 4 * c4);
        gg[i] = nb * *(const f32x4*)(cw + (which == 0 ? 0 : 2 * DFF) + chg); }
#pragma unroll
    for (int i = 0; i < 6; ++i) { const int e = tid + NTHR * i; if (e < 2816) {
        const int c4 = e & 31, which = (e >> 5) & 1, pn = e >> 6, chg = pn * 128 + 4 * c4; const int row = 256 * pm + (which ? 255 : 0);
        const f32x4 cv = cp[i] + gg[i];
        v2u o; o.x = pk2(silu_f(cv.x) * vv[i].x, silu_f(cv.y) * vv[i].y); o.y = pk2(silu_f(cv.z) * vv[i].z, silu_f(cv.w) * vv[i].w);
        *(v2u*)(ACT + (size_t)row * DFF + chg) = o; } }
}

__device__ __forceinline__ void ph_qkprep(const bf16* P, const float* qg, const float* kg, const float* rope, bf16* QR, bf16* KR, int gw, int NGW, int lane) {
    for (int it = gw; it < MR * 4; it += NGW) {
        const int row = it >> 2, qtr = it & 3, isk = qtr >> 1;
        float x[8]; unpack8(*(const v4u*)(P + (size_t)row * NINP + isk * 1024 + (qtr & 1) * 512 + 8 * lane), x);
        float ss = 0.f;
#pragma unroll
        for (int j = 0; j < 8; ++j) ss += x[j] * x[j];
        ss += __shfl_xor(ss, 1); ss += __shfl_xor(ss, 2); ss += __shfl_xor(ss, 4);
        const float r = rsqrtf(ss * (1.f / 64.f) + EPS);
        const int i = lane & 7; const float* gp = (isk ? kg : qg) + 8 * i;
        float y[8], o[8];
#pragma unroll
        for (int j = 0; j < 8; ++j) y[j] = x[j] * r * gp[j];
        if (row < NLATR) {
            const int t = row & 4095, pos = (i < 4) ? (t >> 6) : (t & 63), f0 = 8 * (i & 1);
#pragma unroll
            for (int j = 0; j < 8; ++j) { const float pj = __shfl_xor(y[j], 2), c = rope[pos * 16 + f0 + j], s = rope[1024 + pos * 16 + f0 + j];
                o[j] = (i & 2) ? (pj * s + y[j] * c) : (y[j] * c - pj * s); }
        } else {
#pragma unroll
            for (int j = 0; j < 8; ++j) o[j] = y[j]; }
        if (!isk) {
#pragma unroll
            for (int j = 0; j < 8; ++j) o[j] *= 0.18033688011112042f; }
        *(v4u*)((isk ? KR : QR) + (size_t)row * 1024 + (qtr & 1) * 512 + 8 * lane) = pack8(o);
    }
}

struct ScanP {
    const bf16* P; const bf16* MQK; bf16* MIX;
    const float* gw2; const float* gb;
    const float* mgb;
    const float* ng;
    bf16* DSTp; bf16* SSTp; float* GAM; float* DN; float* NIN; float* BL; float* ML; float* MINp;
};
__device__ __forceinline__ void scan_unit(int u, int& b, int& head, int& mm, int& rowbase) {
    b = u / 272; const int rem = u - b * 272; head = rem / 68; mm = rem - head * 68;
    rowbase = mm < 4 ? NLATR + b * 256 + 64 * mm : b * 4096 + 64 * (mm - 4);
}
__device__ __forceinline__ int scan_chunk(int mm, int dir) { return dir ? (mm < 4 ? 3 - mm : 71 - mm) : mm; }

__device__ __forceinline__ void gla_gates(const ScanP& s, LAS const float* glr, LAS float* tot, int head, int dir, int tid, float (&bb)[16], float& btot) {
    const int dk = tid & 127, grp = tid >> 7;
    float w2[16];
#pragma unroll
    for (int r = 0; r < 16; ++r) w2[r] = s.gw2[(dir * 16 + r) * 512 + head * 128 + dk];
    const float bias = s.gb[dir * 512 + head * 128 + dk];
#pragma unroll
    for (int tt = 0; tt < 16; ++tt) { const int t = 16 * grp + tt; float z = bias;
#pragma unroll
        for (int r = 0; r < 16; ++r) z += glr[t * 32 + dir * 16 + r] * w2[r];
        bb[tt] = logsig_f(z) * 0.0625f; }
    if (dir == 0) {
#pragma unroll
        for (int tt = 1; tt < 16; ++tt) bb[tt] += bb[tt - 1];
        tot[grp * 128 + dk] = bb[15];
    } else {
#pragma unroll
        for (int tt = 14; tt >= 0; --tt) bb[tt] += bb[tt + 1];
        tot[grp * 128 + dk] = bb[0];
    }
    __syncthreads();
    float off = 0.f; btot = 0.f;
#pragma unroll
    for (int g = 0; g < 4; ++g) { const float tv = tot[g * 128 + dk]; btot += tv; if (dir == 0 ? g < grp : g > grp) off += tv; }
#pragma unroll
    for (int tt = 0; tt < 16; ++tt) bb[tt] += off;
}

__device__ __forceinline__ void ph_mlstm_local(const ScanP& s, LAS unsigned char* lds, int tid, int lane, int wave, int bid, int G) {
    LAS unsigned char* Vs = lds; LAS unsigned char* Kh = lds + 33792; LAS unsigned char* Kr = lds + 69632;
    LAS float* wv = (LAS float*)(lds + 87040); LAS float* dnp = (LAS float*)(lds + 87296);
    const int dk = tid & 127, grp = tid >> 7;
    for (int u = bid; u < 544; u += G) {
        int b, head, mm, rowbase; scan_unit(u, b, head, mm, rowbase);
        load_tile(Kr, 272, s.MQK + (size_t)rowbase * 1024 + 512 + head * 128, 1024, 64, 128, tid);
        for (int dir = 0; dir < 2; ++dir) {
            const int chain = (b * 4 + head) * 2 + dir, c = scan_chunk(mm, dir); const size_t cc = (size_t)chain * NCHUNK + c;
            load_tile(Vs, 528, s.P + (size_t)rowbase * NINP + 4096 + head * 256, NINP, 64, 256, tid);
            if (wave == 0) {
                const float ig = bf1(s.P[(size_t)(rowbase + lane) * NINP + 6144 + dir * 8 + head]) + s.mgb[dir * 8 + head];
                const float fg = bf1(s.P[(size_t)(rowbase + lane) * NINP + 6144 + dir * 8 + 4 + head]) + s.mgb[dir * 8 + 4 + head];
                const float lf = logsig_f(fg), bcs = wave_scan_sum(lf, dir, lane), blast = wave_sum(lf);
                const float gs = blast - bcs + ig, mloc = wave_max(gs);
                wv[lane] = __expf(gs - mloc);
                if (lane == 0) { s.BL[cc] = blast; s.ML[cc] = mloc; }
            }
            __syncthreads();
            float part = 0.f;
#pragma unroll
            for (int tt = 0; tt < 16; ++tt) { const int t = 16 * grp + tt; const float kv = bf1(*(LAS const bf16*)(Kr + t * 272 + dk * 2)) * wv[t];
                *(LAS bf16*)(Kh + t * 272 + dk * 2) = f2bf(kv); part += kv; }
            dnp[grp * 128 + dk] = part;
            __syncthreads();
            if (tid < 128) s.DN[cc * 128 + tid] = (dnp[tid] + dnp[128 + tid]) + (dnp[256 + tid] + dnp[384 + tid]);
            f32x16 acc[4];
#pragma unroll
            for (int nt = 0; nt < 4; ++nt) acc[nt] = zero16();
#pragma unroll
            for (int ks = 0; ks < 4; ++ks) { const bf16x8 af = frag_tr(Vs, 528, 16 * ks, 32 * wave, lane);
#pragma unroll
                for (int nt = 0; nt < 4; ++nt) { const bf16x8 bfr = frag_tr(Kh, 272, 16 * ks, 32 * nt, lane); acc[nt] = MFMA32(af, bfr, acc[nt]); } }
            __syncthreads();
#pragma unroll
            for (int nt = 0; nt < 4; ++nt)
#pragma unroll
                for (int r = 0; r < 16; ++r) { const int dv = 32 * wave + (r & 3) + 8 * (r >> 2) + 4 * (lane >> 5); *(LAS bf16*)(lds + dv * 272 + (32 * nt + (lane & 31)) * 2) = f2bf(acc[nt][r]); }
            __syncthreads();
            store_tile(s.DSTp + cc * 32768, 128, lds, 272, 256, 128, tid);
            __syncthreads();
        }
    }
}

__device__ __forceinline__ void ph_gla_local(const ScanP& s, bf16* QT, bf16* KT, LAS unsigned char* lds, int tid, int lane, int wave, int bid, int G) {
    LAS unsigned char* Vs = lds; LAS unsigned char* Kh = lds + 33792; LAS unsigned char* Qr = lds + 51200; LAS unsigned char* Kr = lds + 68608;
    LAS float* glr = (LAS float*)(lds + 86016); LAS float* tot = (LAS float*)(lds + 90112);
    const int dk = tid & 127, grp = tid >> 7;
    for (int u = bid; u < 1088; u += G) {
        const int dir = u & 1; int b, head, mm, rowbase; scan_unit(u >> 1, b, head, mm, rowbase);
        const int chain = (b * 4 + head) * 2 + dir, c = scan_chunk(mm, dir); const size_t cc = (size_t)chain * NCHUNK + c;
        load_tile(Vs, 528, s.P + (size_t)rowbase * NINP + 1024 + head * 256, NINP, 64, 256, tid);
        load_tile(Qr, 272, s.P + (size_t)rowbase * NINP + head * 128, NINP, 64, 128, tid);
        load_tile(Kr, 272, s.P + (size_t)rowbase * NINP + 512 + head * 128, NINP, 64, 128, tid);
        for (int e = tid; e < 1024; e += NTHR) glr[e] = bf1(s.P[(size_t)(rowbase + (e >> 4)) * NINP + 3072 + dir * 16 + (e & 15)]);
        __syncthreads();
        float bb[16], btot;
        { float w2[16];
#pragma unroll
          for (int r = 0; r < 16; ++r) w2[r] = s.gw2[(dir * 16 + r) * 512 + head * 128 + dk];
          const float bias = s.gb[dir * 512 + head * 128 + dk];
#pragma unroll
          for (int tt = 0; tt < 16; ++tt) { const int t = 16 * grp + tt; float z = bias;
#pragma unroll
              for (int r = 0; r < 16; ++r) z += glr[t * 16 + r] * w2[r];
              bb[tt] = logsig_f(z) * 0.0625f; }
          if (dir == 0) {
#pragma unroll
              for (int tt = 1; tt < 16; ++tt) bb[tt] += bb[tt - 1];
              tot[grp * 128 + dk] = bb[15];
          } else {
#pragma unroll
              for (int tt = 14; tt >= 0; --tt) bb[tt] += bb[tt + 1];
              tot[grp * 128 + dk] = bb[0];
          }
          __syncthreads();
          float off = 0.f; btot = 0.f;
#pragma unroll
          for (int g = 0; g < 4; ++g) { const float tv = tot[g * 128 + dk]; btot += tv; if (dir == 0 ? g < grp : g > grp) off += tv; }
#pragma unroll
          for (int tt = 0; tt < 16; ++tt) bb[tt] += off; }
#pragma unroll
        for (int tt = 0; tt < 16; ++tt) { const int t = 16 * grp + tt;
            const float qv = bf1(*(LAS const bf16*)(Qr + t * 272 + dk * 2)), kv = bf1(*(LAS const bf16*)(Kr + t * 272 + dk * 2));
            const float e1 = __expf(bb[tt]);
            *(LAS bf16*)(Kh + t * 272 + dk * 2) = f2bf(kv * __expf(btot - bb[tt]));
            *(LAS bf16*)(Qr + t * 272 + dk * 2) = f2bf(qv * e1 * 0.08838834764831845f); *(LAS bf16*)(Kr + t * 272 + dk * 2) = f2bf(kv * __builtin_amdgcn_rcpf(e1)); }
        if (grp == 0) s.GAM[cc * 128 + dk] = __expf(btot);
        __syncthreads();
        store_tile(QT + ((size_t)dir * MR + rowbase) * 512 + head * 128, 512, Qr, 272, 64, 128, tid);
        store_tile(KT + ((size_t)dir * MR + rowbase) * 512 + head * 128, 512, Kr, 272, 64, 128, tid);
        f32x16 acc[4];
#pragma unroll
        for (int nt = 0; nt < 4; ++nt) acc[nt] = zero16();
#pragma unroll
        for (int ks = 0; ks < 4; ++ks) { const bf16x8 af = frag_tr(Vs, 528, 16 * ks, 32 * wave, lane);
#pragma unroll
            for (int nt = 0; nt < 4; ++nt) { const bf16x8 bfr = frag_tr(Kh, 272, 16 * ks, 32 * nt, lane); acc[nt] = MFMA32(af, bfr, acc[nt]); } }
        __syncthreads();
#pragma unroll
        for (int nt = 0; nt < 4; ++nt)
#pragma unroll
            for (int r = 0; r < 16; ++r) { const int dv = 32 * wave + (r & 3) + 8 * (r >> 2) + 4 * (lane >> 5); *(LAS bf16*)(lds + dv * 272 + (32 * nt + (lane & 31)) * 2) = f2bf(acc[nt][r]); }
        __syncthreads();
        store_tile(s.DSTp + cc * 32768, 128, lds, 272, 256, 128, tid);
        __syncthreads();
    }
}
__device__ __forceinline__ void ph_gla_out(const ScanP& s, const bf16* QT, const bf16* KT, LAS unsigned char* lds, int tid, int lane, int wave, int bid, int G) {
    LAS unsigned char* Vs = lds;
    LAS unsigned char* Qx = lds + 33792;
    LAS unsigned char* Ki = lds + 68608;
    LAS unsigned char* Am = lds + 103424;
    LAS float* Os = (LAS float*)lds;
    for (int u = bid; u < 544; u += G) {
        int b, head, mm, rowbase; scan_unit(u, b, head, mm, rowbase);
        load_tile(Vs, 528, s.P + (size_t)rowbase * NINP + 1024 + head * 256, NINP, 64, 256, tid);
#pragma unroll
        for (int dir = 0; dir < 2; ++dir) {
            load_tile(Qx + dir * 17408, 272, QT + ((size_t)dir * MR + rowbase) * 512 + head * 128, 512, 64, 128, tid);
            load_tile(Ki + dir * 17408, 272, KT + ((size_t)dir * MR + rowbase) * 512 + head * 128, 512, 64, 128, tid); }
        bf16x8 sf[2][8];
#pragma unroll
        for (int dir = 0; dir < 2; ++dir) { const int chain = (b * 4 + head) * 2 + dir, c = scan_chunk(mm, dir); const size_t cc = (size_t)chain * NCHUNK + c;
            const bf16* Sg = s.SSTp + cc * 32768 + (size_t)(32 * wave + (lane & 31)) * 128 + 8 * (lane >> 5);
#pragma unroll
            for (int ks = 0; ks < 8; ++ks) sf[dir][ks] = *(const bf16x8*)(Sg + 16 * ks); }
        __syncthreads();
        {
            const int dir = wave >> 2, ti = (wave >> 1) & 1, tj = wave & 1; f32x16 acc = zero16();
#pragma unroll
            for (int ks = 0; ks < 8; ++ks) { const bf16x8 af = frag_row(Qx + dir * 17408, 272, 32 * ti, 16 * ks, lane), bfr = frag_row(Ki + dir * 17408, 272, 32 * tj, 16 * ks, lane); acc = MFMA32(af, bfr, acc); }
            const int sidx = 32 * tj + (lane & 31);
#pragma unroll
            for (int r = 0; r < 16; ++r) { const int t = 32 * ti + (r & 3) + 8 * (r >> 2) + 4 * (lane >> 5);
                const bool keep = dir == 0 ? (sidx <= t) : (sidx >= t);
                *(LAS bf16*)(Am + dir * 9216 + t * 144 + sidx * 2) = f2bf(keep ? acc[r] : 0.f); }
        }
        __syncthreads();
        f32x16 acc2[2]; acc2[0] = zero16(); acc2[1] = zero16();
#pragma unroll
        for (int dir = 0; dir < 2; ++dir) {
#pragma unroll
            for (int ks = 0; ks < 8; ++ks)
#pragma unroll
                for (int rt = 0; rt < 2; ++rt) { const bf16x8 af = frag_row(Qx + dir * 17408, 272, 32 * rt, 16 * ks, lane); acc2[rt] = MFMA32(af, sf[dir][ks], acc2[rt]); }
#pragma unroll
            for (int ks = 0; ks < 4; ++ks) { const bf16x8 bfr = frag_tr(Vs, 528, 16 * ks, 32 * wave, lane);
#pragma unroll
                for (int rt = 0; rt < 2; ++rt) { const bf16x8 af = frag_row(Am + dir * 9216, 144, 32 * rt, 16 * ks, lane); acc2[rt] = MFMA32(af, bfr, acc2[rt]); } }
        }
        __syncthreads();
#pragma unroll
        for (int rt = 0; rt < 2; ++rt)
#pragma unroll
            for (int r = 0; r < 16; ++r) { const int t = 32 * rt + (r & 3) + 8 * (r >> 2) + 4 * (lane >> 5); Os[t * 260 + 32 * wave + (lane & 31)] = acc2[rt][r]; }
        __syncthreads();
        { const int t = tid >> 3, part = tid & 7; float o[32]; float ss = 0.f;
#pragma unroll
          for (int j = 0; j < 8; ++j) { const f32x4 v = *(LAS const f32x4*)(Os + t * 260 + 32 * part + 4 * j); o[4 * j] = v.x; o[4 * j + 1] = v.y; o[4 * j + 2] = v.z; o[4 * j + 3] = v.w; ss += (v.x * v.x + v.y * v.y) + (v.z * v.z + v.w * v.w); }
          ss += __shfl_xor(ss, 1); ss += __shfl_xor(ss, 2); ss += __shfl_xor(ss, 4);
          const float rn = rsqrtf(ss * (1.f / 256.f) + EPS);
          const size_t row = (size_t)(rowbase + t);
          const bf16* gsrc = s.P + row * NINP + 2048 + head * 256 + 32 * part;
          bf16* dst = s.MIX + row * DM + head * 256 + 32 * part;
#pragma unroll
          for (int j = 0; j < 4; ++j) { float gv[8], ov[8]; unpack8(*(const v4u*)(gsrc + 8 * j), gv);
#pragma unroll
              for (int e = 0; e < 8; ++e) ov[e] = o[8 * j + e] * rn * s.ng[32 * part + 8 * j + e] * silu_f(gv[e]);
              *(v4u*)(dst + 8 * j) = pack8(ov); } }
        __syncthreads();
    }
}

__device__ __forceinline__ void ph_mlstm_out(const ScanP& s, LAS unsigned char* lds, int tid, int lane, int wave, int bid, int G) {
    LAS unsigned char* Vs = lds; LAS unsigned char* Qi = lds + 33792; LAS unsigned char* Ki = lds + 51200; LAS unsigned char* Qx = lds + 68608; LAS unsigned char* Am = lds + 103424;
    LAS float* sc = (LAS float*)(lds + 121856);
    LAS float* qnp = (LAS float*)(lds + 125952);
    LAS float* Os = (LAS float*)lds;
    for (int u = bid; u < 544; u += G) {
        int b, head, mm, rowbase; scan_unit(u, b, head, mm, rowbase);
        load_tile(Vs, 528, s.P + (size_t)rowbase * NINP + 4096 + head * 256, NINP, 64, 256, tid);
        load_tile(Qi, 272, s.MQK + (size_t)rowbase * 1024 + head * 128, 1024, 64, 128, tid);
        load_tile(Ki, 272, s.MQK + (size_t)rowbase * 1024 + 512 + head * 128, 1024, 64, 128, tid);
        size_t ccd[2];
#pragma unroll
        for (int dir = 0; dir < 2; ++dir) ccd[dir] = (size_t)((b * 4 + head) * 2 + dir) * NCHUNK + scan_chunk(mm, dir);
        bf16x8 sf[2][8];
#pragma unroll
        for (int dir = 0; dir < 2; ++dir) { const bf16* Sg = s.SSTp + ccd[dir] * 32768 + (size_t)(32 * wave + (lane & 31)) * 128 + 8 * (lane >> 5);
#pragma unroll
            for (int ks = 0; ks < 8; ++ks) sf[dir][ks] = *(const bf16x8*)(Sg + 16 * ks); }
        if (wave < 2) { const int dir = wave; LAS float* d = sc + dir * 512;
            const float ig = bf1(s.P[(size_t)(rowbase + lane) * NINP + 6144 + dir * 8 + head]) + s.mgb[dir * 8 + head];
            const float fg = bf1(s.P[(size_t)(rowbase + lane) * NINP + 6144 + dir * 8 + 4 + head]) + s.mgb[dir * 8 + 4 + head];
            const float lf = logsig_f(fg), bcs = wave_scan_sum(lf, dir, lane);
            const float uu = ig - bcs, pm = wave_scan_max(uu, dir, lane), min_ = s.MINp[ccd[dir]], Mt = fmaxf(min_, pm);
            d[lane] = uu; d[64 + lane] = Mt; d[128 + lane] = __expf(min_ - Mt); d[192 + lane] = __expf(-bcs - Mt); }
        __syncthreads();
        { const int t = tid & 63, part = tid >> 6;
          float a0 = 0.f, a1 = 0.f; const float w0 = sc[128 + t], w1 = sc[512 + 128 + t];
#pragma unroll
          for (int hh = 0; hh < 2; ++hh) { float qv[8], o0[8], o1[8]; unpack8(*(LAS const v4u*)(Qi + t * 272 + (part * 16 + 8 * hh) * 2), qv);
              const float* n0p = s.NIN + ccd[0] * 128 + part * 16 + 8 * hh; const float* n1p = s.NIN + ccd[1] * 128 + part * 16 + 8 * hh;
              const f32x4 n00 = *(const f32x4*)n0p, n01 = *(const f32x4*)(n0p + 4), n10 = *(const f32x4*)n1p, n11 = *(const f32x4*)(n1p + 4);
              a0 += (qv[0] * n00.x + qv[1] * n00.y) + (qv[2] * n00.z + qv[3] * n00.w) + (qv[4] * n01.x + qv[5] * n01.y) + (qv[6] * n01.z + qv[7] * n01.w);
              a1 += (qv[0] * n10.x + qv[1] * n10.y) + (qv[2] * n10.z + qv[3] * n10.w) + (qv[4] * n11.x + qv[5] * n11.y) + (qv[6] * n11.z + qv[7] * n11.w);
#pragma unroll
              for (int e = 0; e < 8; ++e) { o0[e] = qv[e] * w0; o1[e] = qv[e] * w1; }
              *(LAS v4u*)(Qx + t * 272 + (part * 16 + 8 * hh) * 2) = pack8(o0); *(LAS v4u*)(Qx + 17408 + t * 272 + (part * 16 + 8 * hh) * 2) = pack8(o1); }
          qnp[part * 64 + t] = a0; qnp[512 + part * 64 + t] = a1; }
        {
            const int dir = wave >> 2, ti = (wave >> 1) & 1, tj = wave & 1; LAS const float* d = sc + dir * 512; f32x16 acc = zero16();
#pragma unroll
            for (int ks = 0; ks < 8; ++ks) { const bf16x8 af = frag_row(Qi, 272, 32 * ti, 16 * ks, lane), bfr = frag_row(Ki, 272, 32 * tj, 16 * ks, lane); acc = MFMA32(af, bfr, acc); }
            const int sidx = 32 * tj + (lane & 31); const float usv = d[sidx];
#pragma unroll
            for (int r = 0; r < 16; ++r) { const int t = 32 * ti + (r & 3) + 8 * (r >> 2) + 4 * (lane >> 5);
                const bool keep = dir == 0 ? (sidx <= t) : (sidx >= t);
                const float v = keep ? acc[r] * __expf(usv - d[64 + t]) : 0.f;
                *(LAS bf16*)(Am + dir * 9216 + t * 144 + sidx * 2) = f2bf(v);
                float rsum = v; rsum += __shfl_xor(rsum, 1); rsum += __shfl_xor(rsum, 2); rsum += __shfl_xor(rsum, 4); rsum += __shfl_xor(rsum, 8); rsum += __shfl_xor(rsum, 16);
                if ((lane & 31) == 0) (sc + dir * 512)[384 + tj * 64 + t] = rsum; }
        }
        __syncthreads();
        if (tid < 128) { const int dir = tid >> 6, t = tid & 63; LAS float* d = sc + dir * 512; float q = 0.f;
#pragma unroll
            for (int p = 0; p < 8; ++p) q += qnp[dir * 512 + p * 64 + t];
            const float den = d[128 + t] * q + d[384 + t] + d[448 + t]; d[256 + t] = 1.f / fmaxf(fabsf(den), d[192 + t]); }
        f32x16 ad[2][2];
#pragma unroll
        for (int dir = 0; dir < 2; ++dir) { ad[dir][0] = zero16(); ad[dir][1] = zero16();
#pragma unroll
            for (int ks = 0; ks < 8; ++ks)
#pragma unroll
                for (int rt = 0; rt < 2; ++rt) { const bf16x8 af = frag_row(Qx + dir * 17408, 272, 32 * rt, 16 * ks, lane); ad[dir][rt] = MFMA32(af, sf[dir][ks], ad[dir][rt]); }
#pragma unroll
            for (int ks = 0; ks < 4; ++ks) { const bf16x8 bfr = frag_tr(Vs, 528, 16 * ks, 32 * wave, lane);
#pragma unroll
                for (int rt = 0; rt < 2; ++rt) { const bf16x8 af = frag_row(Am + dir * 9216, 144, 32 * rt, 16 * ks, lane); ad[dir][rt] = MFMA32(af, bfr, ad[dir][rt]); } } }
        __syncthreads();
#pragma unroll
        for (int rt = 0; rt < 2; ++rt)
#pragma unroll
            for (int r = 0; r < 16; ++r) { const int t = 32 * rt + (r & 3) + 8 * (r >> 2) + 4 * (lane >> 5); ad[0][rt][r] = ad[0][rt][r] * sc[256 + t] + ad[1][rt][r] * sc[512 + 256 + t]; }
        __syncthreads();
#pragma unroll
        for (int rt = 0; rt < 2; ++rt)
#pragma unroll
            for (int r = 0; r < 16; ++r) { const int t = 32 * rt + (r & 3) + 8 * (r >> 2) + 4 * (lane >> 5); Os[t * 260 + 32 * wave + (lane & 31)] = ad[0][rt][r]; }
        __syncthreads();
        { const int t = tid >> 3, part = tid & 7; float o[32]; float ss = 0.f;
#pragma unroll
          for (int j = 0; j < 8; ++j) { const f32x4 v = *(LAS const f32x4*)(Os + t * 260 + 32 * part + 4 * j); o[4 * j] = v.x; o[4 * j + 1] = v.y; o[4 * j + 2] = v.z; o[4 * j + 3] = v.w; ss += (v.x * v.x + v.y * v.y) + (v.z * v.z + v.w * v.w); }
          ss += __shfl_xor(ss, 1); ss += __shfl_xor(ss, 2); ss += __shfl_xor(ss, 4);
          const float rn = rsqrtf(ss * (1.f / 256.f) + EPS);
          const size_t row = (size_t)(rowbase + t);
          const bf16* gsrc = s.P + row * NINP + 5120 + head * 256 + 32 * part;
          bf16* dst = s.MIX + row * DM + 1024 + head * 256 + 32 * part;
#pragma unroll
          for (int j = 0; j < 4; ++j) { float gv[8], ov[8]; unpack8(*(const v4u*)(gsrc + 8 * j), gv);
#pragma unroll
              for (int e = 0; e < 8; ++e) ov[e] = o[8 * j + e] * rn * s.ng[32 * part + 8 * j + e] * sigmoid_f(gv[e]);
              *(v4u*)(dst + 8 * j) = pack8(ov); } }
        __syncthreads();
    }
}

template <int MODE>
__device__ __forceinline__ void ph_scan_carry(const ScanP& s, int gtid, int NT) {
    for (int e = gtid; e < 16 * 8192; e += NT) {
        const int chain = e >> 13, rem = e & 8191, dv = rem >> 5, dk = (rem & 31) * 4;
        f32x4 st = {0.f, 0.f, 0.f, 0.f}, nst = st; float m = 0.f;
        for (int c0 = 0; c0 < NCHUNK; c0 += 4) {
            f32x4 d[4], gm[4]; float bl[4], ml[4];
#pragma unroll
            for (int j = 0; j < 4; ++j) { const size_t cc = (size_t)chain * NCHUNK + c0 + j; { const v2u dw = *(const v2u*)(s.DSTp + cc * 32768 + dv * 128 + dk); d[j] = (f32x4){bf_lo(dw.x), bf_hi(dw.x), bf_lo(dw.y), bf_hi(dw.y)}; }
                if (MODE == 0) gm[j] = *(const f32x4*)(s.GAM + cc * 128 + dk);
                else { bl[j] = s.BL[cc]; ml[j] = s.ML[cc]; gm[j] = (dv == 0) ? *(const f32x4*)(s.DN + cc * 128 + dk) : (f32x4){0.f, 0.f, 0.f, 0.f}; } }
#pragma unroll
            for (int j = 0; j < 4; ++j) { const size_t cc = (size_t)chain * NCHUNK + c0 + j;
                v2u o; o.x = pk2(st.x, st.y); o.y = pk2(st.z, st.w); *(v2u*)(s.SSTp + cc * 32768 + dv * 128 + dk) = o;
                if (MODE == 0) st = gm[j] * st + d[j];
                else { if (dv == 0) { *(f32x4*)(s.NIN + cc * 128 + dk) = nst; if (dk == 0) s.MINp[cc] = m; }
                    const float mn = fmaxf(bl[j] + m, ml[j]), dec = __expf(bl[j] + m - mn), sc = __expf(ml[j] - mn);
                    st = st * dec + d[j] * sc; nst = nst * dec + gm[j] * sc; m = mn; } }
        }
    }
}

template <int MODE>
__device__ __forceinline__ void ph_scan_out(const ScanP& s, LAS unsigned char* lds, int tid, int lane, int wave, int bid, int G) {
    LAS unsigned char* Vs = lds; LAS unsigned char* Qx = lds + 33792; LAS unsigned char* Ki = lds + 51200; LAS unsigned char* Qi = lds + 68608; LAS unsigned char* Am = lds + 86016;
    LAS float* glr = (LAS float*)(lds + 95232); LAS float* tot = (LAS float*)(lds + 103424);
    LAS float* us = (LAS float*)(lds + 105472); LAS float* Mts = us + 64; LAS float* wint = us + 128; LAS float* thr = us + 192; LAS float* fac = us + 256; LAS float* qn = us + 320; LAS float* rs = us + 384;
    LAS float* qnp = (LAS float*)(lds + 107520);
    LAS float* Os = (LAS float*)lds;
    const int dk = tid & 127, grp = tid >> 7;
    for (int u = bid; u < 544; u += G) {
        int b, head, mm, rowbase; scan_unit(u, b, head, mm, rowbase);
        load_tile(Vs, 528, s.P + (size_t)rowbase * NINP + (MODE ? 4096 : 1024) + head * 256, NINP, 64, 256, tid);
        if (MODE == 0) { for (int e = tid; e < 2048; e += NTHR) glr[e] = bf1(s.P[(size_t)(rowbase + (e >> 5)) * NINP + 3072 + (e & 31)]); if (tid < 64) fac[tid] = 1.f; }
        else { load_tile(Qi, 272, s.MQK + (size_t)rowbase * 1024 + head * 128, 1024, 64, 128, tid); load_tile(Ki, 272, s.MQK + (size_t)rowbase * 1024 + 512 + head * 128, 1024, 64, 128, tid); }
        f32x16 hsum[2]; hsum[0] = zero16(); hsum[1] = zero16();
        __syncthreads();
        for (int dir = 0; dir < 2; ++dir) {
            const int chain = (b * 4 + head) * 2 + dir, c = scan_chunk(mm, dir); const size_t cc = (size_t)chain * NCHUNK + c;
            if (MODE == 0) {
                float bb[16], btot; gla_gates(s, glr, tot, head, dir, tid, bb, btot);
#pragma unroll
                for (int tt = 0; tt < 16; ++tt) { const int t = 16 * grp + tt; const size_t ro = (size_t)(rowbase + t) * NINP + head * 128 + dk;
                    const float qv = bf1(s.P[ro]), kv = bf1(s.P[ro + 512]);
                    *(LAS bf16*)(Qx + t * 272 + dk * 2) = f2bf(qv * __expf(bb[tt]) * 0.08838834764831845f);
                    *(LAS bf16*)(Ki + t * 272 + dk * 2) = f2bf(kv * __expf(-bb[tt])); }
            } else {
                if (wave == 0) {
                    const float ig = bf1(s.P[(size_t)(rowbase + lane) * NINP + 6144 + dir * 8 + head]) + s.mgb[dir * 8 + head];
                    const float fg = bf1(s.P[(size_t)(rowbase + lane) * NINP + 6144 + dir * 8 + 4 + head]) + s.mgb[dir * 8 + 4 + head];
                    const float lf = logsig_f(fg), bcs = wave_scan_sum(lf, dir, lane);
                    const float uu = ig - bcs, pm = wave_scan_max(uu, dir, lane), min_ = s.MINp[cc], Mt = fmaxf(min_, pm);
                    us[lane] = uu; Mts[lane] = Mt; wint[lane] = __expf(min_ - Mt); thr[lane] = __expf(-bcs - Mt);
                }
                __syncthreads();
                { const int t = tid & 63, part = tid >> 6; float acc = 0.f;
                  const float wi = wint[t];
#pragma unroll
                  for (int hh = 0; hh < 2; ++hh) { float qv[8], ov[8]; unpack8(*(LAS const v4u*)(Qi + t * 272 + (part * 16 + 8 * hh) * 2), qv);
                      const f32x4 n0 = *(const f32x4*)(s.NIN + cc * 128 + part * 16 + 8 * hh), n1 = *(const f32x4*)(s.NIN + cc * 128 + part * 16 + 8 * hh + 4);
                      acc += (qv[0] * n0.x + qv[1] * n0.y) + (qv[2] * n0.z + qv[3] * n0.w) + (qv[4] * n1.x + qv[5] * n1.y) + (qv[6] * n1.z + qv[7] * n1.w);
#pragma unroll
                      for (int e = 0; e < 8; ++e) ov[e] = qv[e] * wi;
                      *(LAS v4u*)(Qx + t * 272 + (part * 16 + 8 * hh) * 2) = pack8(ov); }
                  qnp[part * 64 + t] = acc; }
            }
            __syncthreads();
            if (MODE == 1 && tid < 64) { float q = 0.f;
#pragma unroll
                for (int p = 0; p < 8; ++p) q += qnp[p * 64 + tid];
                qn[tid] = q; }
            if (wave < 4) {
                const int ti = wave >> 1, tj = wave & 1; f32x16 acc = zero16();
#pragma unroll
                for (int ks = 0; ks < 8; ++ks) { const bf16x8 af = frag_row(MODE ? Qi : Qx, 272, 32 * ti, 16 * ks, lane), bfr = frag_row(Ki, 272, 32 * tj, 16 * ks, lane); acc = MFMA32(af, bfr, acc); }
                const int sidx = 32 * tj + (lane & 31);
                const float usv = MODE ? us[sidx] : 0.f;
#pragma unroll
                for (int r = 0; r < 16; ++r) { const int t = 32 * ti + (r & 3) + 8 * (r >> 2) + 4 * (lane >> 5);
                    const bool keep = dir == 0 ? (sidx <= t) : (sidx >= t);
                    float v = acc[r];
                    if (MODE == 1) v *= __expf(usv - Mts[t]);
                    v = keep ? v : 0.f;
                    *(LAS bf16*)(Am + t * 144 + sidx * 2) = f2bf(v);
                    if (MODE == 1) { float rsum = v; rsum += __shfl_xor(rsum, 1); rsum += __shfl_xor(rsum, 2); rsum += __shfl_xor(rsum, 4); rsum += __shfl_xor(rsum, 8); rsum += __shfl_xor(rsum, 16);
                        if ((lane & 31) == 0) rs[tj * 64 + t] = rsum; } }
            }
            __syncthreads();
            if (MODE == 1 && tid < 64) { const float den = wint[tid] * qn[tid] + rs[tid] + rs[64 + tid]; fac[tid] = 1.f / fmaxf(fabsf(den), thr[tid]); }
            f32x16 acc2[2]; acc2[0] = zero16(); acc2[1] = zero16();
            { const bf16* Sg = s.SSTp + cc * 32768 + (size_t)(32 * wave + (lane & 31)) * 128 + 8 * (lane >> 5);
#pragma unroll
              for (int ks = 0; ks < 8; ++ks) { const bf16x8 bfr = *(const bf16x8*)(Sg + 16 * ks);
#pragma unroll
                  for (int rt = 0; rt < 2; ++rt) { const bf16x8 af = frag_row(Qx, 272, 32 * rt, 16 * ks, lane); acc2[rt] = MFMA32(af, bfr, acc2[rt]); } } }
#pragma unroll
            for (int ks = 0; ks < 4; ++ks) { const bf16x8 bfr = frag_tr(Vs, 528, 16 * ks, 32 * wave, lane);
#pragma unroll
                for (int rt = 0; rt < 2; ++rt) { const bf16x8 af = frag_row(Am, 144, 32 * rt, 16 * ks, lane); acc2[rt] = MFMA32(af, bfr, acc2[rt]); } }
            __syncthreads();
#pragma unroll
            for (int rt = 0; rt < 2; ++rt)
#pragma unroll
                for (int r = 0; r < 16; ++r) { const int t = 32 * rt + (r & 3) + 8 * (r >> 2) + 4 * (lane >> 5); hsum[rt][r] += acc2[rt][r] * fac[t]; }
        }
        __syncthreads();
#pragma unroll
        for (int rt = 0; rt < 2; ++rt)
#pragma unroll
            for (int r = 0; r < 16; ++r) { const int t = 32 * rt + (r & 3) + 8 * (r >> 2) + 4 * (lane >> 5); Os[t * 260 + 32 * wave + (lane & 31)] = hsum[rt][r]; }
        __syncthreads();
        { const int t = tid >> 3, part = tid & 7; float o[32]; float ss = 0.f;
#pragma unroll
          for (int j = 0; j < 8; ++j) { const f32x4 v = *(LAS const f32x4*)(Os + t * 260 + 32 * part + 4 * j); o[4 * j] = v.x; o[4 * j + 1] = v.y; o[4 * j + 2] = v.z; o[4 * j + 3] = v.w; ss += (v.x * v.x + v.y * v.y) + (v.z * v.z + v.w * v.w); }
          ss += __shfl_xor(ss, 1); ss += __shfl_xor(ss, 2); ss += __shfl_xor(ss, 4);
          const float rn = rsqrtf(ss * (1.f / 256.f) + EPS);
          const size_t row = (size_t)(rowbase + t);
          const bf16* gsrc = s.P + row * NINP + (MODE ? 5120 : 2048) + head * 256 + 32 * part;
          bf16* dst = s.MIX + row * DM + (MODE ? 1024 : 0) + head * 256 + 32 * part;
#pragma unroll
          for (int j = 0; j < 4; ++j) { float gv[8], ov[8]; unpack8(*(const v4u*)(gsrc + 8 * j), gv);
#pragma unroll
              for (int e = 0; e < 8; ++e) { const float gt = MODE ? sigmoid_f(gv[e]) : silu_f(gv[e]); ov[e] = o[8 * j + e] * rn * s.ng[32 * part + 8 * j + e] * gt; }
              *(v4u*)(dst + 8 * j) = pack8(ov); } }
        __syncthreads();
    }
}

__device__ __forceinline__ void glds16(const void* sbase  , unsigned voff  , unsigned lds_dst  ) { unsigned keep;
    asm volatile("s_mov_b32 %0, m0\n\ts_mov_b32 m0, %3\n\ts_nop 0\n\tglobal_load_lds_dwordx4 %1, %2\n\ts_mov_b32 m0, %0" : "=&s"(keep) : "v"(voff), "s"(sbase), "s"(lds_dst) : "memory"); }
struct AttnP { const bf16* QR; const bf16* KR; const bf16* P; bf16* MIX; const float* lamp; const float* subg; const float* qg; const float* kg; float lam_init; unsigned* queue; };
template <bool SUB>
__device__ __forceinline__ void ph_attn(const AttnP& p, LAS unsigned char* lds, int tid, int lane, int wave, int bid, int G) {
    const float l01 = wave_sum(p.lamp[lane] * p.lamp[64 + lane]), l23 = wave_sum(p.lamp[128 + lane] * p.lamp[192 + lane]);
    const float lam = __expf(l01) - __expf(l23) + p.lam_init;
    const float negm2 = -8.f * wave_max(fabsf(p.qg[lane])) * wave_max(fabsf(p.kg[lane])) * 1.4426950408889634f * 1.02f;
    const int r = lane & 31, h = lane >> 5, mp = wave >> 2, wq = wave & 3;
    LAS float* Ex = (LAS float*)lds;
    const unsigned xcc = xb_xcc_id() & 7u;
    volatile LAS int* qslot = (volatile LAS int*)(lds + MISC_OFF + 96);
    for (int qq = 0; qq < 8; ++qq) for (;;) {
        const int hd = (int)((xcc + (unsigned)qq) & 7u);
        if (tid == 0) qslot[0] = (int)__hip_atomic_fetch_add(p.queue + 16 * hd, 1u, __ATOMIC_RELAXED, __HIP_MEMORY_SCOPE_AGENT);
        __syncthreads();
        const int idx = qslot[0];
        __syncthreads();
        if (idx >= 68) break;
        int b, qrow0, nkt;
        if (idx < 64) { b = idx >> 5; qrow0 = b * 4096 + 128 * (idx & 31); nkt = 68; }
        else { const int uu = idx - 64; b = uu >> 1; qrow0 = NLATR + b * 256 + 128 * (uu & 1); nkt = 4; }
        const int qrow = qrow0 + 32 * wq + r;
        bf16x8 Qf[4];
#pragma unroll
        for (int ks = 0; ks < 4; ++ks) Qf[ks] = *(const bf16x8*)(p.QR + (size_t)qrow * 1024 + (hd * 2 + mp) * 64 + 16 * ks + 8 * h);
        f32x16 O[4];
#pragma unroll
        for (int dt = 0; dt < 4; ++dt) O[dt] = zero16();
        float ls = 0.f;
        const int dq = lane >> 4, dp = lane & 15;
        unsigned voffK[4], voffV[4];
#pragma unroll
        for (int j = 0; j < 4; ++j) { const unsigned ch = 16u * (unsigned)(dp ^ ((dq << 2) | j)); voffK[j] = (unsigned)dq * 2048u + ch; voffV[j] = (unsigned)dq * (unsigned)(NINP * 2) + ch; }
        int kaddr[4], vaddr[2][4];
#pragma unroll
        for (int ks = 0; ks < 4; ++ks) kaddr[ks] = swz_off(r, 8 * mp + 2 * ks + h);
        { const int blk = (lane >> 4) & 1, q = (lane & 15) >> 2, pp = lane & 3;
#pragma unroll
          for (int e = 0; e < 2; ++e)
#pragma unroll
              for (int dt = 0; dt < 4; ++dt) vaddr[e][dt] = swz_off(4 * h + q + 8 * e, 4 * dt + 2 * blk + (pp >> 1)) + 8 * (pp & 1); }
        const int nkt2 = nkt >> 1;
        const unsigned ldsb = (unsigned)(size_t)lds;
#define AT_DMA(kt_, buf_) do { const int krow_ = (kt_) < 2 ? NLATR + b * 256 + 128 * (kt_) : b * 4096 + 128 * ((kt_) - 2); \
            _Pragma("unroll") for (int j = 0; j < 4; ++j) { const int g_ = 4 * wave + j, row_ = krow_ + 4 * g_; \
                glds16(p.KR + (size_t)row_ * 1024 + hd * 128, voffK[j], (unsigned)__builtin_amdgcn_readfirstlane((int)(ldsb + (buf_) * 32768 + 1024 * g_))); \
                glds16(p.P + (size_t)row_ * NINP + 2048 + hd * 128, voffV[j], (unsigned)__builtin_amdgcn_readfirstlane((int)(ldsb + 65536 + (buf_) * 32768 + 1024 * g_))); } } while (0)
#define AT_QK(S_, kb_) do { S_ = zero16(); _Pragma("unroll") for (int ks = 0; ks < 4; ++ks) { const bf16x8 a0 = *(LAS const bf16x8*)(Kt + kaddr[ks] + 8192 * (kb_)); S_ = MFMA32(a0, Qf[ks], S_); } } while (0)
        AT_DMA(0, 0);
        asm volatile("s_waitcnt vmcnt(0)" ::: "memory");
        __syncthreads();
        for (int kt = 0; kt < nkt2; ++kt) {
            const bool more = kt + 1 < nkt2;
            if (more) AT_DMA(kt + 1, (kt + 1) & 1);
            LAS const unsigned char* Kt = lds + (kt & 1) * 32768; LAS const unsigned char* Vt = lds + 65536 + (kt & 1) * 32768;
#define AT_VF(dst_, kb_, dt_) do { const s16x4 t0_ = tr4(Vt + vaddr[0][dt_] + 8192 * (kb_)), t1_ = tr4(Vt + vaddr[1][dt_] + 8192 * (kb_)), t2_ = tr4(Vt + vaddr[0][dt_] + 8192 * (kb_) + 4096), t3_ = tr4(Vt + vaddr[1][dt_] + 8192 * (kb_) + 4096); \
                dst_[0] = (bf16x8){t0_[0], t0_[1], t0_[2], t0_[3], t1_[0], t1_[1], t1_[2], t1_[3]}; dst_[1] = (bf16x8){t2_[0], t2_[1], t2_[2], t2_[3], t3_[0], t3_[1], t3_[2], t3_[3]}; } while (0)
            bf16x8 kf[4], P0, P1;
#pragma unroll
            for (int ks = 0; ks < 4; ++ks) kf[ks] = *(LAS const bf16x8*)(Kt + kaddr[ks]);
            { f32x16 S0 = zero16();
#pragma unroll
              for (int ks = 0; ks < 4; ++ks) S0 = MFMA32(kf[ks], Qf[ks], S0);
#pragma unroll
              for (int ks = 0; ks < 4; ++ks) kf[ks] = *(LAS const bf16x8*)(Kt + kaddr[ks] + 8192);
              unsigned pf[8]; float lacc = 0.f;
#pragma unroll
              for (int i = 0; i < 8; ++i) { const float e0 = __builtin_amdgcn_exp2f(SUB ? S0[2 * i] + negm2 : S0[2 * i]), e1 = __builtin_amdgcn_exp2f(SUB ? S0[2 * i + 1] + negm2 : S0[2 * i + 1]); lacc += e0 + e1; pf[i] = pk2(e0, e1); }
              ls += lacc;
              P0 = __builtin_bit_cast(bf16x8, (v4u){pf[0], pf[1], pf[2], pf[3]}); P1 = __builtin_bit_cast(bf16x8, (v4u){pf[4], pf[5], pf[6], pf[7]}); }
            __builtin_amdgcn_sched_barrier(0);
#pragma unroll
            for (int kb = 0; kb < 4; ++kb) {
                bf16x8 v0[2], v1[2], v2[2], v3[2];
                AT_VF(v0, kb, 0); AT_VF(v1, kb, 1); AT_VF(v2, kb, 2); AT_VF(v3, kb, 3);
                f32x16 Sn = zero16();
                if (kb < 3) {
#pragma unroll
                    for (int ks = 0; ks < 4; ++ks) Sn = MFMA32(kf[ks], Qf[ks], Sn);
                    if (kb < 2) {
#pragma unroll
                        for (int ks = 0; ks < 4; ++ks) kf[ks] = *(LAS const bf16x8*)(Kt + kaddr[ks] + 8192 * (kb + 2)); } }
                O[0] = MFMA32(v0[0], P0, O[0]); O[0] = MFMA32(v0[1], P1, O[0]); O[1] = MFMA32(v1[0], P0, O[1]); O[1] = MFMA32(v1[1], P1, O[1]);
                O[2] = MFMA32(v2[0], P0, O[2]); O[2] = MFMA32(v2[1], P1, O[2]); O[3] = MFMA32(v3[0], P0, O[3]); O[3] = MFMA32(v3[1], P1, O[3]);
                if (kb < 3) {
                    unsigned pf[8]; float lacc = 0.f;
#pragma unroll
                    for (int i = 0; i < 8; ++i) { const float e0 = __builtin_amdgcn_exp2f(SUB ? Sn[2 * i] + negm2 : Sn[2 * i]), e1 = __builtin_amdgcn_exp2f(SUB ? Sn[2 * i + 1] + negm2 : Sn[2 * i + 1]); lacc += e0 + e1; pf[i] = pk2(e0, e1); }
                    ls += lacc;
                    P0 = __builtin_bit_cast(bf16x8, (v4u){pf[0], pf[1], pf[2], pf[3]}); P1 = __builtin_bit_cast(bf16x8, (v4u){pf[4], pf[5], pf[6], pf[7]});
                    __builtin_amdgcn_sched_group_barrier(0x100, 20, 0); __builtin_amdgcn_sched_group_barrier(0x008, 6, 0);
#pragma unroll
                    for (int gI = 0; gI < 6; ++gI) { __builtin_amdgcn_sched_group_barrier(0x002, 8, 0); __builtin_amdgcn_sched_group_barrier(0x008, 1, 0); }
                }
                __builtin_amdgcn_sched_barrier(0);
            }
#undef AT_VF
            asm volatile("s_waitcnt vmcnt(0)" ::: "memory");
            __syncthreads();
        }
#undef AT_DMA
#undef AT_QK
        const float l = ls + __shfl_xor(ls, 32);
        if (mp == 1) { const float sc = lam / l;
#pragma unroll
            for (int dt = 0; dt < 4; ++dt)
#pragma unroll
                for (int i = 0; i < 16; ++i) Ex[(32 * wq + r) * 132 + 32 * dt + (i & 3) + 8 * (i >> 2) + 4 * h] = O[dt][i] * sc; }
        __syncthreads();
        if (mp == 0) { const float a0 = 1.f / l; float ss = 0.f;
#pragma unroll
            for (int dt = 0; dt < 4; ++dt)
#pragma unroll
                for (int i = 0; i < 16; ++i) { const float v = O[dt][i] * a0 - Ex[(32 * wq + r) * 132 + 32 * dt + (i & 3) + 8 * (i >> 2) + 4 * h]; O[dt][i] = v; ss += v * v; }
            ss += __shfl_xor(ss, 32);
            const float rn = rsqrtf(ss * (1.f / 128.f) + EPS) * (1.f - p.lam_init);
            int qrow2 = qrow0 + 32 * wq + r; asm volatile("" : "+v"(qrow2));
            bf16* dst = p.MIX + (size_t)qrow2 * DM + hd * 128;
#pragma unroll
            for (int dt = 0; dt < 4; ++dt)
#pragma unroll
                for (int g4 = 0; g4 < 4; ++g4) { const int dv0 = 32 * dt + 8 * g4 + 4 * h; const f32x4 sg = *(const f32x4*)(p.subg + dv0);
                    v2u o; o.x = pk2(O[dt][4 * g4] * rn * sg.x, O[dt][4 * g4 + 1] * rn * sg.y); o.y = pk2(O[dt][4 * g4 + 2] * rn * sg.z, O[dt][4 * g4 + 3] * rn * sg.w);
                    *(v2u*)(dst + dv0) = o; } }
        __syncthreads();
    }
}

#ifndef PHASE_MASK
#define PHASE_MASK 0xFFFFFFu
#endif
#define PM(j) ((PHASE_MASK >> (j)) & 1u)
#ifndef REP_MASK
#define REP_MASK 0u
#endif
#define REPS(j) ((((REP_MASK) >> (j)) & 1u) ? 2 : 1)
#define PH_BEGIN(j, k) if (PM(j) && IN(k)) for (int rep_ = 0; rep_ < REPS(j); ++rep_) { if (rep_) xcd_barrier(bar);
#define PH_END }
#define PHASE_BEGIN int wave = wave0, bid = bid0, G = G0, zz_ = 0; asm volatile("" : "+s"(wave), "+s"(bid), "+s"(G), "+s"(zz_)); const int lane = (int)__builtin_amdgcn_mbcnt_hi(~0u, __builtin_amdgcn_mbcnt_lo(~0u, (unsigned)zz_)), tid = wave * 64 + lane; \
    unsigned char* ws = ws0; asm volatile("" : "+s"(ws)); const __attribute__((address_space(4))) Args* ap_ = (const __attribute__((address_space(4))) Args*)__builtin_amdgcn_kernarg_segment_ptr(); asm volatile("" : "+s"(ap_)); const Args& a = *(const Args*)ap_; (void)a; const int gw = bid * NWAVES + wave, NGW = G * NWAVES, gtid = bid * NTHR + tid, NT = G * NTHR; (void)gw; (void)NGW; (void)gtid; (void)NT; (void)lane;
__device__ __forceinline__ void fill_scanp(ScanP& sp, const Args& a, unsigned char* ws, int li, bool even) {
    sp.P = (const bf16*)(ws + WS_P); sp.MQK = (const bf16*)(ws + WS_MQK); sp.MIX = (bf16*)(ws + WS_MIX);
    sp.gw2 = a.in[10] + (size_t)li * 2 * 16 * 512; sp.gb = a.in[11] + (size_t)li * 2 * 512; sp.mgb = a.in[21] + (size_t)li * 16;
    sp.ng = even ? a.in[12] + (size_t)li * 256 : a.in[22] + (size_t)li * 256;
    sp.DSTp = (bf16*)(ws + WS_DST); sp.SSTp = (bf16*)(ws + WS_SST); sp.GAM = (float*)(ws + WS_SM + SM_GAM); sp.DN = (float*)(ws + WS_SM + SM_DN); sp.NIN = (float*)(ws + WS_SM + SM_NIN);
    sp.BL = (float*)(ws + WS_SM + SM_BL); sp.ML = (float*)(ws + WS_SM + SM_ML); sp.MINp = (float*)(ws + WS_SM + SM_MIN);
}
__global__ void __launch_bounds__(NTHR, 2) fwd_kernel(Args a) {
    extern __shared__ __attribute__((aligned(16))) unsigned char lds_raw[];
    LAS unsigned char* lds = (LAS unsigned char*)lds_raw;
    const int tid0 = threadIdx.x, wave0 = __builtin_amdgcn_readfirstlane(tid0 >> 6), bid0 = blockIdx.x, G0 = gridDim.x;
    unsigned char* ws0 = a.ws;
    volatile LAS unsigned* MISC = (volatile LAS unsigned*)(lds + MISC_OFF);
    if (tid0 < 32) MISC[tid0] = 0u;
    __syncthreads();
    XcdBarrier bar = xcd_barrier_post((unsigned*)(ws0 + WS_CTL) + CW_BAR + a.li * XCD_BAR_WORDS, MISC + 8, (unsigned)wave0);
    const int lo = a.ph_lo, hi = a.ph_hi;
#define IN(k) (lo <= (k) && (k) < hi)
#ifndef TMASK
#define TMASK 0u
#endif
#ifndef LMASK
#define LMASK 0xFu
#endif
    volatile LAS unsigned long long* tst_ = (volatile LAS unsigned long long*)(lds + MISC_OFF + 64);
    if (TMASK && tid0 == 0) { tst_[0] = __builtin_amdgcn_s_memrealtime(); tst_[1] = 0ull; }
#define SEAM2(k, kk, ll) do { if (IN(k) && IN((k) + 1)) xcd_barrier(bar); if (TMASK && wave0 == 0 && xb_lane() == 0u) { const unsigned long long now_ = __builtin_amdgcn_s_memrealtime(); if (((TMASK >> (kk)) & 1u) && ((LMASK >> (ll)) & 1u)) tst_[1] += now_ - tst_[0]; tst_[0] = now_; } } while (0)
#define SEAM(k) SEAM2(k, (k) == 0 ? 11 : ((k) - 1) % PPL, (k) == 0 ? 0 : ((k) - 1) / PPL)

    PH_BEGIN(11, 0) PHASE_BEGIN; ph_prologue(a, ws, lds, tid, lane, wave, bid, G); PH_END
    SEAM(0);
    for (int layer = 0; layer < NLAYERS; ++layer) {
        const int pb = 1 + layer * PPL, li = layer >> 1; const bool even = (layer & 1) == 0;
        const size_t mod_off = WS_MOD + (size_t)layer * 3 * 12288 * 4;
        const size_t wb_off = WS_W + (size_t)layer * W_LAYER;

        PH_BEGIN(0, pb + 0) PHASE_BEGIN; const float* mod = (const float*)(ws + mod_off); float* ssq = (float*)(ws + WS_SSQ) + (size_t)(2 * layer) * MR;
            if (layer == 0) ph_norm0(a.in[0], a.in[2], (float*)(ws + WS_XS), a.in[6], mod + 1 * DM, (bf16*)(ws + WS_H), ssq, gw, NGW, lane);
            else ph_ctxfix<11>((float*)(ws + WS_XS), (const float*)(ws + WS_DST), mod - 3 * 12288 + 2 * 12288 + 5 * DM, a.in[6] + (size_t)layer * DM, mod + 1 * DM, (bf16*)(ws + WS_H), ssq, gw, NGW, lane);
            { PHASE_BEGIN; const float* mod2 = (const float*)(ws + mod_off); ph_bias((const bf16*)(ws + wb_off), (const bf16*)(ws + wb_off + W_UP), mod2, (float*)(ws + WS_B1) + (size_t)layer * 3 * NINP, (float*)(ws + WS_B2) + (size_t)layer * 3 * NUP, gw, NGW, lane); } }
        SEAM(pb + 0);
        PH_BEGIN(1, pb + 1) PHASE_BEGIN; pg8::Gemm g{(const bf16*)(ws + WS_H), (const bf16*)(ws + wb_off), MR, NINP, DM}; pg8::StaticOrder S; S.init(MR, NINP, G, bid); pg8::EpiStore E{(bf16*)(ws + WS_P), NINP, (const float*)(ws + WS_SSQ) + (size_t)(2 * layer) * MR, (const float*)(ws + WS_B1) + (size_t)layer * 3 * NINP, NINP};
            pg8::gemm_phase<pg8::EpiStore, pg8::StaticOrder, true, true>(lds, g, S, E, wave);
            if (layer + 1 < NLAYERS && G == 256 && bid >= 82) { __syncthreads(); ph_convert(a, ws, lds, (layer + 1) * 25344, (layer + 2) * 25344, (bid - 82) * NWAVES + wave, 174 * NWAVES, wave, lane); }
            else if (layer + 1 < NLAYERS && G != 256) { __syncthreads(); ph_convert(a, ws, lds, (layer + 1) * 25344, (layer + 2) * 25344, bid * NWAVES + wave, G * NWAVES, wave, lane); } }
        SEAM(pb + 1);
        PH_BEGIN(2, pb + 2)
            if (even) {
                if (PM(12)) { PHASE_BEGIN; ph_conv<1>((const bf16*)(ws + WS_P), a.in[13] + (size_t)li * 3 * 1024, nullptr, (bf16*)(ws + WS_MIX), gtid, NT); }
                if (PM(13)) { PHASE_BEGIN; ScanP sp; fill_scanp(sp, a, ws, li, even); ph_gla_local(sp, (bf16*)(ws + WS_QR), (bf16*)(ws + WS_KR), lds, tid, lane, wave, bid, G); }
            } else {
                if (PM(14)) { PHASE_BEGIN; ph_qkprep((const bf16*)(ws + WS_P), a.in[16] + (size_t)li * 64, a.in[17] + (size_t)li * 64, (const float*)(ws + WS_ROPE), (bf16*)(ws + WS_QR), (bf16*)(ws + WS_KR), gw, NGW, lane); }
                if (PM(15)) { PHASE_BEGIN; ph_conv<2>((const bf16*)(ws + WS_P), a.in[20] + (size_t)li * 3 * 1024, nullptr, (bf16*)(ws + WS_MQK), gtid, NT); }
            }
        }
        SEAM(pb + 2);
        PH_BEGIN(3, pb + 3) if (!even) { PHASE_BEGIN; ScanP sp; fill_scanp(sp, a, ws, li, even); ph_mlstm_local(sp, lds, tid, lane, wave, bid, G); } }
        if (!even) SEAM(pb + 3);
        PH_BEGIN(4, pb + 4) PHASE_BEGIN; ScanP sp; fill_scanp(sp, a, ws, li, even); if (even) ph_scan_carry<0>(sp, gtid, NT); else ph_scan_carry<1>(sp, gtid, NT); }
        SEAM(pb + 4);
        PH_BEGIN(5, pb + 5)
            if (even) { if (PM(16)) { PHASE_BEGIN; ScanP sp; fill_scanp(sp, a, ws, li, even); ph_gla_out(sp, (const bf16*)(ws + WS_QR), (const bf16*)(ws + WS_KR), lds, tid, lane, wave, bid, G); } }
            else {
                if (PM(17)) { PHASE_BEGIN; AttnP ap{(const bf16*)(ws + WS_QR), (const bf16*)(ws + WS_KR), (const bf16*)(ws + WS_P), (bf16*)(ws + WS_MIX), a.in[18] + (size_t)li * 256, a.in[19] + (size_t)li * 128, a.in[16] + (size_t)li * 64, a.in[17] + (size_t)li * 64, 0.8f - 0.6f * expf(-0.3f * (float)layer), (unsigned*)(ws + 32768 + 1024 * li)};
                    const float bound = 8.f * wave_max(fabsf(ap.qg[lane])) * wave_max(fabsf(ap.kg[lane])) * 1.4426950408889634f;
                    if (bound < 60.f) ph_attn<false>(ap, lds, tid, lane, wave, bid, G); else ph_attn<true>(ap, lds, tid, lane, wave, bid, G);
                    if (TMASK && wave0 == 0 && xb_lane() == 0u) { const unsigned long long now_ = __builtin_amdgcn_s_memrealtime(); if (((TMASK >> 12) & 1u) && ((LMASK >> layer) & 1u)) tst_[1] += now_ - tst_[0]; tst_[0] = now_; } }
                if (PM(18)) { PHASE_BEGIN; ScanP sp; fill_scanp(sp, a, ws, li, even); ph_mlstm_out(sp, lds, tid, lane, wave, bid, G); }
            }
        }
        SEAM(pb + 5);
        PH_BEGIN(6, pb + 6) PHASE_BEGIN; pg8::Gemm g{(const bf16*)(ws + WS_MIX), (const bf16*)(ws + wb_off + W_OUT), MR, DM, DM}; pg8::ResidOrder S; S.init(G, bid, layer < NLAYERS - 1 ? 8 : 0, 256);
            pg8::EpiResid2 E{(float*)(ws + WS_XS), (const float*)(ws + mod_off) + 2 * DM, nullptr, (float*)(ws + WS_DST), 0, 256, rep_,
                (bf16*)(ws + WS_H), a.in[7] + (size_t)layer * DM, (const float*)(ws + mod_off) + 4 * DM, (float*)(ws + WS_SSQ) + (size_t)(2 * layer + 1) * MR};
            pg8::gemm_phase<pg8::EpiResid2, pg8::ResidOrder, true, true>(lds, g, S, E, wave); }
        SEAM(pb + 6);
        PH_BEGIN(7, pb + 7) PHASE_BEGIN; const float* mod = (const float*)(ws + mod_off);
            if (layer < NLAYERS - 1) ph_ctxfix<8>((float*)(ws + WS_XS), (const float*)(ws + WS_DST), mod + 2 * 12288 + 2 * DM, a.in[7] + (size_t)layer * DM, mod + 4 * DM, (bf16*)(ws + WS_H), (float*)(ws + WS_SSQ) + (size_t)(2 * layer + 1) * MR, gw, NGW, lane); }
        if (layer < NLAYERS - 1) SEAM(pb + 7);
        PH_BEGIN(8, pb + 8) PHASE_BEGIN; pg8::Gemm g{(const bf16*)(ws + WS_H), (const bf16*)(ws + wb_off + W_UP), MR, NUP, DM}; pg8::StaticOrder S; S.init(MR, NUP, G, bid);
            pg8::EpiAct E{(bf16*)(ws + WS_ACT), a.in[24] + (size_t)layer * 3 * DFF, a.in[25] + (size_t)layer * DFF, (float*)(ws + WS_U), (LAS float*)(lds + 131584), (const float*)(ws + WS_SSQ) + (size_t)(2 * layer + 1) * MR, (const float*)(ws + WS_B2) + (size_t)layer * 3 * NUP, 0};
            pg8::gemm_phase<pg8::EpiAct, pg8::StaticOrder, true, true>(lds, g, S, E, wave); }
        SEAM(pb + 8);
        PH_BEGIN(10, pb + 10)
            { PHASE_BEGIN; pg8::ResidOrder S0; S0.init(G, bid, layer < NLAYERS - 1 ? 11 : 0, 512); pg8::Unit uu_;
#pragma unroll 1
              for (int i_ = 0; S0.next(i_, uu_); ++i_) act_fix_tile((const float*)(ws + WS_U), a.in[24] + (size_t)layer * 3 * DFF, (bf16*)(ws + WS_ACT), uu_.pm, tid);
              asm volatile("s_waitcnt vmcnt(0)" ::: "memory"); __syncthreads(); }
            PHASE_BEGIN; pg8::Gemm g{(const bf16*)(ws + WS_ACT), (const bf16*)(ws + wb_off + W_DN), MR, DM, DFF}; pg8::ResidOrder S; S.init(G, bid, layer < NLAYERS - 1 ? 11 : 0, 512);
            pg8::EpiResid2 E{(float*)(ws + WS_XS), (const float*)(ws + mod_off) + 5 * DM, a.out, (float*)(ws + WS_DST), layer == NLAYERS - 1 ? 1 : 0, 512, rep_,
                layer < NLAYERS - 1 ? (bf16*)(ws + WS_H) : nullptr, a.in[6] + (size_t)(layer + 1) * DM, (const float*)(ws + mod_off) + 3 * 12288 + 1 * DM, (float*)(ws + WS_SSQ) + (size_t)(2 * layer + 2) * MR};
            pg8::gemm_phase<pg8::EpiResid2, pg8::ResidOrder, true, true>(lds, g, S, E, wave); }
        if (layer < NLAYERS - 1) SEAM(pb + 10); else if (TMASK && wave0 == 0 && xb_lane() == 0u) { const unsigned long long now_ = __builtin_amdgcn_s_memrealtime(); if (((TMASK >> 10) & 1u) && ((LMASK >> layer) & 1u)) tst_[1] += now_ - tst_[0]; tst_[0] = now_; }
    }
    if (TMASK) { __syncthreads(); const unsigned long long tacc_ = tst_[1], t0_ = __builtin_amdgcn_s_memrealtime(); while (__builtin_amdgcn_s_memrealtime() - t0_ < tacc_) __builtin_amdgcn_s_sleep(8); }
#undef IN
#undef SEAM
}

extern "C" void kernel_launch(void* const* d_in, const int* in_sizes, int n_in, void* d_out, int out_size, void* d_ws, size_t ws_size, hipStream_t stream) {
    static int grid = 0;
    if (grid == 0) {
        int dev = 0, cus = 0;
        if (n_in != 27 || out_size != NLATR * DM || ws_size < WS_END) { fprintf(stderr, "kernel_launch: unexpected problem (n_in %d out %d ws %zu)\n", n_in, out_size, ws_size); grid = -1; return; }
        if (hipGetDevice(&dev) != hipSuccess || hipDeviceGetAttribute(&cus, hipDeviceAttributeMultiprocessorCount, dev) != hipSuccess) { grid = -1; return; }
        if (hipFuncSetAttribute((const void*)fwd_kernel, hipFuncAttributeMaxDynamicSharedMemorySize, LDS_BYTES) != hipSuccess) { fprintf(stderr, "kernel_launch: hipFuncSetAttribute failed\n"); grid = -1; return; }
        int per_cu = 0;
        if (hipOccupancyMaxActiveBlocksPerMultiprocessor(&per_cu, (const void*)fwd_kernel, NTHR, LDS_BYTES) != hipSuccess || per_cu < 1) fprintf(stderr, "kernel_launch: occupancy query reports %d\n", per_cu);
        (void)hipGetLastError();
        grid = cus;
    }
    if (grid < 0) return;
    (void)hipMemsetAsync((char*)d_ws + WS_CTL, 0, CTL_BYTES, stream);
    Args a{};
    for (int i = 0; i < 27; ++i) a.in[i] = (const float*)d_in[i];
    a.out = (float*)d_out; a.ws = (unsigned char*)d_ws; a.pad = 0;
#if ONE_LAUNCH
    a.ph_lo = 0; a.ph_hi = 1 + NLAYERS * PPL; a.li = 0;
    hipLaunchKernelGGL(fwd_kernel, dim3(grid), dim3(NTHR), LDS_BYTES, stream, a);
#else
    for (int p = 0; p < 1 + NLAYERS * PPL; ++p) {
        const int k = p == 0 ? 0 : (p - 1) % PPL, layer = p == 0 ? 0 : (p - 1) / PPL;
        if (p > 0 && k == 3 && (layer & 1) == 0) continue;
        a.ph_lo = p; a.ph_hi = p + 1; a.li = p;
        hipLaunchKernelGGL(fwd_kernel, dim3(grid), dim3(NTHR), LDS_BYTES, stream, a);
    }
#endif
}
```

```cpp
#include <hip/hip_runtime.h>
#include <cstdio>
#include <cstdint>
namespace pg8 {
#define PG8_LAS __attribute__((address_space(3)))
typedef unsigned short bf16_t;
typedef short bf16x8 __attribute__((ext_vector_type(8)));
typedef float f32x4 __attribute__((ext_vector_type(4)));
typedef unsigned u32x4 __attribute__((ext_vector_type(4)));
constexpr int BM = 256, BK = 64, HALF = 128, HTB = HALF * BK * 2  , STAGE_BYTES = 8 * HTB, NXCD = 8, WGM = 8;

__host__ __device__ __forceinline__ int lds_byte(int r, int c) { const int st = (r >> 4) * 2 + (c >> 5), rr = r & 15, cc = c & 31, ob = rr * 64 + cc * 2; return st * 1024 + (ob ^ (((ob >> 9) & 1) << 5)); }
__host__ __device__ __forceinline__ void stage_rc(int b, int& R, int& C) { const int st = b / 1024, sb = b % 1024, swz = sb ^ (((sb >> 9) & 1) << 5); R = (st >> 1) * 16 + swz / 64; C = (st & 1) * 32 + (swz % 64) / 2; }
__host__ __device__ __forceinline__ int perm32(int rho) { const int n = rho >> 4, i = rho & 15; return 8 * (i >> 2) + 4 * n + (i & 3); }

struct Unit { int pm, pn, k0, nt; };
struct Gemm { const bf16_t* A; const bf16_t* Bt; int M, N, K; };

struct StaticOrder {
    int nM, nN, nwg, G, c;
    __host__ __device__ __forceinline__ void init(int M, int N, int G_, int c_) { nM = M / BM; nN = N / BM; nwg = nM * nN; G = G_; c = c_; }
    __host__ __device__ __forceinline__ bool next(int i, Unit& u) const {
        const long L = (long)i * G + c; if (L >= nwg) return false;
        int wgid = (int)L; { const int q = nwg / NXCD, r = nwg % NXCD, xcd = wgid % NXCD, off = wgid / NXCD; wgid = (xcd < r ? xcd * (q + 1) : r * (q + 1) + (xcd - r) * q) + off; }
        const int nig = WGM * nN, gid = wgid / nig, fm = gid * WGM, gsz = (nM - fm) < WGM ? (nM - fm) : WGM;
        u.pm = fm + ((wgid % nig) % gsz); u.pn = (wgid % nig) / gsz; u.k0 = 0; u.nt = 0; return true;
    }
    __device__ __forceinline__ void a_ready(const Unit&) const {}
    __device__ __forceinline__ void done(const Unit&) const {}
};
__device__ __forceinline__ unsigned cvt_pk_bf16(float lo, float hi) { unsigned r; asm volatile("v_cvt_pk_bf16_f32 %0, %1, %2" : "=v"(r) : "v"(lo), "v"(hi)); return r; }

struct EpiStore {
    static constexpr bool PERM = true, AFTER_DRAIN = false;
    bf16_t* O; int ldc; const float* ssq; const float* bias; int ldb;
    __device__ __forceinline__ void operator()(const f32x4 (&acc)[2][2][4][2], const Unit& u, int wr, int wc, int fr, int fq) const {
        const int row0 = u.pm * BM + wr * 64 + fr, col0 = u.pn * BM + wc * 32 + 8 * fq, mi = u.pm < 32 ? (u.pm >> 4) : 2;
        f32x4 bv[2][2];
#pragma unroll
        for (int bj = 0; bj < 2; ++bj)
#pragma unroll
            for (int n = 0; n < 2; ++n) bv[bj][n] = *(const f32x4*)(bias + (size_t)mi * ldb + col0 + bj * HALF + 4 * n);
#pragma unroll
        for (int ai = 0; ai < 2; ++ai)
#pragma unroll
            for (int m = 0; m < 4; ++m) { const int row = row0 + ai * HALF + m * 16; bf16_t* rowp = O + (size_t)row * ldc + col0;
                const float r = __builtin_amdgcn_rsqf(ssq[row] * (1.f / 2048.f) + 1e-6f);
#pragma unroll
                for (int bj = 0; bj < 2; ++bj) { const f32x4 v0 = acc[ai][bj][m][0] * r + bv[bj][0], v1 = acc[ai][bj][m][1] * r + bv[bj][1];
                    u32x4 w; w.x = cvt_pk_bf16(v0[0], v0[1]); w.y = cvt_pk_bf16(v0[2], v0[3]); w.z = cvt_pk_bf16(v1[0], v1[1]); w.w = cvt_pk_bf16(v1[2], v1[3]);
                    *(u32x4*)(rowp + bj * HALF) = w; } }
    }
};
struct ResidOrder {
    StaticOrder L; int G, c, nsub, ksub;
    __device__ __forceinline__ void init(int G_, int c_, int nsplit, int ksub_) { L.init(8192, 2048, G_, c_); G = G_; c = c_; nsub = 16 * nsplit; ksub = ksub_; }
    __device__ __forceinline__ bool next(int i, Unit& u) const {
        const int nl = c < 256 ? (255 - c) / G + 1 : 0;
        if (i < nl) return L.next(i, u);
        const int s = (i - nl) * G + c; if (s >= nsub) return false;
        const int tile = s & 15, j = s >> 4; u.pm = 32 + (tile >> 3); u.pn = tile & 7; u.k0 = j * ksub; u.nt = ksub / BK; return true;
    }
    __device__ __forceinline__ void a_ready(const Unit&) const {}
    __device__ __forceinline__ void done(const Unit&) const {}
};
struct EpiResid2 {
    static constexpr bool PERM = true, AFTER_DRAIN = false;
    float* X; const float* gate; float* out; float* part; int final_; int ksub; int dry;
    bf16_t* Hn; const float* ngn; const float* scn; float* ssqn;
    __device__ __forceinline__ void operator()(const f32x4 (&acc)[2][2][4][2], const Unit& u, int wr, int wc, int fr, int fq) const {
        const int row0 = u.pm * BM + wr * 64 + fr, col0 = u.pn * BM + wc * 32 + 8 * fq;
        if (u.pm >= 32) {
            float* pb = part + ((size_t)(u.k0 / ksub) * 512 + (row0 - 8192)) * 2048 + col0;
#pragma unroll
            for (int ai = 0; ai < 2; ++ai)
#pragma unroll
                for (int m = 0; m < 4; ++m)
#pragma unroll
                    for (int bj = 0; bj < 2; ++bj)
#pragma unroll
                        for (int n = 0; n < 2; ++n) *(f32x4*)(pb + (size_t)(ai * HALF + m * 16) * 2048 + bj * HALF + 4 * n) = acc[ai][bj][m][n];
            return;
        }
        const int mi = u.pm >> 4;
        f32x4 gv[2][2], av[2][2];
#pragma unroll
        for (int bj = 0; bj < 2; ++bj)
#pragma unroll
            for (int n = 0; n < 2; ++n) { const int c = col0 + bj * HALF + 4 * n; gv[bj][n] = *(const f32x4*)(gate + (size_t)mi * 12288 + c);
                av[bj][n] = Hn ? *(const f32x4*)(ngn + c) * (*(const f32x4*)(scn + (size_t)mi * 12288 + c) + 1.f) : (f32x4){0.f, 0.f, 0.f, 0.f}; }
        if (dry && gv[0][0][0] != 1.2345e30f) return;
#pragma unroll
        for (int ai = 0; ai < 2; ++ai)
#pragma unroll
            for (int m = 0; m < 4; ++m) { const int row = row0 + ai * HALF + m * 16; const size_t ro = (size_t)row * 2048 + col0; const float* xr = X + ro; float* orow = (final_ ? out : X) + ro; float ss = 0.f;
#pragma unroll
                for (int bj = 0; bj < 2; ++bj) {
                    const f32x4 x0 = *(const f32x4*)(xr + bj * HALF) + gv[bj][0] * acc[ai][bj][m][0], x1 = *(const f32x4*)(xr + bj * HALF + 4) + gv[bj][1] * acc[ai][bj][m][1];
                    *(f32x4*)(orow + bj * HALF) = x0; *(f32x4*)(orow + bj * HALF + 4) = x1;
                    if (Hn) { ss += (x0[0] * x0[0] + x0[1] * x0[1]) + (x0[2] * x0[2] + x0[3] * x0[3]) + (x1[0] * x1[0] + x1[1] * x1[1]) + (x1[2] * x1[2] + x1[3] * x1[3]);
                        const f32x4 h0 = x0 * av[bj][0], h1 = x1 * av[bj][1];
                        u32x4 w; w.x = cvt_pk_bf16(h0[0], h0[1]); w.y = cvt_pk_bf16(h0[2], h0[3]); w.z = cvt_pk_bf16(h1[0], h1[1]); w.w = cvt_pk_bf16(h1[2], h1[3]);
                        *(u32x4*)(Hn + ro + bj * HALF) = w; } }
                if (Hn) { ss += __shfl_xor(ss, 16); ss += __shfl_xor(ss, 32); if (fq == 0) (void)__hip_atomic_fetch_add(ssqn + row, ss, __ATOMIC_RELAXED, __HIP_MEMORY_SCOPE_AGENT); } }
    }
};
struct EpiAct {
    static constexpr bool PERM = true, AFTER_DRAIN = false;
    bf16_t* ACT; const float* cw; const float* cb; float* halo; PG8_LAS float* exb; const float* ssq; const float* bias; mutable int par;
    __device__ __forceinline__ void operator()(const f32x4 (&acc)[2][2][4][2], const Unit& u, int wr, int wc, int fr, int fq) const {
        const int lane = fq * 16 + fr, ch0 = wc * 32 + 8 * fq, chg = u.pn * 128 + ch0;
        PG8_LAS float* xb = exb + par * 1024; par ^= 1;
        const int mi = u.pm < 32 ? (u.pm >> 4) : 2;
        const float* bp = bias + (size_t)mi * 11264 + u.pn * BM + ch0;
        float rr[2][4];
#pragma unroll
        for (int ai = 0; ai < 2; ++ai)
#pragma unroll
            for (int m = 0; m < 4; ++m) rr[ai][m] = __builtin_amdgcn_rsqf(ssq[u.pm * BM + ai * HALF + wr * 64 + m * 16 + fr] * (1.f / 2048.f) + 1e-6f);
#pragma unroll
        for (int ai = 0; ai < 2; ++ai) { const int q = ai * 2 + wr;
#pragma unroll
            for (int n = 0; n < 2; ++n) { const f32x4 bg4 = *(const f32x4*)(bp + 4 * n);
                if (fr == 0) *(PG8_LAS f32x4*)(xb + q * 128 + ch0 + 4 * n) = acc[ai][0][0][n] * rr[ai][0] + bg4;
                if (fr == 15) *(PG8_LAS f32x4*)(xb + (4 + q) * 128 + ch0 + 4 * n) = acc[ai][0][3][n] * rr[ai][3] + bg4; } }
        asm volatile("s_waitcnt lgkmcnt(0)" ::: "memory"); __builtin_amdgcn_s_barrier(); asm volatile("" ::: "memory");
        float* hb = halo + (size_t)(u.pm * 44 + u.pn) * 768 + ch0;
#pragma unroll
        for (int n = 0; n < 2; ++n) {
            const f32x4 w0 = *(const f32x4*)(cw + chg + 4 * n), w1 = *(const f32x4*)(cw + 5632 + chg + 4 * n), w2 = *(const f32x4*)(cw + 2 * 5632 + chg + 4 * n), bb = *(const f32x4*)(cb + chg + 4 * n);
            const f32x4 bg = *(const f32x4*)(bp + 4 * n), bvv = *(const f32x4*)(bp + 128 + 4 * n);
#pragma unroll
            for (int ai = 0; ai < 2; ++ai) { const int q = ai * 2 + wr;
                const f32x4 pB = q > 0 ? *(PG8_LAS const f32x4*)(xb + (4 + q - 1) * 128 + ch0 + 4 * n) : (f32x4){0.f, 0.f, 0.f, 0.f};
                const f32x4 nB = q < 3 ? *(PG8_LAS const f32x4*)(xb + (q + 1) * 128 + ch0 + 4 * n) : (f32x4){0.f, 0.f, 0.f, 0.f};
#pragma unroll
                for (int m = 0; m < 4; ++m) {
                    const f32x4 x = acc[ai][0][m][n] * rr[ai][m] + bg, vx = acc[ai][1][m][n] * rr[ai][m] + bvv;
                    const f32x4 xm = m > 0 ? acc[ai][0][m > 0 ? m - 1 : 0][n] * rr[ai][m > 0 ? m - 1 : 0] + bg : pB;
                    const f32x4 xq = m < 3 ? acc[ai][0][m < 3 ? m + 1 : 3][n] * rr[ai][m < 3 ? m + 1 : 3] + bg : nB;
                    f32x4 cv, o;
#pragma unroll
                    for (int el = 0; el < 4; ++el) { const float sp = fr == 15 ? xm[el] : x[el], sn = fr == 0 ? xq[el] : x[el];
                        const float pv = __builtin_bit_cast(float, __builtin_amdgcn_update_dpp(0, __builtin_bit_cast(int, sp), 0x121, 0xF, 0xF, false)), nv = __builtin_bit_cast(float, __builtin_amdgcn_update_dpp(0, __builtin_bit_cast(int, sn), 0x12F, 0xF, 0xF, false));
                        cv[el] = w0[el] * pv + w1[el] * x[el] + w2[el] * nv + bb[el];
                        o[el] = cv[el] / (1.f + __expf(-cv[el])) * vx[el]; }
                    const bool top = (q == 0 && m == 0 && fr == 0), bot = (q == 3 && m == 3 && fr == 15);
                    if (top || bot) { const int sl = top ? 0 : 1; *(f32x4*)(hb + sl * 128 + 4 * n) = x; *(f32x4*)(hb + (2 + sl) * 128 + 4 * n) = cv; *(f32x4*)(hb + (4 + sl) * 128 + 4 * n) = vx; }
                    else { typedef unsigned u32x2_ __attribute__((ext_vector_type(2))); u32x2_ w; w.x = cvt_pk_bf16(o[0], o[1]); w.y = cvt_pk_bf16(o[2], o[3]);
                        *(u32x2_*)(ACT + (size_t)(u.pm * BM + q * 64 + m * 16 + fr) * 5632 + chg + 4 * n) = w; }
                }
            }
        }
    }
};
template <class Epi, class Sched, bool ALIGN_EPI = false, bool SP2 = false>
__device__ __forceinline__ void gemm_phase(PG8_LAS unsigned char* lds, const Gemm g, const Sched& S, const Epi& E, int wid_in) {
    int wid = wid_in, zz_ = 0; asm volatile("" : "+s"(wid), "+s"(zz_));
    const int lane = (int)__builtin_amdgcn_mbcnt_hi(~0u, __builtin_amdgcn_mbcnt_lo(~0u, (unsigned)zz_)), tid = wid * 64 + lane, wr = wid >> 2, wc = wid & 3, fr = lane & 15, fq = lane >> 4;
    const int K = g.K, nt = K / BK;
    unsigned voffA[2], voffB[2];
#pragma unroll
    for (int i = 0; i < 2; ++i) { int R, C; stage_rc(tid * 16 + i * 8192, R, C); const int Rb = Epi::PERM ? ((R & ~31) + perm32(R & 31)) : R;
        voffA[i] = (unsigned)(R * K + C) * 2u; voffB[i] = (unsigned)(Rb * K + C) * 2u; }
    const size_t kstep = (size_t)(BK * 2);
    const size_t hstep = (size_t)HALF * K * 2;
    const size_t tstep = 2 * hstep;
    const unsigned ldsw = (unsigned)wid * 1024u;
    const int aoff = lds_byte(wr * 64 + fr, fq * 8), boff = lds_byte(wc * 32 + fr, fq * 8);
#define PG8_SA(b, h) (((b) * 2 + (h)) * HTB)
#define PG8_SB(b, h) ((4 + (b) * 2 + (h)) * HTB)
#define PG8_STAGE(bufoff, gbase, voff) do { _Pragma("unroll") for (int _i = 0; _i < 2; ++_i) \
        __builtin_amdgcn_global_load_lds((const unsigned*)((const char*)(gbase) + (voff)[_i]), (PG8_LAS unsigned*)(lds + (bufoff) + ldsw + _i * 8192), 16, 0, 0); } while (0)
#define PG8_LDA(dst, b, h) do { _Pragma("unroll") for (int m = 0; m < 4; ++m) _Pragma("unroll") for (int k = 0; k < 2; ++k) dst[m][k] = *(const PG8_LAS bf16x8*)(lds + PG8_SA(b, h) + aoff + m * 2048 + k * 1024); } while (0)
#define PG8_LDB(dst, b, h) do { _Pragma("unroll") for (int n = 0; n < 2; ++n) _Pragma("unroll") for (int k = 0; k < 2; ++k) dst[n][k] = *(const PG8_LAS bf16x8*)(lds + PG8_SB(b, h) + boff + n * 2048 + k * 1024); } while (0)
#define PG8_MMA(ai, bj, At, Bt) do { __builtin_amdgcn_s_setprio(1); _Pragma("unroll") for (int m = 0; m < 4; ++m) _Pragma("unroll") for (int n = 0; n < 2; ++n) _Pragma("unroll") for (int k = 0; k < 2; ++k) \
        acc[ai][bj][m][n] = __builtin_amdgcn_mfma_f32_16x16x32_bf16(Bt[n][k], At[m][k], acc[ai][bj][m][n], 0, 0, 0); __builtin_amdgcn_s_setprio(0); } while (0)
#define PG8_WAIT_V(n) asm volatile("s_waitcnt vmcnt(" #n ")" ::: "memory")
#define PG8_WAIT_L(n) asm volatile("s_waitcnt lgkmcnt(" #n ")" ::: "memory")
#define PG8_BAR __builtin_amdgcn_s_barrier()
#define PG8_SCHED __builtin_amdgcn_sched_barrier(0)
    Unit cur, nxt; int ui = 0;
    if (!S.next(0, cur)) return;
    f32x4 acc[2][2][4][2];
#pragma unroll
    for (int a = 0; a < 2; ++a)
#pragma unroll
        for (int b = 0; b < 2; ++b)
#pragma unroll
            for (int m = 0; m < 4; ++m)
#pragma unroll
                for (int n = 0; n < 2; ++n) acc[a][b][m][n] = (f32x4){0.f, 0.f, 0.f, 0.f};
    bf16x8 At[4][2], B0[2][2], B1[2][2];
    const char* cA = (const char*)g.A + (size_t)cur.pm * tstep + (size_t)cur.k0 * 2; const char* cB = (const char*)g.Bt + (size_t)cur.pn * tstep + (size_t)cur.k0 * 2;
    S.a_ready(cur);
    if constexpr (SP2) {
        PG8_STAGE(PG8_SB(0, 0), cB, voffB); PG8_STAGE(PG8_SB(0, 1), cB + hstep, voffB); PG8_STAGE(PG8_SA(0, 0), cA, voffA); PG8_STAGE(PG8_SA(0, 1), cA + hstep, voffA);
        if (wr == 1) PG8_BAR;
        PG8_WAIT_V(2); PG8_BAR;
        PG8_STAGE(PG8_SB(1, 0), cB + kstep, voffB); PG8_STAGE(PG8_SA(1, 0), cA + kstep, voffA); PG8_STAGE(PG8_SB(1, 1), cB + hstep + kstep, voffB);
        PG8_WAIT_V(6); PG8_BAR;
    } else {
        PG8_STAGE(PG8_SB(0, 0), cB, voffB); PG8_STAGE(PG8_SA(0, 0), cA, voffA); PG8_STAGE(PG8_SB(0, 1), cB + hstep, voffB); PG8_STAGE(PG8_SA(0, 1), cA + hstep, voffA);
        if (wr == 1) PG8_BAR;
        PG8_WAIT_V(4); PG8_BAR;
        PG8_STAGE(PG8_SB(1, 0), cB + kstep, voffB); PG8_STAGE(PG8_SA(1, 0), cA + kstep, voffA); PG8_STAGE(PG8_SB(1, 1), cB + hstep + kstep, voffB);
        PG8_WAIT_V(6); PG8_BAR;
    }
    for (;;) {
        const bool has_next = S.next(ui + 1, nxt);
        const char* nA = has_next ? (const char*)g.A + (size_t)nxt.pm * tstep + (size_t)nxt.k0 * 2 : cA; const char* nB = has_next ? (const char*)g.Bt + (size_t)nxt.pn * tstep + (size_t)nxt.k0 * 2 : cB;
        const int unt = cur.nt ? cur.nt : nt;
        for (int t = 0; t < unt; t += 2) {
            const bool last = (t == unt - 2);
            const char* a1 = cA + (size_t)(t + 1) * kstep;
            const char* a2 = last ? nA : cA + (size_t)(t + 2) * kstep; const char* b2 = last ? nB : cB + (size_t)(t + 2) * kstep;
            const char* a3 = a2 + kstep; const char* b3 = b2 + kstep;
            if (last && has_next) S.a_ready(nxt);
            if constexpr (SP2) {
            PG8_LDB(B0, 0, 0); PG8_LDB(B1, 0, 1); PG8_SCHED; PG8_LDA(At, 0, 0); PG8_STAGE(PG8_SA(1, 1), a1 + hstep, voffA);
            PG8_WAIT_V(8); PG8_WAIT_L(0); PG8_BAR; PG8_MMA(0, 0, At, B0); PG8_MMA(0, 1, At, B1); PG8_BAR; PG8_SCHED;
            PG8_LDA(At, 0, 1); PG8_STAGE(PG8_SB(0, 0), b2, voffB); PG8_STAGE(PG8_SB(0, 1), b2 + hstep, voffB); PG8_STAGE(PG8_SA(0, 0), a2, voffA);
            PG8_WAIT_V(8); PG8_WAIT_L(0); PG8_BAR; PG8_MMA(1, 0, At, B0); PG8_MMA(1, 1, At, B1); PG8_BAR; PG8_SCHED;
            PG8_LDB(B0, 1, 0); PG8_LDB(B1, 1, 1); PG8_SCHED; PG8_LDA(At, 1, 0); PG8_STAGE(PG8_SA(0, 1), a2 + hstep, voffA);
            PG8_WAIT_V(8); PG8_WAIT_L(0); PG8_BAR; PG8_MMA(0, 0, At, B0); PG8_MMA(0, 1, At, B1); PG8_BAR; PG8_SCHED;
            PG8_LDA(At, 1, 1); PG8_STAGE(PG8_SB(1, 0), b3, voffB); PG8_STAGE(PG8_SB(1, 1), b3 + hstep, voffB); PG8_STAGE(PG8_SA(1, 0), a3, voffA);
            PG8_WAIT_V(8); PG8_WAIT_L(0); PG8_BAR; PG8_MMA(1, 0, At, B0); PG8_MMA(1, 1, At, B1); PG8_BAR; PG8_SCHED;
            } else {
            PG8_LDB(B0, 0, 0); PG8_SCHED; PG8_LDA(At, 0, 0); PG8_STAGE(PG8_SA(1, 1), a1 + hstep, voffA);
            PG8_WAIT_L(8); PG8_BAR; PG8_WAIT_L(0); PG8_MMA(0, 0, At, B0); PG8_BAR; PG8_SCHED;
            PG8_LDB(B1, 0, 1); PG8_STAGE(PG8_SB(0, 0), b2, voffB);
            PG8_BAR; PG8_WAIT_L(0); PG8_MMA(0, 1, At, B1); PG8_BAR;
            PG8_LDA(At, 0, 1); PG8_STAGE(PG8_SA(0, 0), a2, voffA);
            PG8_BAR; PG8_WAIT_L(0); PG8_MMA(1, 0, At, B0); PG8_BAR; PG8_SCHED;
            PG8_STAGE(PG8_SB(0, 1), b2 + hstep, voffB);
            PG8_WAIT_V(6); PG8_BAR; PG8_MMA(1, 1, At, B1); PG8_BAR;
            PG8_LDB(B0, 1, 0); PG8_SCHED; PG8_LDA(At, 1, 0); PG8_STAGE(PG8_SA(0, 1), a2 + hstep, voffA);
            PG8_WAIT_L(8); PG8_BAR; PG8_WAIT_L(0); PG8_MMA(0, 0, At, B0); PG8_BAR; PG8_SCHED;
            PG8_LDB(B1, 1, 1); PG8_STAGE(PG8_SB(1, 0), b3, voffB);
            PG8_BAR; PG8_WAIT_L(0); PG8_MMA(0, 1, At, B1); PG8_BAR;
            PG8_LDA(At, 1, 1); PG8_STAGE(PG8_SA(1, 0), a3, voffA);
            PG8_BAR; PG8_WAIT_L(0); PG8_MMA(1, 0, At, B0); PG8_BAR; PG8_SCHED;
            PG8_STAGE(PG8_SB(1, 1), b3 + hstep, voffB);
            PG8_WAIT_V(6); PG8_BAR; PG8_MMA(1, 1, At, B1); PG8_BAR;
            }
        }
        if constexpr (ALIGN_EPI) { if (wr == 0) PG8_BAR; }
        if constexpr (!Epi::AFTER_DRAIN) { E(acc, cur, wr, wc, fr, fq); S.done(cur); }
        if (!has_next) break;
#pragma unroll
        for (int a = 0; a < 2; ++a)
#pragma unroll
            for (int b = 0; b < 2; ++b)
#pragma unroll
                for (int m = 0; m < 4; ++m)
#pragma unroll
                    for (int n = 0; n < 2; ++n) acc[a][b][m][n] = (f32x4){0.f, 0.f, 0.f, 0.f};
        cur = nxt; cA = nA; cB = nB; ++ui;
        if constexpr (ALIGN_EPI) { if (wr == 1) PG8_BAR; }
    }
    PG8_WAIT_V(0);
    if constexpr (!ALIGN_EPI) { if (wr == 0) PG8_BAR; }
    PG8_BAR;
    if constexpr (Epi::AFTER_DRAIN) { E.fused(acc, cur, wr, wc, fr, fq, lds, wid, lane); S.done(cur); }
#undef PG8_SA
#undef PG8_SB
#undef PG8_STAGE
#undef PG8_LDA
#undef PG8_LDB
#undef PG8_MMA
#undef PG8_WAIT_V
#undef PG8_WAIT_L
#undef PG8_BAR
#undef PG8_SCHED
}
}
#define GAS __attribute__((address_space(1)))
#define LAS __attribute__((address_space(3)))
typedef unsigned short bf16;
typedef unsigned v4u __attribute__((ext_vector_type(4)));
typedef unsigned v2u __attribute__((ext_vector_type(2)));
typedef float f32x4 __attribute__((ext_vector_type(4)));
typedef float f32x16 __attribute__((ext_vector_type(16)));
typedef short bf16x8 __attribute__((ext_vector_type(8)));
typedef short s16x4 __attribute__((ext_vector_type(4)));
typedef GAS unsigned gu32;
#define RLX_AGENT __ATOMIC_RELAXED, __HIP_MEMORY_SCOPE_AGENT
#define XB_TMO      128
#define XB_XCNT(j)  (256  + 64 * (j))
#define XB_XSUB(j)  (1280 + 64 * (j))
#define XB_XGEN(j)  (2304 + 64 * (j))
#define XB_TOP      3328
#define XB_TOPGEN   3392
#define XCD_BAR_WORDS 3456
#define XB_SPIN_CAP (1u << 18)

__device__ __forceinline__ unsigned xb_ld(unsigned* p)              { return __hip_atomic_load(p, __ATOMIC_RELAXED, __HIP_MEMORY_SCOPE_AGENT); }
__device__ __forceinline__ unsigned xb_add(unsigned* p, unsigned v) { return __hip_atomic_fetch_add(p, v, __ATOMIC_RELAXED, __HIP_MEMORY_SCOPE_AGENT); }
__device__ __forceinline__ unsigned xb_xcc_id() { return (unsigned)__builtin_amdgcn_s_getreg((3 << 11) | 20) & 0xFu; }
#define XB_SPIN(cond, bar) do { unsigned _sp = 0; while (cond) { __builtin_amdgcn_s_sleep(1); \
    if ((++_sp & 255u) == 0u) { if (xb_ld(&(bar)[XB_TMO])) break; if (_sp > XB_SPIN_CAP) { atomicAdd(&(bar)[XB_TMO], 1u); break; } } } } while (0)

struct XcdBarrier {
    unsigned* bar; unsigned x;
    volatile LAS unsigned* st;
    unsigned wv;
};

__device__ __forceinline__ unsigned xb_lane() { return __builtin_amdgcn_mbcnt_hi(~0u, __builtin_amdgcn_mbcnt_lo(~0u, 0u)); }
__device__ __forceinline__ XcdBarrier xcd_barrier_post(unsigned* bar, volatile LAS unsigned* st, unsigned wv) {
    XcdBarrier b; b.bar = bar; b.x = xb_xcc_id(); b.st = st; b.wv = wv;
    if (wv == 0u && xb_lane() == 0u) (void)xb_add(&bar[XB_XCNT(b.x)], 1u);
    return b;
}
__device__ __forceinline__ void xcd_barrier_complete(unsigned* bar, unsigned x, unsigned& nloc, unsigned& nx) {
    const unsigned G = gridDim.x * gridDim.y * gridDim.z;
    unsigned sum, cnt, mine, sp = 0u;
    for (;;) {
        sum = 0u; cnt = 0u; mine = 0u;
#pragma unroll
        for (unsigned j = 0; j < 16; ++j) { const unsigned c = xb_ld(&bar[XB_XCNT(j)]); sum += c; cnt += (c > 0u) ? 1u : 0u; mine = (j == x) ? c : mine; }
        if (sum == G) break;
        __builtin_amdgcn_s_sleep(1);
        if ((++sp & 255u) == 0u) { if (xb_ld(&bar[XB_TMO])) break; if (sp > XB_SPIN_CAP) { atomicAdd(&bar[XB_TMO], 1u); break; } }
    }
    nloc = mine > 0u ? mine : 1u; nx = cnt > 0u ? cnt : 1u;
}

__device__ __forceinline__ void xcd_barrier(const XcdBarrier& b) {
    asm volatile("s_waitcnt vmcnt(0)" ::: "memory");
    __syncthreads();
    if (b.wv == 0u && xb_lane() == 0u) {
        unsigned* bar = b.bar;
        __builtin_amdgcn_s_waitcnt(0);
        unsigned nloc = b.st[0], nx = b.st[1];
        if (nloc == 0u) { xcd_barrier_complete(bar, b.x, nloc, nx); b.st[0] = nloc; b.st[1] = nx; }
        const unsigned old = xb_add(&bar[XB_XSUB(b.x)], 1u);
        const unsigned gen = old / nloc;
        if (old + 1u == (gen + 1u) * nloc) {
            __builtin_amdgcn_fence(__ATOMIC_RELEASE, "agent");
            asm volatile("s_waitcnt vmcnt(0)" ::: "memory");
            const unsigned og = xb_add(&bar[XB_TOP], 1u);
            const unsigned tg = og / nx;
            if (og + 1u == (tg + 1u) * nx) xb_add(&bar[XB_TOPGEN], 1u);
            else XB_SPIN(xb_ld(&bar[XB_TOPGEN]) == tg, bar);
            __builtin_amdgcn_fence(__ATOMIC_ACQUIRE, "agent");
            xb_add(&bar[XB_XGEN(b.x)], 1u);
            asm volatile("s_waitcnt vmcnt(0)" ::: "memory");
        } else {
            XB_SPIN(xb_ld(&bar[XB_XGEN(b.x)]) == gen, bar);
            __builtin_amdgcn_fence(__ATOMIC_ACQUIRE, "agent");
            asm volatile("s_waitcnt vmcnt(0)" ::: "memory");
        }
    }
    __syncthreads();
}
#ifndef ONE_LAUNCH
#define ONE_LAUNCH 1
#endif
#ifndef NLAYERS
#define NLAYERS 4
#endif
constexpr int DM = 2048, MR = 8704, NLATR = 8192;
constexpr int NINP = 6400, DFF = 5632, NUP = 11264, EVIN = 6176, ODIN = 6160;
constexpr int NWAVES = 8, NTHR = 512;
constexpr float EPS = 1e-6f;
constexpr int NCHUNK = 68;
constexpr int PPL = 11, NPH = 1 + 4 * PPL;
constexpr size_t MiB = 1ull << 20;
constexpr size_t WS_CTL = 0, CTL_BYTES = 1 * MiB;
constexpr size_t WS_MOD = 1 * MiB, WS_ROPE = 1 * MiB + 640 * 1024;
constexpr size_t WS_W = 4 * MiB, W_LAYER = 99 * MiB, W_OUT = 25 * MiB, W_UP = 33 * MiB, W_DN = 77 * MiB;
constexpr size_t WS_XS = 400 * MiB, WS_H = 468 * MiB, WS_MIX = 502 * MiB, WS_P = 536 * MiB, WS_U = 644 * MiB, WS_ACT = 832 * MiB;
constexpr size_t WS_QR = 926 * MiB, WS_KR = 943 * MiB, WS_MQK = 960 * MiB, WS_DST = 977 * MiB, WS_SST = 1113 * MiB, WS_SM = 1181 * MiB, WS_B1 = 1185 * MiB, WS_B2 = 1186 * MiB, WS_END = 1187 * MiB;
constexpr size_t WS_SSQ = 524288;
constexpr size_t SM_GAM = 0, SM_DN = 1 * MiB, SM_NIN = 2 * MiB, SM_BL = 3 * MiB, SM_ML = 3 * MiB + 8192, SM_MIN = 3 * MiB + 16384;
constexpr int CW_BAR = 4096;
constexpr int LDS_BYTES = 147456, MISC_OFF = 131072 + 320;

struct Args { const float* in[27]; float* out; unsigned char* ws; int ph_lo, ph_hi, li, pad; };

__device__ __forceinline__ float bf_lo(unsigned u) { return __builtin_bit_cast(float, u << 16); }
__device__ __forceinline__ float bf_hi(unsigned u) { return __builtin_bit_cast(float, u & 0xffff0000u); }
__device__ __forceinline__ float bf1(bf16 b) { return __builtin_bit_cast(float, (unsigned)b << 16); }
typedef float f32x2_t __attribute__((ext_vector_type(2))); typedef __bf16 bf16x2_t __attribute__((ext_vector_type(2)));
__device__ __forceinline__ unsigned pk2(float lo, float hi) { f32x2_t v = {lo, hi}; bf16x2_t b = __builtin_convertvector(v, bf16x2_t); return __builtin_bit_cast(unsigned, b); }
__device__ __forceinline__ bf16 f2bf(float f) { return (bf16)(pk2(f, 0.f) & 0xffffu); }
__device__ __forceinline__ void unpack8(const v4u w, float (&f)[8]) { f[0] = bf_lo(w.x); f[1] = bf_hi(w.x); f[2] = bf_lo(w.y); f[3] = bf_hi(w.y); f[4] = bf_lo(w.z); f[5] = bf_hi(w.z); f[6] = bf_lo(w.w); f[7] = bf_hi(w.w); }
__device__ __forceinline__ v4u pack8(const float (&f)[8]) { v4u w; w.x = pk2(f[0], f[1]); w.y = pk2(f[2], f[3]); w.z = pk2(f[4], f[5]); w.w = pk2(f[6], f[7]); return w; }
__device__ __forceinline__ float silu_f(float x) { return x / (1.f + __expf(-x)); }
__device__ __forceinline__ float sigmoid_f(float x) { return 1.f / (1.f + __expf(-x)); }
__device__ __forceinline__ float logsig_f(float z) { return fminf(z, 0.f) - __logf(1.f + __expf(-fabsf(z))); }
__device__ __forceinline__ float wave_sum(float v) {
#pragma unroll
    for (int o = 1; o < 64; o <<= 1) v += __shfl_xor(v, o);
    return v;
}
__device__ __forceinline__ float wave_max(float v) {
#pragma unroll
    for (int o = 1; o < 64; o <<= 1) v = fmaxf(v, __shfl_xor(v, o));
    return v;
}
__device__ __forceinline__ float wave_scan_sum(float v, int dir, int lane) {
#pragma unroll
    for (int o = 1; o < 64; o <<= 1) { const float up = __shfl_up(v, o), dn = __shfl_down(v, o); if (dir == 0) { if (lane >= o) v += up; } else { if (lane + o < 64) v += dn; } }
    return v;
}
__device__ __forceinline__ float wave_scan_max(float v, int dir, int lane) {
#pragma unroll
    for (int o = 1; o < 64; o <<= 1) { const float up = __shfl_up(v, o), dn = __shfl_down(v, o); if (dir == 0) { if (lane >= o) v = fmaxf(v, up); } else { if (lane + o < 64) v = fmaxf(v, dn); } }
    return v;
}
__device__ __forceinline__ bool seq_start(int r) { return r < NLATR ? (r & 4095) == 0 : ((r - NLATR) & 255) == 0; }

__device__ __forceinline__ bf16x8 frag_row(LAS const unsigned char* base, int stride, int row0, int k0, int lane) {
    return *(LAS const bf16x8*)(base + (row0 + (lane & 31)) * stride + (k0 + 8 * (lane >> 5)) * 2);
}
__device__ __forceinline__ s16x4 tr4(LAS const unsigned char* p) { return __builtin_amdgcn_ds_read_tr16_b64_v4i16((LAS s16x4*)p); }
__device__ __forceinline__ bf16x8 frag_tr(LAS const unsigned char* base, int stride, int k0, int col0, int lane) {
    const int h = lane >> 5, blk = (lane >> 4) & 1, q = (lane & 15) >> 2, p = lane & 3;
    LAS const unsigned char* a = base + (k0 + 8 * h + q) * stride + (col0 + 16 * blk + 4 * p) * 2;
    const s16x4 lo = tr4(a), hi = tr4(a + 4 * stride);
    return (bf16x8){lo[0], lo[1], lo[2], lo[3], hi[0], hi[1], hi[2], hi[3]};
}
__device__ __forceinline__ bf16x8 frag_tr_perm(LAS const unsigned char* base, int stride, int k0, int col0, int lane) {
    const int h = lane >> 5, blk = (lane >> 4) & 1, q = (lane & 15) >> 2, p = lane & 3;
    LAS const unsigned char* a = base + (k0 + 4 * h + q) * stride + (col0 + 16 * blk + 4 * p) * 2;
    const s16x4 lo = tr4(a), hi = tr4(a + 8 * stride);
    return (bf16x8){lo[0], lo[1], lo[2], lo[3], hi[0], hi[1], hi[2], hi[3]};
}
__device__ __forceinline__ int swz_off(int row, int ch) { return 256 * row + 16 * (ch ^ (((row & 3) << 2) | ((row >> 2) & 3))); }
__device__ __forceinline__ bf16x8 sfrag_row(LAS const unsigned char* base, int row0, int k0, int lane) {
    return *(LAS const bf16x8*)(base + swz_off(row0 + (lane & 31), (k0 >> 3) + (lane >> 5)));
}
__device__ __forceinline__ bf16x8 sfrag_tr_perm(LAS const unsigned char* base, int k0, int col0, int lane) {
    const int h = lane >> 5, blk = (lane >> 4) & 1, q = (lane & 15) >> 2, p = lane & 3, ch = (col0 >> 3) + 2 * blk + (p >> 1), r0 = k0 + 4 * h + q;
    const s16x4 lo = tr4(base + swz_off(r0, ch) + 8 * (p & 1)), hi = tr4(base + swz_off(r0 + 8, ch) + 8 * (p & 1));
    return (bf16x8){lo[0], lo[1], lo[2], lo[3], hi[0], hi[1], hi[2], hi[3]};
}
#define MFMA32(a, b, c) __builtin_amdgcn_mfma_f32_32x32x16_bf16((a), (b), (c), 0, 0, 0)
__device__ __forceinline__ f32x16 zero16() { f32x16 z;
#pragma unroll
    for (int i = 0; i < 16; ++i) z[i] = 0.f;
    return z; }
__device__ __forceinline__ void load_tile(LAS unsigned char* dst, int ls, const bf16* src, size_t ld, int rows, int cols, int tid) {
    const int cpr = cols >> 3, n = rows * cpr;
    for (int c = tid; c < n; c += NTHR) { const int r = c / cpr, cc = c - r * cpr; *(LAS v4u*)(dst + r * ls + cc * 16) = *(const v4u*)(src + (size_t)r * ld + cc * 8); }
}

__device__ __forceinline__ void store_tile(bf16* dst, size_t ld, LAS const unsigned char* src, int ls, int rows, int cols, int tid) {
    const int cpr = cols >> 3, n = rows * cpr;
    for (int c = tid; c < n; c += NTHR) { const int r = c / cpr, cc = c - r * cpr; *(v4u*)(dst + (size_t)r * ld + cc * 8) = *(LAS const v4u*)(src + r * ls + cc * 16); }
}

struct TrItem { const float* W; bf16* WT; int K, N, k0, n0, dn0, nts; };
__device__ __forceinline__ void tr_issue(const TrItem& t, f32x4 (&v)[8], int lane) {
    const int n = t.n0 + 4 * (lane & 7);
#pragma unroll
    for (int i = 0; i < 8; ++i) { const int kk = 8 * i + (lane >> 3); v[i] = n < t.N ? __builtin_nontemporal_load((const f32x4*)(t.W + (size_t)(t.k0 + kk) * t.N + n)) : (f32x4){0.f, 0.f, 0.f, 0.f}; }
}
__device__ __forceinline__ void tr_finish(const TrItem& t, const f32x4 (&v)[8], LAS float* scr, int lane) {
#pragma unroll
    for (int i = 0; i < 8; ++i) { const int kk = 8 * i + (lane >> 3); LAS float* d = scr + kk * 33 + 4 * (lane & 7); d[0] = v[i].x; d[1] = v[i].y; d[2] = v[i].z; d[3] = v[i].w; }
    asm volatile("s_waitcnt lgkmcnt(0)" ::: "memory");
    const int c = lane & 7;
#pragma unroll
    for (int j = 0; j < 4; ++j) { const int nn = (lane >> 3) + 8 * j; const LAS float* s = scr + (8 * c) * 33 + nn;
        v4u o; o.x = pk2(s[0 * 33], s[1 * 33]); o.y = pk2(s[2 * 33], s[3 * 33]); o.z = pk2(s[4 * 33], s[5 * 33]); o.w = pk2(s[6 * 33], s[7 * 33]);
        if (t.k0 >= 0 && t.nts) __builtin_nontemporal_store(o, (v4u*)(t.WT + (size_t)(t.dn0 + nn) * t.K + t.k0 + 8 * c)); else *(v4u*)(t.WT + (size_t)(t.dn0 + nn) * t.K + t.k0 + 8 * c) = o; }
    asm volatile("s_waitcnt lgkmcnt(0)" ::: "memory");
}
__device__ __forceinline__ void tr_decode(const Args& a, unsigned char* ws, int g, TrItem& t) {
    const int layer = g / 25344; int r = g - layer * 25344; const int li = layer >> 1; t.nts = layer > 0;
    unsigned char* wb = ws + WS_W + (size_t)layer * W_LAYER;
    int nblk;
    if (r < 6400) { if (layer & 1) { t.W = a.in[14] + (size_t)li * DM * ODIN; t.N = ODIN; } else { t.W = a.in[8] + (size_t)li * DM * EVIN; t.N = EVIN; } t.WT = (bf16*)wb; t.K = DM; nblk = NINP / 32; }
    else if ((r -= 6400) < 2048) { t.W = (layer & 1 ? a.in[15] : a.in[9]) + (size_t)li * DM * DM; t.N = DM; t.WT = (bf16*)(wb + W_OUT); t.K = DM; nblk = DM / 32; }
    else if ((r -= 2048) < 11264) { t.W = a.in[23] + (size_t)layer * DM * NUP; t.N = NUP; t.WT = (bf16*)(wb + W_UP); t.K = DM; nblk = NUP / 32; }
    else { r -= 11264; t.W = a.in[26] + (size_t)layer * DFF * DM; t.N = DM; t.WT = (bf16*)(wb + W_DN); t.K = DFF; nblk = DM / 32; }
    const int kb = r / nblk, nb = r - kb * nblk; t.k0 = 64 * kb; t.n0 = 32 * nb; t.dn0 = t.n0;
    if (t.N == NUP) { const int m0 = t.n0 < DFF ? t.n0 : t.n0 - DFF; t.dn0 = 256 * (m0 >> 7) + (t.n0 < DFF ? 0 : 128) + (m0 & 127); }
}
__device__ __forceinline__ void ph_convert(const Args& a, unsigned char* ws, LAS unsigned char* lds, int g_lo, int g_hi, int w, int nw, int wave, int lane) {
    LAS float* scr = (LAS float*)(lds + wave * 8448);
    TrItem cur, nxt; f32x4 va[8], vb[8];
    int g = g_lo + w;
    if (g < g_hi) { tr_decode(a, ws, g, cur); tr_issue(cur, va, lane); }
    while (g < g_hi) {
        const int g1 = g + nw; if (g1 < g_hi) { tr_decode(a, ws, g1, nxt); tr_issue(nxt, vb, lane); }
        tr_finish(cur, va, scr, lane);
        const int g2 = g1 + nw; if (g1 < g_hi) { if (g2 < g_hi) { tr_decode(a, ws, g2, cur); tr_issue(cur, va, lane); } tr_finish(nxt, vb, scr, lane); }
        g = g2;
    }
}
__device__ __forceinline__ void ph_prologue(const Args& a, unsigned char* ws, LAS unsigned char* lds, int tid, int lane, int wave, int bid, int G) {
    float* MOD = (float*)(ws + WS_MOD);
    LAS float* vec = (LAS float*)(lds + 73728);
    LAS float* red = (LAS float*)(lds + 98304);
    for (int e = tid; e < 3 * DM; e += NTHR) { const float v = e < 2 * DM ? a.in[1][e] : a.in[3][e - 2 * DM]; vec[e] = silu_f(v); }
    __syncthreads();
    for (int it = bid; it < 4 * 192; it += G) {
        const int layer = it / 192, cg = it - layer * 192, col = cg * 64 + 4 * (lane & 15), rq = lane >> 4;
        const float* W = a.in[4] + (size_t)layer * DM * 12288 + col;
        f32x4 a0 = {0.f, 0.f, 0.f, 0.f}, a1 = a0, a2 = a0;
#pragma unroll 16
        for (int i = 0; i < 64; ++i) { const int kk = 256 * wave + 4 * i + rq; const f32x4 w4 = __builtin_nontemporal_load((const f32x4*)(W + (size_t)kk * 12288));
            a0 += w4 * vec[kk]; a1 += w4 * vec[DM + kk]; a2 += w4 * vec[2 * DM + kk]; }
#pragma unroll
        for (int e = 0; e < 4; ++e) { a0[e] += __shfl_xor(a0[e], 16); a0[e] += __shfl_xor(a0[e], 32); a1[e] += __shfl_xor(a1[e], 16); a1[e] += __shfl_xor(a1[e], 32); a2[e] += __shfl_xor(a2[e], 16); a2[e] += __shfl_xor(a2[e], 32); }
        if (lane < 16) { *(LAS f32x4*)(red + (wave * 3 + 0) * 64 + 4 * lane) = a0; *(LAS f32x4*)(red + (wave * 3 + 1) * 64 + 4 * lane) = a1; *(LAS f32x4*)(red + (wave * 3 + 2) * 64 + 4 * lane) = a2; }
        __syncthreads();
        if (tid < 192) { const int j = tid >> 6, c = tid & 63; float s = a.in[5][layer * 12288 + cg * 64 + c];
#pragma unroll
            for (int w = 0; w < 8; ++w) s += red[(w * 3 + j) * 64 + c];
            MOD[(size_t)(layer * 3 + j) * 12288 + cg * 64 + c] = s; }
        __syncthreads();
    }
    if (bid == G - 1) { float* rope = (float*)(ws + WS_ROPE);
        for (int e = tid; e < 1024; e += NTHR) { const int pos = e >> 4, f = e & 15; const float inv = powf(10000.f, -(float)f / 16.f), ang = (float)pos * inv; rope[e] = cosf(ang); rope[1024 + e] = sinf(ang); } }
    ph_convert(a, ws, lds, 0, 25344, bid * NWAVES + wave, G * NWAVES, wave, lane);
}

__device__ __forceinline__ void fuse_row(const float* src, float* XS, int row, int lane, const float* part, const float* pgate, int nsplit, const float* ng, const float* msc, bf16* H, float* ssq) {
    const int mi = row < NLATR ? (row >> 12) : 2;
    const f32x4* sr = (const f32x4*)src + lane; f32x4* xr = (f32x4*)(XS + (size_t)row * DM) + lane;
    f32x4 v[8];
#pragma unroll
    for (int j = 0; j < 8; ++j) v[j] = sr[64 * j];
    if (nsplit > 0) {
        f32x4 sacc[8];
#pragma unroll
        for (int j = 0; j < 8; ++j) sacc[j] = (f32x4){0.f, 0.f, 0.f, 0.f};
        for (int sp = 0; sp < nsplit; ++sp) { const f32x4* pr = (const f32x4*)(part + ((size_t)sp * 512 + (row - NLATR)) * DM) + lane;
#pragma unroll
            for (int j = 0; j < 8; ++j) sacc[j] += pr[64 * j]; }
#pragma unroll
        for (int j = 0; j < 8; ++j) v[j] += *(const f32x4*)(pgate + 4 * lane + 256 * j) * sacc[j];
    }
    float ss = 0.f;
#pragma unroll
    for (int j = 0; j < 8; ++j) { xr[64 * j] = v[j]; ss += (v[j].x * v[j].x + v[j].y * v[j].y) + (v[j].z * v[j].z + v[j].w * v[j].w); }
    ss = wave_sum(ss);
    if (lane == 0) ssq[row] = ss;
#pragma unroll
    for (int j = 0; j < 8; ++j) { const int col = 4 * lane + 256 * j;
        const f32x4 y = v[j] * *(const f32x4*)(ng + col) * (*(const f32x4*)(msc + (size_t)mi * 12288 + col) + 1.f);
        v2u o; o.x = pk2(y.x, y.y); o.y = pk2(y.z, y.w);
        *(v2u*)(H + (size_t)row * DM + col) = o; }
}
__device__ __forceinline__ void ph_norm0(const float* x, const float* ctx, float* XS, const float* ng, const float* msc, bf16* H, float* ssq, int gw, int NGW, int lane) {
    for (int row = gw; row < MR; row += NGW) fuse_row(row < NLATR ? x + (size_t)row * DM : ctx + (size_t)(row - NLATR) * DM, XS, row, lane, nullptr, nullptr, 0, ng, msc, H, ssq);
}
template <int NS>
__device__ __forceinline__ void ph_ctxfix(float* XS, const float* part, const float* pgate, const float* ng, const float* msc, bf16* H, float* ssq, int gw, int NGW, int lane) {
    for (int it = gw; it < 2048; it += NGW) {
        const int row = NLATR + (it >> 2), c0 = (it & 3) * 512 + 8 * lane;
        float* xp = XS + (size_t)row * DM + c0;
        f32x4 v0 = *(const f32x4*)xp, v1 = *(const f32x4*)(xp + 4);
        f32x4 p0[NS], p1[NS];
#pragma unroll
        for (int sp = 0; sp < NS; ++sp) { const float* pp = part + ((size_t)sp * 512 + (row - NLATR)) * DM + c0; p0[sp] = *(const f32x4*)pp; p1[sp] = *(const f32x4*)(pp + 4); }
        f32x4 s0 = p0[0], s1 = p1[0];
#pragma unroll
        for (int sp = 1; sp < NS; ++sp) { s0 += p0[sp]; s1 += p1[sp]; }
        v0 += *(const f32x4*)(pgate + c0) * s0; v1 += *(const f32x4*)(pgate + c0 + 4) * s1;
        *(f32x4*)xp = v0; *(f32x4*)(xp + 4) = v1;
        float ss = (v0.x * v0.x + v0.y * v0.y) + (v0.z * v0.z + v0.w * v0.w) + (v1.x * v1.x + v1.y * v1.y) + (v1.z * v1.z + v1.w * v1.w);
        ss = wave_sum(ss);
        if (lane == 0) (void)__hip_atomic_fetch_add(ssq + row, ss, __ATOMIC_RELAXED, __HIP_MEMORY_SCOPE_AGENT);
        const f32x4 y0 = v0 * *(const f32x4*)(ng + c0) * (*(const f32x4*)(msc + 2 * 12288 + c0) + 1.f), y1 = v1 * *(const f32x4*)(ng + c0 + 4) * (*(const f32x4*)(msc + 2 * 12288 + c0 + 4) + 1.f);
        v4u o; o.x = pk2(y0.x, y0.y); o.y = pk2(y0.z, y0.w); o.z = pk2(y1.x, y1.y); o.w = pk2(y1.z, y1.w);
        *(v4u*)(H + (size_t)row * DM + c0) = o;
    }
}
__device__ __forceinline__ void ph_bias(const bf16* WIN, const bf16* WUPt, const float* mod, float* b1, float* b2, int gw, int NGW, int lane) {
    for (int which = 0; which < 2; ++which) {
        const bf16* WT = which ? WUPt : WIN; const int N = which ? NUP : NINP; const float* sh = mod + (which ? 3 * DM : 0); float* out = which ? b2 : b1;
        float s0[32], s1[32], s2[32];
#pragma unroll
        for (int i = 0; i < 4; ++i)
#pragma unroll
            for (int h = 0; h < 2; ++h) { const int k = 512 * i + 8 * lane + 4 * h; const f32x4 a0 = *(const f32x4*)(sh + k), a1 = *(const f32x4*)(sh + 12288 + k), a2 = *(const f32x4*)(sh + 2 * 12288 + k);
#pragma unroll
                for (int el = 0; el < 4; ++el) { s0[8 * i + 4 * h + el] = a0[el]; s1[8 * i + 4 * h + el] = a1[el]; s2[8 * i + 4 * h + el] = a2[el]; } }
#pragma unroll 1
        for (int n0 = gw * 2; n0 < N; n0 += NGW * 2) {
            v4u wv[2][4];
#pragma unroll
            for (int rr = 0; rr < 2; ++rr)
#pragma unroll
                for (int i = 0; i < 4; ++i) wv[rr][i] = *(const v4u*)(WT + (size_t)(n0 + rr) * DM + 512 * i + 8 * lane);
            float d[2][3];
#pragma unroll
            for (int rr = 0; rr < 2; ++rr) { d[rr][0] = 0.f; d[rr][1] = 0.f; d[rr][2] = 0.f;
#pragma unroll
                for (int i = 0; i < 4; ++i) { float w[8]; unpack8(wv[rr][i], w);
#pragma unroll
                    for (int el = 0; el < 8; ++el) { d[rr][0] += w[el] * s0[8 * i + el]; d[rr][1] += w[el] * s1[8 * i + el]; d[rr][2] += w[el] * s2[8 * i + el]; } } }
#pragma unroll
            for (int rr = 0; rr < 2; ++rr)
#pragma unroll
                for (int j = 0; j < 3; ++j) d[rr][j] = wave_sum(d[rr][j]);
            if (lane == 0) {
#pragma unroll
                for (int rr = 0; rr < 2; ++rr) { out[n0 + rr] = d[rr][0]; out[N + n0 + rr] = d[rr][1]; out[2 * N + n0 + rr] = d[rr][2]; } }
        }
    }
}

template <int MODE>
__device__ __forceinline__ void ph_conv(const bf16* SRC, const float* cw, const float* cb, bf16* DST, int gtid, int NT) {
    constexpr int NC = MODE == 0 ? DFF : 1024, NCG = NC / 8, NRB = MR / 16;
    constexpr int LDS_ = MODE == 0 ? NUP : NINP, LDD = MODE == 0 ? DFF : (MODE == 1 ? DM : 1024);
    for (int it = gtid; it < NRB * NCG; it += NT) {
        const int rb = it / NCG, cg = it - rb * NCG, r0 = rb * 16, c0 = cg * 8;
        float w0[8], w1[8], w2[8], bb[8];
#pragma unroll
        for (int j = 0; j < 8; ++j) { w0[j] = cw[c0 + j]; w1[j] = cw[NC + c0 + j]; w2[j] = cw[2 * NC + c0 + j]; bb[j] = MODE == 0 ? cb[c0 + j] : 0.f; }
        auto ld = [&](int r, float (&f)[8]) {
            if (MODE == 0) { unpack8(*(const v4u*)(SRC + (size_t)r * LDS_ + c0), f); }
            else if (MODE == 1) { float s1[8], s2[8]; unpack8(*(const v4u*)(SRC + (size_t)r * LDS_ + 3104 + c0), s1); unpack8(*(const v4u*)(SRC + (size_t)r * LDS_ + 5152 + c0), s2);
#pragma unroll
                for (int j = 0; j < 8; ++j) f[j] = s1[j] * s2[j]; }
            else { unpack8(*(const v4u*)(SRC + (size_t)r * LDS_ + 3072 + c0), f); }
        };
        float prev[8], cur[8], nxt[8];
        if (!seq_start(r0)) ld(r0 - 1, prev); else {
#pragma unroll
            for (int j = 0; j < 8; ++j) prev[j] = 0.f; }
        ld(r0, cur);
#pragma unroll 2
        for (int i = 0; i < 16; ++i) {
            const int r = r0 + i;
            if (i < 15 || !seq_start(r0 + 16)) ld(r + 1, nxt); else {
#pragma unroll
                for (int j = 0; j < 8; ++j) nxt[j] = 0.f; }
            float o[8];
            if (MODE == 0) { float vv[8]; unpack8(*(const v4u*)(SRC + (size_t)r * LDS_ + DFF + c0), vv);
#pragma unroll
                for (int j = 0; j < 8; ++j) o[j] = silu_f(w0[j] * prev[j] + w1[j] * cur[j] + w2[j] * nxt[j] + bb[j]) * vv[j]; }
            else if (MODE == 1) { float vv[8]; unpack8(*(const v4u*)(SRC + (size_t)r * LDS_ + 4128 + c0), vv);
#pragma unroll
                for (int j = 0; j < 8; ++j) o[j] = (w0[j] * prev[j] + w1[j] * cur[j] + w2[j] * nxt[j]) * vv[j]; }
            else { const float sc = c0 >= 512 ? 0.08838834764831845f : 1.f;
#pragma unroll
                for (int j = 0; j < 8; ++j) o[j] = silu_f(w0[j] * prev[j] + w1[j] * cur[j] + w2[j] * nxt[j]) * sc; }
            *(v4u*)(DST + (size_t)r * LDD + (MODE == 1 ? 1024 : 0) + c0) = pack8(o);
#pragma unroll
            for (int j = 0; j < 8; ++j) { prev[j] = cur[j]; cur[j] = nxt[j]; }
        }
    }
}

__device__ __forceinline__ void ph_act_fix(const float* halo, const float* cw, bf16* ACT, int gtid, int NT) {
    for (int e = gtid; e < 34 * 44 * 256; e += NT) {
        const int ch = e & 127, which = (e >> 7) & 1, tile = e >> 8, pm = tile / 44, pn = tile - pm * 44, chg = pn * 128 + ch;
        const float* hb = halo + (size_t)tile * 768;
        const int row = 256 * pm + (which ? 255 : 0);
        float g = 0.f;
        if (which == 0) { if (!seq_start(row)) g = halo[(size_t)(tile - 44) * 768 + 128 + ch] * cw[chg]; }
        else { if (!seq_start(row + 1)) g = halo[(size_t)(tile + 44) * 768 + ch] * cw[2 * DFF + chg]; }
        const float cv = hb[(2 + which) * 128 + ch] + g;
        ACT[(size_t)row * DFF + chg] = f2bf(silu_f(cv) * hb[(4 + which) * 128 + ch]);
    }
}

__device__ __forceinline__ void act_fix_tile(const float* halo, const float* cw, bf16* ACT, int pm, int tid) {
    f32x4 cp[6], vv[6], gg[6];
#pragma unroll
    for (int i = 0; i < 6; ++i) { const int e = tid + NTHR * i; const bool ok = e < 2816; const int ee = ok ? e : 0;
        const int c4 = ee & 31, which = (ee >> 5) & 1, pn = ee >> 6, tile = pm * 44 + pn, chg = pn * 128 + 4 * c4;
        const float* hb = halo + (size_t)tile * 768 + 4 * c4;
        const int row = 256 * pm + (which ? 255 : 0);
        cp[i] = *(const f32x4*)(hb + (2 + which) * 128); vv[i] = *(const f32x4*)(hb + (4 + which) * 128);
        const bool edge = which == 0 ? seq_start(row) : seq_start(row + 1);
        const f32x4 nb = edge ? (f32x4){0.f, 0.f, 0.f, 0.f} : *(const f32x4*)(halo + (size_t)(which == 0 ? tile - 44 : tile + 44) * 768 + (which == 0 ? 128 : 0) + 4 * c4);
        gg[i] = nb * *(const f32x4*)(cw + (which == 0 ? 0 : 2 * DFF) + chg); }
#pragma unroll
    for (int i = 0; i < 6; ++i) { const int e = tid + NTHR * i; if (e < 2816) {
        const int c4 = e & 31, which = (e >> 5) & 1, pn = e >> 6, chg = pn * 128 + 4 * c4; const int row = 256 * pm + (which ? 255 : 0);
        const f32x4 cv = cp[i] + gg[i];
        v2u o; o.x = pk2(silu_f(cv.x) * vv[i].x, silu_f(cv.y) * vv[i].y); o.y = pk2(silu_f(cv.z) * vv[i].z, silu_f(cv.w) * vv[i].w);
        *(v2u*)(ACT + (size_t)row * DFF + chg) = o; } }
}

__device__ __forceinline__ void ph_qkprep(const bf16* P, const float* qg, const float* kg, const float* rope, bf16* QR, bf16* KR, int gw, int NGW, int lane) {
    for (int it = gw; it < MR * 4; it += NGW) {
        const int row = it >> 2, qtr = it & 3, isk = qtr >> 1;
        float x[8]; unpack8(*(const v4u*)(P + (size_t)row * NINP + isk * 1024 + (qtr & 1) * 512 + 8 * lane), x);
        float ss = 0.f;
#pragma unroll
        for (int j = 0; j < 8; ++j) ss += x[j] * x[j];
        ss += __shfl_xor(ss, 1); ss += __shfl_xor(ss, 2); ss += __shfl_xor(ss, 4);
        const float r = rsqrtf(ss * (1.f / 64.f) + EPS);
        const int i = lane & 7; const float* gp = (isk ? kg : qg) + 8 * i;
        float y[8], o[8];
#pragma unroll
        for (int j = 0; j < 8; ++j) y[j] = x[j] * r * gp[j];
        if (row < NLATR) {
            const int t = row & 4095, pos = (i < 4) ? (t >> 6) : (t & 63), f0 = 8 * (i & 1);
#pragma unroll
            for (int j = 0; j < 8; ++j) { const float pj = __shfl_xor(y[j], 2), c = rope[pos * 16 + f0 + j], s = rope[1024 + pos * 16 + f0 + j];
                o[j] = (i & 2) ? (pj * s + y[j] * c) : (y[j] * c - pj * s); }
        } else {
#pragma unroll
            for (int j = 0; j < 8; ++j) o[j] = y[j]; }
        if (!isk) {
#pragma unroll
            for (int j = 0; j < 8; ++j) o[j] *= 0.18033688011112042f; }
        *(v4u*)((isk ? KR : QR) + (size_t)row * 1024 + (qtr & 1) * 512 + 8 * lane) = pack8(o);
    }
}

struct ScanP {
    const bf16* P; const bf16* MQK; bf16* MIX;
    const float* gw2; const float* gb;
    const float* mgb;
    const float* ng;
    bf16* DSTp; bf16* SSTp; float* GAM; float* DN; float* NIN; float* BL; float* ML; float* MINp;
};
__device__ __forceinline__ void scan_unit(int u, int& b, int& head, int& mm, int& rowbase) {
    b = u / 272; const int rem = u - b * 272; head = rem / 68; mm = rem - head * 68;
    rowbase = mm < 4 ? NLATR + b * 256 + 64 * mm : b * 4096 + 64 * (mm - 4);
}
__device__ __forceinline__ int scan_chunk(int mm, int dir) { return dir ? (mm < 4 ? 3 - mm : 71 - mm) : mm; }

__device__ __forceinline__ void gla_gates(const ScanP& s, LAS const float* glr, LAS float* tot, int head, int dir, int tid, float (&bb)[16], float& btot) {
    const int dk = tid & 127, grp = tid >> 7;
    float w2[16];
#pragma unroll
    for (int r = 0; r < 16; ++r) w2[r] = s.gw2[(dir * 16 + r) * 512 + head * 128 + dk];
    const float bias = s.gb[dir * 512 + head * 128 + dk];
#pragma unroll
    for (int tt = 0; tt < 16; ++tt) { const int t = 16 * grp + tt; float z = bias;
#pragma unroll
        for (int r = 0; r < 16; ++r) z += glr[t * 32 + dir * 16 + r] * w2[r];
        bb[tt] = logsig_f(z) * 0.0625f; }
    if (dir == 0) {
#pragma unroll
        for (int tt = 1; tt < 16; ++tt) bb[tt] += bb[tt - 1];
        tot[grp * 128 + dk] = bb[15];
    } else {
#pragma unroll
        for (int tt = 14; tt >= 0; --tt) bb[tt] += bb[tt + 1];
        tot[grp * 128 + dk] = bb[0];
    }
    __syncthreads();
    float off = 0.f; btot = 0.f;
#pragma unroll
    for (int g = 0; g < 4; ++g) { const float tv = tot[g * 128 + dk]; btot += tv; if (dir == 0 ? g < grp : g > grp) off += tv; }
#pragma unroll
    for (int tt = 0; tt < 16; ++tt) bb[tt] += off;
}

__device__ __forceinline__ void ph_mlstm_local(const ScanP& s, LAS unsigned char* lds, int tid, int lane, int wave, int bid, int G) {
    LAS unsigned char* Vs = lds; LAS unsigned char* Kh = lds + 33792; LAS unsigned char* Kr = lds + 68608;
    LAS float* wv = (LAS float*)(lds + 86016); LAS float* dnp = (LAS float*)(lds + 86528);
    const int dk = tid & 127, grp = tid >> 7;
    v4u pv[4], pk[2];
#define ML_PREF(u_) do { int b_, head_, mm_, rb_; scan_unit((u_), b_, head_, mm_, rb_); \
        _Pragma("unroll") for (int i = 0; i < 4; ++i) { const int c_ = tid + NTHR * i; pv[i] = *(const v4u*)(s.P + (size_t)(rb_ + (c_ >> 5)) * NINP + 4096 + head_ * 256 + (c_ & 31) * 8); } \
        _Pragma("unroll") for (int i = 0; i < 2; ++i) { const int c_ = tid + NTHR * i; pk[i] = *(const v4u*)(s.MQK + (size_t)(rb_ + (c_ >> 4)) * 1024 + 512 + head_ * 128 + (c_ & 15) * 8); } } while (0)
    if (bid < 544) ML_PREF(bid);
    for (int u = bid; u < 544; u += G) {
        int b, head, mm, rowbase; scan_unit(u, b, head, mm, rowbase);
#pragma unroll
        for (int i = 0; i < 4; ++i) { const int c_ = tid + NTHR * i; *(LAS v4u*)(Vs + (c_ >> 5) * 528 + (c_ & 31) * 16) = pv[i]; }
#pragma unroll
        for (int i = 0; i < 2; ++i) { const int c_ = tid + NTHR * i; *(LAS v4u*)(Kr + (c_ >> 4) * 272 + (c_ & 15) * 16) = pk[i]; }
        size_t ccd[2];
#pragma unroll
        for (int dir = 0; dir < 2; ++dir) ccd[dir] = (size_t)((b * 4 + head) * 2 + dir) * NCHUNK + scan_chunk(mm, dir);
        if (wave < 2) { const int dir = wave;
            const float ig = bf1(s.P[(size_t)(rowbase + lane) * NINP + 6144 + dir * 8 + head]) + s.mgb[dir * 8 + head];
            const float fg = bf1(s.P[(size_t)(rowbase + lane) * NINP + 6144 + dir * 8 + 4 + head]) + s.mgb[dir * 8 + 4 + head];
            const float lf = logsig_f(fg), bcs = wave_scan_sum(lf, dir, lane), blast = wave_sum(lf);
            const float gs = blast - bcs + ig, mloc = wave_max(gs);
            wv[dir * 64 + lane] = __expf(gs - mloc);
            if (lane == 0) { s.BL[ccd[dir]] = blast; s.ML[ccd[dir]] = mloc; } }
        __syncthreads();
        if (u + G < 544) ML_PREF(u + G);
        { float p0 = 0.f, p1 = 0.f;
#pragma unroll
          for (int tt = 0; tt < 16; ++tt) { const int t = 16 * grp + tt; const float kr = bf1(*(LAS const bf16*)(Kr + t * 272 + dk * 2)); const float k0 = kr * wv[t], k1 = kr * wv[64 + t];
              *(LAS bf16*)(Kh + t * 272 + dk * 2) = f2bf(k0); *(LAS bf16*)(Kh + 17408 + t * 272 + dk * 2) = f2bf(k1); p0 += k0; p1 += k1; }
          dnp[grp * 128 + dk] = p0; dnp[512 + grp * 128 + dk] = p1; }
        __syncthreads();
        if (tid < 256) { const int dir = tid >> 7, d_ = tid & 127; LAS const float* dp = dnp + dir * 512; s.DN[ccd[dir] * 128 + d_] = (dp[d_] + dp[128 + d_]) + (dp[256 + d_] + dp[384 + d_]); }
#pragma unroll
        for (int dir = 0; dir < 2; ++dir) {
            f32x16 acc[4];
#pragma unroll
            for (int nt = 0; nt < 4; ++nt) acc[nt] = zero16();
#pragma unroll
            for (int ks = 0; ks < 4; ++ks) { const bf16x8 af = frag_tr(Vs, 528, 16 * ks, 32 * wave, lane);
#pragma unroll
                for (int nt = 0; nt < 4; ++nt) { const bf16x8 bfr = frag_tr(Kh + dir * 17408, 272, 16 * ks, 32 * nt, lane); acc[nt] = MFMA32(af, bfr, acc[nt]); } }
            bf16* D = s.DSTp + ccd[dir] * 32768;
#pragma unroll
            for (int nt = 0; nt < 4; ++nt)
#pragma unroll
                for (int r = 0; r < 16; ++r) { const int dv = 32 * wave + (r & 3) + 8 * (r >> 2) + 4 * (lane >> 5); D[dv * 128 + 32 * nt + (lane & 31)] = f2bf(acc[nt][r]); }
        }
        __syncthreads();
    }
#undef ML_PREF
}

__device__ __forceinline__ void ph_gla_local(const ScanP& s, bf16* QT, bf16* KT, LAS unsigned char* lds, int tid, int lane, int wave, int bid, int G) {
    LAS unsigned char* Vs = lds; LAS unsigned char* Kh = lds + 33792; LAS unsigned char* Qr = lds + 51200; LAS unsigned char* Kr = lds + 68608;
    LAS float* glr = (LAS float*)(lds + 86016); LAS float* tot = (LAS float*)(lds + 90112);
    const int dk = tid & 127, grp = tid >> 7;
    v4u pv[4], pq[2], pk[2]; bf16 pg[2];
#define GL_PREF(u_) do { const int dir_ = (u_) & 1; int b_, head_, mm_, rb_; scan_unit((u_) >> 1, b_, head_, mm_, rb_); const bf16* base_ = s.P + (size_t)rb_ * NINP; \
        _Pragma("unroll") for (int i = 0; i < 4; ++i) { const int c_ = tid + NTHR * i; pv[i] = *(const v4u*)(base_ + (size_t)(c_ >> 5) * NINP + 1024 + head_ * 256 + (c_ & 31) * 8); } \
        _Pragma("unroll") for (int i = 0; i < 2; ++i) { const int c_ = tid + NTHR * i; pq[i] = *(const v4u*)(base_ + (size_t)(c_ >> 4) * NINP + head_ * 128 + (c_ & 15) * 8); pk[i] = *(const v4u*)(base_ + (size_t)(c_ >> 4) * NINP + 512 + head_ * 128 + (c_ & 15) * 8); \
            pg[i] = base_[(size_t)(c_ >> 4) * NINP + 3072 + dir_ * 16 + (c_ & 15)]; } } while (0)
    if (bid < 1088) GL_PREF(bid);
    for (int u = bid; u < 1088; u += G) {
        const int dir = u & 1; int b, head, mm, rowbase; scan_unit(u >> 1, b, head, mm, rowbase);
        const int chain = (b * 4 + head) * 2 + dir, c = scan_chunk(mm, dir); const size_t cc = (size_t)chain * NCHUNK + c;
#pragma unroll
        for (int i = 0; i < 4; ++i) { const int c_ = tid + NTHR * i; *(LAS v4u*)(Vs + (c_ >> 5) * 528 + (c_ & 31) * 16) = pv[i]; }
#pragma unroll
        for (int i = 0; i < 2; ++i) { const int c_ = tid + NTHR * i; *(LAS v4u*)(Qr + (c_ >> 4) * 272 + (c_ & 15) * 16) = pq[i]; *(LAS v4u*)(Kr + (c_ >> 4) * 272 + (c_ & 15) * 16) = pk[i]; glr[c_] = bf1(pg[i]); }
        __syncthreads();
        if (u + G < 1088) GL_PREF(u + G);
        float bb[16], btot;
        { float w2[16];
#pragma unroll
          for (int r = 0; r < 16; ++r) w2[r] = s.gw2[(dir * 16 + r) * 512 + head * 128 + dk];
          const float bias = s.gb[dir * 512 + head * 128 + dk];
#pragma unroll
          for (int tt = 0; tt < 16; ++tt) { const int t = 16 * grp + tt; float z = bias;
#pragma unroll
              for (int r = 0; r < 16; ++r) z += glr[t * 16 + r] * w2[r];
              bb[tt] = logsig_f(z) * 0.0625f; }
          if (dir == 0) {
#pragma unroll
              for (int tt = 1; tt < 16; ++tt) bb[tt] += bb[tt - 1];
              tot[grp * 128 + dk] = bb[15];
          } else {
#pragma unroll
              for (int tt = 14; tt >= 0; --tt) bb[tt] += bb[tt + 1];
              tot[grp * 128 + dk] = bb[0];
          }
          __syncthreads();
          float off = 0.f; btot = 0.f;
#pragma unroll
          for (int g = 0; g < 4; ++g) { const float tv = tot[g * 128 + dk]; btot += tv; if (dir == 0 ? g < grp : g > grp) off += tv; }
#pragma unroll
          for (int tt = 0; tt < 16; ++tt) bb[tt] += off; }
#pragma unroll
        for (int tt = 0; tt < 16; ++tt) { const int t = 16 * grp + tt;
            const float qv = bf1(*(LAS const bf16*)(Qr + t * 272 + dk * 2)), kv = bf1(*(LAS const bf16*)(Kr + t * 272 + dk * 2));
            const float e1 = __expf(bb[tt]);
            *(LAS bf16*)(Kh + t * 272 + dk * 2) = f2bf(kv * __expf(btot - bb[tt]));
            *(LAS bf16*)(Qr + t * 272 + dk * 2) = f2bf(qv * e1 * 0.08838834764831845f); *(LAS bf16*)(Kr + t * 272 + dk * 2) = f2bf(kv * __builtin_amdgcn_rcpf(e1)); }
        if (grp == 0) s.GAM[cc * 128 + dk] = __expf(btot);
        __syncthreads();
        store_tile(QT + ((size_t)dir * MR + rowbase) * 512 + head * 128, 512, Qr, 272, 64, 128, tid);
        store_tile(KT + ((size_t)dir * MR + rowbase) * 512 + head * 128, 512, Kr, 272, 64, 128, tid);
        f32x16 acc[4];
#pragma unroll
        for (int nt = 0; nt < 4; ++nt) acc[nt] = zero16();
#pragma unroll
        for (int ks = 0; ks < 4; ++ks) { const bf16x8 af = frag_tr(Vs, 528, 16 * ks, 32 * wave, lane);
#pragma unroll
            for (int nt = 0; nt < 4; ++nt) { const bf16x8 bfr = frag_tr(Kh, 272, 16 * ks, 32 * nt, lane); acc[nt] = MFMA32(af, bfr, acc[nt]); } }
        __syncthreads();
#pragma unroll
        for (int nt = 0; nt < 4; ++nt)
#pragma unroll
            for (int r = 0; r < 16; ++r) { const int dv = 32 * wave + (r & 3) + 8 * (r >> 2) + 4 * (lane >> 5); *(LAS bf16*)(lds + dv * 272 + (32 * nt + (lane & 31)) * 2) = f2bf(acc[nt][r]); }
        __syncthreads();
        store_tile(s.DSTp + cc * 32768, 128, lds, 272, 256, 128, tid);
        __syncthreads();
    }
}
#undef GL_PREF
__device__ __forceinline__ void ph_gla_out(const ScanP& s, const bf16* QT, const bf16* KT, LAS unsigned char* lds, int tid, int lane, int wave, int bid, int G) {
    LAS unsigned char* Vs = lds;
    LAS unsigned char* Qx = lds + 33792;
    LAS unsigned char* Ki = lds + 68608;
    LAS unsigned char* Am = lds + 103424;
    LAS float* Os = (LAS float*)lds;
    v4u pv[4], pq[2][2], pk[2][2];
#define GO_PREF(u_) do { int b_, head_, mm_, rb_; scan_unit((u_), b_, head_, mm_, rb_); \
        _Pragma("unroll") for (int i = 0; i < 4; ++i) { const int c_ = tid + NTHR * i; pv[i] = *(const v4u*)(s.P + (size_t)(rb_ + (c_ >> 5)) * NINP + 1024 + head_ * 256 + (c_ & 31) * 8); } \
        _Pragma("unroll") for (int d_ = 0; d_ < 2; ++d_) _Pragma("unroll") for (int i = 0; i < 2; ++i) { const int c_ = tid + NTHR * i; const size_t o_ = ((size_t)d_ * MR + rb_ + (c_ >> 4)) * 512 + head_ * 128 + (c_ & 15) * 8; \
            pq[d_][i] = *(const v4u*)(QT + o_); pk[d_][i] = *(const v4u*)(KT + o_); } } while (0)
    if (bid < 544) GO_PREF(bid);
    for (int u = bid; u < 544; u += G) {
        int b, head, mm, rowbase; scan_unit(u, b, head, mm, rowbase);
#pragma unroll
        for (int i = 0; i < 4; ++i) { const int c_ = tid + NTHR * i; *(LAS v4u*)(Vs + (c_ >> 5) * 528 + (c_ & 31) * 16) = pv[i]; }
#pragma unroll
        for (int d_ = 0; d_ < 2; ++d_)
#pragma unroll
            for (int i = 0; i < 2; ++i) { const int c_ = tid + NTHR * i; *(LAS v4u*)(Qx + d_ * 17408 + (c_ >> 4) * 272 + (c_ & 15) * 16) = pq[d_][i]; *(LAS v4u*)(Ki + d_ * 17408 + (c_ >> 4) * 272 + (c_ & 15) * 16) = pk[d_][i]; }
        bf16x8 sf[2][8];
#pragma unroll
        for (int dir = 0; dir < 2; ++dir) { const int chain = (b * 4 + head) * 2 + dir, c = scan_chunk(mm, dir); const size_t cc = (size_t)chain * NCHUNK + c;
            const bf16* Sg = s.SSTp + cc * 32768 + (size_t)(32 * wave + (lane & 31)) * 128 + 8 * (lane >> 5);
#pragma unroll
            for (int ks = 0; ks < 8; ++ks) sf[dir][ks] = *(const bf16x8*)(Sg + 16 * ks); }
        __syncthreads();
        if (u + G < 544) GO_PREF(u + G);
        {
            const int dir = wave >> 2, ti = (wave >> 1) & 1, tj = wave & 1; f32x16 acc = zero16();
#pragma unroll
            for (int ks = 0; ks < 8; ++ks) { const bf16x8 af = frag_row(Qx + dir * 17408, 272, 32 * ti, 16 * ks, lane), bfr = frag_row(Ki + dir * 17408, 272, 32 * tj, 16 * ks, lane); acc = MFMA32(af, bfr, acc); }
            const int sidx = 32 * tj + (lane & 31);
#pragma unroll
            for (int r = 0; r < 16; ++r) { const int t = 32 * ti + (r & 3) + 8 * (r >> 2) + 4 * (lane >> 5);
                const bool keep = dir == 0 ? (sidx <= t) : (sidx >= t);
                *(LAS bf16*)(Am + dir * 9216 + t * 144 + sidx * 2) = f2bf(keep ? acc[r] : 0.f); }
        }
        __syncthreads();
        f32x16 acc2[2]; acc2[0] = zero16(); acc2[1] = zero16();
#pragma unroll
        for (int dir = 0; dir < 2; ++dir) {
#pragma unroll
            for (int ks = 0; ks < 8; ++ks)
#pragma unroll
                for (int rt = 0; rt < 2; ++rt) { const bf16x8 af = frag_row(Qx + dir * 17408, 272, 32 * rt, 16 * ks, lane); acc2[rt] = MFMA32(af, sf[dir][ks], acc2[rt]); }
#pragma unroll
            for (int ks = 0; ks < 4; ++ks) { const bf16x8 bfr = frag_tr(Vs, 528, 16 * ks, 32 * wave, lane);
#pragma unroll
                for (int rt = 0; rt < 2; ++rt) { const bf16x8 af = frag_row(Am + dir * 9216, 144, 32 * rt, 16 * ks, lane); acc2[rt] = MFMA32(af, bfr, acc2[rt]); } }
        }
        __syncthreads();
#pragma unroll
        for (int rt = 0; rt < 2; ++rt)
#pragma unroll
            for (int r = 0; r < 16; ++r) { const int t = 32 * rt + (r & 3) + 8 * (r >> 2) + 4 * (lane >> 5); Os[t * 260 + 32 * wave + (lane & 31)] = acc2[rt][r]; }
        __syncthreads();
        { const int t = tid >> 3, part = tid & 7; float o[32]; float ss = 0.f;
#pragma unroll
          for (int j = 0; j < 8; ++j) { const f32x4 v = *(LAS const f32x4*)(Os + t * 260 + 32 * part + 4 * j); o[4 * j] = v.x; o[4 * j + 1] = v.y; o[4 * j + 2] = v.z; o[4 * j + 3] = v.w; ss += (v.x * v.x + v.y * v.y) + (v.z * v.z + v.w * v.w); }
          ss += __shfl_xor(ss, 1); ss += __shfl_xor(ss, 2); ss += __shfl_xor(ss, 4);
          const float rn = rsqrtf(ss * (1.f / 256.f) + EPS);
          const size_t row = (size_t)(rowbase + t);
          const bf16* gsrc = s.P + row * NINP + 2048 + head * 256 + 32 * part;
          bf16* dst = s.MIX + row * DM + head * 256 + 32 * part;
#pragma unroll
          for (int j = 0; j < 4; ++j) { float gv[8], ov[8]; unpack8(*(const v4u*)(gsrc + 8 * j), gv);
#pragma unroll
              for (int e = 0; e < 8; ++e) ov[e] = o[8 * j + e] * rn * s.ng[32 * part + 8 * j + e] * silu_f(gv[e]);
              *(v4u*)(dst + 8 * j) = pack8(ov); } }
        __syncthreads();
    }
}

#undef GO_PREF
__device__ __forceinline__ void ph_mlstm_out(const ScanP& s, LAS unsigned char* lds, int tid, int lane, int wave, int bid, int G) {
    LAS unsigned char* Vs = lds; LAS unsigned char* Qi = lds + 33792; LAS unsigned char* Ki = lds + 51200; LAS unsigned char* Qx = lds + 68608; LAS unsigned char* Am = lds + 103424;
    LAS float* sc = (LAS float*)(lds + 121856);
    LAS float* qnp = (LAS float*)(lds + 125952);
    LAS float* Os = (LAS float*)lds;
    v4u pv[4], pq[2], pk[2];
#define MO_PREF(u_) do { int b_, head_, mm_, rb_; scan_unit((u_), b_, head_, mm_, rb_); \
        _Pragma("unroll") for (int i = 0; i < 4; ++i) { const int c_ = tid + NTHR * i; pv[i] = *(const v4u*)(s.P + (size_t)(rb_ + (c_ >> 5)) * NINP + 4096 + head_ * 256 + (c_ & 31) * 8); } \
        _Pragma("unroll") for (int i = 0; i < 2; ++i) { const int c_ = tid + NTHR * i; const size_t o_ = (size_t)(rb_ + (c_ >> 4)) * 1024 + head_ * 128 + (c_ & 15) * 8; pq[i] = *(const v4u*)(s.MQK + o_); pk[i] = *(const v4u*)(s.MQK + o_ + 512); } } while (0)
    if (bid < 544) MO_PREF(bid);
    for (int u = bid; u < 544; u += G) {
        int b, head, mm, rowbase; scan_unit(u, b, head, mm, rowbase);
#pragma unroll
        for (int i = 0; i < 4; ++i) { const int c_ = tid + NTHR * i; *(LAS v4u*)(Vs + (c_ >> 5) * 528 + (c_ & 31) * 16) = pv[i]; }
#pragma unroll
        for (int i = 0; i < 2; ++i) { const int c_ = tid + NTHR * i; *(LAS v4u*)(Qi + (c_ >> 4) * 272 + (c_ & 15) * 16) = pq[i]; *(LAS v4u*)(Ki + (c_ >> 4) * 272 + (c_ & 15) * 16) = pk[i]; }
        size_t ccd[2];
#pragma unroll
        for (int dir = 0; dir < 2; ++dir) ccd[dir] = (size_t)((b * 4 + head) * 2 + dir) * NCHUNK + scan_chunk(mm, dir);
        bf16x8 sf[2][8];
#pragma unroll
        for (int dir = 0; dir < 2; ++dir) { const bf16* Sg = s.SSTp + ccd[dir] * 32768 + (size_t)(32 * wave + (lane & 31)) * 128 + 8 * (lane >> 5);
#pragma unroll
            for (int ks = 0; ks < 8; ++ks) sf[dir][ks] = *(const bf16x8*)(Sg + 16 * ks); }
        if (wave < 2) { const int dir = wave; LAS float* d = sc + dir * 512;
            const float ig = bf1(s.P[(size_t)(rowbase + lane) * NINP + 6144 + dir * 8 + head]) + s.mgb[dir * 8 + head];
            const float fg = bf1(s.P[(size_t)(rowbase + lane) * NINP + 6144 + dir * 8 + 4 + head]) + s.mgb[dir * 8 + 4 + head];
            const float lf = logsig_f(fg), bcs = wave_scan_sum(lf, dir, lane);
            const float uu = ig - bcs, pm = wave_scan_max(uu, dir, lane), min_ = s.MINp[ccd[dir]], Mt = fmaxf(min_, pm);
            d[lane] = uu; d[64 + lane] = Mt; d[128 + lane] = __expf(min_ - Mt); d[192 + lane] = __expf(-bcs - Mt); }
        __syncthreads();
        if (u + G < 544) MO_PREF(u + G);
        { const int t = tid & 63, part = tid >> 6;
          float a0 = 0.f, a1 = 0.f; const float w0 = sc[128 + t], w1 = sc[512 + 128 + t];
#pragma unroll
          for (int hh = 0; hh < 2; ++hh) { float qv[8], o0[8], o1[8]; unpack8(*(LAS const v4u*)(Qi + t * 272 + (part * 16 + 8 * hh) * 2), qv);
              const float* n0p = s.NIN + ccd[0] * 128 + part * 16 + 8 * hh; const float* n1p = s.NIN + ccd[1] * 128 + part * 16 + 8 * hh;
              const f32x4 n00 = *(const f32x4*)n0p, n01 = *(const f32x4*)(n0p + 4), n10 = *(const f32x4*)n1p, n11 = *(const f32x4*)(n1p + 4);
              a0 += (qv[0] * n00.x + qv[1] * n00.y) + (qv[2] * n00.z + qv[3] * n00.w) + (qv[4] * n01.x + qv[5] * n01.y) + (qv[6] * n01.z + qv[7] * n01.w);
              a1 += (qv[0] * n10.x + qv[1] * n10.y) + (qv[2] * n10.z + qv[3] * n10.w) + (qv[4] * n11.x + qv[5] * n11.y) + (qv[6] * n11.z + qv[7] * n11.w);
#pragma unroll
              for (int e = 0; e < 8; ++e) { o0[e] = qv[e] * w0; o1[e] = qv[e] * w1; }
              *(LAS v4u*)(Qx + t * 272 + (part * 16 + 8 * hh) * 2) = pack8(o0); *(LAS v4u*)(Qx + 17408 + t * 272 + (part * 16 + 8 * hh) * 2) = pack8(o1); }
          qnp[part * 64 + t] = a0; qnp[512 + part * 64 + t] = a1; }
        {
            const int dir = wave >> 2, ti = (wave >> 1) & 1, tj = wave & 1; LAS const float* d = sc + dir * 512; f32x16 acc = zero16();
#pragma unroll
            for (int ks = 0; ks < 8; ++ks) { const bf16x8 af = frag_row(Qi, 272, 32 * ti, 16 * ks, lane), bfr = frag_row(Ki, 272, 32 * tj, 16 * ks, lane); acc = MFMA32(af, bfr, acc); }
            const int sidx = 32 * tj + (lane & 31); const float usv = d[sidx];
#pragma unroll
            for (int r = 0; r < 16; ++r) { const int t = 32 * ti + (r & 3) + 8 * (r >> 2) + 4 * (lane >> 5);
                const bool keep = dir == 0 ? (sidx <= t) : (sidx >= t);
                const float v = keep ? acc[r] * __expf(usv - d[64 + t]) : 0.f;
                *(LAS bf16*)(Am + dir * 9216 + t * 144 + sidx * 2) = f2bf(v);
                float rsum = v; rsum += __shfl_xor(rsum, 1); rsum += __shfl_xor(rsum, 2); rsum += __shfl_xor(rsum, 4); rsum += __shfl_xor(rsum, 8); rsum += __shfl_xor(rsum, 16);
                if ((lane & 31) == 0) (sc + dir * 512)[384 + tj * 64 + t] = rsum; }
        }
        __syncthreads();
        if (tid < 128) { const int dir = tid >> 6, t = tid & 63; LAS float* d = sc + dir * 512; float q = 0.f;
#pragma unroll
            for (int p = 0; p < 8; ++p) q += qnp[dir * 512 + p * 64 + t];
            const float den = d[128 + t] * q + d[384 + t] + d[448 + t]; d[256 + t] = 1.f / fmaxf(fabsf(den), d[192 + t]); }
        f32x16 ad[2][2];
#pragma unroll
        for (int dir = 0; dir < 2; ++dir) { ad[dir][0] = zero16(); ad[dir][1] = zero16();
#pragma unroll
            for (int ks = 0; ks < 8; ++ks)
#pragma unroll
                for (int rt = 0; rt < 2; ++rt) { const bf16x8 af = frag_row(Qx + dir * 17408, 272, 32 * rt, 16 * ks, lane); ad[dir][rt] = MFMA32(af, sf[dir][ks], ad[dir][rt]); }
#pragma unroll
            for (int ks = 0; ks < 4; ++ks) { const bf16x8 bfr = frag_tr(Vs, 528, 16 * ks, 32 * wave, lane);
#pragma unroll
                for (int rt = 0; rt < 2; ++rt) { const bf16x8 af = frag_row(Am + dir * 9216, 144, 32 * rt, 16 * ks, lane); ad[dir][rt] = MFMA32(af, bfr, ad[dir][rt]); } } }
        __syncthreads();
#pragma unroll
        for (int rt = 0; rt < 2; ++rt)
#pragma unroll
            for (int r = 0; r < 16; ++r) { const int t = 32 * rt + (r & 3) + 8 * (r >> 2) + 4 * (lane >> 5); ad[0][rt][r] = ad[0][rt][r] * sc[256 + t] + ad[1][rt][r] * sc[512 + 256 + t]; }
        __syncthreads();
#pragma unroll
        for (int rt = 0; rt < 2; ++rt)
#pragma unroll
            for (int r = 0; r < 16; ++r) { const int t = 32 * rt + (r & 3) + 8 * (r >> 2) + 4 * (lane >> 5); Os[t * 260 + 32 * wave + (lane & 31)] = ad[0][rt][r]; }
        __syncthreads();
        { const int t = tid >> 3, part = tid & 7; float o[32]; float ss = 0.f;
#pragma unroll
          for (int j = 0; j < 8; ++j) { const f32x4 v = *(LAS const f32x4*)(Os + t * 260 + 32 * part + 4 * j); o[4 * j] = v.x; o[4 * j + 1] = v.y; o[4 * j + 2] = v.z; o[4 * j + 3] = v.w; ss += (v.x * v.x + v.y * v.y) + (v.z * v.z + v.w * v.w); }
          ss += __shfl_xor(ss, 1); ss += __shfl_xor(ss, 2); ss += __shfl_xor(ss, 4);
          const float rn = rsqrtf(ss * (1.f / 256.f) + EPS);
          const size_t row = (size_t)(rowbase + t);
          const bf16* gsrc = s.P + row * NINP + 5120 + head * 256 + 32 * part;
          bf16* dst = s.MIX + row * DM + 1024 + head * 256 + 32 * part;
#pragma unroll
          for (int j = 0; j < 4; ++j) { float gv[8], ov[8]; unpack8(*(const v4u*)(gsrc + 8 * j), gv);
#pragma unroll
              for (int e = 0; e < 8; ++e) ov[e] = o[8 * j + e] * rn * s.ng[32 * part + 8 * j + e] * sigmoid_f(gv[e]);
              *(v4u*)(dst + 8 * j) = pack8(ov); } }
        __syncthreads();
    }
}

#undef MO_PREF
template <int MODE>
__device__ __forceinline__ void ph_scan_carry(const ScanP& s, int gtid, int NT) {
    for (int e = gtid; e < 16 * 8192; e += NT) {
        const int chain = e >> 13, rem = e & 8191, dv = rem >> 5, dk = (rem & 31) * 4;
        f32x4 st = {0.f, 0.f, 0.f, 0.f}, nst = st; float m = 0.f;
        for (int c0 = 0; c0 < NCHUNK; c0 += 4) {
            f32x4 d[4], gm[4]; float bl[4], ml[4];
#pragma unroll
            for (int j = 0; j < 4; ++j) { const size_t cc = (size_t)chain * NCHUNK + c0 + j; { const v2u dw = *(const v2u*)(s.DSTp + cc * 32768 + dv * 128 + dk); d[j] = (f32x4){bf_lo(dw.x), bf_hi(dw.x), bf_lo(dw.y), bf_hi(dw.y)}; }
                if (MODE == 0) gm[j] = *(const f32x4*)(s.GAM + cc * 128 + dk);
                else { bl[j] = s.BL[cc]; ml[j] = s.ML[cc]; gm[j] = (dv == 0) ? *(const f32x4*)(s.DN + cc * 128 + dk) : (f32x4){0.f, 0.f, 0.f, 0.f}; } }
#pragma unroll
            for (int j = 0; j < 4; ++j) { const size_t cc = (size_t)chain * NCHUNK + c0 + j;
                v2u o; o.x = pk2(st.x, st.y); o.y = pk2(st.z, st.w); *(v2u*)(s.SSTp + cc * 32768 + dv * 128 + dk) = o;
                if (MODE == 0) st = gm[j] * st + d[j];
                else { if (dv == 0) { *(f32x4*)(s.NIN + cc * 128 + dk) = nst; if (dk == 0) s.MINp[cc] = m; }
                    const float mn = fmaxf(bl[j] + m, ml[j]), dec = __expf(bl[j] + m - mn), sc = __expf(ml[j] - mn);
                    st = st * dec + d[j] * sc; nst = nst * dec + gm[j] * sc; m = mn; } }
        }
    }
}

template <int MODE>
__device__ __forceinline__ void ph_scan_out(const ScanP& s, LAS unsigned char* lds, int tid, int lane, int wave, int bid, int G) {
    LAS unsigned char* Vs = lds; LAS unsigned char* Qx = lds + 33792; LAS unsigned char* Ki = lds + 51200; LAS unsigned char* Qi = lds + 68608; LAS unsigned char* Am = lds + 86016;
    LAS float* glr = (LAS float*)(lds + 95232); LAS float* tot = (LAS float*)(lds + 103424);
    LAS float* us = (LAS float*)(lds + 105472); LAS float* Mts = us + 64; LAS float* wint = us + 128; LAS float* thr = us + 192; LAS float* fac = us + 256; LAS float* qn = us + 320; LAS float* rs = us + 384;
    LAS float* qnp = (LAS float*)(lds + 107520);
    LAS float* Os = (LAS float*)lds;
    const int dk = tid & 127, grp = tid >> 7;
    for (int u = bid; u < 544; u += G) {
        int b, head, mm, rowbase; scan_unit(u, b, head, mm, rowbase);
        load_tile(Vs, 528, s.P + (size_t)rowbase * NINP + (MODE ? 4096 : 1024) + head * 256, NINP, 64, 256, tid);
        if (MODE == 0) { for (int e = tid; e < 2048; e += NTHR) glr[e] = bf1(s.P[(size_t)(rowbase + (e >> 5)) * NINP + 3072 + (e & 31)]); if (tid < 64) fac[tid] = 1.f; }
        else { load_tile(Qi, 272, s.MQK + (size_t)rowbase * 1024 + head * 128, 1024, 64, 128, tid); load_tile(Ki, 272, s.MQK + (size_t)rowbase * 1024 + 512 + head * 128, 1024, 64, 128, tid); }
        f32x16 hsum[2]; hsum[0] = zero16(); hsum[1] = zero16();
        __syncthreads();
        for (int dir = 0; dir < 2; ++dir) {
            const int chain = (b * 4 + head) * 2 + dir, c = scan_chunk(mm, dir); const size_t cc = (size_t)chain * NCHUNK + c;
            if (MODE == 0) {
                float bb[16], btot; gla_gates(s, glr, tot, head, dir, tid, bb, btot);
#pragma unroll
                for (int tt = 0; tt < 16; ++tt) { const int t = 16 * grp + tt; const size_t ro = (size_t)(rowbase + t) * NINP + head * 128 + dk;
                    const float qv = bf1(s.P[ro]), kv = bf1(s.P[ro + 512]);
                    *(LAS bf16*)(Qx + t * 272 + dk * 2) = f2bf(qv * __expf(bb[tt]) * 0.08838834764831845f);
                    *(LAS bf16*)(Ki + t * 272 + dk * 2) = f2bf(kv * __expf(-bb[tt])); }
            } else {
                if (wave == 0) {
                    const float ig = bf1(s.P[(size_t)(rowbase + lane) * NINP + 6144 + dir * 8 + head]) + s.mgb[dir * 8 + head];
                    const float fg = bf1(s.P[(size_t)(rowbase + lane) * NINP + 6144 + dir * 8 + 4 + head]) + s.mgb[dir * 8 + 4 + head];
                    const float lf = logsig_f(fg), bcs = wave_scan_sum(lf, dir, lane);
                    const float uu = ig - bcs, pm = wave_scan_max(uu, dir, lane), min_ = s.MINp[cc], Mt = fmaxf(min_, pm);
                    us[lane] = uu; Mts[lane] = Mt; wint[lane] = __expf(min_ - Mt); thr[lane] = __expf(-bcs - Mt);
                }
                __syncthreads();
                { const int t = tid & 63, part = tid >> 6; float acc = 0.f;
                  const float wi = wint[t];
#pragma unroll
                  for (int hh = 0; hh < 2; ++hh) { float qv[8], ov[8]; unpack8(*(LAS const v4u*)(Qi + t * 272 + (part * 16 + 8 * hh) * 2), qv);
                      const f32x4 n0 = *(const f32x4*)(s.NIN + cc * 128 + part * 16 + 8 * hh), n1 = *(const f32x4*)(s.NIN + cc * 128 + part * 16 + 8 * hh + 4);
                      acc += (qv[0] * n0.x + qv[1] * n0.y) + (qv[2] * n0.z + qv[3] * n0.w) + (qv[4] * n1.x + qv[5] * n1.y) + (qv[6] * n1.z + qv[7] * n1.w);
#pragma unroll
                      for (int e = 0; e < 8; ++e) ov[e] = qv[e] * wi;
                      *(LAS v4u*)(Qx + t * 272 + (part * 16 + 8 * hh) * 2) = pack8(ov); }
                  qnp[part * 64 + t] = acc; }
            }
            __syncthreads();
            if (MODE == 1 && tid < 64) { float q = 0.f;
#pragma unroll
                for (int p = 0; p < 8; ++p) q += qnp[p * 64 + tid];
                qn[tid] = q; }
            if (wave < 4) {
                const int ti = wave >> 1, tj = wave & 1; f32x16 acc = zero16();
#pragma unroll
                for (int ks = 0; ks < 8; ++ks) { const bf16x8 af = frag_row(MODE ? Qi : Qx, 272, 32 * ti, 16 * ks, lane), bfr = frag_row(Ki, 272, 32 * tj, 16 * ks, lane); acc = MFMA32(af, bfr, acc); }
                const int sidx = 32 * tj + (lane & 31);
                const float usv = MODE ? us[sidx] : 0.f;
#pragma unroll
                for (int r = 0; r < 16; ++r) { const int t = 32 * ti + (r & 3) + 8 * (r >> 2) + 4 * (lane >> 5);
                    const bool keep = dir == 0 ? (sidx <= t) : (sidx >= t);
                    float v = acc[r];
                    if (MODE == 1) v *= __expf(usv - Mts[t]);
                    v = keep ? v : 0.f;
                    *(LAS bf16*)(Am + t * 144 + sidx * 2) = f2bf(v);
                    if (MODE == 1) { float rsum = v; rsum += __shfl_xor(rsum, 1); rsum += __shfl_xor(rsum, 2); rsum += __shfl_xor(rsum, 4); rsum += __shfl_xor(rsum, 8); rsum += __shfl_xor(rsum, 16);
                        if ((lane & 31) == 0) rs[tj * 64 + t] = rsum; } }
            }
            __syncthreads();
            if (MODE == 1 && tid < 64) { const float den = wint[tid] * qn[tid] + rs[tid] + rs[64 + tid]; fac[tid] = 1.f / fmaxf(fabsf(den), thr[tid]); }
            f32x16 acc2[2]; acc2[0] = zero16(); acc2[1] = zero16();
            { const bf16* Sg = s.SSTp + cc * 32768 + (size_t)(32 * wave + (lane & 31)) * 128 + 8 * (lane >> 5);
#pragma unroll
              for (int ks = 0; ks < 8; ++ks) { const bf16x8 bfr = *(const bf16x8*)(Sg + 16 * ks);
#pragma unroll
                  for (int rt = 0; rt < 2; ++rt) { const bf16x8 af = frag_row(Qx, 272, 32 * rt, 16 * ks, lane); acc2[rt] = MFMA32(af, bfr, acc2[rt]); } } }
#pragma unroll
            for (int ks = 0; ks < 4; ++ks) { const bf16x8 bfr = frag_tr(Vs, 528, 16 * ks, 32 * wave, lane);
#pragma unroll
                for (int rt = 0; rt < 2; ++rt) { const bf16x8 af = frag_row(Am, 144, 32 * rt, 16 * ks, lane); acc2[rt] = MFMA32(af, bfr, acc2[rt]); } }
            __syncthreads();
#pragma unroll
            for (int rt = 0; rt < 2; ++rt)
#pragma unroll
                for (int r = 0; r < 16; ++r) { const int t = 32 * rt + (r & 3) + 8 * (r >> 2) + 4 * (lane >> 5); hsum[rt][r] += acc2[rt][r] * fac[t]; }
        }
        __syncthreads();
#pragma unroll
        for (int rt = 0; rt < 2; ++rt)
#pragma unroll
            for (int r = 0; r < 16; ++r) { const int t = 32 * rt + (r & 3) + 8 * (r >> 2) + 4 * (lane >> 5); Os[t * 260 + 32 * wave + (lane & 31)] = hsum[rt][r]; }
        __syncthreads();
        { const int t = tid >> 3, part = tid & 7; float o[32]; float ss = 0.f;
#pragma unroll
          for (int j = 0; j < 8; ++j) { const f32x4 v = *(LAS const f32x4*)(Os + t * 260 + 32 * part + 4 * j); o[4 * j] = v.x; o[4 * j + 1] = v.y; o[4 * j + 2] = v.z; o[4 * j + 3] = v.w; ss += (v.x * v.x + v.y * v.y) + (v.z * v.z + v.w * v.w); }
          ss += __shfl_xor(ss, 1); ss += __shfl_xor(ss, 2); ss += __shfl_xor(ss, 4);
          const float rn = rsqrtf(ss * (1.f / 256.f) + EPS);
          const size_t row = (size_t)(rowbase + t);
          const bf16* gsrc = s.P + row * NINP + (MODE ? 5120 : 2048) + head * 256 + 32 * part;
          bf16* dst = s.MIX + row * DM + (MODE ? 1024 : 0) + head * 256 + 32 * part;
#pragma unroll
          for (int j = 0; j < 4; ++j) { float gv[8], ov[8]; unpack8(*(const v4u*)(gsrc + 8 * j), gv);
#pragma unroll
              for (int e = 0; e < 8; ++e) { const float gt = MODE ? sigmoid_f(gv[e]) : silu_f(gv[e]); ov[e] = o[8 * j + e] * rn * s.ng[32 * part + 8 * j + e] * gt; }
              *(v4u*)(dst + 8 * j) = pack8(ov); } }
        __syncthreads();
    }
}

__device__ __forceinline__ void glds16(const void* sbase  , unsigned voff  , unsigned lds_dst  ) { unsigned keep;
    asm volatile("s_mov_b32 %0, m0\n\ts_mov_b32 m0, %3\n\ts_nop 0\n\tglobal_load_lds_dwordx4 %1, %2\n\ts_mov_b32 m0, %0" : "=&s"(keep) : "v"(voff), "s"(sbase), "s"(lds_dst) : "memory"); }
struct AttnP { const bf16* QR; const bf16* KR; const bf16* P; bf16* MIX; const float* lamp; const float* subg; const float* qg; const float* kg; float lam_init; unsigned* queue; };
template <bool SUB>
__device__ __forceinline__ void ph_attn(const AttnP& p, LAS unsigned char* lds, int tid, int lane, int wave, int bid, int G) {
    const float l01 = wave_sum(p.lamp[lane] * p.lamp[64 + lane]), l23 = wave_sum(p.lamp[128 + lane] * p.lamp[192 + lane]);
    const float lam = __expf(l01) - __expf(l23) + p.lam_init;
    const float negm2 = -8.f * wave_max(fabsf(p.qg[lane])) * wave_max(fabsf(p.kg[lane])) * 1.4426950408889634f * 1.02f;
    const int r = lane & 31, h = lane >> 5, mp = wave >> 2, wq = wave & 3;
    LAS float* Ex = (LAS float*)lds;
    const unsigned xcc = xb_xcc_id() & 7u;
    volatile LAS int* qslot = (volatile LAS int*)(lds + MISC_OFF + 96);
    for (int qq = 0; qq < 8; ++qq) for (;;) {
        const int hd = (int)((xcc + (unsigned)qq) & 7u);
        if (tid == 0) qslot[0] = (int)__hip_atomic_fetch_add(p.queue + 16 * hd, 1u, __ATOMIC_RELAXED, __HIP_MEMORY_SCOPE_AGENT);
        __syncthreads();
        const int idx = qslot[0];
        __syncthreads();
        if (idx >= 68) break;
        int b, qrow0, nkt;
        if (idx < 64) { b = idx >> 5; qrow0 = b * 4096 + 128 * (idx & 31); nkt = 68; }
        else { const int uu = idx - 64; b = uu >> 1; qrow0 = NLATR + b * 256 + 128 * (uu & 1); nkt = 4; }
        const int qrow = qrow0 + 32 * wq + r;
        bf16x8 Qf[4];
#pragma unroll
        for (int ks = 0; ks < 4; ++ks) Qf[ks] = *(const bf16x8*)(p.QR + (size_t)qrow * 1024 + (hd * 2 + mp) * 64 + 16 * ks + 8 * h);
        f32x16 O[4];
#pragma unroll
        for (int dt = 0; dt < 4; ++dt) O[dt] = zero16();
        float ls = 0.f;
        const int dq = lane >> 4, dp = lane & 15;
        unsigned voffK[4], voffV[4];
#pragma unroll
        for (int j = 0; j < 4; ++j) { const unsigned ch = 16u * (unsigned)(dp ^ ((dq << 2) | j)); voffK[j] = (unsigned)dq * 2048u + ch; voffV[j] = (unsigned)dq * (unsigned)(NINP * 2) + ch; }
        int kaddr[4], vaddr[2][4];
#pragma unroll
        for (int ks = 0; ks < 4; ++ks) kaddr[ks] = swz_off(r, 8 * mp + 2 * ks + h);
        { const int blk = (lane >> 4) & 1, q = (lane & 15) >> 2, pp = lane & 3;
#pragma unroll
          for (int e = 0; e < 2; ++e)
#pragma unroll
              for (int dt = 0; dt < 4; ++dt) vaddr[e][dt] = swz_off(4 * h + q + 8 * e, 4 * dt + 2 * blk + (pp >> 1)) + 8 * (pp & 1); }
        const int nkt2 = nkt >> 1;
        const unsigned ldsb = (unsigned)(size_t)lds;
#define AT_DMA(kt_, buf_) do { const int krow_ = (kt_) < 2 ? NLATR + b * 256 + 128 * (kt_) : b * 4096 + 128 * ((kt_) - 2); \
            _Pragma("unroll") for (int j = 0; j < 4; ++j) { const int g_ = 4 * wave + j, row_ = krow_ + 4 * g_; \
                glds16(p.KR + (size_t)row_ * 1024 + hd * 128, voffK[j], (unsigned)__builtin_amdgcn_readfirstlane((int)(ldsb + (buf_) * 32768 + 1024 * g_))); \
                glds16(p.P + (size_t)row_ * NINP + 2048 + hd * 128, voffV[j], (unsigned)__builtin_amdgcn_readfirstlane((int)(ldsb + 65536 + (buf_) * 32768 + 1024 * g_))); } } while (0)
#define AT_QK(S_, kb_) do { S_ = zero16(); _Pragma("unroll") for (int ks = 0; ks < 4; ++ks) { const bf16x8 a0 = *(LAS const bf16x8*)(Kt + kaddr[ks] + 8192 * (kb_)); S_ = MFMA32(a0, Qf[ks], S_); } } while (0)
        AT_DMA(0, 0);
        asm volatile("s_waitcnt vmcnt(0)" ::: "memory");
        __syncthreads();
        for (int kt = 0; kt < nkt2; ++kt) {
            const bool more = kt + 1 < nkt2;
            if (more) AT_DMA(kt + 1, (kt + 1) & 1);
            LAS const unsigned char* Kt = lds + (kt & 1) * 32768; LAS const unsigned char* Vt = lds + 65536 + (kt & 1) * 32768;
#define AT_VF(dst_, kb_, dt_) do { const s16x4 t0_ = tr4(Vt + vaddr[0][dt_] + 8192 * (kb_)), t1_ = tr4(Vt + vaddr[1][dt_] + 8192 * (kb_)), t2_ = tr4(Vt + vaddr[0][dt_] + 8192 * (kb_) + 4096), t3_ = tr4(Vt + vaddr[1][dt_] + 8192 * (kb_) + 4096); \
                dst_[0] = (bf16x8){t0_[0], t0_[1], t0_[2], t0_[3], t1_[0], t1_[1], t1_[2], t1_[3]}; dst_[1] = (bf16x8){t2_[0], t2_[1], t2_[2], t2_[3], t3_[0], t3_[1], t3_[2], t3_[3]}; } while (0)
            bf16x8 kf[4], P0, P1;
#pragma unroll
            for (int ks = 0; ks < 4; ++ks) kf[ks] = *(LAS const bf16x8*)(Kt + kaddr[ks]);
            { f32x16 S0 = zero16();
#pragma unroll
              for (int ks = 0; ks < 4; ++ks) S0 = MFMA32(kf[ks], Qf[ks], S0);
#pragma unroll
              for (int ks = 0; ks < 4; ++ks) kf[ks] = *(LAS const bf16x8*)(Kt + kaddr[ks] + 8192);
              unsigned pf[8]; float lacc = 0.f;
#pragma unroll
              for (int i = 0; i < 8; ++i) { const float e0 = __builtin_amdgcn_exp2f(SUB ? S0[2 * i] + negm2 : S0[2 * i]), e1 = __builtin_amdgcn_exp2f(SUB ? S0[2 * i + 1] + negm2 : S0[2 * i + 1]); lacc += e0 + e1; pf[i] = pk2(e0, e1); }
              ls += lacc;
              P0 = __builtin_bit_cast(bf16x8, (v4u){pf[0], pf[1], pf[2], pf[3]}); P1 = __builtin_bit_cast(bf16x8, (v4u){pf[4], pf[5], pf[6], pf[7]}); }
            __builtin_amdgcn_sched_barrier(0);
#pragma unroll
            for (int kb = 0; kb < 4; ++kb) {
                bf16x8 v0[2], v1[2], v2[2], v3[2];
                AT_VF(v0, kb, 0); AT_VF(v1, kb, 1); AT_VF(v2, kb, 2); AT_VF(v3, kb, 3);
                f32x16 Sn = zero16();
                if (kb < 3) {
#pragma unroll
                    for (int ks = 0; ks < 4; ++ks) Sn = MFMA32(kf[ks], Qf[ks], Sn);
                    if (kb < 2) {
#pragma unroll
                        for (int ks = 0; ks < 4; ++ks) kf[ks] = *(LAS const bf16x8*)(Kt + kaddr[ks] + 8192 * (kb + 2)); } }
                O[0] = MFMA32(v0[0], P0, O[0]); O[0] = MFMA32(v0[1], P1, O[0]); O[1] = MFMA32(v1[0], P0, O[1]); O[1] = MFMA32(v1[1], P1, O[1]);
                O[2] = MFMA32(v2[0], P0, O[2]); O[2] = MFMA32(v2[1], P1, O[2]); O[3] = MFMA32(v3[0], P0, O[3]); O[3] = MFMA32(v3[1], P1, O[3]);
                if (kb < 3) {
                    unsigned pf[8]; float lacc = 0.f;
#pragma unroll
                    for (int i = 0; i < 8; ++i) { const float e0 = __builtin_amdgcn_exp2f(SUB ? Sn[2 * i] + negm2 : Sn[2 * i]), e1 = __builtin_amdgcn_exp2f(SUB ? Sn[2 * i + 1] + negm2 : Sn[2 * i + 1]); lacc += e0 + e1; pf[i] = pk2(e0, e1); }
                    ls += lacc;
                    P0 = __builtin_bit_cast(bf16x8, (v4u){pf[0], pf[1], pf[2], pf[3]}); P1 = __builtin_bit_cast(bf16x8, (v4u){pf[4], pf[5], pf[6], pf[7]});
                    __builtin_amdgcn_sched_group_barrier(0x100, 20, 0); __builtin_amdgcn_sched_group_barrier(0x008, 6, 0);
#pragma unroll
                    for (int gI = 0; gI < 6; ++gI) { __builtin_amdgcn_sched_group_barrier(0x002, 8, 0); __builtin_amdgcn_sched_group_barrier(0x008, 1, 0); }
                }
                __builtin_amdgcn_sched_barrier(0);
            }
#undef AT_VF
            asm volatile("s_waitcnt vmcnt(0)" ::: "memory");
            __syncthreads();
        }
#undef AT_DMA
#undef AT_QK
        const float l = ls + __shfl_xor(ls, 32);
        if (mp == 1) { const float sc = lam / l;
#pragma unroll
            for (int dt = 0; dt < 4; ++dt)
#pragma unroll
                for (int i = 0; i < 16; ++i) Ex[(32 * wq + r) * 132 + 32 * dt + (i & 3) + 8 * (i >> 2) + 4 * h] = O[dt][i] * sc; }
        __syncthreads();
        if (mp == 0) { const float a0 = 1.f / l; float ss = 0.f;
#pragma unroll
            for (int dt = 0; dt < 4; ++dt)
#pragma unroll
                for (int i = 0; i < 16; ++i) { const float v = O[dt][i] * a0 - Ex[(32 * wq + r) * 132 + 32 * dt + (i & 3) + 8 * (i >> 2) + 4 * h]; O[dt][i] = v; ss += v * v; }
            ss += __shfl_xor(ss, 32);
            const float rn = rsqrtf(ss * (1.f / 128.f) + EPS) * (1.f - p.lam_init);
            int qrow2 = qrow0 + 32 * wq + r; asm volatile("" : "+v"(qrow2));
            bf16* dst = p.MIX + (size_t)qrow2 * DM + hd * 128;
#pragma unroll
            for (int dt = 0; dt < 4; ++dt)
#pragma unroll
                for (int g4 = 0; g4 < 4; ++g4) { const int dv0 = 32 * dt + 8 * g4 + 4 * h; const f32x4 sg = *(const f32x4*)(p.subg + dv0);
                    v2u o; o.x = pk2(O[dt][4 * g4] * rn * sg.x, O[dt][4 * g4 + 1] * rn * sg.y); o.y = pk2(O[dt][4 * g4 + 2] * rn * sg.z, O[dt][4 * g4 + 3] * rn * sg.w);
                    *(v2u*)(dst + dv0) = o; } }
        __syncthreads();
    }
}

#ifndef PHASE_MASK
#define PHASE_MASK 0xFFFFFFu
#endif
#define PM(j) ((PHASE_MASK >> (j)) & 1u)
#ifndef REP_MASK
#define REP_MASK 0u
#endif
#define REPS(j) ((((REP_MASK) >> (j)) & 1u) ? 2 : 1)
#define PH_BEGIN(j, k) if (PM(j) && IN(k)) for (int rep_ = 0; rep_ < REPS(j); ++rep_) { if (rep_) xcd_barrier(bar);
#define PH_END }
#define PHASE_BEGIN int wave = wave0, bid = bid0, G = G0, zz_ = 0; asm volatile("" : "+s"(wave), "+s"(bid), "+s"(G), "+s"(zz_)); const int lane = (int)__builtin_amdgcn_mbcnt_hi(~0u, __builtin_amdgcn_mbcnt_lo(~0u, (unsigned)zz_)), tid = wave * 64 + lane; \
    unsigned char* ws = ws0; asm volatile("" : "+s"(ws)); const __attribute__((address_space(4))) Args* ap_ = (const __attribute__((address_space(4))) Args*)__builtin_amdgcn_kernarg_segment_ptr(); asm volatile("" : "+s"(ap_)); const Args& a = *(const Args*)ap_; (void)a; const int gw = bid * NWAVES + wave, NGW = G * NWAVES, gtid = bid * NTHR + tid, NT = G * NTHR; (void)gw; (void)NGW; (void)gtid; (void)NT; (void)lane;
__device__ __forceinline__ void fill_scanp(ScanP& sp, const Args& a, unsigned char* ws, int li, bool even) {
    sp.P = (const bf16*)(ws + WS_P); sp.MQK = (const bf16*)(ws + WS_MQK); sp.MIX = (bf16*)(ws + WS_MIX);
    sp.gw2 = a.in[10] + (size_t)li * 2 * 16 * 512; sp.gb = a.in[11] + (size_t)li * 2 * 512; sp.mgb = a.in[21] + (size_t)li * 16;
    sp.ng = even ? a.in[12] + (size_t)li * 256 : a.in[22] + (size_t)li * 256;
    sp.DSTp = (bf16*)(ws + WS_DST); sp.SSTp = (bf16*)(ws + WS_SST); sp.GAM = (float*)(ws + WS_SM + SM_GAM); sp.DN = (float*)(ws + WS_SM + SM_DN); sp.NIN = (float*)(ws + WS_SM + SM_NIN);
    sp.BL = (float*)(ws + WS_SM + SM_BL); sp.ML = (float*)(ws + WS_SM + SM_ML); sp.MINp = (float*)(ws + WS_SM + SM_MIN);
}
__global__ void __launch_bounds__(NTHR, 2) fwd_kernel(Args a) {
    extern __shared__ __attribute__((aligned(16))) unsigned char lds_raw[];
    LAS unsigned char* lds = (LAS unsigned char*)lds_raw;
    const int tid0 = threadIdx.x, wave0 = __builtin_amdgcn_readfirstlane(tid0 >> 6), bid0 = blockIdx.x, G0 = gridDim.x;
    unsigned char* ws0 = a.ws;
    volatile LAS unsigned* MISC = (volatile LAS unsigned*)(lds + MISC_OFF);
    if (tid0 < 32) MISC[tid0] = 0u;
    __syncthreads();
    XcdBarrier bar = xcd_barrier_post((unsigned*)(ws0 + WS_CTL) + CW_BAR + a.li * XCD_BAR_WORDS, MISC + 8, (unsigned)wave0);
    const int lo = a.ph_lo, hi = a.ph_hi;
#define IN(k) (lo <= (k) && (k) < hi)
#ifndef TMASK
#define TMASK 0u
#endif
#ifndef LMASK
#define LMASK 0xFu
#endif
    volatile LAS unsigned long long* tst_ = (volatile LAS unsigned long long*)(lds + MISC_OFF + 64);
    if (TMASK && tid0 == 0) { tst_[0] = __builtin_amdgcn_s_memrealtime(); tst_[1] = 0ull; }
#define SEAM2(k, kk, ll) do { if (IN(k) && IN((k) + 1)) xcd_barrier(bar); if (TMASK && wave0 == 0 && xb_lane() == 0u) { const unsigned long long now_ = __builtin_amdgcn_s_memrealtime(); if (((TMASK >> (kk)) & 1u) && ((LMASK >> (ll)) & 1u)) tst_[1] += now_ - tst_[0]; tst_[0] = now_; } } while (0)
#define SEAM(k) SEAM2(k, (k) == 0 ? 11 : ((k) - 1) % PPL, (k) == 0 ? 0 : ((k) - 1) / PPL)

    PH_BEGIN(11, 0) PHASE_BEGIN; ph_prologue(a, ws, lds, tid, lane, wave, bid, G); PH_END
    SEAM(0);
    for (int layer = 0; layer < NLAYERS; ++layer) {
        const int pb = 1 + layer * PPL, li = layer >> 1; const bool even = (layer & 1) == 0;
        const size_t mod_off = WS_MOD + (size_t)layer * 3 * 12288 * 4;
        const size_t wb_off = WS_W + (size_t)layer * W_LAYER;

        PH_BEGIN(0, pb + 0) PHASE_BEGIN; const float* mod = (const float*)(ws + mod_off); float* ssq = (float*)(ws + WS_SSQ) + (size_t)(2 * layer) * MR;
            if (layer == 0) ph_norm0(a.in[0], a.in[2], (float*)(ws + WS_XS), a.in[6], mod + 1 * DM, (bf16*)(ws + WS_H), ssq, gw, NGW, lane);
            else ph_ctxfix<11>((float*)(ws + WS_XS), (const float*)(ws + WS_DST), mod - 3 * 12288 + 2 * 12288 + 5 * DM, a.in[6] + (size_t)layer * DM, mod + 1 * DM, (bf16*)(ws + WS_H), ssq, gw, NGW, lane);
            { PHASE_BEGIN; const float* mod2 = (const float*)(ws + mod_off); ph_bias((const bf16*)(ws + wb_off), (const bf16*)(ws + wb_off + W_UP), mod2, (float*)(ws + WS_B1) + (size_t)layer * 3 * NINP, (float*)(ws + WS_B2) + (size_t)layer * 3 * NUP, gw, NGW, lane); } }
        SEAM(pb + 0);
        PH_BEGIN(1, pb + 1) PHASE_BEGIN; pg8::Gemm g{(const bf16*)(ws + WS_H), (const bf16*)(ws + wb_off), MR, NINP, DM}; pg8::StaticOrder S; S.init(MR, NINP, G, bid); pg8::EpiStore E{(bf16*)(ws + WS_P), NINP, (const float*)(ws + WS_SSQ) + (size_t)(2 * layer) * MR, (const float*)(ws + WS_B1) + (size_t)layer * 3 * NINP, NINP};
            pg8::gemm_phase<pg8::EpiStore, pg8::StaticOrder, true, true>(lds, g, S, E, wave);
            if (layer + 1 < NLAYERS && G == 256 && bid >= 82) { __syncthreads(); ph_convert(a, ws, lds, (layer + 1) * 25344, (layer + 2) * 25344, (bid - 82) * NWAVES + wave, 174 * NWAVES, wave, lane); }
            else if (layer + 1 < NLAYERS && G != 256) { __syncthreads(); ph_convert(a, ws, lds, (layer + 1) * 25344, (layer + 2) * 25344, bid * NWAVES + wave, G * NWAVES, wave, lane); } }
        SEAM(pb + 1);
        PH_BEGIN(2, pb + 2)
            if (even) {
                if (PM(12)) { PHASE_BEGIN; ph_conv<1>((const bf16*)(ws + WS_P), a.in[13] + (size_t)li * 3 * 1024, nullptr, (bf16*)(ws + WS_MIX), gtid, NT); }
                if (PM(13)) { PHASE_BEGIN; ScanP sp; fill_scanp(sp, a, ws, li, even); ph_gla_local(sp, (bf16*)(ws + WS_QR), (bf16*)(ws + WS_KR), lds, tid, lane, wave, bid, G); }
            } else {
                if (PM(14)) { PHASE_BEGIN; ph_qkprep((const bf16*)(ws + WS_P), a.in[16] + (size_t)li * 64, a.in[17] + (size_t)li * 64, (const float*)(ws + WS_ROPE), (bf16*)(ws + WS_QR), (bf16*)(ws + WS_KR), gw, NGW, lane); }
                if (PM(15)) { PHASE_BEGIN; ph_conv<2>((const bf16*)(ws + WS_P), a.in[20] + (size_t)li * 3 * 1024, nullptr, (bf16*)(ws + WS_MQK), gtid, NT); }
            }
        }
        SEAM(pb + 2);
        PH_BEGIN(3, pb + 3) if (!even) { PHASE_BEGIN; ScanP sp; fill_scanp(sp, a, ws, li, even); ph_mlstm_local(sp, lds, tid, lane, wave, bid, G); } }
        if (!even) SEAM(pb + 3);
        PH_BEGIN(4, pb + 4) PHASE_BEGIN; ScanP sp; fill_scanp(sp, a, ws, li, even); if (even) ph_scan_carry<0>(sp, gtid, NT); else ph_scan_carry<1>(sp, gtid, NT); }
        SEAM(pb + 4);
        PH_BEGIN(5, pb + 5)
            if (even) { if (PM(16)) { PHASE_BEGIN; ScanP sp; fill_scanp(sp, a, ws, li, even); ph_gla_out(sp, (const bf16*)(ws + WS_QR), (const bf16*)(ws + WS_KR), lds, tid, lane, wave, bid, G); } }
            else {
                if (PM(17)) { PHASE_BEGIN; AttnP ap{(const bf16*)(ws + WS_QR), (const bf16*)(ws + WS_KR), (const bf16*)(ws + WS_P), (bf16*)(ws + WS_MIX), a.in[18] + (size_t)li * 256, a.in[19] + (size_t)li * 128, a.in[16] + (size_t)li * 64, a.in[17] + (size_t)li * 64, 0.8f - 0.6f * expf(-0.3f * (float)layer), (unsigned*)(ws + 32768 + 1024 * li)};
                    const float bound = 8.f * wave_max(fabsf(ap.qg[lane])) * wave_max(fabsf(ap.kg[lane])) * 1.4426950408889634f;
                    if (bound < 60.f) ph_attn<false>(ap, lds, tid, lane, wave, bid, G); else ph_attn<true>(ap, lds, tid, lane, wave, bid, G);
                    if (TMASK && wave0 == 0 && xb_lane() == 0u) { const unsigned long long now_ = __builtin_amdgcn_s_memrealtime(); if (((TMASK >> 12) & 1u) && ((LMASK >> layer) & 1u)) tst_[1] += now_ - tst_[0]; tst_[0] = now_; } }
                if (PM(18)) { PHASE_BEGIN; ScanP sp; fill_scanp(sp, a, ws, li, even); ph_mlstm_out(sp, lds, tid, lane, wave, bid, G); }
            }
        }
        SEAM(pb + 5);
        PH_BEGIN(6, pb + 6) PHASE_BEGIN; pg8::Gemm g{(const bf16*)(ws + WS_MIX), (const bf16*)(ws + wb_off + W_OUT), MR, DM, DM}; pg8::ResidOrder S; S.init(G, bid, layer < NLAYERS - 1 ? 8 : 0, 256);
            pg8::EpiResid2 E{(float*)(ws + WS_XS), (const float*)(ws + mod_off) + 2 * DM, nullptr, (float*)(ws + WS_DST), 0, 256, rep_,
                (bf16*)(ws + WS_H), a.in[7] + (size_t)layer * DM, (const float*)(ws + mod_off) + 4 * DM, (float*)(ws + WS_SSQ) + (size_t)(2 * layer + 1) * MR};
            pg8::gemm_phase<pg8::EpiResid2, pg8::ResidOrder, true, true>(lds, g, S, E, wave); }
        SEAM(pb + 6);
        PH_BEGIN(7, pb + 7) PHASE_BEGIN; const float* mod = (const float*)(ws + mod_off);
            if (layer < NLAYERS - 1) ph_ctxfix<8>((float*)(ws + WS_XS), (const float*)(ws + WS_DST), mod + 2 * 12288 + 2 * DM, a.in[7] + (size_t)layer * DM, mod + 4 * DM, (bf16*)(ws + WS_H), (float*)(ws + WS_SSQ) + (size_t)(2 * layer + 1) * MR, gw, NGW, lane); }
        if (layer < NLAYERS - 1) SEAM(pb + 7);
        PH_BEGIN(8, pb + 8) PHASE_BEGIN; pg8::Gemm g{(const bf16*)(ws + WS_H), (const bf16*)(ws + wb_off + W_UP), MR, NUP, DM}; pg8::StaticOrder S; S.init(MR, NUP, G, bid);
            pg8::EpiAct E{(bf16*)(ws + WS_ACT), a.in[24] + (size_t)layer * 3 * DFF, a.in[25] + (size_t)layer * DFF, (float*)(ws + WS_U), (LAS float*)(lds + 131584), (const float*)(ws + WS_SSQ) + (size_t)(2 * layer + 1) * MR, (const float*)(ws + WS_B2) + (size_t)layer * 3 * NUP, 0};
            pg8::gemm_phase<pg8::EpiAct, pg8::StaticOrder, true, true>(lds, g, S, E, wave); }
        SEAM(pb + 8);
        PH_BEGIN(10, pb + 10)
            { PHASE_BEGIN; pg8::ResidOrder S0; S0.init(G, bid, layer < NLAYERS - 1 ? 11 : 0, 512); pg8::Unit uu_;
#pragma unroll 1
              for (int i_ = 0; S0.next(i_, uu_); ++i_) act_fix_tile((const float*)(ws + WS_U), a.in[24] + (size_t)layer * 3 * DFF, (bf16*)(ws + WS_ACT), uu_.pm, tid);
              asm volatile("s_waitcnt vmcnt(0)" ::: "memory"); __syncthreads(); }
            PHASE_BEGIN; pg8::Gemm g{(const bf16*)(ws + WS_ACT), (const bf16*)(ws + wb_off + W_DN), MR, DM, DFF}; pg8::ResidOrder S; S.init(G, bid, layer < NLAYERS - 1 ? 11 : 0, 512);
            pg8::EpiResid2 E{(float*)(ws + WS_XS), (const float*)(ws + mod_off) + 5 * DM, a.out, (float*)(ws + WS_DST), layer == NLAYERS - 1 ? 1 : 0, 512, rep_,
                layer < NLAYERS - 1 ? (bf16*)(ws + WS_H) : nullptr, a.in[6] + (size_t)(layer + 1) * DM, (const float*)(ws + mod_off) + 3 * 12288 + 1 * DM, (float*)(ws + WS_SSQ) + (size_t)(2 * layer + 2) * MR};
            pg8::gemm_phase<pg8::EpiResid2, pg8::ResidOrder, true, true>(lds, g, S, E, wave); }
        if (layer < NLAYERS - 1) SEAM(pb + 10); else if (TMASK && wave0 == 0 && xb_lane() == 0u) { const unsigned long long now_ = __builtin_amdgcn_s_memrealtime(); if (((TMASK >> 10) & 1u) && ((LMASK >> layer) & 1u)) tst_[1] += now_ - tst_[0]; tst_[0] = now_; }
    }
    if (TMASK) { __syncthreads(); const unsigned long long tacc_ = tst_[1], t0_ = __builtin_amdgcn_s_memrealtime(); while (__builtin_amdgcn_s_memrealtime() - t0_ < tacc_) __builtin_amdgcn_s_sleep(8); }
#undef IN
#undef SEAM
}

extern "C" void kernel_launch(void* const* d_in, const int* in_sizes, int n_in, void* d_out, int out_size, void* d_ws, size_t ws_size, hipStream_t stream) {
    static int grid = 0;
    if (grid == 0) {
        int dev = 0, cus = 0;
        if (n_in != 27 || out_size != NLATR * DM || ws_size < WS_END) { fprintf(stderr, "kernel_launch: unexpected problem (n_in %d out %d ws %zu)\n", n_in, out_size, ws_size); grid = -1; return; }
        if (hipGetDevice(&dev) != hipSuccess || hipDeviceGetAttribute(&cus, hipDeviceAttributeMultiprocessorCount, dev) != hipSuccess) { grid = -1; return; }
        if (hipFuncSetAttribute((const void*)fwd_kernel, hipFuncAttributeMaxDynamicSharedMemorySize, LDS_BYTES) != hipSuccess) { fprintf(stderr, "kernel_launch: hipFuncSetAttribute failed\n"); grid = -1; return; }
        int per_cu = 0;
        if (hipOccupancyMaxActiveBlocksPerMultiprocessor(&per_cu, (const void*)fwd_kernel, NTHR, LDS_BYTES) != hipSuccess || per_cu < 1) fprintf(stderr, "kernel_launch: occupancy query reports %d\n", per_cu);
        (void)hipGetLastError();
        grid = cus;
    }
    if (grid < 0) return;
    (void)hipMemsetAsync((char*)d_ws + WS_CTL, 0, CTL_BYTES, stream);
    Args a{};
    for (int i = 0; i < 27; ++i) a.in[i] = (const float*)d_in[i];
    a.out = (float*)d_out; a.ws = (unsigned char*)d_ws; a.pad = 0;
#if ONE_LAUNCH
    a.ph_lo = 0; a.ph_hi = 1 + NLAYERS * PPL; a.li = 0;
    hipLaunchKernelGGL(fwd_kernel, dim3(grid), dim3(NTHR), LDS_BYTES, stream, a);
#else
    for (int p = 0; p < 1 + NLAYERS * PPL; ++p) {
        const int k = p == 0 ? 0 : (p - 1) % PPL, layer = p == 0 ? 0 : (p - 1) / PPL;
        if (p > 0 && k == 3 && (layer & 1) == 0) continue;
        a.ph_lo = p; a.ph_hi = p + 1; a.li = p;
        hipLaunchKernelGGL(fwd_kernel, dim3(grid), dim3(NTHR), LDS_BYTES, stream, a);
    }
#endif
}
```

```cpp
#include <hip/hip_runtime.h>
#include <cstdio>
#include <cstdint>
namespace pg8 {
#define PG8_LAS __attribute__((address_space(3)))
typedef unsigned short bf16_t;
typedef short bf16x8 __attribute__((ext_vector_type(8)));
typedef float f32x4 __attribute__((ext_vector_type(4)));
typedef unsigned u32x4 __attribute__((ext_vector_type(4)));
constexpr int BM = 256, BK = 64, HALF = 128, HTB = HALF * BK * 2  , STAGE_BYTES = 8 * HTB, NXCD = 8, WGM = 8;

__host__ __device__ __forceinline__ int lds_byte(int r, int c) { const int st = (r >> 4) * 2 + (c >> 5), rr = r & 15, cc = c & 31, ob = rr * 64 + cc * 2; return st * 1024 + (ob ^ (((ob >> 9) & 1) << 5)); }
__host__ __device__ __forceinline__ void stage_rc(int b, int& R, int& C) { const int st = b / 1024, sb = b % 1024, swz = sb ^ (((sb >> 9) & 1) << 5); R = (st >> 1) * 16 + swz / 64; C = (st & 1) * 32 + (swz % 64) / 2; }
__host__ __device__ __forceinline__ int perm32(int rho) { const int n = rho >> 4, i = rho & 15; return 8 * (i >> 2) + 4 * n + (i & 3); }

struct Unit { int pm, pn, k0, nt; };
struct Gemm { const bf16_t* A; const bf16_t* Bt; int M, N, K; };

struct StaticOrder {
    int nM, nN, nwg, G, c;
    __host__ __device__ __forceinline__ void init(int M, int N, int G_, int c_) { nM = M / BM; nN = N / BM; nwg = nM * nN; G = G_; c = c_; }
    __host__ __device__ __forceinline__ bool next(int i, Unit& u) const {
        const long L = (long)i * G + c; if (L >= nwg) return false;
        int wgid = (int)L; { const int q = nwg / NXCD, r = nwg % NXCD, xcd = wgid % NXCD, off = wgid / NXCD; wgid = (xcd < r ? xcd * (q + 1) : r * (q + 1) + (xcd - r) * q) + off; }
        const int nig = WGM * nN, gid = wgid / nig, fm = gid * WGM, gsz = (nM - fm) < WGM ? (nM - fm) : WGM;
        u.pm = fm + ((wgid % nig) % gsz); u.pn = (wgid % nig) / gsz; u.k0 = 0; u.nt = 0; return true;
    }
    __device__ __forceinline__ void a_ready(const Unit&) const {}
    __device__ __forceinline__ void done(const Unit&) const {}
};
__device__ __forceinline__ unsigned cvt_pk_bf16(float lo, float hi) { unsigned r; asm volatile("v_cvt_pk_bf16_f32 %0, %1, %2" : "=v"(r) : "v"(lo), "v"(hi)); return r; }

struct EpiStore {
    static constexpr bool PERM = true, AFTER_DRAIN = false;
    bf16_t* O; int ldc; const float* ssq; const float* bias; int ldb;
    __device__ __forceinline__ void operator()(const f32x4 (&acc)[2][2][4][2], const Unit& u, int wr, int wc, int fr, int fq) const {
        const int row0 = u.pm * BM + wr * 64 + fr, col0 = u.pn * BM + wc * 32 + 8 * fq, mi = u.pm < 32 ? (u.pm >> 4) : 2;
        f32x4 bv[2][2];
#pragma unroll
        for (int bj = 0; bj < 2; ++bj)
#pragma unroll
            for (int n = 0; n < 2; ++n) bv[bj][n] = *(const f32x4*)(bias + (size_t)mi * ldb + col0 + bj * HALF + 4 * n);
#pragma unroll
        for (int ai = 0; ai < 2; ++ai)
#pragma unroll
            for (int m = 0; m < 4; ++m) { const int row = row0 + ai * HALF + m * 16; bf16_t* rowp = O + (size_t)row * ldc + col0;
                const float r = __builtin_amdgcn_rsqf(ssq[row] * (1.f / 2048.f) + 1e-6f);
#pragma unroll
                for (int bj = 0; bj < 2; ++bj) { const f32x4 v0 = acc[ai][bj][m][0] * r + bv[bj][0], v1 = acc[ai][bj][m][1] * r + bv[bj][1];
                    u32x4 w; w.x = cvt_pk_bf16(v0[0], v0[1]); w.y = cvt_pk_bf16(v0[2], v0[3]); w.z = cvt_pk_bf16(v1[0], v1[1]); w.w = cvt_pk_bf16(v1[2], v1[3]);
                    *(u32x4*)(rowp + bj * HALF) = w; } }
    }
};
struct ResidOrder {
    StaticOrder L; int G, c, nsub, ksub;
    __device__ __forceinline__ void init(int G_, int c_, int nsplit, int ksub_) { L.init(8192, 2048, G_, c_); G = G_; c = c_; nsub = 16 * nsplit; ksub = ksub_; }
    __device__ __forceinline__ bool next(int i, Unit& u) const {
        const int nl = c < 256 ? (255 - c) / G + 1 : 0;
        if (i < nl) return L.next(i, u);
        const int s = (i - nl) * G + c; if (s >= nsub) return false;
        const int tile = s & 15, j = s >> 4; u.pm = 32 + (tile >> 3); u.pn = tile & 7; u.k0 = j * ksub; u.nt = ksub / BK; return true;
    }
    __device__ __forceinline__ void a_ready(const Unit&) const {}
    __device__ __forceinline__ void done(const Unit&) const {}
};
struct EpiResid2 {
    static constexpr bool PERM = true, AFTER_DRAIN = false;
    float* X; const float* gate; float* out; float* part; int final_; int ksub; int dry;
    bf16_t* Hn; const float* ngn; const float* scn; float* ssqn;
    __device__ __forceinline__ void operator()(const f32x4 (&acc)[2][2][4][2], const Unit& u, int wr, int wc, int fr, int fq) const {
        const int row0 = u.pm * BM + wr * 64 + fr, col0 = u.pn * BM + wc * 32 + 8 * fq;
        if (u.pm >= 32) {
            float* pb = part + ((size_t)(u.k0 / ksub) * 512 + (row0 - 8192)) * 2048 + col0;
#pragma unroll
            for (int ai = 0; ai < 2; ++ai)
#pragma unroll
                for (int m = 0; m < 4; ++m)
#pragma unroll
                    for (int bj = 0; bj < 2; ++bj)
#pragma unroll
                        for (int n = 0; n < 2; ++n) *(f32x4*)(pb + (size_t)(ai * HALF + m * 16) * 2048 + bj * HALF + 4 * n) = acc[ai][bj][m][n];
            return;
        }
        const int mi = u.pm >> 4;
        f32x4 gv[2][2], av[2][2];
#pragma unroll
        for (int bj = 0; bj < 2; ++bj)
#pragma unroll
            for (int n = 0; n < 2; ++n) { const int c = col0 + bj * HALF + 4 * n; gv[bj][n] = *(const f32x4*)(gate + (size_t)mi * 12288 + c);
                av[bj][n] = Hn ? *(const f32x4*)(ngn + c) * (*(const f32x4*)(scn + (size_t)mi * 12288 + c) + 1.f) : (f32x4){0.f, 0.f, 0.f, 0.f}; }
        if (dry && gv[0][0][0] != 1.2345e30f) return;
#pragma unroll
        for (int ai = 0; ai < 2; ++ai)
#pragma unroll
            for (int m = 0; m < 4; ++m) { const int row = row0 + ai * HALF + m * 16; const size_t ro = (size_t)row * 2048 + col0; const float* xr = X + ro; float* orow = (final_ ? out : X) + ro; float ss = 0.f;
#pragma unroll
                for (int bj = 0; bj < 2; ++bj) {
                    const f32x4 x0 = *(const f32x4*)(xr + bj * HALF) + gv[bj][0] * acc[ai][bj][m][0], x1 = *(const f32x4*)(xr + bj * HALF + 4) + gv[bj][1] * acc[ai][bj][m][1];
                    *(f32x4*)(orow + bj * HALF) = x0; *(f32x4*)(orow + bj * HALF + 4) = x1;
                    if (Hn) { ss += (x0[0] * x0[0] + x0[1] * x0[1]) + (x0[2] * x0[2] + x0[3] * x0[3]) + (x1[0] * x1[0] + x1[1] * x1[1]) + (x1[2] * x1[2] + x1[3] * x1[3]);
                        const f32x4 h0 = x0 * av[bj][0], h1 = x1 * av[bj][1];
                        u32x4 w; w.x = cvt_pk_bf16(h0[0], h0[1]); w.y = cvt_pk_bf16(h0[2], h0[3]); w.z = cvt_pk_bf16(h1[0], h1[1]); w.w = cvt_pk_bf16(h1[2], h1[3]);
                        *(u32x4*)(Hn + ro + bj * HALF) = w; } }
                if (Hn) { ss += __shfl_xor(ss, 16); ss += __shfl_xor(ss, 32); if (fq == 0) (void)__hip_atomic_fetch_add(ssqn + row, ss, __ATOMIC_RELAXED, __HIP_MEMORY_SCOPE_AGENT); } }
    }
};
struct EpiAct {
    static constexpr bool PERM = true, AFTER_DRAIN = false;
    bf16_t* ACT; const float* cw; const float* cb; float* halo; PG8_LAS float* exb; const float* ssq; const float* bias; mutable int par;
    __device__ __forceinline__ void operator()(const f32x4 (&acc)[2][2][4][2], const Unit& u, int wr, int wc, int fr, int fq) const {
        const int lane = fq * 16 + fr, ch0 = wc * 32 + 8 * fq, chg = u.pn * 128 + ch0;
        PG8_LAS float* xb = exb + par * 1024; par ^= 1;
        const int mi = u.pm < 32 ? (u.pm >> 4) : 2;
        const float* bp = bias + (size_t)mi * 11264 + u.pn * BM + ch0;
        float rr[2][4];
#pragma unroll
        for (int ai = 0; ai < 2; ++ai)
#pragma unroll
            for (int m = 0; m < 4; ++m) rr[ai][m] = __builtin_amdgcn_rsqf(ssq[u.pm * BM + ai * HALF + wr * 64 + m * 16 + fr] * (1.f / 2048.f) + 1e-6f);
#pragma unroll
        for (int ai = 0; ai < 2; ++ai) { const int q = ai * 2 + wr;
#pragma unroll
            for (int n = 0; n < 2; ++n) { const f32x4 bg4 = *(const f32x4*)(bp + 4 * n);
                if (fr == 0) *(PG8_LAS f32x4*)(xb + q * 128 + ch0 + 4 * n) = acc[ai][0][0][n] * rr[ai][0] + bg4;
                if (fr == 15) *(PG8_LAS f32x4*)(xb + (4 + q) * 128 + ch0 + 4 * n) = acc[ai][0][3][n] * rr[ai][3] + bg4; } }
        asm volatile("s_waitcnt lgkmcnt(0)" ::: "memory"); __builtin_amdgcn_s_barrier(); asm volatile("" ::: "memory");
        float* hb = halo + (size_t)(u.pm * 44 + u.pn) * 768 + ch0;
#pragma unroll
        for (int n = 0; n < 2; ++n) {
            const f32x4 w0 = *(const f32x4*)(cw + chg + 4 * n), w1 = *(const f32x4*)(cw + 5632 + chg + 4 * n), w2 = *(const f32x4*)(cw + 2 * 5632 + chg + 4 * n), bb = *(const f32x4*)(cb + chg + 4 * n);
            const f32x4 bg = *(const f32x4*)(bp + 4 * n), bvv = *(const f32x4*)(bp + 128 + 4 * n);
#pragma unroll
            for (int ai = 0; ai < 2; ++ai) { const int q = ai * 2 + wr;
                const f32x4 pB = q > 0 ? *(PG8_LAS const f32x4*)(xb + (4 + q - 1) * 128 + ch0 + 4 * n) : (f32x4){0.f, 0.f, 0.f, 0.f};
                const f32x4 nB = q < 3 ? *(PG8_LAS const f32x4*)(xb + (q + 1) * 128 + ch0 + 4 * n) : (f32x4){0.f, 0.f, 0.f, 0.f};
#pragma unroll
                for (int m = 0; m < 4; ++m) {
                    const f32x4 x = acc[ai][0][m][n] * rr[ai][m] + bg, vx = acc[ai][1][m][n] * rr[ai][m] + bvv;
                    const f32x4 xm = m > 0 ? acc[ai][0][m > 0 ? m - 1 : 0][n] * rr[ai][m > 0 ? m - 1 : 0] + bg : pB;
                    const f32x4 xq = m < 3 ? acc[ai][0][m < 3 ? m + 1 : 3][n] * rr[ai][m < 3 ? m + 1 : 3] + bg : nB;
                    f32x4 cv, o;
#pragma unroll
                    for (int el = 0; el < 4; ++el) { const float sp = fr == 15 ? xm[el] : x[el], sn = fr == 0 ? xq[el] : x[el];
                        const float pv = __builtin_bit_cast(float, __builtin_amdgcn_update_dpp(0, __builtin_bit_cast(int, sp), 0x121, 0xF, 0xF, false)), nv = __builtin_bit_cast(float, __builtin_amdgcn_update_dpp(0, __builtin_bit_cast(int, sn), 0x12F, 0xF, 0xF, false));
                        cv[el] = w0[el] * pv + w1[el] * x[el] + w2[el] * nv + bb[el];
                        o[el] = cv[el] / (1.f + __expf(-cv[el])) * vx[el]; }
                    const bool top = (q == 0 && m == 0 && fr == 0), bot = (q == 3 && m == 3 && fr == 15);
                    if (top || bot) { const int sl = top ? 0 : 1; *(f32x4*)(hb + sl * 128 + 4 * n) = x; *(f32x4*)(hb + (2 + sl) * 128 + 4 * n) = cv; *(f32x4*)(hb + (4 + sl) * 128 + 4 * n) = vx; }
                    else { typedef unsigned u32x2_ __attribute__((ext_vector_type(2))); u32x2_ w; w.x = cvt_pk_bf16(o[0], o[1]); w.y = cvt_pk_bf16(o[2], o[3]);
                        *(u32x2_*)(ACT + (size_t)(u.pm * BM + q * 64 + m * 16 + fr) * 5632 + chg + 4 * n) = w; }
                }
            }
        }
    }
};
template <class Epi, class Sched, bool ALIGN_EPI = false, bool SP2 = false>
__device__ __forceinline__ void gemm_phase(PG8_LAS unsigned char* lds, const Gemm g, const Sched& S, const Epi& E, int wid_in) {
    int wid = wid_in, zz_ = 0; asm volatile("" : "+s"(wid), "+s"(zz_));
    const int lane = (int)__builtin_amdgcn_mbcnt_hi(~0u, __builtin_amdgcn_mbcnt_lo(~0u, (unsigned)zz_)), tid = wid * 64 + lane, wr = wid >> 2, wc = wid & 3, fr = lane & 15, fq = lane >> 4;
    const int K = g.K, nt = K / BK;
    unsigned voffA[2], voffB[2];
#pragma unroll
    for (int i = 0; i < 2; ++i) { int R, C; stage_rc(tid * 16 + i * 8192, R, C); const int Rb = Epi::PERM ? ((R & ~31) + perm32(R & 31)) : R;
        voffA[i] = (unsigned)(R * K + C) * 2u; voffB[i] = (unsigned)(Rb * K + C) * 2u; }
    const size_t kstep = (size_t)(BK * 2);
    const size_t hstep = (size_t)HALF * K * 2;
    const size_t tstep = 2 * hstep;
    const unsigned ldsw = (unsigned)wid * 1024u;
    const int aoff = lds_byte(wr * 64 + fr, fq * 8), boff = lds_byte(wc * 32 + fr, fq * 8);
#define PG8_SA(b, h) (((b) * 2 + (h)) * HTB)
#define PG8_SB(b, h) ((4 + (b) * 2 + (h)) * HTB)
#define PG8_STAGE(bufoff, gbase, voff) do { _Pragma("unroll") for (int _i = 0; _i < 2; ++_i) \
        __builtin_amdgcn_global_load_lds((const unsigned*)((const char*)(gbase) + (voff)[_i]), (PG8_LAS unsigned*)(lds + (bufoff) + ldsw + _i * 8192), 16, 0, 0); } while (0)
#define PG8_LDA(dst, b, h) do { _Pragma("unroll") for (int m = 0; m < 4; ++m) _Pragma("unroll") for (int k = 0; k < 2; ++k) dst[m][k] = *(const PG8_LAS bf16x8*)(lds + PG8_SA(b, h) + aoff + m * 2048 + k * 1024); } while (0)
#define PG8_LDB(dst, b, h) do { _Pragma("unroll") for (int n = 0; n < 2; ++n) _Pragma("unroll") for (int k = 0; k < 2; ++k) dst[n][k] = *(const PG8_LAS bf16x8*)(lds + PG8_SB(b, h) + boff + n * 2048 + k * 1024); } while (0)
#define PG8_MMA(ai, bj, At, Bt) do { __builtin_amdgcn_s_setprio(1); _Pragma("unroll") for (int m = 0; m < 4; ++m) _Pragma("unroll") for (int n = 0; n < 2; ++n) _Pragma("unroll") for (int k = 0; k < 2; ++k) \
        acc[ai][bj][m][n] = __builtin_amdgcn_mfma_f32_16x16x32_bf16(Bt[n][k], At[m][k], acc[ai][bj][m][n], 0, 0, 0); __builtin_amdgcn_s_setprio(0); } while (0)
#define PG8_WAIT_V(n) asm volatile("s_waitcnt vmcnt(" #n ")" ::: "memory")
#define PG8_WAIT_L(n) asm volatile("s_waitcnt lgkmcnt(" #n ")" ::: "memory")
#define PG8_BAR __builtin_amdgcn_s_barrier()
#define PG8_SCHED __builtin_amdgcn_sched_barrier(0)
    Unit cur, nxt; int ui = 0;
    if (!S.next(0, cur)) return;
    f32x4 acc[2][2][4][2];
#pragma unroll
    for (int a = 0; a < 2; ++a)
#pragma unroll
        for (int b = 0; b < 2; ++b)
#pragma unroll
            for (int m = 0; m < 4; ++m)
#pragma unroll
                for (int n = 0; n < 2; ++n) acc[a][b][m][n] = (f32x4){0.f, 0.f, 0.f, 0.f};
    bf16x8 At[4][2], B0[2][2], B1[2][2];
    const char* cA = (const char*)g.A + (size_t)cur.pm * tstep + (size_t)cur.k0 * 2; const char* cB = (const char*)g.Bt + (size_t)cur.pn * tstep + (size_t)cur.k0 * 2;
    S.a_ready(cur);
    if constexpr (SP2) {
        PG8_STAGE(PG8_SB(0, 0), cB, voffB); PG8_STAGE(PG8_SB(0, 1), cB + hstep, voffB); PG8_STAGE(PG8_SA(0, 0), cA, voffA); PG8_STAGE(PG8_SA(0, 1), cA + hstep, voffA);
        if (wr == 1) PG8_BAR;
        PG8_WAIT_V(2); PG8_BAR;
        PG8_STAGE(PG8_SB(1, 0), cB + kstep, voffB); PG8_STAGE(PG8_SA(1, 0), cA + kstep, voffA); PG8_STAGE(PG8_SB(1, 1), cB + hstep + kstep, voffB);
        PG8_WAIT_V(6); PG8_BAR;
    } else {
        PG8_STAGE(PG8_SB(0, 0), cB, voffB); PG8_STAGE(PG8_SA(0, 0), cA, voffA); PG8_STAGE(PG8_SB(0, 1), cB + hstep, voffB); PG8_STAGE(PG8_SA(0, 1), cA + hstep, voffA);
        if (wr == 1) PG8_BAR;
        PG8_WAIT_V(4); PG8_BAR;
        PG8_STAGE(PG8_SB(1, 0), cB + kstep, voffB); PG8_STAGE(PG8_SA(1, 0), cA + kstep, voffA); PG8_STAGE(PG8_SB(1, 1), cB + hstep + kstep, voffB);
        PG8_WAIT_V(6); PG8_BAR;
    }
    for (;;) {
        const bool has_next = S.next(ui + 1, nxt);
        const char* nA = has_next ? (const char*)g.A + (size_t)nxt.pm * tstep + (size_t)nxt.k0 * 2 : cA; const char* nB = has_next ? (const char*)g.Bt + (size_t)nxt.pn * tstep + (size_t)nxt.k0 * 2 : cB;
        const int unt = cur.nt ? cur.nt : nt;
        for (int t = 0; t < unt; t += 2) {
            const bool last = (t == unt - 2);
            const char* a1 = cA + (size_t)(t + 1) * kstep;
            const char* a2 = last ? nA : cA + (size_t)(t + 2) * kstep; const char* b2 = last ? nB : cB + (size_t)(t + 2) * kstep;
            const char* a3 = a2 + kstep; const char* b3 = b2 + kstep;
            if (last && has_next) S.a_ready(nxt);
            if constexpr (SP2) {
            PG8_LDB(B0, 0, 0); PG8_LDB(B1, 0, 1); PG8_SCHED; PG8_LDA(At, 0, 0); PG8_STAGE(PG8_SA(1, 1), a1 + hstep, voffA);
            PG8_WAIT_V(8); PG8_WAIT_L(0); PG8_BAR; PG8_MMA(0, 0, At, B0); PG8_MMA(0, 1, At, B1); PG8_BAR; PG8_SCHED;
            PG8_LDA(At, 0, 1); PG8_STAGE(PG8_SB(0, 0), b2, voffB); PG8_STAGE(PG8_SB(0, 1), b2 + hstep, voffB); PG8_STAGE(PG8_SA(0, 0), a2, voffA);
            PG8_WAIT_V(8); PG8_WAIT_L(0); PG8_BAR; PG8_MMA(1, 0, At, B0); PG8_MMA(1, 1, At, B1); PG8_BAR; PG8_SCHED;
            PG8_LDB(B0, 1, 0); PG8_LDB(B1, 1, 1); PG8_SCHED; PG8_LDA(At, 1, 0); PG8_STAGE(PG8_SA(0, 1), a2 + hstep, voffA);
            PG8_WAIT_V(8); PG8_WAIT_L(0); PG8_BAR; PG8_MMA(0, 0, At, B0); PG8_MMA(0, 1, At, B1); PG8_BAR; PG8_SCHED;
            PG8_LDA(At, 1, 1); PG8_STAGE(PG8_SB(1, 0), b3, voffB); PG8_STAGE(PG8_SB(1, 1), b3 + hstep, voffB); PG8_STAGE(PG8_SA(1, 0), a3, voffA);
            PG8_WAIT_V(8); PG8_WAIT_L(0); PG8_BAR; PG8_MMA(1, 0, At, B0); PG8_MMA(1, 1, At, B1); PG8_BAR; PG8_SCHED;
            } else {
            PG8_LDB(B0, 0, 0); PG8_SCHED; PG8_LDA(At, 0, 0); PG8_STAGE(PG8_SA(1, 1), a1 + hstep, voffA);
            PG8_WAIT_L(8); PG8_BAR; PG8_WAIT_L(0); PG8_MMA(0, 0, At, B0); PG8_BAR; PG8_SCHED;
            PG8_LDB(B1, 0, 1); PG8_STAGE(PG8_SB(0, 0), b2, voffB);
            PG8_BAR; PG8_WAIT_L(0); PG8_MMA(0, 1, At, B1); PG8_BAR;
            PG8_LDA(At, 0, 1); PG8_STAGE(PG8_SA(0, 0), a2, voffA);
            PG8_BAR; PG8_WAIT_L(0); PG8_MMA(1, 0, At, B0); PG8_BAR; PG8_SCHED;
            PG8_STAGE(PG8_SB(0, 1), b2 + hstep, voffB);
            PG8_WAIT_V(6); PG8_BAR; PG8_MMA(1, 1, At, B1); PG8_BAR;
            PG8_LDB(B0, 1, 0); PG8_SCHED; PG8_LDA(At, 1, 0); PG8_STAGE(PG8_SA(0, 1), a2 + hstep, voffA);
            PG8_WAIT_L(8); PG8_BAR; PG8_WAIT_L(0); PG8_MMA(0, 0, At, B0); PG8_BAR; PG8_SCHED;
            PG8_LDB(B1, 1, 1); PG8_STAGE(PG8_SB(1, 0), b3, voffB);
            PG8_BAR; PG8_WAIT_L(0); PG8_MMA(0, 1, At, B1); PG8_BAR;
            PG8_LDA(At, 1, 1); PG8_STAGE(PG8_SA(1, 0), a3, voffA);
            PG8_BAR; PG8_WAIT_L(0); PG8_MMA(1, 0, At, B0); PG8_BAR; PG8_SCHED;
            PG8_STAGE(PG8_SB(1, 1), b3 + hstep, voffB);
            PG8_WAIT_V(6); PG8_BAR; PG8_MMA(1, 1, At, B1); PG8_BAR;
            }
        }
        if constexpr (ALIGN_EPI) { if (wr == 0) PG8_BAR; }
        if constexpr (!Epi::AFTER_DRAIN) { E(acc, cur, wr, wc, fr, fq); S.done(cur); }
        if (!has_next) break;
#pragma unroll
        for (int a = 0; a < 2; ++a)
#pragma unroll
            for (int b = 0; b < 2; ++b)
#pragma unroll
                for (int m = 0; m < 4; ++m)
#pragma unroll
                    for (int n = 0; n < 2; ++n) acc[a][b][m][n] = (f32x4){0.f, 0.f, 0.f, 0.f};
        cur = nxt; cA = nA; cB = nB; ++ui;
        if constexpr (ALIGN_EPI) { if (wr == 1) PG8_BAR; }
    }
    PG8_WAIT_V(0);
    if constexpr (!ALIGN_EPI) { if (wr == 0) PG8_BAR; }
    PG8_BAR;
    if constexpr (Epi::AFTER_DRAIN) { E.fused(acc, cur, wr, wc, fr, fq, lds, wid, lane); S.done(cur); }
#undef PG8_SA
#undef PG8_SB
#undef PG8_STAGE
#undef PG8_LDA
#undef PG8_LDB
#undef PG8_MMA
#undef PG8_WAIT_V
#undef PG8_WAIT_L
#undef PG8_BAR
#undef PG8_SCHED
}
}
#define GAS __attribute__((address_space(1)))
#define LAS __attribute__((address_space(3)))
typedef unsigned short bf16;
typedef unsigned v4u __attribute__((ext_vector_type(4)));
typedef unsigned v2u __attribute__((ext_vector_type(2)));
typedef float f32x4 __attribute__((ext_vector_type(4)));
typedef float f32x16 __attribute__((ext_vector_type(16)));
typedef short bf16x8 __attribute__((ext_vector_type(8)));
typedef short s16x4 __attribute__((ext_vector_type(4)));
typedef GAS unsigned gu32;
#define RLX_AGENT __ATOMIC_RELAXED, __HIP_MEMORY_SCOPE_AGENT
#define XB_TMO      128
#define XB_XCNT(j)  (256  + 64 * (j))
#define XB_XSUB(j)  (1280 + 64 * (j))
#define XB_XGEN(j)  (2304 + 64 * (j))
#define XB_TOP      3328
#define XB_TOPGEN   3392
#define XCD_BAR_WORDS 3456
#define XB_SPIN_CAP (1u << 18)

__device__ __forceinline__ unsigned xb_ld(unsigned* p)              { return __hip_atomic_load(p, __ATOMIC_RELAXED, __HIP_MEMORY_SCOPE_AGENT); }
__device__ __forceinline__ unsigned xb_add(unsigned* p, unsigned v) { return __hip_atomic_fetch_add(p, v, __ATOMIC_RELAXED, __HIP_MEMORY_SCOPE_AGENT); }
__device__ __forceinline__ unsigned xb_xcc_id() { return (unsigned)__builtin_amdgcn_s_getreg((3 << 11) | 20) & 0xFu; }
#define XB_SPIN(cond, bar) do { unsigned _sp = 0; while (cond) { __builtin_amdgcn_s_sleep(1); \
    if ((++_sp & 255u) == 0u) { if (xb_ld(&(bar)[XB_TMO])) break; if (_sp > XB_SPIN_CAP) { atomicAdd(&(bar)[XB_TMO], 1u); break; } } } } while (0)

struct XcdBarrier {
    unsigned* bar; unsigned x;
    volatile LAS unsigned* st;
    unsigned wv;
};

__device__ __forceinline__ unsigned xb_lane() { return __builtin_amdgcn_mbcnt_hi(~0u, __builtin_amdgcn_mbcnt_lo(~0u, 0u)); }
__device__ __forceinline__ XcdBarrier xcd_barrier_post(unsigned* bar, volatile LAS unsigned* st, unsigned wv) {
    XcdBarrier b; b.bar = bar; b.x = xb_xcc_id(); b.st = st; b.wv = wv;
    if (wv == 0u && xb_lane() == 0u) (void)xb_add(&bar[XB_XCNT(b.x)], 1u);
    return b;
}
__device__ __forceinline__ void xcd_barrier_complete(unsigned* bar, unsigned x, unsigned& nloc, unsigned& nx) {
    const unsigned G = gridDim.x * gridDim.y * gridDim.z;
    unsigned sum, cnt, mine, sp = 0u;
    for (;;) {
        sum = 0u; cnt = 0u; mine = 0u;
#pragma unroll
        for (unsigned j = 0; j < 16; ++j) { const unsigned c = xb_ld(&bar[XB_XCNT(j)]); sum += c; cnt += (c > 0u) ? 1u : 0u; mine = (j == x) ? c : mine; }
        if (sum == G) break;
        __builtin_amdgcn_s_sleep(1);
        if ((++sp & 255u) == 0u) { if (xb_ld(&bar[XB_TMO])) break; if (sp > XB_SPIN_CAP) { atomicAdd(&bar[XB_TMO], 1u); break; } }
    }
    nloc = mine > 0u ? mine : 1u; nx = cnt > 0u ? cnt : 1u;
}

__device__ __forceinline__ void xcd_barrier(const XcdBarrier& b) {
    asm volatile("s_waitcnt vmcnt(0)" ::: "memory");
    __syncthreads();
    if (b.wv == 0u && xb_lane() == 0u) {
        unsigned* bar = b.bar;
        __builtin_amdgcn_s_waitcnt(0);
        unsigned nloc = b.st[0], nx = b.st[1];
        if (nloc == 0u) { xcd_barrier_complete(bar, b.x, nloc, nx); b.st[0] = nloc; b.st[1] = nx; }
        const unsigned old = xb_add(&bar[XB_XSUB(b.x)], 1u);
        const unsigned gen = old / nloc;
        if (old + 1u == (gen + 1u) * nloc) {
            __builtin_amdgcn_fence(__ATOMIC_RELEASE, "agent");
            asm volatile("s_waitcnt vmcnt(0)" ::: "memory");
            const unsigned og = xb_add(&bar[XB_TOP], 1u);
            const unsigned tg = og / nx;
            if (og + 1u == (tg + 1u) * nx) xb_add(&bar[XB_TOPGEN], 1u);
            else XB_SPIN(xb_ld(&bar[XB_TOPGEN]) == tg, bar);
            __builtin_amdgcn_fence(__ATOMIC_ACQUIRE, "agent");
            xb_add(&bar[XB_XGEN(b.x)], 1u);
            asm volatile("s_waitcnt vmcnt(0)" ::: "memory");
        } else {
            XB_SPIN(xb_ld(&bar[XB_XGEN(b.x)]) == gen, bar);
            __builtin_amdgcn_fence(__ATOMIC_ACQUIRE, "agent");
            asm volatile("s_waitcnt vmcnt(0)" ::: "memory");
        }
    }
    __syncthreads();
}
#ifndef ONE_LAUNCH
#define ONE_LAUNCH 1
#endif
#ifndef NLAYERS
#define NLAYERS 4
#endif
constexpr int DM = 2048, MR = 8704, NLATR = 8192;
constexpr int NINP = 6400, DFF = 5632, NUP = 11264, EVIN = 6176, ODIN = 6160;
constexpr int NWAVES = 8, NTHR = 512;
constexpr float EPS = 1e-6f;
constexpr int NCHUNK = 68;
constexpr int PPL = 11, NPH = 1 + 4 * PPL;
constexpr size_t MiB = 1ull << 20;
constexpr size_t WS_CTL = 0, CTL_BYTES = 1 * MiB;
constexpr size_t WS_MOD = 1 * MiB, WS_ROPE = 1 * MiB + 640 * 1024;
constexpr size_t WS_W = 4 * MiB, W_LAYER = 99 * MiB, W_OUT = 25 * MiB, W_UP = 33 * MiB, W_DN = 77 * MiB;
constexpr size_t WS_XS = 400 * MiB, WS_H = 468 * MiB, WS_MIX = 502 * MiB, WS_P = 536 * MiB, WS_U = 644 * MiB, WS_ACT = 832 * MiB;
constexpr size_t WS_QR = 926 * MiB, WS_KR = 943 * MiB, WS_MQK = 960 * MiB, WS_DST = 977 * MiB, WS_SST = 1113 * MiB, WS_SM = 1181 * MiB, WS_B1 = 1185 * MiB, WS_B2 = 1186 * MiB, WS_END = 1187 * MiB;
constexpr size_t WS_SSQ = 524288;
constexpr size_t SM_GAM = 0, SM_DN = 1 * MiB, SM_NIN = 2 * MiB, SM_BL = 3 * MiB, SM_ML = 3 * MiB + 8192, SM_MIN = 3 * MiB + 16384;
constexpr int CW_BAR = 4096;
constexpr int LDS_BYTES = 147456, MISC_OFF = 131072 + 320;

struct Args { const float* in[27]; float* out; unsigned char* ws; int ph_lo, ph_hi, li, pad; };

__device__ __forceinline__ float bf_lo(unsigned u) { return __builtin_bit_cast(float, u << 16); }
__device__ __forceinline__ float bf_hi(unsigned u) { return __builtin_bit_cast(float, u & 0xffff0000u); }
__device__ __forceinline__ float bf1(bf16 b) { return __builtin_bit_cast(float, (unsigned)b << 16); }
typedef float f32x2_t __attribute__((ext_vector_type(2))); typedef __bf16 bf16x2_t __attribute__((ext_vector_type(2)));
__device__ __forceinline__ unsigned pk2(float lo, float hi) { f32x2_t v = {lo, hi}; bf16x2_t b = __builtin_convertvector(v, bf16x2_t); return __builtin_bit_cast(unsigned, b); }
__device__ __forceinline__ bf16 f2bf(float f) { return (bf16)(pk2(f, 0.f) & 0xffffu); }
__device__ __forceinline__ void unpack8(const v4u w, float (&f)[8]) { f[0] = bf_lo(w.x); f[1] = bf_hi(w.x); f[2] = bf_lo(w.y); f[3] = bf_hi(w.y); f[4] = bf_lo(w.z); f[5] = bf_hi(w.z); f[6] = bf_lo(w.w); f[7] = bf_hi(w.w); }
__device__ __forceinline__ v4u pack8(const float (&f)[8]) { v4u w; w.x = pk2(f[0], f[1]); w.y = pk2(f[2], f[3]); w.z = pk2(f[4], f[5]); w.w = pk2(f[6], f[7]); return w; }
__device__ __forceinline__ float silu_f(float x) { return x / (1.f + __expf(-x)); }
__device__ __forceinline__ float sigmoid_f(float x) { return 1.f / (1.f + __expf(-x)); }
__device__ __forceinline__ float logsig_f(float z) { return fminf(z, 0.f) - __logf(1.f + __expf(-fabsf(z))); }
__device__ __forceinline__ float wave_sum(float v) {
#pragma unroll
    for (int o = 1; o < 64; o <<= 1) v += __shfl_xor(v, o);
    return v;
}
__device__ __forceinline__ float wave_max(float v) {
#pragma unroll
    for (int o = 1; o < 64; o <<= 1) v = fmaxf(v, __shfl_xor(v, o));
    return v;
}
__device__ __forceinline__ float wave_scan_sum(float v, int dir, int lane) {
#pragma unroll
    for (int o = 1; o < 64; o <<= 1) { const float up = __shfl_up(v, o), dn = __shfl_down(v, o); if (dir == 0) { if (lane >= o) v += up; } else { if (lane + o < 64) v += dn; } }
    return v;
}
__device__ __forceinline__ float wave_scan_max(float v, int dir, int lane) {
#pragma unroll
    for (int o = 1; o < 64; o <<= 1) { const float up = __shfl_up(v, o), dn = __shfl_down(v, o); if (dir == 0) { if (lane >= o) v = fmaxf(v, up); } else { if (lane + o < 64) v = fmaxf(v, dn); } }
    return v;
}
__device__ __forceinline__ bool seq_start(int r) { return r < NLATR ? (r & 4095) == 0 : ((r - NLATR) & 255) == 0; }

__device__ __forceinline__ bf16x8 frag_row(LAS const unsigned char* base, int stride, int row0, int k0, int lane) {
    return *(LAS const bf16x8*)(base + (row0 + (lane & 31)) * stride + (k0 + 8 * (lane >> 5)) * 2);
}
__device__ __forceinline__ s16x4 tr4(LAS const unsigned char* p) { return __builtin_amdgcn_ds_read_tr16_b64_v4i16((LAS s16x4*)p); }
__device__ __forceinline__ bf16x8 frag_tr(LAS const unsigned char* base, int stride, int k0, int col0, int lane) {
    const int h = lane >> 5, blk = (lane >> 4) & 1, q = (lane & 15) >> 2, p = lane & 3;
    LAS const unsigned char* a = base + (k0 + 8 * h + q) * stride + (col0 + 16 * blk + 4 * p) * 2;
    const s16x4 lo = tr4(a), hi = tr4(a + 4 * stride);
    return (bf16x8){lo[0], lo[1], lo[2], lo[3], hi[0], hi[1], hi[2], hi[3]};
}
__device__ __forceinline__ bf16x8 frag_tr_perm(LAS const unsigned char* base, int stride, int k0, int col0, int lane) {
    const int h = lane >> 5, blk = (lane >> 4) & 1, q = (lane & 15) >> 2, p = lane & 3;
    LAS const unsigned char* a = base + (k0 + 4 * h + q) * stride + (col0 + 16 * blk + 4 * p) * 2;
    const s16x4 lo = tr4(a), hi = tr4(a + 8 * stride);
    return (bf16x8){lo[0], lo[1], lo[2], lo[3], hi[0], hi[1], hi[2], hi[3]};
}
__device__ __forceinline__ int swz_off(int row, int ch) { return 256 * row + 16 * (ch ^ (((row & 3) << 2) | ((row >> 2) & 3))); }
__device__ __forceinline__ bf16x8 sfrag_row(LAS const unsigned char* base, int row0, int k0, int lane) {
    return *(LAS const bf16x8*)(base + swz_off(row0 + (lane & 31), (k0 >> 3) + (lane >> 5)));
}
__device__ __forceinline__ bf16x8 sfrag_tr_perm(LAS const unsigned char* base, int k0, int col0, int lane) {
    const int h = lane >> 5, blk = (lane >> 4) & 1, q = (lane & 15) >> 2, p = lane & 3, ch = (col0 >> 3) + 2 * blk + (p >> 1), r0 = k0 + 4 * h + q;
    const s16x4 lo = tr4(base + swz_off(r0, ch) + 8 * (p & 1)), hi = tr4(base + swz_off(r0 + 8, ch) + 8 * (p & 1));
    return (bf16x8){lo[0], lo[1], lo[2], lo[3], hi[0], hi[1], hi[2], hi[3]};
}
#define MFMA32(a, b, c) __builtin_amdgcn_mfma_f32_32x32x16_bf16((a), (b), (c), 0, 0, 0)
__device__ __forceinline__ f32x16 zero16() { f32x16 z;
#pragma unroll
    for (int i = 0; i < 16; ++i) z[i] = 0.f;
    return z; }
__device__ __forceinline__ void load_tile(LAS unsigned char* dst, int ls, const bf16* src, size_t ld, int rows, int cols, int tid) {
    const int cpr = cols >> 3, n = rows * cpr;
    for (int c = tid; c < n; c += NTHR) { const int r = c / cpr, cc = c - r * cpr; *(LAS v4u*)(dst + r * ls + cc * 16) = *(const v4u*)(src + (size_t)r * ld + cc * 8); }
}

__device__ __forceinline__ void store_tile(bf16* dst, size_t ld, LAS const unsigned char* src, int ls, int rows, int cols, int tid) {
    const int cpr = cols >> 3, n = rows * cpr;
    for (int c = tid; c < n; c += NTHR) { const int r = c / cpr, cc = c - r * cpr; *(v4u*)(dst + (size_t)r * ld + cc * 8) = *(LAS const v4u*)(src + r * ls + cc * 16); }
}

struct TrItem { const float* W; bf16* WT; int K, N, k0, n0, dn0, nts; };
__device__ __forceinline__ void tr_issue(const TrItem& t, f32x4 (&v)[8], int lane) {
    const int n = t.n0 + 4 * (lane & 7);
#pragma unroll
    for (int i = 0; i < 8; ++i) { const int kk = 8 * i + (lane >> 3); v[i] = n < t.N ? __builtin_nontemporal_load((const f32x4*)(t.W + (size_t)(t.k0 + kk) * t.N + n)) : (f32x4){0.f, 0.f, 0.f, 0.f}; }
}
__device__ __forceinline__ void tr_finish(const TrItem& t, const f32x4 (&v)[8], LAS float* scr, int lane) {
#pragma unroll
    for (int i = 0; i < 8; ++i) { const int kk = 8 * i + (lane >> 3); LAS float* d = scr + kk * 33 + 4 * (lane & 7); d[0] = v[i].x; d[1] = v[i].y; d[2] = v[i].z; d[3] = v[i].w; }
    asm volatile("s_waitcnt lgkmcnt(0)" ::: "memory");
    const int c = lane & 7;
#pragma unroll
    for (int j = 0; j < 4; ++j) { const int nn = (lane >> 3) + 8 * j; const LAS float* s = scr + (8 * c) * 33 + nn;
        v4u o; o.x = pk2(s[0 * 33], s[1 * 33]); o.y = pk2(s[2 * 33], s[3 * 33]); o.z = pk2(s[4 * 33], s[5 * 33]); o.w = pk2(s[6 * 33], s[7 * 33]);
        if (t.k0 >= 0 && t.nts) __builtin_nontemporal_store(o, (v4u*)(t.WT + (size_t)(t.dn0 + nn) * t.K + t.k0 + 8 * c)); else *(v4u*)(t.WT + (size_t)(t.dn0 + nn) * t.K + t.k0 + 8 * c) = o; }
    asm volatile("s_waitcnt lgkmcnt(0)" ::: "memory");
}
__device__ __forceinline__ void tr_decode(const Args& a, unsigned char* ws, int g, TrItem& t) {
    const int layer = g / 25344; int r = g - layer * 25344; const int li = layer >> 1; t.nts = layer > 0;
    unsigned char* wb = ws + WS_W + (size_t)layer * W_LAYER;
    int nblk;
    if (r < 6400) { if (layer & 1) { t.W = a.in[14] + (size_t)li * DM * ODIN; t.N = ODIN; } else { t.W = a.in[8] + (size_t)li * DM * EVIN; t.N = EVIN; } t.WT = (bf16*)wb; t.K = DM; nblk = NINP / 32; }
    else if ((r -= 6400) < 2048) { t.W = (layer & 1 ? a.in[15] : a.in[9]) + (size_t)li * DM * DM; t.N = DM; t.WT = (bf16*)(wb + W_OUT); t.K = DM; nblk = DM / 32; }
    else if ((r -= 2048) < 11264) { t.W = a.in[23] + (size_t)layer * DM * NUP; t.N = NUP; t.WT = (bf16*)(wb + W_UP); t.K = DM; nblk = NUP / 32; }
    else { r -= 11264; t.W = a.in[26] + (size_t)layer * DFF * DM; t.N = DM; t.WT = (bf16*)(wb + W_DN); t.K = DFF; nblk = DM / 32; }
    const int kb = r / nblk, nb = r - kb * nblk; t.k0 = 64 * kb; t.n0 = 32 * nb; t.dn0 = t.n0;
    if (t.N == NUP) { const int m0 = t.n0 < DFF ? t.n0 : t.n0 - DFF; t.dn0 = 256 * (m0 >> 7) + (t.n0 < DFF ? 0 : 128) + (m0 & 127); }
}
__device__ __forceinline__ void ph_convert(const Args& a, unsigned char* ws, LAS unsigned char* lds, int g_lo, int g_hi, int w, int nw, int wave, int lane) {
    LAS float* scr = (LAS float*)(lds + wave * 8448);
    TrItem cur, nxt; f32x4 va[8], vb[8];
    int g = g_lo + w;
    if (g < g_hi) { tr_decode(a, ws, g, cur); tr_issue(cur, va, lane); }
    while (g < g_hi) {
        const int g1 = g + nw; if (g1 < g_hi) { tr_decode(a, ws, g1, nxt); tr_issue(nxt, vb, lane); }
        tr_finish(cur, va, scr, lane);
        const int g2 = g1 + nw; if (g1 < g_hi) { if (g2 < g_hi) { tr_decode(a, ws, g2, cur); tr_issue(cur, va, lane); } tr_finish(nxt, vb, scr, lane); }
        g = g2;
    }
}
__device__ __forceinline__ void ph_prologue(const Args& a, unsigned char* ws, LAS unsigned char* lds, int tid, int lane, int wave, int bid, int G) {
    float* MOD = (float*)(ws + WS_MOD);
    LAS float* vec = (LAS float*)(lds + 73728);
    LAS float* red = (LAS float*)(lds + 98304);
    for (int e = tid; e < 3 * DM; e += NTHR) { const float v = e < 2 * DM ? a.in[1][e] : a.in[3][e - 2 * DM]; vec[e] = silu_f(v); }
    __syncthreads();
    for (int it = bid; it < 4 * 192; it += G) {
        const int layer = it / 192, cg = it - layer * 192, col = cg * 64 + 4 * (lane & 15), rq = lane >> 4;
        const float* W = a.in[4] + (size_t)layer * DM * 12288 + col;
        f32x4 a0 = {0.f, 0.f, 0.f, 0.f}, a1 = a0, a2 = a0;
#pragma unroll 16
        for (int i = 0; i < 64; ++i) { const int kk = 256 * wave + 4 * i + rq; const f32x4 w4 = __builtin_nontemporal_load((const f32x4*)(W + (size_t)kk * 12288));
            a0 += w4 * vec[kk]; a1 += w4 * vec[DM + kk]; a2 += w4 * vec[2 * DM + kk]; }
#pragma unroll
        for (int e = 0; e < 4; ++e) { a0[e] += __shfl_xor(a0[e], 16); a0[e] += __shfl_xor(a0[e], 32); a1[e] += __shfl_xor(a1[e], 16); a1[e] += __shfl_xor(a1[e], 32); a2[e] += __shfl_xor(a2[e], 16); a2[e] += __shfl_xor(a2[e], 32); }
        if (lane < 16) { *(LAS f32x4*)(red + (wave * 3 + 0) * 64 + 4 * lane) = a0; *(LAS f32x4*)(red + (wave * 3 + 1) * 64 + 4 * lane) = a1; *(LAS f32x4*)(red + (wave * 3 + 2) * 64 + 4 * lane) = a2; }
        __syncthreads();
        if (tid < 192) { const int j = tid >> 6, c = tid & 63; float s = a.in[5][layer * 12288 + cg * 64 + c];
#pragma unroll
            for (int w = 0; w < 8; ++w) s += red[(w * 3 + j) * 64 + c];
            MOD[(size_t)(layer * 3 + j) * 12288 + cg * 64 + c] = s; }
        __syncthreads();
    }
    if (bid == G - 1) { float* rope = (float*)(ws + WS_ROPE);
        for (int e = tid; e < 1024; e += NTHR) { const int pos = e >> 4, f = e & 15; const float inv = powf(10000.f, -(float)f / 16.f), ang = (float)pos * inv; rope[e] = cosf(ang); rope[1024 + e] = sinf(ang); } }
    ph_convert(a, ws, lds, 0, 25344, bid * NWAVES + wave, G * NWAVES, wave, lane);
}

__device__ __forceinline__ void fuse_row(const float* src, float* XS, int row, int lane, const float* part, const float* pgate, int nsplit, const float* ng, const float* msc, bf16* H, float* ssq) {
    const int mi = row < NLATR ? (row >> 12) : 2;
    const f32x4* sr = (const f32x4*)src + lane; f32x4* xr = (f32x4*)(XS + (size_t)row * DM) + lane;
    f32x4 v[8];
#pragma unroll
    for (int j = 0; j < 8; ++j) v[j] = sr[64 * j];
    if (nsplit > 0) {
        f32x4 sacc[8];
#pragma unroll
        for (int j = 0; j < 8; ++j) sacc[j] = (f32x4){0.f, 0.f, 0.f, 0.f};
        for (int sp = 0; sp < nsplit; ++sp) { const f32x4* pr = (const f32x4*)(part + ((size_t)sp * 512 + (row - NLATR)) * DM) + lane;
#pragma unroll
            for (int j = 0; j < 8; ++j) sacc[j] += pr[64 * j]; }
#pragma unroll
        for (int j = 0; j < 8; ++j) v[j] += *(const f32x4*)(pgate + 4 * lane + 256 * j) * sacc[j];
    }
    float ss = 0.f;
#pragma unroll
    for (int j = 0; j < 8; ++j) { xr[64 * j] = v[j]; ss += (v[j].x * v[j].x + v[j].y * v[j].y) + (v[j].z * v[j].z + v[j].w * v[j].w); }
    ss = wave_sum(ss);
    if (lane == 0) ssq[row] = ss;
#pragma unroll
    for (int j = 0; j < 8; ++j) { const int col = 4 * lane + 256 * j;
        const f32x4 y = v[j] * *(const f32x4*)(ng + col) * (*(const f32x4*)(msc + (size_t)mi * 12288 + col) + 1.f);
        v2u o; o.x = pk2(y.x, y.y); o.y = pk2(y.z, y.w);
        *(v2u*)(H + (size_t)row * DM + col) = o; }
}
__device__ __forceinline__ void ph_norm0(const float* x, const float* ctx, float* XS, const float* ng, const float* msc, bf16* H, float* ssq, int gw, int NGW, int lane) {
    for (int row = gw; row < MR; row += NGW) fuse_row(row < NLATR ? x + (size_t)row * DM : ctx + (size_t)(row - NLATR) * DM, XS, row, lane, nullptr, nullptr, 0, ng, msc, H, ssq);
}
template <int NS>
__device__ __forceinline__ void ph_ctxfix(float* XS, const float* part, const float* pgate, const float* ng, const float* msc, bf16* H, float* ssq, int gw, int NGW, int lane) {
    for (int it = gw; it < 2048; it += NGW) {
        const int row = NLATR + (it >> 2), c0 = (it & 3) * 512 + 8 * lane;
        float* xp = XS + (size_t)row * DM + c0;
        f32x4 v0 = *(const f32x4*)xp, v1 = *(const f32x4*)(xp + 4);
        f32x4 p0[NS], p1[NS];
#pragma unroll
        for (int sp = 0; sp < NS; ++sp) { const float* pp = part + ((size_t)sp * 512 + (row - NLATR)) * DM + c0; p0[sp] = *(const f32x4*)pp; p1[sp] = *(const f32x4*)(pp + 4); }
        f32x4 s0 = p0[0], s1 = p1[0];
#pragma unroll
        for (int sp = 1; sp < NS; ++sp) { s0 += p0[sp]; s1 += p1[sp]; }
        v0 += *(const f32x4*)(pgate + c0) * s0; v1 += *(const f32x4*)(pgate + c0 + 4) * s1;
        *(f32x4*)xp = v0; *(f32x4*)(xp + 4) = v1;
        float ss = (v0.x * v0.x + v0.y * v0.y) + (v0.z * v0.z + v0.w * v0.w) + (v1.x * v1.x + v1.y * v1.y) + (v1.z * v1.z + v1.w * v1.w);
        ss = wave_sum(ss);
        if (lane == 0) (void)__hip_atomic_fetch_add(ssq + row, ss, __ATOMIC_RELAXED, __HIP_MEMORY_SCOPE_AGENT);
        const f32x4 y0 = v0 * *(const f32x4*)(ng + c0) * (*(const f32x4*)(msc + 2 * 12288 + c0) + 1.f), y1 = v1 * *(const f32x4*)(ng + c0 + 4) * (*(const f32x4*)(msc + 2 * 12288 + c0 + 4) + 1.f);
        v4u o; o.x = pk2(y0.x, y0.y); o.y = pk2(y0.z, y0.w); o.z = pk2(y1.x, y1.y); o.w = pk2(y1.z, y1.w);
        *(v4u*)(H + (size_t)row * DM + c0) = o;
    }
}
__device__ __forceinline__ void ph_bias(const bf16* WIN, const bf16* WUPt, const float* mod, float* b1, float* b2, int gw, int NGW, int lane) {
    for (int which = 0; which < 2; ++which) {
        const bf16* WT = which ? WUPt : WIN; const int N = which ? NUP : NINP; const float* sh = mod + (which ? 3 * DM : 0); float* out = which ? b2 : b1;
        float s0[32], s1[32], s2[32];
#pragma unroll
        for (int i = 0; i < 4; ++i)
#pragma unroll
            for (int h = 0; h < 2; ++h) { const int k = 512 * i + 8 * lane + 4 * h; const f32x4 a0 = *(const f32x4*)(sh + k), a1 = *(const f32x4*)(sh + 12288 + k), a2 = *(const f32x4*)(sh + 2 * 12288 + k);
#pragma unroll
                for (int el = 0; el < 4; ++el) { s0[8 * i + 4 * h + el] = a0[el]; s1[8 * i + 4 * h + el] = a1[el]; s2[8 * i + 4 * h + el] = a2[el]; } }
#pragma unroll 1
        for (int n0 = gw * 2; n0 < N; n0 += NGW * 2) {
            v4u wv[2][4];
#pragma unroll
            for (int rr = 0; rr < 2; ++rr)
#pragma unroll
                for (int i = 0; i < 4; ++i) wv[rr][i] = *(const v4u*)(WT + (size_t)(n0 + rr) * DM + 512 * i + 8 * lane);
            float d[2][3];
#pragma unroll
            for (int rr = 0; rr < 2; ++rr) { d[rr][0] = 0.f; d[rr][1] = 0.f; d[rr][2] = 0.f;
#pragma unroll
                for (int i = 0; i < 4; ++i) { float w[8]; unpack8(wv[rr][i], w);
#pragma unroll
                    for (int el = 0; el < 8; ++el) { d[rr][0] += w[el] * s0[8 * i + el]; d[rr][1] += w[el] * s1[8 * i + el]; d[rr][2] += w[el] * s2[8 * i + el]; } } }
#pragma unroll
            for (int rr = 0; rr < 2; ++rr)
#pragma unroll
                for (int j = 0; j < 3; ++j) d[rr][j] = wave_sum(d[rr][j]);
            if (lane == 0) {
#pragma unroll
                for (int rr = 0; rr < 2; ++rr) { out[n0 + rr] = d[rr][0]; out[N + n0 + rr] = d[rr][1]; out[2 * N + n0 + rr] = d[rr][2]; } }
        }
    }
}

template <int MODE>
__device__ __forceinline__ void ph_conv(const bf16* SRC, const float* cw, const float* cb, bf16* DST, int gtid, int NT) {
    constexpr int NC = MODE == 0 ? DFF : 1024, NCG = NC / 8, NRB = MR / 16;
    constexpr int LDS_ = MODE == 0 ? NUP : NINP, LDD = MODE == 0 ? DFF : (MODE == 1 ? DM : 1024);
    for (int it = gtid; it < NRB * NCG; it += NT) {
        const int rb = it / NCG, cg = it - rb * NCG, r0 = rb * 16, c0 = cg * 8;
        float w0[8], w1[8], w2[8], bb[8];
#pragma unroll
        for (int j = 0; j < 8; ++j) { w0[j] = cw[c0 + j]; w1[j] = cw[NC + c0 + j]; w2[j] = cw[2 * NC + c0 + j]; bb[j] = MODE == 0 ? cb[c0 + j] : 0.f; }
        auto ld = [&](int r, float (&f)[8]) {
            if (MODE == 0) { unpack8(*(const v4u*)(SRC + (size_t)r * LDS_ + c0), f); }
            else if (MODE == 1) { float s1[8], s2[8]; unpack8(*(const v4u*)(SRC + (size_t)r * LDS_ + 3104 + c0), s1); unpack8(*(const v4u*)(SRC + (size_t)r * LDS_ + 5152 + c0), s2);
#pragma unroll
                for (int j = 0; j < 8; ++j) f[j] = s1[j] * s2[j]; }
            else { unpack8(*(const v4u*)(SRC + (size_t)r * LDS_ + 3072 + c0), f); }
        };
        float prev[8], cur[8], nxt[8];
        if (!seq_start(r0)) ld(r0 - 1, prev); else {
#pragma unroll
            for (int j = 0; j < 8; ++j) prev[j] = 0.f; }
        ld(r0, cur);
#pragma unroll 2
        for (int i = 0; i < 16; ++i) {
            const int r = r0 + i;
            if (i < 15 || !seq_start(r0 + 16)) ld(r + 1, nxt); else {
#pragma unroll
                for (int j = 0; j < 8; ++j) nxt[j] = 0.f; }
            float o[8];
            if (MODE == 0) { float vv[8]; unpack8(*(const v4u*)(SRC + (size_t)r * LDS_ + DFF + c0), vv);
#pragma unroll
                for (int j = 0; j < 8; ++j) o[j] = silu_f(w0[j] * prev[j] + w1[j] * cur[j] + w2[j] * nxt[j] + bb[j]) * vv[j]; }
            else if (MODE == 1) { float vv[8]; unpack8(*(const v4u*)(SRC + (size_t)r * LDS_ + 4128 + c0), vv);
#pragma unroll
                for (int j = 0; j < 8; ++j) o[j] = (w0[j] * prev[j] + w1[j] * cur[j] + w2[j] * nxt[j]) * vv[j]; }
            else { const float sc = c0 >= 512 ? 0.08838834764831845f : 1.f;
#pragma unroll
                for (int j = 0; j < 8; ++j) o[j] = silu_f(w0[j] * prev[j] + w1[j] * cur[j] + w2[j] * nxt[j]) * sc; }
            *(v4u*)(DST + (size_t)r * LDD + (MODE == 1 ? 1024 : 0) + c0) = pack8(o);
#pragma unroll
            for (int j = 0; j < 8; ++j) { prev[j] = cur[j]; cur[j] = nxt[j]; }
        }
    }
}

__device__ __forceinline__ void ph_act_fix(const float* halo, const float* cw, bf16* ACT, int gtid, int NT) {
    for (int e = gtid; e < 34 * 44 * 256; e += NT) {
        const int ch = e & 127, which = (e >> 7) & 1, tile = e >> 8, pm = tile / 44, pn = tile - pm * 44, chg = pn * 128 + ch;
        const float* hb = halo + (size_t)tile * 768;
        const int row = 256 * pm + (which ? 255 : 0);
        float g = 0.f;
        if (which == 0) { if (!seq_start(row)) g = halo[(size_t)(tile - 44) * 768 + 128 + ch] * cw[chg]; }
        else { if (!seq_start(row + 1)) g = halo[(size_t)(tile + 44) * 768 + ch] * cw[2 * DFF + chg]; }
        const float cv = hb[(2 + which) * 128 + ch] + g;
        ACT[(size_t)row * DFF + chg] = f2bf(silu_f(cv) * hb[(4 + which) * 128 + ch]);
    }
}

__device__ __forceinline__ void act_fix_tile(const float* halo, const float* cw, bf16* ACT, int pm, int tid) {
    f32x4 cp[6], vv[6], gg[6];
#pragma unroll
    for (int i = 0; i < 6; ++i) { const int e = tid + NTHR * i; const bool ok = e < 2816; const int ee = ok ? e : 0;
        const int c4 = ee & 31, which = (ee >> 5) & 1, pn = ee >> 6, tile = pm * 44 + pn, chg = pn * 128 + 4 * c4;
        const float* hb = halo + (size_t)tile * 768 + 4 * c4;
        const int row = 256 * pm + (which ? 255 : 0);
        cp[i] = *(const f32x4*)(hb + (2 + which) * 128); vv[i] = *(const f32x4*)(hb + (4 + which) * 128);
        const bool edge = which == 0 ? seq_start(row) : seq_start(row + 1);
        const f32x4 nb = edge ? (f32x4){0.f, 0.f, 0.f, 0.f} : *(const f32x4*)(halo + (size_t)(which == 0 ? tile - 44 : tile + 44) * 768 + (which == 0 ? 128 : 0) + 4 * c4);
        gg[i] = nb * *(const f32x4*)(cw + (which == 0 ? 0 : 2 * DFF) + chg); }
#pragma unroll
    for (int i = 0; i < 6; ++i) { const int e = tid + NTHR * i; if (e < 2816) {
        const int c4 = e & 31, which = (e >> 5) & 1, pn = e >> 6, chg = pn * 128 + 4 * c4; const int row = 256 * pm + (which ? 255 : 0);
        const f32x4 cv = cp[i] + gg[i];
        v2u o; o.x = pk2(silu_f(cv.x) * vv[i].x, silu_f(cv.y) * vv[i].y); o.y = pk2(silu_f(cv.z) * vv[i].z, silu_f(cv.w) * vv[i].w);
        *(v2u*)(ACT + (size_t)row * DFF + chg) = o; } }
}

template <int MODE>
__device__ __forceinline__ void ph_conv8(const bf16* SRC, const float* cw, bf16* DST, int gtid, int NT) {
    constexpr int NCG = 128, NRB = MR / 8, LDD = MODE == 1 ? DM : 1024;
    for (int it = gtid; it < NRB * NCG; it += NT) {
        const int rb = it >> 7, cg = it & 127, r0 = rb * 8, c0 = cg * 8;
        const bf16* base = SRC + (size_t)r0 * NINP + c0;
        const bool hp = !seq_start(r0), hn = !seq_start(r0 + 8);
        v4u xa[10], xb[10], xg[8];
#pragma unroll
        for (int i = 0; i < 10; ++i) { const bool ok = (i > 0 || hp) && (i < 9 || hn); const bf16* rp = base + (ptrdiff_t)(i - 1) * NINP;
            if (MODE == 1) { xa[i] = ok ? *(const v4u*)(rp + 3104) : (v4u){0u, 0u, 0u, 0u}; xb[i] = ok ? *(const v4u*)(rp + 5152) : (v4u){0u, 0u, 0u, 0u}; }
            else { xa[i] = ok ? *(const v4u*)(rp + 3072) : (v4u){0u, 0u, 0u, 0u}; } }
        if (MODE == 1) {
#pragma unroll
            for (int i = 0; i < 8; ++i) xg[i] = *(const v4u*)(base + (size_t)i * NINP + 4128); }
        float w0[8], w1[8], w2[8];
#pragma unroll
        for (int j = 0; j < 8; ++j) { w0[j] = cw[c0 + j]; w1[j] = cw[1024 + c0 + j]; w2[j] = cw[2048 + c0 + j]; }
        float prev[8], cur[8], nxt[8];
        auto cvt = [&](int i, float (&f)[8]) { unpack8(xa[i], f); if (MODE == 1) { float g[8]; unpack8(xb[i], g);
#pragma unroll
            for (int j = 0; j < 8; ++j) f[j] *= g[j]; } };
        cvt(0, prev); cvt(1, cur);
        const float sc = (MODE == 2 && c0 >= 512) ? 0.08838834764831845f : 1.f;
#pragma unroll
        for (int i = 0; i < 8; ++i) { cvt(i + 2, nxt); float o[8];
            if (MODE == 1) { float vv[8]; unpack8(xg[i], vv);
#pragma unroll
                for (int j = 0; j < 8; ++j) o[j] = (w0[j] * prev[j] + w1[j] * cur[j] + w2[j] * nxt[j]) * vv[j]; }
            else {
#pragma unroll
                for (int j = 0; j < 8; ++j) o[j] = silu_f(w0[j] * prev[j] + w1[j] * cur[j] + w2[j] * nxt[j]) * sc; }
            *(v4u*)(DST + (size_t)(r0 + i) * LDD + (MODE == 1 ? 1024 : 0) + c0) = pack8(o);
#pragma unroll
            for (int j = 0; j < 8; ++j) { prev[j] = cur[j]; cur[j] = nxt[j]; } }
    }
}

__device__ __forceinline__ void ph_qkprep(const bf16* P, const float* qg, const float* kg, const float* rope, bf16* QR, bf16* KR, int gw, int NGW, int lane) {
    const int i8 = lane & 7;
    float gq[8], gk[8];
#pragma unroll
    for (int j = 0; j < 8; ++j) { gq[j] = qg[8 * i8 + j]; gk[j] = kg[8 * i8 + j]; }
    for (int it0 = gw; it0 < MR * 4; it0 += 4 * NGW) {
        v4u xv[4];
#pragma unroll
        for (int k = 0; k < 4; ++k) { const int it = it0 + k * NGW; const int itc = it < MR * 4 ? it : it0; const int row = itc >> 2, qtr = itc & 3;
            xv[k] = *(const v4u*)(P + (size_t)row * NINP + (qtr >> 1) * 1024 + (qtr & 1) * 512 + 8 * lane); }
#pragma unroll
        for (int k = 0; k < 4; ++k) { const int it = it0 + k * NGW; if (it < MR * 4) {
            const int row = it >> 2, qtr = it & 3, isk = qtr >> 1;
            float x[8]; unpack8(xv[k], x);
            float ss = 0.f;
#pragma unroll
            for (int j = 0; j < 8; ++j) ss += x[j] * x[j];
            ss += __shfl_xor(ss, 1); ss += __shfl_xor(ss, 2); ss += __shfl_xor(ss, 4);
            const float r = rsqrtf(ss * (1.f / 64.f) + EPS);
            float y[8], o[8];
#pragma unroll
            for (int j = 0; j < 8; ++j) y[j] = x[j] * r * (isk ? gk[j] : gq[j]);
            if (row < NLATR) {
                const int t = row & 4095, pos = (i8 < 4) ? (t >> 6) : (t & 63), f0 = 8 * (i8 & 1);
                const f32x4 c0 = *(const f32x4*)(rope + pos * 16 + f0), c1 = *(const f32x4*)(rope + pos * 16 + f0 + 4), s0 = *(const f32x4*)(rope + 1024 + pos * 16 + f0), s1 = *(const f32x4*)(rope + 1024 + pos * 16 + f0 + 4);
#pragma unroll
                for (int j = 0; j < 8; ++j) { const float pj = __shfl_xor(y[j], 2), c = j < 4 ? c0[j & 3] : c1[j & 3], sn = j < 4 ? s0[j & 3] : s1[j & 3];
                    o[j] = (i8 & 2) ? (pj * sn + y[j] * c) : (y[j] * c - pj * sn); }
            } else {
#pragma unroll
                for (int j = 0; j < 8; ++j) o[j] = y[j]; }
            if (!isk) {
#pragma unroll
                for (int j = 0; j < 8; ++j) o[j] *= 0.18033688011112042f; }
            *(v4u*)((isk ? KR : QR) + (size_t)row * 1024 + (qtr & 1) * 512 + 8 * lane) = pack8(o); } }
    }
}

struct ScanP {
    const bf16* P; const bf16* MQK; bf16* MIX;
    const float* gw2; const float* gb;
    const float* mgb;
    const float* ng;
    bf16* DSTp; bf16* SSTp; float* GAM; float* DN; float* NIN; float* BL; float* ML; float* MINp;
};
__device__ __forceinline__ void scan_unit(int u, int& b, int& head, int& mm, int& rowbase) {
    b = u / 272; const int rem = u - b * 272; head = rem / 68; mm = rem - head * 68;
    rowbase = mm < 4 ? NLATR + b * 256 + 64 * mm : b * 4096 + 64 * (mm - 4);
}
__device__ __forceinline__ int scan_chunk(int mm, int dir) { return dir ? (mm < 4 ? 3 - mm : 71 - mm) : mm; }

__device__ __forceinline__ void gla_gates(const ScanP& s, LAS const float* glr, LAS float* tot, int head, int dir, int tid, float (&bb)[16], float& btot) {
    const int dk = tid & 127, grp = tid >> 7;
    float w2[16];
#pragma unroll
    for (int r = 0; r < 16; ++r) w2[r] = s.gw2[(dir * 16 + r) * 512 + head * 128 + dk];
    const float bias = s.gb[dir * 512 + head * 128 + dk];
#pragma unroll
    for (int tt = 0; tt < 16; ++tt) { const int t = 16 * grp + tt; float z = bias;
#pragma unroll
        for (int r = 0; r < 16; ++r) z += glr[t * 32 + dir * 16 + r] * w2[r];
        bb[tt] = logsig_f(z) * 0.0625f; }
    if (dir == 0) {
#pragma unroll
        for (int tt = 1; tt < 16; ++tt) bb[tt] += bb[tt - 1];
        tot[grp * 128 + dk] = bb[15];
    } else {
#pragma unroll
        for (int tt = 14; tt >= 0; --tt) bb[tt] += bb[tt + 1];
        tot[grp * 128 + dk] = bb[0];
    }
    __syncthreads();
    float off = 0.f; btot = 0.f;
#pragma unroll
    for (int g = 0; g < 4; ++g) { const float tv = tot[g * 128 + dk]; btot += tv; if (dir == 0 ? g < grp : g > grp) off += tv; }
#pragma unroll
    for (int tt = 0; tt < 16; ++tt) bb[tt] += off;
}

__device__ __forceinline__ void ph_mlstm_local(const ScanP& s, LAS unsigned char* lds, int tid, int lane, int wave, int bid, int G) {
    LAS unsigned char* Vs = lds; LAS unsigned char* Kh = lds + 33792; LAS unsigned char* Kr = lds + 68608;
    LAS float* wv = (LAS float*)(lds + 86016); LAS float* dnp = (LAS float*)(lds + 86528);
    const int dk = tid & 127, grp = tid >> 7;
    v4u pv[4], pk[2];
#define ML_PREF(u_) do { int b_, head_, mm_, rb_; scan_unit((u_), b_, head_, mm_, rb_); \
        _Pragma("unroll") for (int i = 0; i < 4; ++i) { const int c_ = tid + NTHR * i; pv[i] = *(const v4u*)(s.P + (size_t)(rb_ + (c_ >> 5)) * NINP + 4096 + head_ * 256 + (c_ & 31) * 8); } \
        _Pragma("unroll") for (int i = 0; i < 2; ++i) { const int c_ = tid + NTHR * i; pk[i] = *(const v4u*)(s.MQK + (size_t)(rb_ + (c_ >> 4)) * 1024 + 512 + head_ * 128 + (c_ & 15) * 8); } } while (0)
    if (bid < 544) ML_PREF(bid);
    for (int u = bid; u < 544; u += G) {
        int b, head, mm, rowbase; scan_unit(u, b, head, mm, rowbase);
#pragma unroll
        for (int i = 0; i < 4; ++i) { const int c_ = tid + NTHR * i; *(LAS v4u*)(Vs + (c_ >> 5) * 528 + (c_ & 31) * 16) = pv[i]; }
#pragma unroll
        for (int i = 0; i < 2; ++i) { const int c_ = tid + NTHR * i; *(LAS v4u*)(Kr + (c_ >> 4) * 272 + (c_ & 15) * 16) = pk[i]; }
        size_t ccd[2];
#pragma unroll
        for (int dir = 0; dir < 2; ++dir) ccd[dir] = (size_t)((b * 4 + head) * 2 + dir) * NCHUNK + scan_chunk(mm, dir);
        if (wave < 2) { const int dir = wave;
            const float ig = bf1(s.P[(size_t)(rowbase + lane) * NINP + 6144 + dir * 8 + head]) + s.mgb[dir * 8 + head];
            const float fg = bf1(s.P[(size_t)(rowbase + lane) * NINP + 6144 + dir * 8 + 4 + head]) + s.mgb[dir * 8 + 4 + head];
            const float lf = logsig_f(fg), bcs = wave_scan_sum(lf, dir, lane), blast = wave_sum(lf);
            const float gs = blast - bcs + ig, mloc = wave_max(gs);
            wv[dir * 64 + lane] = __expf(gs - mloc);
            if (lane == 0) { s.BL[ccd[dir]] = blast; s.ML[ccd[dir]] = mloc; } }
        __syncthreads();
        if (u + G < 544) ML_PREF(u + G);
        { float p0 = 0.f, p1 = 0.f;
#pragma unroll
          for (int tt = 0; tt < 16; ++tt) { const int t = 16 * grp + tt; const float kr = bf1(*(LAS const bf16*)(Kr + t * 272 + dk * 2)); const float k0 = kr * wv[t], k1 = kr * wv[64 + t];
              *(LAS bf16*)(Kh + t * 272 + dk * 2) = f2bf(k0); *(LAS bf16*)(Kh + 17408 + t * 272 + dk * 2) = f2bf(k1); p0 += k0; p1 += k1; }
          dnp[grp * 128 + dk] = p0; dnp[512 + grp * 128 + dk] = p1; }
        __syncthreads();
        if (tid < 256) { const int dir = tid >> 7, d_ = tid & 127; LAS const float* dp = dnp + dir * 512; s.DN[ccd[dir] * 128 + d_] = (dp[d_] + dp[128 + d_]) + (dp[256 + d_] + dp[384 + d_]); }
#pragma unroll
        for (int dir = 0; dir < 2; ++dir) {
            f32x16 acc[4];
#pragma unroll
            for (int nt = 0; nt < 4; ++nt) acc[nt] = zero16();
#pragma unroll
            for (int ks = 0; ks < 4; ++ks) { const bf16x8 af = frag_tr(Vs, 528, 16 * ks, 32 * wave, lane);
#pragma unroll
                for (int nt = 0; nt < 4; ++nt) { const bf16x8 bfr = frag_tr(Kh + dir * 17408, 272, 16 * ks, 32 * nt, lane); acc[nt] = MFMA32(af, bfr, acc[nt]); } }
            bf16* D = s.DSTp + ccd[dir] * 32768;
#pragma unroll
            for (int nt = 0; nt < 4; ++nt)
#pragma unroll
                for (int r = 0; r < 16; ++r) { const int dv = 32 * wave + (r & 3) + 8 * (r >> 2) + 4 * (lane >> 5); D[dv * 128 + 32 * nt + (lane & 31)] = f2bf(acc[nt][r]); }
        }
        __syncthreads();
    }
#undef ML_PREF
}

__device__ __forceinline__ void ph_gla_local(const ScanP& s, bf16* QT, bf16* KT, LAS unsigned char* lds, int tid, int lane, int wave, int bid, int G) {
    LAS unsigned char* Vs = lds; LAS unsigned char* Kh = lds + 33792; LAS unsigned char* Qr = lds + 51200; LAS unsigned char* Kr = lds + 68608;
    LAS float* glr = (LAS float*)(lds + 86016); LAS float* tot = (LAS float*)(lds + 90112);
    const int dk = tid & 127, grp = tid >> 7;
    v4u pv[4], pq[2], pk[2]; bf16 pg[2]; float pw[17];
#define GL_PREF(u_) do { const int dir_ = (u_) & 1; int b_, head_, mm_, rb_; scan_unit((u_) >> 1, b_, head_, mm_, rb_); const bf16* base_ = s.P + (size_t)rb_ * NINP; \
        _Pragma("unroll") for (int i = 0; i < 4; ++i) { const int c_ = tid + NTHR * i; pv[i] = *(const v4u*)(base_ + (size_t)(c_ >> 5) * NINP + 1024 + head_ * 256 + (c_ & 31) * 8); } \
        _Pragma("unroll") for (int i = 0; i < 2; ++i) { const int c_ = tid + NTHR * i; pq[i] = *(const v4u*)(base_ + (size_t)(c_ >> 4) * NINP + head_ * 128 + (c_ & 15) * 8); pk[i] = *(const v4u*)(base_ + (size_t)(c_ >> 4) * NINP + 512 + head_ * 128 + (c_ & 15) * 8); \
            pg[i] = base_[(size_t)(c_ >> 4) * NINP + 3072 + dir_ * 16 + (c_ & 15)]; } \
        _Pragma("unroll") for (int r_ = 0; r_ < 16; ++r_) pw[r_] = s.gw2[(dir_ * 16 + r_) * 512 + head_ * 128 + (tid & 127)]; pw[16] = s.gb[dir_ * 512 + head_ * 128 + (tid & 127)]; } while (0)
    if (bid < 1088) GL_PREF(bid);
    for (int u = bid; u < 1088; u += G) {
        const int dir = u & 1; int b, head, mm, rowbase; scan_unit(u >> 1, b, head, mm, rowbase);
        const int chain = (b * 4 + head) * 2 + dir, c = scan_chunk(mm, dir); const size_t cc = (size_t)chain * NCHUNK + c;
#pragma unroll
        for (int i = 0; i < 4; ++i) { const int c_ = tid + NTHR * i; *(LAS v4u*)(Vs + (c_ >> 5) * 528 + (c_ & 31) * 16) = pv[i]; }
#pragma unroll
        for (int i = 0; i < 2; ++i) { const int c_ = tid + NTHR * i; *(LAS v4u*)(Qr + (c_ >> 4) * 272 + (c_ & 15) * 16) = pq[i]; *(LAS v4u*)(Kr + (c_ >> 4) * 272 + (c_ & 15) * 16) = pk[i]; glr[c_] = bf1(pg[i]); }
        __syncthreads();
        float bb[16], btot;
        { float w2[16];
#pragma unroll
          for (int r = 0; r < 16; ++r) w2[r] = pw[r];
          const float bias = pw[16];
#pragma unroll
          for (int tt = 0; tt < 16; ++tt) { const int t = 16 * grp + tt; float z = bias;
#pragma unroll
              for (int r = 0; r < 16; ++r) z += glr[t * 16 + r] * w2[r];
              bb[tt] = logsig_f(z) * 0.0625f; }
          if (dir == 0) {
#pragma unroll
              for (int tt = 1; tt < 16; ++tt) bb[tt] += bb[tt - 1];
              tot[grp * 128 + dk] = bb[15];
          } else {
#pragma unroll
              for (int tt = 14; tt >= 0; --tt) bb[tt] += bb[tt + 1];
              tot[grp * 128 + dk] = bb[0];
          }
          __syncthreads();
          float off = 0.f; btot = 0.f;
#pragma unroll
          for (int g = 0; g < 4; ++g) { const float tv = tot[g * 128 + dk]; btot += tv; if (dir == 0 ? g < grp : g > grp) off += tv; }
#pragma unroll
          for (int tt = 0; tt < 16; ++tt) bb[tt] += off; }
        if (u + G < 1088) GL_PREF(u + G);
#pragma unroll
        for (int tt = 0; tt < 16; ++tt) { const int t = 16 * grp + tt;
            const float qv = bf1(*(LAS const bf16*)(Qr + t * 272 + dk * 2)), kv = bf1(*(LAS const bf16*)(Kr + t * 272 + dk * 2));
            const float e1 = __expf(bb[tt]);
            *(LAS bf16*)(Kh + t * 272 + dk * 2) = f2bf(kv * __expf(btot - bb[tt]));
            *(LAS bf16*)(Qr + t * 272 + dk * 2) = f2bf(qv * e1 * 0.08838834764831845f); *(LAS bf16*)(Kr + t * 272 + dk * 2) = f2bf(kv * __builtin_amdgcn_rcpf(e1)); }
        if (grp == 0) s.GAM[cc * 128 + dk] = __expf(btot);
        __syncthreads();
        store_tile(QT + ((size_t)dir * MR + rowbase) * 512 + head * 128, 512, Qr, 272, 64, 128, tid);
        store_tile(KT + ((size_t)dir * MR + rowbase) * 512 + head * 128, 512, Kr, 272, 64, 128, tid);
        f32x16 acc[4];
#pragma unroll
        for (int nt = 0; nt < 4; ++nt) acc[nt] = zero16();
#pragma unroll
        for (int ks = 0; ks < 4; ++ks) { const bf16x8 af = frag_tr(Vs, 528, 16 * ks, 32 * wave, lane);
#pragma unroll
            for (int nt = 0; nt < 4; ++nt) { const bf16x8 bfr = frag_tr(Kh, 272, 16 * ks, 32 * nt, lane); acc[nt] = MFMA32(af, bfr, acc[nt]); } }
        bf16* D = s.DSTp + cc * 32768;
#pragma unroll
        for (int nt = 0; nt < 4; ++nt)
#pragma unroll
            for (int r = 0; r < 16; ++r) { const int dv = 32 * wave + (r & 3) + 8 * (r >> 2) + 4 * (lane >> 5); D[dv * 128 + 32 * nt + (lane & 31)] = f2bf(acc[nt][r]); }
        __syncthreads();
    }
}
#undef GL_PREF
__device__ __forceinline__ void ph_gla_out(const ScanP& s, const bf16* QT, const bf16* KT, LAS unsigned char* lds, int tid, int lane, int wave, int bid, int G) {
    LAS unsigned char* Vs = lds;
    LAS unsigned char* Qx = lds + 33792;
    LAS unsigned char* Ki = lds + 68608;
    LAS unsigned char* Am = lds + 103424;
    LAS float* Os = (LAS float*)lds;
    v4u pv[4], pq[2][2], pk[2][2];
#define GO_PREF(u_) do { int b_, head_, mm_, rb_; scan_unit((u_), b_, head_, mm_, rb_); \
        _Pragma("unroll") for (int i = 0; i < 4; ++i) { const int c_ = tid + NTHR * i; pv[i] = *(const v4u*)(s.P + (size_t)(rb_ + (c_ >> 5)) * NINP + 1024 + head_ * 256 + (c_ & 31) * 8); } \
        _Pragma("unroll") for (int d_ = 0; d_ < 2; ++d_) _Pragma("unroll") for (int i = 0; i < 2; ++i) { const int c_ = tid + NTHR * i; const size_t o_ = ((size_t)d_ * MR + rb_ + (c_ >> 4)) * 512 + head_ * 128 + (c_ & 15) * 8; \
            pq[d_][i] = *(const v4u*)(QT + o_); pk[d_][i] = *(const v4u*)(KT + o_); } } while (0)
    if (bid < 544) GO_PREF(bid);
    for (int u = bid; u < 544; u += G) {
        int b, head, mm, rowbase; scan_unit(u, b, head, mm, rowbase);
#pragma unroll
        for (int i = 0; i < 4; ++i) { const int c_ = tid + NTHR * i; *(LAS v4u*)(Vs + (c_ >> 5) * 528 + (c_ & 31) * 16) = pv[i]; }
#pragma unroll
        for (int d_ = 0; d_ < 2; ++d_)
#pragma unroll
            for (int i = 0; i < 2; ++i) { const int c_ = tid + NTHR * i; *(LAS v4u*)(Qx + d_ * 17408 + (c_ >> 4) * 272 + (c_ & 15) * 16) = pq[d_][i]; *(LAS v4u*)(Ki + d_ * 17408 + (c_ >> 4) * 272 + (c_ & 15) * 16) = pk[d_][i]; }
        v4u gp[4];
#pragma unroll
        for (int j = 0; j < 4; ++j) gp[j] = *(const v4u*)(s.P + (size_t)(rowbase + (tid >> 3)) * NINP + 2048 + head * 256 + 32 * (tid & 7) + 8 * j);
        bf16x8 sf[2][8];
#pragma unroll
        for (int dir = 0; dir < 2; ++dir) { const int chain = (b * 4 + head) * 2 + dir, c = scan_chunk(mm, dir); const size_t cc = (size_t)chain * NCHUNK + c;
            const bf16* Sg = s.SSTp + cc * 32768 + (size_t)(32 * wave + (lane & 31)) * 128 + 8 * (lane >> 5);
#pragma unroll
            for (int ks = 0; ks < 8; ++ks) sf[dir][ks] = *(const bf16x8*)(Sg + 16 * ks); }
        __syncthreads();
        if (u + G < 544) GO_PREF(u + G);
        {
            const int dir = wave >> 2, ti = (wave >> 1) & 1, tj = wave & 1; f32x16 acc = zero16();
#pragma unroll
            for (int ks = 0; ks < 8; ++ks) { const bf16x8 af = frag_row(Qx + dir * 17408, 272, 32 * ti, 16 * ks, lane), bfr = frag_row(Ki + dir * 17408, 272, 32 * tj, 16 * ks, lane); acc = MFMA32(af, bfr, acc); }
            const int sidx = 32 * tj + (lane & 31);
#pragma unroll
            for (int r = 0; r < 16; ++r) { const int t = 32 * ti + (r & 3) + 8 * (r >> 2) + 4 * (lane >> 5);
                const bool keep = dir == 0 ? (sidx <= t) : (sidx >= t);
                *(LAS bf16*)(Am + dir * 9216 + t * 144 + sidx * 2) = f2bf(keep ? acc[r] : 0.f); }
        }
        __syncthreads();
        f32x16 acc2[2]; acc2[0] = zero16(); acc2[1] = zero16();
#pragma unroll
        for (int dir = 0; dir < 2; ++dir) {
#pragma unroll
            for (int ks = 0; ks < 8; ++ks)
#pragma unroll
                for (int rt = 0; rt < 2; ++rt) { const bf16x8 af = frag_row(Qx + dir * 17408, 272, 32 * rt, 16 * ks, lane); acc2[rt] = MFMA32(af, sf[dir][ks], acc2[rt]); }
#pragma unroll
            for (int ks = 0; ks < 4; ++ks) { const bf16x8 bfr = frag_tr(Vs, 528, 16 * ks, 32 * wave, lane);
#pragma unroll
                for (int rt = 0; rt < 2; ++rt) { const bf16x8 af = frag_row(Am + dir * 9216, 144, 32 * rt, 16 * ks, lane); acc2[rt] = MFMA32(af, bfr, acc2[rt]); } }
        }
        __syncthreads();
#pragma unroll
        for (int rt = 0; rt < 2; ++rt)
#pragma unroll
            for (int r = 0; r < 16; ++r) { const int t = 32 * rt + (r & 3) + 8 * (r >> 2) + 4 * (lane >> 5); Os[t * 260 + 32 * wave + (lane & 31)] = acc2[rt][r]; }
        __syncthreads();
        { const int t = tid >> 3, part = tid & 7; float o[32]; float ss = 0.f;
#pragma unroll
          for (int j = 0; j < 8; ++j) { const f32x4 v = *(LAS const f32x4*)(Os + t * 260 + 32 * part + 4 * j); o[4 * j] = v.x; o[4 * j + 1] = v.y; o[4 * j + 2] = v.z; o[4 * j + 3] = v.w; ss += (v.x * v.x + v.y * v.y) + (v.z * v.z + v.w * v.w); }
          ss += __shfl_xor(ss, 1); ss += __shfl_xor(ss, 2); ss += __shfl_xor(ss, 4);
          const float rn = rsqrtf(ss * (1.f / 256.f) + EPS);
          const size_t row = (size_t)(rowbase + t);
          bf16* dst = s.MIX + row * DM + head * 256 + 32 * part;
#pragma unroll
          for (int j = 0; j < 4; ++j) { float gv[8], ov[8]; unpack8(gp[j], gv);
#pragma unroll
              for (int e = 0; e < 8; ++e) ov[e] = o[8 * j + e] * rn * s.ng[32 * part + 8 * j + e] * silu_f(gv[e]);
              *(v4u*)(dst + 8 * j) = pack8(ov); } }
        __syncthreads();
    }
}

#undef GO_PREF
__device__ __forceinline__ void ph_mlstm_out(const ScanP& s, LAS unsigned char* lds, int tid, int lane, int wave, int bid, int G) {
    LAS unsigned char* Vs = lds; LAS unsigned char* Qi = lds + 33792; LAS unsigned char* Ki = lds + 51200; LAS unsigned char* Qx = lds + 68608; LAS unsigned char* Am = lds + 103424;
    LAS float* sc = (LAS float*)(lds + 121856);
    LAS float* qnp = (LAS float*)(lds + 125952);
    LAS float* Os = (LAS float*)lds;
    v4u pv[4], pq[2], pk[2];
#define MO_PREF(u_) do { int b_, head_, mm_, rb_; scan_unit((u_), b_, head_, mm_, rb_); \
        _Pragma("unroll") for (int i = 0; i < 4; ++i) { const int c_ = tid + NTHR * i; pv[i] = *(const v4u*)(s.P + (size_t)(rb_ + (c_ >> 5)) * NINP + 4096 + head_ * 256 + (c_ & 31) * 8); } \
        _Pragma("unroll") for (int i = 0; i < 2; ++i) { const int c_ = tid + NTHR * i; const size_t o_ = (size_t)(rb_ + (c_ >> 4)) * 1024 + head_ * 128 + (c_ & 15) * 8; pq[i] = *(const v4u*)(s.MQK + o_); pk[i] = *(const v4u*)(s.MQK + o_ + 512); } } while (0)
    if (bid < 544) MO_PREF(bid);
    for (int u = bid; u < 544; u += G) {
        int b, head, mm, rowbase; scan_unit(u, b, head, mm, rowbase);
#pragma unroll
        for (int i = 0; i < 4; ++i) { const int c_ = tid + NTHR * i; *(LAS v4u*)(Vs + (c_ >> 5) * 528 + (c_ & 31) * 16) = pv[i]; }
#pragma unroll
        for (int i = 0; i < 2; ++i) { const int c_ = tid + NTHR * i; *(LAS v4u*)(Qi + (c_ >> 4) * 272 + (c_ & 15) * 16) = pq[i]; *(LAS v4u*)(Ki + (c_ >> 4) * 272 + (c_ & 15) * 16) = pk[i]; }
        size_t ccd[2];
#pragma unroll
        for (int dir = 0; dir < 2; ++dir) ccd[dir] = (size_t)((b * 4 + head) * 2 + dir) * NCHUNK + scan_chunk(mm, dir);
        v4u gp[4];
#pragma unroll
        for (int j = 0; j < 4; ++j) gp[j] = *(const v4u*)(s.P + (size_t)(rowbase + (tid >> 3)) * NINP + 5120 + head * 256 + 32 * (tid & 7) + 8 * j);
        bf16x8 sf[2][8];
#pragma unroll
        for (int dir = 0; dir < 2; ++dir) { const bf16* Sg = s.SSTp + ccd[dir] * 32768 + (size_t)(32 * wave + (lane & 31)) * 128 + 8 * (lane >> 5);
#pragma unroll
            for (int ks = 0; ks < 8; ++ks) sf[dir][ks] = *(const bf16x8*)(Sg + 16 * ks); }
        if (wave < 2) { const int dir = wave; LAS float* d = sc + dir * 512;
            const float ig = bf1(s.P[(size_t)(rowbase + lane) * NINP + 6144 + dir * 8 + head]) + s.mgb[dir * 8 + head];
            const float fg = bf1(s.P[(size_t)(rowbase + lane) * NINP + 6144 + dir * 8 + 4 + head]) + s.mgb[dir * 8 + 4 + head];
            const float lf = logsig_f(fg), bcs = wave_scan_sum(lf, dir, lane);
            const float uu = ig - bcs, pm = wave_scan_max(uu, dir, lane), min_ = s.MINp[ccd[dir]], Mt = fmaxf(min_, pm);
            d[lane] = uu; d[64 + lane] = Mt; d[128 + lane] = __expf(min_ - Mt); d[192 + lane] = __expf(-bcs - Mt); }
        __syncthreads();
        if (u + G < 544) MO_PREF(u + G);
        { const int t = tid & 63, part = tid >> 6;
          float a0 = 0.f, a1 = 0.f; const float w0 = sc[128 + t], w1 = sc[512 + 128 + t];
#pragma unroll
          for (int hh = 0; hh < 2; ++hh) { float qv[8], o0[8], o1[8]; unpack8(*(LAS const v4u*)(Qi + t * 272 + (part * 16 + 8 * hh) * 2), qv);
              const float* n0p = s.NIN + ccd[0] * 128 + part * 16 + 8 * hh; const float* n1p = s.NIN + ccd[1] * 128 + part * 16 + 8 * hh;
              const f32x4 n00 = *(const f32x4*)n0p, n01 = *(const f32x4*)(n0p + 4), n10 = *(const f32x4*)n1p, n11 = *(const f32x4*)(n1p + 4);
              a0 += (qv[0] * n00.x + qv[1] * n00.y) + (qv[2] * n00.z + qv[3] * n00.w) + (qv[4] * n01.x + qv[5] * n01.y) + (qv[6] * n01.z + qv[7] * n01.w);
              a1 += (qv[0] * n10.x + qv[1] * n10.y) + (qv[2] * n10.z + qv[3] * n10.w) + (qv[4] * n11.x + qv[5] * n11.y) + (qv[6] * n11.z + qv[7] * n11.w);
#pragma unroll
              for (int e = 0; e < 8; ++e) { o0[e] = qv[e] * w0; o1[e] = qv[e] * w1; }
              *(LAS v4u*)(Qx + t * 272 + (part * 16 + 8 * hh) * 2) = pack8(o0); *(LAS v4u*)(Qx + 17408 + t * 272 + (part * 16 + 8 * hh) * 2) = pack8(o1); }
          qnp[part * 64 + t] = a0; qnp[512 + part * 64 + t] = a1; }
        {
            const int dir = wave >> 2, ti = (wave >> 1) & 1, tj = wave & 1; LAS const float* d = sc + dir * 512; f32x16 acc = zero16();
#pragma unroll
            for (int ks = 0; ks < 8; ++ks) { const bf16x8 af = frag_row(Qi, 272, 32 * ti, 16 * ks, lane), bfr = frag_row(Ki, 272, 32 * tj, 16 * ks, lane); acc = MFMA32(af, bfr, acc); }
            const int sidx = 32 * tj + (lane & 31); const float usv = d[sidx];
#pragma unroll
            for (int r = 0; r < 16; ++r) { const int t = 32 * ti + (r & 3) + 8 * (r >> 2) + 4 * (lane >> 5);
                const bool keep = dir == 0 ? (sidx <= t) : (sidx >= t);
                const float v = keep ? acc[r] * __expf(usv - d[64 + t]) : 0.f;
                *(LAS bf16*)(Am + dir * 9216 + t * 144 + sidx * 2) = f2bf(v);
                float rsum = v; rsum += __shfl_xor(rsum, 1); rsum += __shfl_xor(rsum, 2); rsum += __shfl_xor(rsum, 4); rsum += __shfl_xor(rsum, 8); rsum += __shfl_xor(rsum, 16);
                if ((lane & 31) == 0) (sc + dir * 512)[384 + tj * 64 + t] = rsum; }
        }
        __syncthreads();
        if (tid < 128) { const int dir = tid >> 6, t = tid & 63; LAS float* d = sc + dir * 512; float q = 0.f;
#pragma unroll
            for (int p = 0; p < 8; ++p) q += qnp[dir * 512 + p * 64 + t];
            const float den = d[128 + t] * q + d[384 + t] + d[448 + t]; d[256 + t] = 1.f / fmaxf(fabsf(den), d[192 + t]); }
        f32x16 ad[2][2];
#pragma unroll
        for (int dir = 0; dir < 2; ++dir) { ad[dir][0] = zero16(); ad[dir][1] = zero16();
#pragma unroll
            for (int ks = 0; ks < 8; ++ks)
#pragma unroll
                for (int rt = 0; rt < 2; ++rt) { const bf16x8 af = frag_row(Qx + dir * 17408, 272, 32 * rt, 16 * ks, lane); ad[dir][rt] = MFMA32(af, sf[dir][ks], ad[dir][rt]); }
#pragma unroll
            for (int ks = 0; ks < 4; ++ks) { const bf16x8 bfr = frag_tr(Vs, 528, 16 * ks, 32 * wave, lane);
#pragma unroll
                for (int rt = 0; rt < 2; ++rt) { const bf16x8 af = frag_row(Am + dir * 9216, 144, 32 * rt, 16 * ks, lane); ad[dir][rt] = MFMA32(af, bfr, ad[dir][rt]); } } }
        __syncthreads();
#pragma unroll
        for (int rt = 0; rt < 2; ++rt)
#pragma unroll
            for (int r = 0; r < 16; ++r) { const int t = 32 * rt + (r & 3) + 8 * (r >> 2) + 4 * (lane >> 5); ad[0][rt][r] = ad[0][rt][r] * sc[256 + t] + ad[1][rt][r] * sc[512 + 256 + t]; }
        __syncthreads();
#pragma unroll
        for (int rt = 0; rt < 2; ++rt)
#pragma unroll
            for (int r = 0; r < 16; ++r) { const int t = 32 * rt + (r & 3) + 8 * (r >> 2) + 4 * (lane >> 5); Os[t * 260 + 32 * wave + (lane & 31)] = ad[0][rt][r]; }
        __syncthreads();
        { const int t = tid >> 3, part = tid & 7; float o[32]; float ss = 0.f;
#pragma unroll
          for (int j = 0; j < 8; ++j) { const f32x4 v = *(LAS const f32x4*)(Os + t * 260 + 32 * part + 4 * j); o[4 * j] = v.x; o[4 * j + 1] = v.y; o[4 * j + 2] = v.z; o[4 * j + 3] = v.w; ss += (v.x * v.x + v.y * v.y) + (v.z * v.z + v.w * v.w); }
          ss += __shfl_xor(ss, 1); ss += __shfl_xor(ss, 2); ss += __shfl_xor(ss, 4);
          const float rn = rsqrtf(ss * (1.f / 256.f) + EPS);
          const size_t row = (size_t)(rowbase + t);
          bf16* dst = s.MIX + row * DM + 1024 + head * 256 + 32 * part;
#pragma unroll
          for (int j = 0; j < 4; ++j) { float gv[8], ov[8]; unpack8(gp[j], gv);
#pragma unroll
              for (int e = 0; e < 8; ++e) ov[e] = o[8 * j + e] * rn * s.ng[32 * part + 8 * j + e] * sigmoid_f(gv[e]);
              *(v4u*)(dst + 8 * j) = pack8(ov); } }
        __syncthreads();
    }
}

#undef MO_PREF
template <int MODE>
__device__ __forceinline__ void ph_scan_carry(const ScanP& s, int gtid, int NT) {
    for (int e = gtid; e < 16 * 8192; e += NT) {
        const int chain = e >> 13, rem = e & 8191, dv = rem >> 5, dk = (rem & 31) * 4;
        f32x4 st = {0.f, 0.f, 0.f, 0.f}, nst = st; float m = 0.f;
        for (int c0 = 0; c0 < NCHUNK; c0 += 4) {
            f32x4 d[4], gm[4]; float bl[4], ml[4];
#pragma unroll
            for (int j = 0; j < 4; ++j) { const size_t cc = (size_t)chain * NCHUNK + c0 + j; { const v2u dw = *(const v2u*)(s.DSTp + cc * 32768 + dv * 128 + dk); d[j] = (f32x4){bf_lo(dw.x), bf_hi(dw.x), bf_lo(dw.y), bf_hi(dw.y)}; }
                if (MODE == 0) gm[j] = *(const f32x4*)(s.GAM + cc * 128 + dk);
                else { bl[j] = s.BL[cc]; ml[j] = s.ML[cc]; gm[j] = (dv == 0) ? *(const f32x4*)(s.DN + cc * 128 + dk) : (f32x4){0.f, 0.f, 0.f, 0.f}; } }
#pragma unroll
            for (int j = 0; j < 4; ++j) { const size_t cc = (size_t)chain * NCHUNK + c0 + j;
                v2u o; o.x = pk2(st.x, st.y); o.y = pk2(st.z, st.w); *(v2u*)(s.SSTp + cc * 32768 + dv * 128 + dk) = o;
                if (MODE == 0) st = gm[j] * st + d[j];
                else { if (dv == 0) { *(f32x4*)(s.NIN + cc * 128 + dk) = nst; if (dk == 0) s.MINp[cc] = m; }
                    const float mn = fmaxf(bl[j] + m, ml[j]), dec = __expf(bl[j] + m - mn), sc = __expf(ml[j] - mn);
                    st = st * dec + d[j] * sc; nst = nst * dec + gm[j] * sc; m = mn; } }
        }
    }
}

template <int MODE>
__device__ __forceinline__ void ph_scan_out(const ScanP& s, LAS unsigned char* lds, int tid, int lane, int wave, int bid, int G) {
    LAS unsigned char* Vs = lds; LAS unsigned char* Qx = lds + 33792; LAS unsigned char* Ki = lds + 51200; LAS unsigned char* Qi = lds + 68608; LAS unsigned char* Am = lds + 86016;
    LAS float* glr = (LAS float*)(lds + 95232); LAS float* tot = (LAS float*)(lds + 103424);
    LAS float* us = (LAS float*)(lds + 105472); LAS float* Mts = us + 64; LAS float* wint = us + 128; LAS float* thr = us + 192; LAS float* fac = us + 256; LAS float* qn = us + 320; LAS float* rs = us + 384;
    LAS float* qnp = (LAS float*)(lds + 107520);
    LAS float* Os = (LAS float*)lds;
    const int dk = tid & 127, grp = tid >> 7;
    for (int u = bid; u < 544; u += G) {
        int b, head, mm, rowbase; scan_unit(u, b, head, mm, rowbase);
        load_tile(Vs, 528, s.P + (size_t)rowbase * NINP + (MODE ? 4096 : 1024) + head * 256, NINP, 64, 256, tid);
        if (MODE == 0) { for (int e = tid; e < 2048; e += NTHR) glr[e] = bf1(s.P[(size_t)(rowbase + (e >> 5)) * NINP + 3072 + (e & 31)]); if (tid < 64) fac[tid] = 1.f; }
        else { load_tile(Qi, 272, s.MQK + (size_t)rowbase * 1024 + head * 128, 1024, 64, 128, tid); load_tile(Ki, 272, s.MQK + (size_t)rowbase * 1024 + 512 + head * 128, 1024, 64, 128, tid); }
        f32x16 hsum[2]; hsum[0] = zero16(); hsum[1] = zero16();
        __syncthreads();
        for (int dir = 0; dir < 2; ++dir) {
            const int chain = (b * 4 + head) * 2 + dir, c = scan_chunk(mm, dir); const size_t cc = (size_t)chain * NCHUNK + c;
            if (MODE == 0) {
                float bb[16], btot; gla_gates(s, glr, tot, head, dir, tid, bb, btot);
#pragma unroll
                for (int tt = 0; tt < 16; ++tt) { const int t = 16 * grp + tt; const size_t ro = (size_t)(rowbase + t) * NINP + head * 128 + dk;
                    const float qv = bf1(s.P[ro]), kv = bf1(s.P[ro + 512]);
                    *(LAS bf16*)(Qx + t * 272 + dk * 2) = f2bf(qv * __expf(bb[tt]) * 0.08838834764831845f);
                    *(LAS bf16*)(Ki + t * 272 + dk * 2) = f2bf(kv * __expf(-bb[tt])); }
            } else {
                if (wave == 0) {
                    const float ig = bf1(s.P[(size_t)(rowbase + lane) * NINP + 6144 + dir * 8 + head]) + s.mgb[dir * 8 + head];
                    const float fg = bf1(s.P[(size_t)(rowbase + lane) * NINP + 6144 + dir * 8 + 4 + head]) + s.mgb[dir * 8 + 4 + head];
                    const float lf = logsig_f(fg), bcs = wave_scan_sum(lf, dir, lane);
                    const float uu = ig - bcs, pm = wave_scan_max(uu, dir, lane), min_ = s.MINp[cc], Mt = fmaxf(min_, pm);
                    us[lane] = uu; Mts[lane] = Mt; wint[lane] = __expf(min_ - Mt); thr[lane] = __expf(-bcs - Mt);
                }
                __syncthreads();
                { const int t = tid & 63, part = tid >> 6; float acc = 0.f;
                  const float wi = wint[t];
#pragma unroll
                  for (int hh = 0; hh < 2; ++hh) { float qv[8], ov[8]; unpack8(*(LAS const v4u*)(Qi + t * 272 + (part * 16 + 8 * hh) * 2), qv);
                      const f32x4 n0 = *(const f32x4*)(s.NIN + cc * 128 + part * 16 + 8 * hh), n1 = *(const f32x4*)(s.NIN + cc * 128 + part * 16 + 8 * hh + 4);
                      acc += (qv[0] * n0.x + qv[1] * n0.y) + (qv[2] * n0.z + qv[3] * n0.w) + (qv[4] * n1.x + qv[5] * n1.y) + (qv[6] * n1.z + qv[7] * n1.w);
#pragma unroll
                      for (int e = 0; e < 8; ++e) ov[e] = qv[e] * wi;
                      *(LAS v4u*)(Qx + t * 272 + (part * 16 + 8 * hh) * 2) = pack8(ov); }
                  qnp[part * 64 + t] = acc; }
            }
            __syncthreads();
            if (MODE == 1 && tid < 64) { float q = 0.f;
#pragma unroll
                for (int p = 0; p < 8; ++p) q += qnp[p * 64 + tid];
                qn[tid] = q; }
            if (wave < 4) {
                const int ti = wave >> 1, tj = wave & 1; f32x16 acc = zero16();
#pragma unroll
                for (int ks = 0; ks < 8; ++ks) { const bf16x8 af = frag_row(MODE ? Qi : Qx, 272, 32 * ti, 16 * ks, lane), bfr = frag_row(Ki, 272, 32 * tj, 16 * ks, lane); acc = MFMA32(af, bfr, acc); }
                const int sidx = 32 * tj + (lane & 31);
                const float usv = MODE ? us[sidx] : 0.f;
#pragma unroll
                for (int r = 0; r < 16; ++r) { const int t = 32 * ti + (r & 3) + 8 * (r >> 2) + 4 * (lane >> 5);
                    const bool keep = dir == 0 ? (sidx <= t) : (sidx >= t);
                    float v = acc[r];
                    if (MODE == 1) v *= __expf(usv - Mts[t]);
                    v = keep ? v : 0.f;
                    *(LAS bf16*)(Am + t * 144 + sidx * 2) = f2bf(v);
                    if (MODE == 1) { float rsum = v; rsum += __shfl_xor(rsum, 1); rsum += __shfl_xor(rsum, 2); rsum += __shfl_xor(rsum, 4); rsum += __shfl_xor(rsum, 8); rsum += __shfl_xor(rsum, 16);
                        if ((lane & 31) == 0) rs[tj * 64 + t] = rsum; } }
            }
            __syncthreads();
            if (MODE == 1 && tid < 64) { const float den = wint[tid] * qn[tid] + rs[tid] + rs[64 + tid]; fac[tid] = 1.f / fmaxf(fabsf(den), thr[tid]); }
            f32x16 acc2[2]; acc2[0] = zero16(); acc2[1] = zero16();
            { const bf16* Sg = s.SSTp + cc * 32768 + (size_t)(32 * wave + (lane & 31)) * 128 + 8 * (lane >> 5);
#pragma unroll
              for (int ks = 0; ks < 8; ++ks) { const bf16x8 bfr = *(const bf16x8*)(Sg + 16 * ks);
#pragma unroll
                  for (int rt = 0; rt < 2; ++rt) { const bf16x8 af = frag_row(Qx, 272, 32 * rt, 16 * ks, lane); acc2[rt] = MFMA32(af, bfr, acc2[rt]); } } }
#pragma unroll
            for (int ks = 0; ks < 4; ++ks) { const bf16x8 bfr = frag_tr(Vs, 528, 16 * ks, 32 * wave, lane);
#pragma unroll
                for (int rt = 0; rt < 2; ++rt) { const bf16x8 af = frag_row(Am, 144, 32 * rt, 16 * ks, lane); acc2[rt] = MFMA32(af, bfr, acc2[rt]); } }
            __syncthreads();
#pragma unroll
            for (int rt = 0; rt < 2; ++rt)
#pragma unroll
                for (int r = 0; r < 16; ++r) { const int t = 32 * rt + (r & 3) + 8 * (r >> 2) + 4 * (lane >> 5); hsum[rt][r] += acc2[rt][r] * fac[t]; }
        }
        __syncthreads();
#pragma unroll
        for (int rt = 0; rt < 2; ++rt)
#pragma unroll
            for (int r = 0; r < 16; ++r) { const int t = 32 * rt + (r & 3) + 8 * (r >> 2) + 4 * (lane >> 5); Os[t * 260 + 32 * wave + (lane & 31)] = hsum[rt][r]; }
        __syncthreads();
        { const int t = tid >> 3, part = tid & 7; float o[32]; float ss = 0.f;
#pragma unroll
          for (int j = 0; j < 8; ++j) { const f32x4 v = *(LAS const f32x4*)(Os + t * 260 + 32 * part + 4 * j); o[4 * j] = v.x; o[4 * j + 1] = v.y; o[4 * j + 2] = v.z; o[4 * j + 3] = v.w; ss += (v.x * v.x + v.y * v.y) + (v.z * v.z + v.w * v.w); }
          ss += __shfl_xor(ss, 1); ss += __shfl_xor(ss, 2); ss += __shfl_xor(ss, 4);
          const float rn = rsqrtf(ss * (1.f / 256.f) + EPS);
          const size_t row = (size_t)(rowbase + t);
          const bf16* gsrc = s.P + row * NINP + (MODE ? 5120 : 2048) + head * 256 + 32 * part;
          bf16* dst = s.MIX + row * DM + (MODE ? 1024 : 0) + head * 256 + 32 * part;
#pragma unroll
          for (int j = 0; j < 4; ++j) { float gv[8], ov[8]; unpack8(*(const v4u*)(gsrc + 8 * j), gv);
#pragma unroll
              for (int e = 0; e < 8; ++e) { const float gt = MODE ? sigmoid_f(gv[e]) : silu_f(gv[e]); ov[e] = o[8 * j + e] * rn * s.ng[32 * part + 8 * j + e] * gt; }
              *(v4u*)(dst + 8 * j) = pack8(ov); } }
        __syncthreads();
    }
}

__device__ __forceinline__ void glds16(const void* sbase  , unsigned voff  , unsigned lds_dst  ) { unsigned keep;
    asm volatile("s_mov_b32 %0, m0\n\ts_mov_b32 m0, %3\n\ts_nop 0\n\tglobal_load_lds_dwordx4 %1, %2\n\ts_mov_b32 m0, %0" : "=&s"(keep) : "v"(voff), "s"(sbase), "s"(lds_dst) : "memory"); }
struct AttnP { const bf16* QR; const bf16* KR; const bf16* P; bf16* MIX; const float* lamp; const float* subg; const float* qg; const float* kg; float lam_init; unsigned* queue; };
template <bool SUB>
__device__ __forceinline__ void ph_attn(const AttnP& p, LAS unsigned char* lds, int tid, int lane, int wave, int bid, int G) {
    const float l01 = wave_sum(p.lamp[lane] * p.lamp[64 + lane]), l23 = wave_sum(p.lamp[128 + lane] * p.lamp[192 + lane]);
    const float lam = __expf(l01) - __expf(l23) + p.lam_init;
    const float negm2 = -8.f * wave_max(fabsf(p.qg[lane])) * wave_max(fabsf(p.kg[lane])) * 1.4426950408889634f * 1.02f;
    const int r = lane & 31, h = lane >> 5, mp = wave >> 2, wq = wave & 3;
    LAS float* Ex = (LAS float*)lds;
    const unsigned xcc = xb_xcc_id() & 7u;
    volatile LAS int* qslot = (volatile LAS int*)(lds + MISC_OFF + 96);
    for (int qq = 0; qq < 8; ++qq) for (;;) {
        const int hd = (int)((xcc + (unsigned)qq) & 7u);
        if (tid == 0) qslot[0] = (int)__hip_atomic_fetch_add(p.queue + 16 * hd, 1u, __ATOMIC_RELAXED, __HIP_MEMORY_SCOPE_AGENT);
        __syncthreads();
        const int idx = qslot[0];
        __syncthreads();
        if (idx >= 68) break;
        int b, qrow0, nkt;
        if (idx < 64) { b = idx >> 5; qrow0 = b * 4096 + 128 * (idx & 31); nkt = 68; }
        else { const int uu = idx - 64; b = uu >> 1; qrow0 = NLATR + b * 256 + 128 * (uu & 1); nkt = 4; }
        const int qrow = qrow0 + 32 * wq + r;
        bf16x8 Qf[4];
#pragma unroll
        for (int ks = 0; ks < 4; ++ks) Qf[ks] = *(const bf16x8*)(p.QR + (size_t)qrow * 1024 + (hd * 2 + mp) * 64 + 16 * ks + 8 * h);
        f32x16 O[4];
#pragma unroll
        for (int dt = 0; dt < 4; ++dt) O[dt] = zero16();
        float ls = 0.f;
        const int dq = lane >> 4, dp = lane & 15;
        unsigned voffK[4], voffV[4];
#pragma unroll
        for (int j = 0; j < 4; ++j) { const unsigned ch = 16u * (unsigned)(dp ^ ((dq << 2) | j)); voffK[j] = (unsigned)dq * 2048u + ch; voffV[j] = (unsigned)dq * (unsigned)(NINP * 2) + ch; }
        int kaddr[4], vaddr[2][4];
#pragma unroll
        for (int ks = 0; ks < 4; ++ks) kaddr[ks] = swz_off(r, 8 * mp + 2 * ks + h);
        { const int blk = (lane >> 4) & 1, q = (lane & 15) >> 2, pp = lane & 3;
#pragma unroll
          for (int e = 0; e < 2; ++e)
#pragma unroll
              for (int dt = 0; dt < 4; ++dt) vaddr[e][dt] = swz_off(4 * h + q + 8 * e, 4 * dt + 2 * blk + (pp >> 1)) + 8 * (pp & 1); }
        const int nkt2 = nkt >> 1;
        const unsigned ldsb = (unsigned)(size_t)lds;
#define AT_DMA(kt_, buf_) do { const int krow_ = (kt_) < 2 ? NLATR + b * 256 + 128 * (kt_) : b * 4096 + 128 * ((kt_) - 2); \
            _Pragma("unroll") for (int j = 0; j < 4; ++j) { const int g_ = 4 * wave + j, row_ = krow_ + 4 * g_; \
                glds16(p.KR + (size_t)row_ * 1024 + hd * 128, voffK[j], (unsigned)__builtin_amdgcn_readfirstlane((int)(ldsb + (buf_) * 32768 + 1024 * g_))); \
                glds16(p.P + (size_t)row_ * NINP + 2048 + hd * 128, voffV[j], (unsigned)__builtin_amdgcn_readfirstlane((int)(ldsb + 65536 + (buf_) * 32768 + 1024 * g_))); } } while (0)
#define AT_QK(S_, kb_) do { S_ = zero16(); _Pragma("unroll") for (int ks = 0; ks < 4; ++ks) { const bf16x8 a0 = *(LAS const bf16x8*)(Kt + kaddr[ks] + 8192 * (kb_)); S_ = MFMA32(a0, Qf[ks], S_); } } while (0)
        AT_DMA(0, 0);
        asm volatile("s_waitcnt vmcnt(0)" ::: "memory");
        __syncthreads();
        for (int kt = 0; kt < nkt2; ++kt) {
            const bool more = kt + 1 < nkt2;
            if (more) AT_DMA(kt + 1, (kt + 1) & 1);
            LAS const unsigned char* Kt = lds + (kt & 1) * 32768; LAS const unsigned char* Vt = lds + 65536 + (kt & 1) * 32768;
#define AT_VF(dst_, kb_, dt_) do { const s16x4 t0_ = tr4(Vt + vaddr[0][dt_] + 8192 * (kb_)), t1_ = tr4(Vt + vaddr[1][dt_] + 8192 * (kb_)), t2_ = tr4(Vt + vaddr[0][dt_] + 8192 * (kb_) + 4096), t3_ = tr4(Vt + vaddr[1][dt_] + 8192 * (kb_) + 4096); \
                dst_[0] = (bf16x8){t0_[0], t0_[1], t0_[2], t0_[3], t1_[0], t1_[1], t1_[2], t1_[3]}; dst_[1] = (bf16x8){t2_[0], t2_[1], t2_[2], t2_[3], t3_[0], t3_[1], t3_[2], t3_[3]}; } while (0)
            bf16x8 kf[4], P0, P1;
#pragma unroll
            for (int ks = 0; ks < 4; ++ks) kf[ks] = *(LAS const bf16x8*)(Kt + kaddr[ks]);
            { f32x16 S0 = zero16();
#pragma unroll
              for (int ks = 0; ks < 4; ++ks) S0 = MFMA32(kf[ks], Qf[ks], S0);
#pragma unroll
              for (int ks = 0; ks < 4; ++ks) kf[ks] = *(LAS const bf16x8*)(Kt + kaddr[ks] + 8192);
              unsigned pf[8]; float lacc = 0.f;
#pragma unroll
              for (int i = 0; i < 8; ++i) { const float e0 = __builtin_amdgcn_exp2f(SUB ? S0[2 * i] + negm2 : S0[2 * i]), e1 = __builtin_amdgcn_exp2f(SUB ? S0[2 * i + 1] + negm2 : S0[2 * i + 1]); lacc += e0 + e1; pf[i] = pk2(e0, e1); }
              ls += lacc;
              P0 = __builtin_bit_cast(bf16x8, (v4u){pf[0], pf[1], pf[2], pf[3]}); P1 = __builtin_bit_cast(bf16x8, (v4u){pf[4], pf[5], pf[6], pf[7]}); }
            __builtin_amdgcn_sched_barrier(0);
#pragma unroll
            for (int kb = 0; kb < 4; ++kb) {
                bf16x8 v0[2], v1[2], v2[2], v3[2];
                AT_VF(v0, kb, 0); AT_VF(v1, kb, 1); AT_VF(v2, kb, 2); AT_VF(v3, kb, 3);
                f32x16 Sn = zero16();
                if (kb < 3) {
#pragma unroll
                    for (int ks = 0; ks < 4; ++ks) Sn = MFMA32(kf[ks], Qf[ks], Sn);
                    if (kb < 2) {
#pragma unroll
                        for (int ks = 0; ks < 4; ++ks) kf[ks] = *(LAS const bf16x8*)(Kt + kaddr[ks] + 8192 * (kb + 2)); } }
                O[0] = MFMA32(v0[0], P0, O[0]); O[0] = MFMA32(v0[1], P1, O[0]); O[1] = MFMA32(v1[0], P0, O[1]); O[1] = MFMA32(v1[1], P1, O[1]);
                O[2] = MFMA32(v2[0], P0, O[2]); O[2] = MFMA32(v2[1], P1, O[2]); O[3] = MFMA32(v3[0], P0, O[3]); O[3] = MFMA32(v3[1], P1, O[3]);
                if (kb < 3) {
                    unsigned pf[8]; float lacc = 0.f;
#pragma unroll
                    for (int i = 0; i < 8; ++i) { const float e0 = __builtin_amdgcn_exp2f(SUB ? Sn[2 * i] + negm2 : Sn[2 * i]), e1 = __builtin_amdgcn_exp2f(SUB ? Sn[2 * i + 1] + negm2 : Sn[2 * i + 1]); lacc += e0 + e1; pf[i] = pk2(e0, e1); }
                    ls += lacc;
                    P0 = __builtin_bit_cast(bf16x8, (v4u){pf[0], pf[1], pf[2], pf[3]}); P1 = __builtin_bit_cast(bf16x8, (v4u){pf[4], pf[5], pf[6], pf[7]});
                    __builtin_amdgcn_sched_group_barrier(0x100, 20, 0); __builtin_amdgcn_sched_group_barrier(0x008, 6, 0);
#pragma unroll
                    for (int gI = 0; gI < 6; ++gI) { __builtin_amdgcn_sched_group_barrier(0x002, 8, 0); __builtin_amdgcn_sched_group_barrier(0x008, 1, 0); }
                }
                __builtin_amdgcn_sched_barrier(0);
            }
#undef AT_VF
            asm volatile("s_waitcnt vmcnt(0)" ::: "memory");
            __syncthreads();
        }
#undef AT_DMA
#undef AT_QK
        const float l = ls + __shfl_xor(ls, 32);
        if (mp == 1) { const float sc = lam / l;
#pragma unroll
            for (int dt = 0; dt < 4; ++dt)
#pragma unroll
                for (int i = 0; i < 16; ++i) Ex[(32 * wq + r) * 132 + 32 * dt + (i & 3) + 8 * (i >> 2) + 4 * h] = O[dt][i] * sc; }
        __syncthreads();
        if (mp == 0) { const float a0 = 1.f / l; float ss = 0.f;
#pragma unroll
            for (int dt = 0; dt < 4; ++dt)
#pragma unroll
                for (int i = 0; i < 16; ++i) { const float v = O[dt][i] * a0 - Ex[(32 * wq + r) * 132 + 32 * dt + (i & 3) + 8 * (i >> 2) + 4 * h]; O[dt][i] = v; ss += v * v; }
            ss += __shfl_xor(ss, 32);
            const float rn = rsqrtf(ss * (1.f / 128.f) + EPS) * (1.f - p.lam_init);
            int qrow2 = qrow0 + 32 * wq + r; asm volatile("" : "+v"(qrow2));
            bf16* dst = p.MIX + (size_t)qrow2 * DM + hd * 128;
#pragma unroll
            for (int dt = 0; dt < 4; ++dt)
#pragma unroll
                for (int g4 = 0; g4 < 4; ++g4) { const int dv0 = 32 * dt + 8 * g4 + 4 * h; const f32x4 sg = *(const f32x4*)(p.subg + dv0);
                    v2u o; o.x = pk2(O[dt][4 * g4] * rn * sg.x, O[dt][4 * g4 + 1] * rn * sg.y); o.y = pk2(O[dt][4 * g4 + 2] * rn * sg.z, O[dt][4 * g4 + 3] * rn * sg.w);
                    *(v2u*)(dst + dv0) = o; } }
        __syncthreads();
    }
}

#ifndef PHASE_MASK
#define PHASE_MASK 0xFFFFFFu
#endif
#define PM(j) ((PHASE_MASK >> (j)) & 1u)
#ifndef REP_MASK
#define REP_MASK 0u
#endif
#define REPS(j) ((((REP_MASK) >> (j)) & 1u) ? 2 : 1)
#define PH_BEGIN(j, k) if (PM(j) && IN(k)) for (int rep_ = 0; rep_ < REPS(j); ++rep_) { if (rep_) xcd_barrier(bar);
#define PH_END }
#define PHASE_BEGIN int wave = wave0, bid = bid0, G = G0, zz_ = 0; asm volatile("" : "+s"(wave), "+s"(bid), "+s"(G), "+s"(zz_)); const int lane = (int)__builtin_amdgcn_mbcnt_hi(~0u, __builtin_amdgcn_mbcnt_lo(~0u, (unsigned)zz_)), tid = wave * 64 + lane; \
    unsigned char* ws = ws0; asm volatile("" : "+s"(ws)); const __attribute__((address_space(4))) Args* ap_ = (const __attribute__((address_space(4))) Args*)__builtin_amdgcn_kernarg_segment_ptr(); asm volatile("" : "+s"(ap_)); const Args& a = *(const Args*)ap_; (void)a; const int gw = bid * NWAVES + wave, NGW = G * NWAVES, gtid = bid * NTHR + tid, NT = G * NTHR; (void)gw; (void)NGW; (void)gtid; (void)NT; (void)lane;
__device__ __forceinline__ void fill_scanp(ScanP& sp, const Args& a, unsigned char* ws, int li, bool even) {
    sp.P = (const bf16*)(ws + WS_P); sp.MQK = (const bf16*)(ws + WS_MQK); sp.MIX = (bf16*)(ws + WS_MIX);
    sp.gw2 = a.in[10] + (size_t)li * 2 * 16 * 512; sp.gb = a.in[11] + (size_t)li * 2 * 512; sp.mgb = a.in[21] + (size_t)li * 16;
    sp.ng = even ? a.in[12] + (size_t)li * 256 : a.in[22] + (size_t)li * 256;
    sp.DSTp = (bf16*)(ws + WS_DST); sp.SSTp = (bf16*)(ws + WS_SST); sp.GAM = (float*)(ws + WS_SM + SM_GAM); sp.DN = (float*)(ws + WS_SM + SM_DN); sp.NIN = (float*)(ws + WS_SM + SM_NIN);
    sp.BL = (float*)(ws + WS_SM + SM_BL); sp.ML = (float*)(ws + WS_SM + SM_ML); sp.MINp = (float*)(ws + WS_SM + SM_MIN);
}
__global__ void __launch_bounds__(NTHR, 2) fwd_kernel(Args a) {
    extern __shared__ __attribute__((aligned(16))) unsigned char lds_raw[];
    LAS unsigned char* lds = (LAS unsigned char*)lds_raw;
    const int tid0 = threadIdx.x, wave0 = __builtin_amdgcn_readfirstlane(tid0 >> 6), bid0 = blockIdx.x, G0 = gridDim.x;
    unsigned char* ws0 = a.ws;
    volatile LAS unsigned* MISC = (volatile LAS unsigned*)(lds + MISC_OFF);
    if (tid0 < 32) MISC[tid0] = 0u;
    __syncthreads();
    XcdBarrier bar = xcd_barrier_post((unsigned*)(ws0 + WS_CTL) + CW_BAR + a.li * XCD_BAR_WORDS, MISC + 8, (unsigned)wave0);
    const int lo = a.ph_lo, hi = a.ph_hi;
#define IN(k) (lo <= (k) && (k) < hi)
#ifndef TMASK
#define TMASK 0u
#endif
#ifndef LMASK
#define LMASK 0xFu
#endif
    volatile LAS unsigned long long* tst_ = (volatile LAS unsigned long long*)(lds + MISC_OFF + 64);
    if (TMASK && tid0 == 0) { tst_[0] = __builtin_amdgcn_s_memrealtime(); tst_[1] = 0ull; }
#define SEAM2(k, kk, ll) do { if (IN(k) && IN((k) + 1)) xcd_barrier(bar); if (TMASK && wave0 == 0 && xb_lane() == 0u) { const unsigned long long now_ = __builtin_amdgcn_s_memrealtime(); if (((TMASK >> (kk)) & 1u) && ((LMASK >> (ll)) & 1u)) tst_[1] += now_ - tst_[0]; tst_[0] = now_; } } while (0)
#define SEAM(k) SEAM2(k, (k) == 0 ? 11 : ((k) - 1) % PPL, (k) == 0 ? 0 : ((k) - 1) / PPL)

    PH_BEGIN(11, 0) PHASE_BEGIN; ph_prologue(a, ws, lds, tid, lane, wave, bid, G); PH_END
    SEAM(0);
    for (int layer = 0; layer < NLAYERS; ++layer) {
        const int pb = 1 + layer * PPL, li = layer >> 1; const bool even = (layer & 1) == 0;
        const size_t mod_off = WS_MOD + (size_t)layer * 3 * 12288 * 4;
        const size_t wb_off = WS_W + (size_t)layer * W_LAYER;

        PH_BEGIN(0, pb + 0) PHASE_BEGIN; const float* mod = (const float*)(ws + mod_off); float* ssq = (float*)(ws + WS_SSQ) + (size_t)(2 * layer) * MR;
            if (layer == 0) ph_norm0(a.in[0], a.in[2], (float*)(ws + WS_XS), a.in[6], mod + 1 * DM, (bf16*)(ws + WS_H), ssq, gw, NGW, lane);
            else ph_ctxfix<11>((float*)(ws + WS_XS), (const float*)(ws + WS_DST), mod - 3 * 12288 + 2 * 12288 + 5 * DM, a.in[6] + (size_t)layer * DM, mod + 1 * DM, (bf16*)(ws + WS_H), ssq, gw, NGW, lane);
            { PHASE_BEGIN; const float* mod2 = (const float*)(ws + mod_off); ph_bias((const bf16*)(ws + wb_off), (const bf16*)(ws + wb_off + W_UP), mod2, (float*)(ws + WS_B1) + (size_t)layer * 3 * NINP, (float*)(ws + WS_B2) + (size_t)layer * 3 * NUP, gw, NGW, lane); } }
        SEAM(pb + 0);
        PH_BEGIN(1, pb + 1) PHASE_BEGIN; pg8::Gemm g{(const bf16*)(ws + WS_H), (const bf16*)(ws + wb_off), MR, NINP, DM}; pg8::StaticOrder S; S.init(MR, NINP, G, bid); pg8::EpiStore E{(bf16*)(ws + WS_P), NINP, (const float*)(ws + WS_SSQ) + (size_t)(2 * layer) * MR, (const float*)(ws + WS_B1) + (size_t)layer * 3 * NINP, NINP};
            pg8::gemm_phase<pg8::EpiStore, pg8::StaticOrder, true, true>(lds, g, S, E, wave);
            if (layer + 1 < NLAYERS && G == 256 && bid >= 82) { __syncthreads(); ph_convert(a, ws, lds, (layer + 1) * 25344, (layer + 2) * 25344, (bid - 82) * NWAVES + wave, 174 * NWAVES, wave, lane); }
            else if (layer + 1 < NLAYERS && G != 256) { __syncthreads(); ph_convert(a, ws, lds, (layer + 1) * 25344, (layer + 2) * 25344, bid * NWAVES + wave, G * NWAVES, wave, lane); } }
        SEAM(pb + 1);
        PH_BEGIN(2, pb + 2)
            if (even) {
                if (PM(12)) { PHASE_BEGIN; ph_conv8<1>((const bf16*)(ws + WS_P), a.in[13] + (size_t)li * 3 * 1024, (bf16*)(ws + WS_MIX), gtid, NT); }
                if (PM(13)) { PHASE_BEGIN; ScanP sp; fill_scanp(sp, a, ws, li, even); ph_gla_local(sp, (bf16*)(ws + WS_QR), (bf16*)(ws + WS_KR), lds, tid, lane, wave, bid, G); }
            } else {
                if (PM(14)) { PHASE_BEGIN; ph_qkprep((const bf16*)(ws + WS_P), a.in[16] + (size_t)li * 64, a.in[17] + (size_t)li * 64, (const float*)(ws + WS_ROPE), (bf16*)(ws + WS_QR), (bf16*)(ws + WS_KR), gw, NGW, lane); }
                if (PM(15)) { PHASE_BEGIN; ph_conv8<2>((const bf16*)(ws + WS_P), a.in[20] + (size_t)li * 3 * 1024, (bf16*)(ws + WS_MQK), gtid, NT); }
            }
        }
        SEAM(pb + 2);
        PH_BEGIN(3, pb + 3) if (!even) { PHASE_BEGIN; ScanP sp; fill_scanp(sp, a, ws, li, even); ph_mlstm_local(sp, lds, tid, lane, wave, bid, G); } }
        if (!even) SEAM(pb + 3);
        PH_BEGIN(4, pb + 4) PHASE_BEGIN; ScanP sp; fill_scanp(sp, a, ws, li, even); if (even) ph_scan_carry<0>(sp, gtid, NT); else ph_scan_carry<1>(sp, gtid, NT); }
        SEAM(pb + 4);
        PH_BEGIN(5, pb + 5)
            if (even) { if (PM(16)) { PHASE_BEGIN; ScanP sp; fill_scanp(sp, a, ws, li, even); ph_gla_out(sp, (const bf16*)(ws + WS_QR), (const bf16*)(ws + WS_KR), lds, tid, lane, wave, bid, G); } }
            else {
                if (PM(17)) { PHASE_BEGIN; AttnP ap{(const bf16*)(ws + WS_QR), (const bf16*)(ws + WS_KR), (const bf16*)(ws + WS_P), (bf16*)(ws + WS_MIX), a.in[18] + (size_t)li * 256, a.in[19] + (size_t)li * 128, a.in[16] + (size_t)li * 64, a.in[17] + (size_t)li * 64, 0.8f - 0.6f * expf(-0.3f * (float)layer), (unsigned*)(ws + 32768 + 1024 * li)};
                    const float bound = 8.f * wave_max(fabsf(ap.qg[lane])) * wave_max(fabsf(ap.kg[lane])) * 1.4426950408889634f;
                    if (bound < 60.f) ph_attn<false>(ap, lds, tid, lane, wave, bid, G); else ph_attn<true>(ap, lds, tid, lane, wave, bid, G);
                    if (TMASK && wave0 == 0 && xb_lane() == 0u) { const unsigned long long now_ = __builtin_amdgcn_s_memrealtime(); if (((TMASK >> 12) & 1u) && ((LMASK >> layer) & 1u)) tst_[1] += now_ - tst_[0]; tst_[0] = now_; } }
                if (PM(18)) { PHASE_BEGIN; ScanP sp; fill_scanp(sp, a, ws, li, even); ph_mlstm_out(sp, lds, tid, lane, wave, bid, G); }
            }
        }
        SEAM(pb + 5);
        PH_BEGIN(6, pb + 6) PHASE_BEGIN; pg8::Gemm g{(const bf16*)(ws + WS_MIX), (const bf16*)(ws + wb_off + W_OUT), MR, DM, DM}; pg8::ResidOrder S; S.init(G, bid, layer < NLAYERS - 1 ? 8 : 0, 256);
            pg8::EpiResid2 E{(float*)(ws + WS_XS), (const float*)(ws + mod_off) + 2 * DM, nullptr, (float*)(ws + WS_DST), 0, 256, rep_,
                (bf16*)(ws + WS_H), a.in[7] + (size_t)layer * DM, (const float*)(ws + mod_off) + 4 * DM, (float*)(ws + WS_SSQ) + (size_t)(2 * layer + 1) * MR};
            pg8::gemm_phase<pg8::EpiResid2, pg8::ResidOrder, true, true>(lds, g, S, E, wave); }
        SEAM(pb + 6);
        PH_BEGIN(7, pb + 7) PHASE_BEGIN; const float* mod = (const float*)(ws + mod_off);
            if (layer < NLAYERS - 1) ph_ctxfix<8>((float*)(ws + WS_XS), (const float*)(ws + WS_DST), mod + 2 * 12288 + 2 * DM, a.in[7] + (size_t)layer * DM, mod + 4 * DM, (bf16*)(ws + WS_H), (float*)(ws + WS_SSQ) + (size_t)(2 * layer + 1) * MR, gw, NGW, lane); }
        if (layer < NLAYERS - 1) SEAM(pb + 7);
        PH_BEGIN(8, pb + 8) PHASE_BEGIN; pg8::Gemm g{(const bf16*)(ws + WS_H), (const bf16*)(ws + wb_off + W_UP), MR, NUP, DM}; pg8::StaticOrder S; S.init(MR, NUP, G, bid);
            pg8::EpiAct E{(bf16*)(ws + WS_ACT), a.in[24] + (size_t)layer * 3 * DFF, a.in[25] + (size_t)layer * DFF, (float*)(ws + WS_U), (LAS float*)(lds + 131584), (const float*)(ws + WS_SSQ) + (size_t)(2 * layer + 1) * MR, (const float*)(ws + WS_B2) + (size_t)layer * 3 * NUP, 0};
            pg8::gemm_phase<pg8::EpiAct, pg8::StaticOrder, true, true>(lds, g, S, E, wave); }
        SEAM(pb + 8);
        PH_BEGIN(10, pb + 10)
            { PHASE_BEGIN; pg8::ResidOrder S0; S0.init(G, bid, layer < NLAYERS - 1 ? 11 : 0, 512); pg8::Unit uu_;
#pragma unroll 1
              for (int i_ = 0; S0.next(i_, uu_); ++i_) act_fix_tile((const float*)(ws + WS_U), a.in[24] + (size_t)layer * 3 * DFF, (bf16*)(ws + WS_ACT), uu_.pm, tid);
              asm volatile("s_waitcnt vmcnt(0)" ::: "memory"); __syncthreads(); }
            PHASE_BEGIN; pg8::Gemm g{(const bf16*)(ws + WS_ACT), (const bf16*)(ws + wb_off + W_DN), MR, DM, DFF}; pg8::ResidOrder S; S.init(G, bid, layer < NLAYERS - 1 ? 11 : 0, 512);
            pg8::EpiResid2 E{(float*)(ws + WS_XS), (const float*)(ws + mod_off) + 5 * DM, a.out, (float*)(ws + WS_DST), layer == NLAYERS - 1 ? 1 : 0, 512, rep_,
                layer < NLAYERS - 1 ? (bf16*)(ws + WS_H) : nullptr, a.in[6] + (size_t)(layer + 1) * DM, (const float*)(ws + mod_off) + 3 * 12288 + 1 * DM, (float*)(ws + WS_SSQ) + (size_t)(2 * layer + 2) * MR};
            pg8::gemm_phase<pg8::EpiResid2, pg8::ResidOrder, true, true>(lds, g, S, E, wave); }
        if (layer < NLAYERS - 1) SEAM(pb + 10); else if (TMASK && wave0 == 0 && xb_lane() == 0u) { const unsigned long long now_ = __builtin_amdgcn_s_memrealtime(); if (((TMASK >> 10) & 1u) && ((LMASK >> layer) & 1u)) tst_[1] += now_ - tst_[0]; tst_[0] = now_; }
    }
    if (TMASK) { __syncthreads(); const unsigned long long tacc_ = tst_[1], t0_ = __builtin_amdgcn_s_memrealtime(); while (__builtin_amdgcn_s_memrealtime() - t0_ < tacc_) __builtin_amdgcn_s_sleep(8); }
#undef IN
#undef SEAM
}

extern "C" void kernel_launch(void* const* d_in, const int* in_sizes, int n_in, void* d_out, int out_size, void* d_ws, size_t ws_size, hipStream_t stream) {
    static int grid = 0;
    if (grid == 0) {
        int dev = 0, cus = 0;
        if (n_in != 27 || out_size != NLATR * DM || ws_size < WS_END) { fprintf(stderr, "kernel_launch: unexpected problem (n_in %d out %d ws %zu)\n", n_in, out_size, ws_size); grid = -1; return; }
        if (hipGetDevice(&dev) != hipSuccess || hipDeviceGetAttribute(&cus, hipDeviceAttributeMultiprocessorCount, dev) != hipSuccess) { grid = -1; return; }
        if (hipFuncSetAttribute((const void*)fwd_kernel, hipFuncAttributeMaxDynamicSharedMemorySize, LDS_BYTES) != hipSuccess) { fprintf(stderr, "kernel_launch: hipFuncSetAttribute failed\n"); grid = -1; return; }
        int per_cu = 0;
        if (hipOccupancyMaxActiveBlocksPerMultiprocessor(&per_cu, (const void*)fwd_kernel, NTHR, LDS_BYTES) != hipSuccess || per_cu < 1) fprintf(stderr, "kernel_launch: occupancy query reports %d\n", per_cu);
        (void)hipGetLastError();
        grid = cus;
    }
    if (grid < 0) return;
    (void)hipMemsetAsync((char*)d_ws + WS_CTL, 0, CTL_BYTES, stream);
    Args a{};
    for (int i = 0; i < 27; ++i) a.in[i] = (const float*)d_in[i];
    a.out = (float*)d_out; a.ws = (unsigned char*)d_ws; a.pad = 0;
#if ONE_LAUNCH
    a.ph_lo = 0; a.ph_hi = 1 + NLAYERS * PPL; a.li = 0;
    hipLaunchKernelGGL(fwd_kernel, dim3(grid), dim3(NTHR), LDS_BYTES, stream, a);
#else
    for (int p = 0; p < 1 + NLAYERS * PPL; ++p) {
        const int k = p == 0 ? 0 : (p - 1) % PPL, layer = p == 0 ? 0 : (p - 1) / PPL;
        if (p > 0 && k == 3 && (layer & 1) == 0) continue;
        a.ph_lo = p; a.ph_hi = p + 1; a.li = p;
        hipLaunchKernelGGL(fwd_kernel, dim3(grid), dim3(NTHR), LDS_BYTES, stream, a);
    }
#endif
}
```

```cpp
#include <hip/hip_runtime.h>
#include <cstdio>
#include <cstdint>
namespace pg8 {
#define PG8_LAS __attribute__((address_space(3)))
typedef unsigned short bf16_t;
typedef short bf16x8 __attribute__((ext_vector_type(8)));
typedef float f32x4 __attribute__((ext_vector_type(4)));
typedef unsigned u32x4 __attribute__((ext_vector_type(4)));
constexpr int BM = 256, BK = 64, HALF = 128, HTB = HALF * BK * 2  , STAGE_BYTES = 8 * HTB, NXCD = 8, WGM = 8;

__host__ __device__ __forceinline__ int lds_byte(int r, int c) { const int st = (r >> 4) * 2 + (c >> 5), rr = r & 15, cc = c & 31, ob = rr * 64 + cc * 2; return st * 1024 + (ob ^ (((ob >> 9) & 1) << 5)); }
__host__ __device__ __forceinline__ void stage_rc(int b, int& R, int& C) { const int st = b / 1024, sb = b % 1024, swz = sb ^ (((sb >> 9) & 1) << 5); R = (st >> 1) * 16 + swz / 64; C = (st & 1) * 32 + (swz % 64) / 2; }
__host__ __device__ __forceinline__ int perm32(int rho) { const int n = rho >> 4, i = rho & 15; return 8 * (i >> 2) + 4 * n + (i & 3); }

struct Unit { int pm, pn, k0, nt; };
struct Gemm { const bf16_t* A; const bf16_t* Bt; int M, N, K; };

struct StaticOrder {
    int nM, nN, nwg, G, c;
    __host__ __device__ __forceinline__ void init(int M, int N, int G_, int c_) { nM = M / BM; nN = N / BM; nwg = nM * nN; G = G_; c = c_; }
    __host__ __device__ __forceinline__ bool next(int i, Unit& u) const {
        const long L = (long)i * G + c; if (L >= nwg) return false;
        int wgid = (int)L; { const int q = nwg / NXCD, r = nwg % NXCD, xcd = wgid % NXCD, off = wgid / NXCD; wgid = (xcd < r ? xcd * (q + 1) : r * (q + 1) + (xcd - r) * q) + off; }
        const int nig = WGM * nN, gid = wgid / nig, fm = gid * WGM, gsz = (nM - fm) < WGM ? (nM - fm) : WGM;
        u.pm = fm + ((wgid % nig) % gsz); u.pn = (wgid % nig) / gsz; u.k0 = 0; u.nt = 0; return true;
    }
    __device__ __forceinline__ void a_ready(const Unit&) const {}
    __device__ __forceinline__ void done(const Unit&) const {}
};
__device__ __forceinline__ unsigned cvt_pk_bf16(float lo, float hi) { unsigned r; asm volatile("v_cvt_pk_bf16_f32 %0, %1, %2" : "=v"(r) : "v"(lo), "v"(hi)); return r; }

struct EpiStore {
    static constexpr bool PERM = true, AFTER_DRAIN = false;
    bf16_t* O; int ldc; const float* ssq; const float* bias; int ldb;
    __device__ __forceinline__ void operator()(const f32x4 (&acc)[2][2][4][2], const Unit& u, int wr, int wc, int fr, int fq) const {
        const int row0 = u.pm * BM + wr * 64 + fr, col0 = u.pn * BM + wc * 32 + 8 * fq, mi = u.pm < 32 ? (u.pm >> 4) : 2;
        f32x4 bv[2][2];
#pragma unroll
        for (int bj = 0; bj < 2; ++bj)
#pragma unroll
            for (int n = 0; n < 2; ++n) bv[bj][n] = *(const f32x4*)(bias + (size_t)mi * ldb + col0 + bj * HALF + 4 * n);
#pragma unroll
        for (int ai = 0; ai < 2; ++ai)
#pragma unroll
            for (int m = 0; m < 4; ++m) { const int row = row0 + ai * HALF + m * 16; bf16_t* rowp = O + (size_t)row * ldc + col0;
                const float r = __builtin_amdgcn_rsqf(ssq[row] * (1.f / 2048.f) + 1e-6f);
#pragma unroll
                for (int bj = 0; bj < 2; ++bj) { const f32x4 v0 = acc[ai][bj][m][0] * r + bv[bj][0], v1 = acc[ai][bj][m][1] * r + bv[bj][1];
                    u32x4 w; w.x = cvt_pk_bf16(v0[0], v0[1]); w.y = cvt_pk_bf16(v0[2], v0[3]); w.z = cvt_pk_bf16(v1[0], v1[1]); w.w = cvt_pk_bf16(v1[2], v1[3]);
                    *(u32x4*)(rowp + bj * HALF) = w; } }
    }
};
struct ResidOrder {
    StaticOrder L; int G, c, nsub, ksub;
    __device__ __forceinline__ void init(int G_, int c_, int nsplit, int ksub_) { L.init(8192, 2048, G_, c_); G = G_; c = c_; nsub = 16 * nsplit; ksub = ksub_; }
    __device__ __forceinline__ bool next(int i, Unit& u) const {
        const int nl = c < 256 ? (255 - c) / G + 1 : 0;
        if (i < nl) return L.next(i, u);
        const int s = (i - nl) * G + c; if (s >= nsub) return false;
        const int tile = s & 15, j = s >> 4; u.pm = 32 + (tile >> 3); u.pn = tile & 7; u.k0 = j * ksub; u.nt = ksub / BK; return true;
    }
    __device__ __forceinline__ void a_ready(const Unit&) const {}
    __device__ __forceinline__ void done(const Unit&) const {}
};
struct EpiResid2 {
    static constexpr bool PERM = true, AFTER_DRAIN = false;
    float* X; const float* gate; float* out; float* part; int final_; int ksub; int dry;
    bf16_t* Hn; const float* ngn; const float* scn; float* ssqn;
    __device__ __forceinline__ void operator()(const f32x4 (&acc)[2][2][4][2], const Unit& u, int wr, int wc, int fr, int fq) const {
        const int row0 = u.pm * BM + wr * 64 + fr, col0 = u.pn * BM + wc * 32 + 8 * fq;
        if (u.pm >= 32) {
            float* pb = part + ((size_t)(u.k0 / ksub) * 512 + (row0 - 8192)) * 2048 + col0;
#pragma unroll
            for (int ai = 0; ai < 2; ++ai)
#pragma unroll
                for (int m = 0; m < 4; ++m)
#pragma unroll
                    for (int bj = 0; bj < 2; ++bj)
#pragma unroll
                        for (int n = 0; n < 2; ++n) *(f32x4*)(pb + (size_t)(ai * HALF + m * 16) * 2048 + bj * HALF + 4 * n) = acc[ai][bj][m][n];
            return;
        }
        const int mi = u.pm >> 4;
        f32x4 gv[2][2], av[2][2];
#pragma unroll
        for (int bj = 0; bj < 2; ++bj)
#pragma unroll
            for (int n = 0; n < 2; ++n) { const int c = col0 + bj * HALF + 4 * n; gv[bj][n] = *(const f32x4*)(gate + (size_t)mi * 12288 + c);
                av[bj][n] = Hn ? *(const f32x4*)(ngn + c) * (*(const f32x4*)(scn + (size_t)mi * 12288 + c) + 1.f) : (f32x4){0.f, 0.f, 0.f, 0.f}; }
        if (dry && gv[0][0][0] != 1.2345e30f) return;
#pragma unroll
        for (int ai = 0; ai < 2; ++ai)
#pragma unroll
            for (int m = 0; m < 4; ++m) { const int row = row0 + ai * HALF + m * 16; const size_t ro = (size_t)row * 2048 + col0; const float* xr = X + ro; float* orow = (final_ ? out : X) + ro; float ss = 0.f;
#pragma unroll
                for (int bj = 0; bj < 2; ++bj) {
                    const f32x4 x0 = *(const f32x4*)(xr + bj * HALF) + gv[bj][0] * acc[ai][bj][m][0], x1 = *(const f32x4*)(xr + bj * HALF + 4) + gv[bj][1] * acc[ai][bj][m][1];
                    *(f32x4*)(orow + bj * HALF) = x0; *(f32x4*)(orow + bj * HALF + 4) = x1;
                    if (Hn) { ss += (x0[0] * x0[0] + x0[1] * x0[1]) + (x0[2] * x0[2] + x0[3] * x0[3]) + (x1[0] * x1[0] + x1[1] * x1[1]) + (x1[2] * x1[2] + x1[3] * x1[3]);
                        const f32x4 h0 = x0 * av[bj][0], h1 = x1 * av[bj][1];
                        u32x4 w; w.x = cvt_pk_bf16(h0[0], h0[1]); w.y = cvt_pk_bf16(h0[2], h0[3]); w.z = cvt_pk_bf16(h1[0], h1[1]); w.w = cvt_pk_bf16(h1[2], h1[3]);
                        *(u32x4*)(Hn + ro + bj * HALF) = w; } }
                if (Hn) { ss += __shfl_xor(ss, 16); ss += __shfl_xor(ss, 32); if (fq == 0) (void)__hip_atomic_fetch_add(ssqn + row, ss, __ATOMIC_RELAXED, __HIP_MEMORY_SCOPE_AGENT); } }
    }
};
struct EpiAct {
    static constexpr bool PERM = true, AFTER_DRAIN = false;
    bf16_t* ACT; const float* cw; const float* cb; float* halo; PG8_LAS float* exb; const float* ssq; const float* bias; mutable int par;
    __device__ __forceinline__ void operator()(const f32x4 (&acc)[2][2][4][2], const Unit& u, int wr, int wc, int fr, int fq) const {
        const int lane = fq * 16 + fr, ch0 = wc * 32 + 8 * fq, chg = u.pn * 128 + ch0;
        PG8_LAS float* xb = exb + par * 1024; par ^= 1;
        const int mi = u.pm < 32 ? (u.pm >> 4) : 2;
        const float* bp = bias + (size_t)mi * 11264 + u.pn * BM + ch0;
        float rr[2][4];
#pragma unroll
        for (int ai = 0; ai < 2; ++ai)
#pragma unroll
            for (int m = 0; m < 4; ++m) rr[ai][m] = __builtin_amdgcn_rsqf(ssq[u.pm * BM + ai * HALF + wr * 64 + m * 16 + fr] * (1.f / 2048.f) + 1e-6f);
#pragma unroll
        for (int ai = 0; ai < 2; ++ai) { const int q = ai * 2 + wr;
#pragma unroll
            for (int n = 0; n < 2; ++n) { const f32x4 bg4 = *(const f32x4*)(bp + 4 * n);
                if (fr == 0) *(PG8_LAS f32x4*)(xb + q * 128 + ch0 + 4 * n) = acc[ai][0][0][n] * rr[ai][0] + bg4;
                if (fr == 15) *(PG8_LAS f32x4*)(xb + (4 + q) * 128 + ch0 + 4 * n) = acc[ai][0][3][n] * rr[ai][3] + bg4; } }
        asm volatile("s_waitcnt lgkmcnt(0)" ::: "memory"); __builtin_amdgcn_s_barrier(); asm volatile("" ::: "memory");
        float* hb = halo + (size_t)(u.pm * 44 + u.pn) * 768 + ch0;
#pragma unroll
        for (int n = 0; n < 2; ++n) {
            const f32x4 w0 = *(const f32x4*)(cw + chg + 4 * n), w1 = *(const f32x4*)(cw + 5632 + chg + 4 * n), w2 = *(const f32x4*)(cw + 2 * 5632 + chg + 4 * n), bb = *(const f32x4*)(cb + chg + 4 * n);
            const f32x4 bg = *(const f32x4*)(bp + 4 * n), bvv = *(const f32x4*)(bp + 128 + 4 * n);
#pragma unroll
            for (int ai = 0; ai < 2; ++ai) { const int q = ai * 2 + wr;
                const f32x4 pB = q > 0 ? *(PG8_LAS const f32x4*)(xb + (4 + q - 1) * 128 + ch0 + 4 * n) : (f32x4){0.f, 0.f, 0.f, 0.f};
                const f32x4 nB = q < 3 ? *(PG8_LAS const f32x4*)(xb + (q + 1) * 128 + ch0 + 4 * n) : (f32x4){0.f, 0.f, 0.f, 0.f};
#pragma unroll
                for (int m = 0; m < 4; ++m) {
                    const f32x4 x = acc[ai][0][m][n] * rr[ai][m] + bg, vx = acc[ai][1][m][n] * rr[ai][m] + bvv;
                    const f32x4 xm = m > 0 ? acc[ai][0][m > 0 ? m - 1 : 0][n] * rr[ai][m > 0 ? m - 1 : 0] + bg : pB;
                    const f32x4 xq = m < 3 ? acc[ai][0][m < 3 ? m + 1 : 3][n] * rr[ai][m < 3 ? m + 1 : 3] + bg : nB;
                    f32x4 cv, o;
#pragma unroll
                    for (int el = 0; el < 4; ++el) { const float sp = fr == 15 ? xm[el] : x[el], sn = fr == 0 ? xq[el] : x[el];
                        const float pv = __builtin_bit_cast(float, __builtin_amdgcn_update_dpp(0, __builtin_bit_cast(int, sp), 0x121, 0xF, 0xF, false)), nv = __builtin_bit_cast(float, __builtin_amdgcn_update_dpp(0, __builtin_bit_cast(int, sn), 0x12F, 0xF, 0xF, false));
                        cv[el] = w0[el] * pv + w1[el] * x[el] + w2[el] * nv + bb[el];
                        o[el] = cv[el] / (1.f + __expf(-cv[el])) * vx[el]; }
                    const bool top = (q == 0 && m == 0 && fr == 0), bot = (q == 3 && m == 3 && fr == 15);
                    if (top || bot) { const int sl = top ? 0 : 1; *(f32x4*)(hb + sl * 128 + 4 * n) = x; *(f32x4*)(hb + (2 + sl) * 128 + 4 * n) = cv; *(f32x4*)(hb + (4 + sl) * 128 + 4 * n) = vx; }
                    else { typedef unsigned u32x2_ __attribute__((ext_vector_type(2))); u32x2_ w; w.x = cvt_pk_bf16(o[0], o[1]); w.y = cvt_pk_bf16(o[2], o[3]);
                        *(u32x2_*)(ACT + (size_t)(u.pm * BM + q * 64 + m * 16 + fr) * 5632 + chg + 4 * n) = w; }
                }
            }
        }
    }
};
template <class Epi, class Sched, bool ALIGN_EPI = false, bool SP2 = false>
__device__ __forceinline__ void gemm_phase(PG8_LAS unsigned char* lds, const Gemm g, const Sched& S, const Epi& E, int wid_in) {
    int wid = wid_in, zz_ = 0; asm volatile("" : "+s"(wid), "+s"(zz_));
    const int lane = (int)__builtin_amdgcn_mbcnt_hi(~0u, __builtin_amdgcn_mbcnt_lo(~0u, (unsigned)zz_)), tid = wid * 64 + lane, wr = wid >> 2, wc = wid & 3, fr = lane & 15, fq = lane >> 4;
    const int K = g.K, nt = K / BK;
    unsigned voffA[2], voffB[2];
#pragma unroll
    for (int i = 0; i < 2; ++i) { int R, C; stage_rc(tid * 16 + i * 8192, R, C); const int Rb = Epi::PERM ? ((R & ~31) + perm32(R & 31)) : R;
        voffA[i] = (unsigned)(R * K + C) * 2u; voffB[i] = (unsigned)(Rb * K + C) * 2u; }
    const size_t kstep = (size_t)(BK * 2);
    const size_t hstep = (size_t)HALF * K * 2;
    const size_t tstep = 2 * hstep;
    const unsigned ldsw = (unsigned)wid * 1024u;
    const int aoff = lds_byte(wr * 64 + fr, fq * 8), boff = lds_byte(wc * 32 + fr, fq * 8);
#define PG8_SA(b, h) (((b) * 2 + (h)) * HTB)
#define PG8_SB(b, h) ((4 + (b) * 2 + (h)) * HTB)
#define PG8_STAGE(bufoff, gbase, voff) do { _Pragma("unroll") for (int _i = 0; _i < 2; ++_i) \
        __builtin_amdgcn_global_load_lds((const unsigned*)((const char*)(gbase) + (voff)[_i]), (PG8_LAS unsigned*)(lds + (bufoff) + ldsw + _i * 8192), 16, 0, 0); } while (0)
#define PG8_LDA(dst, b, h) do { _Pragma("unroll") for (int m = 0; m < 4; ++m) _Pragma("unroll") for (int k = 0; k < 2; ++k) dst[m][k] = *(const PG8_LAS bf16x8*)(lds + PG8_SA(b, h) + aoff + m * 2048 + k * 1024); } while (0)
#define PG8_LDB(dst, b, h) do { _Pragma("unroll") for (int n = 0; n < 2; ++n) _Pragma("unroll") for (int k = 0; k < 2; ++k) dst[n][k] = *(const PG8_LAS bf16x8*)(lds + PG8_SB(b, h) + boff + n * 2048 + k * 1024); } while (0)
#define PG8_MMA(ai, bj, At, Bt) do { __builtin_amdgcn_s_setprio(1); _Pragma("unroll") for (int m = 0; m < 4; ++m) _Pragma("unroll") for (int n = 0; n < 2; ++n) _Pragma("unroll") for (int k = 0; k < 2; ++k) \
        acc[ai][bj][m][n] = __builtin_amdgcn_mfma_f32_16x16x32_bf16(Bt[n][k], At[m][k], acc[ai][bj][m][n], 0, 0, 0); __builtin_amdgcn_s_setprio(0); } while (0)
#define PG8_WAIT_V(n) asm volatile("s_waitcnt vmcnt(" #n ")" ::: "memory")
#define PG8_WAIT_L(n) asm volatile("s_waitcnt lgkmcnt(" #n ")" ::: "memory")
#define PG8_BAR __builtin_amdgcn_s_barrier()
#define PG8_SCHED __builtin_amdgcn_sched_barrier(0)
    Unit cur, nxt; int ui = 0;
    if (!S.next(0, cur)) return;
    f32x4 acc[2][2][4][2];
#pragma unroll
    for (int a = 0; a < 2; ++a)
#pragma unroll
        for (int b = 0; b < 2; ++b)
#pragma unroll
            for (int m = 0; m < 4; ++m)
#pragma unroll
                for (int n = 0; n < 2; ++n) acc[a][b][m][n] = (f32x4){0.f, 0.f, 0.f, 0.f};
    bf16x8 At[4][2], B0[2][2], B1[2][2];
    const char* cA = (const char*)g.A + (size_t)cur.pm * tstep + (size_t)cur.k0 * 2; const char* cB = (const char*)g.Bt + (size_t)cur.pn * tstep + (size_t)cur.k0 * 2;
    S.a_ready(cur);
    if constexpr (SP2) {
        PG8_STAGE(PG8_SB(0, 0), cB, voffB); PG8_STAGE(PG8_SB(0, 1), cB + hstep, voffB); PG8_STAGE(PG8_SA(0, 0), cA, voffA); PG8_STAGE(PG8_SA(0, 1), cA + hstep, voffA);
        if (wr == 1) PG8_BAR;
        PG8_WAIT_V(2); PG8_BAR;
        PG8_STAGE(PG8_SB(1, 0), cB + kstep, voffB); PG8_STAGE(PG8_SA(1, 0), cA + kstep, voffA); PG8_STAGE(PG8_SB(1, 1), cB + hstep + kstep, voffB);
        PG8_WAIT_V(6); PG8_BAR;
    } else {
        PG8_STAGE(PG8_SB(0, 0), cB, voffB); PG8_STAGE(PG8_SA(0, 0), cA, voffA); PG8_STAGE(PG8_SB(0, 1), cB + hstep, voffB); PG8_STAGE(PG8_SA(0, 1), cA + hstep, voffA);
        if (wr == 1) PG8_BAR;
        PG8_WAIT_V(4); PG8_BAR;
        PG8_STAGE(PG8_SB(1, 0), cB + kstep, voffB); PG8_STAGE(PG8_SA(1, 0), cA + kstep, voffA); PG8_STAGE(PG8_SB(1, 1), cB + hstep + kstep, voffB);
        PG8_WAIT_V(6); PG8_BAR;
    }
    for (;;) {
        const bool has_next = S.next(ui + 1, nxt);
        const char* nA = has_next ? (const char*)g.A + (size_t)nxt.pm * tstep + (size_t)nxt.k0 * 2 : cA; const char* nB = has_next ? (const char*)g.Bt + (size_t)nxt.pn * tstep + (size_t)nxt.k0 * 2 : cB;
        const int unt = cur.nt ? cur.nt : nt;
        for (int t = 0; t < unt; t += 2) {
            const bool last = (t == unt - 2);
            const char* a1 = cA + (size_t)(t + 1) * kstep;
            const char* a2 = last ? nA : cA + (size_t)(t + 2) * kstep; const char* b2 = last ? nB : cB + (size_t)(t + 2) * kstep;
            const char* a3 = a2 + kstep; const char* b3 = b2 + kstep;
            if (last && has_next) S.a_ready(nxt);
            if constexpr (SP2) {
            PG8_LDB(B0, 0, 0); PG8_LDB(B1, 0, 1); PG8_SCHED; PG8_LDA(At, 0, 0); PG8_STAGE(PG8_SA(1, 1), a1 + hstep, voffA);
            PG8_WAIT_V(8); PG8_WAIT_L(0); PG8_BAR; PG8_MMA(0, 0, At, B0); PG8_MMA(0, 1, At, B1); PG8_BAR; PG8_SCHED;
            PG8_LDA(At, 0, 1); PG8_STAGE(PG8_SB(0, 0), b2, voffB); PG8_STAGE(PG8_SB(0, 1), b2 + hstep, voffB); PG8_STAGE(PG8_SA(0, 0), a2, voffA);
            PG8_WAIT_V(8); PG8_WAIT_L(0); PG8_BAR; PG8_MMA(1, 0, At, B0); PG8_MMA(1, 1, At, B1); PG8_BAR; PG8_SCHED;
            PG8_LDB(B0, 1, 0); PG8_LDB(B1, 1, 1); PG8_SCHED; PG8_LDA(At, 1, 0); PG8_STAGE(PG8_SA(0, 1), a2 + hstep, voffA);
            PG8_WAIT_V(8); PG8_WAIT_L(0); PG8_BAR; PG8_MMA(0, 0, At, B0); PG8_MMA(0, 1, At, B1); PG8_BAR; PG8_SCHED;
            PG8_LDA(At, 1, 1); PG8_STAGE(PG8_SB(1, 0), b3, voffB); PG8_STAGE(PG8_SB(1, 1), b3 + hstep, voffB); PG8_STAGE(PG8_SA(1, 0), a3, voffA);
            PG8_WAIT_V(8); PG8_WAIT_L(0); PG8_BAR; PG8_MMA(1, 0, At, B0); PG8_MMA(1, 1, At, B1); PG8_BAR; PG8_SCHED;
            } else {
            PG8_LDB(B0, 0, 0); PG8_SCHED; PG8_LDA(At, 0, 0); PG8_STAGE(PG8_SA(1, 1), a1 + hstep, voffA);
            PG8_WAIT_L(8); PG8_BAR; PG8_WAIT_L(0); PG8_MMA(0, 0, At, B0); PG8_BAR; PG8_SCHED;
            PG8_LDB(B1, 0, 1); PG8_STAGE(PG8_SB(0, 0), b2, voffB);
            PG8_BAR; PG8_WAIT_L(0); PG8_MMA(0, 1, At, B1); PG8_BAR;
            PG8_LDA(At, 0, 1); PG8_STAGE(PG8_SA(0, 0), a2, voffA);
            PG8_BAR; PG8_WAIT_L(0); PG8_MMA(1, 0, At, B0); PG8_BAR; PG8_SCHED;
            PG8_STAGE(PG8_SB(0, 1), b2 + hstep, voffB);
            PG8_WAIT_V(6); PG8_BAR; PG8_MMA(1, 1, At, B1); PG8_BAR;
            PG8_LDB(B0, 1, 0); PG8_SCHED; PG8_LDA(At, 1, 0); PG8_STAGE(PG8_SA(0, 1), a2 + hstep, voffA);
            PG8_WAIT_L(8); PG8_BAR; PG8_WAIT_L(0); PG8_MMA(0, 0, At, B0); PG8_BAR; PG8_SCHED;
            PG8_LDB(B1, 1, 1); PG8_STAGE(PG8_SB(1, 0), b3, voffB);
            PG8_BAR; PG8_WAIT_L(0); PG8_MMA(0, 1, At, B1); PG8_BAR;
            PG8_LDA(At, 1, 1); PG8_STAGE(PG8_SA(1, 0), a3, voffA);
            PG8_BAR; PG8_WAIT_L(0); PG8_MMA(1, 0, At, B0); PG8_BAR; PG8_SCHED;
            PG8_STAGE(PG8_SB(1, 1), b3 + hstep, voffB);
            PG8_WAIT_V(6); PG8_BAR; PG8_MMA(1, 1, At, B1); PG8_BAR;
            }
        }
        if constexpr (ALIGN_EPI) { if (wr == 0) PG8_BAR; }
        if constexpr (!Epi::AFTER_DRAIN) { E(acc, cur, wr, wc, fr, fq); S.done(cur); }
        if (!has_next) break;
#pragma unroll
        for (int a = 0; a < 2; ++a)
#pragma unroll
            for (int b = 0; b < 2; ++b)
#pragma unroll
                for (int m = 0; m < 4; ++m)
#pragma unroll
                    for (int n = 0; n < 2; ++n) acc[a][b][m][n] = (f32x4){0.f, 0.f, 0.f, 0.f};
        cur = nxt; cA = nA; cB = nB; ++ui;
        if constexpr (ALIGN_EPI) { if (wr == 1) PG8_BAR; }
    }
    PG8_WAIT_V(0);
    if constexpr (!ALIGN_EPI) { if (wr == 0) PG8_BAR; }
    PG8_BAR;
    if constexpr (Epi::AFTER_DRAIN) { E.fused(acc, cur, wr, wc, fr, fq, lds, wid, lane); S.done(cur); }
#undef PG8_SA
#undef PG8_SB
#undef PG8_STAGE
#undef PG8_LDA
#undef PG8_LDB
#undef PG8_MMA
#undef PG8_WAIT_V
#undef PG8_WAIT_L
#undef PG8_BAR
#undef PG8_SCHED
}
}
#define GAS __attribute__((address_space(1)))
#define LAS __attribute__((address_space(3)))
typedef unsigned short bf16;
typedef unsigned v4u __attribute__((ext_vector_type(4)));
typedef unsigned v2u __attribute__((ext_vector_type(2)));
typedef float f32x4 __attribute__((ext_vector_type(4)));
typedef float f32x16 __attribute__((ext_vector_type(16)));
typedef short bf16x8 __attribute__((ext_vector_type(8)));
typedef short s16x4 __attribute__((ext_vector_type(4)));
typedef GAS unsigned gu32;
#define RLX_AGENT __ATOMIC_RELAXED, __HIP_MEMORY_SCOPE_AGENT
#define XB_TMO      128
#define XB_XCNT(j)  (256  + 64 * (j))
#define XB_XSUB(j)  (1280 + 64 * (j))
#define XB_XGEN(j)  (2304 + 64 * (j))
#define XB_TOP      3328
#define XB_TOPGEN   3392
#define XCD_BAR_WORDS 3456
#define XB_SPIN_CAP (1u << 18)

__device__ __forceinline__ unsigned xb_ld(unsigned* p)              { return __hip_atomic_load(p, __ATOMIC_RELAXED, __HIP_MEMORY_SCOPE_AGENT); }
__device__ __forceinline__ unsigned xb_add(unsigned* p, unsigned v) { return __hip_atomic_fetch_add(p, v, __ATOMIC_RELAXED, __HIP_MEMORY_SCOPE_AGENT); }
__device__ __forceinline__ unsigned xb_xcc_id() { return (unsigned)__builtin_amdgcn_s_getreg((3 << 11) | 20) & 0xFu; }
#define XB_SPIN(cond, bar) do { unsigned _sp = 0; while (cond) { __builtin_amdgcn_s_sleep(1); \
    if ((++_sp & 255u) == 0u) { if (xb_ld(&(bar)[XB_TMO])) break; if (_sp > XB_SPIN_CAP) { atomicAdd(&(bar)[XB_TMO], 1u); break; } } } } while (0)

struct XcdBarrier {
    unsigned* bar; unsigned x;
    volatile LAS unsigned* st;
    unsigned wv;
};

__device__ __forceinline__ unsigned xb_lane() { return __builtin_amdgcn_mbcnt_hi(~0u, __builtin_amdgcn_mbcnt_lo(~0u, 0u)); }
__device__ __forceinline__ XcdBarrier xcd_barrier_post(unsigned* bar, volatile LAS unsigned* st, unsigned wv) {
    XcdBarrier b; b.bar = bar; b.x = xb_xcc_id(); b.st = st; b.wv = wv;
    if (wv == 0u && xb_lane() == 0u) (void)xb_add(&bar[XB_XCNT(b.x)], 1u);
    return b;
}
__device__ __forceinline__ void xcd_barrier_complete(unsigned* bar, unsigned x, unsigned& nloc, unsigned& nx) {
    const unsigned G = gridDim.x * gridDim.y * gridDim.z;
    unsigned sum, cnt, mine, sp = 0u;
    for (;;) {
        sum = 0u; cnt = 0u; mine = 0u;
#pragma unroll
        for (unsigned j = 0; j < 16; ++j) { const unsigned c = xb_ld(&bar[XB_XCNT(j)]); sum += c; cnt += (c > 0u) ? 1u : 0u; mine = (j == x) ? c : mine; }
        if (sum == G) break;
        __builtin_amdgcn_s_sleep(1);
        if ((++sp & 255u) == 0u) { if (xb_ld(&bar[XB_TMO])) break; if (sp > XB_SPIN_CAP) { atomicAdd(&bar[XB_TMO], 1u); break; } }
    }
    nloc = mine > 0u ? mine : 1u; nx = cnt > 0u ? cnt : 1u;
}

__device__ __forceinline__ void xcd_barrier(const XcdBarrier& b) {
    asm volatile("s_waitcnt vmcnt(0)" ::: "memory");
    __syncthreads();
    if (b.wv == 0u && xb_lane() == 0u) {
        unsigned* bar = b.bar;
        __builtin_amdgcn_s_waitcnt(0);
        unsigned nloc = b.st[0], nx = b.st[1];
        if (nloc == 0u) { xcd_barrier_complete(bar, b.x, nloc, nx); b.st[0] = nloc; b.st[1] = nx; }
        const unsigned old = xb_add(&bar[XB_XSUB(b.x)], 1u);
        const unsigned gen = old / nloc;
        if (old + 1u == (gen + 1u) * nloc) {
            __builtin_amdgcn_fence(__ATOMIC_RELEASE, "agent");
            asm volatile("s_waitcnt vmcnt(0)" ::: "memory");
            const unsigned og = xb_add(&bar[XB_TOP], 1u);
            const unsigned tg = og / nx;
            if (og + 1u == (tg + 1u) * nx) xb_add(&bar[XB_TOPGEN], 1u);
            else XB_SPIN(xb_ld(&bar[XB_TOPGEN]) == tg, bar);
            __builtin_amdgcn_fence(__ATOMIC_ACQUIRE, "agent");
            xb_add(&bar[XB_XGEN(b.x)], 1u);
            asm volatile("s_waitcnt vmcnt(0)" ::: "memory");
        } else {
            XB_SPIN(xb_ld(&bar[XB_XGEN(b.x)]) == gen, bar);
            __builtin_amdgcn_fence(__ATOMIC_ACQUIRE, "agent");
            asm volatile("s_waitcnt vmcnt(0)" ::: "memory");
        }
    }
    __syncthreads();
}
#ifndef ONE_LAUNCH
#define ONE_LAUNCH 1
#endif
#ifndef NLAYERS
#define NLAYERS 4
#endif
constexpr int DM = 2048, MR = 8704, NLATR = 8192;
constexpr int NINP = 6400, DFF = 5632, NUP = 11264, EVIN = 6176, ODIN = 6160;
constexpr int NWAVES = 8, NTHR = 512;
constexpr float EPS = 1e-6f;
constexpr int NCHUNK = 68;
constexpr int PPL = 11, NPH = 1 + 4 * PPL;
constexpr size_t MiB = 1ull << 20;
constexpr size_t WS_CTL = 0, CTL_BYTES = 1 * MiB;
constexpr size_t WS_MOD = 1 * MiB, WS_ROPE = 1 * MiB + 640 * 1024;
constexpr size_t WS_W = 4 * MiB, W_LAYER = 99 * MiB, W_OUT = 25 * MiB, W_UP = 33 * MiB, W_DN = 77 * MiB;
constexpr size_t WS_XS = 400 * MiB, WS_H = 468 * MiB, WS_MIX = 502 * MiB, WS_P = 536 * MiB, WS_U = 644 * MiB, WS_ACT = 832 * MiB;
constexpr size_t WS_QR = 926 * MiB, WS_KR = 943 * MiB, WS_MQK = 960 * MiB, WS_DST = 977 * MiB, WS_SST = 1113 * MiB, WS_SM = 1181 * MiB, WS_B1 = 1185 * MiB, WS_B2 = 1186 * MiB, WS_END = 1187 * MiB;
constexpr size_t WS_SSQ = 524288;
constexpr size_t SM_GAM = 0, SM_DN = 1 * MiB, SM_NIN = 2 * MiB, SM_BL = 3 * MiB, SM_ML = 3 * MiB + 8192, SM_MIN = 3 * MiB + 16384;
constexpr int CW_BAR = 4096;
constexpr int LDS_BYTES = 147456, MISC_OFF = 131072 + 320;

struct Args { const float* in[27]; float* out; unsigned char* ws; int ph_lo, ph_hi, li, pad; };

__device__ __forceinline__ float bf_lo(unsigned u) { return __builtin_bit_cast(float, u << 16); }
__device__ __forceinline__ float bf_hi(unsigned u) { return __builtin_bit_cast(float, u & 0xffff0000u); }
__device__ __forceinline__ float bf1(bf16 b) { return __builtin_bit_cast(float, (unsigned)b << 16); }
typedef float f32x2_t __attribute__((ext_vector_type(2))); typedef __bf16 bf16x2_t __attribute__((ext_vector_type(2)));
__device__ __forceinline__ unsigned pk2(float lo, float hi) { f32x2_t v = {lo, hi}; bf16x2_t b = __builtin_convertvector(v, bf16x2_t); return __builtin_bit_cast(unsigned, b); }
__device__ __forceinline__ bf16 f2bf(float f) { return (bf16)(pk2(f, 0.f) & 0xffffu); }
__device__ __forceinline__ void unpack8(const v4u w, float (&f)[8]) { f[0] = bf_lo(w.x); f[1] = bf_hi(w.x); f[2] = bf_lo(w.y); f[3] = bf_hi(w.y); f[4] = bf_lo(w.z); f[5] = bf_hi(w.z); f[6] = bf_lo(w.w); f[7] = bf_hi(w.w); }
__device__ __forceinline__ v4u pack8(const float (&f)[8]) { v4u w; w.x = pk2(f[0], f[1]); w.y = pk2(f[2], f[3]); w.z = pk2(f[4], f[5]); w.w = pk2(f[6], f[7]); return w; }
__device__ __forceinline__ float silu_f(float x) { return x / (1.f + __expf(-x)); }
__device__ __forceinline__ float sigmoid_f(float x) { return 1.f / (1.f + __expf(-x)); }
__device__ __forceinline__ float logsig_f(float z) { return fminf(z, 0.f) - __logf(1.f + __expf(-fabsf(z))); }
__device__ __forceinline__ float wave_sum(float v) {
#pragma unroll
    for (int o = 1; o < 64; o <<= 1) v += __shfl_xor(v, o);
    return v;
}
__device__ __forceinline__ float wave_max(float v) {
#pragma unroll
    for (int o = 1; o < 64; o <<= 1) v = fmaxf(v, __shfl_xor(v, o));
    return v;
}
__device__ __forceinline__ float wave_scan_sum(float v, int dir, int lane) {
#pragma unroll
    for (int o = 1; o < 64; o <<= 1) { const float up = __shfl_up(v, o), dn = __shfl_down(v, o); if (dir == 0) { if (lane >= o) v += up; } else { if (lane + o < 64) v += dn; } }
    return v;
}
__device__ __forceinline__ float wave_scan_max(float v, int dir, int lane) {
#pragma unroll
    for (int o = 1; o < 64; o <<= 1) { const float up = __shfl_up(v, o), dn = __shfl_down(v, o); if (dir == 0) { if (lane >= o) v = fmaxf(v, up); } else { if (lane + o < 64) v = fmaxf(v, dn); } }
    return v;
}
__device__ __forceinline__ bool seq_start(int r) { return r < NLATR ? (r & 4095) == 0 : ((r - NLATR) & 255) == 0; }

__device__ __forceinline__ bf16x8 frag_row(LAS const unsigned char* base, int stride, int row0, int k0, int lane) {
    return *(LAS const bf16x8*)(base + (row0 + (lane & 31)) * stride + (k0 + 8 * (lane >> 5)) * 2);
}
__device__ __forceinline__ s16x4 tr4(LAS const unsigned char* p) { return __builtin_amdgcn_ds_read_tr16_b64_v4i16((LAS s16x4*)p); }
__device__ __forceinline__ bf16x8 frag_tr(LAS const unsigned char* base, int stride, int k0, int col0, int lane) {
    const int h = lane >> 5, blk = (lane >> 4) & 1, q = (lane & 15) >> 2, p = lane & 3;
    LAS const unsigned char* a = base + (k0 + 8 * h + q) * stride + (col0 + 16 * blk + 4 * p) * 2;
    const s16x4 lo = tr4(a), hi = tr4(a + 4 * stride);
    return (bf16x8){lo[0], lo[1], lo[2], lo[3], hi[0], hi[1], hi[2], hi[3]};
}
__device__ __forceinline__ bf16x8 frag_tr_perm(LAS const unsigned char* base, int stride, int k0, int col0, int lane) {
    const int h = lane >> 5, blk = (lane >> 4) & 1, q = (lane & 15) >> 2, p = lane & 3;
    LAS const unsigned char* a = base + (k0 + 4 * h + q) * stride + (col0 + 16 * blk + 4 * p) * 2;
    const s16x4 lo = tr4(a), hi = tr4(a + 8 * stride);
    return (bf16x8){lo[0], lo[1], lo[2], lo[3], hi[0], hi[1], hi[2], hi[3]};
}
__device__ __forceinline__ int swz_off(int row, int ch) { return 256 * row + 16 * (ch ^ (((row & 3) << 2) | ((row >> 2) & 3))); }
__device__ __forceinline__ bf16x8 sfrag_row(LAS const unsigned char* base, int row0, int k0, int lane) {
    return *(LAS const bf16x8*)(base + swz_off(row0 + (lane & 31), (k0 >> 3) + (lane >> 5)));
}
__device__ __forceinline__ bf16x8 sfrag_tr_perm(LAS const unsigned char* base, int k0, int col0, int lane) {
    const int h = lane >> 5, blk = (lane >> 4) & 1, q = (lane & 15) >> 2, p = lane & 3, ch = (col0 >> 3) + 2 * blk + (p >> 1), r0 = k0 + 4 * h + q;
    const s16x4 lo = tr4(base + swz_off(r0, ch) + 8 * (p & 1)), hi = tr4(base + swz_off(r0 + 8, ch) + 8 * (p & 1));
    return (bf16x8){lo[0], lo[1], lo[2], lo[3], hi[0], hi[1], hi[2], hi[3]};
}
#define MFMA32(a, b, c) __builtin_amdgcn_mfma_f32_32x32x16_bf16((a), (b), (c), 0, 0, 0)
__device__ __forceinline__ f32x16 zero16() { f32x16 z;
#pragma unroll
    for (int i = 0; i < 16; ++i) z[i] = 0.f;
    return z; }
__device__ __forceinline__ void load_tile(LAS unsigned char* dst, int ls, const bf16* src, size_t ld, int rows, int cols, int tid) {
    const int cpr = cols >> 3, n = rows * cpr;
    for (int c = tid; c < n; c += NTHR) { const int r = c / cpr, cc = c - r * cpr; *(LAS v4u*)(dst + r * ls + cc * 16) = *(const v4u*)(src + (size_t)r * ld + cc * 8); }
}

__device__ __forceinline__ void store_tile(bf16* dst, size_t ld, LAS const unsigned char* src, int ls, int rows, int cols, int tid) {
    const int cpr = cols >> 3, n = rows * cpr;
    for (int c = tid; c < n; c += NTHR) { const int r = c / cpr, cc = c - r * cpr; *(v4u*)(dst + (size_t)r * ld + cc * 8) = *(LAS const v4u*)(src + r * ls + cc * 16); }
}

struct TrItem { const float* W; bf16* WT; int K, N, k0, n0, dn0, nts; };
__device__ __forceinline__ void tr_issue(const TrItem& t, f32x4 (&v)[8], int lane) {
    const int n = t.n0 + 4 * (lane & 7);
#pragma unroll
    for (int i = 0; i < 8; ++i) { const int kk = 8 * i + (lane >> 3); v[i] = n < t.N ? __builtin_nontemporal_load((const f32x4*)(t.W + (size_t)(t.k0 + kk) * t.N + n)) : (f32x4){0.f, 0.f, 0.f, 0.f}; }
}
__device__ __forceinline__ void tr_finish(const TrItem& t, const f32x4 (&v)[8], LAS float* scr, int lane) {
#pragma unroll
    for (int i = 0; i < 8; ++i) { const int kk = 8 * i + (lane >> 3); LAS float* d = scr + kk * 33 + 4 * (lane & 7); d[0] = v[i].x; d[1] = v[i].y; d[2] = v[i].z; d[3] = v[i].w; }
    asm volatile("s_waitcnt lgkmcnt(0)" ::: "memory");
    const int c = lane & 7;
#pragma unroll
    for (int j = 0; j < 4; ++j) { const int nn = (lane >> 3) + 8 * j; const LAS float* s = scr + (8 * c) * 33 + nn;
        v4u o; o.x = pk2(s[0 * 33], s[1 * 33]); o.y = pk2(s[2 * 33], s[3 * 33]); o.z = pk2(s[4 * 33], s[5 * 33]); o.w = pk2(s[6 * 33], s[7 * 33]);
        if (t.k0 >= 0 && t.nts) __builtin_nontemporal_store(o, (v4u*)(t.WT + (size_t)(t.dn0 + nn) * t.K + t.k0 + 8 * c)); else *(v4u*)(t.WT + (size_t)(t.dn0 + nn) * t.K + t.k0 + 8 * c) = o; }
    asm volatile("s_waitcnt lgkmcnt(0)" ::: "memory");
}
__device__ __forceinline__ void tr_decode(const Args& a, unsigned char* ws, int g, TrItem& t) {
    const int layer = g / 25344; int r = g - layer * 25344; const int li = layer >> 1; t.nts = layer > 0;
    unsigned char* wb = ws + WS_W + (size_t)layer * W_LAYER;
    int nblk;
    if (r < 6400) { if (layer & 1) { t.W = a.in[14] + (size_t)li * DM * ODIN; t.N = ODIN; } else { t.W = a.in[8] + (size_t)li * DM * EVIN; t.N = EVIN; } t.WT = (bf16*)wb; t.K = DM; nblk = NINP / 32; }
    else if ((r -= 6400) < 2048) { t.W = (layer & 1 ? a.in[15] : a.in[9]) + (size_t)li * DM * DM; t.N = DM; t.WT = (bf16*)(wb + W_OUT); t.K = DM; nblk = DM / 32; }
    else if ((r -= 2048) < 11264) { t.W = a.in[23] + (size_t)layer * DM * NUP; t.N = NUP; t.WT = (bf16*)(wb + W_UP); t.K = DM; nblk = NUP / 32; }
    else { r -= 11264; t.W = a.in[26] + (size_t)layer * DFF * DM; t.N = DM; t.WT = (bf16*)(wb + W_DN); t.K = DFF; nblk = DM / 32; }
    const int kb = r / nblk, nb = r - kb * nblk; t.k0 = 64 * kb; t.n0 = 32 * nb; t.dn0 = t.n0;
    if (t.N == NUP) { const int m0 = t.n0 < DFF ? t.n0 : t.n0 - DFF; t.dn0 = 256 * (m0 >> 7) + (t.n0 < DFF ? 0 : 128) + (m0 & 127); }
}
__device__ __forceinline__ void ph_convert(const Args& a, unsigned char* ws, LAS unsigned char* lds, int g_lo, int g_hi, int w, int nw, int wave, int lane) {
    LAS float* scr = (LAS float*)(lds + wave * 8448);
    TrItem cur, nxt; f32x4 va[8], vb[8];
    int g = g_lo + w;
    if (g < g_hi) { tr_decode(a, ws, g, cur); tr_issue(cur, va, lane); }
    while (g < g_hi) {
        const int g1 = g + nw; if (g1 < g_hi) { tr_decode(a, ws, g1, nxt); tr_issue(nxt, vb, lane); }
        tr_finish(cur, va, scr, lane);
        const int g2 = g1 + nw; if (g1 < g_hi) { if (g2 < g_hi) { tr_decode(a, ws, g2, cur); tr_issue(cur, va, lane); } tr_finish(nxt, vb, scr, lane); }
        g = g2;
    }
}
__device__ __forceinline__ void ph_prologue(const Args& a, unsigned char* ws, LAS unsigned char* lds, int tid, int lane, int wave, int bid, int G) {
    float* MOD = (float*)(ws + WS_MOD);
    LAS float* vec = (LAS float*)(lds + 73728);
    LAS float* red = (LAS float*)(lds + 98304);
    for (int e = tid; e < 3 * DM; e += NTHR) { const float v = e < 2 * DM ? a.in[1][e] : a.in[3][e - 2 * DM]; vec[e] = silu_f(v); }
    __syncthreads();
    for (int it = bid; it < 4 * 192; it += G) {
        const int layer = it / 192, cg = it - layer * 192, col = cg * 64 + 4 * (lane & 15), rq = lane >> 4;
        const float* W = a.in[4] + (size_t)layer * DM * 12288 + col;
        f32x4 a0 = {0.f, 0.f, 0.f, 0.f}, a1 = a0, a2 = a0;
#pragma unroll 16
        for (int i = 0; i < 64; ++i) { const int kk = 256 * wave + 4 * i + rq; const f32x4 w4 = __builtin_nontemporal_load((const f32x4*)(W + (size_t)kk * 12288));
            a0 += w4 * vec[kk]; a1 += w4 * vec[DM + kk]; a2 += w4 * vec[2 * DM + kk]; }
#pragma unroll
        for (int e = 0; e < 4; ++e) { a0[e] += __shfl_xor(a0[e], 16); a0[e] += __shfl_xor(a0[e], 32); a1[e] += __shfl_xor(a1[e], 16); a1[e] += __shfl_xor(a1[e], 32); a2[e] += __shfl_xor(a2[e], 16); a2[e] += __shfl_xor(a2[e], 32); }
        if (lane < 16) { *(LAS f32x4*)(red + (wave * 3 + 0) * 64 + 4 * lane) = a0; *(LAS f32x4*)(red + (wave * 3 + 1) * 64 + 4 * lane) = a1; *(LAS f32x4*)(red + (wave * 3 + 2) * 64 + 4 * lane) = a2; }
        __syncthreads();
        if (tid < 192) { const int j = tid >> 6, c = tid & 63; float s = a.in[5][layer * 12288 + cg * 64 + c];
#pragma unroll
            for (int w = 0; w < 8; ++w) s += red[(w * 3 + j) * 64 + c];
            MOD[(size_t)(layer * 3 + j) * 12288 + cg * 64 + c] = s; }
        __syncthreads();
    }
    if (bid == G - 1) { float* rope = (float*)(ws + WS_ROPE);
        for (int e = tid; e < 1024; e += NTHR) { const int pos = e >> 4, f = e & 15; const float inv = powf(10000.f, -(float)f / 16.f), ang = (float)pos * inv; rope[e] = cosf(ang); rope[1024 + e] = sinf(ang); } }
    ph_convert(a, ws, lds, 0, 25344, bid * NWAVES + wave, G * NWAVES, wave, lane);
}

__device__ __forceinline__ void fuse_row(const float* src, float* XS, int row, int lane, const float* part, const float* pgate, int nsplit, const float* ng, const float* msc, bf16* H, float* ssq) {
    const int mi = row < NLATR ? (row >> 12) : 2;
    const f32x4* sr = (const f32x4*)src + lane; f32x4* xr = (f32x4*)(XS + (size_t)row * DM) + lane;
    f32x4 v[8];
#pragma unroll
    for (int j = 0; j < 8; ++j) v[j] = sr[64 * j];
    if (nsplit > 0) {
        f32x4 sacc[8];
#pragma unroll
        for (int j = 0; j < 8; ++j) sacc[j] = (f32x4){0.f, 0.f, 0.f, 0.f};
        for (int sp = 0; sp < nsplit; ++sp) { const f32x4* pr = (const f32x4*)(part + ((size_t)sp * 512 + (row - NLATR)) * DM) + lane;
#pragma unroll
            for (int j = 0; j < 8; ++j) sacc[j] += pr[64 * j]; }
#pragma unroll
        for (int j = 0; j < 8; ++j) v[j] += *(const f32x4*)(pgate + 4 * lane + 256 * j) * sacc[j];
    }
    float ss = 0.f;
#pragma unroll
    for (int j = 0; j < 8; ++j) { xr[64 * j] = v[j]; ss += (v[j].x * v[j].x + v[j].y * v[j].y) + (v[j].z * v[j].z + v[j].w * v[j].w); }
    ss = wave_sum(ss);
    if (lane == 0) ssq[row] = ss;
#pragma unroll
    for (int j = 0; j < 8; ++j) { const int col = 4 * lane + 256 * j;
        const f32x4 y = v[j] * *(const f32x4*)(ng + col) * (*(const f32x4*)(msc + (size_t)mi * 12288 + col) + 1.f);
        v2u o; o.x = pk2(y.x, y.y); o.y = pk2(y.z, y.w);
        *(v2u*)(H + (size_t)row * DM + col) = o; }
}
__device__ __forceinline__ void ph_norm0(const float* x, const float* ctx, float* XS, const float* ng, const float* msc, bf16* H, float* ssq, int gw, int NGW, int lane) {
    for (int row = gw; row < MR; row += NGW) fuse_row(row < NLATR ? x + (size_t)row * DM : ctx + (size_t)(row - NLATR) * DM, XS, row, lane, nullptr, nullptr, 0, ng, msc, H, ssq);
}
template <int NS>
__device__ __forceinline__ void ph_ctxfix(float* XS, const float* part, const float* pgate, const float* ng, const float* msc, bf16* H, float* ssq, int gw, int NGW, int lane) {
    for (int it = gw; it < 2048; it += NGW) {
        const int row = NLATR + (it >> 2), c0 = (it & 3) * 512 + 8 * lane;
        float* xp = XS + (size_t)row * DM + c0;
        f32x4 v0 = *(const f32x4*)xp, v1 = *(const f32x4*)(xp + 4);
        f32x4 p0[NS], p1[NS];
#pragma unroll
        for (int sp = 0; sp < NS; ++sp) { const float* pp = part + ((size_t)sp * 512 + (row - NLATR)) * DM + c0; p0[sp] = *(const f32x4*)pp; p1[sp] = *(const f32x4*)(pp + 4); }
        f32x4 s0 = p0[0], s1 = p1[0];
#pragma unroll
        for (int sp = 1; sp < NS; ++sp) { s0 += p0[sp]; s1 += p1[sp]; }
        v0 += *(const f32x4*)(pgate + c0) * s0; v1 += *(const f32x4*)(pgate + c0 + 4) * s1;
        *(f32x4*)xp = v0; *(f32x4*)(xp + 4) = v1;
        float ss = (v0.x * v0.x + v0.y * v0.y) + (v0.z * v0.z + v0.w * v0.w) + (v1.x * v1.x + v1.y * v1.y) + (v1.z * v1.z + v1.w * v1.w);
        ss = wave_sum(ss);
        if (lane == 0) (void)__hip_atomic_fetch_add(ssq + row, ss, __ATOMIC_RELAXED, __HIP_MEMORY_SCOPE_AGENT);
        const f32x4 y0 = v0 * *(const f32x4*)(ng + c0) * (*(const f32x4*)(msc + 2 * 12288 + c0) + 1.f), y1 = v1 * *(const f32x4*)(ng + c0 + 4) * (*(const f32x4*)(msc + 2 * 12288 + c0 + 4) + 1.f);
        v4u o; o.x = pk2(y0.x, y0.y); o.y = pk2(y0.z, y0.w); o.z = pk2(y1.x, y1.y); o.w = pk2(y1.z, y1.w);
        *(v4u*)(H + (size_t)row * DM + c0) = o;
    }
}
__device__ __forceinline__ void ph_bias(const bf16* WIN, const bf16* WUPt, const float* mod, float* b1, float* b2, int gw, int NGW, int lane) {
    for (int which = 0; which < 2; ++which) {
        const bf16* WT = which ? WUPt : WIN; const int N = which ? NUP : NINP; const float* sh = mod + (which ? 3 * DM : 0); float* out = which ? b2 : b1;
        float s0[32], s1[32], s2[32];
#pragma unroll
        for (int i = 0; i < 4; ++i)
#pragma unroll
            for (int h = 0; h < 2; ++h) { const int k = 512 * i + 8 * lane + 4 * h; const f32x4 a0 = *(const f32x4*)(sh + k), a1 = *(const f32x4*)(sh + 12288 + k), a2 = *(const f32x4*)(sh + 2 * 12288 + k);
#pragma unroll
                for (int el = 0; el < 4; ++el) { s0[8 * i + 4 * h + el] = a0[el]; s1[8 * i + 4 * h + el] = a1[el]; s2[8 * i + 4 * h + el] = a2[el]; } }
#pragma unroll 1
        for (int n0 = gw * 2; n0 < N; n0 += NGW * 2) {
            v4u wv[2][4];
#pragma unroll
            for (int rr = 0; rr < 2; ++rr)
#pragma unroll
                for (int i = 0; i < 4; ++i) wv[rr][i] = *(const v4u*)(WT + (size_t)(n0 + rr) * DM + 512 * i + 8 * lane);
            float d[2][3];
#pragma unroll
            for (int rr = 0; rr < 2; ++rr) { d[rr][0] = 0.f; d[rr][1] = 0.f; d[rr][2] = 0.f;
#pragma unroll
                for (int i = 0; i < 4; ++i) { float w[8]; unpack8(wv[rr][i], w);
#pragma unroll
                    for (int el = 0; el < 8; ++el) { d[rr][0] += w[el] * s0[8 * i + el]; d[rr][1] += w[el] * s1[8 * i + el]; d[rr][2] += w[el] * s2[8 * i + el]; } } }
#pragma unroll
            for (int rr = 0; rr < 2; ++rr)
#pragma unroll
                for (int j = 0; j < 3; ++j) d[rr][j] = wave_sum(d[rr][j]);
            if (lane == 0) {
#pragma unroll
                for (int rr = 0; rr < 2; ++rr) { out[n0 + rr] = d[rr][0]; out[N + n0 + rr] = d[rr][1]; out[2 * N + n0 + rr] = d[rr][2]; } }
        }
    }
}

template <int MODE>
__device__ __forceinline__ void ph_conv(const bf16* SRC, const float* cw, const float* cb, bf16* DST, int gtid, int NT) {
    constexpr int NC = MODE == 0 ? DFF : 1024, NCG = NC / 8, NRB = MR / 16;
    constexpr int LDS_ = MODE == 0 ? NUP : NINP, LDD = MODE == 0 ? DFF : (MODE == 1 ? DM : 1024);
    for (int it = gtid; it < NRB * NCG; it += NT) {
        const int rb = it / NCG, cg = it - rb * NCG, r0 = rb * 16, c0 = cg * 8;
        float w0[8], w1[8], w2[8], bb[8];
#pragma unroll
        for (int j = 0; j < 8; ++j) { w0[j] = cw[c0 + j]; w1[j] = cw[NC + c0 + j]; w2[j] = cw[2 * NC + c0 + j]; bb[j] = MODE == 0 ? cb[c0 + j] : 0.f; }
        auto ld = [&](int r, float (&f)[8]) {
            if (MODE == 0) { unpack8(*(const v4u*)(SRC + (size_t)r * LDS_ + c0), f); }
            else if (MODE == 1) { float s1[8], s2[8]; unpack8(*(const v4u*)(SRC + (size_t)r * LDS_ + 3104 + c0), s1); unpack8(*(const v4u*)(SRC + (size_t)r * LDS_ + 5152 + c0), s2);
#pragma unroll
                for (int j = 0; j < 8; ++j) f[j] = s1[j] * s2[j]; }
            else { unpack8(*(const v4u*)(SRC + (size_t)r * LDS_ + 3072 + c0), f); }
        };
        float prev[8], cur[8], nxt[8];
        if (!seq_start(r0)) ld(r0 - 1, prev); else {
#pragma unroll
            for (int j = 0; j < 8; ++j) prev[j] = 0.f; }
        ld(r0, cur);
#pragma unroll 2
        for (int i = 0; i < 16; ++i) {
            const int r = r0 + i;
            if (i < 15 || !seq_start(r0 + 16)) ld(r + 1, nxt); else {
#pragma unroll
                for (int j = 0; j < 8; ++j) nxt[j] = 0.f; }
            float o[8];
            if (MODE == 0) { float vv[8]; unpack8(*(const v4u*)(SRC + (size_t)r * LDS_ + DFF + c0), vv);
#pragma unroll
                for (int j = 0; j < 8; ++j) o[j] = silu_f(w0[j] * prev[j] + w1[j] * cur[j] + w2[j] * nxt[j] + bb[j]) * vv[j]; }
            else if (MODE == 1) { float vv[8]; unpack8(*(const v4u*)(SRC + (size_t)r * LDS_ + 4128 + c0), vv);
#pragma unroll
                for (int j = 0; j < 8; ++j) o[j] = (w0[j] * prev[j] + w1[j] * cur[j] + w2[j] * nxt[j]) * vv[j]; }
            else { const float sc = c0 >= 512 ? 0.08838834764831845f : 1.f;
#pragma unroll
                for (int j = 0; j < 8; ++j) o[j] = silu_f(w0[j] * prev[j] + w1[j] * cur[j] + w2[j] * nxt[j]) * sc; }
            *(v4u*)(DST + (size_t)r * LDD + (MODE == 1 ? 1024 : 0) + c0) = pack8(o);
#pragma unroll
            for (int j = 0; j < 8; ++j) { prev[j] = cur[j]; cur[j] = nxt[j]; }
        }
    }
}

__device__ __forceinline__ void ph_act_fix(const float* halo, const float* cw, bf16* ACT, int gtid, int NT) {
    for (int e = gtid; e < 34 * 44 * 256; e += NT) {
        const int ch = e & 127, which = (e >> 7) & 1, tile = e >> 8, pm = tile / 44, pn = tile - pm * 44, chg = pn * 128 + ch;
        const float* hb = halo + (size_t)tile * 768;
        const int row = 256 * pm + (which ? 255 : 0);
        float g = 0.f;
        if (which == 0) { if (!seq_start(row)) g = halo[(size_t)(tile - 44) * 768 + 128 + ch] * cw[chg]; }
        else { if (!seq_start(row + 1)) g = halo[(size_t)(tile + 44) * 768 + ch] * cw[2 * DFF + chg]; }
        const float cv = hb[(2 + which) * 128 + ch] + g;
        ACT[(size_t)row * DFF + chg] = f2bf(silu_f(cv) * hb[(4 + which) * 128 + ch]);
    }
}

__device__ __forceinline__ void act_fix_tile(const float* halo, const float* cw, bf16* ACT, int pm, int tid) {
    f32x4 cp[6], vv[6], gg[6];
#pragma unroll
    for (int i = 0; i < 6; ++i) { const int e = tid + NTHR * i; const bool ok = e < 2816; const int ee = ok ? e : 0;
        const int c4 = ee & 31, which = (ee >> 5) & 1, pn = ee >> 6, tile = pm * 44 + pn, chg = pn * 128 + 4 * c4;
        const float* hb = halo + (size_t)tile * 768 + 4 * c4;
        const int row = 256 * pm + (which ? 255 : 0);
        cp[i] = *(const f32x4*)(hb + (2 + which) * 128); vv[i] = *(const f32x4*)(hb + (4 + which) * 128);
        const bool edge = which == 0 ? seq_start(row) : seq_start(row + 1);
        const f32x4 nb = edge ? (f32x4){0.f, 0.f, 0.f, 0.f} : *(const f32x4*)(halo + (size_t)(which == 0 ? tile - 44 : tile + 44) * 768 + (which == 0 ? 128 : 0) + 4 * c4);
        gg[i] = nb * *(const f32x4*)(cw + (which == 0 ? 0 : 2 * DFF) + chg); }
#pragma unroll
    for (int i = 0; i < 6; ++i) { const int e = tid + NTHR * i; if (e < 2816) {
        const int c4 = e & 31, which = (e >> 5) & 1, pn = e >> 6, chg = pn * 128 + 4 * c4; const int row = 256 * pm + (which ? 255 : 0);
        const f32x4 cv = cp[i] + gg[i];
        v2u o; o.x = pk2(silu_f(cv.x) * vv[i].x, silu_f(cv.y) * vv[i].y); o.y = pk2(silu_f(cv.z) * vv[i].z, silu_f(cv.w) * vv[i].w);
        *(v2u*)(ACT + (size_t)row * DFF + chg) = o; } }
}

template <int MODE>
__device__ __forceinline__ void ph_conv8(const bf16* SRC, const float* cw, bf16* DST, int gtid, int NT) {
    constexpr int NCG = 128, NRB = MR / 8, LDD = MODE == 1 ? DM : 1024;
    for (int it = gtid; it < NRB * NCG; it += NT) {
        const int rb = it >> 7, cg = it & 127, r0 = rb * 8, c0 = cg * 8;
        const bf16* base = SRC + (size_t)r0 * NINP + c0;
        const bool hp = !seq_start(r0), hn = !seq_start(r0 + 8);
        v4u xa[10], xb[10], xg[8];
#pragma unroll
        for (int i = 0; i < 10; ++i) { const bool ok = (i > 0 || hp) && (i < 9 || hn); const bf16* rp = base + (ptrdiff_t)(i - 1) * NINP;
            if (MODE == 1) { xa[i] = ok ? *(const v4u*)(rp + 3104) : (v4u){0u, 0u, 0u, 0u}; xb[i] = ok ? *(const v4u*)(rp + 5152) : (v4u){0u, 0u, 0u, 0u}; }
            else { xa[i] = ok ? *(const v4u*)(rp + 3072) : (v4u){0u, 0u, 0u, 0u}; } }
        if (MODE == 1) {
#pragma unroll
            for (int i = 0; i < 8; ++i) xg[i] = *(const v4u*)(base + (size_t)i * NINP + 4128); }
        float w0[8], w1[8], w2[8];
#pragma unroll
        for (int j = 0; j < 8; ++j) { w0[j] = cw[c0 + j]; w1[j] = cw[1024 + c0 + j]; w2[j] = cw[2048 + c0 + j]; }
        float prev[8], cur[8], nxt[8];
        auto cvt = [&](int i, float (&f)[8]) { unpack8(xa[i], f); if (MODE == 1) { float g[8]; unpack8(xb[i], g);
#pragma unroll
            for (int j = 0; j < 8; ++j) f[j] *= g[j]; } };
        cvt(0, prev); cvt(1, cur);
        const float sc = (MODE == 2 && c0 >= 512) ? 0.08838834764831845f : 1.f;
#pragma unroll
        for (int i = 0; i < 8; ++i) { cvt(i + 2, nxt); float o[8];
            if (MODE == 1) { float vv[8]; unpack8(xg[i], vv);
#pragma unroll
                for (int j = 0; j < 8; ++j) o[j] = (w0[j] * prev[j] + w1[j] * cur[j] + w2[j] * nxt[j]) * vv[j]; }
            else {
#pragma unroll
                for (int j = 0; j < 8; ++j) o[j] = silu_f(w0[j] * prev[j] + w1[j] * cur[j] + w2[j] * nxt[j]) * sc; }
            *(v4u*)(DST + (size_t)(r0 + i) * LDD + (MODE == 1 ? 1024 : 0) + c0) = pack8(o);
#pragma unroll
            for (int j = 0; j < 8; ++j) { prev[j] = cur[j]; cur[j] = nxt[j]; } }
    }
}

__device__ __forceinline__ void ph_qkprep(const bf16* P, const float* qg, const float* kg, const float* rope, bf16* QR, bf16* KR, int gw, int NGW, int lane) {
    const int i8 = lane & 7;
    float gq[8], gk[8];
#pragma unroll
    for (int j = 0; j < 8; ++j) { gq[j] = qg[8 * i8 + j]; gk[j] = kg[8 * i8 + j]; }
    for (int it0 = gw; it0 < MR * 4; it0 += 4 * NGW) {
        v4u xv[4];
#pragma unroll
        for (int k = 0; k < 4; ++k) { const int it = it0 + k * NGW; const int itc = it < MR * 4 ? it : it0; const int row = itc >> 2, qtr = itc & 3;
            xv[k] = *(const v4u*)(P + (size_t)row * NINP + (qtr >> 1) * 1024 + (qtr & 1) * 512 + 8 * lane); }
#pragma unroll
        for (int k = 0; k < 4; ++k) { const int it = it0 + k * NGW; if (it < MR * 4) {
            const int row = it >> 2, qtr = it & 3, isk = qtr >> 1;
            float x[8]; unpack8(xv[k], x);
            float ss = 0.f;
#pragma unroll
            for (int j = 0; j < 8; ++j) ss += x[j] * x[j];
            ss += __shfl_xor(ss, 1); ss += __shfl_xor(ss, 2); ss += __shfl_xor(ss, 4);
            const float r = rsqrtf(ss * (1.f / 64.f) + EPS);
            float y[8], o[8];
#pragma unroll
            for (int j = 0; j < 8; ++j) y[j] = x[j] * r * (isk ? gk[j] : gq[j]);
            if (row < NLATR) {
                const int t = row & 4095, pos = (i8 < 4) ? (t >> 6) : (t & 63), f0 = 8 * (i8 & 1);
                const f32x4 c0 = *(const f32x4*)(rope + pos * 16 + f0), c1 = *(const f32x4*)(rope + pos * 16 + f0 + 4), s0 = *(const f32x4*)(rope + 1024 + pos * 16 + f0), s1 = *(const f32x4*)(rope + 1024 + pos * 16 + f0 + 4);
#pragma unroll
                for (int j = 0; j < 8; ++j) { const float pj = __shfl_xor(y[j], 2), c = j < 4 ? c0[j & 3] : c1[j & 3], sn = j < 4 ? s0[j & 3] : s1[j & 3];
                    o[j] = (i8 & 2) ? (pj * sn + y[j] * c) : (y[j] * c - pj * sn); }
            } else {
#pragma unroll
                for (int j = 0; j < 8; ++j) o[j] = y[j]; }
            if (!isk) {
#pragma unroll
                for (int j = 0; j < 8; ++j) o[j] *= 0.18033688011112042f; }
            *(v4u*)((isk ? KR : QR) + (size_t)row * 1024 + (qtr & 1) * 512 + 8 * lane) = pack8(o); } }
    }
}

struct ScanP {
    const bf16* P; const bf16* MQK; bf16* MIX;
    const float* gw2; const float* gb;
    const float* mgb;
    const float* ng;
    bf16* DSTp; bf16* SSTp; float* GAM; float* DN; float* NIN; float* BL; float* ML; float* MINp;
};
__device__ __forceinline__ void scan_unit(int u, int& b, int& head, int& mm, int& rowbase) {
    b = u / 272; const int rem = u - b * 272; head = rem / 68; mm = rem - head * 68;
    rowbase = mm < 4 ? NLATR + b * 256 + 64 * mm : b * 4096 + 64 * (mm - 4);
}
__device__ __forceinline__ int scan_chunk(int mm, int dir) { return dir ? (mm < 4 ? 3 - mm : 71 - mm) : mm; }

__device__ __forceinline__ void gla_gates(const ScanP& s, LAS const float* glr, LAS float* tot, int head, int dir, int tid, float (&bb)[16], float& btot) {
    const int dk = tid & 127, grp = tid >> 7;
    float w2[16];
#pragma unroll
    for (int r = 0; r < 16; ++r) w2[r] = s.gw2[(dir * 16 + r) * 512 + head * 128 + dk];
    const float bias = s.gb[dir * 512 + head * 128 + dk];
#pragma unroll
    for (int tt = 0; tt < 16; ++tt) { const int t = 16 * grp + tt; float z = bias;
#pragma unroll
        for (int r = 0; r < 16; ++r) z += glr[t * 32 + dir * 16 + r] * w2[r];
        bb[tt] = logsig_f(z) * 0.0625f; }
    if (dir == 0) {
#pragma unroll
        for (int tt = 1; tt < 16; ++tt) bb[tt] += bb[tt - 1];
        tot[grp * 128 + dk] = bb[15];
    } else {
#pragma unroll
        for (int tt = 14; tt >= 0; --tt) bb[tt] += bb[tt + 1];
        tot[grp * 128 + dk] = bb[0];
    }
    __syncthreads();
    float off = 0.f; btot = 0.f;
#pragma unroll
    for (int g = 0; g < 4; ++g) { const float tv = tot[g * 128 + dk]; btot += tv; if (dir == 0 ? g < grp : g > grp) off += tv; }
#pragma unroll
    for (int tt = 0; tt < 16; ++tt) bb[tt] += off;
}

__device__ __forceinline__ void ph_mlstm_local(const ScanP& s, LAS unsigned char* lds, int tid, int lane, int wave, int bid, int G) {
    LAS unsigned char* Vs = lds; LAS unsigned char* Kh = lds + 33792; LAS unsigned char* Kr = lds + 68608;
    LAS float* wv = (LAS float*)(lds + 86016); LAS float* dnp = (LAS float*)(lds + 86528);
    const int dk = tid & 127, grp = tid >> 7;
    v4u pv[4], pk[2];
#define ML_PREF(u_) do { int b_, head_, mm_, rb_; scan_unit((u_), b_, head_, mm_, rb_); \
        _Pragma("unroll") for (int i = 0; i < 4; ++i) { const int c_ = tid + NTHR * i; pv[i] = *(const v4u*)(s.P + (size_t)(rb_ + (c_ >> 5)) * NINP + 4096 + head_ * 256 + (c_ & 31) * 8); } \
        _Pragma("unroll") for (int i = 0; i < 2; ++i) { const int c_ = tid + NTHR * i; pk[i] = *(const v4u*)(s.MQK + (size_t)(rb_ + (c_ >> 4)) * 1024 + 512 + head_ * 128 + (c_ & 15) * 8); } } while (0)
    if (bid < 544) ML_PREF(bid);
    for (int u = bid; u < 544; u += G) {
        int b, head, mm, rowbase; scan_unit(u, b, head, mm, rowbase);
#pragma unroll
        for (int i = 0; i < 4; ++i) { const int c_ = tid + NTHR * i; *(LAS v4u*)(Vs + (c_ >> 5) * 528 + (c_ & 31) * 16) = pv[i]; }
#pragma unroll
        for (int i = 0; i < 2; ++i) { const int c_ = tid + NTHR * i; *(LAS v4u*)(Kr + (c_ >> 4) * 272 + (c_ & 15) * 16) = pk[i]; }
        size_t ccd[2];
#pragma unroll
        for (int dir = 0; dir < 2; ++dir) ccd[dir] = (size_t)((b * 4 + head) * 2 + dir) * NCHUNK + scan_chunk(mm, dir);
        if (wave < 2) { const int dir = wave;
            const float ig = bf1(s.P[(size_t)(rowbase + lane) * NINP + 6144 + dir * 8 + head]) + s.mgb[dir * 8 + head];
            const float fg = bf1(s.P[(size_t)(rowbase + lane) * NINP + 6144 + dir * 8 + 4 + head]) + s.mgb[dir * 8 + 4 + head];
            const float lf = logsig_f(fg), bcs = wave_scan_sum(lf, dir, lane), blast = wave_sum(lf);
            const float gs = blast - bcs + ig, mloc = wave_max(gs);
            wv[dir * 64 + lane] = __expf(gs - mloc);
            if (lane == 0) { s.BL[ccd[dir]] = blast; s.ML[ccd[dir]] = mloc; } }
        __syncthreads();
        if (u + G < 544) ML_PREF(u + G);
        { float p0 = 0.f, p1 = 0.f;
#pragma unroll
          for (int tt = 0; tt < 16; ++tt) { const int t = 16 * grp + tt; const float kr = bf1(*(LAS const bf16*)(Kr + t * 272 + dk * 2)); const float k0 = kr * wv[t], k1 = kr * wv[64 + t];
              *(LAS bf16*)(Kh + t * 272 + dk * 2) = f2bf(k0); *(LAS bf16*)(Kh + 17408 + t * 272 + dk * 2) = f2bf(k1); p0 += k0; p1 += k1; }
          dnp[grp * 128 + dk] = p0; dnp[512 + grp * 128 + dk] = p1; }
        __syncthreads();
        if (tid < 256) { const int dir = tid >> 7, d_ = tid & 127; LAS const float* dp = dnp + dir * 512; s.DN[ccd[dir] * 128 + d_] = (dp[d_] + dp[128 + d_]) + (dp[256 + d_] + dp[384 + d_]); }
#pragma unroll
        for (int dir = 0; dir < 2; ++dir) {
            f32x16 acc[4];
#pragma unroll
            for (int nt = 0; nt < 4; ++nt) acc[nt] = zero16();
#pragma unroll
            for (int ks = 0; ks < 4; ++ks) { const bf16x8 af = frag_tr(Vs, 528, 16 * ks, 32 * wave, lane);
#pragma unroll
                for (int nt = 0; nt < 4; ++nt) { const bf16x8 bfr = frag_tr(Kh + dir * 17408, 272, 16 * ks, 32 * nt, lane); acc[nt] = MFMA32(af, bfr, acc[nt]); } }
            bf16* D = s.DSTp + ccd[dir] * 32768;
#pragma unroll
            for (int nt = 0; nt < 4; ++nt)
#pragma unroll
                for (int r = 0; r < 16; ++r) { const int dv = 32 * wave + (r & 3) + 8 * (r >> 2) + 4 * (lane >> 5); D[dv * 128 + 32 * nt + (lane & 31)] = f2bf(acc[nt][r]); }
        }
        __syncthreads();
    }
#undef ML_PREF
}

__device__ __forceinline__ void ph_gla_local(const ScanP& s, bf16* QT, bf16* KT, LAS unsigned char* lds, int tid, int lane, int wave, int bid, int G) {
    LAS unsigned char* Vs = lds; LAS unsigned char* Kh = lds + 33792; LAS unsigned char* Qr = lds + 51200; LAS unsigned char* Kr = lds + 68608;
    LAS float* glr = (LAS float*)(lds + 86016); LAS float* tot = (LAS float*)(lds + 90112);
    const int dk = tid & 127, grp = tid >> 7;
    v4u pv[4], pq[2], pk[2]; bf16 pg[2]; float pw[17];
#define GL_PREF(u_) do { const int dir_ = (u_) & 1; int b_, head_, mm_, rb_; scan_unit((u_) >> 1, b_, head_, mm_, rb_); const bf16* base_ = s.P + (size_t)rb_ * NINP; \
        _Pragma("unroll") for (int i = 0; i < 4; ++i) { const int c_ = tid + NTHR * i; pv[i] = *(const v4u*)(base_ + (size_t)(c_ >> 5) * NINP + 1024 + head_ * 256 + (c_ & 31) * 8); } \
        _Pragma("unroll") for (int i = 0; i < 2; ++i) { const int c_ = tid + NTHR * i; pq[i] = *(const v4u*)(base_ + (size_t)(c_ >> 4) * NINP + head_ * 128 + (c_ & 15) * 8); pk[i] = *(const v4u*)(base_ + (size_t)(c_ >> 4) * NINP + 512 + head_ * 128 + (c_ & 15) * 8); \
            pg[i] = base_[(size_t)(c_ >> 4) * NINP + 3072 + dir_ * 16 + (c_ & 15)]; } \
        _Pragma("unroll") for (int r_ = 0; r_ < 16; ++r_) pw[r_] = s.gw2[(dir_ * 16 + r_) * 512 + head_ * 128 + (tid & 127)]; pw[16] = s.gb[dir_ * 512 + head_ * 128 + (tid & 127)]; } while (0)
    if (bid < 1088) GL_PREF(bid);
    for (int u = bid; u < 1088; u += G) {
        const int dir = u & 1; int b, head, mm, rowbase; scan_unit(u >> 1, b, head, mm, rowbase);
        const int chain = (b * 4 + head) * 2 + dir, c = scan_chunk(mm, dir); const size_t cc = (size_t)chain * NCHUNK + c;
#pragma unroll
        for (int i = 0; i < 4; ++i) { const int c_ = tid + NTHR * i; *(LAS v4u*)(Vs + (c_ >> 5) * 528 + (c_ & 31) * 16) = pv[i]; }
#pragma unroll
        for (int i = 0; i < 2; ++i) { const int c_ = tid + NTHR * i; *(LAS v4u*)(Qr + (c_ >> 4) * 272 + (c_ & 15) * 16) = pq[i]; *(LAS v4u*)(Kr + (c_ >> 4) * 272 + (c_ & 15) * 16) = pk[i]; glr[c_] = bf1(pg[i]); }
        __syncthreads();
        float bb[16], btot;
        { float w2[16];
#pragma unroll
          for (int r = 0; r < 16; ++r) w2[r] = pw[r];
          const float bias = pw[16];
#pragma unroll
          for (int tt = 0; tt < 16; ++tt) { const int t = 16 * grp + tt; float z = bias;
#pragma unroll
              for (int r = 0; r < 16; ++r) z += glr[t * 16 + r] * w2[r];
              bb[tt] = logsig_f(z) * 0.0625f; }
          if (dir == 0) {
#pragma unroll
              for (int tt = 1; tt < 16; ++tt) bb[tt] += bb[tt - 1];
              tot[grp * 128 + dk] = bb[15];
          } else {
#pragma unroll
              for (int tt = 14; tt >= 0; --tt) bb[tt] += bb[tt + 1];
              tot[grp * 128 + dk] = bb[0];
          }
          __syncthreads();
          float off = 0.f; btot = 0.f;
#pragma unroll
          for (int g = 0; g < 4; ++g) { const float tv = tot[g * 128 + dk]; btot += tv; if (dir == 0 ? g < grp : g > grp) off += tv; }
#pragma unroll
          for (int tt = 0; tt < 16; ++tt) bb[tt] += off; }
        if (u + G < 1088) GL_PREF(u + G);
#pragma unroll
        for (int tt = 0; tt < 16; ++tt) { const int t = 16 * grp + tt;
            const float qv = bf1(*(LAS const bf16*)(Qr + t * 272 + dk * 2)), kv = bf1(*(LAS const bf16*)(Kr + t * 272 + dk * 2));
            const float e1 = __expf(bb[tt]);
            *(LAS bf16*)(Kh + t * 272 + dk * 2) = f2bf(kv * __expf(btot - bb[tt]));
            *(LAS bf16*)(Qr + t * 272 + dk * 2) = f2bf(qv * e1 * 0.08838834764831845f); *(LAS bf16*)(Kr + t * 272 + dk * 2) = f2bf(kv * __builtin_amdgcn_rcpf(e1)); }
        if (grp == 0) s.GAM[cc * 128 + dk] = __expf(btot);
        __syncthreads();
        store_tile(QT + ((size_t)dir * MR + rowbase) * 512 + head * 128, 512, Qr, 272, 64, 128, tid);
        store_tile(KT + ((size_t)dir * MR + rowbase) * 512 + head * 128, 512, Kr, 272, 64, 128, tid);
        f32x16 acc[4];
#pragma unroll
        for (int nt = 0; nt < 4; ++nt) acc[nt] = zero16();
#pragma unroll
        for (int ks = 0; ks < 4; ++ks) { const bf16x8 af = frag_tr(Vs, 528, 16 * ks, 32 * wave, lane);
#pragma unroll
            for (int nt = 0; nt < 4; ++nt) { const bf16x8 bfr = frag_tr(Kh, 272, 16 * ks, 32 * nt, lane); acc[nt] = MFMA32(af, bfr, acc[nt]); } }
        bf16* D = s.DSTp + cc * 32768;
#pragma unroll
        for (int nt = 0; nt < 4; ++nt)
#pragma unroll
            for (int r = 0; r < 16; ++r) { const int dv = 32 * wave + (r & 3) + 8 * (r >> 2) + 4 * (lane >> 5); D[dv * 128 + 32 * nt + (lane & 31)] = f2bf(acc[nt][r]); }
        __syncthreads();
    }
}
#undef GL_PREF
__device__ __forceinline__ void ph_gla_out(const ScanP& s, const bf16* QT, const bf16* KT, LAS unsigned char* lds, int tid, int lane, int wave, int bid, int G) {
    LAS unsigned char* Vs = lds;
    LAS unsigned char* Qx = lds + 33792;
    LAS unsigned char* Ki = lds + 68608;
    LAS unsigned char* Am = lds + 103424;
    LAS float* Os = (LAS float*)lds;
    v4u pv[4], pq[2][2], pk[2][2];
#define GO_PREF(u_) do { int b_, head_, mm_, rb_; scan_unit((u_), b_, head_, mm_, rb_); \
        _Pragma("unroll") for (int i = 0; i < 4; ++i) { const int c_ = tid + NTHR * i; pv[i] = *(const v4u*)(s.P + (size_t)(rb_ + (c_ >> 5)) * NINP + 1024 + head_ * 256 + (c_ & 31) * 8); } \
        _Pragma("unroll") for (int d_ = 0; d_ < 2; ++d_) _Pragma("unroll") for (int i = 0; i < 2; ++i) { const int c_ = tid + NTHR * i; const size_t o_ = ((size_t)d_ * MR + rb_ + (c_ >> 4)) * 512 + head_ * 128 + (c_ & 15) * 8; \
            pq[d_][i] = *(const v4u*)(QT + o_); pk[d_][i] = *(const v4u*)(KT + o_); } } while (0)
    if (bid < 544) GO_PREF(bid);
    for (int u = bid; u < 544; u += G) {
        int b, head, mm, rowbase; scan_unit(u, b, head, mm, rowbase);
#pragma unroll
        for (int i = 0; i < 4; ++i) { const int c_ = tid + NTHR * i; *(LAS v4u*)(Vs + (c_ >> 5) * 528 + (c_ & 31) * 16) = pv[i]; }
#pragma unroll
        for (int d_ = 0; d_ < 2; ++d_)
#pragma unroll
            for (int i = 0; i < 2; ++i) { const int c_ = tid + NTHR * i; *(LAS v4u*)(Qx + d_ * 17408 + (c_ >> 4) * 272 + (c_ & 15) * 16) = pq[d_][i]; *(LAS v4u*)(Ki + d_ * 17408 + (c_ >> 4) * 272 + (c_ & 15) * 16) = pk[d_][i]; }
        v4u gp[4];
#pragma unroll
        for (int j = 0; j < 4; ++j) gp[j] = *(const v4u*)(s.P + (size_t)(rowbase + (tid >> 3)) * NINP + 2048 + head * 256 + 32 * (tid & 7) + 8 * j);
        bf16x8 sf[2][8];
#pragma unroll
        for (int dir = 0; dir < 2; ++dir) { const int chain = (b * 4 + head) * 2 + dir, c = scan_chunk(mm, dir); const size_t cc = (size_t)chain * NCHUNK + c;
            const bf16* Sg = s.SSTp + cc * 32768 + (size_t)(32 * wave + (lane & 31)) * 128 + 8 * (lane >> 5);
#pragma unroll
            for (int ks = 0; ks < 8; ++ks) sf[dir][ks] = *(const bf16x8*)(Sg + 16 * ks); }
        __syncthreads();
        if (u + G < 544) GO_PREF(u + G);
        {
            const int dir = wave >> 2, ti = (wave >> 1) & 1, tj = wave & 1; f32x16 acc = zero16();
#pragma unroll
            for (int ks = 0; ks < 8; ++ks) { const bf16x8 af = frag_row(Qx + dir * 17408, 272, 32 * ti, 16 * ks, lane), bfr = frag_row(Ki + dir * 17408, 272, 32 * tj, 16 * ks, lane); acc = MFMA32(af, bfr, acc); }
            const int sidx = 32 * tj + (lane & 31);
#pragma unroll
            for (int r = 0; r < 16; ++r) { const int t = 32 * ti + (r & 3) + 8 * (r >> 2) + 4 * (lane >> 5);
                const bool keep = dir == 0 ? (sidx <= t) : (sidx >= t);
                *(LAS bf16*)(Am + dir * 9216 + t * 144 + sidx * 2) = f2bf(keep ? acc[r] : 0.f); }
        }
        __syncthreads();
        f32x16 acc2[2]; acc2[0] = zero16(); acc2[1] = zero16();
#pragma unroll
        for (int dir = 0; dir < 2; ++dir) {
#pragma unroll
            for (int ks = 0; ks < 8; ++ks)
#pragma unroll
                for (int rt = 0; rt < 2; ++rt) { const bf16x8 af = frag_row(Qx + dir * 17408, 272, 32 * rt, 16 * ks, lane); acc2[rt] = MFMA32(af, sf[dir][ks], acc2[rt]); }
#pragma unroll
            for (int ks = 0; ks < 4; ++ks) { const bf16x8 bfr = frag_tr(Vs, 528, 16 * ks, 32 * wave, lane);
#pragma unroll
                for (int rt = 0; rt < 2; ++rt) { const bf16x8 af = frag_row(Am + dir * 9216, 144, 32 * rt, 16 * ks, lane); acc2[rt] = MFMA32(af, bfr, acc2[rt]); } }
        }
        __syncthreads();
#pragma unroll
        for (int rt = 0; rt < 2; ++rt)
#pragma unroll
            for (int r = 0; r < 16; ++r) { const int t = 32 * rt + (r & 3) + 8 * (r >> 2) + 4 * (lane >> 5); Os[t * 260 + 32 * wave + (lane & 31)] = acc2[rt][r]; }
        __syncthreads();
        { const int t = tid >> 3, part = tid & 7; float o[32]; float ss = 0.f;
#pragma unroll
          for (int j = 0; j < 8; ++j) { const f32x4 v = *(LAS const f32x4*)(Os + t * 260 + 32 * part + 4 * j); o[4 * j] = v.x; o[4 * j + 1] = v.y; o[4 * j + 2] = v.z; o[4 * j + 3] = v.w; ss += (v.x * v.x + v.y * v.y) + (v.z * v.z + v.w * v.w); }
          ss += __shfl_xor(ss, 1); ss += __shfl_xor(ss, 2); ss += __shfl_xor(ss, 4);
          const float rn = rsqrtf(ss * (1.f / 256.f) + EPS);
          const size_t row = (size_t)(rowbase + t);
          bf16* dst = s.MIX + row * DM + head * 256 + 32 * part;
#pragma unroll
          for (int j = 0; j < 4; ++j) { float gv[8], ov[8]; unpack8(gp[j], gv);
#pragma unroll
              for (int e = 0; e < 8; ++e) ov[e] = o[8 * j + e] * rn * s.ng[32 * part + 8 * j + e] * silu_f(gv[e]);
              *(v4u*)(dst + 8 * j) = pack8(ov); } }
        __syncthreads();
    }
}

#undef GO_PREF
__device__ __forceinline__ void ph_mlstm_out(const ScanP& s, LAS unsigned char* lds, int tid, int lane, int wave, int bid, int G, int skip_ctx, unsigned* qhead) {
    LAS unsigned char* Vs = lds; LAS unsigned char* Qi = lds + 33792; LAS unsigned char* Ki = lds + 51200; LAS unsigned char* Qx = lds + 68608; LAS unsigned char* Am = lds + 103424;
    LAS float* sc = (LAS float*)(lds + 121856);
    LAS float* qnp = (LAS float*)(lds + 125952);
    LAS float* Os = (LAS float*)lds;
    v4u pv[4], pq[2], pk[2];
#define MO_UNIT(u_) (skip_ctx ? ((u_) >> 6) * 68 + 4 + ((u_) & 63) : (u_))
#define MO_PREF(u_) do { int b_, head_, mm_, rb_; scan_unit(MO_UNIT(u_), b_, head_, mm_, rb_); \
        _Pragma("unroll") for (int i = 0; i < 4; ++i) { const int c_ = tid + NTHR * i; pv[i] = *(const v4u*)(s.P + (size_t)(rb_ + (c_ >> 5)) * NINP + 4096 + head_ * 256 + (c_ & 31) * 8); } \
        _Pragma("unroll") for (int i = 0; i < 2; ++i) { const int c_ = tid + NTHR * i; const size_t o_ = (size_t)(rb_ + (c_ >> 4)) * 1024 + head_ * 128 + (c_ & 15) * 8; pq[i] = *(const v4u*)(s.MQK + o_); pk[i] = *(const v4u*)(s.MQK + o_ + 512); } } while (0)
    const int nu = skip_ctx ? 512 : 544;
    volatile LAS int* qs = (volatile LAS int*)(lds + MISC_OFF + 104);
    if (tid == 0) qs[0] = (int)__hip_atomic_fetch_add(qhead, 1u, __ATOMIC_RELAXED, __HIP_MEMORY_SCOPE_AGENT);
    __syncthreads();
    int u = qs[0], par = 0;
    if (u < nu) MO_PREF(u);
    for (; u < nu; par ^= 1) {
        if (tid == 0) qs[par ^ 1] = (int)__hip_atomic_fetch_add(qhead, 1u, __ATOMIC_RELAXED, __HIP_MEMORY_SCOPE_AGENT);
        int b, head, mm, rowbase; scan_unit(MO_UNIT(u), b, head, mm, rowbase);
#pragma unroll
        for (int i = 0; i < 4; ++i) { const int c_ = tid + NTHR * i; *(LAS v4u*)(Vs + (c_ >> 5) * 528 + (c_ & 31) * 16) = pv[i]; }
#pragma unroll
        for (int i = 0; i < 2; ++i) { const int c_ = tid + NTHR * i; *(LAS v4u*)(Qi + (c_ >> 4) * 272 + (c_ & 15) * 16) = pq[i]; *(LAS v4u*)(Ki + (c_ >> 4) * 272 + (c_ & 15) * 16) = pk[i]; }
        size_t ccd[2];
#pragma unroll
        for (int dir = 0; dir < 2; ++dir) ccd[dir] = (size_t)((b * 4 + head) * 2 + dir) * NCHUNK + scan_chunk(mm, dir);
        v4u gp[4];
#pragma unroll
        for (int j = 0; j < 4; ++j) gp[j] = *(const v4u*)(s.P + (size_t)(rowbase + (tid >> 3)) * NINP + 5120 + head * 256 + 32 * (tid & 7) + 8 * j);
        bf16x8 sf[2][8];
#pragma unroll
        for (int dir = 0; dir < 2; ++dir) { const bf16* Sg = s.SSTp + ccd[dir] * 32768 + (size_t)(32 * wave + (lane & 31)) * 128 + 8 * (lane >> 5);
#pragma unroll
            for (int ks = 0; ks < 8; ++ks) sf[dir][ks] = *(const bf16x8*)(Sg + 16 * ks); }
        if (wave < 2) { const int dir = wave; LAS float* d = sc + dir * 512;
            const float ig = bf1(s.P[(size_t)(rowbase + lane) * NINP + 6144 + dir * 8 + head]) + s.mgb[dir * 8 + head];
            const float fg = bf1(s.P[(size_t)(rowbase + lane) * NINP + 6144 + dir * 8 + 4 + head]) + s.mgb[dir * 8 + 4 + head];
            const float lf = logsig_f(fg), bcs = wave_scan_sum(lf, dir, lane);
            const float uu = ig - bcs, pm = wave_scan_max(uu, dir, lane), min_ = s.MINp[ccd[dir]], Mt = fmaxf(min_, pm);
            d[lane] = uu; d[64 + lane] = Mt; d[128 + lane] = __expf(min_ - Mt); d[192 + lane] = __expf(-bcs - Mt); }
        __syncthreads();
        const int un = qs[par ^ 1];
        if (un < nu) MO_PREF(un);
        { const int t = tid & 63, part = tid >> 6;
          float a0 = 0.f, a1 = 0.f; const float w0 = sc[128 + t], w1 = sc[512 + 128 + t];
#pragma unroll
          for (int hh = 0; hh < 2; ++hh) { float qv[8], o0[8], o1[8]; unpack8(*(LAS const v4u*)(Qi + t * 272 + (part * 16 + 8 * hh) * 2), qv);
              const float* n0p = s.NIN + ccd[0] * 128 + part * 16 + 8 * hh; const float* n1p = s.NIN + ccd[1] * 128 + part * 16 + 8 * hh;
              const f32x4 n00 = *(const f32x4*)n0p, n01 = *(const f32x4*)(n0p + 4), n10 = *(const f32x4*)n1p, n11 = *(const f32x4*)(n1p + 4);
              a0 += (qv[0] * n00.x + qv[1] * n00.y) + (qv[2] * n00.z + qv[3] * n00.w) + (qv[4] * n01.x + qv[5] * n01.y) + (qv[6] * n01.z + qv[7] * n01.w);
              a1 += (qv[0] * n10.x + qv[1] * n10.y) + (qv[2] * n10.z + qv[3] * n10.w) + (qv[4] * n11.x + qv[5] * n11.y) + (qv[6] * n11.z + qv[7] * n11.w);
#pragma unroll
              for (int e = 0; e < 8; ++e) { o0[e] = qv[e] * w0; o1[e] = qv[e] * w1; }
              *(LAS v4u*)(Qx + t * 272 + (part * 16 + 8 * hh) * 2) = pack8(o0); *(LAS v4u*)(Qx + 17408 + t * 272 + (part * 16 + 8 * hh) * 2) = pack8(o1); }
          qnp[part * 64 + t] = a0; qnp[512 + part * 64 + t] = a1; }
        {
            const int dir = wave >> 2, ti = (wave >> 1) & 1, tj = wave & 1; LAS const float* d = sc + dir * 512; f32x16 acc = zero16();
#pragma unroll
            for (int ks = 0; ks < 8; ++ks) { const bf16x8 af = frag_row(Qi, 272, 32 * ti, 16 * ks, lane), bfr = frag_row(Ki, 272, 32 * tj, 16 * ks, lane); acc = MFMA32(af, bfr, acc); }
            const int sidx = 32 * tj + (lane & 31); const float usv = d[sidx];
#pragma unroll
            for (int r = 0; r < 16; ++r) { const int t = 32 * ti + (r & 3) + 8 * (r >> 2) + 4 * (lane >> 5);
                const bool keep = dir == 0 ? (sidx <= t) : (sidx >= t);
                const float v = keep ? acc[r] * __expf(usv - d[64 + t]) : 0.f;
                *(LAS bf16*)(Am + dir * 9216 + t * 144 + sidx * 2) = f2bf(v);
                float rsum = v; rsum += __shfl_xor(rsum, 1); rsum += __shfl_xor(rsum, 2); rsum += __shfl_xor(rsum, 4); rsum += __shfl_xor(rsum, 8); rsum += __shfl_xor(rsum, 16);
                if ((lane & 31) == 0) (sc + dir * 512)[384 + tj * 64 + t] = rsum; }
        }
        __syncthreads();
        if (tid < 128) { const int dir = tid >> 6, t = tid & 63; LAS float* d = sc + dir * 512; float q = 0.f;
#pragma unroll
            for (int p = 0; p < 8; ++p) q += qnp[dir * 512 + p * 64 + t];
            const float den = d[128 + t] * q + d[384 + t] + d[448 + t]; d[256 + t] = 1.f / fmaxf(fabsf(den), d[192 + t]); }
        f32x16 ad[2][2];
#pragma unroll
        for (int dir = 0; dir < 2; ++dir) { ad[dir][0] = zero16(); ad[dir][1] = zero16();
#pragma unroll
            for (int ks = 0; ks < 8; ++ks)
#pragma unroll
                for (int rt = 0; rt < 2; ++rt) { const bf16x8 af = frag_row(Qx + dir * 17408, 272, 32 * rt, 16 * ks, lane); ad[dir][rt] = MFMA32(af, sf[dir][ks], ad[dir][rt]); }
#pragma unroll
            for (int ks = 0; ks < 4; ++ks) { const bf16x8 bfr = frag_tr(Vs, 528, 16 * ks, 32 * wave, lane);
#pragma unroll
                for (int rt = 0; rt < 2; ++rt) { const bf16x8 af = frag_row(Am + dir * 9216, 144, 32 * rt, 16 * ks, lane); ad[dir][rt] = MFMA32(af, bfr, ad[dir][rt]); } } }
        __syncthreads();
#pragma unroll
        for (int rt = 0; rt < 2; ++rt)
#pragma unroll
            for (int r = 0; r < 16; ++r) { const int t = 32 * rt + (r & 3) + 8 * (r >> 2) + 4 * (lane >> 5); ad[0][rt][r] = ad[0][rt][r] * sc[256 + t] + ad[1][rt][r] * sc[512 + 256 + t]; }
        __syncthreads();
#pragma unroll
        for (int rt = 0; rt < 2; ++rt)
#pragma unroll
            for (int r = 0; r < 16; ++r) { const int t = 32 * rt + (r & 3) + 8 * (r >> 2) + 4 * (lane >> 5); Os[t * 260 + 32 * wave + (lane & 31)] = ad[0][rt][r]; }
        __syncthreads();
        { const int t = tid >> 3, part = tid & 7; float o[32]; float ss = 0.f;
#pragma unroll
          for (int j = 0; j < 8; ++j) { const f32x4 v = *(LAS const f32x4*)(Os + t * 260 + 32 * part + 4 * j); o[4 * j] = v.x; o[4 * j + 1] = v.y; o[4 * j + 2] = v.z; o[4 * j + 3] = v.w; ss += (v.x * v.x + v.y * v.y) + (v.z * v.z + v.w * v.w); }
          ss += __shfl_xor(ss, 1); ss += __shfl_xor(ss, 2); ss += __shfl_xor(ss, 4);
          const float rn = rsqrtf(ss * (1.f / 256.f) + EPS);
          const size_t row = (size_t)(rowbase + t);
          bf16* dst = s.MIX + row * DM + 1024 + head * 256 + 32 * part;
#pragma unroll
          for (int j = 0; j < 4; ++j) { float gv[8], ov[8]; unpack8(gp[j], gv);
#pragma unroll
              for (int e = 0; e < 8; ++e) ov[e] = o[8 * j + e] * rn * s.ng[32 * part + 8 * j + e] * sigmoid_f(gv[e]);
              *(v4u*)(dst + 8 * j) = pack8(ov); } }
        __syncthreads();
        u = un;
    }
}

#undef MO_PREF
#undef MO_UNIT
template <int MODE>
__device__ __forceinline__ void ph_scan_carry(const ScanP& s, int gtid, int NT) {
    for (int e = gtid; e < 16 * 8192; e += NT) {
        const int chain = e >> 13, rem = e & 8191, dv = rem >> 5, dk = (rem & 31) * 4;
        f32x4 st = {0.f, 0.f, 0.f, 0.f}, nst = st; float m = 0.f;
        for (int c0 = 0; c0 < NCHUNK; c0 += 4) {
            f32x4 d[4], gm[4]; float bl[4], ml[4];
#pragma unroll
            for (int j = 0; j < 4; ++j) { const size_t cc = (size_t)chain * NCHUNK + c0 + j; { const v2u dw = *(const v2u*)(s.DSTp + cc * 32768 + dv * 128 + dk); d[j] = (f32x4){bf_lo(dw.x), bf_hi(dw.x), bf_lo(dw.y), bf_hi(dw.y)}; }
                if (MODE == 0) gm[j] = *(const f32x4*)(s.GAM + cc * 128 + dk);
                else { bl[j] = s.BL[cc]; ml[j] = s.ML[cc]; gm[j] = (dv == 0) ? *(const f32x4*)(s.DN + cc * 128 + dk) : (f32x4){0.f, 0.f, 0.f, 0.f}; } }
#pragma unroll
            for (int j = 0; j < 4; ++j) { const size_t cc = (size_t)chain * NCHUNK + c0 + j;
                v2u o; o.x = pk2(st.x, st.y); o.y = pk2(st.z, st.w); *(v2u*)(s.SSTp + cc * 32768 + dv * 128 + dk) = o;
                if (MODE == 0) st = gm[j] * st + d[j];
                else { if (dv == 0) { *(f32x4*)(s.NIN + cc * 128 + dk) = nst; if (dk == 0) s.MINp[cc] = m; }
                    const float mn = fmaxf(bl[j] + m, ml[j]), dec = __expf(bl[j] + m - mn), sc = __expf(ml[j] - mn);
                    st = st * dec + d[j] * sc; nst = nst * dec + gm[j] * sc; m = mn; } }
        }
    }
}

template <int MODE>
__device__ __forceinline__ void ph_scan_out(const ScanP& s, LAS unsigned char* lds, int tid, int lane, int wave, int bid, int G) {
    LAS unsigned char* Vs = lds; LAS unsigned char* Qx = lds + 33792; LAS unsigned char* Ki = lds + 51200; LAS unsigned char* Qi = lds + 68608; LAS unsigned char* Am = lds + 86016;
    LAS float* glr = (LAS float*)(lds + 95232); LAS float* tot = (LAS float*)(lds + 103424);
    LAS float* us = (LAS float*)(lds + 105472); LAS float* Mts = us + 64; LAS float* wint = us + 128; LAS float* thr = us + 192; LAS float* fac = us + 256; LAS float* qn = us + 320; LAS float* rs = us + 384;
    LAS float* qnp = (LAS float*)(lds + 107520);
    LAS float* Os = (LAS float*)lds;
    const int dk = tid & 127, grp = tid >> 7;
    for (int u = bid; u < 544; u += G) {
        int b, head, mm, rowbase; scan_unit(u, b, head, mm, rowbase);
        load_tile(Vs, 528, s.P + (size_t)rowbase * NINP + (MODE ? 4096 : 1024) + head * 256, NINP, 64, 256, tid);
        if (MODE == 0) { for (int e = tid; e < 2048; e += NTHR) glr[e] = bf1(s.P[(size_t)(rowbase + (e >> 5)) * NINP + 3072 + (e & 31)]); if (tid < 64) fac[tid] = 1.f; }
        else { load_tile(Qi, 272, s.MQK + (size_t)rowbase * 1024 + head * 128, 1024, 64, 128, tid); load_tile(Ki, 272, s.MQK + (size_t)rowbase * 1024 + 512 + head * 128, 1024, 64, 128, tid); }
        f32x16 hsum[2]; hsum[0] = zero16(); hsum[1] = zero16();
        __syncthreads();
        for (int dir = 0; dir < 2; ++dir) {
            const int chain = (b * 4 + head) * 2 + dir, c = scan_chunk(mm, dir); const size_t cc = (size_t)chain * NCHUNK + c;
            if (MODE == 0) {
                float bb[16], btot; gla_gates(s, glr, tot, head, dir, tid, bb, btot);
#pragma unroll
                for (int tt = 0; tt < 16; ++tt) { const int t = 16 * grp + tt; const size_t ro = (size_t)(rowbase + t) * NINP + head * 128 + dk;
                    const float qv = bf1(s.P[ro]), kv = bf1(s.P[ro + 512]);
                    *(LAS bf16*)(Qx + t * 272 + dk * 2) = f2bf(qv * __expf(bb[tt]) * 0.08838834764831845f);
                    *(LAS bf16*)(Ki + t * 272 + dk * 2) = f2bf(kv * __expf(-bb[tt])); }
            } else {
                if (wave == 0) {
                    const float ig = bf1(s.P[(size_t)(rowbase + lane) * NINP + 6144 + dir * 8 + head]) + s.mgb[dir * 8 + head];
                    const float fg = bf1(s.P[(size_t)(rowbase + lane) * NINP + 6144 + dir * 8 + 4 + head]) + s.mgb[dir * 8 + 4 + head];
                    const float lf = logsig_f(fg), bcs = wave_scan_sum(lf, dir, lane);
                    const float uu = ig - bcs, pm = wave_scan_max(uu, dir, lane), min_ = s.MINp[cc], Mt = fmaxf(min_, pm);
                    us[lane] = uu; Mts[lane] = Mt; wint[lane] = __expf(min_ - Mt); thr[lane] = __expf(-bcs - Mt);
                }
                __syncthreads();
                { const int t = tid & 63, part = tid >> 6; float acc = 0.f;
                  const float wi = wint[t];
#pragma unroll
                  for (int hh = 0; hh < 2; ++hh) { float qv[8], ov[8]; unpack8(*(LAS const v4u*)(Qi + t * 272 + (part * 16 + 8 * hh) * 2), qv);
                      const f32x4 n0 = *(const f32x4*)(s.NIN + cc * 128 + part * 16 + 8 * hh), n1 = *(const f32x4*)(s.NIN + cc * 128 + part * 16 + 8 * hh + 4);
                      acc += (qv[0] * n0.x + qv[1] * n0.y) + (qv[2] * n0.z + qv[3] * n0.w) + (qv[4] * n1.x + qv[5] * n1.y) + (qv[6] * n1.z + qv[7] * n1.w);
#pragma unroll
                      for (int e = 0; e < 8; ++e) ov[e] = qv[e] * wi;
                      *(LAS v4u*)(Qx + t * 272 + (part * 16 + 8 * hh) * 2) = pack8(ov); }
                  qnp[part * 64 + t] = acc; }
            }
            __syncthreads();
            if (MODE == 1 && tid < 64) { float q = 0.f;
#pragma unroll
                for (int p = 0; p < 8; ++p) q += qnp[p * 64 + tid];
                qn[tid] = q; }
            if (wave < 4) {
                const int ti = wave >> 1, tj = wave & 1; f32x16 acc = zero16();
#pragma unroll
                for (int ks = 0; ks < 8; ++ks) { const bf16x8 af = frag_row(MODE ? Qi : Qx, 272, 32 * ti, 16 * ks, lane), bfr = frag_row(Ki, 272, 32 * tj, 16 * ks, lane); acc = MFMA32(af, bfr, acc); }
                const int sidx = 32 * tj + (lane & 31);
                const float usv = MODE ? us[sidx] : 0.f;
#pragma unroll
                for (int r = 0; r < 16; ++r) { const int t = 32 * ti + (r & 3) + 8 * (r >> 2) + 4 * (lane >> 5);
                    const bool keep = dir == 0 ? (sidx <= t) : (sidx >= t);
                    float v = acc[r];
                    if (MODE == 1) v *= __expf(usv - Mts[t]);
                    v = keep ? v : 0.f;
                    *(LAS bf16*)(Am + t * 144 + sidx * 2) = f2bf(v);
                    if (MODE == 1) { float rsum = v; rsum += __shfl_xor(rsum, 1); rsum += __shfl_xor(rsum, 2); rsum += __shfl_xor(rsum, 4); rsum += __shfl_xor(rsum, 8); rsum += __shfl_xor(rsum, 16);
                        if ((lane & 31) == 0) rs[tj * 64 + t] = rsum; } }
            }
            __syncthreads();
            if (MODE == 1 && tid < 64) { const float den = wint[tid] * qn[tid] + rs[tid] + rs[64 + tid]; fac[tid] = 1.f / fmaxf(fabsf(den), thr[tid]); }
            f32x16 acc2[2]; acc2[0] = zero16(); acc2[1] = zero16();
            { const bf16* Sg = s.SSTp + cc * 32768 + (size_t)(32 * wave + (lane & 31)) * 128 + 8 * (lane >> 5);
#pragma unroll
              for (int ks = 0; ks < 8; ++ks) { const bf16x8 bfr = *(const bf16x8*)(Sg + 16 * ks);
#pragma unroll
                  for (int rt = 0; rt < 2; ++rt) { const bf16x8 af = frag_row(Qx, 272, 32 * rt, 16 * ks, lane); acc2[rt] = MFMA32(af, bfr, acc2[rt]); } } }
#pragma unroll
            for (int ks = 0; ks < 4; ++ks) { const bf16x8 bfr = frag_tr(Vs, 528, 16 * ks, 32 * wave, lane);
#pragma unroll
                for (int rt = 0; rt < 2; ++rt) { const bf16x8 af = frag_row(Am, 144, 32 * rt, 16 * ks, lane); acc2[rt] = MFMA32(af, bfr, acc2[rt]); } }
            __syncthreads();
#pragma unroll
            for (int rt = 0; rt < 2; ++rt)
#pragma unroll
                for (int r = 0; r < 16; ++r) { const int t = 32 * rt + (r & 3) + 8 * (r >> 2) + 4 * (lane >> 5); hsum[rt][r] += acc2[rt][r] * fac[t]; }
        }
        __syncthreads();
#pragma unroll
        for (int rt = 0; rt < 2; ++rt)
#pragma unroll
            for (int r = 0; r < 16; ++r) { const int t = 32 * rt + (r & 3) + 8 * (r >> 2) + 4 * (lane >> 5); Os[t * 260 + 32 * wave + (lane & 31)] = hsum[rt][r]; }
        __syncthreads();
        { const int t = tid >> 3, part = tid & 7; float o[32]; float ss = 0.f;
#pragma unroll
          for (int j = 0; j < 8; ++j) { const f32x4 v = *(LAS const f32x4*)(Os + t * 260 + 32 * part + 4 * j); o[4 * j] = v.x; o[4 * j + 1] = v.y; o[4 * j + 2] = v.z; o[4 * j + 3] = v.w; ss += (v.x * v.x + v.y * v.y) + (v.z * v.z + v.w * v.w); }
          ss += __shfl_xor(ss, 1); ss += __shfl_xor(ss, 2); ss += __shfl_xor(ss, 4);
          const float rn = rsqrtf(ss * (1.f / 256.f) + EPS);
          const size_t row = (size_t)(rowbase + t);
          const bf16* gsrc = s.P + row * NINP + (MODE ? 5120 : 2048) + head * 256 + 32 * part;
          bf16* dst = s.MIX + row * DM + (MODE ? 1024 : 0) + head * 256 + 32 * part;
#pragma unroll
          for (int j = 0; j < 4; ++j) { float gv[8], ov[8]; unpack8(*(const v4u*)(gsrc + 8 * j), gv);
#pragma unroll
              for (int e = 0; e < 8; ++e) { const float gt = MODE ? sigmoid_f(gv[e]) : silu_f(gv[e]); ov[e] = o[8 * j + e] * rn * s.ng[32 * part + 8 * j + e] * gt; }
              *(v4u*)(dst + 8 * j) = pack8(ov); } }
        __syncthreads();
    }
}

__device__ __forceinline__ void glds16(const void* sbase  , unsigned voff  , unsigned lds_dst  ) { unsigned keep;
    asm volatile("s_mov_b32 %0, m0\n\ts_mov_b32 m0, %3\n\ts_nop 0\n\tglobal_load_lds_dwordx4 %1, %2\n\ts_mov_b32 m0, %0" : "=&s"(keep) : "v"(voff), "s"(sbase), "s"(lds_dst) : "memory"); }
struct AttnP { const bf16* QR; const bf16* KR; const bf16* P; bf16* MIX; const float* lamp; const float* subg; const float* qg; const float* kg; float lam_init; unsigned* queue; int nq; };
template <bool SUB>
__device__ __forceinline__ void ph_attn(const AttnP& p, LAS unsigned char* lds, int tid, int lane, int wave, int bid, int G) {
    const float l01 = wave_sum(p.lamp[lane] * p.lamp[64 + lane]), l23 = wave_sum(p.lamp[128 + lane] * p.lamp[192 + lane]);
    const float lam = __expf(l01) - __expf(l23) + p.lam_init;
    const float negm2 = -8.f * wave_max(fabsf(p.qg[lane])) * wave_max(fabsf(p.kg[lane])) * 1.4426950408889634f * 1.02f;
    const int r = lane & 31, h = lane >> 5, mp = wave >> 2, wq = wave & 3;
    LAS float* Ex = (LAS float*)lds;
    const unsigned xcc = xb_xcc_id() & 7u;
    volatile LAS int* qslot = (volatile LAS int*)(lds + MISC_OFF + 96);
    for (int qq = 0; qq < 8; ++qq) for (;;) {
        const int hd = (int)((xcc + (unsigned)qq) & 7u);
        if (tid == 0) qslot[0] = (int)__hip_atomic_fetch_add(p.queue + 16 * hd, 1u, __ATOMIC_RELAXED, __HIP_MEMORY_SCOPE_AGENT);
        __syncthreads();
        const int idx = qslot[0];
        __syncthreads();
        if (idx >= p.nq) break;
        int b, qrow0, nkt;
        if (idx < 64) { b = idx >> 5; qrow0 = b * 4096 + 128 * (idx & 31); nkt = 68; }
        else { const int uu = idx - 64; b = uu >> 1; qrow0 = NLATR + b * 256 + 128 * (uu & 1); nkt = 4; }
        const int qrow = qrow0 + 32 * wq + r;
        bf16x8 Qf[4];
#pragma unroll
        for (int ks = 0; ks < 4; ++ks) Qf[ks] = *(const bf16x8*)(p.QR + (size_t)qrow * 1024 + (hd * 2 + mp) * 64 + 16 * ks + 8 * h);
        f32x16 O[4];
#pragma unroll
        for (int dt = 0; dt < 4; ++dt) O[dt] = zero16();
        float ls = 0.f;
        const int dq = lane >> 4, dp = lane & 15;
        unsigned voffK[4], voffV[4];
#pragma unroll
        for (int j = 0; j < 4; ++j) { const unsigned ch = 16u * (unsigned)(dp ^ ((dq << 2) | j)); voffK[j] = (unsigned)dq * 2048u + ch; voffV[j] = (unsigned)dq * (unsigned)(NINP * 2) + ch; }
        int kaddr[4], vaddr[2][4];
#pragma unroll
        for (int ks = 0; ks < 4; ++ks) kaddr[ks] = swz_off(r, 8 * mp + 2 * ks + h);
        { const int blk = (lane >> 4) & 1, q = (lane & 15) >> 2, pp = lane & 3;
#pragma unroll
          for (int e = 0; e < 2; ++e)
#pragma unroll
              for (int dt = 0; dt < 4; ++dt) vaddr[e][dt] = swz_off(4 * h + q + 8 * e, 4 * dt + 2 * blk + (pp >> 1)) + 8 * (pp & 1); }
        const int nkt2 = nkt >> 1;
        const unsigned ldsb = (unsigned)(size_t)lds;
#define AT_DMA(kt_, buf_) do { const int krow_ = (kt_) < 2 ? NLATR + b * 256 + 128 * (kt_) : b * 4096 + 128 * ((kt_) - 2); \
            _Pragma("unroll") for (int j = 0; j < 4; ++j) { const int g_ = 4 * wave + j, row_ = krow_ + 4 * g_; \
                glds16(p.KR + (size_t)row_ * 1024 + hd * 128, voffK[j], (unsigned)__builtin_amdgcn_readfirstlane((int)(ldsb + (buf_) * 32768 + 1024 * g_))); \
                glds16(p.P + (size_t)row_ * NINP + 2048 + hd * 128, voffV[j], (unsigned)__builtin_amdgcn_readfirstlane((int)(ldsb + 65536 + (buf_) * 32768 + 1024 * g_))); } } while (0)
#define AT_QK(S_, kb_) do { S_ = zero16(); _Pragma("unroll") for (int ks = 0; ks < 4; ++ks) { const bf16x8 a0 = *(LAS const bf16x8*)(Kt + kaddr[ks] + 8192 * (kb_)); S_ = MFMA32(a0, Qf[ks], S_); } } while (0)
        AT_DMA(0, 0);
        asm volatile("s_waitcnt vmcnt(0)" ::: "memory");
        __syncthreads();
        for (int kt = 0; kt < nkt2; ++kt) {
            const bool more = kt + 1 < nkt2;
            if (more) AT_DMA(kt + 1, (kt + 1) & 1);
            LAS const unsigned char* Kt = lds + (kt & 1) * 32768; LAS const unsigned char* Vt = lds + 65536 + (kt & 1) * 32768;
#define AT_VF(dst_, kb_, dt_) do { const s16x4 t0_ = tr4(Vt + vaddr[0][dt_] + 8192 * (kb_)), t1_ = tr4(Vt + vaddr[1][dt_] + 8192 * (kb_)), t2_ = tr4(Vt + vaddr[0][dt_] + 8192 * (kb_) + 4096), t3_ = tr4(Vt + vaddr[1][dt_] + 8192 * (kb_) + 4096); \
                dst_[0] = (bf16x8){t0_[0], t0_[1], t0_[2], t0_[3], t1_[0], t1_[1], t1_[2], t1_[3]}; dst_[1] = (bf16x8){t2_[0], t2_[1], t2_[2], t2_[3], t3_[0], t3_[1], t3_[2], t3_[3]}; } while (0)
            bf16x8 kf[4], P0, P1;
#pragma unroll
            for (int ks = 0; ks < 4; ++ks) kf[ks] = *(LAS const bf16x8*)(Kt + kaddr[ks]);
            { f32x16 S0 = zero16();
#pragma unroll
              for (int ks = 0; ks < 4; ++ks) S0 = MFMA32(kf[ks], Qf[ks], S0);
#pragma unroll
              for (int ks = 0; ks < 4; ++ks) kf[ks] = *(LAS const bf16x8*)(Kt + kaddr[ks] + 8192);
              unsigned pf[8]; float lacc = 0.f;
#pragma unroll
              for (int i = 0; i < 8; ++i) { const float e0 = __builtin_amdgcn_exp2f(SUB ? S0[2 * i] + negm2 : S0[2 * i]), e1 = __builtin_amdgcn_exp2f(SUB ? S0[2 * i + 1] + negm2 : S0[2 * i + 1]); lacc += e0 + e1; pf[i] = pk2(e0, e1); }
              ls += lacc;
              P0 = __builtin_bit_cast(bf16x8, (v4u){pf[0], pf[1], pf[2], pf[3]}); P1 = __builtin_bit_cast(bf16x8, (v4u){pf[4], pf[5], pf[6], pf[7]}); }
            __builtin_amdgcn_sched_barrier(0);
#pragma unroll
            for (int kb = 0; kb < 4; ++kb) {
                bf16x8 v0[2], v1[2], v2[2], v3[2];
                AT_VF(v0, kb, 0); AT_VF(v1, kb, 1); AT_VF(v2, kb, 2); AT_VF(v3, kb, 3);
                f32x16 Sn = zero16();
                if (kb < 3) {
#pragma unroll
                    for (int ks = 0; ks < 4; ++ks) Sn = MFMA32(kf[ks], Qf[ks], Sn);
                    if (kb < 2) {
#pragma unroll
                        for (int ks = 0; ks < 4; ++ks) kf[ks] = *(LAS const bf16x8*)(Kt + kaddr[ks] + 8192 * (kb + 2)); } }
                O[0] = MFMA32(v0[0], P0, O[0]); O[0] = MFMA32(v0[1], P1, O[0]); O[1] = MFMA32(v1[0], P0, O[1]); O[1] = MFMA32(v1[1], P1, O[1]);
                O[2] = MFMA32(v2[0], P0, O[2]); O[2] = MFMA32(v2[1], P1, O[2]); O[3] = MFMA32(v3[0], P0, O[3]); O[3] = MFMA32(v3[1], P1, O[3]);
                if (kb < 3) {
                    unsigned pf[8]; float lacc = 0.f;
#pragma unroll
                    for (int i = 0; i < 8; ++i) { const float e0 = __builtin_amdgcn_exp2f(SUB ? Sn[2 * i] + negm2 : Sn[2 * i]), e1 = __builtin_amdgcn_exp2f(SUB ? Sn[2 * i + 1] + negm2 : Sn[2 * i + 1]); lacc += e0 + e1; pf[i] = pk2(e0, e1); }
                    ls += lacc;
                    P0 = __builtin_bit_cast(bf16x8, (v4u){pf[0], pf[1], pf[2], pf[3]}); P1 = __builtin_bit_cast(bf16x8, (v4u){pf[4], pf[5], pf[6], pf[7]});
                    __builtin_amdgcn_sched_group_barrier(0x100, 20, 0); __builtin_amdgcn_sched_group_barrier(0x008, 6, 0);
#pragma unroll
                    for (int gI = 0; gI < 6; ++gI) { __builtin_amdgcn_sched_group_barrier(0x002, 8, 0); __builtin_amdgcn_sched_group_barrier(0x008, 1, 0); }
                }
                __builtin_amdgcn_sched_barrier(0);
            }
#undef AT_VF
            asm volatile("s_waitcnt vmcnt(0)" ::: "memory");
            __syncthreads();
        }
#undef AT_DMA
#undef AT_QK
        const float l = ls + __shfl_xor(ls, 32);
        if (mp == 1) { const float sc = lam / l;
#pragma unroll
            for (int dt = 0; dt < 4; ++dt)
#pragma unroll
                for (int i = 0; i < 16; ++i) Ex[(32 * wq + r) * 132 + 32 * dt + (i & 3) + 8 * (i >> 2) + 4 * h] = O[dt][i] * sc; }
        __syncthreads();
        if (mp == 0) { const float a0 = 1.f / l; float ss = 0.f;
#pragma unroll
            for (int dt = 0; dt < 4; ++dt)
#pragma unroll
                for (int i = 0; i < 16; ++i) { const float v = O[dt][i] * a0 - Ex[(32 * wq + r) * 132 + 32 * dt + (i & 3) + 8 * (i >> 2) + 4 * h]; O[dt][i] = v; ss += v * v; }
            ss += __shfl_xor(ss, 32);
            const float rn = rsqrtf(ss * (1.f / 128.f) + EPS) * (1.f - p.lam_init);
            int qrow2 = qrow0 + 32 * wq + r; asm volatile("" : "+v"(qrow2));
            bf16* dst = p.MIX + (size_t)qrow2 * DM + hd * 128;
#pragma unroll
            for (int dt = 0; dt < 4; ++dt)
#pragma unroll
                for (int g4 = 0; g4 < 4; ++g4) { const int dv0 = 32 * dt + 8 * g4 + 4 * h; const f32x4 sg = *(const f32x4*)(p.subg + dv0);
                    v2u o; o.x = pk2(O[dt][4 * g4] * rn * sg.x, O[dt][4 * g4 + 1] * rn * sg.y); o.y = pk2(O[dt][4 * g4 + 2] * rn * sg.z, O[dt][4 * g4 + 3] * rn * sg.w);
                    *(v2u*)(dst + dv0) = o; } }
        __syncthreads();
    }
}

#ifndef PHASE_MASK
#define PHASE_MASK 0xFFFFFFu
#endif
#define PM(j) ((PHASE_MASK >> (j)) & 1u)
#ifndef REP_MASK
#define REP_MASK 0u
#endif
#define REPS(j) ((((REP_MASK) >> (j)) & 1u) ? 2 : 1)
#define PH_BEGIN(j, k) if (PM(j) && IN(k)) for (int rep_ = 0; rep_ < REPS(j); ++rep_) { if (rep_) xcd_barrier(bar);
#define PH_END }
#define PHASE_BEGIN int wave = wave0, bid = bid0, G = G0, zz_ = 0; asm volatile("" : "+s"(wave), "+s"(bid), "+s"(G), "+s"(zz_)); const int lane = (int)__builtin_amdgcn_mbcnt_hi(~0u, __builtin_amdgcn_mbcnt_lo(~0u, (unsigned)zz_)), tid = wave * 64 + lane; \
    unsigned char* ws = ws0; asm volatile("" : "+s"(ws)); const __attribute__((address_space(4))) Args* ap_ = (const __attribute__((address_space(4))) Args*)__builtin_amdgcn_kernarg_segment_ptr(); asm volatile("" : "+s"(ap_)); const Args& a = *(const Args*)ap_; (void)a; const int gw = bid * NWAVES + wave, NGW = G * NWAVES, gtid = bid * NTHR + tid, NT = G * NTHR; (void)gw; (void)NGW; (void)gtid; (void)NT; (void)lane;
__device__ __forceinline__ void fill_scanp(ScanP& sp, const Args& a, unsigned char* ws, int li, bool even) {
    sp.P = (const bf16*)(ws + WS_P); sp.MQK = (const bf16*)(ws + WS_MQK); sp.MIX = (bf16*)(ws + WS_MIX);
    sp.gw2 = a.in[10] + (size_t)li * 2 * 16 * 512; sp.gb = a.in[11] + (size_t)li * 2 * 512; sp.mgb = a.in[21] + (size_t)li * 16;
    sp.ng = even ? a.in[12] + (size_t)li * 256 : a.in[22] + (size_t)li * 256;
    sp.DSTp = (bf16*)(ws + WS_DST); sp.SSTp = (bf16*)(ws + WS_SST); sp.GAM = (float*)(ws + WS_SM + SM_GAM); sp.DN = (float*)(ws + WS_SM + SM_DN); sp.NIN = (float*)(ws + WS_SM + SM_NIN);
    sp.BL = (float*)(ws + WS_SM + SM_BL); sp.ML = (float*)(ws + WS_SM + SM_ML); sp.MINp = (float*)(ws + WS_SM + SM_MIN);
}
__global__ void __launch_bounds__(NTHR, 2) fwd_kernel(Args a) {
    extern __shared__ __attribute__((aligned(16))) unsigned char lds_raw[];
    LAS unsigned char* lds = (LAS unsigned char*)lds_raw;
    const int tid0 = threadIdx.x, wave0 = __builtin_amdgcn_readfirstlane(tid0 >> 6), bid0 = blockIdx.x, G0 = gridDim.x;
    unsigned char* ws0 = a.ws;
    volatile LAS unsigned* MISC = (volatile LAS unsigned*)(lds + MISC_OFF);
    if (tid0 < 32) MISC[tid0] = 0u;
    __syncthreads();
    XcdBarrier bar = xcd_barrier_post((unsigned*)(ws0 + WS_CTL) + CW_BAR + a.li * XCD_BAR_WORDS, MISC + 8, (unsigned)wave0);
    const int lo = a.ph_lo, hi = a.ph_hi;
#define IN(k) (lo <= (k) && (k) < hi)
#ifndef TMASK
#define TMASK 0u
#endif
#ifndef LMASK
#define LMASK 0xFu
#endif
    volatile LAS unsigned long long* tst_ = (volatile LAS unsigned long long*)(lds + MISC_OFF + 64);
    if (TMASK && tid0 == 0) { tst_[0] = __builtin_amdgcn_s_memrealtime(); tst_[1] = 0ull; }
#define SEAM2(k, kk, ll) do { if (IN(k) && IN((k) + 1)) xcd_barrier(bar); if (TMASK && wave0 == 0 && xb_lane() == 0u) { const unsigned long long now_ = __builtin_amdgcn_s_memrealtime(); if (((TMASK >> (kk)) & 1u) && ((LMASK >> (ll)) & 1u)) tst_[1] += now_ - tst_[0]; tst_[0] = now_; } } while (0)
#define SEAM(k) SEAM2(k, (k) == 0 ? 11 : ((k) - 1) % PPL, (k) == 0 ? 0 : ((k) - 1) / PPL)

    PH_BEGIN(11, 0) PHASE_BEGIN; ph_prologue(a, ws, lds, tid, lane, wave, bid, G); PH_END
    SEAM(0);
    for (int layer = 0; layer < NLAYERS; ++layer) {
        const int pb = 1 + layer * PPL, li = layer >> 1; const bool even = (layer & 1) == 0;
        const size_t mod_off = WS_MOD + (size_t)layer * 3 * 12288 * 4;
        const size_t wb_off = WS_W + (size_t)layer * W_LAYER;

        PH_BEGIN(0, pb + 0) PHASE_BEGIN; const float* mod = (const float*)(ws + mod_off); float* ssq = (float*)(ws + WS_SSQ) + (size_t)(2 * layer) * MR;
            if (layer == 0) ph_norm0(a.in[0], a.in[2], (float*)(ws + WS_XS), a.in[6], mod + 1 * DM, (bf16*)(ws + WS_H), ssq, gw, NGW, lane);
            else ph_ctxfix<11>((float*)(ws + WS_XS), (const float*)(ws + WS_DST), mod - 3 * 12288 + 2 * 12288 + 5 * DM, a.in[6] + (size_t)layer * DM, mod + 1 * DM, (bf16*)(ws + WS_H), ssq, gw, NGW, lane);
            { PHASE_BEGIN; const float* mod2 = (const float*)(ws + mod_off); ph_bias((const bf16*)(ws + wb_off), (const bf16*)(ws + wb_off + W_UP), mod2, (float*)(ws + WS_B1) + (size_t)layer * 3 * NINP, (float*)(ws + WS_B2) + (size_t)layer * 3 * NUP, gw, NGW, lane); } }
        SEAM(pb + 0);
        PH_BEGIN(1, pb + 1) PHASE_BEGIN; pg8::Gemm g{(const bf16*)(ws + WS_H), (const bf16*)(ws + wb_off), MR, NINP, DM}; pg8::StaticOrder S; S.init(MR, NINP, G, bid); pg8::EpiStore E{(bf16*)(ws + WS_P), NINP, (const float*)(ws + WS_SSQ) + (size_t)(2 * layer) * MR, (const float*)(ws + WS_B1) + (size_t)layer * 3 * NINP, NINP};
            pg8::gemm_phase<pg8::EpiStore, pg8::StaticOrder, true, true>(lds, g, S, E, wave);
            if (layer + 1 < NLAYERS && G == 256 && bid >= 82) { __syncthreads(); ph_convert(a, ws, lds, (layer + 1) * 25344, (layer + 2) * 25344, (bid - 82) * NWAVES + wave, 174 * NWAVES, wave, lane); }
            else if (layer + 1 < NLAYERS && G != 256) { __syncthreads(); ph_convert(a, ws, lds, (layer + 1) * 25344, (layer + 2) * 25344, bid * NWAVES + wave, G * NWAVES, wave, lane); } }
        SEAM(pb + 1);
        PH_BEGIN(2, pb + 2)
            if (even) {
                if (PM(12)) { PHASE_BEGIN; ph_conv8<1>((const bf16*)(ws + WS_P), a.in[13] + (size_t)li * 3 * 1024, (bf16*)(ws + WS_MIX), gtid, NT); }
                if (PM(13)) { PHASE_BEGIN; ScanP sp; fill_scanp(sp, a, ws, li, even); ph_gla_local(sp, (bf16*)(ws + WS_QR), (bf16*)(ws + WS_KR), lds, tid, lane, wave, bid, G); }
            } else {
                if (PM(14)) { PHASE_BEGIN; ph_qkprep((const bf16*)(ws + WS_P), a.in[16] + (size_t)li * 64, a.in[17] + (size_t)li * 64, (const float*)(ws + WS_ROPE), (bf16*)(ws + WS_QR), (bf16*)(ws + WS_KR), gw, NGW, lane); }
                if (PM(15)) { PHASE_BEGIN; ph_conv8<2>((const bf16*)(ws + WS_P), a.in[20] + (size_t)li * 3 * 1024, (bf16*)(ws + WS_MQK), gtid, NT); }
            }
        }
        SEAM(pb + 2);
        PH_BEGIN(3, pb + 3) if (!even) { PHASE_BEGIN; ScanP sp; fill_scanp(sp, a, ws, li, even); ph_mlstm_local(sp, lds, tid, lane, wave, bid, G); } }
        if (!even) SEAM(pb + 3);
        PH_BEGIN(4, pb + 4) PHASE_BEGIN; ScanP sp; fill_scanp(sp, a, ws, li, even); if (even) ph_scan_carry<0>(sp, gtid, NT); else ph_scan_carry<1>(sp, gtid, NT); }
        SEAM(pb + 4);
        PH_BEGIN(5, pb + 5)
            if (even) { if (PM(16)) { PHASE_BEGIN; ScanP sp; fill_scanp(sp, a, ws, li, even); ph_gla_out(sp, (const bf16*)(ws + WS_QR), (const bf16*)(ws + WS_KR), lds, tid, lane, wave, bid, G); } }
            else {
                if (PM(17)) { PHASE_BEGIN; AttnP ap{(const bf16*)(ws + WS_QR), (const bf16*)(ws + WS_KR), (const bf16*)(ws + WS_P), (bf16*)(ws + WS_MIX), a.in[18] + (size_t)li * 256, a.in[19] + (size_t)li * 128, a.in[16] + (size_t)li * 64, a.in[17] + (size_t)li * 64, 0.8f - 0.6f * expf(-0.3f * (float)layer), (unsigned*)(ws + 32768 + 1024 * li), layer == NLAYERS - 1 ? 64 : 68};
                    const float bound = 8.f * wave_max(fabsf(ap.qg[lane])) * wave_max(fabsf(ap.kg[lane])) * 1.4426950408889634f;
                    if (bound < 60.f) ph_attn<false>(ap, lds, tid, lane, wave, bid, G); else ph_attn<true>(ap, lds, tid, lane, wave, bid, G);
                    if (TMASK && wave0 == 0 && xb_lane() == 0u) { const unsigned long long now_ = __builtin_amdgcn_s_memrealtime(); if (((TMASK >> 12) & 1u) && ((LMASK >> layer) & 1u)) tst_[1] += now_ - tst_[0]; tst_[0] = now_; } }
                if (PM(18)) { PHASE_BEGIN; ScanP sp; fill_scanp(sp, a, ws, li, even); ph_mlstm_out(sp, lds, tid, lane, wave, bid, G, layer == NLAYERS - 1 ? 1 : 0, (unsigned*)(ws + 32768 + 1024 * li + 512)); }
            }
        }
        SEAM(pb + 5);
        PH_BEGIN(6, pb + 6) PHASE_BEGIN; pg8::Gemm g{(const bf16*)(ws + WS_MIX), (const bf16*)(ws + wb_off + W_OUT), MR, DM, DM}; pg8::ResidOrder S; S.init(G, bid, layer < NLAYERS - 1 ? 8 : 0, 256);
            pg8::EpiResid2 E{(float*)(ws + WS_XS), (const float*)(ws + mod_off) + 2 * DM, nullptr, (float*)(ws + WS_DST), 0, 256, rep_,
                (bf16*)(ws + WS_H), a.in[7] + (size_t)layer * DM, (const float*)(ws + mod_off) + 4 * DM, (float*)(ws + WS_SSQ) + (size_t)(2 * layer + 1) * MR};
            pg8::gemm_phase<pg8::EpiResid2, pg8::ResidOrder, true, true>(lds, g, S, E, wave); }
        SEAM(pb + 6);
        PH_BEGIN(7, pb + 7) PHASE_BEGIN; const float* mod = (const float*)(ws + mod_off);
            if (layer < NLAYERS - 1) ph_ctxfix<8>((float*)(ws + WS_XS), (const float*)(ws + WS_DST), mod + 2 * 12288 + 2 * DM, a.in[7] + (size_t)layer * DM, mod + 4 * DM, (bf16*)(ws + WS_H), (float*)(ws + WS_SSQ) + (size_t)(2 * layer + 1) * MR, gw, NGW, lane); }
        if (layer < NLAYERS - 1) SEAM(pb + 7);
        PH_BEGIN(8, pb + 8) PHASE_BEGIN; pg8::Gemm g{(const bf16*)(ws + WS_H), (const bf16*)(ws + wb_off + W_UP), MR, NUP, DM}; pg8::StaticOrder S; S.init(MR, NUP, G, bid);
            pg8::EpiAct E{(bf16*)(ws + WS_ACT), a.in[24] + (size_t)layer * 3 * DFF, a.in[25] + (size_t)layer * DFF, (float*)(ws + WS_U), (LAS float*)(lds + 131584), (const float*)(ws + WS_SSQ) + (size_t)(2 * layer + 1) * MR, (const float*)(ws + WS_B2) + (size_t)layer * 3 * NUP, 0};
            pg8::gemm_phase<pg8::EpiAct, pg8::StaticOrder, true, true>(lds, g, S, E, wave); }
        SEAM(pb + 8);
        PH_BEGIN(10, pb + 10)
            { PHASE_BEGIN; pg8::ResidOrder S0; S0.init(G, bid, layer < NLAYERS - 1 ? 11 : 0, 512); pg8::Unit uu_;
#pragma unroll 1
              for (int i_ = 0; S0.next(i_, uu_); ++i_) act_fix_tile((const float*)(ws + WS_U), a.in[24] + (size_t)layer * 3 * DFF, (bf16*)(ws + WS_ACT), uu_.pm, tid);
              asm volatile("s_waitcnt vmcnt(0)" ::: "memory"); __syncthreads(); }
            PHASE_BEGIN; pg8::Gemm g{(const bf16*)(ws + WS_ACT), (const bf16*)(ws + wb_off + W_DN), MR, DM, DFF}; pg8::ResidOrder S; S.init(G, bid, layer < NLAYERS - 1 ? 11 : 0, 512);
            pg8::EpiResid2 E{(float*)(ws + WS_XS), (const float*)(ws + mod_off) + 5 * DM, a.out, (float*)(ws + WS_DST), layer == NLAYERS - 1 ? 1 : 0, 512, rep_,
                layer < NLAYERS - 1 ? (bf16*)(ws + WS_H) : nullptr, a.in[6] + (size_t)(layer + 1) * DM, (const float*)(ws + mod_off) + 3 * 12288 + 1 * DM, (float*)(ws + WS_SSQ) + (size_t)(2 * layer + 2) * MR};
            pg8::gemm_phase<pg8::EpiResid2, pg8::ResidOrder, true, true>(lds, g, S, E, wave); }
        if (layer < NLAYERS - 1) SEAM(pb + 10); else if (TMASK && wave0 == 0 && xb_lane() == 0u) { const unsigned long long now_ = __builtin_amdgcn_s_memrealtime(); if (((TMASK >> 10) & 1u) && ((LMASK >> layer) & 1u)) tst_[1] += now_ - tst_[0]; tst_[0] = now_; }
    }
    if (TMASK) { __syncthreads(); const unsigned long long tacc_ = tst_[1], t0_ = __builtin_amdgcn_s_memrealtime(); while (__builtin_amdgcn_s_memrealtime() - t0_ < tacc_) __builtin_amdgcn_s_sleep(8); }
#undef IN
#undef SEAM
}

extern "C" void kernel_launch(void* const* d_in, const int* in_sizes, int n_in, void* d_out, int out_size, void* d_ws, size_t ws_size, hipStream_t stream) {
    static int grid = 0;
    if (grid == 0) {
        int dev = 0, cus = 0;
        if (n_in != 27 || out_size != NLATR * DM || ws_size < WS_END) { fprintf(stderr, "kernel_launch: unexpected problem (n_in %d out %d ws %zu)\n", n_in, out_size, ws_size); grid = -1; return; }
        if (hipGetDevice(&dev) != hipSuccess || hipDeviceGetAttribute(&cus, hipDeviceAttributeMultiprocessorCount, dev) != hipSuccess) { grid = -1; return; }
        if (hipFuncSetAttribute((const void*)fwd_kernel, hipFuncAttributeMaxDynamicSharedMemorySize, LDS_BYTES) != hipSuccess) { fprintf(stderr, "kernel_launch: hipFuncSetAttribute failed\n"); grid = -1; return; }
        int per_cu = 0;
        if (hipOccupancyMaxActiveBlocksPerMultiprocessor(&per_cu, (const void*)fwd_kernel, NTHR, LDS_BYTES) != hipSuccess || per_cu < 1) fprintf(stderr, "kernel_launch: occupancy query reports %d\n", per_cu);
        (void)hipGetLastError();
        grid = cus;
    }
    if (grid < 0) return;
    (void)hipMemsetAsync((char*)d_ws + WS_CTL, 0, CTL_BYTES, stream);
    Args a{};
    for (int i = 0; i < 27; ++i) a.in[i] = (const float*)d_in[i];
    a.out = (float*)d_out; a.ws = (unsigned char*)d_ws; a.pad = 0;
#if ONE_LAUNCH
    a.ph_lo = 0; a.ph_hi = 1 + NLAYERS * PPL; a.li = 0;
    hipLaunchKernelGGL(fwd_kernel, dim3(grid), dim3(NTHR), LDS_BYTES, stream, a);
#else
    for (int p = 0; p < 1 + NLAYERS * PPL; ++p) {
        const int k = p == 0 ? 0 : (p - 1) % PPL, layer = p == 0 ? 0 : (p - 1) / PPL;
        if (p > 0 && k == 3 && (layer & 1) == 0) continue;
        a.ph_lo = p; a.ph_hi = p + 1; a.li = p;
        hipLaunchKernelGGL(fwd_kernel, dim3(grid), dim3(NTHR), LDS_BYTES, stream, a);
    }
#endif
}
```

```cpp
#include <hip/hip_runtime.h>
#include <cstdio>
#include <cstdint>
namespace pg8 {
#define PG8_LAS __attribute__((address_space(3)))
typedef unsigned short bf16_t;
typedef short bf16x8 __attribute__((ext_vector_type(8)));
typedef float f32x4 __attribute__((ext_vector_type(4)));
typedef unsigned u32x4 __attribute__((ext_vector_type(4)));
constexpr int BM = 256, BK = 64, HALF = 128, HTB = HALF * BK * 2  , STAGE_BYTES = 8 * HTB, NXCD = 8, WGM = 8;

__host__ __device__ __forceinline__ int lds_byte(int r, int c) { const int st = (r >> 4) * 2 + (c >> 5), rr = r & 15, cc = c & 31, ob = rr * 64 + cc * 2; return st * 1024 + (ob ^ (((ob >> 9) & 1) << 5)); }
__host__ __device__ __forceinline__ void stage_rc(int b, int& R, int& C) { const int st = b / 1024, sb = b % 1024, swz = sb ^ (((sb >> 9) & 1) << 5); R = (st >> 1) * 16 + swz / 64; C = (st & 1) * 32 + (swz % 64) / 2; }
__host__ __device__ __forceinline__ int perm32(int rho) { const int n = rho >> 4, i = rho & 15; return 8 * (i >> 2) + 4 * n + (i & 3); }

struct Unit { int pm, pn, k0, nt; };
struct Gemm { const bf16_t* A; const bf16_t* Bt; int M, N, K; };

struct StaticOrder {
    int nM, nN, nwg, G, c;
    __host__ __device__ __forceinline__ void init(int M, int N, int G_, int c_) { nM = M / BM; nN = N / BM; nwg = nM * nN; G = G_; c = c_; }
    __host__ __device__ __forceinline__ bool next(int i, Unit& u) const {
        const long L = (long)i * G + c; if (L >= nwg) return false;
        int wgid = (int)L; { const int q = nwg / NXCD, r = nwg % NXCD, xcd = wgid % NXCD, off = wgid / NXCD; wgid = (xcd < r ? xcd * (q + 1) : r * (q + 1) + (xcd - r) * q) + off; }
        const int nig = WGM * nN, gid = wgid / nig, fm = gid * WGM, gsz = (nM - fm) < WGM ? (nM - fm) : WGM;
        u.pm = fm + ((wgid % nig) % gsz); u.pn = (wgid % nig) / gsz; u.k0 = 0; u.nt = 0; return true;
    }
    __device__ __forceinline__ void a_ready(const Unit&) const {}
    __device__ __forceinline__ void done(const Unit&) const {}
};
__device__ __forceinline__ unsigned cvt_pk_bf16(float lo, float hi) { unsigned r; asm volatile("v_cvt_pk_bf16_f32 %0, %1, %2" : "=v"(r) : "v"(lo), "v"(hi)); return r; }

struct EpiStore {
    static constexpr bool PERM = true, AFTER_DRAIN = false;
    bf16_t* O; int ldc; const float* ssq; const float* bias; int ldb;
    __device__ __forceinline__ void operator()(const f32x4 (&acc)[2][2][4][2], const Unit& u, int wr, int wc, int fr, int fq) const {
        const int row0 = u.pm * BM + wr * 64 + fr, col0 = u.pn * BM + wc * 32 + 8 * fq, mi = u.pm < 32 ? (u.pm >> 4) : 2;
        f32x4 bv[2][2];
#pragma unroll
        for (int bj = 0; bj < 2; ++bj)
#pragma unroll
            for (int n = 0; n < 2; ++n) bv[bj][n] = *(const f32x4*)(bias + (size_t)mi * ldb + col0 + bj * HALF + 4 * n);
#pragma unroll
        for (int ai = 0; ai < 2; ++ai)
#pragma unroll
            for (int m = 0; m < 4; ++m) { const int row = row0 + ai * HALF + m * 16; bf16_t* rowp = O + (size_t)row * ldc + col0;
                const float r = __builtin_amdgcn_rsqf(ssq[row] * (1.f / 2048.f) + 1e-6f);
#pragma unroll
                for (int bj = 0; bj < 2; ++bj) { const f32x4 v0 = acc[ai][bj][m][0] * r + bv[bj][0], v1 = acc[ai][bj][m][1] * r + bv[bj][1];
                    u32x4 w; w.x = cvt_pk_bf16(v0[0], v0[1]); w.y = cvt_pk_bf16(v0[2], v0[3]); w.z = cvt_pk_bf16(v1[0], v1[1]); w.w = cvt_pk_bf16(v1[2], v1[3]);
                    *(u32x4*)(rowp + bj * HALF) = w; } }
    }
};
struct ResidOrder {
    StaticOrder L; int G, c, nsub, ksub;
    __device__ __forceinline__ void init(int G_, int c_, int nsplit, int ksub_) { L.init(8192, 2048, G_, c_); G = G_; c = c_; nsub = 16 * nsplit; ksub = ksub_; }
    __device__ __forceinline__ bool next(int i, Unit& u) const {
        const int nl = c < 256 ? (255 - c) / G + 1 : 0;
        if (i < nl) return L.next(i, u);
        const int s = (i - nl) * G + c; if (s >= nsub) return false;
        const int tile = s & 15, j = s >> 4; u.pm = 32 + (tile >> 3); u.pn = tile & 7; u.k0 = j * ksub; u.nt = ksub / BK; return true;
    }
    __device__ __forceinline__ void a_ready(const Unit&) const {}
    __device__ __forceinline__ void done(const Unit&) const {}
};
struct EpiResid2 {
    static constexpr bool PERM = true, AFTER_DRAIN = false;
    float* X; const float* gate; float* out; float* part; int final_; int ksub; int dry;
    bf16_t* Hn; const float* ngn; const float* scn; float* ssqn;
    __device__ __forceinline__ void operator()(const f32x4 (&acc)[2][2][4][2], const Unit& u, int wr, int wc, int fr, int fq) const {
        const int row0 = u.pm * BM + wr * 64 + fr, col0 = u.pn * BM + wc * 32 + 8 * fq;
        if (u.pm >= 32) {
            float* pb = part + ((size_t)(u.k0 / ksub) * 512 + (row0 - 8192)) * 2048 + col0;
#pragma unroll
            for (int ai = 0; ai < 2; ++ai)
#pragma unroll
                for (int m = 0; m < 4; ++m)
#pragma unroll
                    for (int bj = 0; bj < 2; ++bj)
#pragma unroll
                        for (int n = 0; n < 2; ++n) *(f32x4*)(pb + (size_t)(ai * HALF + m * 16) * 2048 + bj * HALF + 4 * n) = acc[ai][bj][m][n];
            return;
        }
        const int mi = u.pm >> 4;
        f32x4 gv[2][2], av[2][2];
#pragma unroll
        for (int bj = 0; bj < 2; ++bj)
#pragma unroll
            for (int n = 0; n < 2; ++n) { const int c = col0 + bj * HALF + 4 * n; gv[bj][n] = *(const f32x4*)(gate + (size_t)mi * 12288 + c);
                av[bj][n] = Hn ? *(const f32x4*)(ngn + c) * (*(const f32x4*)(scn + (size_t)mi * 12288 + c) + 1.f) : (f32x4){0.f, 0.f, 0.f, 0.f}; }
        if (dry && gv[0][0][0] != 1.2345e30f) return;
        f32x4 xa[4], xb[4];
#pragma unroll
        for (int bj = 0; bj < 2; ++bj) { const float* xr = X + (size_t)row0 * 2048 + col0; xa[2 * bj] = *(const f32x4*)(xr + bj * HALF); xa[2 * bj + 1] = *(const f32x4*)(xr + bj * HALF + 4); }
#pragma unroll
        for (int gI = 0; gI < 8; ++gI) { const int ai = gI >> 2, m = gI & 3;
            const int row = row0 + ai * HALF + m * 16; const size_t ro = (size_t)row * 2048 + col0; float* orow = (final_ ? out : X) + ro; float ss = 0.f;
            if (gI < 7) { const int ai2 = (gI + 1) >> 2, m2 = (gI + 1) & 3; const float* xr2 = X + (size_t)(row0 + ai2 * HALF + m2 * 16) * 2048 + col0;
#pragma unroll
                for (int bj = 0; bj < 2; ++bj) { xb[2 * bj] = *(const f32x4*)(xr2 + bj * HALF); xb[2 * bj + 1] = *(const f32x4*)(xr2 + bj * HALF + 4); } }
#pragma unroll
            for (int bj = 0; bj < 2; ++bj) {
                const f32x4 x0 = xa[2 * bj] + gv[bj][0] * acc[ai][bj][m][0], x1 = xa[2 * bj + 1] + gv[bj][1] * acc[ai][bj][m][1];
                *(f32x4*)(orow + bj * HALF) = x0; *(f32x4*)(orow + bj * HALF + 4) = x1;
                if (Hn) { ss += (x0[0] * x0[0] + x0[1] * x0[1]) + (x0[2] * x0[2] + x0[3] * x0[3]) + (x1[0] * x1[0] + x1[1] * x1[1]) + (x1[2] * x1[2] + x1[3] * x1[3]);
                    const f32x4 h0 = x0 * av[bj][0], h1 = x1 * av[bj][1];
                    u32x4 w; w.x = cvt_pk_bf16(h0[0], h0[1]); w.y = cvt_pk_bf16(h0[2], h0[3]); w.z = cvt_pk_bf16(h1[0], h1[1]); w.w = cvt_pk_bf16(h1[2], h1[3]);
                    *(u32x4*)(Hn + ro + bj * HALF) = w; } }
            if (Hn) { ss += __shfl_xor(ss, 16); ss += __shfl_xor(ss, 32); if (fq == 0) (void)__hip_atomic_fetch_add(ssqn + row, ss, __ATOMIC_RELAXED, __HIP_MEMORY_SCOPE_AGENT); }
#pragma unroll
            for (int q = 0; q < 4; ++q) xa[q] = xb[q]; }
    }
};
struct EpiAct {
    static constexpr bool PERM = true, AFTER_DRAIN = false;
    bf16_t* ACT; const float* cw; const float* cb; float* halo; PG8_LAS float* exb; const float* ssq; const float* bias; mutable int par;
    __device__ __forceinline__ void operator()(const f32x4 (&acc)[2][2][4][2], const Unit& u, int wr, int wc, int fr, int fq) const {
        const int lane = fq * 16 + fr, ch0 = wc * 32 + 8 * fq, chg = u.pn * 128 + ch0;
        PG8_LAS float* xb = exb + par * 1024; par ^= 1;
        const int mi = u.pm < 32 ? (u.pm >> 4) : 2;
        const float* bp = bias + (size_t)mi * 11264 + u.pn * BM + ch0;
        float rr[2][4];
#pragma unroll
        for (int ai = 0; ai < 2; ++ai)
#pragma unroll
            for (int m = 0; m < 4; ++m) rr[ai][m] = __builtin_amdgcn_rsqf(ssq[u.pm * BM + ai * HALF + wr * 64 + m * 16 + fr] * (1.f / 2048.f) + 1e-6f);
#pragma unroll
        for (int ai = 0; ai < 2; ++ai) { const int q = ai * 2 + wr;
#pragma unroll
            for (int n = 0; n < 2; ++n) { const f32x4 bg4 = *(const f32x4*)(bp + 4 * n);
                if (fr == 0) *(PG8_LAS f32x4*)(xb + q * 128 + ch0 + 4 * n) = acc[ai][0][0][n] * rr[ai][0] + bg4;
                if (fr == 15) *(PG8_LAS f32x4*)(xb + (4 + q) * 128 + ch0 + 4 * n) = acc[ai][0][3][n] * rr[ai][3] + bg4; } }
        asm volatile("s_waitcnt lgkmcnt(0)" ::: "memory"); __builtin_amdgcn_s_barrier(); asm volatile("" ::: "memory");
        float* hb = halo + (size_t)(u.pm * 44 + u.pn) * 768 + ch0;
#pragma unroll
        for (int n = 0; n < 2; ++n) {
            const f32x4 w0 = *(const f32x4*)(cw + chg + 4 * n), w1 = *(const f32x4*)(cw + 5632 + chg + 4 * n), w2 = *(const f32x4*)(cw + 2 * 5632 + chg + 4 * n), bb = *(const f32x4*)(cb + chg + 4 * n);
            const f32x4 bg = *(const f32x4*)(bp + 4 * n), bvv = *(const f32x4*)(bp + 128 + 4 * n);
#pragma unroll
            for (int ai = 0; ai < 2; ++ai) { const int q = ai * 2 + wr;
                const f32x4 pB = q > 0 ? *(PG8_LAS const f32x4*)(xb + (4 + q - 1) * 128 + ch0 + 4 * n) : (f32x4){0.f, 0.f, 0.f, 0.f};
                const f32x4 nB = q < 3 ? *(PG8_LAS const f32x4*)(xb + (q + 1) * 128 + ch0 + 4 * n) : (f32x4){0.f, 0.f, 0.f, 0.f};
#pragma unroll
                for (int m = 0; m < 4; ++m) {
                    const f32x4 x = acc[ai][0][m][n] * rr[ai][m] + bg, vx = acc[ai][1][m][n] * rr[ai][m] + bvv;
                    const f32x4 xm = m > 0 ? acc[ai][0][m > 0 ? m - 1 : 0][n] * rr[ai][m > 0 ? m - 1 : 0] + bg : pB;
                    const f32x4 xq = m < 3 ? acc[ai][0][m < 3 ? m + 1 : 3][n] * rr[ai][m < 3 ? m + 1 : 3] + bg : nB;
                    f32x4 cv, o;
#pragma unroll
                    for (int el = 0; el < 4; ++el) { const float sp = fr == 15 ? xm[el] : x[el], sn = fr == 0 ? xq[el] : x[el];
                        const float pv = __builtin_bit_cast(float, __builtin_amdgcn_update_dpp(0, __builtin_bit_cast(int, sp), 0x121, 0xF, 0xF, false)), nv = __builtin_bit_cast(float, __builtin_amdgcn_update_dpp(0, __builtin_bit_cast(int, sn), 0x12F, 0xF, 0xF, false));
                        cv[el] = w0[el] * pv + w1[el] * x[el] + w2[el] * nv + bb[el];
                        o[el] = cv[el] / (1.f + __expf(-cv[el])) * vx[el]; }
                    const bool top = (q == 0 && m == 0 && fr == 0), bot = (q == 3 && m == 3 && fr == 15);
                    if (top || bot) { const int sl = top ? 0 : 1; *(f32x4*)(hb + sl * 128 + 4 * n) = x; *(f32x4*)(hb + (2 + sl) * 128 + 4 * n) = cv; *(f32x4*)(hb + (4 + sl) * 128 + 4 * n) = vx; }
                    else { typedef unsigned u32x2_ __attribute__((ext_vector_type(2))); u32x2_ w; w.x = cvt_pk_bf16(o[0], o[1]); w.y = cvt_pk_bf16(o[2], o[3]);
                        *(u32x2_*)(ACT + (size_t)(u.pm * BM + q * 64 + m * 16 + fr) * 5632 + chg + 4 * n) = w; }
                }
            }
        }
    }
};
template <class Epi, class Sched, bool ALIGN_EPI = false, bool SP2 = false>
__device__ __forceinline__ void gemm_phase(PG8_LAS unsigned char* lds, const Gemm g, const Sched& S, const Epi& E, int wid_in) {
    int wid = wid_in, zz_ = 0; asm volatile("" : "+s"(wid), "+s"(zz_));
    const int lane = (int)__builtin_amdgcn_mbcnt_hi(~0u, __builtin_amdgcn_mbcnt_lo(~0u, (unsigned)zz_)), tid = wid * 64 + lane, wr = wid >> 2, wc = wid & 3, fr = lane & 15, fq = lane >> 4;
    const int K = g.K, nt = K / BK;
    unsigned voffA[2], voffB[2];
#pragma unroll
    for (int i = 0; i < 2; ++i) { int R, C; stage_rc(tid * 16 + i * 8192, R, C); const int Rb = Epi::PERM ? ((R & ~31) + perm32(R & 31)) : R;
        voffA[i] = (unsigned)(R * K + C) * 2u; voffB[i] = (unsigned)(Rb * K + C) * 2u; }
    const size_t kstep = (size_t)(BK * 2);
    const size_t hstep = (size_t)HALF * K * 2;
    const size_t tstep = 2 * hstep;
    const unsigned ldsw = (unsigned)wid * 1024u;
    const int aoff = lds_byte(wr * 64 + fr, fq * 8), boff = lds_byte(wc * 32 + fr, fq * 8);
#define PG8_SA(b, h) (((b) * 2 + (h)) * HTB)
#define PG8_SB(b, h) ((4 + (b) * 2 + (h)) * HTB)
#define PG8_STAGE(bufoff, gbase, voff) do { _Pragma("unroll") for (int _i = 0; _i < 2; ++_i) \
        __builtin_amdgcn_global_load_lds((const unsigned*)((const char*)(gbase) + (voff)[_i]), (PG8_LAS unsigned*)(lds + (bufoff) + ldsw + _i * 8192), 16, 0, 0); } while (0)
#define PG8_LDA(dst, b, h) do { _Pragma("unroll") for (int m = 0; m < 4; ++m) _Pragma("unroll") for (int k = 0; k < 2; ++k) dst[m][k] = *(const PG8_LAS bf16x8*)(lds + PG8_SA(b, h) + aoff + m * 2048 + k * 1024); } while (0)
#define PG8_LDB(dst, b, h) do { _Pragma("unroll") for (int n = 0; n < 2; ++n) _Pragma("unroll") for (int k = 0; k < 2; ++k) dst[n][k] = *(const PG8_LAS bf16x8*)(lds + PG8_SB(b, h) + boff + n * 2048 + k * 1024); } while (0)
#define PG8_MMA(ai, bj, At, Bt) do { __builtin_amdgcn_s_setprio(1); _Pragma("unroll") for (int m = 0; m < 4; ++m) _Pragma("unroll") for (int n = 0; n < 2; ++n) _Pragma("unroll") for (int k = 0; k < 2; ++k) \
        acc[ai][bj][m][n] = __builtin_amdgcn_mfma_f32_16x16x32_bf16(Bt[n][k], At[m][k], acc[ai][bj][m][n], 0, 0, 0); __builtin_amdgcn_s_setprio(0); } while (0)
#define PG8_WAIT_V(n) asm volatile("s_waitcnt vmcnt(" #n ")" ::: "memory")
#define PG8_WAIT_L(n) asm volatile("s_waitcnt lgkmcnt(" #n ")" ::: "memory")
#define PG8_BAR __builtin_amdgcn_s_barrier()
#define PG8_SCHED __builtin_amdgcn_sched_barrier(0)
    Unit cur, nxt; int ui = 0;
    if (!S.next(0, cur)) return;
    f32x4 acc[2][2][4][2];
#pragma unroll
    for (int a = 0; a < 2; ++a)
#pragma unroll
        for (int b = 0; b < 2; ++b)
#pragma unroll
            for (int m = 0; m < 4; ++m)
#pragma unroll
                for (int n = 0; n < 2; ++n) acc[a][b][m][n] = (f32x4){0.f, 0.f, 0.f, 0.f};
    bf16x8 At[4][2], B0[2][2], B1[2][2];
    const char* cA = (const char*)g.A + (size_t)cur.pm * tstep + (size_t)cur.k0 * 2; const char* cB = (const char*)g.Bt + (size_t)cur.pn * tstep + (size_t)cur.k0 * 2;
    S.a_ready(cur);
    if constexpr (SP2) {
        PG8_STAGE(PG8_SB(0, 0), cB, voffB); PG8_STAGE(PG8_SB(0, 1), cB + hstep, voffB); PG8_STAGE(PG8_SA(0, 0), cA, voffA); PG8_STAGE(PG8_SA(0, 1), cA + hstep, voffA);
        if (wr == 1) PG8_BAR;
        PG8_WAIT_V(2); PG8_BAR;
        PG8_STAGE(PG8_SB(1, 0), cB + kstep, voffB); PG8_STAGE(PG8_SA(1, 0), cA + kstep, voffA); PG8_STAGE(PG8_SB(1, 1), cB + hstep + kstep, voffB);
        PG8_WAIT_V(6); PG8_BAR;
    } else {
        PG8_STAGE(PG8_SB(0, 0), cB, voffB); PG8_STAGE(PG8_SA(0, 0), cA, voffA); PG8_STAGE(PG8_SB(0, 1), cB + hstep, voffB); PG8_STAGE(PG8_SA(0, 1), cA + hstep, voffA);
        if (wr == 1) PG8_BAR;
        PG8_WAIT_V(4); PG8_BAR;
        PG8_STAGE(PG8_SB(1, 0), cB + kstep, voffB); PG8_STAGE(PG8_SA(1, 0), cA + kstep, voffA); PG8_STAGE(PG8_SB(1, 1), cB + hstep + kstep, voffB);
        PG8_WAIT_V(6); PG8_BAR;
    }
    for (;;) {
        const bool has_next = S.next(ui + 1, nxt);
        const char* nA = has_next ? (const char*)g.A + (size_t)nxt.pm * tstep + (size_t)nxt.k0 * 2 : cA; const char* nB = has_next ? (const char*)g.Bt + (size_t)nxt.pn * tstep + (size_t)nxt.k0 * 2 : cB;
        const int unt = cur.nt ? cur.nt : nt;
        for (int t = 0; t < unt; t += 2) {
            const bool last = (t == unt - 2);
            const char* a1 = cA + (size_t)(t + 1) * kstep;
            const char* a2 = last ? nA : cA + (size_t)(t + 2) * kstep; const char* b2 = last ? nB : cB + (size_t)(t + 2) * kstep;
            const char* a3 = a2 + kstep; const char* b3 = b2 + kstep;
            if (last && has_next) S.a_ready(nxt);
            if constexpr (SP2) {
            PG8_LDB(B0, 0, 0); PG8_LDB(B1, 0, 1); PG8_SCHED; PG8_LDA(At, 0, 0); PG8_STAGE(PG8_SA(1, 1), a1 + hstep, voffA);
            PG8_WAIT_V(8); PG8_WAIT_L(0); PG8_BAR; PG8_MMA(0, 0, At, B0); PG8_MMA(0, 1, At, B1); PG8_BAR; PG8_SCHED;
            PG8_LDA(At, 0, 1); PG8_STAGE(PG8_SB(0, 0), b2, voffB); PG8_STAGE(PG8_SB(0, 1), b2 + hstep, voffB); PG8_STAGE(PG8_SA(0, 0), a2, voffA);
            PG8_WAIT_V(8); PG8_WAIT_L(0); PG8_BAR; PG8_MMA(1, 0, At, B0); PG8_MMA(1, 1, At, B1); PG8_BAR; PG8_SCHED;
            PG8_LDB(B0, 1, 0); PG8_LDB(B1, 1, 1); PG8_SCHED; PG8_LDA(At, 1, 0); PG8_STAGE(PG8_SA(0, 1), a2 + hstep, voffA);
            PG8_WAIT_V(8); PG8_WAIT_L(0); PG8_BAR; PG8_MMA(0, 0, At, B0); PG8_MMA(0, 1, At, B1); PG8_BAR; PG8_SCHED;
            PG8_LDA(At, 1, 1); PG8_STAGE(PG8_SB(1, 0), b3, voffB); PG8_STAGE(PG8_SB(1, 1), b3 + hstep, voffB); PG8_STAGE(PG8_SA(1, 0), a3, voffA);
            PG8_WAIT_V(8); PG8_WAIT_L(0); PG8_BAR; PG8_MMA(1, 0, At, B0); PG8_MMA(1, 1, At, B1); PG8_BAR; PG8_SCHED;
            } else {
            PG8_LDB(B0, 0, 0); PG8_SCHED; PG8_LDA(At, 0, 0); PG8_STAGE(PG8_SA(1, 1), a1 + hstep, voffA);
            PG8_WAIT_L(8); PG8_BAR; PG8_WAIT_L(0); PG8_MMA(0, 0, At, B0); PG8_BAR; PG8_SCHED;
            PG8_LDB(B1, 0, 1); PG8_STAGE(PG8_SB(0, 0), b2, voffB);
            PG8_BAR; PG8_WAIT_L(0); PG8_MMA(0, 1, At, B1); PG8_BAR;
            PG8_LDA(At, 0, 1); PG8_STAGE(PG8_SA(0, 0), a2, voffA);
            PG8_BAR; PG8_WAIT_L(0); PG8_MMA(1, 0, At, B0); PG8_BAR; PG8_SCHED;
            PG8_STAGE(PG8_SB(0, 1), b2 + hstep, voffB);
            PG8_WAIT_V(6); PG8_BAR; PG8_MMA(1, 1, At, B1); PG8_BAR;
            PG8_LDB(B0, 1, 0); PG8_SCHED; PG8_LDA(At, 1, 0); PG8_STAGE(PG8_SA(0, 1), a2 + hstep, voffA);
            PG8_WAIT_L(8); PG8_BAR; PG8_WAIT_L(0); PG8_MMA(0, 0, At, B0); PG8_BAR; PG8_SCHED;
            PG8_LDB(B1, 1, 1); PG8_STAGE(PG8_SB(1, 0), b3, voffB);
            PG8_BAR; PG8_WAIT_L(0); PG8_MMA(0, 1, At, B1); PG8_BAR;
            PG8_LDA(At, 1, 1); PG8_STAGE(PG8_SA(1, 0), a3, voffA);
            PG8_BAR; PG8_WAIT_L(0); PG8_MMA(1, 0, At, B0); PG8_BAR; PG8_SCHED;
            PG8_STAGE(PG8_SB(1, 1), b3 + hstep, voffB);
            PG8_WAIT_V(6); PG8_BAR; PG8_MMA(1, 1, At, B1); PG8_BAR;
            }
        }
        if constexpr (ALIGN_EPI) { if (wr == 0) PG8_BAR; }
        if constexpr (!Epi::AFTER_DRAIN) { E(acc, cur, wr, wc, fr, fq); S.done(cur); }
        if (!has_next) break;
#pragma unroll
        for (int a = 0; a < 2; ++a)
#pragma unroll
            for (int b = 0; b < 2; ++b)
#pragma unroll
                for (int m = 0; m < 4; ++m)
#pragma unroll
                    for (int n = 0; n < 2; ++n) acc[a][b][m][n] = (f32x4){0.f, 0.f, 0.f, 0.f};
        cur = nxt; cA = nA; cB = nB; ++ui;
        if constexpr (ALIGN_EPI) { if (wr == 1) PG8_BAR; }
    }
    PG8_WAIT_V(0);
    if constexpr (!ALIGN_EPI) { if (wr == 0) PG8_BAR; }
    PG8_BAR;
    if constexpr (Epi::AFTER_DRAIN) { E.fused(acc, cur, wr, wc, fr, fq, lds, wid, lane); S.done(cur); }
#undef PG8_SA
#undef PG8_SB
#undef PG8_STAGE
#undef PG8_LDA
#undef PG8_LDB
#undef PG8_MMA
#undef PG8_WAIT_V
#undef PG8_WAIT_L
#undef PG8_BAR
#undef PG8_SCHED
}
}
#define GAS __attribute__((address_space(1)))
#define LAS __attribute__((address_space(3)))
typedef unsigned short bf16;
typedef unsigned v4u __attribute__((ext_vector_type(4)));
typedef unsigned v2u __attribute__((ext_vector_type(2)));
typedef float f32x4 __attribute__((ext_vector_type(4)));
typedef float f32x16 __attribute__((ext_vector_type(16)));
typedef short bf16x8 __attribute__((ext_vector_type(8)));
typedef short s16x4 __attribute__((ext_vector_type(4)));
typedef GAS unsigned gu32;
#define RLX_AGENT __ATOMIC_RELAXED, __HIP_MEMORY_SCOPE_AGENT
#define XB_TMO      128
#define XB_XCNT(j)  (256  + 64 * (j))
#define XB_XSUB(j)  (1280 + 64 * (j))
#define XB_XGEN(j)  (2304 + 64 * (j))
#define XB_TOP      3328
#define XB_TOPGEN   3392
#define XCD_BAR_WORDS 3456
#define XB_SPIN_CAP (1u << 18)

__device__ __forceinline__ unsigned xb_ld(unsigned* p)              { return __hip_atomic_load(p, __ATOMIC_RELAXED, __HIP_MEMORY_SCOPE_AGENT); }
__device__ __forceinline__ unsigned xb_add(unsigned* p, unsigned v) { return __hip_atomic_fetch_add(p, v, __ATOMIC_RELAXED, __HIP_MEMORY_SCOPE_AGENT); }
__device__ __forceinline__ unsigned xb_xcc_id() { return (unsigned)__builtin_amdgcn_s_getreg((3 << 11) | 20) & 0xFu; }
#define XB_SPIN(cond, bar) do { unsigned _sp = 0; while (cond) { __builtin_amdgcn_s_sleep(1); \
    if ((++_sp & 255u) == 0u) { if (xb_ld(&(bar)[XB_TMO])) break; if (_sp > XB_SPIN_CAP) { atomicAdd(&(bar)[XB_TMO], 1u); break; } } } } while (0)

struct XcdBarrier {
    unsigned* bar; unsigned x;
    volatile LAS unsigned* st;
    unsigned wv;
};

__device__ __forceinline__ unsigned xb_lane() { return __builtin_amdgcn_mbcnt_hi(~0u, __builtin_amdgcn_mbcnt_lo(~0u, 0u)); }
__device__ __forceinline__ XcdBarrier xcd_barrier_post(unsigned* bar, volatile LAS unsigned* st, unsigned wv) {
    XcdBarrier b; b.bar = bar; b.x = xb_xcc_id(); b.st = st; b.wv = wv;
    if (wv == 0u && xb_lane() == 0u) (void)xb_add(&bar[XB_XCNT(b.x)], 1u);
    return b;
}
__device__ __forceinline__ void xcd_barrier_complete(unsigned* bar, unsigned x, unsigned& nloc, unsigned& nx) {
    const unsigned G = gridDim.x * gridDim.y * gridDim.z;
    unsigned sum, cnt, mine, sp = 0u;
    for (;;) {
        sum = 0u; cnt = 0u; mine = 0u;
#pragma unroll
        for (unsigned j = 0; j < 16; ++j) { const unsigned c = xb_ld(&bar[XB_XCNT(j)]); sum += c; cnt += (c > 0u) ? 1u : 0u; mine = (j == x) ? c : mine; }
        if (sum == G) break;
        __builtin_amdgcn_s_sleep(1);
        if ((++sp & 255u) == 0u) { if (xb_ld(&bar[XB_TMO])) break; if (sp > XB_SPIN_CAP) { atomicAdd(&bar[XB_TMO], 1u); break; } }
    }
    nloc = mine > 0u ? mine : 1u; nx = cnt > 0u ? cnt : 1u;
}

__device__ __forceinline__ void xcd_barrier(const XcdBarrier& b) {
    asm volatile("s_waitcnt vmcnt(0)" ::: "memory");
    __syncthreads();
    if (b.wv == 0u && xb_lane() == 0u) {
        unsigned* bar = b.bar;
        __builtin_amdgcn_s_waitcnt(0);
        unsigned nloc = b.st[0], nx = b.st[1];
        if (nloc == 0u) { xcd_barrier_complete(bar, b.x, nloc, nx); b.st[0] = nloc; b.st[1] = nx; }
        const unsigned old = xb_add(&bar[XB_XSUB(b.x)], 1u);
        const unsigned gen = old / nloc;
        if (old + 1u == (gen + 1u) * nloc) {
            __builtin_amdgcn_fence(__ATOMIC_RELEASE, "agent");
            asm volatile("s_waitcnt vmcnt(0)" ::: "memory");
            const unsigned og = xb_add(&bar[XB_TOP], 1u);
            const unsigned tg = og / nx;
            if (og + 1u == (tg + 1u) * nx) xb_add(&bar[XB_TOPGEN], 1u);
            else XB_SPIN(xb_ld(&bar[XB_TOPGEN]) == tg, bar);
            __builtin_amdgcn_fence(__ATOMIC_ACQUIRE, "agent");
            xb_add(&bar[XB_XGEN(b.x)], 1u);
            asm volatile("s_waitcnt vmcnt(0)" ::: "memory");
        } else {
            XB_SPIN(xb_ld(&bar[XB_XGEN(b.x)]) == gen, bar);
            __builtin_amdgcn_fence(__ATOMIC_ACQUIRE, "agent");
            asm volatile("s_waitcnt vmcnt(0)" ::: "memory");
        }
    }
    __syncthreads();
}
#ifndef ONE_LAUNCH
#define ONE_LAUNCH 1
#endif
#ifndef NLAYERS
#define NLAYERS 4
#endif
constexpr int DM = 2048, MR = 8704, NLATR = 8192;
constexpr int NINP = 6400, DFF = 5632, NUP = 11264, EVIN = 6176, ODIN = 6160;
constexpr int NWAVES = 8, NTHR = 512;
constexpr float EPS = 1e-6f;
constexpr int NCHUNK = 68;
constexpr int PPL = 11, NPH = 1 + 4 * PPL;
constexpr size_t MiB = 1ull << 20;
constexpr size_t WS_CTL = 0, CTL_BYTES = 1 * MiB;
constexpr size_t WS_MOD = 1 * MiB, WS_ROPE = 1 * MiB + 640 * 1024;
constexpr size_t WS_W = 4 * MiB, W_LAYER = 99 * MiB, W_OUT = 25 * MiB, W_UP = 33 * MiB, W_DN = 77 * MiB;
constexpr size_t WS_XS = 400 * MiB, WS_H = 468 * MiB, WS_MIX = 502 * MiB, WS_P = 536 * MiB, WS_U = 644 * MiB, WS_ACT = 832 * MiB;
constexpr size_t WS_QR = 926 * MiB, WS_KR = 943 * MiB, WS_MQK = 960 * MiB, WS_DST = 977 * MiB, WS_SST = 1113 * MiB, WS_SM = 1181 * MiB, WS_B1 = 1185 * MiB, WS_B2 = 1186 * MiB, WS_END = 1187 * MiB;
constexpr size_t WS_SSQ = 524288;
constexpr size_t SM_GAM = 0, SM_DN = 1 * MiB, SM_NIN = 2 * MiB, SM_BL = 3 * MiB, SM_ML = 3 * MiB + 8192, SM_MIN = 3 * MiB + 16384;
constexpr int CW_BAR = 4096;
constexpr int LDS_BYTES = 147456, MISC_OFF = 131072 + 320;

struct Args { const float* in[27]; float* out; unsigned char* ws; int ph_lo, ph_hi, li, pad; };

__device__ __forceinline__ float bf_lo(unsigned u) { return __builtin_bit_cast(float, u << 16); }
__device__ __forceinline__ float bf_hi(unsigned u) { return __builtin_bit_cast(float, u & 0xffff0000u); }
__device__ __forceinline__ float bf1(bf16 b) { return __builtin_bit_cast(float, (unsigned)b << 16); }
typedef float f32x2_t __attribute__((ext_vector_type(2))); typedef __bf16 bf16x2_t __attribute__((ext_vector_type(2)));
__device__ __forceinline__ unsigned pk2(float lo, float hi) { f32x2_t v = {lo, hi}; bf16x2_t b = __builtin_convertvector(v, bf16x2_t); return __builtin_bit_cast(unsigned, b); }
__device__ __forceinline__ bf16 f2bf(float f) { return (bf16)(pk2(f, 0.f) & 0xffffu); }
__device__ __forceinline__ void unpack8(const v4u w, float (&f)[8]) { f[0] = bf_lo(w.x); f[1] = bf_hi(w.x); f[2] = bf_lo(w.y); f[3] = bf_hi(w.y); f[4] = bf_lo(w.z); f[5] = bf_hi(w.z); f[6] = bf_lo(w.w); f[7] = bf_hi(w.w); }
__device__ __forceinline__ v4u pack8(const float (&f)[8]) { v4u w; w.x = pk2(f[0], f[1]); w.y = pk2(f[2], f[3]); w.z = pk2(f[4], f[5]); w.w = pk2(f[6], f[7]); return w; }
__device__ __forceinline__ float silu_f(float x) { return x / (1.f + __expf(-x)); }
__device__ __forceinline__ float sigmoid_f(float x) { return 1.f / (1.f + __expf(-x)); }
__device__ __forceinline__ float logsig_f(float z) { return fminf(z, 0.f) - __logf(1.f + __expf(-fabsf(z))); }
__device__ __forceinline__ float wave_sum(float v) {
#pragma unroll
    for (int o = 1; o < 64; o <<= 1) v += __shfl_xor(v, o);
    return v;
}
__device__ __forceinline__ float wave_max(float v) {
#pragma unroll
    for (int o = 1; o < 64; o <<= 1) v = fmaxf(v, __shfl_xor(v, o));
    return v;
}
__device__ __forceinline__ float wave_scan_sum(float v, int dir, int lane) {
#pragma unroll
    for (int o = 1; o < 64; o <<= 1) { const float up = __shfl_up(v, o), dn = __shfl_down(v, o); if (dir == 0) { if (lane >= o) v += up; } else { if (lane + o < 64) v += dn; } }
    return v;
}
__device__ __forceinline__ float wave_scan_max(float v, int dir, int lane) {
#pragma unroll
    for (int o = 1; o < 64; o <<= 1) { const float up = __shfl_up(v, o), dn = __shfl_down(v, o); if (dir == 0) { if (lane >= o) v = fmaxf(v, up); } else { if (lane + o < 64) v = fmaxf(v, dn); } }
    return v;
}
__device__ __forceinline__ bool seq_start(int r) { return r < NLATR ? (r & 4095) == 0 : ((r - NLATR) & 255) == 0; }

__device__ __forceinline__ bf16x8 frag_row(LAS const unsigned char* base, int stride, int row0, int k0, int lane) {
    return *(LAS const bf16x8*)(base + (row0 + (lane & 31)) * stride + (k0 + 8 * (lane >> 5)) * 2);
}
__device__ __forceinline__ s16x4 tr4(LAS const unsigned char* p) { return __builtin_amdgcn_ds_read_tr16_b64_v4i16((LAS s16x4*)p); }
__device__ __forceinline__ bf16x8 frag_tr(LAS const unsigned char* base, int stride, int k0, int col0, int lane) {
    const int h = lane >> 5, blk = (lane >> 4) & 1, q = (lane & 15) >> 2, p = lane & 3;
    LAS const unsigned char* a = base + (k0 + 8 * h + q) * stride + (col0 + 16 * blk + 4 * p) * 2;
    const s16x4 lo = tr4(a), hi = tr4(a + 4 * stride);
    return (bf16x8){lo[0], lo[1], lo[2], lo[3], hi[0], hi[1], hi[2], hi[3]};
}
__device__ __forceinline__ bf16x8 frag_tr_perm(LAS const unsigned char* base, int stride, int k0, int col0, int lane) {
    const int h = lane >> 5, blk = (lane >> 4) & 1, q = (lane & 15) >> 2, p = lane & 3;
    LAS const unsigned char* a = base + (k0 + 4 * h + q) * stride + (col0 + 16 * blk + 4 * p) * 2;
    const s16x4 lo = tr4(a), hi = tr4(a + 8 * stride);
    return (bf16x8){lo[0], lo[1], lo[2], lo[3], hi[0], hi[1], hi[2], hi[3]};
}
__device__ __forceinline__ int swz_off(int row, int ch) { return 256 * row + 16 * (ch ^ (((row & 3) << 2) | ((row >> 2) & 3))); }
__device__ __forceinline__ bf16x8 sfrag_row(LAS const unsigned char* base, int row0, int k0, int lane) {
    return *(LAS const bf16x8*)(base + swz_off(row0 + (lane & 31), (k0 >> 3) + (lane >> 5)));
}
__device__ __forceinline__ bf16x8 sfrag_tr_perm(LAS const unsigned char* base, int k0, int col0, int lane) {
    const int h = lane >> 5, blk = (lane >> 4) & 1, q = (lane & 15) >> 2, p = lane & 3, ch = (col0 >> 3) + 2 * blk + (p >> 1), r0 = k0 + 4 * h + q;
    const s16x4 lo = tr4(base + swz_off(r0, ch) + 8 * (p & 1)), hi = tr4(base + swz_off(r0 + 8, ch) + 8 * (p & 1));
    return (bf16x8){lo[0], lo[1], lo[2], lo[3], hi[0], hi[1], hi[2], hi[3]};
}
#define MFMA32(a, b, c) __builtin_amdgcn_mfma_f32_32x32x16_bf16((a), (b), (c), 0, 0, 0)
__device__ __forceinline__ f32x16 zero16() { f32x16 z;
#pragma unroll
    for (int i = 0; i < 16; ++i) z[i] = 0.f;
    return z; }
__device__ __forceinline__ void load_tile(LAS unsigned char* dst, int ls, const bf16* src, size_t ld, int rows, int cols, int tid) {
    const int cpr = cols >> 3, n = rows * cpr;
    for (int c = tid; c < n; c += NTHR) { const int r = c / cpr, cc = c - r * cpr; *(LAS v4u*)(dst + r * ls + cc * 16) = *(const v4u*)(src + (size_t)r * ld + cc * 8); }
}

__device__ __forceinline__ void store_tile(bf16* dst, size_t ld, LAS const unsigned char* src, int ls, int rows, int cols, int tid) {
    const int cpr = cols >> 3, n = rows * cpr;
    for (int c = tid; c < n; c += NTHR) { const int r = c / cpr, cc = c - r * cpr; *(v4u*)(dst + (size_t)r * ld + cc * 8) = *(LAS const v4u*)(src + r * ls + cc * 16); }
}

struct TrItem { const float* W; bf16* WT; int K, N, k0, n0, dn0, nts; };
__device__ __forceinline__ void tr_issue(const TrItem& t, f32x4 (&v)[8], int lane) {
    const int n = t.n0 + 4 * (lane & 7);
#pragma unroll
    for (int i = 0; i < 8; ++i) { const int kk = 8 * i + (lane >> 3); v[i] = n < t.N ? __builtin_nontemporal_load((const f32x4*)(t.W + (size_t)(t.k0 + kk) * t.N + n)) : (f32x4){0.f, 0.f, 0.f, 0.f}; }
}
__device__ __forceinline__ void tr_finish(const TrItem& t, const f32x4 (&v)[8], LAS float* scr, int lane) {
#pragma unroll
    for (int i = 0; i < 8; ++i) { const int kk = 8 * i + (lane >> 3); LAS float* d = scr + kk * 33 + 4 * (lane & 7); d[0] = v[i].x; d[1] = v[i].y; d[2] = v[i].z; d[3] = v[i].w; }
    asm volatile("s_waitcnt lgkmcnt(0)" ::: "memory");
    const int c = lane & 7;
#pragma unroll
    for (int j = 0; j < 4; ++j) { const int nn = (lane >> 3) + 8 * j; const LAS float* s = scr + (8 * c) * 33 + nn;
        v4u o; o.x = pk2(s[0 * 33], s[1 * 33]); o.y = pk2(s[2 * 33], s[3 * 33]); o.z = pk2(s[4 * 33], s[5 * 33]); o.w = pk2(s[6 * 33], s[7 * 33]);
        if (t.k0 >= 0 && t.nts) __builtin_nontemporal_store(o, (v4u*)(t.WT + (size_t)(t.dn0 + nn) * t.K + t.k0 + 8 * c)); else *(v4u*)(t.WT + (size_t)(t.dn0 + nn) * t.K + t.k0 + 8 * c) = o; }
    asm volatile("s_waitcnt lgkmcnt(0)" ::: "memory");
}
__device__ __forceinline__ void tr_decode(const Args& a, unsigned char* ws, int g, TrItem& t) {
    const int layer = g / 25344; int r = g - layer * 25344; const int li = layer >> 1; t.nts = layer > 0;
    unsigned char* wb = ws + WS_W + (size_t)layer * W_LAYER;
    int nblk;
    if (r < 6400) { if (layer & 1) { t.W = a.in[14] + (size_t)li * DM * ODIN; t.N = ODIN; } else { t.W = a.in[8] + (size_t)li * DM * EVIN; t.N = EVIN; } t.WT = (bf16*)wb; t.K = DM; nblk = NINP / 32; }
    else if ((r -= 6400) < 2048) { t.W = (layer & 1 ? a.in[15] : a.in[9]) + (size_t)li * DM * DM; t.N = DM; t.WT = (bf16*)(wb + W_OUT); t.K = DM; nblk = DM / 32; }
    else if ((r -= 2048) < 11264) { t.W = a.in[23] + (size_t)layer * DM * NUP; t.N = NUP; t.WT = (bf16*)(wb + W_UP); t.K = DM; nblk = NUP / 32; }
    else { r -= 11264; t.W = a.in[26] + (size_t)layer * DFF * DM; t.N = DM; t.WT = (bf16*)(wb + W_DN); t.K = DFF; nblk = DM / 32; }
    const int kb = r / nblk, nb = r - kb * nblk; t.k0 = 64 * kb; t.n0 = 32 * nb; t.dn0 = t.n0;
    if (t.N == NUP) { const int m0 = t.n0 < DFF ? t.n0 : t.n0 - DFF; t.dn0 = 256 * (m0 >> 7) + (t.n0 < DFF ? 0 : 128) + (m0 & 127); }
}
__device__ __forceinline__ void ph_convert(const Args& a, unsigned char* ws, LAS unsigned char* lds, int g_lo, int g_hi, int w, int nw, int wave, int lane) {
    LAS float* scr = (LAS float*)(lds + wave * 8448);
    TrItem cur, nxt; f32x4 va[8], vb[8];
    int g = g_lo + w;
    if (g < g_hi) { tr_decode(a, ws, g, cur); tr_issue(cur, va, lane); }
    while (g < g_hi) {
        const int g1 = g + nw; if (g1 < g_hi) { tr_decode(a, ws, g1, nxt); tr_issue(nxt, vb, lane); }
        tr_finish(cur, va, scr, lane);
        const int g2 = g1 + nw; if (g1 < g_hi) { if (g2 < g_hi) { tr_decode(a, ws, g2, cur); tr_issue(cur, va, lane); } tr_finish(nxt, vb, scr, lane); }
        g = g2;
    }
}
__device__ __forceinline__ void ph_prologue(const Args& a, unsigned char* ws, LAS unsigned char* lds, int tid, int lane, int wave, int bid, int G) {
    float* MOD = (float*)(ws + WS_MOD);
    LAS float* vec = (LAS float*)(lds + 73728);
    LAS float* red = (LAS float*)(lds + 98304);
    for (int e = tid; e < 3 * DM; e += NTHR) { const float v = e < 2 * DM ? a.in[1][e] : a.in[3][e - 2 * DM]; vec[e] = silu_f(v); }
    __syncthreads();
    for (int it = bid; it < 4 * 192; it += G) {
        const int layer = it / 192, cg = it - layer * 192, col = cg * 64 + 4 * (lane & 15), rq = lane >> 4;
        const float* W = a.in[4] + (size_t)layer * DM * 12288 + col;
        f32x4 a0 = {0.f, 0.f, 0.f, 0.f}, a1 = a0, a2 = a0;
#pragma unroll 16
        for (int i = 0; i < 64; ++i) { const int kk = 256 * wave + 4 * i + rq; const f32x4 w4 = __builtin_nontemporal_load((const f32x4*)(W + (size_t)kk * 12288));
            a0 += w4 * vec[kk]; a1 += w4 * vec[DM + kk]; a2 += w4 * vec[2 * DM + kk]; }
#pragma unroll
        for (int e = 0; e < 4; ++e) { a0[e] += __shfl_xor(a0[e], 16); a0[e] += __shfl_xor(a0[e], 32); a1[e] += __shfl_xor(a1[e], 16); a1[e] += __shfl_xor(a1[e], 32); a2[e] += __shfl_xor(a2[e], 16); a2[e] += __shfl_xor(a2[e], 32); }
        if (lane < 16) { *(LAS f32x4*)(red + (wave * 3 + 0) * 64 + 4 * lane) = a0; *(LAS f32x4*)(red + (wave * 3 + 1) * 64 + 4 * lane) = a1; *(LAS f32x4*)(red + (wave * 3 + 2) * 64 + 4 * lane) = a2; }
        __syncthreads();
        if (tid < 192) { const int j = tid >> 6, c = tid & 63; float s = a.in[5][layer * 12288 + cg * 64 + c];
#pragma unroll
            for (int w = 0; w < 8; ++w) s += red[(w * 3 + j) * 64 + c];
            MOD[(size_t)(layer * 3 + j) * 12288 + cg * 64 + c] = s; }
        __syncthreads();
    }
    if (bid == G - 1) { float* rope = (float*)(ws + WS_ROPE);
        for (int e = tid; e < 1024; e += NTHR) { const int pos = e >> 4, f = e & 15; const float inv = powf(10000.f, -(float)f / 16.f), ang = (float)pos * inv; rope[e] = cosf(ang); rope[1024 + e] = sinf(ang); } }
    ph_convert(a, ws, lds, 0, 25344, bid * NWAVES + wave, G * NWAVES, wave, lane);
}

__device__ __forceinline__ void fuse_row(const float* src, float* XS, int row, int lane, const float* part, const float* pgate, int nsplit, const float* ng, const float* msc, bf16* H, float* ssq) {
    const int mi = row < NLATR ? (row >> 12) : 2;
    const f32x4* sr = (const f32x4*)src + lane; f32x4* xr = (f32x4*)(XS + (size_t)row * DM) + lane;
    f32x4 v[8];
#pragma unroll
    for (int j = 0; j < 8; ++j) v[j] = sr[64 * j];
    if (nsplit > 0) {
        f32x4 sacc[8];
#pragma unroll
        for (int j = 0; j < 8; ++j) sacc[j] = (f32x4){0.f, 0.f, 0.f, 0.f};
        for (int sp = 0; sp < nsplit; ++sp) { const f32x4* pr = (const f32x4*)(part + ((size_t)sp * 512 + (row - NLATR)) * DM) + lane;
#pragma unroll
            for (int j = 0; j < 8; ++j) sacc[j] += pr[64 * j]; }
#pragma unroll
        for (int j = 0; j < 8; ++j) v[j] += *(const f32x4*)(pgate + 4 * lane + 256 * j) * sacc[j];
    }
    float ss = 0.f;
#pragma unroll
    for (int j = 0; j < 8; ++j) { xr[64 * j] = v[j]; ss += (v[j].x * v[j].x + v[j].y * v[j].y) + (v[j].z * v[j].z + v[j].w * v[j].w); }
    ss = wave_sum(ss);
    if (lane == 0) ssq[row] = ss;
#pragma unroll
    for (int j = 0; j < 8; ++j) { const int col = 4 * lane + 256 * j;
        const f32x4 y = v[j] * *(const f32x4*)(ng + col) * (*(const f32x4*)(msc + (size_t)mi * 12288 + col) + 1.f);
        v2u o; o.x = pk2(y.x, y.y); o.y = pk2(y.z, y.w);
        *(v2u*)(H + (size_t)row * DM + col) = o; }
}
__device__ __forceinline__ void ph_norm0(const float* x, const float* ctx, float* XS, const float* ng, const float* msc, bf16* H, float* ssq, int gw, int NGW, int lane) {
    for (int row = gw; row < MR; row += NGW) fuse_row(row < NLATR ? x + (size_t)row * DM : ctx + (size_t)(row - NLATR) * DM, XS, row, lane, nullptr, nullptr, 0, ng, msc, H, ssq);
}
template <int NS>
__device__ __forceinline__ void ph_ctxfix(float* XS, const float* part, const float* pgate, const float* ng, const float* msc, bf16* H, float* ssq, int gw, int NGW, int lane) {
    for (int it = gw; it < 2048; it += NGW) {
        const int row = NLATR + (it >> 2), c0 = (it & 3) * 512 + 8 * lane;
        float* xp = XS + (size_t)row * DM + c0;
        f32x4 v0 = *(const f32x4*)xp, v1 = *(const f32x4*)(xp + 4);
        f32x4 p0[NS], p1[NS];
#pragma unroll
        for (int sp = 0; sp < NS; ++sp) { const float* pp = part + ((size_t)sp * 512 + (row - NLATR)) * DM + c0; p0[sp] = *(const f32x4*)pp; p1[sp] = *(const f32x4*)(pp + 4); }
        f32x4 s0 = p0[0], s1 = p1[0];
#pragma unroll
        for (int sp = 1; sp < NS; ++sp) { s0 += p0[sp]; s1 += p1[sp]; }
        v0 += *(const f32x4*)(pgate + c0) * s0; v1 += *(const f32x4*)(pgate + c0 + 4) * s1;
        *(f32x4*)xp = v0; *(f32x4*)(xp + 4) = v1;
        float ss = (v0.x * v0.x + v0.y * v0.y) + (v0.z * v0.z + v0.w * v0.w) + (v1.x * v1.x + v1.y * v1.y) + (v1.z * v1.z + v1.w * v1.w);
        ss = wave_sum(ss);
        if (lane == 0) (void)__hip_atomic_fetch_add(ssq + row, ss, __ATOMIC_RELAXED, __HIP_MEMORY_SCOPE_AGENT);
        const f32x4 y0 = v0 * *(const f32x4*)(ng + c0) * (*(const f32x4*)(msc + 2 * 12288 + c0) + 1.f), y1 = v1 * *(const f32x4*)(ng + c0 + 4) * (*(const f32x4*)(msc + 2 * 12288 + c0 + 4) + 1.f);
        v4u o; o.x = pk2(y0.x, y0.y); o.y = pk2(y0.z, y0.w); o.z = pk2(y1.x, y1.y); o.w = pk2(y1.z, y1.w);
        *(v4u*)(H + (size_t)row * DM + c0) = o;
    }
}
__device__ __forceinline__ void ph_bias(const bf16* WIN, const bf16* WUPt, const float* mod, float* b1, float* b2, int gw, int NGW, int lane) {
    for (int which = 0; which < 2; ++which) {
        const bf16* WT = which ? WUPt : WIN; const int N = which ? NUP : NINP; const float* sh = mod + (which ? 3 * DM : 0); float* out = which ? b2 : b1;
        float s0[32], s1[32], s2[32];
#pragma unroll
        for (int i = 0; i < 4; ++i)
#pragma unroll
            for (int h = 0; h < 2; ++h) { const int k = 512 * i + 8 * lane + 4 * h; const f32x4 a0 = *(const f32x4*)(sh + k), a1 = *(const f32x4*)(sh + 12288 + k), a2 = *(const f32x4*)(sh + 2 * 12288 + k);
#pragma unroll
                for (int el = 0; el < 4; ++el) { s0[8 * i + 4 * h + el] = a0[el]; s1[8 * i + 4 * h + el] = a1[el]; s2[8 * i + 4 * h + el] = a2[el]; } }
#pragma unroll 1
        for (int n0 = gw * 2; n0 < N; n0 += NGW * 2) {
            v4u wv[2][4];
#pragma unroll
            for (int rr = 0; rr < 2; ++rr)
#pragma unroll
                for (int i = 0; i < 4; ++i) wv[rr][i] = *(const v4u*)(WT + (size_t)(n0 + rr) * DM + 512 * i + 8 * lane);
            float d[2][3];
#pragma unroll
            for (int rr = 0; rr < 2; ++rr) { d[rr][0] = 0.f; d[rr][1] = 0.f; d[rr][2] = 0.f;
#pragma unroll
                for (int i = 0; i < 4; ++i) { float w[8]; unpack8(wv[rr][i], w);
#pragma unroll
                    for (int el = 0; el < 8; ++el) { d[rr][0] += w[el] * s0[8 * i + el]; d[rr][1] += w[el] * s1[8 * i + el]; d[rr][2] += w[el] * s2[8 * i + el]; } } }
#pragma unroll
            for (int rr = 0; rr < 2; ++rr)
#pragma unroll
                for (int j = 0; j < 3; ++j) d[rr][j] = wave_sum(d[rr][j]);
            if (lane == 0) {
#pragma unroll
                for (int rr = 0; rr < 2; ++rr) { out[n0 + rr] = d[rr][0]; out[N + n0 + rr] = d[rr][1]; out[2 * N + n0 + rr] = d[rr][2]; } }
        }
    }
}

template <int MODE>
__device__ __forceinline__ void ph_conv(const bf16* SRC, const float* cw, const float* cb, bf16* DST, int gtid, int NT) {
    constexpr int NC = MODE == 0 ? DFF : 1024, NCG = NC / 8, NRB = MR / 16;
    constexpr int LDS_ = MODE == 0 ? NUP : NINP, LDD = MODE == 0 ? DFF : (MODE == 1 ? DM : 1024);
    for (int it = gtid; it < NRB * NCG; it += NT) {
        const int rb = it / NCG, cg = it - rb * NCG, r0 = rb * 16, c0 = cg * 8;
        float w0[8], w1[8], w2[8], bb[8];
#pragma unroll
        for (int j = 0; j < 8; ++j) { w0[j] = cw[c0 + j]; w1[j] = cw[NC + c0 + j]; w2[j] = cw[2 * NC + c0 + j]; bb[j] = MODE == 0 ? cb[c0 + j] : 0.f; }
        auto ld = [&](int r, float (&f)[8]) {
            if (MODE == 0) { unpack8(*(const v4u*)(SRC + (size_t)r * LDS_ + c0), f); }
            else if (MODE == 1) { float s1[8], s2[8]; unpack8(*(const v4u*)(SRC + (size_t)r * LDS_ + 3104 + c0), s1); unpack8(*(const v4u*)(SRC + (size_t)r * LDS_ + 5152 + c0), s2);
#pragma unroll
                for (int j = 0; j < 8; ++j) f[j] = s1[j] * s2[j]; }
            else { unpack8(*(const v4u*)(SRC + (size_t)r * LDS_ + 3072 + c0), f); }
        };
        float prev[8], cur[8], nxt[8];
        if (!seq_start(r0)) ld(r0 - 1, prev); else {
#pragma unroll
            for (int j = 0; j < 8; ++j) prev[j] = 0.f; }
        ld(r0, cur);
#pragma unroll 2
        for (int i = 0; i < 16; ++i) {
            const int r = r0 + i;
            if (i < 15 || !seq_start(r0 + 16)) ld(r + 1, nxt); else {
#pragma unroll
                for (int j = 0; j < 8; ++j) nxt[j] = 0.f; }
            float o[8];
            if (MODE == 0) { float vv[8]; unpack8(*(const v4u*)(SRC + (size_t)r * LDS_ + DFF + c0), vv);
#pragma unroll
                for (int j = 0; j < 8; ++j) o[j] = silu_f(w0[j] * prev[j] + w1[j] * cur[j] + w2[j] * nxt[j] + bb[j]) * vv[j]; }
            else if (MODE == 1) { float vv[8]; unpack8(*(const v4u*)(SRC + (size_t)r * LDS_ + 4128 + c0), vv);
#pragma unroll
                for (int j = 0; j < 8; ++j) o[j] = (w0[j] * prev[j] + w1[j] * cur[j] + w2[j] * nxt[j]) * vv[j]; }
            else { const float sc = c0 >= 512 ? 0.08838834764831845f : 1.f;
#pragma unroll
                for (int j = 0; j < 8; ++j) o[j] = silu_f(w0[j] * prev[j] + w1[j] * cur[j] + w2[j] * nxt[j]) * sc; }
            *(v4u*)(DST + (size_t)r * LDD + (MODE == 1 ? 1024 : 0) + c0) = pack8(o);
#pragma unroll
            for (int j = 0; j < 8; ++j) { prev[j] = cur[j]; cur[j] = nxt[j]; }
        }
    }
}

__device__ __forceinline__ void ph_act_fix(const float* halo, const float* cw, bf16* ACT, int gtid, int NT) {
    for (int e = gtid; e < 34 * 44 * 256; e += NT) {
        const int ch = e & 127, which = (e >> 7) & 1, tile = e >> 8, pm = tile / 44, pn = tile - pm * 44, chg = pn * 128 + ch;
        const float* hb = halo + (size_t)tile * 768;
        const int row = 256 * pm + (which ? 255 : 0);
        float g = 0.f;
        if (which == 0) { if (!seq_start(row)) g = halo[(size_t)(tile - 44) * 768 + 128 + ch] * cw[chg]; }
        else { if (!seq_start(row + 1)) g = halo[(size_t)(tile + 44) * 768 + ch] * cw[2 * DFF + chg]; }
        const float cv = hb[(2 + which) * 128 + ch] + g;
        ACT[(size_t)row * DFF + chg] = f2bf(silu_f(cv) * hb[(4 + which) * 128 + ch]);
    }
}

__device__ __forceinline__ void act_fix_tile(const float* halo, const float* cw, bf16* ACT, int pm, int tid) {
    f32x4 cp[6], vv[6], gg[6];
#pragma unroll
    for (int i = 0; i < 6; ++i) { const int e = tid + NTHR * i; const bool ok = e < 2816; const int ee = ok ? e : 0;
        const int c4 = ee & 31, which = (ee >> 5) & 1, pn = ee >> 6, tile = pm * 44 + pn, chg = pn * 128 + 4 * c4;
        const float* hb = halo + (size_t)tile * 768 + 4 * c4;
        const int row = 256 * pm + (which ? 255 : 0);
        cp[i] = *(const f32x4*)(hb + (2 + which) * 128); vv[i] = *(const f32x4*)(hb + (4 + which) * 128);
        const bool edge = which == 0 ? seq_start(row) : seq_start(row + 1);
        const f32x4 nb = edge ? (f32x4){0.f, 0.f, 0.f, 0.f} : *(const f32x4*)(halo + (size_t)(which == 0 ? tile - 44 : tile + 44) * 768 + (which == 0 ? 128 : 0) + 4 * c4);
        gg[i] = nb * *(const f32x4*)(cw + (which == 0 ? 0 : 2 * DFF) + chg); }
#pragma unroll
    for (int i = 0; i < 6; ++i) { const int e = tid + NTHR * i; if (e < 2816) {
        const int c4 = e & 31, which = (e >> 5) & 1, pn = e >> 6, chg = pn * 128 + 4 * c4; const int row = 256 * pm + (which ? 255 : 0);
        const f32x4 cv = cp[i] + gg[i];
        v2u o; o.x = pk2(silu_f(cv.x) * vv[i].x, silu_f(cv.y) * vv[i].y); o.y = pk2(silu_f(cv.z) * vv[i].z, silu_f(cv.w) * vv[i].w);
        *(v2u*)(ACT + (size_t)row * DFF + chg) = o; } }
}

template <int MODE>
__device__ __forceinline__ void ph_conv8(const bf16* SRC, const float* cw, bf16* DST, int gtid, int NT) {
    constexpr int NCG = 128, NRB = MR / 8, LDD = MODE == 1 ? DM : 1024;
    for (int it = gtid; it < NRB * NCG; it += NT) {
        const int rb = it >> 7, cg = it & 127, r0 = rb * 8, c0 = cg * 8;
        const bf16* base = SRC + (size_t)r0 * NINP + c0;
        const bool hp = !seq_start(r0), hn = !seq_start(r0 + 8);
        v4u xa[10], xb[10], xg[8];
#pragma unroll
        for (int i = 0; i < 10; ++i) { const bool ok = (i > 0 || hp) && (i < 9 || hn); const bf16* rp = base + (ptrdiff_t)(i - 1) * NINP;
            if (MODE == 1) { xa[i] = ok ? *(const v4u*)(rp + 3104) : (v4u){0u, 0u, 0u, 0u}; xb[i] = ok ? *(const v4u*)(rp + 5152) : (v4u){0u, 0u, 0u, 0u}; }
            else { xa[i] = ok ? *(const v4u*)(rp + 3072) : (v4u){0u, 0u, 0u, 0u}; } }
        if (MODE == 1) {
#pragma unroll
            for (int i = 0; i < 8; ++i) xg[i] = *(const v4u*)(base + (size_t)i * NINP + 4128); }
        float w0[8], w1[8], w2[8];
#pragma unroll
        for (int j = 0; j < 8; ++j) { w0[j] = cw[c0 + j]; w1[j] = cw[1024 + c0 + j]; w2[j] = cw[2048 + c0 + j]; }
        float prev[8], cur[8], nxt[8];
        auto cvt = [&](int i, float (&f)[8]) { unpack8(xa[i], f); if (MODE == 1) { float g[8]; unpack8(xb[i], g);
#pragma unroll
            for (int j = 0; j < 8; ++j) f[j] *= g[j]; } };
        cvt(0, prev); cvt(1, cur);
        const float sc = (MODE == 2 && c0 >= 512) ? 0.08838834764831845f : 1.f;
#pragma unroll
        for (int i = 0; i < 8; ++i) { cvt(i + 2, nxt); float o[8];
            if (MODE == 1) { float vv[8]; unpack8(xg[i], vv);
#pragma unroll
                for (int j = 0; j < 8; ++j) o[j] = (w0[j] * prev[j] + w1[j] * cur[j] + w2[j] * nxt[j]) * vv[j]; }
            else {
#pragma unroll
                for (int j = 0; j < 8; ++j) o[j] = silu_f(w0[j] * prev[j] + w1[j] * cur[j] + w2[j] * nxt[j]) * sc; }
            *(v4u*)(DST + (size_t)(r0 + i) * LDD + (MODE == 1 ? 1024 : 0) + c0) = pack8(o);
#pragma unroll
            for (int j = 0; j < 8; ++j) { prev[j] = cur[j]; cur[j] = nxt[j]; } }
    }
}

__device__ __forceinline__ void ph_qkprep(const bf16* P, const float* qg, const float* kg, const float* rope, bf16* QR, bf16* KR, int gw, int NGW, int lane) {
    const int i8 = lane & 7;
    float gq[8], gk[8];
#pragma unroll
    for (int j = 0; j < 8; ++j) { gq[j] = qg[8 * i8 + j]; gk[j] = kg[8 * i8 + j]; }
    for (int it0 = gw; it0 < MR * 4; it0 += 4 * NGW) {
        v4u xv[4];
#pragma unroll
        for (int k = 0; k < 4; ++k) { const int it = it0 + k * NGW; const int itc = it < MR * 4 ? it : it0; const int row = itc >> 2, qtr = itc & 3;
            xv[k] = *(const v4u*)(P + (size_t)row * NINP + (qtr >> 1) * 1024 + (qtr & 1) * 512 + 8 * lane); }
#pragma unroll
        for (int k = 0; k < 4; ++k) { const int it = it0 + k * NGW; if (it < MR * 4) {
            const int row = it >> 2, qtr = it & 3, isk = qtr >> 1;
            float x[8]; unpack8(xv[k], x);
            float ss = 0.f;
#pragma unroll
            for (int j = 0; j < 8; ++j) ss += x[j] * x[j];
            ss += __shfl_xor(ss, 1); ss += __shfl_xor(ss, 2); ss += __shfl_xor(ss, 4);
            const float r = rsqrtf(ss * (1.f / 64.f) + EPS);
            float y[8], o[8];
#pragma unroll
            for (int j = 0; j < 8; ++j) y[j] = x[j] * r * (isk ? gk[j] : gq[j]);
            if (row < NLATR) {
                const int t = row & 4095, pos = (i8 < 4) ? (t >> 6) : (t & 63), f0 = 8 * (i8 & 1);
                const f32x4 c0 = *(const f32x4*)(rope + pos * 16 + f0), c1 = *(const f32x4*)(rope + pos * 16 + f0 + 4), s0 = *(const f32x4*)(rope + 1024 + pos * 16 + f0), s1 = *(const f32x4*)(rope + 1024 + pos * 16 + f0 + 4);
#pragma unroll
                for (int j = 0; j < 8; ++j) { const float pj = __shfl_xor(y[j], 2), c = j < 4 ? c0[j & 3] : c1[j & 3], sn = j < 4 ? s0[j & 3] : s1[j & 3];
                    o[j] = (i8 & 2) ? (pj * sn + y[j] * c) : (y[j] * c - pj * sn); }
            } else {
#pragma unroll
                for (int j = 0; j < 8; ++j) o[j] = y[j]; }
            if (!isk) {
#pragma unroll
                for (int j = 0; j < 8; ++j) o[j] *= 0.18033688011112042f; }
            *(v4u*)((isk ? KR : QR) + (size_t)row * 1024 + (qtr & 1) * 512 + 8 * lane) = pack8(o); } }
    }
}

struct ScanP {
    const bf16* P; const bf16* MQK; bf16* MIX;
    const float* gw2; const float* gb;
    const float* mgb;
    const float* ng;
    bf16* DSTp; bf16* SSTp; float* GAM; float* DN; float* NIN; float* BL; float* ML; float* MINp;
};
__device__ __forceinline__ void scan_unit(int u, int& b, int& head, int& mm, int& rowbase) {
    b = u / 272; const int rem = u - b * 272; head = rem / 68; mm = rem - head * 68;
    rowbase = mm < 4 ? NLATR + b * 256 + 64 * mm : b * 4096 + 64 * (mm - 4);
}
__device__ __forceinline__ int scan_chunk(int mm, int dir) { return dir ? (mm < 4 ? 3 - mm : 71 - mm) : mm; }

__device__ __forceinline__ void gla_gates(const ScanP& s, LAS const float* glr, LAS float* tot, int head, int dir, int tid, float (&bb)[16], float& btot) {
    const int dk = tid & 127, grp = tid >> 7;
    float w2[16];
#pragma unroll
    for (int r = 0; r < 16; ++r) w2[r] = s.gw2[(dir * 16 + r) * 512 + head * 128 + dk];
    const float bias = s.gb[dir * 512 + head * 128 + dk];
#pragma unroll
    for (int tt = 0; tt < 16; ++tt) { const int t = 16 * grp + tt; float z = bias;
#pragma unroll
        for (int r = 0; r < 16; ++r) z += glr[t * 32 + dir * 16 + r] * w2[r];
        bb[tt] = logsig_f(z) * 0.0625f; }
    if (dir == 0) {
#pragma unroll
        for (int tt = 1; tt < 16; ++tt) bb[tt] += bb[tt - 1];
        tot[grp * 128 + dk] = bb[15];
    } else {
#pragma unroll
        for (int tt = 14; tt >= 0; --tt) bb[tt] += bb[tt + 1];
        tot[grp * 128 + dk] = bb[0];
    }
    __syncthreads();
    float off = 0.f; btot = 0.f;
#pragma unroll
    for (int g = 0; g < 4; ++g) { const float tv = tot[g * 128 + dk]; btot += tv; if (dir == 0 ? g < grp : g > grp) off += tv; }
#pragma unroll
    for (int tt = 0; tt < 16; ++tt) bb[tt] += off;
}

__device__ __forceinline__ void ph_mlstm_local(const ScanP& s, LAS unsigned char* lds, int tid, int lane, int wave, int bid, int G) {
    LAS unsigned char* Vs = lds; LAS unsigned char* Kh = lds + 33792; LAS unsigned char* Kr = lds + 68608;
    LAS float* wv = (LAS float*)(lds + 86016); LAS float* dnp = (LAS float*)(lds + 86528);
    const int dk = tid & 127, grp = tid >> 7;
    v4u pv[4], pk[2];
#define ML_PREF(u_) do { int b_, head_, mm_, rb_; scan_unit((u_), b_, head_, mm_, rb_); \
        _Pragma("unroll") for (int i = 0; i < 4; ++i) { const int c_ = tid + NTHR * i; pv[i] = *(const v4u*)(s.P + (size_t)(rb_ + (c_ >> 5)) * NINP + 4096 + head_ * 256 + (c_ & 31) * 8); } \
        _Pragma("unroll") for (int i = 0; i < 2; ++i) { const int c_ = tid + NTHR * i; pk[i] = *(const v4u*)(s.MQK + (size_t)(rb_ + (c_ >> 4)) * 1024 + 512 + head_ * 128 + (c_ & 15) * 8); } } while (0)
    if (bid < 544) ML_PREF(bid);
    for (int u = bid; u < 544; u += G) {
        int b, head, mm, rowbase; scan_unit(u, b, head, mm, rowbase);
#pragma unroll
        for (int i = 0; i < 4; ++i) { const int c_ = tid + NTHR * i; *(LAS v4u*)(Vs + (c_ >> 5) * 528 + (c_ & 31) * 16) = pv[i]; }
#pragma unroll
        for (int i = 0; i < 2; ++i) { const int c_ = tid + NTHR * i; *(LAS v4u*)(Kr + (c_ >> 4) * 272 + (c_ & 15) * 16) = pk[i]; }
        size_t ccd[2];
#pragma unroll
        for (int dir = 0; dir < 2; ++dir) ccd[dir] = (size_t)((b * 4 + head) * 2 + dir) * NCHUNK + scan_chunk(mm, dir);
        if (wave < 2) { const int dir = wave;
            const float ig = bf1(s.P[(size_t)(rowbase + lane) * NINP + 6144 + dir * 8 + head]) + s.mgb[dir * 8 + head];
            const float fg = bf1(s.P[(size_t)(rowbase + lane) * NINP + 6144 + dir * 8 + 4 + head]) + s.mgb[dir * 8 + 4 + head];
            const float lf = logsig_f(fg), bcs = wave_scan_sum(lf, dir, lane), blast = wave_sum(lf);
            const float gs = blast - bcs + ig, mloc = wave_max(gs);
            wv[dir * 64 + lane] = __expf(gs - mloc);
            if (lane == 0) { s.BL[ccd[dir]] = blast; s.ML[ccd[dir]] = mloc; } }
        __syncthreads();
        if (u + G < 544) ML_PREF(u + G);
        { float p0 = 0.f, p1 = 0.f;
#pragma unroll
          for (int tt = 0; tt < 16; ++tt) { const int t = 16 * grp + tt; const float kr = bf1(*(LAS const bf16*)(Kr + t * 272 + dk * 2)); const float k0 = kr * wv[t], k1 = kr * wv[64 + t];
              *(LAS bf16*)(Kh + t * 272 + dk * 2) = f2bf(k0); *(LAS bf16*)(Kh + 17408 + t * 272 + dk * 2) = f2bf(k1); p0 += k0; p1 += k1; }
          dnp[grp * 128 + dk] = p0; dnp[512 + grp * 128 + dk] = p1; }
        __syncthreads();
        if (tid < 256) { const int dir = tid >> 7, d_ = tid & 127; LAS const float* dp = dnp + dir * 512; s.DN[ccd[dir] * 128 + d_] = (dp[d_] + dp[128 + d_]) + (dp[256 + d_] + dp[384 + d_]); }
#pragma unroll
        for (int dir = 0; dir < 2; ++dir) {
            f32x16 acc[4];
#pragma unroll
            for (int nt = 0; nt < 4; ++nt) acc[nt] = zero16();
#pragma unroll
            for (int ks = 0; ks < 4; ++ks) { const bf16x8 af = frag_tr(Vs, 528, 16 * ks, 32 * wave, lane);
#pragma unroll
                for (int nt = 0; nt < 4; ++nt) { const bf16x8 bfr = frag_tr(Kh + dir * 17408, 272, 16 * ks, 32 * nt, lane); acc[nt] = MFMA32(af, bfr, acc[nt]); } }
            bf16* D = s.DSTp + ccd[dir] * 32768;
#pragma unroll
            for (int nt = 0; nt < 4; ++nt)
#pragma unroll
                for (int r = 0; r < 16; ++r) { const int dv = 32 * wave + (r & 3) + 8 * (r >> 2) + 4 * (lane >> 5); D[dv * 128 + 32 * nt + (lane & 31)] = f2bf(acc[nt][r]); }
        }
        __syncthreads();
    }
#undef ML_PREF
}

__device__ __forceinline__ void ph_gla_local(const ScanP& s, bf16* QT, bf16* KT, LAS unsigned char* lds, int tid, int lane, int wave, int bid, int G) {
    LAS unsigned char* Vs = lds; LAS unsigned char* Kh = lds + 33792; LAS unsigned char* Qr = lds + 51200; LAS unsigned char* Kr = lds + 68608;
    LAS float* glr = (LAS float*)(lds + 86016); LAS float* tot = (LAS float*)(lds + 90112);
    const int dk = tid & 127, grp = tid >> 7;
    v4u pv[4], pq[2], pk[2]; bf16 pg[2]; float pw[17];
#define GL_PREF(u_) do { const int dir_ = (u_) & 1; int b_, head_, mm_, rb_; scan_unit((u_) >> 1, b_, head_, mm_, rb_); const bf16* base_ = s.P + (size_t)rb_ * NINP; \
        _Pragma("unroll") for (int i = 0; i < 4; ++i) { const int c_ = tid + NTHR * i; pv[i] = *(const v4u*)(base_ + (size_t)(c_ >> 5) * NINP + 1024 + head_ * 256 + (c_ & 31) * 8); } \
        _Pragma("unroll") for (int i = 0; i < 2; ++i) { const int c_ = tid + NTHR * i; pq[i] = *(const v4u*)(base_ + (size_t)(c_ >> 4) * NINP + head_ * 128 + (c_ & 15) * 8); pk[i] = *(const v4u*)(base_ + (size_t)(c_ >> 4) * NINP + 512 + head_ * 128 + (c_ & 15) * 8); \
            pg[i] = base_[(size_t)(c_ >> 4) * NINP + 3072 + dir_ * 16 + (c_ & 15)]; } \
        _Pragma("unroll") for (int r_ = 0; r_ < 16; ++r_) pw[r_] = s.gw2[(dir_ * 16 + r_) * 512 + head_ * 128 + (tid & 127)]; pw[16] = s.gb[dir_ * 512 + head_ * 128 + (tid & 127)]; } while (0)
    if (bid < 1088) GL_PREF(bid);
    for (int u = bid; u < 1088; u += G) {
        const int dir = u & 1; int b, head, mm, rowbase; scan_unit(u >> 1, b, head, mm, rowbase);
        const int chain = (b * 4 + head) * 2 + dir, c = scan_chunk(mm, dir); const size_t cc = (size_t)chain * NCHUNK + c;
#pragma unroll
        for (int i = 0; i < 4; ++i) { const int c_ = tid + NTHR * i; *(LAS v4u*)(Vs + (c_ >> 5) * 528 + (c_ & 31) * 16) = pv[i]; }
#pragma unroll
        for (int i = 0; i < 2; ++i) { const int c_ = tid + NTHR * i; *(LAS v4u*)(Qr + (c_ >> 4) * 272 + (c_ & 15) * 16) = pq[i]; *(LAS v4u*)(Kr + (c_ >> 4) * 272 + (c_ & 15) * 16) = pk[i]; glr[c_] = bf1(pg[i]); }
        __syncthreads();
        float bb[16], btot;
        { float w2[16];
#pragma unroll
          for (int r = 0; r < 16; ++r) w2[r] = pw[r];
          const float bias = pw[16];
#pragma unroll
          for (int tt = 0; tt < 16; ++tt) { const int t = 16 * grp + tt; float z = bias;
#pragma unroll
              for (int r = 0; r < 16; ++r) z += glr[t * 16 + r] * w2[r];
              bb[tt] = logsig_f(z) * 0.0625f; }
          if (dir == 0) {
#pragma unroll
              for (int tt = 1; tt < 16; ++tt) bb[tt] += bb[tt - 1];
              tot[grp * 128 + dk] = bb[15];
          } else {
#pragma unroll
              for (int tt = 14; tt >= 0; --tt) bb[tt] += bb[tt + 1];
              tot[grp * 128 + dk] = bb[0];
          }
          __syncthreads();
          float off = 0.f; btot = 0.f;
#pragma unroll
          for (int g = 0; g < 4; ++g) { const float tv = tot[g * 128 + dk]; btot += tv; if (dir == 0 ? g < grp : g > grp) off += tv; }
#pragma unroll
          for (int tt = 0; tt < 16; ++tt) bb[tt] += off; }
        if (u + G < 1088) GL_PREF(u + G);
#pragma unroll
        for (int tt = 0; tt < 16; ++tt) { const int t = 16 * grp + tt;
            const float qv = bf1(*(LAS const bf16*)(Qr + t * 272 + dk * 2)), kv = bf1(*(LAS const bf16*)(Kr + t * 272 + dk * 2));
            const float e1 = __expf(bb[tt]);
            *(LAS bf16*)(Kh + t * 272 + dk * 2) = f2bf(kv * __expf(btot - bb[tt]));
            *(LAS bf16*)(Qr + t * 272 + dk * 2) = f2bf(qv * e1 * 0.08838834764831845f); *(LAS bf16*)(Kr + t * 272 + dk * 2) = f2bf(kv * __builtin_amdgcn_rcpf(e1)); }
        if (grp == 0) s.GAM[cc * 128 + dk] = __expf(btot);
        __syncthreads();
        store_tile(QT + ((size_t)dir * MR + rowbase) * 512 + head * 128, 512, Qr, 272, 64, 128, tid);
        store_tile(KT + ((size_t)dir * MR + rowbase) * 512 + head * 128, 512, Kr, 272, 64, 128, tid);
        f32x16 acc[4];
#pragma unroll
        for (int nt = 0; nt < 4; ++nt) acc[nt] = zero16();
#pragma unroll
        for (int ks = 0; ks < 4; ++ks) { const bf16x8 af = frag_tr(Vs, 528, 16 * ks, 32 * wave, lane);
#pragma unroll
            for (int nt = 0; nt < 4; ++nt) { const bf16x8 bfr = frag_tr(Kh, 272, 16 * ks, 32 * nt, lane); acc[nt] = MFMA32(af, bfr, acc[nt]); } }
        bf16* D = s.DSTp + cc * 32768;
#pragma unroll
        for (int nt = 0; nt < 4; ++nt)
#pragma unroll
            for (int r = 0; r < 16; ++r) { const int dv = 32 * wave + (r & 3) + 8 * (r >> 2) + 4 * (lane >> 5); D[dv * 128 + 32 * nt + (lane & 31)] = f2bf(acc[nt][r]); }
        __syncthreads();
    }
}
#undef GL_PREF
__device__ __forceinline__ void ph_gla_out(const ScanP& s, const bf16* QT, const bf16* KT, LAS unsigned char* lds, int tid, int lane, int wave, int bid, int G) {
    LAS unsigned char* Vs = lds;
    LAS unsigned char* Qx = lds + 33792;
    LAS unsigned char* Ki = lds + 68608;
    LAS unsigned char* Am = lds + 103424;
    LAS float* Os = (LAS float*)lds;
    v4u pv[4], pq[2][2], pk[2][2];
#define GO_PREF(u_) do { int b_, head_, mm_, rb_; scan_unit((u_), b_, head_, mm_, rb_); \
        _Pragma("unroll") for (int i = 0; i < 4; ++i) { const int c_ = tid + NTHR * i; pv[i] = *(const v4u*)(s.P + (size_t)(rb_ + (c_ >> 5)) * NINP + 1024 + head_ * 256 + (c_ & 31) * 8); } \
        _Pragma("unroll") for (int d_ = 0; d_ < 2; ++d_) _Pragma("unroll") for (int i = 0; i < 2; ++i) { const int c_ = tid + NTHR * i; const size_t o_ = ((size_t)d_ * MR + rb_ + (c_ >> 4)) * 512 + head_ * 128 + (c_ & 15) * 8; \
            pq[d_][i] = *(const v4u*)(QT + o_); pk[d_][i] = *(const v4u*)(KT + o_); } } while (0)
    if (bid < 544) GO_PREF(bid);
    for (int u = bid; u < 544; u += G) {
        int b, head, mm, rowbase; scan_unit(u, b, head, mm, rowbase);
#pragma unroll
        for (int i = 0; i < 4; ++i) { const int c_ = tid + NTHR * i; *(LAS v4u*)(Vs + (c_ >> 5) * 528 + (c_ & 31) * 16) = pv[i]; }
#pragma unroll
        for (int d_ = 0; d_ < 2; ++d_)
#pragma unroll
            for (int i = 0; i < 2; ++i) { const int c_ = tid + NTHR * i; *(LAS v4u*)(Qx + d_ * 17408 + (c_ >> 4) * 272 + (c_ & 15) * 16) = pq[d_][i]; *(LAS v4u*)(Ki + d_ * 17408 + (c_ >> 4) * 272 + (c_ & 15) * 16) = pk[d_][i]; }
        v4u gp[4];
#pragma unroll
        for (int j = 0; j < 4; ++j) gp[j] = *(const v4u*)(s.P + (size_t)(rowbase + (tid >> 3)) * NINP + 2048 + head * 256 + 32 * (tid & 7) + 8 * j);
        bf16x8 sf[2][8];
#pragma unroll
        for (int dir = 0; dir < 2; ++dir) { const int chain = (b * 4 + head) * 2 + dir, c = scan_chunk(mm, dir); const size_t cc = (size_t)chain * NCHUNK + c;
            const bf16* Sg = s.SSTp + cc * 32768 + (size_t)(32 * wave + (lane & 31)) * 128 + 8 * (lane >> 5);
#pragma unroll
            for (int ks = 0; ks < 8; ++ks) sf[dir][ks] = *(const bf16x8*)(Sg + 16 * ks); }
        __syncthreads();
        if (u + G < 544) GO_PREF(u + G);
        {
            const int dir = wave >> 2, ti = (wave >> 1) & 1, tj = wave & 1; f32x16 acc = zero16();
#pragma unroll
            for (int ks = 0; ks < 8; ++ks) { const bf16x8 af = frag_row(Qx + dir * 17408, 272, 32 * ti, 16 * ks, lane), bfr = frag_row(Ki + dir * 17408, 272, 32 * tj, 16 * ks, lane); acc = MFMA32(af, bfr, acc); }
            const int sidx = 32 * tj + (lane & 31);
#pragma unroll
            for (int r = 0; r < 16; ++r) { const int t = 32 * ti + (r & 3) + 8 * (r >> 2) + 4 * (lane >> 5);
                const bool keep = dir == 0 ? (sidx <= t) : (sidx >= t);
                *(LAS bf16*)(Am + dir * 9216 + t * 144 + sidx * 2) = f2bf(keep ? acc[r] : 0.f); }
        }
        __syncthreads();
        f32x16 acc2[2]; acc2[0] = zero16(); acc2[1] = zero16();
#pragma unroll
        for (int dir = 0; dir < 2; ++dir) {
#pragma unroll
            for (int ks = 0; ks < 8; ++ks)
#pragma unroll
                for (int rt = 0; rt < 2; ++rt) { const bf16x8 af = frag_row(Qx + dir * 17408, 272, 32 * rt, 16 * ks, lane); acc2[rt] = MFMA32(af, sf[dir][ks], acc2[rt]); }
#pragma unroll
            for (int ks = 0; ks < 4; ++ks) { const bf16x8 bfr = frag_tr(Vs, 528, 16 * ks, 32 * wave, lane);
#pragma unroll
                for (int rt = 0; rt < 2; ++rt) { const bf16x8 af = frag_row(Am + dir * 9216, 144, 32 * rt, 16 * ks, lane); acc2[rt] = MFMA32(af, bfr, acc2[rt]); } }
        }
        __syncthreads();
#pragma unroll
        for (int rt = 0; rt < 2; ++rt)
#pragma unroll
            for (int r = 0; r < 16; ++r) { const int t = 32 * rt + (r & 3) + 8 * (r >> 2) + 4 * (lane >> 5); Os[t * 260 + 32 * wave + (lane & 31)] = acc2[rt][r]; }
        __syncthreads();
        { const int t = tid >> 3, part = tid & 7; float o[32]; float ss = 0.f;
#pragma unroll
          for (int j = 0; j < 8; ++j) { const f32x4 v = *(LAS const f32x4*)(Os + t * 260 + 32 * part + 4 * j); o[4 * j] = v.x; o[4 * j + 1] = v.y; o[4 * j + 2] = v.z; o[4 * j + 3] = v.w; ss += (v.x * v.x + v.y * v.y) + (v.z * v.z + v.w * v.w); }
          ss += __shfl_xor(ss, 1); ss += __shfl_xor(ss, 2); ss += __shfl_xor(ss, 4);
          const float rn = rsqrtf(ss * (1.f / 256.f) + EPS);
          const size_t row = (size_t)(rowbase + t);
          bf16* dst = s.MIX + row * DM + head * 256 + 32 * part;
#pragma unroll
          for (int j = 0; j < 4; ++j) { float gv[8], ov[8]; unpack8(gp[j], gv);
#pragma unroll
              for (int e = 0; e < 8; ++e) ov[e] = o[8 * j + e] * rn * s.ng[32 * part + 8 * j + e] * silu_f(gv[e]);
              *(v4u*)(dst + 8 * j) = pack8(ov); } }
        __syncthreads();
    }
}

#undef GO_PREF
__device__ __forceinline__ void ph_mlstm_out(const ScanP& s, LAS unsigned char* lds, int tid, int lane, int wave, int bid, int G, int skip_ctx, unsigned* qhead) {
    LAS unsigned char* Vs = lds; LAS unsigned char* Qi = lds + 33792; LAS unsigned char* Ki = lds + 51200; LAS unsigned char* Qx = lds + 68608; LAS unsigned char* Am = lds + 103424;
    LAS float* sc = (LAS float*)(lds + 121856);
    LAS float* qnp = (LAS float*)(lds + 125952);
    LAS float* Os = (LAS float*)lds;
    v4u pv[4], pq[2], pk[2];
#define MO_UNIT(u_) (skip_ctx ? ((u_) >> 6) * 68 + 4 + ((u_) & 63) : (u_))
#define MO_PREF(u_) do { int b_, head_, mm_, rb_; scan_unit(MO_UNIT(u_), b_, head_, mm_, rb_); \
        _Pragma("unroll") for (int i = 0; i < 4; ++i) { const int c_ = tid + NTHR * i; pv[i] = *(const v4u*)(s.P + (size_t)(rb_ + (c_ >> 5)) * NINP + 4096 + head_ * 256 + (c_ & 31) * 8); } \
        _Pragma("unroll") for (int i = 0; i < 2; ++i) { const int c_ = tid + NTHR * i; const size_t o_ = (size_t)(rb_ + (c_ >> 4)) * 1024 + head_ * 128 + (c_ & 15) * 8; pq[i] = *(const v4u*)(s.MQK + o_); pk[i] = *(const v4u*)(s.MQK + o_ + 512); } } while (0)
    const int nu = skip_ctx ? 512 : 544;
    volatile LAS int* qs = (volatile LAS int*)(lds + MISC_OFF + 104);
    if (tid == 0) qs[0] = (int)__hip_atomic_fetch_add(qhead, 1u, __ATOMIC_RELAXED, __HIP_MEMORY_SCOPE_AGENT);
    __syncthreads();
    int u = qs[0], par = 0;
    if (u < nu) MO_PREF(u);
    for (; u < nu; par ^= 1) {
        if (tid == 0) qs[par ^ 1] = (int)__hip_atomic_fetch_add(qhead, 1u, __ATOMIC_RELAXED, __HIP_MEMORY_SCOPE_AGENT);
        int b, head, mm, rowbase; scan_unit(MO_UNIT(u), b, head, mm, rowbase);
#pragma unroll
        for (int i = 0; i < 4; ++i) { const int c_ = tid + NTHR * i; *(LAS v4u*)(Vs + (c_ >> 5) * 528 + (c_ & 31) * 16) = pv[i]; }
#pragma unroll
        for (int i = 0; i < 2; ++i) { const int c_ = tid + NTHR * i; *(LAS v4u*)(Qi + (c_ >> 4) * 272 + (c_ & 15) * 16) = pq[i]; *(LAS v4u*)(Ki + (c_ >> 4) * 272 + (c_ & 15) * 16) = pk[i]; }
        size_t ccd[2];
#pragma unroll
        for (int dir = 0; dir < 2; ++dir) ccd[dir] = (size_t)((b * 4 + head) * 2 + dir) * NCHUNK + scan_chunk(mm, dir);
        v4u gp[4];
#pragma unroll
        for (int j = 0; j < 4; ++j) gp[j] = *(const v4u*)(s.P + (size_t)(rowbase + (tid >> 3)) * NINP + 5120 + head * 256 + 32 * (tid & 7) + 8 * j);
        bf16x8 sf[2][8];
#pragma unroll
        for (int dir = 0; dir < 2; ++dir) { const bf16* Sg = s.SSTp + ccd[dir] * 32768 + (size_t)(32 * wave + (lane & 31)) * 128 + 8 * (lane >> 5);
#pragma unroll
            for (int ks = 0; ks < 8; ++ks) sf[dir][ks] = *(const bf16x8*)(Sg + 16 * ks); }
        if (wave < 2) { const int dir = wave; LAS float* d = sc + dir * 512;
            const float ig = bf1(s.P[(size_t)(rowbase + lane) * NINP + 6144 + dir * 8 + head]) + s.mgb[dir * 8 + head];
            const float fg = bf1(s.P[(size_t)(rowbase + lane) * NINP + 6144 + dir * 8 + 4 + head]) + s.mgb[dir * 8 + 4 + head];
            const float lf = logsig_f(fg), bcs = wave_scan_sum(lf, dir, lane);
            const float uu = ig - bcs, pm = wave_scan_max(uu, dir, lane), min_ = s.MINp[ccd[dir]], Mt = fmaxf(min_, pm);
            d[lane] = uu; d[64 + lane] = Mt; d[128 + lane] = __expf(min_ - Mt); d[192 + lane] = __expf(-bcs - Mt); }
        __syncthreads();
        const int un = qs[par ^ 1];
        if (un < nu) MO_PREF(un);
        { const int t = tid & 63, part = tid >> 6;
          float a0 = 0.f, a1 = 0.f; const float w0 = sc[128 + t], w1 = sc[512 + 128 + t];
#pragma unroll
          for (int hh = 0; hh < 2; ++hh) { float qv[8], o0[8], o1[8]; unpack8(*(LAS const v4u*)(Qi + t * 272 + (part * 16 + 8 * hh) * 2), qv);
              const float* n0p = s.NIN + ccd[0] * 128 + part * 16 + 8 * hh; const float* n1p = s.NIN + ccd[1] * 128 + part * 16 + 8 * hh;
              const f32x4 n00 = *(const f32x4*)n0p, n01 = *(const f32x4*)(n0p + 4), n10 = *(const f32x4*)n1p, n11 = *(const f32x4*)(n1p + 4);
              a0 += (qv[0] * n00.x + qv[1] * n00.y) + (qv[2] * n00.z + qv[3] * n00.w) + (qv[4] * n01.x + qv[5] * n01.y) + (qv[6] * n01.z + qv[7] * n01.w);
              a1 += (qv[0] * n10.x + qv[1] * n10.y) + (qv[2] * n10.z + qv[3] * n10.w) + (qv[4] * n11.x + qv[5] * n11.y) + (qv[6] * n11.z + qv[7] * n11.w);
#pragma unroll
              for (int e = 0; e < 8; ++e) { o0[e] = qv[e] * w0; o1[e] = qv[e] * w1; }
              *(LAS v4u*)(Qx + t * 272 + (part * 16 + 8 * hh) * 2) = pack8(o0); *(LAS v4u*)(Qx + 17408 + t * 272 + (part * 16 + 8 * hh) * 2) = pack8(o1); }
          qnp[part * 64 + t] = a0; qnp[512 + part * 64 + t] = a1; }
        {
            const int dir = wave >> 2, ti = (wave >> 1) & 1, tj = wave & 1; LAS const float* d = sc + dir * 512; f32x16 acc = zero16();
#pragma unroll
            for (int ks = 0; ks < 8; ++ks) { const bf16x8 af = frag_row(Qi, 272, 32 * ti, 16 * ks, lane), bfr = frag_row(Ki, 272, 32 * tj, 16 * ks, lane); acc = MFMA32(af, bfr, acc); }
            const int sidx = 32 * tj + (lane & 31); const float usv = d[sidx];
#pragma unroll
            for (int r = 0; r < 16; ++r) { const int t = 32 * ti + (r & 3) + 8 * (r >> 2) + 4 * (lane >> 5);
                const bool keep = dir == 0 ? (sidx <= t) : (sidx >= t);
                const float v = keep ? acc[r] * __expf(usv - d[64 + t]) : 0.f;
                *(LAS bf16*)(Am + dir * 9216 + t * 144 + sidx * 2) = f2bf(v);
                float rsum = v; rsum += __shfl_xor(rsum, 1); rsum += __shfl_xor(rsum, 2); rsum += __shfl_xor(rsum, 4); rsum += __shfl_xor(rsum, 8); rsum += __shfl_xor(rsum, 16);
                if ((lane & 31) == 0) (sc + dir * 512)[384 + tj * 64 + t] = rsum; }
        }
        __syncthreads();
        if (tid < 128) { const int dir = tid >> 6, t = tid & 63; LAS float* d = sc + dir * 512; float q = 0.f;
#pragma unroll
            for (int p = 0; p < 8; ++p) q += qnp[dir * 512 + p * 64 + t];
            const float den = d[128 + t] * q + d[384 + t] + d[448 + t]; d[256 + t] = 1.f / fmaxf(fabsf(den), d[192 + t]); }
        f32x16 ad[2][2];
#pragma unroll
        for (int dir = 0; dir < 2; ++dir) { ad[dir][0] = zero16(); ad[dir][1] = zero16();
#pragma unroll
            for (int ks = 0; ks < 8; ++ks)
#pragma unroll
                for (int rt = 0; rt < 2; ++rt) { const bf16x8 af = frag_row(Qx + dir * 17408, 272, 32 * rt, 16 * ks, lane); ad[dir][rt] = MFMA32(af, sf[dir][ks], ad[dir][rt]); }
#pragma unroll
            for (int ks = 0; ks < 4; ++ks) { const bf16x8 bfr = frag_tr(Vs, 528, 16 * ks, 32 * wave, lane);
#pragma unroll
                for (int rt = 0; rt < 2; ++rt) { const bf16x8 af = frag_row(Am + dir * 9216, 144, 32 * rt, 16 * ks, lane); ad[dir][rt] = MFMA32(af, bfr, ad[dir][rt]); } } }
        __syncthreads();
#pragma unroll
        for (int rt = 0; rt < 2; ++rt)
#pragma unroll
            for (int r = 0; r < 16; ++r) { const int t = 32 * rt + (r & 3) + 8 * (r >> 2) + 4 * (lane >> 5); ad[0][rt][r] = ad[0][rt][r] * sc[256 + t] + ad[1][rt][r] * sc[512 + 256 + t]; }
        __syncthreads();
#pragma unroll
        for (int rt = 0; rt < 2; ++rt)
#pragma unroll
            for (int r = 0; r < 16; ++r) { const int t = 32 * rt + (r & 3) + 8 * (r >> 2) + 4 * (lane >> 5); Os[t * 260 + 32 * wave + (lane & 31)] = ad[0][rt][r]; }
        __syncthreads();
        { const int t = tid >> 3, part = tid & 7; float o[32]; float ss = 0.f;
#pragma unroll
          for (int j = 0; j < 8; ++j) { const f32x4 v = *(LAS const f32x4*)(Os + t * 260 + 32 * part + 4 * j); o[4 * j] = v.x; o[4 * j + 1] = v.y; o[4 * j + 2] = v.z; o[4 * j + 3] = v.w; ss += (v.x * v.x + v.y * v.y) + (v.z * v.z + v.w * v.w); }
          ss += __shfl_xor(ss, 1); ss += __shfl_xor(ss, 2); ss += __shfl_xor(ss, 4);
          const float rn = rsqrtf(ss * (1.f / 256.f) + EPS);
          const size_t row = (size_t)(rowbase + t);
          bf16* dst = s.MIX + row * DM + 1024 + head * 256 + 32 * part;
#pragma unroll
          for (int j = 0; j < 4; ++j) { float gv[8], ov[8]; unpack8(gp[j], gv);
#pragma unroll
              for (int e = 0; e < 8; ++e) ov[e] = o[8 * j + e] * rn * s.ng[32 * part + 8 * j + e] * sigmoid_f(gv[e]);
              *(v4u*)(dst + 8 * j) = pack8(ov); } }
        __syncthreads();
        u = un;
    }
}

#undef MO_PREF
#undef MO_UNIT
template <int MODE>
__device__ __forceinline__ void ph_scan_carry(const ScanP& s, int gtid, int NT) {
    for (int e = gtid; e < 16 * 8192; e += NT) {
        const int chain = e >> 13, rem = e & 8191, dv = rem >> 5, dk = (rem & 31) * 4;
        f32x4 st = {0.f, 0.f, 0.f, 0.f}, nst = st; float m = 0.f;
        for (int c0 = 0; c0 < NCHUNK; c0 += 4) {
            f32x4 d[4], gm[4]; float bl[4], ml[4];
#pragma unroll
            for (int j = 0; j < 4; ++j) { const size_t cc = (size_t)chain * NCHUNK + c0 + j; { const v2u dw = *(const v2u*)(s.DSTp + cc * 32768 + dv * 128 + dk); d[j] = (f32x4){bf_lo(dw.x), bf_hi(dw.x), bf_lo(dw.y), bf_hi(dw.y)}; }
                if (MODE == 0) gm[j] = *(const f32x4*)(s.GAM + cc * 128 + dk);
                else { bl[j] = s.BL[cc]; ml[j] = s.ML[cc]; gm[j] = (dv == 0) ? *(const f32x4*)(s.DN + cc * 128 + dk) : (f32x4){0.f, 0.f, 0.f, 0.f}; } }
#pragma unroll
            for (int j = 0; j < 4; ++j) { const size_t cc = (size_t)chain * NCHUNK + c0 + j;
                v2u o; o.x = pk2(st.x, st.y); o.y = pk2(st.z, st.w); *(v2u*)(s.SSTp + cc * 32768 + dv * 128 + dk) = o;
                if (MODE == 0) st = gm[j] * st + d[j];
                else { if (dv == 0) { *(f32x4*)(s.NIN + cc * 128 + dk) = nst; if (dk == 0) s.MINp[cc] = m; }
                    const float mn = fmaxf(bl[j] + m, ml[j]), dec = __expf(bl[j] + m - mn), sc = __expf(ml[j] - mn);
                    st = st * dec + d[j] * sc; nst = nst * dec + gm[j] * sc; m = mn; } }
        }
    }
}

template <int MODE>
__device__ __forceinline__ void ph_scan_out(const ScanP& s, LAS unsigned char* lds, int tid, int lane, int wave, int bid, int G) {
    LAS unsigned char* Vs = lds; LAS unsigned char* Qx = lds + 33792; LAS unsigned char* Ki = lds + 51200; LAS unsigned char* Qi = lds + 68608; LAS unsigned char* Am = lds + 86016;
    LAS float* glr = (LAS float*)(lds + 95232); LAS float* tot = (LAS float*)(lds + 103424);
    LAS float* us = (LAS float*)(lds + 105472); LAS float* Mts = us + 64; LAS float* wint = us + 128; LAS float* thr = us + 192; LAS float* fac = us + 256; LAS float* qn = us + 320; LAS float* rs = us + 384;
    LAS float* qnp = (LAS float*)(lds + 107520);
    LAS float* Os = (LAS float*)lds;
    const int dk = tid & 127, grp = tid >> 7;
    for (int u = bid; u < 544; u += G) {
        int b, head, mm, rowbase; scan_unit(u, b, head, mm, rowbase);
        load_tile(Vs, 528, s.P + (size_t)rowbase * NINP + (MODE ? 4096 : 1024) + head * 256, NINP, 64, 256, tid);
        if (MODE == 0) { for (int e = tid; e < 2048; e += NTHR) glr[e] = bf1(s.P[(size_t)(rowbase + (e >> 5)) * NINP + 3072 + (e & 31)]); if (tid < 64) fac[tid] = 1.f; }
        else { load_tile(Qi, 272, s.MQK + (size_t)rowbase * 1024 + head * 128, 1024, 64, 128, tid); load_tile(Ki, 272, s.MQK + (size_t)rowbase * 1024 + 512 + head * 128, 1024, 64, 128, tid); }
        f32x16 hsum[2]; hsum[0] = zero16(); hsum[1] = zero16();
        __syncthreads();
        for (int dir = 0; dir < 2; ++dir) {
            const int chain = (b * 4 + head) * 2 + dir, c = scan_chunk(mm, dir); const size_t cc = (size_t)chain * NCHUNK + c;
            if (MODE == 0) {
                float bb[16], btot; gla_gates(s, glr, tot, head, dir, tid, bb, btot);
#pragma unroll
                for (int tt = 0; tt < 16; ++tt) { const int t = 16 * grp + tt; const size_t ro = (size_t)(rowbase + t) * NINP + head * 128 + dk;
                    const float qv = bf1(s.P[ro]), kv = bf1(s.P[ro + 512]);
                    *(LAS bf16*)(Qx + t * 272 + dk * 2) = f2bf(qv * __expf(bb[tt]) * 0.08838834764831845f);
                    *(LAS bf16*)(Ki + t * 272 + dk * 2) = f2bf(kv * __expf(-bb[tt])); }
            } else {
                if (wave == 0) {
                    const float ig = bf1(s.P[(size_t)(rowbase + lane) * NINP + 6144 + dir * 8 + head]) + s.mgb[dir * 8 + head];
                    const float fg = bf1(s.P[(size_t)(rowbase + lane) * NINP + 6144 + dir * 8 + 4 + head]) + s.mgb[dir * 8 + 4 + head];
                    const float lf = logsig_f(fg), bcs = wave_scan_sum(lf, dir, lane);
                    const float uu = ig - bcs, pm = wave_scan_max(uu, dir, lane), min_ = s.MINp[cc], Mt = fmaxf(min_, pm);
                    us[lane] = uu; Mts[lane] = Mt; wint[lane] = __expf(min_ - Mt); thr[lane] = __expf(-bcs - Mt);
                }
                __syncthreads();
                { const int t = tid & 63, part = tid >> 6; float acc = 0.f;
                  const float wi = wint[t];
#pragma unroll
                  for (int hh = 0; hh < 2; ++hh) { float qv[8], ov[8]; unpack8(*(LAS const v4u*)(Qi + t * 272 + (part * 16 + 8 * hh) * 2), qv);
                      const f32x4 n0 = *(const f32x4*)(s.NIN + cc * 128 + part * 16 + 8 * hh), n1 = *(const f32x4*)(s.NIN + cc * 128 + part * 16 + 8 * hh + 4);
                      acc += (qv[0] * n0.x + qv[1] * n0.y) + (qv[2] * n0.z + qv[3] * n0.w) + (qv[4] * n1.x + qv[5] * n1.y) + (qv[6] * n1.z + qv[7] * n1.w);
#pragma unroll
                      for (int e = 0; e < 8; ++e) ov[e] = qv[e] * wi;
                      *(LAS v4u*)(Qx + t * 272 + (part * 16 + 8 * hh) * 2) = pack8(ov); }
                  qnp[part * 64 + t] = acc; }
            }
            __syncthreads();
            if (MODE == 1 && tid < 64) { float q = 0.f;
#pragma unroll
                for (int p = 0; p < 8; ++p) q += qnp[p * 64 + tid];
                qn[tid] = q; }
            if (wave < 4) {
                const int ti = wave >> 1, tj = wave & 1; f32x16 acc = zero16();
#pragma unroll
                for (int ks = 0; ks < 8; ++ks) { const bf16x8 af = frag_row(MODE ? Qi : Qx, 272, 32 * ti, 16 * ks, lane), bfr = frag_row(Ki, 272, 32 * tj, 16 * ks, lane); acc = MFMA32(af, bfr, acc); }
                const int sidx = 32 * tj + (lane & 31);
                const float usv = MODE ? us[sidx] : 0.f;
#pragma unroll
                for (int r = 0; r < 16; ++r) { const int t = 32 * ti + (r & 3) + 8 * (r >> 2) + 4 * (lane >> 5);
                    const bool keep = dir == 0 ? (sidx <= t) : (sidx >= t);
                    float v = acc[r];
                    if (MODE == 1) v *= __expf(usv - Mts[t]);
                    v = keep ? v : 0.f;
                    *(LAS bf16*)(Am + t * 144 + sidx * 2) = f2bf(v);
                    if (MODE == 1) { float rsum = v; rsum += __shfl_xor(rsum, 1); rsum += __shfl_xor(rsum, 2); rsum += __shfl_xor(rsum, 4); rsum += __shfl_xor(rsum, 8); rsum += __shfl_xor(rsum, 16);
                        if ((lane & 31) == 0) rs[tj * 64 + t] = rsum; } }
            }
            __syncthreads();
            if (MODE == 1 && tid < 64) { const float den = wint[tid] * qn[tid] + rs[tid] + rs[64 + tid]; fac[tid] = 1.f / fmaxf(fabsf(den), thr[tid]); }
            f32x16 acc2[2]; acc2[0] = zero16(); acc2[1] = zero16();
            { const bf16* Sg = s.SSTp + cc * 32768 + (size_t)(32 * wave + (lane & 31)) * 128 + 8 * (lane >> 5);
#pragma unroll
              for (int ks = 0; ks < 8; ++ks) { const bf16x8 bfr = *(const bf16x8*)(Sg + 16 * ks);
#pragma unroll
                  for (int rt = 0; rt < 2; ++rt) { const bf16x8 af = frag_row(Qx, 272, 32 * rt, 16 * ks, lane); acc2[rt] = MFMA32(af, bfr, acc2[rt]); } } }
#pragma unroll
            for (int ks = 0; ks < 4; ++ks) { const bf16x8 bfr = frag_tr(Vs, 528, 16 * ks, 32 * wave, lane);
#pragma unroll
                for (int rt = 0; rt < 2; ++rt) { const bf16x8 af = frag_row(Am, 144, 32 * rt, 16 * ks, lane); acc2[rt] = MFMA32(af, bfr, acc2[rt]); } }
            __syncthreads();
#pragma unroll
            for (int rt = 0; rt < 2; ++rt)
#pragma unroll
                for (int r = 0; r < 16; ++r) { const int t = 32 * rt + (r & 3) + 8 * (r >> 2) + 4 * (lane >> 5); hsum[rt][r] += acc2[rt][r] * fac[t]; }
        }
        __syncthreads();
#pragma unroll
        for (int rt = 0; rt < 2; ++rt)
#pragma unroll
            for (int r = 0; r < 16; ++r) { const int t = 32 * rt + (r & 3) + 8 * (r >> 2) + 4 * (lane >> 5); Os[t * 260 + 32 * wave + (lane & 31)] = hsum[rt][r]; }
        __syncthreads();
        { const int t = tid >> 3, part = tid & 7; float o[32]; float ss = 0.f;
#pragma unroll
          for (int j = 0; j < 8; ++j) { const f32x4 v = *(LAS const f32x4*)(Os + t * 260 + 32 * part + 4 * j); o[4 * j] = v.x; o[4 * j + 1] = v.y; o[4 * j + 2] = v.z; o[4 * j + 3] = v.w; ss += (v.x * v.x + v.y * v.y) + (v.z * v.z + v.w * v.w); }
          ss += __shfl_xor(ss, 1); ss += __shfl_xor(ss, 2); ss += __shfl_xor(ss, 4);
          const float rn = rsqrtf(ss * (1.f / 256.f) + EPS);
          const size_t row = (size_t)(rowbase + t);
          const bf16* gsrc = s.P + row * NINP + (MODE ? 5120 : 2048) + head * 256 + 32 * part;
          bf16* dst = s.MIX + row * DM + (MODE ? 1024 : 0) + head * 256 + 32 * part;
#pragma unroll
          for (int j = 0; j < 4; ++j) { float gv[8], ov[8]; unpack8(*(const v4u*)(gsrc + 8 * j), gv);
#pragma unroll
              for (int e = 0; e < 8; ++e) { const float gt = MODE ? sigmoid_f(gv[e]) : silu_f(gv[e]); ov[e] = o[8 * j + e] * rn * s.ng[32 * part + 8 * j + e] * gt; }
              *(v4u*)(dst + 8 * j) = pack8(ov); } }
        __syncthreads();
    }
}

__device__ __forceinline__ void glds16(const void* sbase  , unsigned voff  , unsigned lds_dst  ) { unsigned keep;
    asm volatile("s_mov_b32 %0, m0\n\ts_mov_b32 m0, %3\n\ts_nop 0\n\tglobal_load_lds_dwordx4 %1, %2\n\ts_mov_b32 m0, %0" : "=&s"(keep) : "v"(voff), "s"(sbase), "s"(lds_dst) : "memory"); }
struct AttnP { const bf16* QR; const bf16* KR; const bf16* P; bf16* MIX; const float* lamp; const float* subg; const float* qg; const float* kg; float lam_init; unsigned* queue; int nq; };
template <bool SUB>
__device__ __forceinline__ void ph_attn(const AttnP& p, LAS unsigned char* lds, int tid, int lane, int wave, int bid, int G) {
    const float l01 = wave_sum(p.lamp[lane] * p.lamp[64 + lane]), l23 = wave_sum(p.lamp[128 + lane] * p.lamp[192 + lane]);
    const float lam = __expf(l01) - __expf(l23) + p.lam_init;
    const float negm2 = -8.f * wave_max(fabsf(p.qg[lane])) * wave_max(fabsf(p.kg[lane])) * 1.4426950408889634f * 1.02f;
    const int r = lane & 31, h = lane >> 5, mp = wave >> 2, wq = wave & 3;
    LAS float* Ex = (LAS float*)lds;
    const unsigned xcc = xb_xcc_id() & 7u;
    volatile LAS int* qslot = (volatile LAS int*)(lds + MISC_OFF + 96);
    for (int qq = 0; qq < 8; ++qq) for (;;) {
        const int hd = (int)((xcc + (unsigned)qq) & 7u);
        if (tid == 0) qslot[0] = (int)__hip_atomic_fetch_add(p.queue + 16 * hd, 1u, __ATOMIC_RELAXED, __HIP_MEMORY_SCOPE_AGENT);
        __syncthreads();
        const int idx = qslot[0];
        __syncthreads();
        if (idx >= p.nq) break;
        int b, qrow0, nkt;
        if (idx < 64) { b = idx >> 5; qrow0 = b * 4096 + 128 * (idx & 31); nkt = 68; }
        else { const int uu = idx - 64; b = uu >> 1; qrow0 = NLATR + b * 256 + 128 * (uu & 1); nkt = 4; }
        const int qrow = qrow0 + 32 * wq + r;
        bf16x8 Qf[4];
#pragma unroll
        for (int ks = 0; ks < 4; ++ks) Qf[ks] = *(const bf16x8*)(p.QR + (size_t)qrow * 1024 + (hd * 2 + mp) * 64 + 16 * ks + 8 * h);
        f32x16 O[4];
#pragma unroll
        for (int dt = 0; dt < 4; ++dt) O[dt] = zero16();
        float ls = 0.f;
        const int dq = lane >> 4, dp = lane & 15;
        unsigned voffK[4], voffV[4];
#pragma unroll
        for (int j = 0; j < 4; ++j) { const unsigned ch = 16u * (unsigned)(dp ^ ((dq << 2) | j)); voffK[j] = (unsigned)dq * 2048u + ch; voffV[j] = (unsigned)dq * (unsigned)(NINP * 2) + ch; }
        int kaddr[4], vaddr[2][4];
#pragma unroll
        for (int ks = 0; ks < 4; ++ks) kaddr[ks] = swz_off(r, 8 * mp + 2 * ks + h);
        { const int blk = (lane >> 4) & 1, q = (lane & 15) >> 2, pp = lane & 3;
#pragma unroll
          for (int e = 0; e < 2; ++e)
#pragma unroll
              for (int dt = 0; dt < 4; ++dt) vaddr[e][dt] = swz_off(4 * h + q + 8 * e, 4 * dt + 2 * blk + (pp >> 1)) + 8 * (pp & 1); }
        const int nkt2 = nkt >> 1;
        const unsigned ldsb = (unsigned)(size_t)lds;
#define AT_DMA(kt_, buf_) do { const int krow_ = (kt_) < 2 ? NLATR + b * 256 + 128 * (kt_) : b * 4096 + 128 * ((kt_) - 2); \
            _Pragma("unroll") for (int j = 0; j < 4; ++j) { const int g_ = 4 * wave + j, row_ = krow_ + 4 * g_; \
                glds16(p.KR + (size_t)row_ * 1024 + hd * 128, voffK[j], (unsigned)__builtin_amdgcn_readfirstlane((int)(ldsb + (buf_) * 32768 + 1024 * g_))); \
                glds16(p.P + (size_t)row_ * NINP + 2048 + hd * 128, voffV[j], (unsigned)__builtin_amdgcn_readfirstlane((int)(ldsb + 65536 + (buf_) * 32768 + 1024 * g_))); } } while (0)
#define AT_QK(S_, kb_) do { S_ = zero16(); _Pragma("unroll") for (int ks = 0; ks < 4; ++ks) { const bf16x8 a0 = *(LAS const bf16x8*)(Kt + kaddr[ks] + 8192 * (kb_)); S_ = MFMA32(a0, Qf[ks], S_); } } while (0)
        AT_DMA(0, 0);
        asm volatile("s_waitcnt vmcnt(0)" ::: "memory");
        __syncthreads();
        for (int kt = 0; kt < nkt2; ++kt) {
            const bool more = kt + 1 < nkt2;
            if (more) AT_DMA(kt + 1, (kt + 1) & 1);
            LAS const unsigned char* Kt = lds + (kt & 1) * 32768; LAS const unsigned char* Vt = lds + 65536 + (kt & 1) * 32768;
#define AT_VF(dst_, kb_, dt_) do { const s16x4 t0_ = tr4(Vt + vaddr[0][dt_] + 8192 * (kb_)), t1_ = tr4(Vt + vaddr[1][dt_] + 8192 * (kb_)), t2_ = tr4(Vt + vaddr[0][dt_] + 8192 * (kb_) + 4096), t3_ = tr4(Vt + vaddr[1][dt_] + 8192 * (kb_) + 4096); \
                dst_[0] = (bf16x8){t0_[0], t0_[1], t0_[2], t0_[3], t1_[0], t1_[1], t1_[2], t1_[3]}; dst_[1] = (bf16x8){t2_[0], t2_[1], t2_[2], t2_[3], t3_[0], t3_[1], t3_[2], t3_[3]}; } while (0)
            bf16x8 kf[4], P0, P1;
#pragma unroll
            for (int ks = 0; ks < 4; ++ks) kf[ks] = *(LAS const bf16x8*)(Kt + kaddr[ks]);
            { f32x16 S0 = zero16();
#pragma unroll
              for (int ks = 0; ks < 4; ++ks) S0 = MFMA32(kf[ks], Qf[ks], S0);
#pragma unroll
              for (int ks = 0; ks < 4; ++ks) kf[ks] = *(LAS const bf16x8*)(Kt + kaddr[ks] + 8192);
              unsigned pf[8]; float lacc = 0.f;
#pragma unroll
              for (int i = 0; i < 8; ++i) { const float e0 = __builtin_amdgcn_exp2f(SUB ? S0[2 * i] + negm2 : S0[2 * i]), e1 = __builtin_amdgcn_exp2f(SUB ? S0[2 * i + 1] + negm2 : S0[2 * i + 1]); lacc += e0 + e1; pf[i] = pk2(e0, e1); }
              ls += lacc;
              P0 = __builtin_bit_cast(bf16x8, (v4u){pf[0], pf[1], pf[2], pf[3]}); P1 = __builtin_bit_cast(bf16x8, (v4u){pf[4], pf[5], pf[6], pf[7]}); }
            __builtin_amdgcn_sched_barrier(0);
#pragma unroll
            for (int kb = 0; kb < 4; ++kb) {
                bf16x8 v0[2], v1[2], v2[2], v3[2];
                AT_VF(v0, kb, 0); AT_VF(v1, kb, 1); AT_VF(v2, kb, 2); AT_VF(v3, kb, 3);
                f32x16 Sn = zero16();
                if (kb < 3) {
#pragma unroll
                    for (int ks = 0; ks < 4; ++ks) Sn = MFMA32(kf[ks], Qf[ks], Sn);
                    if (kb < 2) {
#pragma unroll
                        for (int ks = 0; ks < 4; ++ks) kf[ks] = *(LAS const bf16x8*)(Kt + kaddr[ks] + 8192 * (kb + 2)); } }
                O[0] = MFMA32(v0[0], P0, O[0]); O[0] = MFMA32(v0[1], P1, O[0]); O[1] = MFMA32(v1[0], P0, O[1]); O[1] = MFMA32(v1[1], P1, O[1]);
                O[2] = MFMA32(v2[0], P0, O[2]); O[2] = MFMA32(v2[1], P1, O[2]); O[3] = MFMA32(v3[0], P0, O[3]); O[3] = MFMA32(v3[1], P1, O[3]);
                if (kb < 3) {
                    unsigned pf[8]; float lacc = 0.f;
#pragma unroll
                    for (int i = 0; i < 8; ++i) { const float e0 = __builtin_amdgcn_exp2f(SUB ? Sn[2 * i] + negm2 : Sn[2 * i]), e1 = __builtin_amdgcn_exp2f(SUB ? Sn[2 * i + 1] + negm2 : Sn[2 * i + 1]); lacc += e0 + e1; pf[i] = pk2(e0, e1); }
                    ls += lacc;
                    P0 = __builtin_bit_cast(bf16x8, (v4u){pf[0], pf[1], pf[2], pf[3]}); P1 = __builtin_bit_cast(bf16x8, (v4u){pf[4], pf[5], pf[6], pf[7]});
                    __builtin_amdgcn_sched_group_barrier(0x100, 20, 0); __builtin_amdgcn_sched_group_barrier(0x008, 6, 0);
#pragma unroll
                    for (int gI = 0; gI < 6; ++gI) { __builtin_amdgcn_sched_group_barrier(0x002, 8, 0); __builtin_amdgcn_sched_group_barrier(0x008, 1, 0); }
                }
                __builtin_amdgcn_sched_barrier(0);
            }
#undef AT_VF
            asm volatile("s_waitcnt vmcnt(0)" ::: "memory");
            __syncthreads();
        }
#undef AT_DMA
#undef AT_QK
        const float l = ls + __shfl_xor(ls, 32);
        if (mp == 1) { const float sc = lam / l;
#pragma unroll
            for (int dt = 0; dt < 4; ++dt)
#pragma unroll
                for (int i = 0; i < 16; ++i) Ex[(32 * wq + r) * 132 + 32 * dt + (i & 3) + 8 * (i >> 2) + 4 * h] = O[dt][i] * sc; }
        __syncthreads();
        if (mp == 0) { const float a0 = 1.f / l; float ss = 0.f;
#pragma unroll
            for (int dt = 0; dt < 4; ++dt)
#pragma unroll
                for (int i = 0; i < 16; ++i) { const float v = O[dt][i] * a0 - Ex[(32 * wq + r) * 132 + 32 * dt + (i & 3) + 8 * (i >> 2) + 4 * h]; O[dt][i] = v; ss += v * v; }
            ss += __shfl_xor(ss, 32);
            const float rn = rsqrtf(ss * (1.f / 128.f) + EPS) * (1.f - p.lam_init);
            int qrow2 = qrow0 + 32 * wq + r; asm volatile("" : "+v"(qrow2));
            bf16* dst = p.MIX + (size_t)qrow2 * DM + hd * 128;
#pragma unroll
            for (int dt = 0; dt < 4; ++dt)
#pragma unroll
                for (int g4 = 0; g4 < 4; ++g4) { const int dv0 = 32 * dt + 8 * g4 + 4 * h; const f32x4 sg = *(const f32x4*)(p.subg + dv0);
                    v2u o; o.x = pk2(O[dt][4 * g4] * rn * sg.x, O[dt][4 * g4 + 1] * rn * sg.y); o.y = pk2(O[dt][4 * g4 + 2] * rn * sg.z, O[dt][4 * g4 + 3] * rn * sg.w);
                    *(v2u*)(dst + dv0) = o; } }
        __syncthreads();
    }
}

#ifndef PHASE_MASK
#define PHASE_MASK 0xFFFFFFu
#endif
#define PM(j) ((PHASE_MASK >> (j)) & 1u)
#ifndef REP_MASK
#define REP_MASK 0u
#endif
#define REPS(j) ((((REP_MASK) >> (j)) & 1u) ? 2 : 1)
#define PH_BEGIN(j, k) if (PM(j) && IN(k)) for (int rep_ = 0; rep_ < REPS(j); ++rep_) { if (rep_) xcd_barrier(bar);
#define PH_END }
#define PHASE_BEGIN int wave = wave0, bid = bid0, G = G0, zz_ = 0; asm volatile("" : "+s"(wave), "+s"(bid), "+s"(G), "+s"(zz_)); const int lane = (int)__builtin_amdgcn_mbcnt_hi(~0u, __builtin_amdgcn_mbcnt_lo(~0u, (unsigned)zz_)), tid = wave * 64 + lane; \
    unsigned char* ws = ws0; asm volatile("" : "+s"(ws)); const __attribute__((address_space(4))) Args* ap_ = (const __attribute__((address_space(4))) Args*)__builtin_amdgcn_kernarg_segment_ptr(); asm volatile("" : "+s"(ap_)); const Args& a = *(const Args*)ap_; (void)a; const int gw = bid * NWAVES + wave, NGW = G * NWAVES, gtid = bid * NTHR + tid, NT = G * NTHR; (void)gw; (void)NGW; (void)gtid; (void)NT; (void)lane;
__device__ __forceinline__ void fill_scanp(ScanP& sp, const Args& a, unsigned char* ws, int li, bool even) {
    sp.P = (const bf16*)(ws + WS_P); sp.MQK = (const bf16*)(ws + WS_MQK); sp.MIX = (bf16*)(ws + WS_MIX);
    sp.gw2 = a.in[10] + (size_t)li * 2 * 16 * 512; sp.gb = a.in[11] + (size_t)li * 2 * 512; sp.mgb = a.in[21] + (size_t)li * 16;
    sp.ng = even ? a.in[12] + (size_t)li * 256 : a.in[22] + (size_t)li * 256;
    sp.DSTp = (bf16*)(ws + WS_DST); sp.SSTp = (bf16*)(ws + WS_SST); sp.GAM = (float*)(ws + WS_SM + SM_GAM); sp.DN = (float*)(ws + WS_SM + SM_DN); sp.NIN = (float*)(ws + WS_SM + SM_NIN);
    sp.BL = (float*)(ws + WS_SM + SM_BL); sp.ML = (float*)(ws + WS_SM + SM_ML); sp.MINp = (float*)(ws + WS_SM + SM_MIN);
}
__global__ void __launch_bounds__(NTHR, 2) fwd_kernel(Args a) {
    extern __shared__ __attribute__((aligned(16))) unsigned char lds_raw[];
    LAS unsigned char* lds = (LAS unsigned char*)lds_raw;
    const int tid0 = threadIdx.x, wave0 = __builtin_amdgcn_readfirstlane(tid0 >> 6), bid0 = blockIdx.x, G0 = gridDim.x;
    unsigned char* ws0 = a.ws;
    volatile LAS unsigned* MISC = (volatile LAS unsigned*)(lds + MISC_OFF);
    if (tid0 < 32) MISC[tid0] = 0u;
    __syncthreads();
    XcdBarrier bar = xcd_barrier_post((unsigned*)(ws0 + WS_CTL) + CW_BAR + a.li * XCD_BAR_WORDS, MISC + 8, (unsigned)wave0);
    const int lo = a.ph_lo, hi = a.ph_hi;
#define IN(k) (lo <= (k) && (k) < hi)
#ifndef TMASK
#define TMASK 0u
#endif
#ifndef LMASK
#define LMASK 0xFu
#endif
    volatile LAS unsigned long long* tst_ = (volatile LAS unsigned long long*)(lds + MISC_OFF + 64);
    if (TMASK && tid0 == 0) { tst_[0] = __builtin_amdgcn_s_memrealtime(); tst_[1] = 0ull; }
#define SEAM2(k, kk, ll) do { if (IN(k) && IN((k) + 1)) xcd_barrier(bar); if (TMASK && wave0 == 0 && xb_lane() == 0u) { const unsigned long long now_ = __builtin_amdgcn_s_memrealtime(); if (((TMASK >> (kk)) & 1u) && ((LMASK >> (ll)) & 1u)) tst_[1] += now_ - tst_[0]; tst_[0] = now_; } } while (0)
#define SEAM(k) SEAM2(k, (k) == 0 ? 11 : ((k) - 1) % PPL, (k) == 0 ? 0 : ((k) - 1) / PPL)

    PH_BEGIN(11, 0) PHASE_BEGIN; ph_prologue(a, ws, lds, tid, lane, wave, bid, G); PH_END
    SEAM(0);
    for (int layer = 0; layer < NLAYERS; ++layer) {
        const int pb = 1 + layer * PPL, li = layer >> 1; const bool even = (layer & 1) == 0;
        const size_t mod_off = WS_MOD + (size_t)layer * 3 * 12288 * 4;
        const size_t wb_off = WS_W + (size_t)layer * W_LAYER;

        PH_BEGIN(0, pb + 0) PHASE_BEGIN; const float* mod = (const float*)(ws + mod_off); float* ssq = (float*)(ws + WS_SSQ) + (size_t)(2 * layer) * MR;
            if (layer == 0) ph_norm0(a.in[0], a.in[2], (float*)(ws + WS_XS), a.in[6], mod + 1 * DM, (bf16*)(ws + WS_H), ssq, gw, NGW, lane);
            else ph_ctxfix<11>((float*)(ws + WS_XS), (const float*)(ws + WS_DST), mod - 3 * 12288 + 2 * 12288 + 5 * DM, a.in[6] + (size_t)layer * DM, mod + 1 * DM, (bf16*)(ws + WS_H), ssq, gw, NGW, lane);
            { PHASE_BEGIN; const float* mod2 = (const float*)(ws + mod_off); ph_bias((const bf16*)(ws + wb_off), (const bf16*)(ws + wb_off + W_UP), mod2, (float*)(ws + WS_B1) + (size_t)layer * 3 * NINP, (float*)(ws + WS_B2) + (size_t)layer * 3 * NUP, gw, NGW, lane); } }
        SEAM(pb + 0);
        PH_BEGIN(1, pb + 1) PHASE_BEGIN; pg8::Gemm g{(const bf16*)(ws + WS_H), (const bf16*)(ws + wb_off), MR, NINP, DM}; pg8::StaticOrder S; S.init(MR, NINP, G, bid); pg8::EpiStore E{(bf16*)(ws + WS_P), NINP, (const float*)(ws + WS_SSQ) + (size_t)(2 * layer) * MR, (const float*)(ws + WS_B1) + (size_t)layer * 3 * NINP, NINP};
            pg8::gemm_phase<pg8::EpiStore, pg8::StaticOrder, true, true>(lds, g, S, E, wave);
            if (layer + 1 < NLAYERS && G == 256 && bid >= 82) { __syncthreads(); ph_convert(a, ws, lds, (layer + 1) * 25344, (layer + 2) * 25344, (bid - 82) * NWAVES + wave, 174 * NWAVES, wave, lane); }
            else if (layer + 1 < NLAYERS && G != 256) { __syncthreads(); ph_convert(a, ws, lds, (layer + 1) * 25344, (layer + 2) * 25344, bid * NWAVES + wave, G * NWAVES, wave, lane); } }
        SEAM(pb + 1);
        PH_BEGIN(2, pb + 2)
            if (even) {
                if (PM(12)) { PHASE_BEGIN; ph_conv8<1>((const bf16*)(ws + WS_P), a.in[13] + (size_t)li * 3 * 1024, (bf16*)(ws + WS_MIX), gtid, NT); }
                if (PM(13)) { PHASE_BEGIN; ScanP sp; fill_scanp(sp, a, ws, li, even); ph_gla_local(sp, (bf16*)(ws + WS_QR), (bf16*)(ws + WS_KR), lds, tid, lane, wave, bid, G); }
            } else {
                if (PM(14)) { PHASE_BEGIN; ph_qkprep((const bf16*)(ws + WS_P), a.in[16] + (size_t)li * 64, a.in[17] + (size_t)li * 64, (const float*)(ws + WS_ROPE), (bf16*)(ws + WS_QR), (bf16*)(ws + WS_KR), gw, NGW, lane); }
                if (PM(15)) { PHASE_BEGIN; ph_conv8<2>((const bf16*)(ws + WS_P), a.in[20] + (size_t)li * 3 * 1024, (bf16*)(ws + WS_MQK), gtid, NT); }
            }
        }
        SEAM(pb + 2);
        PH_BEGIN(3, pb + 3) if (!even) { PHASE_BEGIN; ScanP sp; fill_scanp(sp, a, ws, li, even); ph_mlstm_local(sp, lds, tid, lane, wave, bid, G); } }
        if (!even) SEAM(pb + 3);
        PH_BEGIN(4, pb + 4) PHASE_BEGIN; ScanP sp; fill_scanp(sp, a, ws, li, even); if (even) ph_scan_carry<0>(sp, gtid, NT); else ph_scan_carry<1>(sp, gtid, NT); }
        SEAM(pb + 4);
        PH_BEGIN(5, pb + 5)
            if (even) { if (PM(16)) { PHASE_BEGIN; ScanP sp; fill_scanp(sp, a, ws, li, even); ph_gla_out(sp, (const bf16*)(ws + WS_QR), (const bf16*)(ws + WS_KR), lds, tid, lane, wave, bid, G); } }
            else {
                if (PM(17)) { PHASE_BEGIN; AttnP ap{(const bf16*)(ws + WS_QR), (const bf16*)(ws + WS_KR), (const bf16*)(ws + WS_P), (bf16*)(ws + WS_MIX), a.in[18] + (size_t)li * 256, a.in[19] + (size_t)li * 128, a.in[16] + (size_t)li * 64, a.in[17] + (size_t)li * 64, 0.8f - 0.6f * expf(-0.3f * (float)layer), (unsigned*)(ws + 32768 + 1024 * li), layer == NLAYERS - 1 ? 64 : 68};
                    const float bound = 8.f * wave_max(fabsf(ap.qg[lane])) * wave_max(fabsf(ap.kg[lane])) * 1.4426950408889634f;
                    if (bound < 60.f) ph_attn<false>(ap, lds, tid, lane, wave, bid, G); else ph_attn<true>(ap, lds, tid, lane, wave, bid, G);
                    if (TMASK && wave0 == 0 && xb_lane() == 0u) { const unsigned long long now_ = __builtin_amdgcn_s_memrealtime(); if (((TMASK >> 12) & 1u) && ((LMASK >> layer) & 1u)) tst_[1] += now_ - tst_[0]; tst_[0] = now_; } }
                if (PM(18)) { PHASE_BEGIN; ScanP sp; fill_scanp(sp, a, ws, li, even); ph_mlstm_out(sp, lds, tid, lane, wave, bid, G, layer == NLAYERS - 1 ? 1 : 0, (unsigned*)(ws + 32768 + 1024 * li + 512)); }
            }
        }
        SEAM(pb + 5);
        PH_BEGIN(6, pb + 6) PHASE_BEGIN; pg8::Gemm g{(const bf16*)(ws + WS_MIX), (const bf16*)(ws + wb_off + W_OUT), MR, DM, DM}; pg8::ResidOrder S; S.init(G, bid, layer < NLAYERS - 1 ? 8 : 0, 256);
            pg8::EpiResid2 E{(float*)(ws + WS_XS), (const float*)(ws + mod_off) + 2 * DM, nullptr, (float*)(ws + WS_DST), 0, 256, rep_,
                (bf16*)(ws + WS_H), a.in[7] + (size_t)layer * DM, (const float*)(ws + mod_off) + 4 * DM, (float*)(ws + WS_SSQ) + (size_t)(2 * layer + 1) * MR};
            pg8::gemm_phase<pg8::EpiResid2, pg8::ResidOrder, true, true>(lds, g, S, E, wave); }
        SEAM(pb + 6);
        PH_BEGIN(7, pb + 7) PHASE_BEGIN; const float* mod = (const float*)(ws + mod_off);
            if (layer < NLAYERS - 1) ph_ctxfix<8>((float*)(ws + WS_XS), (const float*)(ws + WS_DST), mod + 2 * 12288 + 2 * DM, a.in[7] + (size_t)layer * DM, mod + 4 * DM, (bf16*)(ws + WS_H), (float*)(ws + WS_SSQ) + (size_t)(2 * layer + 1) * MR, gw, NGW, lane); }
        if (layer < NLAYERS - 1) SEAM(pb + 7);
        PH_BEGIN(8, pb + 8) PHASE_BEGIN; pg8::Gemm g{(const bf16*)(ws + WS_H), (const bf16*)(ws + wb_off + W_UP), MR, NUP, DM}; pg8::StaticOrder S; S.init(MR, NUP, G, bid);
            pg8::EpiAct E{(bf16*)(ws + WS_ACT), a.in[24] + (size_t)layer * 3 * DFF, a.in[25] + (size_t)layer * DFF, (float*)(ws + WS_U), (LAS float*)(lds + 131584), (const float*)(ws + WS_SSQ) + (size_t)(2 * layer + 1) * MR, (const float*)(ws + WS_B2) + (size_t)layer * 3 * NUP, 0};
            pg8::gemm_phase<pg8::EpiAct, pg8::StaticOrder, true, true>(lds, g, S, E, wave); }
        SEAM(pb + 8);
        PH_BEGIN(10, pb + 10)
            { PHASE_BEGIN; pg8::ResidOrder S0; S0.init(G, bid, layer < NLAYERS - 1 ? 11 : 0, 512); pg8::Unit uu_;
#pragma unroll 1
              for (int i_ = 0; S0.next(i_, uu_); ++i_) act_fix_tile((const float*)(ws + WS_U), a.in[24] + (size_t)layer * 3 * DFF, (bf16*)(ws + WS_ACT), uu_.pm, tid);
              asm volatile("s_waitcnt vmcnt(0)" ::: "memory"); __syncthreads(); }
            PHASE_BEGIN; pg8::Gemm g{(const bf16*)(ws + WS_ACT), (const bf16*)(ws + wb_off + W_DN), MR, DM, DFF}; pg8::ResidOrder S; S.init(G, bid, layer < NLAYERS - 1 ? 11 : 0, 512);
            pg8::EpiResid2 E{(float*)(ws + WS_XS), (const float*)(ws + mod_off) + 5 * DM, a.out, (float*)(ws + WS_DST), layer == NLAYERS - 1 ? 1 : 0, 512, rep_,
                layer < NLAYERS - 1 ? (bf16*)(ws + WS_H) : nullptr, a.in[6] + (size_t)(layer + 1) * DM, (const float*)(ws + mod_off) + 3 * 12288 + 1 * DM, (float*)(ws + WS_SSQ) + (size_t)(2 * layer + 2) * MR};
            pg8::gemm_phase<pg8::EpiResid2, pg8::ResidOrder, true, true>(lds, g, S, E, wave); }
        if (layer < NLAYERS - 1) SEAM(pb + 10); else if (TMASK && wave0 == 0 && xb_lane() == 0u) { const unsigned long long now_ = __builtin_amdgcn_s_memrealtime(); if (((TMASK >> 10) & 1u) && ((LMASK >> layer) & 1u)) tst_[1] += now_ - tst_[0]; tst_[0] = now_; }
    }
    if (TMASK) { __syncthreads(); const unsigned long long tacc_ = tst_[1], t0_ = __builtin_amdgcn_s_memrealtime(); while (__builtin_amdgcn_s_memrealtime() - t0_ < tacc_) __builtin_amdgcn_s_sleep(8); }
#undef IN
#undef SEAM
}

extern "C" void kernel_launch(void* const* d_in, const int* in_sizes, int n_in, void* d_out, int out_size, void* d_ws, size_t ws_size, hipStream_t stream) {
    static int grid = 0;
    if (grid == 0) {
        int dev = 0, cus = 0;
        if (n_in != 27 || out_size != NLATR * DM || ws_size < WS_END) { fprintf(stderr, "kernel_launch: unexpected problem (n_in %d out %d ws %zu)\n", n_in, out_size, ws_size); grid = -1; return; }
        if (hipGetDevice(&dev) != hipSuccess || hipDeviceGetAttribute(&cus, hipDeviceAttributeMultiprocessorCount, dev) != hipSuccess) { grid = -1; return; }
        if (hipFuncSetAttribute((const void*)fwd_kernel, hipFuncAttributeMaxDynamicSharedMemorySize, LDS_BYTES) != hipSuccess) { fprintf(stderr, "kernel_launch: hipFuncSetAttribute failed\n"); grid = -1; return; }
        int per_cu = 0;
        if (hipOccupancyMaxActiveBlocksPerMultiprocessor(&per_cu, (const void*)fwd_kernel, NTHR, LDS_BYTES) != hipSuccess || per_cu < 1) fprintf(stderr, "kernel_launch: occupancy query reports %d\n", per_cu);
        (void)hipGetLastError();
        grid = cus;
    }
    if (grid < 0) return;
    (void)hipMemsetAsync((char*)d_ws + WS_CTL, 0, CTL_BYTES, stream);
    Args a{};
    for (int i = 0; i < 27; ++i) a.in[i] = (const float*)d_in[i];
    a.out = (float*)d_out; a.ws = (unsigned char*)d_ws; a.pad = 0;
#if ONE_LAUNCH
    a.ph_lo = 0; a.ph_hi = 1 + NLAYERS * PPL; a.li = 0;
    hipLaunchKernelGGL(fwd_kernel, dim3(grid), dim3(NTHR), LDS_BYTES, stream, a);
#else
    for (int p = 0; p < 1 + NLAYERS * PPL; ++p) {
        const int k = p == 0 ? 0 : (p - 1) % PPL, layer = p == 0 ? 0 : (p - 1) / PPL;
        if (p > 0 && k == 3 && (layer & 1) == 0) continue;
        a.ph_lo = p; a.ph_hi = p + 1; a.li = p;
        hipLaunchKernelGGL(fwd_kernel, dim3(grid), dim3(NTHR), LDS_BYTES, stream, a);
    }
#endif
}
```

```cpp
#include <hip/hip_runtime.h>
#include <cstdio>
#include <cstdint>
namespace pg8 {
#define PG8_LAS __attribute__((address_space(3)))
typedef unsigned short bf16_t;
typedef short bf16x8 __attribute__((ext_vector_type(8)));
typedef float f32x4 __attribute__((ext_vector_type(4)));
typedef unsigned u32x4 __attribute__((ext_vector_type(4)));
constexpr int BM = 256, BK = 64, HALF = 128, HTB = HALF * BK * 2  , STAGE_BYTES = 8 * HTB, NXCD = 8, WGM = 8;

__host__ __device__ __forceinline__ int lds_byte(int r, int c) { const int st = (r >> 4) * 2 + (c >> 5), rr = r & 15, cc = c & 31, ob = rr * 64 + cc * 2; return st * 1024 + (ob ^ (((ob >> 9) & 1) << 5)); }
__host__ __device__ __forceinline__ void stage_rc(int b, int& R, int& C) { const int st = b / 1024, sb = b % 1024, swz = sb ^ (((sb >> 9) & 1) << 5); R = (st >> 1) * 16 + swz / 64; C = (st & 1) * 32 + (swz % 64) / 2; }
__host__ __device__ __forceinline__ int perm32(int rho) { const int n = rho >> 4, i = rho & 15; return 8 * (i >> 2) + 4 * n + (i & 3); }

struct Unit { int pm, pn, k0, nt; };
struct Gemm { const bf16_t* A; const bf16_t* Bt; int M, N, K; };

struct StaticOrder {
    int nM, nN, nwg, G, c;
    __host__ __device__ __forceinline__ void init(int M, int N, int G_, int c_) { nM = M / BM; nN = N / BM; nwg = nM * nN; G = G_; c = c_; }
    __host__ __device__ __forceinline__ bool next(int i, Unit& u) const {
        const long L = (long)i * G + c; if (L >= nwg) return false;
        int wgid = (int)L; { const int q = nwg / NXCD, r = nwg % NXCD, xcd = wgid % NXCD, off = wgid / NXCD; wgid = (xcd < r ? xcd * (q + 1) : r * (q + 1) + (xcd - r) * q) + off; }
        const int nig = WGM * nN, gid = wgid / nig, fm = gid * WGM, gsz = (nM - fm) < WGM ? (nM - fm) : WGM;
        u.pm = fm + ((wgid % nig) % gsz); u.pn = (wgid % nig) / gsz; u.k0 = 0; u.nt = 0; return true;
    }
    __device__ __forceinline__ void a_ready(const Unit&) const {}
    __device__ __forceinline__ void done(const Unit&) const {}
};
__device__ __forceinline__ unsigned cvt_pk_bf16(float lo, float hi) { unsigned r; asm volatile("v_cvt_pk_bf16_f32 %0, %1, %2" : "=v"(r) : "v"(lo), "v"(hi)); return r; }

struct EpiStore {
    static constexpr bool PERM = true, AFTER_DRAIN = false;
    bf16_t* O; int ldc; const float* ssq; const float* bias; int ldb;
    __device__ __forceinline__ void operator()(const f32x4 (&acc)[2][2][4][2], const Unit& u, int wr, int wc, int fr, int fq) const {
        const int row0 = u.pm * BM + wr * 64 + fr, col0 = u.pn * BM + wc * 32 + 8 * fq, mi = u.pm < 32 ? (u.pm >> 4) : 2;
        f32x4 bv[2][2];
#pragma unroll
        for (int bj = 0; bj < 2; ++bj)
#pragma unroll
            for (int n = 0; n < 2; ++n) bv[bj][n] = *(const f32x4*)(bias + (size_t)mi * ldb + col0 + bj * HALF + 4 * n);
#pragma unroll
        for (int ai = 0; ai < 2; ++ai) {
            float sq[4];
#pragma unroll
            for (int m = 0; m < 4; ++m) sq[m] = ssq[row0 + ai * HALF + m * 16];
#pragma unroll
            for (int m = 0; m < 4; ++m) { const int row = row0 + ai * HALF + m * 16; bf16_t* rowp = O + (size_t)row * ldc + col0;
                const float r = __builtin_amdgcn_rsqf(sq[m] * (1.f / 2048.f) + 1e-6f);
#pragma unroll
                for (int bj = 0; bj < 2; ++bj) { const f32x4 v0 = acc[ai][bj][m][0] * r + bv[bj][0], v1 = acc[ai][bj][m][1] * r + bv[bj][1];
                    u32x4 w; w.x = cvt_pk_bf16(v0[0], v0[1]); w.y = cvt_pk_bf16(v0[2], v0[3]); w.z = cvt_pk_bf16(v1[0], v1[1]); w.w = cvt_pk_bf16(v1[2], v1[3]);
                    *(u32x4*)(rowp + bj * HALF) = w; } } }
    }
};
struct ResidOrder {
    StaticOrder L; int G, c, nsub, ksub;
    __device__ __forceinline__ void init(int G_, int c_, int nsplit, int ksub_) { L.init(8192, 2048, G_, c_); G = G_; c = c_; nsub = 16 * nsplit; ksub = ksub_; }
    __device__ __forceinline__ bool next(int i, Unit& u) const {
        const int nl = c < 256 ? (255 - c) / G + 1 : 0;
        if (i < nl) return L.next(i, u);
        const int s = (i - nl) * G + c; if (s >= nsub) return false;
        const int tile = s & 15, j = s >> 4; u.pm = 32 + (tile >> 3); u.pn = tile & 7; u.k0 = j * ksub; u.nt = ksub / BK; return true;
    }
    __device__ __forceinline__ void a_ready(const Unit&) const {}
    __device__ __forceinline__ void done(const Unit&) const {}
};
struct EpiResid2 {
    static constexpr bool PERM = true, AFTER_DRAIN = false;
    float* X; const float* Xs; const float* gate; float* out; float* part; int final_; int ksub; int dry;
    bf16_t* Hn; const float* ngn; const float* scn; float* ssqn;
    __device__ __forceinline__ void operator()(const f32x4 (&acc)[2][2][4][2], const Unit& u, int wr, int wc, int fr, int fq) const {
        const int row0 = u.pm * BM + wr * 64 + fr, col0 = u.pn * BM + wc * 32 + 8 * fq;
        if (u.pm >= 32) {
            float* pb = part + ((size_t)(u.k0 / ksub) * 512 + (row0 - 8192)) * 2048 + col0;
#pragma unroll
            for (int ai = 0; ai < 2; ++ai)
#pragma unroll
                for (int m = 0; m < 4; ++m)
#pragma unroll
                    for (int bj = 0; bj < 2; ++bj)
#pragma unroll
                        for (int n = 0; n < 2; ++n) *(f32x4*)(pb + (size_t)(ai * HALF + m * 16) * 2048 + bj * HALF + 4 * n) = acc[ai][bj][m][n];
            return;
        }
        const int mi = u.pm >> 4;
        f32x4 gv[2][2], av[2][2];
#pragma unroll
        for (int bj = 0; bj < 2; ++bj)
#pragma unroll
            for (int n = 0; n < 2; ++n) { const int c = col0 + bj * HALF + 4 * n; gv[bj][n] = *(const f32x4*)(gate + (size_t)mi * 12288 + c);
                av[bj][n] = Hn ? *(const f32x4*)(ngn + c) * (*(const f32x4*)(scn + (size_t)mi * 12288 + c) + 1.f) : (f32x4){0.f, 0.f, 0.f, 0.f}; }
        if (dry && gv[0][0][0] != 1.2345e30f) return;
#pragma unroll
        for (int gB = 0; gB < 4; ++gB) {
            f32x4 xa[8];
#pragma unroll
            for (int h = 0; h < 2; ++h) { const int g2 = 2 * gB + h, ai2 = g2 >> 2, m2 = g2 & 3; const float* xr2 = Xs + (size_t)(row0 + ai2 * HALF + m2 * 16) * 2048 + col0;
#pragma unroll
                for (int bj = 0; bj < 2; ++bj) { xa[4 * h + 2 * bj] = *(const f32x4*)(xr2 + bj * HALF); xa[4 * h + 2 * bj + 1] = *(const f32x4*)(xr2 + bj * HALF + 4); } }
#pragma unroll
            for (int h = 0; h < 2; ++h) { const int gI = 2 * gB + h, ai = gI >> 2, m = gI & 3;
                const int row = row0 + ai * HALF + m * 16; const size_t ro = (size_t)row * 2048 + col0; float* orow = (final_ ? out : X) + ro; float ss = 0.f;
#pragma unroll
                for (int bj = 0; bj < 2; ++bj) {
                    const f32x4 x0 = xa[4 * h + 2 * bj] + gv[bj][0] * acc[ai][bj][m][0], x1 = xa[4 * h + 2 * bj + 1] + gv[bj][1] * acc[ai][bj][m][1];
                    *(f32x4*)(orow + bj * HALF) = x0; *(f32x4*)(orow + bj * HALF + 4) = x1;
                    if (Hn) { ss += (x0[0] * x0[0] + x0[1] * x0[1]) + (x0[2] * x0[2] + x0[3] * x0[3]) + (x1[0] * x1[0] + x1[1] * x1[1]) + (x1[2] * x1[2] + x1[3] * x1[3]);
                        const f32x4 h0 = x0 * av[bj][0], h1 = x1 * av[bj][1];
                        u32x4 w; w.x = cvt_pk_bf16(h0[0], h0[1]); w.y = cvt_pk_bf16(h0[2], h0[3]); w.z = cvt_pk_bf16(h1[0], h1[1]); w.w = cvt_pk_bf16(h1[2], h1[3]);
                        *(u32x4*)(Hn + ro + bj * HALF) = w; } }
                if (Hn) { ss += __shfl_xor(ss, 16); ss += __shfl_xor(ss, 32); if (fq == 0) (void)__hip_atomic_fetch_add(ssqn + row, ss, __ATOMIC_RELAXED, __HIP_MEMORY_SCOPE_AGENT); } } }
    }
};
struct EpiAct {
    static constexpr bool PERM = true, AFTER_DRAIN = false;
    bf16_t* ACT; const float* cw; const float* cb; float* halo; PG8_LAS float* exb; const float* ssq; const float* bias; mutable int par;
    __device__ __forceinline__ void operator()(const f32x4 (&acc)[2][2][4][2], const Unit& u, int wr, int wc, int fr, int fq) const {
        const int lane = fq * 16 + fr, ch0 = wc * 32 + 8 * fq, chg = u.pn * 128 + ch0;
        PG8_LAS float* xb = exb + par * 1024; par ^= 1;
        const int mi = u.pm < 32 ? (u.pm >> 4) : 2;
        const float* bp = bias + (size_t)mi * 11264 + u.pn * BM + ch0;
        float rr[2][4];
#pragma unroll
        for (int ai = 0; ai < 2; ++ai)
#pragma unroll
            for (int m = 0; m < 4; ++m) rr[ai][m] = __builtin_amdgcn_rsqf(ssq[u.pm * BM + ai * HALF + wr * 64 + m * 16 + fr] * (1.f / 2048.f) + 1e-6f);
#pragma unroll
        for (int ai = 0; ai < 2; ++ai) { const int q = ai * 2 + wr;
#pragma unroll
            for (int n = 0; n < 2; ++n) { const f32x4 bg4 = *(const f32x4*)(bp + 4 * n);
                if (fr == 0) *(PG8_LAS f32x4*)(xb + q * 128 + ch0 + 4 * n) = acc[ai][0][0][n] * rr[ai][0] + bg4;
                if (fr == 15) *(PG8_LAS f32x4*)(xb + (4 + q) * 128 + ch0 + 4 * n) = acc[ai][0][3][n] * rr[ai][3] + bg4; } }
        asm volatile("s_waitcnt lgkmcnt(0)" ::: "memory"); __builtin_amdgcn_s_barrier(); asm volatile("" ::: "memory");
        float* hb = halo + (size_t)(u.pm * 44 + u.pn) * 768 + ch0;
        unsigned keep[2][4][2]; bf16_t* actb = ACT + (size_t)(u.pm * BM + wr * 64 + fr) * 5632 + chg;
        f32x4 pw0[2], pw1[2], pw2[2], pbb[2], pbg[2], pbv[2];
#pragma unroll
        for (int n = 0; n < 2; ++n) { pw0[n] = *(const f32x4*)(cw + chg + 4 * n); pw1[n] = *(const f32x4*)(cw + 5632 + chg + 4 * n); pw2[n] = *(const f32x4*)(cw + 2 * 5632 + chg + 4 * n); pbb[n] = *(const f32x4*)(cb + chg + 4 * n);
            pbg[n] = *(const f32x4*)(bp + 4 * n); pbv[n] = *(const f32x4*)(bp + 128 + 4 * n); }
#pragma unroll
        for (int n = 0; n < 2; ++n) {
            const f32x4 w0 = pw0[n], w1 = pw1[n], w2 = pw2[n], bb = pbb[n], bg = pbg[n], bvv = pbv[n];
#pragma unroll
            for (int ai = 0; ai < 2; ++ai) { const int q = ai * 2 + wr;
                const f32x4 pB = q > 0 ? *(PG8_LAS const f32x4*)(xb + (4 + q - 1) * 128 + ch0 + 4 * n) : (f32x4){0.f, 0.f, 0.f, 0.f};
                const f32x4 nB = q < 3 ? *(PG8_LAS const f32x4*)(xb + (q + 1) * 128 + ch0 + 4 * n) : (f32x4){0.f, 0.f, 0.f, 0.f};
#pragma unroll
                for (int m = 0; m < 4; ++m) {
                    const f32x4 x = acc[ai][0][m][n] * rr[ai][m] + bg, vx = acc[ai][1][m][n] * rr[ai][m] + bvv;
                    const f32x4 xm = m > 0 ? acc[ai][0][m > 0 ? m - 1 : 0][n] * rr[ai][m > 0 ? m - 1 : 0] + bg : pB;
                    const f32x4 xq = m < 3 ? acc[ai][0][m < 3 ? m + 1 : 3][n] * rr[ai][m < 3 ? m + 1 : 3] + bg : nB;
                    f32x4 cv, o;
#pragma unroll
                    for (int el = 0; el < 4; ++el) { const float sp = fr == 15 ? xm[el] : x[el], sn = fr == 0 ? xq[el] : x[el];
                        const float pv = __builtin_bit_cast(float, __builtin_amdgcn_update_dpp(0, __builtin_bit_cast(int, sp), 0x121, 0xF, 0xF, true)), nv = __builtin_bit_cast(float, __builtin_amdgcn_update_dpp(0, __builtin_bit_cast(int, sn), 0x12F, 0xF, 0xF, true));
                        cv[el] = w0[el] * pv + w1[el] * x[el] + w2[el] * nv + bb[el];
                        o[el] = cv[el] * __builtin_amdgcn_rcpf(1.f + __expf(-cv[el])) * vx[el]; }
                    const bool top = (q == 0 && m == 0 && fr == 0), bot = (q == 3 && m == 3 && fr == 15);
                    if (top || bot) { const int sl = top ? 0 : 1; *(f32x4*)(hb + sl * 128 + 4 * n) = x; *(f32x4*)(hb + (2 + sl) * 128 + 4 * n) = cv; *(f32x4*)(hb + (4 + sl) * 128 + 4 * n) = vx; }
                    const unsigned pk0 = cvt_pk_bf16(o[0], o[1]), pk1 = cvt_pk_bf16(o[2], o[3]);
                    if (n == 0) { keep[ai][m][0] = pk0; keep[ai][m][1] = pk1; }
                    else if (!(top || bot)) { u32x4 w; w.x = keep[ai][m][0]; w.y = keep[ai][m][1]; w.z = pk0; w.w = pk1;
                        *(u32x4*)(actb + (size_t)(ai * HALF + m * 16) * 5632) = w; }
                }
            }
        }
    }
};
template <class Epi, class Sched, bool ALIGN_EPI = false, bool SP2 = false>
__device__ __forceinline__ void gemm_phase(PG8_LAS unsigned char* lds, const Gemm g, const Sched& S, const Epi& E, int wid_in) {
    int wid = wid_in, zz_ = 0; asm volatile("" : "+s"(wid), "+s"(zz_));
    const int lane = (int)__builtin_amdgcn_mbcnt_hi(~0u, __builtin_amdgcn_mbcnt_lo(~0u, (unsigned)zz_)), tid = wid * 64 + lane, wr = wid >> 2, wc = wid & 3, fr = lane & 15, fq = lane >> 4;
    const int K = g.K, nt = K / BK;
    unsigned voffA[2], voffB[2];
#pragma unroll
    for (int i = 0; i < 2; ++i) { int R, C; stage_rc(tid * 16 + i * 8192, R, C); const int Rb = Epi::PERM ? ((R & ~31) + perm32(R & 31)) : R;
        voffA[i] = (unsigned)(R * K + C) * 2u; voffB[i] = (unsigned)(Rb * K + C) * 2u; }
    const size_t kstep = (size_t)(BK * 2);
    const size_t hstep = (size_t)HALF * K * 2;
    const size_t tstep = 2 * hstep;
    const unsigned ldsw = (unsigned)wid * 1024u;
    const int aoff = lds_byte(wr * 64 + fr, fq * 8), boff = lds_byte(wc * 32 + fr, fq * 8);
#define PG8_SA(b, h) (((b) * 2 + (h)) * HTB)
#define PG8_SB(b, h) ((4 + (b) * 2 + (h)) * HTB)
#define PG8_STAGE(bufoff, gbase, voff) do { _Pragma("unroll") for (int _i = 0; _i < 2; ++_i) \
        __builtin_amdgcn_global_load_lds((const unsigned*)((const char*)(gbase) + (voff)[_i]), (PG8_LAS unsigned*)(lds + (bufoff) + ldsw + _i * 8192), 16, 0, 0); } while (0)
#define PG8_LDA(dst, b, h) do { _Pragma("unroll") for (int m = 0; m < 4; ++m) _Pragma("unroll") for (int k = 0; k < 2; ++k) dst[m][k] = *(const PG8_LAS bf16x8*)(lds + PG8_SA(b, h) + aoff + m * 2048 + k * 1024); } while (0)
#define PG8_LDB(dst, b, h) do { _Pragma("unroll") for (int n = 0; n < 2; ++n) _Pragma("unroll") for (int k = 0; k < 2; ++k) dst[n][k] = *(const PG8_LAS bf16x8*)(lds + PG8_SB(b, h) + boff + n * 2048 + k * 1024); } while (0)
#define PG8_MMA(ai, bj, At, Bt) do { __builtin_amdgcn_s_setprio(1); _Pragma("unroll") for (int m = 0; m < 4; ++m) _Pragma("unroll") for (int n = 0; n < 2; ++n) _Pragma("unroll") for (int k = 0; k < 2; ++k) \
        acc[ai][bj][m][n] = __builtin_amdgcn_mfma_f32_16x16x32_bf16(Bt[n][k], At[m][k], acc[ai][bj][m][n], 0, 0, 0); __builtin_amdgcn_s_setprio(0); } while (0)
#define PG8_WAIT_V(n) asm volatile("s_waitcnt vmcnt(" #n ")" ::: "memory")
#define PG8_WAIT_L(n) asm volatile("s_waitcnt lgkmcnt(" #n ")" ::: "memory")
#define PG8_BAR __builtin_amdgcn_s_barrier()
#define PG8_SCHED __builtin_amdgcn_sched_barrier(0)
    Unit cur, nxt; int ui = 0;
    if (!S.next(0, cur)) return;
    f32x4 acc[2][2][4][2];
#pragma unroll
    for (int a = 0; a < 2; ++a)
#pragma unroll
        for (int b = 0; b < 2; ++b)
#pragma unroll
            for (int m = 0; m < 4; ++m)
#pragma unroll
                for (int n = 0; n < 2; ++n) acc[a][b][m][n] = (f32x4){0.f, 0.f, 0.f, 0.f};
    bf16x8 At[4][2], B0[2][2], B1[2][2];
    const char* cA = (const char*)g.A + (size_t)cur.pm * tstep + (size_t)cur.k0 * 2; const char* cB = (const char*)g.Bt + (size_t)cur.pn * tstep + (size_t)cur.k0 * 2;
    S.a_ready(cur);
    if constexpr (SP2) {
        PG8_STAGE(PG8_SB(0, 0), cB, voffB); PG8_STAGE(PG8_SB(0, 1), cB + hstep, voffB); PG8_STAGE(PG8_SA(0, 0), cA, voffA); PG8_STAGE(PG8_SA(0, 1), cA + hstep, voffA);
        if (wr == 1) PG8_BAR;
        PG8_WAIT_V(2); PG8_BAR;
        PG8_STAGE(PG8_SB(1, 0), cB + kstep, voffB); PG8_STAGE(PG8_SA(1, 0), cA + kstep, voffA); PG8_STAGE(PG8_SB(1, 1), cB + hstep + kstep, voffB);
        PG8_WAIT_V(6); PG8_BAR;
    } else {
        PG8_STAGE(PG8_SB(0, 0), cB, voffB); PG8_STAGE(PG8_SA(0, 0), cA, voffA); PG8_STAGE(PG8_SB(0, 1), cB + hstep, voffB); PG8_STAGE(PG8_SA(0, 1), cA + hstep, voffA);
        if (wr == 1) PG8_BAR;
        PG8_WAIT_V(4); PG8_BAR;
        PG8_STAGE(PG8_SB(1, 0), cB + kstep, voffB); PG8_STAGE(PG8_SA(1, 0), cA + kstep, voffA); PG8_STAGE(PG8_SB(1, 1), cB + hstep + kstep, voffB);
        PG8_WAIT_V(6); PG8_BAR;
    }
    for (;;) {
        const bool has_next = S.next(ui + 1, nxt);
        const char* nA = has_next ? (const char*)g.A + (size_t)nxt.pm * tstep + (size_t)nxt.k0 * 2 : cA; const char* nB = has_next ? (const char*)g.Bt + (size_t)nxt.pn * tstep + (size_t)nxt.k0 * 2 : cB;
        const int unt = cur.nt ? cur.nt : nt;
        for (int t = 0; t < unt; t += 2) {
            const bool last = (t == unt - 2);
            const char* a1 = cA + (size_t)(t + 1) * kstep;
            const char* a2 = last ? nA : cA + (size_t)(t + 2) * kstep; const char* b2 = last ? nB : cB + (size_t)(t + 2) * kstep;
            const char* a3 = a2 + kstep; const char* b3 = b2 + kstep;
            if (last && has_next) S.a_ready(nxt);
            if constexpr (SP2) {
            PG8_LDB(B0, 0, 0); PG8_LDB(B1, 0, 1); PG8_SCHED; PG8_LDA(At, 0, 0); PG8_STAGE(PG8_SA(1, 1), a1 + hstep, voffA);
            PG8_WAIT_V(8); PG8_WAIT_L(0); PG8_BAR; PG8_MMA(0, 0, At, B0); PG8_MMA(0, 1, At, B1); PG8_BAR; PG8_SCHED;
            PG8_LDA(At, 0, 1); PG8_STAGE(PG8_SB(0, 0), b2, voffB); PG8_STAGE(PG8_SB(0, 1), b2 + hstep, voffB); PG8_STAGE(PG8_SA(0, 0), a2, voffA);
            PG8_WAIT_V(8); PG8_WAIT_L(0); PG8_BAR; PG8_MMA(1, 0, At, B0); PG8_MMA(1, 1, At, B1); PG8_BAR; PG8_SCHED;
            PG8_LDB(B0, 1, 0); PG8_LDB(B1, 1, 1); PG8_SCHED; PG8_LDA(At, 1, 0); PG8_STAGE(PG8_SA(0, 1), a2 + hstep, voffA);
            PG8_WAIT_V(8); PG8_WAIT_L(0); PG8_BAR; PG8_MMA(0, 0, At, B0); PG8_MMA(0, 1, At, B1); PG8_BAR; PG8_SCHED;
            PG8_LDA(At, 1, 1); PG8_STAGE(PG8_SB(1, 0), b3, voffB); PG8_STAGE(PG8_SB(1, 1), b3 + hstep, voffB); PG8_STAGE(PG8_SA(1, 0), a3, voffA);
            PG8_WAIT_V(8); PG8_WAIT_L(0); PG8_BAR; PG8_MMA(1, 0, At, B0); PG8_MMA(1, 1, At, B1); PG8_BAR; PG8_SCHED;
            } else {
            PG8_LDB(B0, 0, 0); PG8_SCHED; PG8_LDA(At, 0, 0); PG8_STAGE(PG8_SA(1, 1), a1 + hstep, voffA);
            PG8_WAIT_L(8); PG8_BAR; PG8_WAIT_L(0); PG8_MMA(0, 0, At, B0); PG8_BAR; PG8_SCHED;
            PG8_LDB(B1, 0, 1); PG8_STAGE(PG8_SB(0, 0), b2, voffB);
            PG8_BAR; PG8_WAIT_L(0); PG8_MMA(0, 1, At, B1); PG8_BAR;
            PG8_LDA(At, 0, 1); PG8_STAGE(PG8_SA(0, 0), a2, voffA);
            PG8_BAR; PG8_WAIT_L(0); PG8_MMA(1, 0, At, B0); PG8_BAR; PG8_SCHED;
            PG8_STAGE(PG8_SB(0, 1), b2 + hstep, voffB);
            PG8_WAIT_V(6); PG8_BAR; PG8_MMA(1, 1, At, B1); PG8_BAR;
            PG8_LDB(B0, 1, 0); PG8_SCHED; PG8_LDA(At, 1, 0); PG8_STAGE(PG8_SA(0, 1), a2 + hstep, voffA);
            PG8_WAIT_L(8); PG8_BAR; PG8_WAIT_L(0); PG8_MMA(0, 0, At, B0); PG8_BAR; PG8_SCHED;
            PG8_LDB(B1, 1, 1); PG8_STAGE(PG8_SB(1, 0), b3, voffB);
            PG8_BAR; PG8_WAIT_L(0); PG8_MMA(0, 1, At, B1); PG8_BAR;
            PG8_LDA(At, 1, 1); PG8_STAGE(PG8_SA(1, 0), a3, voffA);
            PG8_BAR; PG8_WAIT_L(0); PG8_MMA(1, 0, At, B0); PG8_BAR; PG8_SCHED;
            PG8_STAGE(PG8_SB(1, 1), b3 + hstep, voffB);
            PG8_WAIT_V(6); PG8_BAR; PG8_MMA(1, 1, At, B1); PG8_BAR;
            }
        }
        if constexpr (ALIGN_EPI) { if (wr == 0) PG8_BAR; }
        if constexpr (!Epi::AFTER_DRAIN) { E(acc, cur, wr, wc, fr, fq); S.done(cur); }
        if (!has_next) break;
#pragma unroll
        for (int a = 0; a < 2; ++a)
#pragma unroll
            for (int b = 0; b < 2; ++b)
#pragma unroll
                for (int m = 0; m < 4; ++m)
#pragma unroll
                    for (int n = 0; n < 2; ++n) acc[a][b][m][n] = (f32x4){0.f, 0.f, 0.f, 0.f};
        cur = nxt; cA = nA; cB = nB; ++ui;
        if constexpr (ALIGN_EPI) { if (wr == 1) PG8_BAR; }
    }
    PG8_WAIT_V(0);
    if constexpr (!ALIGN_EPI) { if (wr == 0) PG8_BAR; }
    PG8_BAR;
    if constexpr (Epi::AFTER_DRAIN) { E.fused(acc, cur, wr, wc, fr, fq, lds, wid, lane); S.done(cur); }
#undef PG8_SA
#undef PG8_SB
#undef PG8_STAGE
#undef PG8_LDA
#undef PG8_LDB
#undef PG8_MMA
#undef PG8_WAIT_V
#undef PG8_WAIT_L
#undef PG8_BAR
#undef PG8_SCHED
}
}
#define GAS __attribute__((address_space(1)))
#define LAS __attribute__((address_space(3)))
typedef unsigned short bf16;
typedef unsigned v4u __attribute__((ext_vector_type(4)));
typedef unsigned v2u __attribute__((ext_vector_type(2)));
typedef float f32x4 __attribute__((ext_vector_type(4)));
typedef float f32x16 __attribute__((ext_vector_type(16)));
typedef short bf16x8 __attribute__((ext_vector_type(8)));
typedef short s16x4 __attribute__((ext_vector_type(4)));
typedef GAS unsigned gu32;
#define RLX_AGENT __ATOMIC_RELAXED, __HIP_MEMORY_SCOPE_AGENT
#define XB_TMO      128
#define XB_XCNT(j)  (256  + 64 * (j))
#define XB_XSUB(j)  (1280 + 64 * (j))
#define XB_XGEN(j)  (2304 + 64 * (j))
#define XB_TOP      3328
#define XB_TOPGEN   3392
#define XCD_BAR_WORDS 3456
#define XB_SPIN_CAP (1u << 18)

__device__ __forceinline__ unsigned xb_ld(unsigned* p)              { return __hip_atomic_load(p, __ATOMIC_RELAXED, __HIP_MEMORY_SCOPE_AGENT); }
__device__ __forceinline__ unsigned xb_add(unsigned* p, unsigned v) { return __hip_atomic_fetch_add(p, v, __ATOMIC_RELAXED, __HIP_MEMORY_SCOPE_AGENT); }
__device__ __forceinline__ unsigned xb_xcc_id() { return (unsigned)__builtin_amdgcn_s_getreg((3 << 11) | 20) & 0xFu; }
#define XB_SPIN(cond, bar) do { unsigned _sp = 0; while (cond) { __builtin_amdgcn_s_sleep(1); \
    if ((++_sp & 255u) == 0u) { if (xb_ld(&(bar)[XB_TMO])) break; if (_sp > XB_SPIN_CAP) { atomicAdd(&(bar)[XB_TMO], 1u); break; } } } } while (0)

struct XcdBarrier {
    unsigned* bar; unsigned x;
    volatile LAS unsigned* st;
    unsigned wv;
};

__device__ __forceinline__ unsigned xb_lane() { return __builtin_amdgcn_mbcnt_hi(~0u, __builtin_amdgcn_mbcnt_lo(~0u, 0u)); }
__device__ __forceinline__ XcdBarrier xcd_barrier_post(unsigned* bar, volatile LAS unsigned* st, unsigned wv) {
    XcdBarrier b; b.bar = bar; b.x = xb_xcc_id(); b.st = st; b.wv = wv;
    if (wv == 0u && xb_lane() == 0u) (void)xb_add(&bar[XB_XCNT(b.x)], 1u);
    return b;
}
__device__ __forceinline__ void xcd_barrier_complete(unsigned* bar, unsigned x, unsigned& nloc, unsigned& nx) {
    const unsigned G = gridDim.x * gridDim.y * gridDim.z;
    unsigned sum, cnt, mine, sp = 0u;
    for (;;) {
        sum = 0u; cnt = 0u; mine = 0u;
#pragma unroll
        for (unsigned j = 0; j < 16; ++j) { const unsigned c = xb_ld(&bar[XB_XCNT(j)]); sum += c; cnt += (c > 0u) ? 1u : 0u; mine = (j == x) ? c : mine; }
        if (sum == G) break;
        __builtin_amdgcn_s_sleep(1);
        if ((++sp & 255u) == 0u) { if (xb_ld(&bar[XB_TMO])) break; if (sp > XB_SPIN_CAP) { atomicAdd(&bar[XB_TMO], 1u); break; } }
    }
    nloc = mine > 0u ? mine : 1u; nx = cnt > 0u ? cnt : 1u;
}

__device__ __forceinline__ void xcd_barrier(const XcdBarrier& b) {
    asm volatile("s_waitcnt vmcnt(0)" ::: "memory");
    __syncthreads();
    if (b.wv == 0u && xb_lane() == 0u) {
        unsigned* bar = b.bar;
        __builtin_amdgcn_s_waitcnt(0);
        unsigned nloc = b.st[0], nx = b.st[1];
        if (nloc == 0u) { xcd_barrier_complete(bar, b.x, nloc, nx); b.st[0] = nloc; b.st[1] = nx; }
        const unsigned old = xb_add(&bar[XB_XSUB(b.x)], 1u);
        const unsigned gen = old / nloc;
        if (old + 1u == (gen + 1u) * nloc) {
            __builtin_amdgcn_fence(__ATOMIC_RELEASE, "agent");
            asm volatile("s_waitcnt vmcnt(0)" ::: "memory");
            const unsigned og = xb_add(&bar[XB_TOP], 1u);
            const unsigned tg = og / nx;
            if (og + 1u == (tg + 1u) * nx) xb_add(&bar[XB_TOPGEN], 1u);
            else XB_SPIN(xb_ld(&bar[XB_TOPGEN]) == tg, bar);
            __builtin_amdgcn_fence(__ATOMIC_ACQUIRE, "agent");
            xb_add(&bar[XB_XGEN(b.x)], 1u);
            asm volatile("s_waitcnt vmcnt(0)" ::: "memory");
        } else {
            XB_SPIN(xb_ld(&bar[XB_XGEN(b.x)]) == gen, bar);
            __builtin_amdgcn_fence(__ATOMIC_ACQUIRE, "agent");
            asm volatile("s_waitcnt vmcnt(0)" ::: "memory");
        }
    }
    __syncthreads();
}
#ifndef ONE_LAUNCH
#define ONE_LAUNCH 1
#endif
#ifndef NLAYERS
#define NLAYERS 4
#endif
constexpr int DM = 2048, MR = 8704, NLATR = 8192;
constexpr int NINP = 6400, DFF = 5632, NUP = 11264, EVIN = 6176, ODIN = 6160;
constexpr int NWAVES = 8, NTHR = 512;
constexpr float EPS = 1e-6f;
constexpr int NCHUNK = 68;
constexpr int PPL = 11, NPH = 1 + 4 * PPL;
constexpr size_t MiB = 1ull << 20;
constexpr size_t WS_CTL = 0, CTL_BYTES = 1 * MiB;
constexpr size_t WS_MOD = 1 * MiB, WS_ROPE = 1 * MiB + 640 * 1024;
constexpr size_t WS_W = 4 * MiB, W_LAYER = 99 * MiB, W_OUT = 25 * MiB, W_UP = 33 * MiB, W_DN = 77 * MiB;
constexpr size_t WS_XS = 400 * MiB, WS_H = 468 * MiB, WS_MIX = 502 * MiB, WS_P = 536 * MiB, WS_U = 644 * MiB, WS_ACT = 832 * MiB;
constexpr size_t WS_QR = 926 * MiB, WS_KR = 943 * MiB, WS_MQK = 960 * MiB, WS_DST = 977 * MiB, WS_SST = 1113 * MiB, WS_SM = 1181 * MiB, WS_B1 = 1185 * MiB, WS_B2 = 1186 * MiB, WS_END = 1187 * MiB;
constexpr size_t WS_SSQ = 524288;
constexpr size_t SM_GAM = 0, SM_DN = 1 * MiB, SM_NIN = 2 * MiB, SM_BL = 3 * MiB, SM_ML = 3 * MiB + 8192, SM_MIN = 3 * MiB + 16384;
constexpr int CW_BAR = 4096;
constexpr int LDS_BYTES = 147456, MISC_OFF = 131072 + 320;

struct Args { const float* in[27]; float* out; unsigned char* ws; int ph_lo, ph_hi, li, pad; };

__device__ __forceinline__ float bf_lo(unsigned u) { return __builtin_bit_cast(float, u << 16); }
__device__ __forceinline__ float bf_hi(unsigned u) { return __builtin_bit_cast(float, u & 0xffff0000u); }
__device__ __forceinline__ float bf1(bf16 b) { return __builtin_bit_cast(float, (unsigned)b << 16); }
typedef float f32x2_t __attribute__((ext_vector_type(2))); typedef __bf16 bf16x2_t __attribute__((ext_vector_type(2)));
__device__ __forceinline__ unsigned pk2(float lo, float hi) { f32x2_t v = {lo, hi}; bf16x2_t b = __builtin_convertvector(v, bf16x2_t); return __builtin_bit_cast(unsigned, b); }
__device__ __forceinline__ bf16 f2bf(float f) { return (bf16)(pk2(f, 0.f) & 0xffffu); }
__device__ __forceinline__ void unpack8(const v4u w, float (&f)[8]) { f[0] = bf_lo(w.x); f[1] = bf_hi(w.x); f[2] = bf_lo(w.y); f[3] = bf_hi(w.y); f[4] = bf_lo(w.z); f[5] = bf_hi(w.z); f[6] = bf_lo(w.w); f[7] = bf_hi(w.w); }
__device__ __forceinline__ v4u pack8(const float (&f)[8]) { v4u w; w.x = pk2(f[0], f[1]); w.y = pk2(f[2], f[3]); w.z = pk2(f[4], f[5]); w.w = pk2(f[6], f[7]); return w; }
__device__ __forceinline__ float silu_f(float x) { return x * __builtin_amdgcn_rcpf(1.f + __expf(-x)); }
__device__ __forceinline__ float sigmoid_f(float x) { return __builtin_amdgcn_rcpf(1.f + __expf(-x)); }
__device__ __forceinline__ float logsig_f(float z) { return fminf(z, 0.f) - __logf(1.f + __expf(-fabsf(z))); }
__device__ __forceinline__ float wave_sum(float v) {
#pragma unroll
    for (int o = 1; o < 64; o <<= 1) v += __shfl_xor(v, o);
    return v;
}
__device__ __forceinline__ float wave_max(float v) {
#pragma unroll
    for (int o = 1; o < 64; o <<= 1) v = fmaxf(v, __shfl_xor(v, o));
    return v;
}
__device__ __forceinline__ float wave_scan_sum(float v, int dir, int lane) {
#pragma unroll
    for (int o = 1; o < 64; o <<= 1) { const float up = __shfl_up(v, o), dn = __shfl_down(v, o); if (dir == 0) { if (lane >= o) v += up; } else { if (lane + o < 64) v += dn; } }
    return v;
}
__device__ __forceinline__ float wave_scan_max(float v, int dir, int lane) {
#pragma unroll
    for (int o = 1; o < 64; o <<= 1) { const float up = __shfl_up(v, o), dn = __shfl_down(v, o); if (dir == 0) { if (lane >= o) v = fmaxf(v, up); } else { if (lane + o < 64) v = fmaxf(v, dn); } }
    return v;
}
__device__ __forceinline__ bool seq_start(int r) { return r < NLATR ? (r & 4095) == 0 : ((r - NLATR) & 255) == 0; }

__device__ __forceinline__ bf16x8 frag_row(LAS const unsigned char* base, int stride, int row0, int k0, int lane) {
    return *(LAS const bf16x8*)(base + (row0 + (lane & 31)) * stride + (k0 + 8 * (lane >> 5)) * 2);
}
__device__ __forceinline__ s16x4 tr4(LAS const unsigned char* p) { return __builtin_amdgcn_ds_read_tr16_b64_v4i16((LAS s16x4*)p); }
__device__ __forceinline__ bf16x8 frag_tr(LAS const unsigned char* base, int stride, int k0, int col0, int lane) {
    const int h = lane >> 5, blk = (lane >> 4) & 1, q = (lane & 15) >> 2, p = lane & 3;
    LAS const unsigned char* a = base + (k0 + 8 * h + q) * stride + (col0 + 16 * blk + 4 * p) * 2;
    const s16x4 lo = tr4(a), hi = tr4(a + 4 * stride);
    return (bf16x8){lo[0], lo[1], lo[2], lo[3], hi[0], hi[1], hi[2], hi[3]};
}
__device__ __forceinline__ bf16x8 frag_tr_perm(LAS const unsigned char* base, int stride, int k0, int col0, int lane) {
    const int h = lane >> 5, blk = (lane >> 4) & 1, q = (lane & 15) >> 2, p = lane & 3;
    LAS const unsigned char* a = base + (k0 + 4 * h + q) * stride + (col0 + 16 * blk + 4 * p) * 2;
    const s16x4 lo = tr4(a), hi = tr4(a + 8 * stride);
    return (bf16x8){lo[0], lo[1], lo[2], lo[3], hi[0], hi[1], hi[2], hi[3]};
}
__device__ __forceinline__ int swz_off(int row, int ch) { return 256 * row + 16 * (ch ^ (((row & 3) << 2) | ((row >> 2) & 3))); }
__device__ __forceinline__ bf16x8 sfrag_row(LAS const unsigned char* base, int row0, int k0, int lane) {
    return *(LAS const bf16x8*)(base + swz_off(row0 + (lane & 31), (k0 >> 3) + (lane >> 5)));
}
__device__ __forceinline__ bf16x8 sfrag_tr_perm(LAS const unsigned char* base, int k0, int col0, int lane) {
    const int h = lane >> 5, blk = (lane >> 4) & 1, q = (lane & 15) >> 2, p = lane & 3, ch = (col0 >> 3) + 2 * blk + (p >> 1), r0 = k0 + 4 * h + q;
    const s16x4 lo = tr4(base + swz_off(r0, ch) + 8 * (p & 1)), hi = tr4(base + swz_off(r0 + 8, ch) + 8 * (p & 1));
    return (bf16x8){lo[0], lo[1], lo[2], lo[3], hi[0], hi[1], hi[2], hi[3]};
}
#define MFMA32(a, b, c) __builtin_amdgcn_mfma_f32_32x32x16_bf16((a), (b), (c), 0, 0, 0)
__device__ __forceinline__ f32x16 zero16() { f32x16 z;
#pragma unroll
    for (int i = 0; i < 16; ++i) z[i] = 0.f;
    return z; }
__device__ __forceinline__ void load_tile(LAS unsigned char* dst, int ls, const bf16* src, size_t ld, int rows, int cols, int tid) {
    const int cpr = cols >> 3, n = rows * cpr;
    for (int c = tid; c < n; c += NTHR) { const int r = c / cpr, cc = c - r * cpr; *(LAS v4u*)(dst + r * ls + cc * 16) = *(const v4u*)(src + (size_t)r * ld + cc * 8); }
}

__device__ __forceinline__ void store_tile(bf16* dst, size_t ld, LAS const unsigned char* src, int ls, int rows, int cols, int tid) {
    const int cpr = cols >> 3, n = rows * cpr;
    for (int c = tid; c < n; c += NTHR) { const int r = c / cpr, cc = c - r * cpr; *(v4u*)(dst + (size_t)r * ld + cc * 8) = *(LAS const v4u*)(src + r * ls + cc * 16); }
}

struct TrItem { const float* W; bf16* WT; int K, N, k0, n0, dn0, nts; };
__device__ __forceinline__ void tr_issue(const TrItem& t, f32x4 (&v)[8], int lane) {
    const int n = t.n0 + 4 * (lane & 7);
#pragma unroll
    for (int i = 0; i < 8; ++i) { const int kk = 8 * i + (lane >> 3); v[i] = n < t.N ? __builtin_nontemporal_load((const f32x4*)(t.W + (size_t)(t.k0 + kk) * t.N + n)) : (f32x4){0.f, 0.f, 0.f, 0.f}; }
}
__device__ __forceinline__ void tr_finish(const TrItem& t, const f32x4 (&v)[8], LAS float* scr, int lane) {
#pragma unroll
    for (int i = 0; i < 8; ++i) { const int kk = 8 * i + (lane >> 3); LAS float* d = scr + kk * 33 + 4 * (lane & 7); d[0] = v[i].x; d[1] = v[i].y; d[2] = v[i].z; d[3] = v[i].w; }
    asm volatile("s_waitcnt lgkmcnt(0)" ::: "memory");
    const int c = lane & 7;
#pragma unroll
    for (int j = 0; j < 4; ++j) { const int nn = (lane >> 3) + 8 * j; const LAS float* s = scr + (8 * c) * 33 + nn;
        v4u o; o.x = pk2(s[0 * 33], s[1 * 33]); o.y = pk2(s[2 * 33], s[3 * 33]); o.z = pk2(s[4 * 33], s[5 * 33]); o.w = pk2(s[6 * 33], s[7 * 33]);
        if (t.k0 >= 0 && t.nts) __builtin_nontemporal_store(o, (v4u*)(t.WT + (size_t)(t.dn0 + nn) * t.K + t.k0 + 8 * c)); else *(v4u*)(t.WT + (size_t)(t.dn0 + nn) * t.K + t.k0 + 8 * c) = o; }
    asm volatile("s_waitcnt lgkmcnt(0)" ::: "memory");
}
__device__ __forceinline__ void tr_decode(const Args& a, unsigned char* ws, int g, TrItem& t) {
    const int layer = g / 25344; int r = g - layer * 25344; const int li = layer >> 1; t.nts = layer > 0;
    unsigned char* wb = ws + WS_W + (size_t)layer * W_LAYER;
    int nblk;
    if (r < 6400) { if (layer & 1) { t.W = a.in[14] + (size_t)li * DM * ODIN; t.N = ODIN; } else { t.W = a.in[8] + (size_t)li * DM * EVIN; t.N = EVIN; } t.WT = (bf16*)wb; t.K = DM; nblk = NINP / 32; }
    else if ((r -= 6400) < 2048) { t.W = (layer & 1 ? a.in[15] : a.in[9]) + (size_t)li * DM * DM; t.N = DM; t.WT = (bf16*)(wb + W_OUT); t.K = DM; nblk = DM / 32; }
    else if ((r -= 2048) < 11264) { t.W = a.in[23] + (size_t)layer * DM * NUP; t.N = NUP; t.WT = (bf16*)(wb + W_UP); t.K = DM; nblk = NUP / 32; }
    else { r -= 11264; t.W = a.in[26] + (size_t)layer * DFF * DM; t.N = DM; t.WT = (bf16*)(wb + W_DN); t.K = DFF; nblk = DM / 32; }
    const int kb = r / nblk, nb = r - kb * nblk; t.k0 = 64 * kb; t.n0 = 32 * nb; t.dn0 = t.n0;
    if (t.N == NUP) { const int m0 = t.n0 < DFF ? t.n0 : t.n0 - DFF; t.dn0 = 256 * (m0 >> 7) + (t.n0 < DFF ? 0 : 128) + (m0 & 127); }
}
__device__ __forceinline__ void ph_convert(const Args& a, unsigned char* ws, LAS unsigned char* lds, int g_lo, int g_hi, int w, int nw, int wave, int lane) {
    LAS float* scr = (LAS float*)(lds + wave * 8448);
    TrItem cur, nxt; f32x4 va[8], vb[8];
    int g = g_lo + w;
    if (g < g_hi) { tr_decode(a, ws, g, cur); tr_issue(cur, va, lane); }
    while (g < g_hi) {
        const int g1 = g + nw; if (g1 < g_hi) { tr_decode(a, ws, g1, nxt); tr_issue(nxt, vb, lane); }
        tr_finish(cur, va, scr, lane);
        const int g2 = g1 + nw; if (g1 < g_hi) { if (g2 < g_hi) { tr_decode(a, ws, g2, cur); tr_issue(cur, va, lane); } tr_finish(nxt, vb, scr, lane); }
        g = g2;
    }
}
__device__ __forceinline__ void ph_prologue(const Args& a, unsigned char* ws, LAS unsigned char* lds, int tid, int lane, int wave, int bid, int G) {
    float* MOD = (float*)(ws + WS_MOD);
    LAS float* vec = (LAS float*)(lds + 73728);
    LAS float* red = (LAS float*)(lds + 98304);
    for (int e = tid; e < 3 * DM; e += NTHR) { const float v = e < 2 * DM ? a.in[1][e] : a.in[3][e - 2 * DM]; vec[e] = silu_f(v); }
    __syncthreads();
    for (int it = bid; it < 4 * 192; it += G) {
        const int layer = it / 192, cg = it - layer * 192, col = cg * 64 + 4 * (lane & 15), rq = lane >> 4;
        const float* W = a.in[4] + (size_t)layer * DM * 12288 + col;
        f32x4 a0 = {0.f, 0.f, 0.f, 0.f}, a1 = a0, a2 = a0;
#pragma unroll 16
        for (int i = 0; i < 64; ++i) { const int kk = 256 * wave + 4 * i + rq; const f32x4 w4 = __builtin_nontemporal_load((const f32x4*)(W + (size_t)kk * 12288));
            a0 += w4 * vec[kk]; a1 += w4 * vec[DM + kk]; a2 += w4 * vec[2 * DM + kk]; }
#pragma unroll
        for (int e = 0; e < 4; ++e) { a0[e] += __shfl_xor(a0[e], 16); a0[e] += __shfl_xor(a0[e], 32); a1[e] += __shfl_xor(a1[e], 16); a1[e] += __shfl_xor(a1[e], 32); a2[e] += __shfl_xor(a2[e], 16); a2[e] += __shfl_xor(a2[e], 32); }
        if (lane < 16) { *(LAS f32x4*)(red + (wave * 3 + 0) * 64 + 4 * lane) = a0; *(LAS f32x4*)(red + (wave * 3 + 1) * 64 + 4 * lane) = a1; *(LAS f32x4*)(red + (wave * 3 + 2) * 64 + 4 * lane) = a2; }
        __syncthreads();
        if (tid < 192) { const int j = tid >> 6, c = tid & 63; float s = a.in[5][layer * 12288 + cg * 64 + c];
#pragma unroll
            for (int w = 0; w < 8; ++w) s += red[(w * 3 + j) * 64 + c];
            MOD[(size_t)(layer * 3 + j) * 12288 + cg * 64 + c] = s; }
        __syncthreads();
    }
    if (bid == G - 1) { float* rope = (float*)(ws + WS_ROPE);
        for (int e = tid; e < 1024; e += NTHR) { const int pos = e >> 4, f = e & 15; const float inv = powf(10000.f, -(float)f / 16.f), ang = (float)pos * inv; rope[e] = cosf(ang); rope[1024 + e] = sinf(ang); } }
    ph_convert(a, ws, lds, 0, 25344, bid * NWAVES + wave, G * NWAVES, wave, lane);
}

__device__ __forceinline__ void fuse_row(const float* src, float* XS, int row, int lane, const float* part, const float* pgate, int nsplit, const float* ng, const float* msc, bf16* H, float* ssq) {
    const int mi = row < NLATR ? (row >> 12) : 2;
    const f32x4* sr = (const f32x4*)src + lane; f32x4* xr = (f32x4*)(XS + (size_t)row * DM) + lane;
    f32x4 v[8];
#pragma unroll
    for (int j = 0; j < 8; ++j) v[j] = sr[64 * j];
    if (nsplit > 0) {
        f32x4 sacc[8];
#pragma unroll
        for (int j = 0; j < 8; ++j) sacc[j] = (f32x4){0.f, 0.f, 0.f, 0.f};
        for (int sp = 0; sp < nsplit; ++sp) { const f32x4* pr = (const f32x4*)(part + ((size_t)sp * 512 + (row - NLATR)) * DM) + lane;
#pragma unroll
            for (int j = 0; j < 8; ++j) sacc[j] += pr[64 * j]; }
#pragma unroll
        for (int j = 0; j < 8; ++j) v[j] += *(const f32x4*)(pgate + 4 * lane + 256 * j) * sacc[j];
    }
    float ss = 0.f;
#pragma unroll
    for (int j = 0; j < 8; ++j) { if (nsplit > 0 || row >= NLATR) xr[64 * j] = v[j];
        ss += (v[j].x * v[j].x + v[j].y * v[j].y) + (v[j].z * v[j].z + v[j].w * v[j].w); }
    ss = wave_sum(ss);
    if (lane == 0) ssq[row] = ss;
#pragma unroll
    for (int j = 0; j < 8; ++j) { const int col = 4 * lane + 256 * j;
        const f32x4 y = v[j] * *(const f32x4*)(ng + col) * (*(const f32x4*)(msc + (size_t)mi * 12288 + col) + 1.f);
        v2u o; o.x = pk2(y.x, y.y); o.y = pk2(y.z, y.w);
        *(v2u*)(H + (size_t)row * DM + col) = o; }
}
__device__ __forceinline__ void ph_norm0(const float* x, const float* ctx, float* XS, const float* ng, const float* msc, bf16* H, float* ssq, int gw, int NGW, int lane) {
    for (int row = gw; row < MR; row += NGW) fuse_row(row < NLATR ? x + (size_t)row * DM : ctx + (size_t)(row - NLATR) * DM, XS, row, lane, nullptr, nullptr, 0, ng, msc, H, ssq);
}
template <int NS>
__device__ __forceinline__ void ph_ctxfix(float* XS, const float* part, const float* pgate, const float* ng, const float* msc, bf16* H, float* ssq, int gw, int NGW, int lane) {
    for (int it = gw; it < 2048; it += NGW) {
        const int row = NLATR + (it >> 2), c0 = (it & 3) * 512 + 8 * lane;
        float* xp = XS + (size_t)row * DM + c0;
        f32x4 v0 = *(const f32x4*)xp, v1 = *(const f32x4*)(xp + 4);
        f32x4 p0[NS], p1[NS];
#pragma unroll
        for (int sp = 0; sp < NS; ++sp) { const float* pp = part + ((size_t)sp * 512 + (row - NLATR)) * DM + c0; p0[sp] = *(const f32x4*)pp; p1[sp] = *(const f32x4*)(pp + 4); }
        f32x4 s0 = p0[0], s1 = p1[0];
#pragma unroll
        for (int sp = 1; sp < NS; ++sp) { s0 += p0[sp]; s1 += p1[sp]; }
        v0 += *(const f32x4*)(pgate + c0) * s0; v1 += *(const f32x4*)(pgate + c0 + 4) * s1;
        *(f32x4*)xp = v0; *(f32x4*)(xp + 4) = v1;
        float ss = (v0.x * v0.x + v0.y * v0.y) + (v0.z * v0.z + v0.w * v0.w) + (v1.x * v1.x + v1.y * v1.y) + (v1.z * v1.z + v1.w * v1.w);
        ss = wave_sum(ss);
        if (lane == 0) (void)__hip_atomic_fetch_add(ssq + row, ss, __ATOMIC_RELAXED, __HIP_MEMORY_SCOPE_AGENT);
        const f32x4 y0 = v0 * *(const f32x4*)(ng + c0) * (*(const f32x4*)(msc + 2 * 12288 + c0) + 1.f), y1 = v1 * *(const f32x4*)(ng + c0 + 4) * (*(const f32x4*)(msc + 2 * 12288 + c0 + 4) + 1.f);
        v4u o; o.x = pk2(y0.x, y0.y); o.y = pk2(y0.z, y0.w); o.z = pk2(y1.x, y1.y); o.w = pk2(y1.z, y1.w);
        *(v4u*)(H + (size_t)row * DM + c0) = o;
    }
}
__device__ __forceinline__ void ph_bias(const bf16* WIN, const bf16* WUPt, const float* mod, float* b1, float* b2, int gw, int NGW, int lane, int w_lo, int w_hi) {
    for (int which = w_lo; which < w_hi; ++which) {
        const bf16* WT = which ? WUPt : WIN; const int N = which ? NUP : NINP; const float* sh = mod + (which ? 3 * DM : 0); float* out = which ? b2 : b1;
        float s0[32], s1[32], s2[32];
#pragma unroll
        for (int i = 0; i < 4; ++i)
#pragma unroll
            for (int h = 0; h < 2; ++h) { const int k = 512 * i + 8 * lane + 4 * h; const f32x4 a0 = *(const f32x4*)(sh + k), a1 = *(const f32x4*)(sh + 12288 + k), a2 = *(const f32x4*)(sh + 2 * 12288 + k);
#pragma unroll
                for (int el = 0; el < 4; ++el) { s0[8 * i + 4 * h + el] = a0[el]; s1[8 * i + 4 * h + el] = a1[el]; s2[8 * i + 4 * h + el] = a2[el]; } }
#pragma unroll 1
        for (int n0 = gw * 2; n0 < N; n0 += NGW * 2) {
            v4u wv[2][4];
#pragma unroll
            for (int rr = 0; rr < 2; ++rr)
#pragma unroll
                for (int i = 0; i < 4; ++i) wv[rr][i] = *(const v4u*)(WT + (size_t)(n0 + rr) * DM + 512 * i + 8 * lane);
            float d[2][3];
#pragma unroll
            for (int rr = 0; rr < 2; ++rr) { d[rr][0] = 0.f; d[rr][1] = 0.f; d[rr][2] = 0.f;
#pragma unroll
                for (int i = 0; i < 4; ++i) { float w[8]; unpack8(wv[rr][i], w);
#pragma unroll
                    for (int el = 0; el < 8; ++el) { d[rr][0] += w[el] * s0[8 * i + el]; d[rr][1] += w[el] * s1[8 * i + el]; d[rr][2] += w[el] * s2[8 * i + el]; } } }
#pragma unroll
            for (int rr = 0; rr < 2; ++rr)
#pragma unroll
                for (int j = 0; j < 3; ++j) d[rr][j] = wave_sum(d[rr][j]);
            if (lane == 0) {
#pragma unroll
                for (int rr = 0; rr < 2; ++rr) { out[n0 + rr] = d[rr][0]; out[N + n0 + rr] = d[rr][1]; out[2 * N + n0 + rr] = d[rr][2]; } }
        }
    }
}

template <int MODE>
__device__ __forceinline__ void ph_conv(const bf16* SRC, const float* cw, const float* cb, bf16* DST, int gtid, int NT) {
    constexpr int NC = MODE == 0 ? DFF : 1024, NCG = NC / 8, NRB = MR / 16;
    constexpr int LDS_ = MODE == 0 ? NUP : NINP, LDD = MODE == 0 ? DFF : (MODE == 1 ? DM : 1024);
    for (int it = gtid; it < NRB * NCG; it += NT) {
        const int rb = it / NCG, cg = it - rb * NCG, r0 = rb * 16, c0 = cg * 8;
        float w0[8], w1[8], w2[8], bb[8];
#pragma unroll
        for (int j = 0; j < 8; ++j) { w0[j] = cw[c0 + j]; w1[j] = cw[NC + c0 + j]; w2[j] = cw[2 * NC + c0 + j]; bb[j] = MODE == 0 ? cb[c0 + j] : 0.f; }
        auto ld = [&](int r, float (&f)[8]) {
            if (MODE == 0) { unpack8(*(const v4u*)(SRC + (size_t)r * LDS_ + c0), f); }
            else if (MODE == 1) { float s1[8], s2[8]; unpack8(*(const v4u*)(SRC + (size_t)r * LDS_ + 3104 + c0), s1); unpack8(*(const v4u*)(SRC + (size_t)r * LDS_ + 5152 + c0), s2);
#pragma unroll
                for (int j = 0; j < 8; ++j) f[j] = s1[j] * s2[j]; }
            else { unpack8(*(const v4u*)(SRC + (size_t)r * LDS_ + 3072 + c0), f); }
        };
        float prev[8], cur[8], nxt[8];
        if (!seq_start(r0)) ld(r0 - 1, prev); else {
#pragma unroll
            for (int j = 0; j < 8; ++j) prev[j] = 0.f; }
        ld(r0, cur);
#pragma unroll 2
        for (int i = 0; i < 16; ++i) {
            const int r = r0 + i;
            if (i < 15 || !seq_start(r0 + 16)) ld(r + 1, nxt); else {
#pragma unroll
                for (int j = 0; j < 8; ++j) nxt[j] = 0.f; }
            float o[8];
            if (MODE == 0) { float vv[8]; unpack8(*(const v4u*)(SRC + (size_t)r * LDS_ + DFF + c0), vv);
#pragma unroll
                for (int j = 0; j < 8; ++j) o[j] = silu_f(w0[j] * prev[j] + w1[j] * cur[j] + w2[j] * nxt[j] + bb[j]) * vv[j]; }
            else if (MODE == 1) { float vv[8]; unpack8(*(const v4u*)(SRC + (size_t)r * LDS_ + 4128 + c0), vv);
#pragma unroll
                for (int j = 0; j < 8; ++j) o[j] = (w0[j] * prev[j] + w1[j] * cur[j] + w2[j] * nxt[j]) * vv[j]; }
            else { const float sc = c0 >= 512 ? 0.08838834764831845f : 1.f;
#pragma unroll
                for (int j = 0; j < 8; ++j) o[j] = silu_f(w0[j] * prev[j] + w1[j] * cur[j] + w2[j] * nxt[j]) * sc; }
            *(v4u*)(DST + (size_t)r * LDD + (MODE == 1 ? 1024 : 0) + c0) = pack8(o);
#pragma unroll
            for (int j = 0; j < 8; ++j) { prev[j] = cur[j]; cur[j] = nxt[j]; }
        }
    }
}

__device__ __forceinline__ void ph_act_fix(const float* halo, const float* cw, bf16* ACT, int gtid, int NT) {
    for (int e = gtid; e < 34 * 44 * 256; e += NT) {
        const int ch = e & 127, which = (e >> 7) & 1, tile = e >> 8, pm = tile / 44, pn = tile - pm * 44, chg = pn * 128 + ch;
        const float* hb = halo + (size_t)tile * 768;
        const int row = 256 * pm + (which ? 255 : 0);
        float g = 0.f;
        if (which == 0) { if (!seq_start(row)) g = halo[(size_t)(tile - 44) * 768 + 128 + ch] * cw[chg]; }
        else { if (!seq_start(row + 1)) g = halo[(size_t)(tile + 44) * 768 + ch] * cw[2 * DFF + chg]; }
        const float cv = hb[(2 + which) * 128 + ch] + g;
        ACT[(size_t)row * DFF + chg] = f2bf(silu_f(cv) * hb[(4 + which) * 128 + ch]);
    }
}

__device__ __forceinline__ void act_fix_tile(const float* halo, const float* cw, bf16* ACT, int pm, int tid) {
    f32x4 cp[6], vv[6], gg[6];
#pragma unroll
    for (int i = 0; i < 6; ++i) { const int e = tid + NTHR * i; const bool ok = e < 2816; const int ee = ok ? e : 0;
        const int c4 = ee & 31, which = (ee >> 5) & 1, pn = ee >> 6, tile = pm * 44 + pn, chg = pn * 128 + 4 * c4;
        const float* hb = halo + (size_t)tile * 768 + 4 * c4;
        const int row = 256 * pm + (which ? 255 : 0);
        cp[i] = *(const f32x4*)(hb + (2 + which) * 128); vv[i] = *(const f32x4*)(hb + (4 + which) * 128);
        const bool edge = which == 0 ? seq_start(row) : seq_start(row + 1);
        const f32x4 nb = edge ? (f32x4){0.f, 0.f, 0.f, 0.f} : *(const f32x4*)(halo + (size_t)(which == 0 ? tile - 44 : tile + 44) * 768 + (which == 0 ? 128 : 0) + 4 * c4);
        gg[i] = nb * *(const f32x4*)(cw + (which == 0 ? 0 : 2 * DFF) + chg); }
#pragma unroll
    for (int i = 0; i < 6; ++i) { const int e = tid + NTHR * i; if (e < 2816) {
        const int c4 = e & 31, which = (e >> 5) & 1, pn = e >> 6, chg = pn * 128 + 4 * c4; const int row = 256 * pm + (which ? 255 : 0);
        const f32x4 cv = cp[i] + gg[i];
        v2u o; o.x = pk2(silu_f(cv.x) * vv[i].x, silu_f(cv.y) * vv[i].y); o.y = pk2(silu_f(cv.z) * vv[i].z, silu_f(cv.w) * vv[i].w);
        *(v2u*)(ACT + (size_t)row * DFF + chg) = o; } }
}

template <int MODE>
__device__ __forceinline__ void ph_conv8(const bf16* SRC, const float* cw, bf16* DST, int gtid, int NT) {
    constexpr int NCG = 128, NRB = MR / 8, LDD = MODE == 1 ? DM : 1024;
    for (int p = 0, it = gtid; it < NRB * NCG; ++p, it = p * NT + ((p & 1) ? NT - 1 - gtid : gtid)) {
        const int rb = it >> 7, cg = it & 127, r0 = rb * 8, c0 = cg * 8;
        const bf16* base = SRC + (size_t)r0 * NINP + c0;
        const bool hp = !seq_start(r0), hn = !seq_start(r0 + 8);
        v4u xa[10], xb[10], xg[8];
#pragma unroll
        for (int i = 0; i < 10; ++i) { const bool ok = (i > 0 || hp) && (i < 9 || hn); const bf16* rp = base + (ptrdiff_t)(i - 1) * NINP;
            if (MODE == 1) { xa[i] = ok ? *(const v4u*)(rp + 3104) : (v4u){0u, 0u, 0u, 0u}; xb[i] = ok ? *(const v4u*)(rp + 5152) : (v4u){0u, 0u, 0u, 0u}; }
            else { xa[i] = ok ? *(const v4u*)(rp + 3072) : (v4u){0u, 0u, 0u, 0u}; } }
        if (MODE == 1) {
#pragma unroll
            for (int i = 0; i < 8; ++i) xg[i] = *(const v4u*)(base + (size_t)i * NINP + 4128); }
        float w0[8], w1[8], w2[8];
#pragma unroll
        for (int j = 0; j < 8; ++j) { w0[j] = cw[c0 + j]; w1[j] = cw[1024 + c0 + j]; w2[j] = cw[2048 + c0 + j]; }
        float prev[8], cur[8], nxt[8];
        auto cvt = [&](int i, float (&f)[8]) { unpack8(xa[i], f); if (MODE == 1) { float g[8]; unpack8(xb[i], g);
#pragma unroll
            for (int j = 0; j < 8; ++j) f[j] *= g[j]; } };
        cvt(0, prev); cvt(1, cur);
        const float sc = (MODE == 2 && c0 >= 512) ? 0.08838834764831845f : 1.f;
#pragma unroll
        for (int i = 0; i < 8; ++i) { cvt(i + 2, nxt); float o[8];
            if (MODE == 1) { float vv[8]; unpack8(xg[i], vv);
#pragma unroll
                for (int j = 0; j < 8; ++j) o[j] = (w0[j] * prev[j] + w1[j] * cur[j] + w2[j] * nxt[j]) * vv[j]; }
            else {
#pragma unroll
                for (int j = 0; j < 8; ++j) o[j] = silu_f(w0[j] * prev[j] + w1[j] * cur[j] + w2[j] * nxt[j]) * sc; }
            *(v4u*)(DST + (size_t)(r0 + i) * LDD + (MODE == 1 ? 1024 : 0) + c0) = pack8(o);
#pragma unroll
            for (int j = 0; j < 8; ++j) { prev[j] = cur[j]; cur[j] = nxt[j]; } }
    }
}

__device__ __forceinline__ void ph_qkprep(const bf16* P, const float* qg, const float* kg, const float* rope, bf16* QR, bf16* KR, int gw, int NGW, int lane) {
    const int i8 = lane & 7;
    float gq[8], gk[8];
#pragma unroll
    for (int j = 0; j < 8; ++j) { gq[j] = qg[8 * i8 + j]; gk[j] = kg[8 * i8 + j]; }
    for (int it0 = gw; it0 < MR * 4; it0 += 4 * NGW) {
        v4u xv[4];
#pragma unroll
        for (int k = 0; k < 4; ++k) { const int it = it0 + k * NGW; const int itc = it < MR * 4 ? it : it0; const int row = itc >> 2, qtr = itc & 3;
            xv[k] = *(const v4u*)(P + (size_t)row * NINP + (qtr >> 1) * 1024 + (qtr & 1) * 512 + 8 * lane); }
#pragma unroll
        for (int k = 0; k < 4; ++k) { const int it = it0 + k * NGW; if (it < MR * 4) {
            const int row = it >> 2, qtr = it & 3, isk = qtr >> 1;
            float x[8]; unpack8(xv[k], x);
            float ss = 0.f;
#pragma unroll
            for (int j = 0; j < 8; ++j) ss += x[j] * x[j];
            ss += __shfl_xor(ss, 1); ss += __shfl_xor(ss, 2); ss += __shfl_xor(ss, 4);
            const float r = __builtin_amdgcn_rsqf(ss * (1.f / 64.f) + EPS);
            float y[8], o[8];
#pragma unroll
            for (int j = 0; j < 8; ++j) y[j] = x[j] * r * (isk ? gk[j] : gq[j]);
            if (row < NLATR) {
                const int t = row & 4095, pos = (i8 < 4) ? (t >> 6) : (t & 63), f0 = 8 * (i8 & 1);
                const f32x4 c0 = *(const f32x4*)(rope + pos * 16 + f0), c1 = *(const f32x4*)(rope + pos * 16 + f0 + 4), s0 = *(const f32x4*)(rope + 1024 + pos * 16 + f0), s1 = *(const f32x4*)(rope + 1024 + pos * 16 + f0 + 4);
#pragma unroll
                for (int j = 0; j < 8; ++j) { const float pj = __shfl_xor(y[j], 2), c = j < 4 ? c0[j & 3] : c1[j & 3], sn = j < 4 ? s0[j & 3] : s1[j & 3];
                    o[j] = (i8 & 2) ? (pj * sn + y[j] * c) : (y[j] * c - pj * sn); }
            } else {
#pragma unroll
                for (int j = 0; j < 8; ++j) o[j] = y[j]; }
            if (!isk) {
#pragma unroll
                for (int j = 0; j < 8; ++j) o[j] *= 0.18033688011112042f; }
            *(v4u*)((isk ? KR : QR) + (size_t)row * 1024 + (qtr & 1) * 512 + 8 * lane) = pack8(o); } }
    }
}

struct ScanP {
    const bf16* P; const bf16* MQK; bf16* MIX;
    const float* gw2; const float* gb;
    const float* mgb;
    const float* ng;
    bf16* DSTp; bf16* SSTp; float* GAM; float* DN; float* NIN; float* BL; float* ML; float* MINp;
};
__device__ __forceinline__ void scan_unit(int u, int& b, int& head, int& mm, int& rowbase) {
    b = u / 272; const int rem = u - b * 272; head = rem / 68; mm = rem - head * 68;
    rowbase = mm < 4 ? NLATR + b * 256 + 64 * mm : b * 4096 + 64 * (mm - 4);
}
__device__ __forceinline__ int scan_chunk(int mm, int dir) { return dir ? (mm < 4 ? 3 - mm : 71 - mm) : mm; }

__device__ __forceinline__ void gla_gates(const ScanP& s, LAS const float* glr, LAS float* tot, int head, int dir, int tid, float (&bb)[16], float& btot) {
    const int dk = tid & 127, grp = tid >> 7;
    float w2[16];
#pragma unroll
    for (int r = 0; r < 16; ++r) w2[r] = s.gw2[(dir * 16 + r) * 512 + head * 128 + dk];
    const float bias = s.gb[dir * 512 + head * 128 + dk];
#pragma unroll
    for (int tt = 0; tt < 16; ++tt) { const int t = 16 * grp + tt; float z = bias;
#pragma unroll
        for (int r = 0; r < 16; ++r) z += glr[t * 32 + dir * 16 + r] * w2[r];
        bb[tt] = logsig_f(z) * 0.0625f; }
    if (dir == 0) {
#pragma unroll
        for (int tt = 1; tt < 16; ++tt) bb[tt] += bb[tt - 1];
        tot[grp * 128 + dk] = bb[15];
    } else {
#pragma unroll
        for (int tt = 14; tt >= 0; --tt) bb[tt] += bb[tt + 1];
        tot[grp * 128 + dk] = bb[0];
    }
    __syncthreads();
    float off = 0.f; btot = 0.f;
#pragma unroll
    for (int g = 0; g < 4; ++g) { const float tv = tot[g * 128 + dk]; btot += tv; if (dir == 0 ? g < grp : g > grp) off += tv; }
#pragma unroll
    for (int tt = 0; tt < 16; ++tt) bb[tt] += off;
}

__device__ __forceinline__ void ph_mlstm_local(const ScanP& s, LAS unsigned char* lds, int tid, int lane, int wave, int bid, int G) {
    LAS unsigned char* Vs = lds; LAS unsigned char* Kh = lds + 33792; LAS unsigned char* Kr = lds + 68608;
    LAS float* wv = (LAS float*)(lds + 86016); LAS float* dnp = (LAS float*)(lds + 86528);
    const int dk = tid & 127, grp = tid >> 7;
    v4u pv[4], pk[2];
#define ML_PREF(u_) do { int b_, head_, mm_, rb_; scan_unit((u_), b_, head_, mm_, rb_); \
        _Pragma("unroll") for (int i = 0; i < 4; ++i) { const int c_ = tid + NTHR * i; pv[i] = *(const v4u*)(s.P + (size_t)(rb_ + (c_ >> 5)) * NINP + 4096 + head_ * 256 + (c_ & 31) * 8); } \
        _Pragma("unroll") for (int i = 0; i < 2; ++i) { const int c_ = tid + NTHR * i; pk[i] = *(const v4u*)(s.MQK + (size_t)(rb_ + (c_ >> 4)) * 1024 + 512 + head_ * 128 + (c_ & 15) * 8); } } while (0)
    if (bid < 544) ML_PREF(bid);
    for (int u = bid; u < 544; u += G) {
        int b, head, mm, rowbase; scan_unit(u, b, head, mm, rowbase);
#pragma unroll
        for (int i = 0; i < 4; ++i) { const int c_ = tid + NTHR * i; *(LAS v4u*)(Vs + (c_ >> 5) * 528 + (c_ & 31) * 16) = pv[i]; }
#pragma unroll
        for (int i = 0; i < 2; ++i) { const int c_ = tid + NTHR * i; *(LAS v4u*)(Kr + (c_ >> 4) * 272 + (c_ & 15) * 16) = pk[i]; }
        size_t ccd[2];
#pragma unroll
        for (int dir = 0; dir < 2; ++dir) ccd[dir] = (size_t)((b * 4 + head) * 2 + dir) * NCHUNK + scan_chunk(mm, dir);
        if (wave < 2) { const int dir = wave;
            const float ig = bf1(s.P[(size_t)(rowbase + lane) * NINP + 6144 + dir * 8 + head]) + s.mgb[dir * 8 + head];
            const float fg = bf1(s.P[(size_t)(rowbase + lane) * NINP + 6144 + dir * 8 + 4 + head]) + s.mgb[dir * 8 + 4 + head];
            const float lf = logsig_f(fg), bcs = wave_scan_sum(lf, dir, lane), blast = wave_sum(lf);
            const float gs = blast - bcs + ig, mloc = wave_max(gs);
            wv[dir * 64 + lane] = __expf(gs - mloc);
            if (lane == 0) { s.BL[ccd[dir]] = blast; s.ML[ccd[dir]] = mloc; } }
        __syncthreads();
        if (u + G < 544) ML_PREF(u + G);
        { float p0 = 0.f, p1 = 0.f;
#pragma unroll
          for (int tt = 0; tt < 16; ++tt) { const int t = 16 * grp + tt; const float kr = bf1(*(LAS const bf16*)(Kr + t * 272 + dk * 2)); const float k0 = kr * wv[t], k1 = kr * wv[64 + t];
              *(LAS bf16*)(Kh + t * 272 + dk * 2) = f2bf(k0); *(LAS bf16*)(Kh + 17408 + t * 272 + dk * 2) = f2bf(k1); p0 += k0; p1 += k1; }
          dnp[grp * 128 + dk] = p0; dnp[512 + grp * 128 + dk] = p1; }
        __syncthreads();
        if (tid < 256) { const int dir = tid >> 7, d_ = tid & 127; LAS const float* dp = dnp + dir * 512; s.DN[ccd[dir] * 128 + d_] = (dp[d_] + dp[128 + d_]) + (dp[256 + d_] + dp[384 + d_]); }
#pragma unroll
        for (int dir = 0; dir < 2; ++dir) {
            f32x16 acc[4];
#pragma unroll
            for (int nt = 0; nt < 4; ++nt) acc[nt] = zero16();
#pragma unroll
            for (int ks = 0; ks < 4; ++ks) { const bf16x8 af = frag_tr(Vs, 528, 16 * ks, 32 * wave, lane);
#pragma unroll
                for (int nt = 0; nt < 4; ++nt) { const bf16x8 bfr = frag_tr(Kh + dir * 17408, 272, 16 * ks, 32 * nt, lane); acc[nt] = MFMA32(af, bfr, acc[nt]); } }
            bf16* D = s.DSTp + ccd[dir] * 32768;
#pragma unroll
            for (int nt = 0; nt < 4; ++nt)
#pragma unroll
                for (int r = 0; r < 16; ++r) { const int dv = 32 * wave + (r & 3) + 8 * (r >> 2) + 4 * (lane >> 5); D[dv * 128 + 32 * nt + (lane & 31)] = f2bf(acc[nt][r]); }
        }
        __syncthreads();
    }
#undef ML_PREF
}

__device__ __forceinline__ void ph_gla_local(const ScanP& s, bf16* QT, bf16* KT, LAS unsigned char* lds, int tid, int lane, int wave, int bid, int G) {
    LAS unsigned char* Vs = lds; LAS unsigned char* Kh = lds + 33792; LAS unsigned char* Qr = lds + 51200; LAS unsigned char* Kr = lds + 68608;
    LAS float* glr = (LAS float*)(lds + 86016); LAS float* tot = (LAS float*)(lds + 90112);
    const int dk = tid & 127, grp = tid >> 7;
    v4u pv[4], pq[2], pk[2]; bf16 pg[2]; float pw[17];
#define GL_PREF(u_) do { const int dir_ = (u_) & 1; int b_, head_, mm_, rb_; scan_unit((u_) >> 1, b_, head_, mm_, rb_); const bf16* base_ = s.P + (size_t)rb_ * NINP; \
        _Pragma("unroll") for (int i = 0; i < 4; ++i) { const int c_ = tid + NTHR * i; pv[i] = *(const v4u*)(base_ + (size_t)(c_ >> 5) * NINP + 1024 + head_ * 256 + (c_ & 31) * 8); } \
        _Pragma("unroll") for (int i = 0; i < 2; ++i) { const int c_ = tid + NTHR * i; pq[i] = *(const v4u*)(base_ + (size_t)(c_ >> 4) * NINP + head_ * 128 + (c_ & 15) * 8); pk[i] = *(const v4u*)(base_ + (size_t)(c_ >> 4) * NINP + 512 + head_ * 128 + (c_ & 15) * 8); \
            pg[i] = base_[(size_t)(c_ >> 4) * NINP + 3072 + dir_ * 16 + (c_ & 15)]; } \
        _Pragma("unroll") for (int r_ = 0; r_ < 16; ++r_) pw[r_] = s.gw2[(dir_ * 16 + r_) * 512 + head_ * 128 + (tid & 127)]; pw[16] = s.gb[dir_ * 512 + head_ * 128 + (tid & 127)]; } while (0)
    if (bid < 1088) GL_PREF(bid);
    for (int u = bid; u < 1088; u += G) {
        const int dir = u & 1; int b, head, mm, rowbase; scan_unit(u >> 1, b, head, mm, rowbase);
        const int chain = (b * 4 + head) * 2 + dir, c = scan_chunk(mm, dir); const size_t cc = (size_t)chain * NCHUNK + c;
#pragma unroll
        for (int i = 0; i < 4; ++i) { const int c_ = tid + NTHR * i; *(LAS v4u*)(Vs + (c_ >> 5) * 528 + (c_ & 31) * 16) = pv[i]; }
#pragma unroll
        for (int i = 0; i < 2; ++i) { const int c_ = tid + NTHR * i; *(LAS v4u*)(Qr + (c_ >> 4) * 272 + (c_ & 15) * 16) = pq[i]; *(LAS v4u*)(Kr + (c_ >> 4) * 272 + (c_ & 15) * 16) = pk[i]; glr[c_] = bf1(pg[i]); }
        __syncthreads();
        float bb[16], btot;
        { float w2[16];
#pragma unroll
          for (int r = 0; r < 16; ++r) w2[r] = pw[r];
          const float bias = pw[16];
#pragma unroll
          for (int tt = 0; tt < 16; ++tt) { const int t = 16 * grp + tt; float z = bias;
#pragma unroll
              for (int r = 0; r < 16; ++r) z += glr[t * 16 + r] * w2[r];
              bb[tt] = logsig_f(z) * 0.0625f; }
          if (dir == 0) {
#pragma unroll
              for (int tt = 1; tt < 16; ++tt) bb[tt] += bb[tt - 1];
              tot[grp * 128 + dk] = bb[15];
          } else {
#pragma unroll
              for (int tt = 14; tt >= 0; --tt) bb[tt] += bb[tt + 1];
              tot[grp * 128 + dk] = bb[0];
          }
          __syncthreads();
          float off = 0.f; btot = 0.f;
#pragma unroll
          for (int g = 0; g < 4; ++g) { const float tv = tot[g * 128 + dk]; btot += tv; if (dir == 0 ? g < grp : g > grp) off += tv; }
#pragma unroll
          for (int tt = 0; tt < 16; ++tt) bb[tt] += off; }
        if (u + G < 1088) GL_PREF(u + G);
#pragma unroll
        for (int tt = 0; tt < 16; ++tt) { const int t = 16 * grp + tt;
            const float qv = bf1(*(LAS const bf16*)(Qr + t * 272 + dk * 2)), kv = bf1(*(LAS const bf16*)(Kr + t * 272 + dk * 2));
            const float e1 = __expf(bb[tt]);
            *(LAS bf16*)(Kh + t * 272 + dk * 2) = f2bf(kv * __expf(btot - bb[tt]));
            *(LAS bf16*)(Qr + t * 272 + dk * 2) = f2bf(qv * e1 * 0.08838834764831845f); *(LAS bf16*)(Kr + t * 272 + dk * 2) = f2bf(kv * __builtin_amdgcn_rcpf(e1)); }
        if (grp == 0) s.GAM[cc * 128 + dk] = __expf(btot);
        __syncthreads();
        store_tile(QT + ((size_t)dir * MR + rowbase) * 512 + head * 128, 512, Qr, 272, 64, 128, tid);
        store_tile(KT + ((size_t)dir * MR + rowbase) * 512 + head * 128, 512, Kr, 272, 64, 128, tid);
        f32x16 acc[4];
#pragma unroll
        for (int nt = 0; nt < 4; ++nt) acc[nt] = zero16();
#pragma unroll
        for (int ks = 0; ks < 4; ++ks) { const bf16x8 af = frag_tr(Vs, 528, 16 * ks, 32 * wave, lane);
#pragma unroll
            for (int nt = 0; nt < 4; ++nt) { const bf16x8 bfr = frag_tr(Kh, 272, 16 * ks, 32 * nt, lane); acc[nt] = MFMA32(af, bfr, acc[nt]); } }
        bf16* D = s.DSTp + cc * 32768;
#pragma unroll
        for (int nt = 0; nt < 4; ++nt)
#pragma unroll
            for (int r = 0; r < 16; ++r) { const int dv = 32 * wave + (r & 3) + 8 * (r >> 2) + 4 * (lane >> 5); D[dv * 128 + 32 * nt + (lane & 31)] = f2bf(acc[nt][r]); }
        __syncthreads();
    }
}
#undef GL_PREF
__device__ __forceinline__ void ph_gla_out(const ScanP& s, const bf16* QT, const bf16* KT, LAS unsigned char* lds, int tid, int lane, int wave, int bid, int G) {
    LAS unsigned char* Vs = lds;
    LAS unsigned char* Qx = lds + 33792;
    LAS unsigned char* Ki = lds + 68608;
    LAS unsigned char* Am = lds + 103424;
    LAS float* Os = (LAS float*)lds;
    v4u pv[4], pq[2][2], pk[2][2];
#define GO_PREF(u_) do { int b_, head_, mm_, rb_; scan_unit((u_), b_, head_, mm_, rb_); \
        _Pragma("unroll") for (int i = 0; i < 4; ++i) { const int c_ = tid + NTHR * i; pv[i] = *(const v4u*)(s.P + (size_t)(rb_ + (c_ >> 5)) * NINP + 1024 + head_ * 256 + (c_ & 31) * 8); } \
        _Pragma("unroll") for (int d_ = 0; d_ < 2; ++d_) _Pragma("unroll") for (int i = 0; i < 2; ++i) { const int c_ = tid + NTHR * i; const size_t o_ = ((size_t)d_ * MR + rb_ + (c_ >> 4)) * 512 + head_ * 128 + (c_ & 15) * 8; \
            pq[d_][i] = *(const v4u*)(QT + o_); pk[d_][i] = *(const v4u*)(KT + o_); } } while (0)
    if (bid < 544) GO_PREF(bid);
    for (int u = bid; u < 544; u += G) {
        int b, head, mm, rowbase; scan_unit(u, b, head, mm, rowbase);
#pragma unroll
        for (int i = 0; i < 4; ++i) { const int c_ = tid + NTHR * i; *(LAS v4u*)(Vs + (c_ >> 5) * 528 + (c_ & 31) * 16) = pv[i]; }
#pragma unroll
        for (int d_ = 0; d_ < 2; ++d_)
#pragma unroll
            for (int i = 0; i < 2; ++i) { const int c_ = tid + NTHR * i; *(LAS v4u*)(Qx + d_ * 17408 + (c_ >> 4) * 272 + (c_ & 15) * 16) = pq[d_][i]; *(LAS v4u*)(Ki + d_ * 17408 + (c_ >> 4) * 272 + (c_ & 15) * 16) = pk[d_][i]; }
        v4u gp[4];
#pragma unroll
        for (int j = 0; j < 4; ++j) gp[j] = *(const v4u*)(s.P + (size_t)(rowbase + (tid >> 3)) * NINP + 2048 + head * 256 + 32 * (tid & 7) + 8 * j);
        bf16x8 sf[2][8];
#pragma unroll
        for (int dir = 0; dir < 2; ++dir) { const int chain = (b * 4 + head) * 2 + dir, c = scan_chunk(mm, dir); const size_t cc = (size_t)chain * NCHUNK + c;
            const bf16* Sg = s.SSTp + cc * 32768 + (size_t)(32 * wave + (lane & 31)) * 128 + 8 * (lane >> 5);
#pragma unroll
            for (int ks = 0; ks < 8; ++ks) sf[dir][ks] = *(const bf16x8*)(Sg + 16 * ks); }
        __syncthreads();
        if (u + G < 544) GO_PREF(u + G);
        {
            const int dir = wave >> 2, ti = (wave >> 1) & 1, tj = wave & 1; f32x16 acc = zero16();
#pragma unroll
            for (int ks = 0; ks < 8; ++ks) { const bf16x8 af = frag_row(Qx + dir * 17408, 272, 32 * ti, 16 * ks, lane), bfr = frag_row(Ki + dir * 17408, 272, 32 * tj, 16 * ks, lane); acc = MFMA32(af, bfr, acc); }
            const int sidx = 32 * tj + (lane & 31);
#pragma unroll
            for (int r = 0; r < 16; ++r) { const int t = 32 * ti + (r & 3) + 8 * (r >> 2) + 4 * (lane >> 5);
                const bool keep = dir == 0 ? (sidx <= t) : (sidx >= t);
                *(LAS bf16*)(Am + dir * 9216 + t * 144 + sidx * 2) = f2bf(keep ? acc[r] : 0.f); }
        }
        __syncthreads();
        f32x16 acc2[2]; acc2[0] = zero16(); acc2[1] = zero16();
#pragma unroll
        for (int dir = 0; dir < 2; ++dir) {
#pragma unroll
            for (int ks = 0; ks < 8; ++ks)
#pragma unroll
                for (int rt = 0; rt < 2; ++rt) { const bf16x8 af = frag_row(Qx + dir * 17408, 272, 32 * rt, 16 * ks, lane); acc2[rt] = MFMA32(af, sf[dir][ks], acc2[rt]); }
#pragma unroll
            for (int ks = 0; ks < 4; ++ks) { const bf16x8 bfr = frag_tr(Vs, 528, 16 * ks, 32 * wave, lane);
#pragma unroll
                for (int rt = 0; rt < 2; ++rt) { const bf16x8 af = frag_row(Am + dir * 9216, 144, 32 * rt, 16 * ks, lane); acc2[rt] = MFMA32(af, bfr, acc2[rt]); } }
        }
        __syncthreads();
#pragma unroll
        for (int rt = 0; rt < 2; ++rt)
#pragma unroll
            for (int r = 0; r < 16; ++r) { const int t = 32 * rt + (r & 3) + 8 * (r >> 2) + 4 * (lane >> 5); Os[t * 260 + 32 * wave + (lane & 31)] = acc2[rt][r]; }
        __syncthreads();
        { const int t = tid >> 3, part = tid & 7; float o[32]; float ss = 0.f;
#pragma unroll
          for (int j = 0; j < 8; ++j) { const f32x4 v = *(LAS const f32x4*)(Os + t * 260 + 32 * part + 4 * j); o[4 * j] = v.x; o[4 * j + 1] = v.y; o[4 * j + 2] = v.z; o[4 * j + 3] = v.w; ss += (v.x * v.x + v.y * v.y) + (v.z * v.z + v.w * v.w); }
          ss += __shfl_xor(ss, 1); ss += __shfl_xor(ss, 2); ss += __shfl_xor(ss, 4);
          const float rn = __builtin_amdgcn_rsqf(ss * (1.f / 256.f) + EPS);
          const size_t row = (size_t)(rowbase + t);
          bf16* dst = s.MIX + row * DM + head * 256 + 32 * part;
#pragma unroll
          for (int j = 0; j < 4; ++j) { float gv[8], ov[8]; unpack8(gp[j], gv);
#pragma unroll
              for (int e = 0; e < 8; ++e) ov[e] = o[8 * j + e] * rn * s.ng[32 * part + 8 * j + e] * silu_f(gv[e]);
              *(v4u*)(dst + 8 * j) = pack8(ov); } }
        __syncthreads();
    }
}

#undef GO_PREF
__device__ __forceinline__ void ph_mlstm_out(const ScanP& s, LAS unsigned char* lds, int tid, int lane, int wave, int bid, int G, int skip_ctx, unsigned* qhead) {
    LAS unsigned char* Vs = lds; LAS unsigned char* Qi = lds + 33792; LAS unsigned char* Ki = lds + 51200; LAS unsigned char* Qx = lds + 68608; LAS unsigned char* Am = lds + 103424;
    LAS float* sc = (LAS float*)(lds + 121856);
    LAS float* qnp = (LAS float*)(lds + 125952);
    LAS float* Os = (LAS float*)lds;
    v4u pv[4], pq[2], pk[2];
#define MO_UNIT(u_) (skip_ctx ? ((u_) >> 6) * 68 + 4 + ((u_) & 63) : (u_))
#define MO_PREF(u_) do { int b_, head_, mm_, rb_; scan_unit(MO_UNIT(u_), b_, head_, mm_, rb_); \
        _Pragma("unroll") for (int i = 0; i < 4; ++i) { const int c_ = tid + NTHR * i; pv[i] = *(const v4u*)(s.P + (size_t)(rb_ + (c_ >> 5)) * NINP + 4096 + head_ * 256 + (c_ & 31) * 8); } \
        _Pragma("unroll") for (int i = 0; i < 2; ++i) { const int c_ = tid + NTHR * i; const size_t o_ = (size_t)(rb_ + (c_ >> 4)) * 1024 + head_ * 128 + (c_ & 15) * 8; pq[i] = *(const v4u*)(s.MQK + o_); pk[i] = *(const v4u*)(s.MQK + o_ + 512); } } while (0)
    const int nu = skip_ctx ? 512 : 544;
    volatile LAS int* qs = (volatile LAS int*)(lds + MISC_OFF + 104);
    if (tid == 0) qs[0] = (int)__hip_atomic_fetch_add(qhead, 1u, __ATOMIC_RELAXED, __HIP_MEMORY_SCOPE_AGENT);
    __syncthreads();
    int u = qs[0], par = 0;
    if (u < nu) MO_PREF(u);
    for (; u < nu; par ^= 1) {
        if (tid == 0) qs[par ^ 1] = (int)__hip_atomic_fetch_add(qhead, 1u, __ATOMIC_RELAXED, __HIP_MEMORY_SCOPE_AGENT);
        int b, head, mm, rowbase; scan_unit(MO_UNIT(u), b, head, mm, rowbase);
#pragma unroll
        for (int i = 0; i < 4; ++i) { const int c_ = tid + NTHR * i; *(LAS v4u*)(Vs + (c_ >> 5) * 528 + (c_ & 31) * 16) = pv[i]; }
#pragma unroll
        for (int i = 0; i < 2; ++i) { const int c_ = tid + NTHR * i; *(LAS v4u*)(Qi + (c_ >> 4) * 272 + (c_ & 15) * 16) = pq[i]; *(LAS v4u*)(Ki + (c_ >> 4) * 272 + (c_ & 15) * 16) = pk[i]; }
        size_t ccd[2];
#pragma unroll
        for (int dir = 0; dir < 2; ++dir) ccd[dir] = (size_t)((b * 4 + head) * 2 + dir) * NCHUNK + scan_chunk(mm, dir);
        v4u gp[4];
#pragma unroll
        for (int j = 0; j < 4; ++j) gp[j] = *(const v4u*)(s.P + (size_t)(rowbase + (tid >> 3)) * NINP + 5120 + head * 256 + 32 * (tid & 7) + 8 * j);
        bf16x8 sf[2][8];
#pragma unroll
        for (int dir = 0; dir < 2; ++dir) { const bf16* Sg = s.SSTp + ccd[dir] * 32768 + (size_t)(32 * wave + (lane & 31)) * 128 + 8 * (lane >> 5);
#pragma unroll
            for (int ks = 0; ks < 8; ++ks) sf[dir][ks] = *(const bf16x8*)(Sg + 16 * ks); }
        if (wave < 2) { const int dir = wave; LAS float* d = sc + dir * 512;
            const float ig = bf1(s.P[(size_t)(rowbase + lane) * NINP + 6144 + dir * 8 + head]) + s.mgb[dir * 8 + head];
            const float fg = bf1(s.P[(size_t)(rowbase + lane) * NINP + 6144 + dir * 8 + 4 + head]) + s.mgb[dir * 8 + 4 + head];
            const float lf = logsig_f(fg), bcs = wave_scan_sum(lf, dir, lane);
            const float uu = ig - bcs, pm = wave_scan_max(uu, dir, lane), min_ = s.MINp[ccd[dir]], Mt = fmaxf(min_, pm);
            d[lane] = uu; d[64 + lane] = Mt; d[128 + lane] = __expf(min_ - Mt); d[192 + lane] = __expf(-bcs - Mt); }
        __syncthreads();
        const int un = qs[par ^ 1];
        if (un < nu) MO_PREF(un);
        { const int t = tid & 63, part = tid >> 6;
          float a0 = 0.f, a1 = 0.f; const float w0 = sc[128 + t], w1 = sc[512 + 128 + t];
#pragma unroll
          for (int hh = 0; hh < 2; ++hh) { float qv[8], o0[8], o1[8]; unpack8(*(LAS const v4u*)(Qi + t * 272 + (part * 16 + 8 * hh) * 2), qv);
              const float* n0p = s.NIN + ccd[0] * 128 + part * 16 + 8 * hh; const float* n1p = s.NIN + ccd[1] * 128 + part * 16 + 8 * hh;
              const f32x4 n00 = *(const f32x4*)n0p, n01 = *(const f32x4*)(n0p + 4), n10 = *(const f32x4*)n1p, n11 = *(const f32x4*)(n1p + 4);
              a0 += (qv[0] * n00.x + qv[1] * n00.y) + (qv[2] * n00.z + qv[3] * n00.w) + (qv[4] * n01.x + qv[5] * n01.y) + (qv[6] * n01.z + qv[7] * n01.w);
              a1 += (qv[0] * n10.x + qv[1] * n10.y) + (qv[2] * n10.z + qv[3] * n10.w) + (qv[4] * n11.x + qv[5] * n11.y) + (qv[6] * n11.z + qv[7] * n11.w);
#pragma unroll
              for (int e = 0; e < 8; ++e) { o0[e] = qv[e] * w0; o1[e] = qv[e] * w1; }
              *(LAS v4u*)(Qx + t * 272 + (part * 16 + 8 * hh) * 2) = pack8(o0); *(LAS v4u*)(Qx + 17408 + t * 272 + (part * 16 + 8 * hh) * 2) = pack8(o1); }
          qnp[part * 64 + t] = a0; qnp[512 + part * 64 + t] = a1; }
        {
            const int dir = wave >> 2, ti = (wave >> 1) & 1, tj = wave & 1; LAS const float* d = sc + dir * 512; f32x16 acc = zero16();
#pragma unroll
            for (int ks = 0; ks < 8; ++ks) { const bf16x8 af = frag_row(Qi, 272, 32 * ti, 16 * ks, lane), bfr = frag_row(Ki, 272, 32 * tj, 16 * ks, lane); acc = MFMA32(af, bfr, acc); }
            const int sidx = 32 * tj + (lane & 31); const float usv = d[sidx];
#pragma unroll
            for (int r = 0; r < 16; ++r) { const int t = 32 * ti + (r & 3) + 8 * (r >> 2) + 4 * (lane >> 5);
                const bool keep = dir == 0 ? (sidx <= t) : (sidx >= t);
                const float v = keep ? acc[r] * __expf(usv - d[64 + t]) : 0.f;
                *(LAS bf16*)(Am + dir * 9216 + t * 144 + sidx * 2) = f2bf(v);
                float rsum = v; rsum += __shfl_xor(rsum, 1); rsum += __shfl_xor(rsum, 2); rsum += __shfl_xor(rsum, 4); rsum += __shfl_xor(rsum, 8); rsum += __shfl_xor(rsum, 16);
                if ((lane & 31) == 0) (sc + dir * 512)[384 + tj * 64 + t] = rsum; }
        }
        __syncthreads();
        if (tid < 128) { const int dir = tid >> 6, t = tid & 63; LAS float* d = sc + dir * 512; float q = 0.f;
#pragma unroll
            for (int p = 0; p < 8; ++p) q += qnp[dir * 512 + p * 64 + t];
            const float den = d[128 + t] * q + d[384 + t] + d[448 + t]; d[256 + t] = __builtin_amdgcn_rcpf(fmaxf(fabsf(den), d[192 + t])); }
        f32x16 ad[2][2];
#pragma unroll
        for (int dir = 0; dir < 2; ++dir) { ad[dir][0] = zero16(); ad[dir][1] = zero16();
#pragma unroll
            for (int ks = 0; ks < 8; ++ks)
#pragma unroll
                for (int rt = 0; rt < 2; ++rt) { const bf16x8 af = frag_row(Qx + dir * 17408, 272, 32 * rt, 16 * ks, lane); ad[dir][rt] = MFMA32(af, sf[dir][ks], ad[dir][rt]); }
#pragma unroll
            for (int ks = 0; ks < 4; ++ks) { const bf16x8 bfr = frag_tr(Vs, 528, 16 * ks, 32 * wave, lane);
#pragma unroll
                for (int rt = 0; rt < 2; ++rt) { const bf16x8 af = frag_row(Am + dir * 9216, 144, 32 * rt, 16 * ks, lane); ad[dir][rt] = MFMA32(af, bfr, ad[dir][rt]); } } }
        __syncthreads();
#pragma unroll
        for (int rt = 0; rt < 2; ++rt)
#pragma unroll
            for (int r = 0; r < 16; ++r) { const int t = 32 * rt + (r & 3) + 8 * (r >> 2) + 4 * (lane >> 5); ad[0][rt][r] = ad[0][rt][r] * sc[256 + t] + ad[1][rt][r] * sc[512 + 256 + t]; }
        __syncthreads();
#pragma unroll
        for (int rt = 0; rt < 2; ++rt)
#pragma unroll
            for (int r = 0; r < 16; ++r) { const int t = 32 * rt + (r & 3) + 8 * (r >> 2) + 4 * (lane >> 5); Os[t * 260 + 32 * wave + (lane & 31)] = ad[0][rt][r]; }
        __syncthreads();
        { const int t = tid >> 3, part = tid & 7; float o[32]; float ss = 0.f;
#pragma unroll
          for (int j = 0; j < 8; ++j) { const f32x4 v = *(LAS const f32x4*)(Os + t * 260 + 32 * part + 4 * j); o[4 * j] = v.x; o[4 * j + 1] = v.y; o[4 * j + 2] = v.z; o[4 * j + 3] = v.w; ss += (v.x * v.x + v.y * v.y) + (v.z * v.z + v.w * v.w); }
          ss += __shfl_xor(ss, 1); ss += __shfl_xor(ss, 2); ss += __shfl_xor(ss, 4);
          const float rn = __builtin_amdgcn_rsqf(ss * (1.f / 256.f) + EPS);
          const size_t row = (size_t)(rowbase + t);
          bf16* dst = s.MIX + row * DM + 1024 + head * 256 + 32 * part;
#pragma unroll
          for (int j = 0; j < 4; ++j) { float gv[8], ov[8]; unpack8(gp[j], gv);
#pragma unroll
              for (int e = 0; e < 8; ++e) ov[e] = o[8 * j + e] * rn * s.ng[32 * part + 8 * j + e] * sigmoid_f(gv[e]);
              *(v4u*)(dst + 8 * j) = pack8(ov); } }
        __syncthreads();
        u = un;
    }
}

#undef MO_PREF
#undef MO_UNIT
template <int MODE>
__device__ __forceinline__ void ph_scan_carry(const ScanP& s, int gtid, int NT) {
    for (int e = gtid; e < 16 * 8192; e += NT) {
        const int chain = e >> 13, rem = e & 8191, dv = rem >> 5, dk = (rem & 31) * 4;
        f32x4 st = {0.f, 0.f, 0.f, 0.f}, nst = st; float m = 0.f;
        for (int c0 = 0; c0 < NCHUNK; c0 += 4) {
            f32x4 d[4], gm[4]; float bl[4], ml[4];
#pragma unroll
            for (int j = 0; j < 4; ++j) { const size_t cc = (size_t)chain * NCHUNK + c0 + j; { const v2u dw = *(const v2u*)(s.DSTp + cc * 32768 + dv * 128 + dk); d[j] = (f32x4){bf_lo(dw.x), bf_hi(dw.x), bf_lo(dw.y), bf_hi(dw.y)}; }
                if (MODE == 0) gm[j] = *(const f32x4*)(s.GAM + cc * 128 + dk);
                else { bl[j] = s.BL[cc]; ml[j] = s.ML[cc]; gm[j] = (dv == 0) ? *(const f32x4*)(s.DN + cc * 128 + dk) : (f32x4){0.f, 0.f, 0.f, 0.f}; } }
#pragma unroll
            for (int j = 0; j < 4; ++j) { const size_t cc = (size_t)chain * NCHUNK + c0 + j;
                v2u o; o.x = pk2(st.x, st.y); o.y = pk2(st.z, st.w); *(v2u*)(s.SSTp + cc * 32768 + dv * 128 + dk) = o;
                if (MODE == 0) st = gm[j] * st + d[j];
                else { if (dv == 0) { *(f32x4*)(s.NIN + cc * 128 + dk) = nst; if (dk == 0) s.MINp[cc] = m; }
                    const float mn = fmaxf(bl[j] + m, ml[j]), dec = __expf(bl[j] + m - mn), sc = __expf(ml[j] - mn);
                    st = st * dec + d[j] * sc; nst = nst * dec + gm[j] * sc; m = mn; } }
        }
    }
}

template <int MODE>
__device__ __forceinline__ void ph_scan_out(const ScanP& s, LAS unsigned char* lds, int tid, int lane, int wave, int bid, int G) {
    LAS unsigned char* Vs = lds; LAS unsigned char* Qx = lds + 33792; LAS unsigned char* Ki = lds + 51200; LAS unsigned char* Qi = lds + 68608; LAS unsigned char* Am = lds + 86016;
    LAS float* glr = (LAS float*)(lds + 95232); LAS float* tot = (LAS float*)(lds + 103424);
    LAS float* us = (LAS float*)(lds + 105472); LAS float* Mts = us + 64; LAS float* wint = us + 128; LAS float* thr = us + 192; LAS float* fac = us + 256; LAS float* qn = us + 320; LAS float* rs = us + 384;
    LAS float* qnp = (LAS float*)(lds + 107520);
    LAS float* Os = (LAS float*)lds;
    const int dk = tid & 127, grp = tid >> 7;
    for (int u = bid; u < 544; u += G) {
        int b, head, mm, rowbase; scan_unit(u, b, head, mm, rowbase);
        load_tile(Vs, 528, s.P + (size_t)rowbase * NINP + (MODE ? 4096 : 1024) + head * 256, NINP, 64, 256, tid);
        if (MODE == 0) { for (int e = tid; e < 2048; e += NTHR) glr[e] = bf1(s.P[(size_t)(rowbase + (e >> 5)) * NINP + 3072 + (e & 31)]); if (tid < 64) fac[tid] = 1.f; }
        else { load_tile(Qi, 272, s.MQK + (size_t)rowbase * 1024 + head * 128, 1024, 64, 128, tid); load_tile(Ki, 272, s.MQK + (size_t)rowbase * 1024 + 512 + head * 128, 1024, 64, 128, tid); }
        f32x16 hsum[2]; hsum[0] = zero16(); hsum[1] = zero16();
        __syncthreads();
        for (int dir = 0; dir < 2; ++dir) {
            const int chain = (b * 4 + head) * 2 + dir, c = scan_chunk(mm, dir); const size_t cc = (size_t)chain * NCHUNK + c;
            if (MODE == 0) {
                float bb[16], btot; gla_gates(s, glr, tot, head, dir, tid, bb, btot);
#pragma unroll
                for (int tt = 0; tt < 16; ++tt) { const int t = 16 * grp + tt; const size_t ro = (size_t)(rowbase + t) * NINP + head * 128 + dk;
                    const float qv = bf1(s.P[ro]), kv = bf1(s.P[ro + 512]);
                    *(LAS bf16*)(Qx + t * 272 + dk * 2) = f2bf(qv * __expf(bb[tt]) * 0.08838834764831845f);
                    *(LAS bf16*)(Ki + t * 272 + dk * 2) = f2bf(kv * __expf(-bb[tt])); }
            } else {
                if (wave == 0) {
                    const float ig = bf1(s.P[(size_t)(rowbase + lane) * NINP + 6144 + dir * 8 + head]) + s.mgb[dir * 8 + head];
                    const float fg = bf1(s.P[(size_t)(rowbase + lane) * NINP + 6144 + dir * 8 + 4 + head]) + s.mgb[dir * 8 + 4 + head];
                    const float lf = logsig_f(fg), bcs = wave_scan_sum(lf, dir, lane);
                    const float uu = ig - bcs, pm = wave_scan_max(uu, dir, lane), min_ = s.MINp[cc], Mt = fmaxf(min_, pm);
                    us[lane] = uu; Mts[lane] = Mt; wint[lane] = __expf(min_ - Mt); thr[lane] = __expf(-bcs - Mt);
                }
                __syncthreads();
                { const int t = tid & 63, part = tid >> 6; float acc = 0.f;
                  const float wi = wint[t];
#pragma unroll
                  for (int hh = 0; hh < 2; ++hh) { float qv[8], ov[8]; unpack8(*(LAS const v4u*)(Qi + t * 272 + (part * 16 + 8 * hh) * 2), qv);
                      const f32x4 n0 = *(const f32x4*)(s.NIN + cc * 128 + part * 16 + 8 * hh), n1 = *(const f32x4*)(s.NIN + cc * 128 + part * 16 + 8 * hh + 4);
                      acc += (qv[0] * n0.x + qv[1] * n0.y) + (qv[2] * n0.z + qv[3] * n0.w) + (qv[4] * n1.x + qv[5] * n1.y) + (qv[6] * n1.z + qv[7] * n1.w);
#pragma unroll
                      for (int e = 0; e < 8; ++e) ov[e] = qv[e] * wi;
                      *(LAS v4u*)(Qx + t * 272 + (part * 16 + 8 * hh) * 2) = pack8(ov); }
                  qnp[part * 64 + t] = acc; }
            }
            __syncthreads();
            if (MODE == 1 && tid < 64) { float q = 0.f;
#pragma unroll
                for (int p = 0; p < 8; ++p) q += qnp[p * 64 + tid];
                qn[tid] = q; }
            if (wave < 4) {
                const int ti = wave >> 1, tj = wave & 1; f32x16 acc = zero16();
#pragma unroll
                for (int ks = 0; ks < 8; ++ks) { const bf16x8 af = frag_row(MODE ? Qi : Qx, 272, 32 * ti, 16 * ks, lane), bfr = frag_row(Ki, 272, 32 * tj, 16 * ks, lane); acc = MFMA32(af, bfr, acc); }
                const int sidx = 32 * tj + (lane & 31);
                const float usv = MODE ? us[sidx] : 0.f;
#pragma unroll
                for (int r = 0; r < 16; ++r) { const int t = 32 * ti + (r & 3) + 8 * (r >> 2) + 4 * (lane >> 5);
                    const bool keep = dir == 0 ? (sidx <= t) : (sidx >= t);
                    float v = acc[r];
                    if (MODE == 1) v *= __expf(usv - Mts[t]);
                    v = keep ? v : 0.f;
                    *(LAS bf16*)(Am + t * 144 + sidx * 2) = f2bf(v);
                    if (MODE == 1) { float rsum = v; rsum += __shfl_xor(rsum, 1); rsum += __shfl_xor(rsum, 2); rsum += __shfl_xor(rsum, 4); rsum += __shfl_xor(rsum, 8); rsum += __shfl_xor(rsum, 16);
                        if ((lane & 31) == 0) rs[tj * 64 + t] = rsum; } }
            }
            __syncthreads();
            if (MODE == 1 && tid < 64) { const float den = wint[tid] * qn[tid] + rs[tid] + rs[64 + tid]; fac[tid] = __builtin_amdgcn_rcpf(fmaxf(fabsf(den), thr[tid])); }
            f32x16 acc2[2]; acc2[0] = zero16(); acc2[1] = zero16();
            { const bf16* Sg = s.SSTp + cc * 32768 + (size_t)(32 * wave + (lane & 31)) * 128 + 8 * (lane >> 5);
#pragma unroll
              for (int ks = 0; ks < 8; ++ks) { const bf16x8 bfr = *(const bf16x8*)(Sg + 16 * ks);
#pragma unroll
                  for (int rt = 0; rt < 2; ++rt) { const bf16x8 af = frag_row(Qx, 272, 32 * rt, 16 * ks, lane); acc2[rt] = MFMA32(af, bfr, acc2[rt]); } } }
#pragma unroll
            for (int ks = 0; ks < 4; ++ks) { const bf16x8 bfr = frag_tr(Vs, 528, 16 * ks, 32 * wave, lane);
#pragma unroll
                for (int rt = 0; rt < 2; ++rt) { const bf16x8 af = frag_row(Am, 144, 32 * rt, 16 * ks, lane); acc2[rt] = MFMA32(af, bfr, acc2[rt]); } }
            __syncthreads();
#pragma unroll
            for (int rt = 0; rt < 2; ++rt)
#pragma unroll
                for (int r = 0; r < 16; ++r) { const int t = 32 * rt + (r & 3) + 8 * (r >> 2) + 4 * (lane >> 5); hsum[rt][r] += acc2[rt][r] * fac[t]; }
        }
        __syncthreads();
#pragma unroll
        for (int rt = 0; rt < 2; ++rt)
#pragma unroll
            for (int r = 0; r < 16; ++r) { const int t = 32 * rt + (r & 3) + 8 * (r >> 2) + 4 * (lane >> 5); Os[t * 260 + 32 * wave + (lane & 31)] = hsum[rt][r]; }
        __syncthreads();
        { const int t = tid >> 3, part = tid & 7; float o[32]; float ss = 0.f;
#pragma unroll
          for (int j = 0; j < 8; ++j) { const f32x4 v = *(LAS const f32x4*)(Os + t * 260 + 32 * part + 4 * j); o[4 * j] = v.x; o[4 * j + 1] = v.y; o[4 * j + 2] = v.z; o[4 * j + 3] = v.w; ss += (v.x * v.x + v.y * v.y) + (v.z * v.z + v.w * v.w); }
          ss += __shfl_xor(ss, 1); ss += __shfl_xor(ss, 2); ss += __shfl_xor(ss, 4);
          const float rn = __builtin_amdgcn_rsqf(ss * (1.f / 256.f) + EPS);
          const size_t row = (size_t)(rowbase + t);
          const bf16* gsrc = s.P + row * NINP + (MODE ? 5120 : 2048) + head * 256 + 32 * part;
          bf16* dst = s.MIX + row * DM + (MODE ? 1024 : 0) + head * 256 + 32 * part;
#pragma unroll
          for (int j = 0; j < 4; ++j) { float gv[8], ov[8]; unpack8(*(const v4u*)(gsrc + 8 * j), gv);
#pragma unroll
              for (int e = 0; e < 8; ++e) { const float gt = MODE ? sigmoid_f(gv[e]) : silu_f(gv[e]); ov[e] = o[8 * j + e] * rn * s.ng[32 * part + 8 * j + e] * gt; }
              *(v4u*)(dst + 8 * j) = pack8(ov); } }
        __syncthreads();
    }
}

__device__ __forceinline__ void glds16(const void* sbase  , unsigned voff  , unsigned lds_dst  ) { unsigned keep;
    asm volatile("s_mov_b32 %0, m0\n\ts_mov_b32 m0, %3\n\ts_nop 0\n\tglobal_load_lds_dwordx4 %1, %2\n\ts_mov_b32 m0, %0" : "=&s"(keep) : "v"(voff), "s"(sbase), "s"(lds_dst) : "memory"); }
struct AttnP { const bf16* QR; const bf16* KR; const bf16* P; bf16* MIX; const float* lamp; const float* subg; const float* qg; const float* kg; float lam_init; unsigned* queue; int nq; };
template <bool SUB>
__device__ __forceinline__ void ph_attn(const AttnP& p, LAS unsigned char* lds, int tid, int lane, int wave, int bid, int G) {
    const float l01 = wave_sum(p.lamp[lane] * p.lamp[64 + lane]), l23 = wave_sum(p.lamp[128 + lane] * p.lamp[192 + lane]);
    const float lam = __expf(l01) - __expf(l23) + p.lam_init;
    const float negm2 = -8.f * wave_max(fabsf(p.qg[lane])) * wave_max(fabsf(p.kg[lane])) * 1.4426950408889634f * 1.02f;
    const int r = lane & 31, h = lane >> 5, mp = wave >> 2, wq = wave & 3;
    LAS float* Ex = (LAS float*)lds;
    const unsigned xcc = xb_xcc_id() & 7u;
    volatile LAS int* qslot = (volatile LAS int*)(lds + MISC_OFF + 96);
    for (int qq = 0; qq < 8; ++qq) for (;;) {
        const int hd = (int)((xcc + (unsigned)qq) & 7u);
        if (tid == 0) qslot[0] = (int)__hip_atomic_fetch_add(p.queue + 16 * hd, 1u, __ATOMIC_RELAXED, __HIP_MEMORY_SCOPE_AGENT);
        __syncthreads();
        const int idx = qslot[0];
        __syncthreads();
        if (idx >= p.nq) break;
        int b, qrow0, nkt;
        if (idx < 64) { b = idx >> 5; qrow0 = b * 4096 + 128 * (idx & 31); nkt = 68; }
        else { const int uu = idx - 64; b = uu >> 1; qrow0 = NLATR + b * 256 + 128 * (uu & 1); nkt = 4; }
        const int qrow = qrow0 + 32 * wq + r;
        bf16x8 Qf[4];
#pragma unroll
        for (int ks = 0; ks < 4; ++ks) Qf[ks] = *(const bf16x8*)(p.QR + (size_t)qrow * 1024 + (hd * 2 + mp) * 64 + 16 * ks + 8 * h);
        f32x16 O[4];
#pragma unroll
        for (int dt = 0; dt < 4; ++dt) O[dt] = zero16();
        float ls = 0.f;
        const int dq = lane >> 4, dp = lane & 15;
        unsigned voffK[4], voffV[4];
#pragma unroll
        for (int j = 0; j < 4; ++j) { const unsigned ch = 16u * (unsigned)(dp ^ ((dq << 2) | j)); voffK[j] = (unsigned)dq * 2048u + ch; voffV[j] = (unsigned)dq * (unsigned)(NINP * 2) + ch; }
        int kaddr[4], vaddr[2][4];
#pragma unroll
        for (int ks = 0; ks < 4; ++ks) kaddr[ks] = swz_off(r, 8 * mp + 2 * ks + h);
        { const int blk = (lane >> 4) & 1, q = (lane & 15) >> 2, pp = lane & 3;
#pragma unroll
          for (int e = 0; e < 2; ++e)
#pragma unroll
              for (int dt = 0; dt < 4; ++dt) vaddr[e][dt] = swz_off(4 * h + q + 8 * e, 4 * dt + 2 * blk + (pp >> 1)) + 8 * (pp & 1); }
        const int nkt2 = nkt >> 1;
        const unsigned ldsb = (unsigned)(size_t)lds;
#define AT_DMA(kt_, buf_) do { const int krow_ = (kt_) < 2 ? NLATR + b * 256 + 128 * (kt_) : b * 4096 + 128 * ((kt_) - 2); \
            _Pragma("unroll") for (int j = 0; j < 4; ++j) { const int g_ = 4 * wave + j, row_ = krow_ + 4 * g_; \
                glds16(p.KR + (size_t)row_ * 1024 + hd * 128, voffK[j], (unsigned)__builtin_amdgcn_readfirstlane((int)(ldsb + (buf_) * 32768 + 1024 * g_))); \
                glds16(p.P + (size_t)row_ * NINP + 2048 + hd * 128, voffV[j], (unsigned)__builtin_amdgcn_readfirstlane((int)(ldsb + 65536 + (buf_) * 32768 + 1024 * g_))); } } while (0)
#define AT_QK(S_, kb_) do { S_ = zero16(); _Pragma("unroll") for (int ks = 0; ks < 4; ++ks) { const bf16x8 a0 = *(LAS const bf16x8*)(Kt + kaddr[ks] + 8192 * (kb_)); S_ = MFMA32(a0, Qf[ks], S_); } } while (0)
        AT_DMA(0, 0);
        asm volatile("s_waitcnt vmcnt(0)" ::: "memory");
        __syncthreads();
        for (int kt = 0; kt < nkt2; ++kt) {
            const bool more = kt + 1 < nkt2;
            if (more) AT_DMA(kt + 1, (kt + 1) & 1);
            LAS const unsigned char* Kt = lds + (kt & 1) * 32768; LAS const unsigned char* Vt = lds + 65536 + (kt & 1) * 32768;
#define AT_VF(dst_, kb_, dt_) do { const s16x4 t0_ = tr4(Vt + vaddr[0][dt_] + 8192 * (kb_)), t1_ = tr4(Vt + vaddr[1][dt_] + 8192 * (kb_)), t2_ = tr4(Vt + vaddr[0][dt_] + 8192 * (kb_) + 4096), t3_ = tr4(Vt + vaddr[1][dt_] + 8192 * (kb_) + 4096); \
                dst_[0] = (bf16x8){t0_[0], t0_[1], t0_[2], t0_[3], t1_[0], t1_[1], t1_[2], t1_[3]}; dst_[1] = (bf16x8){t2_[0], t2_[1], t2_[2], t2_[3], t3_[0], t3_[1], t3_[2], t3_[3]}; } while (0)
            bf16x8 kf[4], P0, P1;
#pragma unroll
            for (int ks = 0; ks < 4; ++ks) kf[ks] = *(LAS const bf16x8*)(Kt + kaddr[ks]);
            { f32x16 S0 = zero16();
#pragma unroll
              for (int ks = 0; ks < 4; ++ks) S0 = MFMA32(kf[ks], Qf[ks], S0);
#pragma unroll
              for (int ks = 0; ks < 4; ++ks) kf[ks] = *(LAS const bf16x8*)(Kt + kaddr[ks] + 8192);
              unsigned pf[8]; float lacc = 0.f;
#pragma unroll
              for (int i = 0; i < 8; ++i) { const float e0 = __builtin_amdgcn_exp2f(SUB ? S0[2 * i] + negm2 : S0[2 * i]), e1 = __builtin_amdgcn_exp2f(SUB ? S0[2 * i + 1] + negm2 : S0[2 * i + 1]); lacc += e0 + e1; pf[i] = pk2(e0, e1); }
              ls += lacc;
              P0 = __builtin_bit_cast(bf16x8, (v4u){pf[0], pf[1], pf[2], pf[3]}); P1 = __builtin_bit_cast(bf16x8, (v4u){pf[4], pf[5], pf[6], pf[7]}); }
            __builtin_amdgcn_sched_barrier(0);
#pragma unroll
            for (int kb = 0; kb < 4; ++kb) {
                bf16x8 v0[2], v1[2], v2[2], v3[2];
                AT_VF(v0, kb, 0); AT_VF(v1, kb, 1); AT_VF(v2, kb, 2); AT_VF(v3, kb, 3);
                f32x16 Sn = zero16();
                if (kb < 3) {
#pragma unroll
                    for (int ks = 0; ks < 4; ++ks) Sn = MFMA32(kf[ks], Qf[ks], Sn);
                    if (kb < 2) {
#pragma unroll
                        for (int ks = 0; ks < 4; ++ks) kf[ks] = *(LAS const bf16x8*)(Kt + kaddr[ks] + 8192 * (kb + 2)); } }
                O[0] = MFMA32(v0[0], P0, O[0]); O[0] = MFMA32(v0[1], P1, O[0]); O[1] = MFMA32(v1[0], P0, O[1]); O[1] = MFMA32(v1[1], P1, O[1]);
                O[2] = MFMA32(v2[0], P0, O[2]); O[2] = MFMA32(v2[1], P1, O[2]); O[3] = MFMA32(v3[0], P0, O[3]); O[3] = MFMA32(v3[1], P1, O[3]);
                if (kb < 3) {
                    unsigned pf[8]; float lacc = 0.f;
#pragma unroll
                    for (int i = 0; i < 8; ++i) { const float e0 = __builtin_amdgcn_exp2f(SUB ? Sn[2 * i] + negm2 : Sn[2 * i]), e1 = __builtin_amdgcn_exp2f(SUB ? Sn[2 * i + 1] + negm2 : Sn[2 * i + 1]); lacc += e0 + e1; pf[i] = pk2(e0, e1); }
                    ls += lacc;
                    P0 = __builtin_bit_cast(bf16x8, (v4u){pf[0], pf[1], pf[2], pf[3]}); P1 = __builtin_bit_cast(bf16x8, (v4u){pf[4], pf[5], pf[6], pf[7]});
                    __builtin_amdgcn_sched_group_barrier(0x100, 20, 0); __builtin_amdgcn_sched_group_barrier(0x008, 6, 0);
#pragma unroll
                    for (int gI = 0; gI < 6; ++gI) { __builtin_amdgcn_sched_group_barrier(0x002, 8, 0); __builtin_amdgcn_sched_group_barrier(0x008, 1, 0); }
                }
                __builtin_amdgcn_sched_barrier(0);
            }
#undef AT_VF
            asm volatile("s_waitcnt vmcnt(0)" ::: "memory");
            __syncthreads();
        }
#undef AT_DMA
#undef AT_QK
        const float l = ls + __shfl_xor(ls, 32);
        if (mp == 1) { const float sc = lam * __builtin_amdgcn_rcpf(l);
#pragma unroll
            for (int dt = 0; dt < 4; ++dt)
#pragma unroll
                for (int i = 0; i < 16; ++i) Ex[(32 * wq + r) * 132 + 32 * dt + (i & 3) + 8 * (i >> 2) + 4 * h] = O[dt][i] * sc; }
        __syncthreads();
        if (mp == 0) { const float a0 = __builtin_amdgcn_rcpf(l); float ss = 0.f;
#pragma unroll
            for (int dt = 0; dt < 4; ++dt)
#pragma unroll
                for (int i = 0; i < 16; ++i) { const float v = O[dt][i] * a0 - Ex[(32 * wq + r) * 132 + 32 * dt + (i & 3) + 8 * (i >> 2) + 4 * h]; O[dt][i] = v; ss += v * v; }
            ss += __shfl_xor(ss, 32);
            const float rn = __builtin_amdgcn_rsqf(ss * (1.f / 128.f) + EPS) * (1.f - p.lam_init);
            int qrow2 = qrow0 + 32 * wq + r; asm volatile("" : "+v"(qrow2));
            bf16* dst = p.MIX + (size_t)qrow2 * DM + hd * 128;
#pragma unroll
            for (int dt = 0; dt < 4; ++dt)
#pragma unroll
                for (int g4 = 0; g4 < 4; ++g4) { const int dv0 = 32 * dt + 8 * g4 + 4 * h; const f32x4 sg = *(const f32x4*)(p.subg + dv0);
                    v2u o; o.x = pk2(O[dt][4 * g4] * rn * sg.x, O[dt][4 * g4 + 1] * rn * sg.y); o.y = pk2(O[dt][4 * g4 + 2] * rn * sg.z, O[dt][4 * g4 + 3] * rn * sg.w);
                    *(v2u*)(dst + dv0) = o; } }
        __syncthreads();
    }
}

#ifndef PHASE_MASK
#define PHASE_MASK 0xFFFFFFu
#endif
#define PM(j) ((PHASE_MASK >> (j)) & 1u)
#ifndef REP_MASK
#define REP_MASK 0u
#endif
#define REPS(j) ((((REP_MASK) >> (j)) & 1u) ? 2 : 1)
#define PH_BEGIN(j, k) if (PM(j) && IN(k)) for (int rep_ = 0; rep_ < REPS(j); ++rep_) { if (rep_) xcd_barrier(bar);
#define PH_END }
#ifndef CONV_A
#define CONV_A 17744
#define CONV_B 21544
#endif
#define PHASE_BEGIN int wave = wave0, bid = bid0, G = G0, zz_ = 0; asm volatile("" : "+s"(wave), "+s"(bid), "+s"(G), "+s"(zz_)); const int lane = (int)__builtin_amdgcn_mbcnt_hi(~0u, __builtin_amdgcn_mbcnt_lo(~0u, (unsigned)zz_)), tid = wave * 64 + lane; \
    unsigned char* ws = ws0; asm volatile("" : "+s"(ws)); const __attribute__((address_space(4))) Args* ap_ = (const __attribute__((address_space(4))) Args*)__builtin_amdgcn_kernarg_segment_ptr(); asm volatile("" : "+s"(ap_)); const Args& a = *(const Args*)ap_; (void)a; const int gw = bid * NWAVES + wave, NGW = G * NWAVES, gtid = bid * NTHR + tid, NT = G * NTHR; (void)gw; (void)NGW; (void)gtid; (void)NT; (void)lane;
__device__ __forceinline__ void fill_scanp(ScanP& sp, const Args& a, unsigned char* ws, int li, bool even) {
    sp.P = (const bf16*)(ws + WS_P); sp.MQK = (const bf16*)(ws + WS_MQK); sp.MIX = (bf16*)(ws + WS_MIX);
    sp.gw2 = a.in[10] + (size_t)li * 2 * 16 * 512; sp.gb = a.in[11] + (size_t)li * 2 * 512; sp.mgb = a.in[21] + (size_t)li * 16;
    sp.ng = even ? a.in[12] + (size_t)li * 256 : a.in[22] + (size_t)li * 256;
    sp.DSTp = (bf16*)(ws + WS_DST); sp.SSTp = (bf16*)(ws + WS_SST); sp.GAM = (float*)(ws + WS_SM + SM_GAM); sp.DN = (float*)(ws + WS_SM + SM_DN); sp.NIN = (float*)(ws + WS_SM + SM_NIN);
    sp.BL = (float*)(ws + WS_SM + SM_BL); sp.ML = (float*)(ws + WS_SM + SM_ML); sp.MINp = (float*)(ws + WS_SM + SM_MIN);
}
__global__ void __launch_bounds__(NTHR, 2) fwd_kernel(Args a) {
    extern __shared__ __attribute__((aligned(16))) unsigned char lds_raw[];
    LAS unsigned char* lds = (LAS unsigned char*)lds_raw;
    const int tid0 = threadIdx.x, wave0 = __builtin_amdgcn_readfirstlane(tid0 >> 6), bid0 = blockIdx.x, G0 = gridDim.x;
    unsigned char* ws0 = a.ws;
    volatile LAS unsigned* MISC = (volatile LAS unsigned*)(lds + MISC_OFF);
    if (tid0 < 32) MISC[tid0] = 0u;
    __syncthreads();
    XcdBarrier bar = xcd_barrier_post((unsigned*)(ws0 + WS_CTL) + CW_BAR + a.li * XCD_BAR_WORDS, MISC + 8, (unsigned)wave0);
    const int lo = a.ph_lo, hi = a.ph_hi;
#define IN(k) (lo <= (k) && (k) < hi)
#ifndef TMASK
#define TMASK 0u
#endif
#ifndef LMASK
#define LMASK 0xFu
#endif
    volatile LAS unsigned long long* tst_ = (volatile LAS unsigned long long*)(lds + MISC_OFF + 64);
    if (TMASK && tid0 == 0) { tst_[0] = __builtin_amdgcn_s_memrealtime(); tst_[1] = 0ull; }
#define SEAM2(k, kk, ll) do { if (IN(k) && IN((k) + 1)) xcd_barrier(bar); if (TMASK && wave0 == 0 && xb_lane() == 0u) { const unsigned long long now_ = __builtin_amdgcn_s_memrealtime(); if (((TMASK >> (kk)) & 1u) && ((LMASK >> (ll)) & 1u)) tst_[1] += now_ - tst_[0]; tst_[0] = now_; } } while (0)
#define SEAM(k) SEAM2(k, (k) == 0 ? 11 : ((k) - 1) % PPL, (k) == 0 ? 0 : ((k) - 1) / PPL)

    PH_BEGIN(11, 0) PHASE_BEGIN; ph_prologue(a, ws, lds, tid, lane, wave, bid, G); PH_END
    SEAM(0);
    for (int layer = 0; layer < NLAYERS; ++layer) {
        const int pb = 1 + layer * PPL, li = layer >> 1; const bool even = (layer & 1) == 0;
        const size_t mod_off = WS_MOD + (size_t)layer * 3 * 12288 * 4;
        const size_t wb_off = WS_W + (size_t)layer * W_LAYER;

        PH_BEGIN(0, pb + 0) PHASE_BEGIN; const float* mod = (const float*)(ws + mod_off); float* ssq = (float*)(ws + WS_SSQ) + (size_t)(2 * layer) * MR;
            if (layer == 0) ph_norm0(a.in[0], a.in[2], (float*)(ws + WS_XS), a.in[6], mod + 1 * DM, (bf16*)(ws + WS_H), ssq, gw, NGW, lane);
            else ph_ctxfix<11>((float*)(ws + WS_XS), (const float*)(ws + WS_DST), mod - 3 * 12288 + 2 * 12288 + 5 * DM, a.in[6] + (size_t)layer * DM, mod + 1 * DM, (bf16*)(ws + WS_H), ssq, gw, NGW, lane);
            if (G != 256 || layer == 0) { PHASE_BEGIN; const float* mod2 = (const float*)(ws + mod_off); ph_bias((const bf16*)(ws + wb_off), (const bf16*)(ws + wb_off + W_UP), mod2, (float*)(ws + WS_B1) + (size_t)layer * 3 * NINP, (float*)(ws + WS_B2) + (size_t)layer * 3 * NUP, gw, NGW, lane, 0, G != 256 ? 2 : 1); } }
        SEAM(pb + 0);
        PH_BEGIN(1, pb + 1) PHASE_BEGIN; pg8::Gemm g{(const bf16*)(ws + WS_H), (const bf16*)(ws + wb_off), MR, NINP, DM}; pg8::StaticOrder S; S.init(MR, NINP, G, bid); pg8::EpiStore E{(bf16*)(ws + WS_P), NINP, (const float*)(ws + WS_SSQ) + (size_t)(2 * layer) * MR, (const float*)(ws + WS_B1) + (size_t)layer * 3 * NINP, NINP};
            pg8::gemm_phase<pg8::EpiStore, pg8::StaticOrder, true, true>(lds, g, S, E, wave);
            if (layer + 1 < NLAYERS && G == 256 && bid >= 82) { __syncthreads(); ph_convert(a, ws, lds, (layer + 1) * 25344, (layer + 1) * 25344 + CONV_A, (bid - 82) * NWAVES + wave, 174 * NWAVES, wave, lane); }
            else if (layer + 1 < NLAYERS && G != 256) { __syncthreads(); ph_convert(a, ws, lds, (layer + 1) * 25344, (layer + 2) * 25344, bid * NWAVES + wave, G * NWAVES, wave, lane); }
            if (G == 256 && bid >= 82) { PHASE_BEGIN; const float* mod2 = (const float*)(ws + mod_off); ph_bias((const bf16*)(ws + wb_off), (const bf16*)(ws + wb_off + W_UP), mod2, (float*)(ws + WS_B1) + (size_t)layer * 3 * NINP, (float*)(ws + WS_B2) + (size_t)layer * 3 * NUP, (bid - 82) * NWAVES + wave, 174 * NWAVES, lane, 1, 2); } }
        SEAM(pb + 1);
        PH_BEGIN(2, pb + 2)
            if (even) {
                if (PM(12)) { PHASE_BEGIN; ph_conv8<1>((const bf16*)(ws + WS_P), a.in[13] + (size_t)li * 3 * 1024, (bf16*)(ws + WS_MIX), gtid, NT); }
                if (PM(13)) { PHASE_BEGIN; ScanP sp; fill_scanp(sp, a, ws, li, even); ph_gla_local(sp, (bf16*)(ws + WS_QR), (bf16*)(ws + WS_KR), lds, tid, lane, wave, bid, G); }
            } else {
                if (PM(14)) { PHASE_BEGIN; if (G != 256) ph_qkprep((const bf16*)(ws + WS_P), a.in[16] + (size_t)li * 64, a.in[17] + (size_t)li * 64, (const float*)(ws + WS_ROPE), (bf16*)(ws + WS_QR), (bf16*)(ws + WS_KR), gw, NGW, lane); else if (bid < 240) ph_qkprep((const bf16*)(ws + WS_P), a.in[16] + (size_t)li * 64, a.in[17] + (size_t)li * 64, (const float*)(ws + WS_ROPE), (bf16*)(ws + WS_QR), (bf16*)(ws + WS_KR), gw, 240 * NWAVES, lane); }
                if (PM(15)) { PHASE_BEGIN; ph_conv8<2>((const bf16*)(ws + WS_P), a.in[20] + (size_t)li * 3 * 1024, (bf16*)(ws + WS_MQK), gtid, NT); }
            }
        }
        SEAM(pb + 2);
        PH_BEGIN(3, pb + 3) if (!even) { PHASE_BEGIN; ScanP sp; fill_scanp(sp, a, ws, li, even); ph_mlstm_local(sp, lds, tid, lane, wave, bid, G); } }
        if (!even) SEAM(pb + 3);
        PH_BEGIN(4, pb + 4) PHASE_BEGIN; ScanP sp; fill_scanp(sp, a, ws, li, even); if (even) ph_scan_carry<0>(sp, gtid, NT); else ph_scan_carry<1>(sp, gtid, NT); }
        SEAM(pb + 4);
        PH_BEGIN(5, pb + 5)
            if (even) { if (PM(16)) { PHASE_BEGIN; ScanP sp; fill_scanp(sp, a, ws, li, even); ph_gla_out(sp, (const bf16*)(ws + WS_QR), (const bf16*)(ws + WS_KR), lds, tid, lane, wave, bid, G); } }
            else {
                if (PM(17)) { PHASE_BEGIN; AttnP ap{(const bf16*)(ws + WS_QR), (const bf16*)(ws + WS_KR), (const bf16*)(ws + WS_P), (bf16*)(ws + WS_MIX), a.in[18] + (size_t)li * 256, a.in[19] + (size_t)li * 128, a.in[16] + (size_t)li * 64, a.in[17] + (size_t)li * 64, 0.8f - 0.6f * expf(-0.3f * (float)layer), (unsigned*)(ws + 32768 + 1024 * li), layer == NLAYERS - 1 ? 64 : 68};
                    const float bound = 8.f * wave_max(fabsf(ap.qg[lane])) * wave_max(fabsf(ap.kg[lane])) * 1.4426950408889634f;
                    if (bound < 60.f) ph_attn<false>(ap, lds, tid, lane, wave, bid, G); else ph_attn<true>(ap, lds, tid, lane, wave, bid, G);
                    if (TMASK && wave0 == 0 && xb_lane() == 0u) { const unsigned long long now_ = __builtin_amdgcn_s_memrealtime(); if (((TMASK >> 12) & 1u) && ((LMASK >> layer) & 1u)) tst_[1] += now_ - tst_[0]; tst_[0] = now_; } }
                if (PM(18)) { PHASE_BEGIN; ScanP sp; fill_scanp(sp, a, ws, li, even); ph_mlstm_out(sp, lds, tid, lane, wave, bid, G, layer == NLAYERS - 1 ? 1 : 0, (unsigned*)(ws + 32768 + 1024 * li + 512)); }
            }
        }
        SEAM(pb + 5);
        PH_BEGIN(6, pb + 6) PHASE_BEGIN; pg8::Gemm g{(const bf16*)(ws + WS_MIX), (const bf16*)(ws + wb_off + W_OUT), MR, DM, DM}; pg8::ResidOrder S; S.init(G, bid, layer < NLAYERS - 1 ? 8 : 0, 256);
            pg8::EpiResid2 E{(float*)(ws + WS_XS), layer == 0 ? a.in[0] : (const float*)(ws + WS_XS), (const float*)(ws + mod_off) + 2 * DM, nullptr, (float*)(ws + WS_DST), 0, 256, rep_,
                (bf16*)(ws + WS_H), a.in[7] + (size_t)layer * DM, (const float*)(ws + mod_off) + 4 * DM, (float*)(ws + WS_SSQ) + (size_t)(2 * layer + 1) * MR};
            pg8::gemm_phase<pg8::EpiResid2, pg8::ResidOrder, true, true>(lds, g, S, E, wave);
            if (layer + 1 < NLAYERS && G == 256 && bid >= 128) { __syncthreads(); ph_convert(a, ws, lds, (layer + 1) * 25344 + CONV_A, (layer + 1) * 25344 + CONV_B, (bid - 128) * NWAVES + wave, 128 * NWAVES, wave, lane); } }
        SEAM(pb + 6);
        PH_BEGIN(7, pb + 7) PHASE_BEGIN; const float* mod = (const float*)(ws + mod_off);
            if (layer < NLAYERS - 1) ph_ctxfix<8>((float*)(ws + WS_XS), (const float*)(ws + WS_DST), mod + 2 * 12288 + 2 * DM, a.in[7] + (size_t)layer * DM, mod + 4 * DM, (bf16*)(ws + WS_H), (float*)(ws + WS_SSQ) + (size_t)(2 * layer + 1) * MR, gw, NGW, lane); }
        if (layer < NLAYERS - 1) SEAM(pb + 7);
        PH_BEGIN(8, pb + 8) PHASE_BEGIN; pg8::Gemm g{(const bf16*)(ws + WS_H), (const bf16*)(ws + wb_off + W_UP), MR, NUP, DM}; pg8::StaticOrder S; S.init(MR, NUP, G, bid);
            pg8::EpiAct E{(bf16*)(ws + WS_ACT), a.in[24] + (size_t)layer * 3 * DFF, a.in[25] + (size_t)layer * DFF, (float*)(ws + WS_U), (LAS float*)(lds + 131584), (const float*)(ws + WS_SSQ) + (size_t)(2 * layer + 1) * MR, (const float*)(ws + WS_B2) + (size_t)layer * 3 * NUP, 0};
            pg8::gemm_phase<pg8::EpiAct, pg8::StaticOrder, true, true>(lds, g, S, E, wave);
            if (G == 256 && bid >= 216 && layer + 1 < NLAYERS) { PHASE_BEGIN; const float* mod2 = (const float*)(ws + mod_off) + 3 * 12288; ph_bias((const bf16*)(ws + wb_off + W_LAYER), (const bf16*)(ws + wb_off + W_LAYER + W_UP), mod2, (float*)(ws + WS_B1) + (size_t)(layer + 1) * 3 * NINP, (float*)(ws + WS_B2) + (size_t)(layer + 1) * 3 * NUP, (bid - 216) * NWAVES + wave, 40 * NWAVES, lane, 0, 1); } }
        SEAM(pb + 8);
        PH_BEGIN(10, pb + 10)
            { PHASE_BEGIN; pg8::ResidOrder S0; S0.init(G, bid, layer < NLAYERS - 1 ? 11 : 0, 512); pg8::Unit uu_;
#pragma unroll 1
              for (int i_ = 0; S0.next(i_, uu_); ++i_) act_fix_tile((const float*)(ws + WS_U), a.in[24] + (size_t)layer * 3 * DFF, (bf16*)(ws + WS_ACT), uu_.pm, tid);
              asm volatile("s_waitcnt vmcnt(0)" ::: "memory"); __syncthreads(); }
            PHASE_BEGIN; pg8::Gemm g{(const bf16*)(ws + WS_ACT), (const bf16*)(ws + wb_off + W_DN), MR, DM, DFF}; pg8::ResidOrder S; S.init(G, bid, layer < NLAYERS - 1 ? 11 : 0, 512);
            pg8::EpiResid2 E{(float*)(ws + WS_XS), (const float*)(ws + WS_XS), (const float*)(ws + mod_off) + 5 * DM, a.out, (float*)(ws + WS_DST), layer == NLAYERS - 1 ? 1 : 0, 512, rep_,
                layer < NLAYERS - 1 ? (bf16*)(ws + WS_H) : nullptr, a.in[6] + (size_t)(layer + 1) * DM, (const float*)(ws + mod_off) + 3 * 12288 + 1 * DM, (float*)(ws + WS_SSQ) + (size_t)(2 * layer + 2) * MR};
            pg8::gemm_phase<pg8::EpiResid2, pg8::ResidOrder, true, true>(lds, g, S, E, wave);
            if (layer + 1 < NLAYERS && G == 256 && bid >= 176) { __syncthreads(); ph_convert(a, ws, lds, (layer + 1) * 25344 + CONV_B, (layer + 2) * 25344, (bid - 176) * NWAVES + wave, 80 * NWAVES, wave, lane); } }
        if (layer < NLAYERS - 1) SEAM(pb + 10); else if (TMASK && wave0 == 0 && xb_lane() == 0u) { const unsigned long long now_ = __builtin_amdgcn_s_memrealtime(); if (((TMASK >> 10) & 1u) && ((LMASK >> layer) & 1u)) tst_[1] += now_ - tst_[0]; tst_[0] = now_; }
    }
    if (TMASK) { __syncthreads(); const unsigned long long tacc_ = tst_[1], t0_ = __builtin_amdgcn_s_memrealtime(); while (__builtin_amdgcn_s_memrealtime() - t0_ < tacc_) __builtin_amdgcn_s_sleep(8); }
#undef IN
#undef SEAM
}

extern "C" void kernel_launch(void* const* d_in, const int* in_sizes, int n_in, void* d_out, int out_size, void* d_ws, size_t ws_size, hipStream_t stream) {
    static int grid = 0;
    if (grid == 0) {
        int dev = 0, cus = 0;
        if (n_in != 27 || out_size != NLATR * DM || ws_size < WS_END) { fprintf(stderr, "kernel_launch: unexpected problem (n_in %d out %d ws %zu)\n", n_in, out_size, ws_size); grid = -1; return; }
        if (hipGetDevice(&dev) != hipSuccess || hipDeviceGetAttribute(&cus, hipDeviceAttributeMultiprocessorCount, dev) != hipSuccess) { grid = -1; return; }
        if (hipFuncSetAttribute((const void*)fwd_kernel, hipFuncAttributeMaxDynamicSharedMemorySize, LDS_BYTES) != hipSuccess) { fprintf(stderr, "kernel_launch: hipFuncSetAttribute failed\n"); grid = -1; return; }
        int per_cu = 0;
        if (hipOccupancyMaxActiveBlocksPerMultiprocessor(&per_cu, (const void*)fwd_kernel, NTHR, LDS_BYTES) != hipSuccess || per_cu < 1) fprintf(stderr, "kernel_launch: occupancy query reports %d\n", per_cu);
        (void)hipGetLastError();
        grid = cus;
    }
    if (grid < 0) return;
    (void)hipMemsetAsync((char*)d_ws + WS_CTL, 0, CTL_BYTES, stream);
    Args a{};
    for (int i = 0; i < 27; ++i) a.in[i] = (const float*)d_in[i];
    a.out = (float*)d_out; a.ws = (unsigned char*)d_ws; a.pad = 0;
#if ONE_LAUNCH
    a.ph_lo = 0; a.ph_hi = 1 + NLAYERS * PPL; a.li = 0;
    hipLaunchKernelGGL(fwd_kernel, dim3(grid), dim3(NTHR), LDS_BYTES, stream, a);
#else
    for (int p = 0; p < 1 + NLAYERS * PPL; ++p) {
        const int k = p == 0 ? 0 : (p - 1) % PPL, layer = p == 0 ? 0 : (p - 1) / PPL;
        if (p > 0 && k == 3 && (layer & 1) == 0) continue;
        a.ph_lo = p; a.ph_hi = p + 1; a.li = p;
        hipLaunchKernelGGL(fwd_kernel, dim3(grid), dim3(NTHR), LDS_BYTES, stream, a);
    }
#endif
}
```
